# Optimizing an MI355X kernel written in HIP

```python
import jax
import jax.numpy as jnp
from jax import lax
import numpy as np

D_MODEL = 1024
BATCH = 8
SEQ = 4096
DEPTH = 2

GRID_W = 64
CTX_LEN = 256
NORM_EPS = 1e-6
N_MOD = 6

POOL_WINDOWS = (2, 4, 8, 16)
POOL_WIDTH = D_MODEL // 4
POOL_GROUP = POOL_WIDTH // len(POOL_WINDOWS)

MLA_HEADS = 8
MLA_NOPE = 64
MLA_ROPE = 32
MLA_V = 64
MLA_Q_RANK = 384
MLA_KV_RANK = 256
MLA_WIDTH = MLA_HEADS * MLA_V
Q_BLOCK = 128
ROPE_BASE = 10000.0

RWKV_HEAD = 64
RWKV_WIDTH = D_MODEL // 4
RWKV_HEADS = RWKV_WIDTH // RWKV_HEAD
DECAY_RANK = 64
AAA_RANK = 64
GATE_RANK = 128
RWKV_GN_EPS = 64e-5
RWKV_SIZES = (RWKV_WIDTH, RWKV_WIDTH, RWKV_WIDTH, DECAY_RANK, DECAY_RANK, AAA_RANK, AAA_RANK, GATE_RANK)
RWKV_IN = 3 * RWKV_WIDTH + 2 * DECAY_RANK + 2 * AAA_RANK + GATE_RANK

N_BRANCH = 3
IN_SIZES = (POOL_WIDTH, MLA_Q_RANK, MLA_KV_RANK, MLA_ROPE, RWKV_IN, N_BRANCH * D_MODEL)
IN_COLS = POOL_WIDTH + MLA_Q_RANK + MLA_KV_RANK + MLA_ROPE + RWKV_IN + N_BRANCH * D_MODEL
D_FF = 4 * D_MODEL

kernel_name = 'hybrid_pool_mla_rwkv7_dit_block'


def split_cols(z, sizes):
    idx = []
    acc = 0
    for s in sizes[:-1]:
        acc += s
        idx.append(acc)
    return jnp.split(z, idx, axis=-1)


def rms_norm(x, g, eps=NORM_EPS):
    xf = x.astype(jnp.float32)
    y = xf * lax.rsqrt(jnp.mean(xf * xf, axis=-1, keepdims=True) + eps)
    return (y * g).astype(x.dtype)


def modulate(h, shift, scale):
    return h * (1.0 + scale) + shift


def axial_rope_tables(n_tokens):
    rows = n_tokens // GRID_W
    row = jnp.repeat(jnp.arange(rows), GRID_W).astype(jnp.float32)
    col = jnp.tile(jnp.arange(GRID_W), rows).astype(jnp.float32)
    n_freq = MLA_ROPE // 4
    inv_freq = jnp.power(ROPE_BASE, -jnp.arange(n_freq, dtype=jnp.float32) / n_freq)
    ang = jnp.concatenate([row[:, None] * inv_freq, col[:, None] * inv_freq], axis=-1)
    return jnp.cos(ang), jnp.sin(ang)


def apply_rope(x, cos, sin):
    half = MLA_ROPE // 2
    cos = cos.astype(x.dtype)
    sin = sin.astype(x.dtype)
    x1, x2 = x[..., :half], x[..., half:]
    return jnp.concatenate([x1 * cos - x2 * sin, x1 * sin + x2 * cos], axis=-1)


def pool_mixer(u, pool_w, pool_scale):
    B, L, _ = u.shape
    uf = u.astype(jnp.float32)
    csum = jnp.concatenate([jnp.zeros((B, 1, POOL_WIDTH), jnp.float32), jnp.cumsum(uf, axis=1)], axis=1)
    t = jnp.arange(L)
    groups = []
    for gi, win in enumerate(POOL_WINDOWS):
        sl = slice(gi * POOL_GROUP, (gi + 1) * POOL_GROUP)
        lo = jnp.clip(t - win // 2, 0, L)
        hi = jnp.clip(t + win // 2, 0, L)
        total = jnp.take(csum[..., sl], hi, axis=1) - jnp.take(csum[..., sl], lo, axis=1)
        mean = total / (hi - lo).astype(jnp.float32)[:, None]
        groups.append(mean - uf[..., sl])
    pooled = jnp.stack(groups, axis=2).astype(u.dtype)
    y = jnp.einsum('blgc,gcd->blgd', pooled, pool_w).reshape(B, L, POOL_WIDTH)
    return y * pool_scale


def mla_queries(q_c, p):
    B, L, _ = q_c.shape
    q = (rms_norm(q_c, p['mla_q_norm']) @ p['mla_w_uq']).reshape(B, L, MLA_HEADS, MLA_NOPE + MLA_ROPE)
    q_nope = rms_norm(q[..., :MLA_NOPE], p['qk_gain_q'][:MLA_NOPE])
    q_rope = rms_norm(q[..., MLA_NOPE:], p['qk_gain_q'][MLA_NOPE:])
    return q_nope, q_rope


def mla_keys(kv_c, k_r, p):
    B, L, _ = kv_c.shape
    kv = (rms_norm(kv_c, p['mla_kv_norm']) @ p['mla_w_ukv']).reshape(B, L, MLA_HEADS, MLA_NOPE + MLA_V)
    k_nope = rms_norm(kv[..., :MLA_NOPE], p['qk_gain_k'][:MLA_NOPE])
    v = kv[..., MLA_NOPE:]
    k_rope = rms_norm(k_r, p['qk_gain_k'][MLA_NOPE:])
    return k_nope, k_rope, v


def attend(qn, qr, kn, kr, v):
    s = jnp.einsum('bqhd,bkhd->bhqk', qn, kn) + jnp.einsum('bqhd,bkd->bhqk', qr, kr)
    s = s.astype(jnp.float32) * ((MLA_NOPE + MLA_ROPE) ** -0.5)
    prob = jax.nn.softmax(s, axis=-1)
    return jnp.einsum('bhqk,bkhd->bqhd', prob.astype(v.dtype), v)


def latent_attention(qn, qr, kn, kr, v):
    B, L, H, _ = qn.shape
    nb = L // Q_BLOCK

    def blocks(a):
        return jnp.moveaxis(a.reshape((B, nb, Q_BLOCK) + a.shape[2:]), 1, 0)

    out = lax.map(lambda q: attend(q[0], q[1], kn, kr, v), (blocks(qn), blocks(qr)))
    return jnp.moveaxis(out, 0, 1).reshape(B, L, H * MLA_V)


def bidir_shift(z, mu_prev, mu_next):
    zp = jnp.pad(z, ((0, 0), (1, 0), (0, 0)))[:, :-1]
    zn = jnp.pad(z, ((0, 0), (0, 1), (0, 0)))[:, 1:]
    return z + mu_prev * (zp - z) + mu_next * (zn - z)


def rwkv_prepare(z, p):
    B, L, _ = z.shape
    z = bidir_shift(z.astype(jnp.float32), p['rwkv_mu'][0], p['rwkv_mu'][1])
    r, k, v, wd_f, wd_b, ad_f, ad_b, gd = split_cols(z, RWKV_SIZES)

    def heads(t):
        return t.reshape(B, L, RWKV_HEADS, RWKV_HEAD).astype(jnp.float32)

    kk = heads(k * p['rwkv_kk'])
    kk = kk * lax.rsqrt(jnp.maximum(jnp.sum(kk * kk, axis=-1, keepdims=True), 1e-24))
    dirs = []
    for d, (wd, ad) in enumerate(((wd_f, ad_f), (wd_b, ad_b))):
        w_log = -jax.nn.softplus(-(p['rwkv_w0'][d] + jnp.tanh(wd) @ p['rwkv_w2'][d])) - 0.5
        decay = jnp.exp(-jnp.exp(w_log.astype(jnp.float32)))
        a = jax.nn.sigmoid(p['rwkv_a0'][d] + ad @ p['rwkv_a2'][d])
        k_d = k * (1.0 + (a - 1.0) * p['rwkv_ka'][d])
        a_h = heads(a)
        dirs.append((heads(decay), heads(k_d), -kk, kk * a_h))
    return heads(r), heads(v), gd, dirs


def rwkv7_scan(s0, r, decay, k, a_vec, b_vec, v, reverse, emit):
    def step(S, inp):
        r_t, w_t, k_t, a_t, b_t, v_t = inp
        sa = jnp.einsum('bhvk,bhk->bhv', S, a_t)
        S = S * w_t[:, :, None, :] + sa[..., None] * b_t[:, :, None, :] + v_t[..., None] * k_t[:, :, None, :]
        y = jnp.einsum('bhvk,bhk->bhv', S, r_t) if emit else None
        return S, y

    xs = tuple(jnp.moveaxis(t, 1, 0) for t in (r, decay, k, a_vec, b_vec, v))
    S, ys = lax.scan(step, s0, xs, reverse=reverse)
    return S, (jnp.moveaxis(ys, 0, 1) if emit else None)


def rwkv_readout(y, r, v, k_f, k_b, gd, p):
    B, L = y.shape[:2]
    mu = jnp.mean(y, axis=-1, keepdims=True)
    var = jnp.mean(jnp.square(y - mu), axis=-1, keepdims=True)
    yn = ((y - mu) * lax.rsqrt(var + RWKV_GN_EPS)).reshape(B, L, RWKV_WIDTH) * p['rwkv_ln_w'] + p['rwkv_ln_b']
    bonus = jnp.sum(r * (0.5 * (k_f + k_b)) * p['rwkv_rk'], axis=-1, keepdims=True) * v
    g = jax.nn.sigmoid(gd) @ p['rwkv_g2']
    return (yn + bonus.reshape(B, L, RWKV_WIDTH)) * g


def merge_branches(o_pool, o_mla, o_rwkv, gate_cols, p):
    g_pool, g_mla, g_rwkv = jnp.split(jax.nn.sigmoid(gate_cols), N_BRANCH, axis=-1)
    m = (g_pool * (o_pool @ p['w_br_pool'])
         + g_mla * (o_mla @ p['w_br_mla'])
         + g_rwkv * (o_rwkv @ p['w_br_rwkv']))
    return m @ p['w_o']


def mixer_sublayer(h_l, h_c, p, cos, sin, need_ctx):
    B, L, _ = h_l.shape
    Lc = h_c.shape[1]
    pool_l, qc_l, kvc_l, kr_l, rw_l, gate_l = split_cols(h_l @ p['w_in'], IN_SIZES)
    pool_c, qc_c, kvc_c, kr_c, rw_c, gate_c = split_cols(h_c @ p['w_in'], IN_SIZES)

    o_pool_l = pool_mixer(pool_l, p['pool_w'], p['pool_scale'])

    kn_c, krn_c, v_c = mla_keys(kvc_c, kr_c, p)
    kn_l, krn_l, v_l = mla_keys(kvc_l, kr_l, p)
    krn_l = apply_rope(krn_l, cos, sin)
    qn_l, qr_l = mla_queries(qc_l, p)
    qr_l = apply_rope(qr_l, cos[:, None, :], sin[:, None, :])
    o_mla_l = latent_attention(qn_l, qr_l,
                               jnp.concatenate([kn_l, kn_c], axis=1),
                               jnp.concatenate([krn_l, krn_c], axis=1),
                               jnp.concatenate([v_l, v_c], axis=1))

    r_c, vr_c, gd_c, dirs_c = rwkv_prepare(rw_c, p)
    r_l, vr_l, gd_l, dirs_l = rwkv_prepare(rw_l, p)
    s0 = jnp.zeros((B, RWKV_HEADS, RWKV_HEAD, RWKV_HEAD), jnp.float32)
    ys_l = []
    ys_c = []
    for d in range(2):
        rev = d == 1
        s_ctx, yc = rwkv7_scan(s0, r_c, *dirs_c[d], vr_c, rev, need_ctx)
        _, yl = rwkv7_scan(s_ctx, r_l, *dirs_l[d], vr_l, rev, True)
        ys_l.append(yl)
        ys_c.append(yc)
    o_rwkv_l = rwkv_readout(ys_l[0] + ys_l[1], r_l, vr_l, dirs_l[0][1], dirs_l[1][1], gd_l, p)

    out_l = merge_branches(o_pool_l, o_mla_l, o_rwkv_l, gate_l, p)
    if not need_ctx:
        return out_l, None

    o_pool_c = pool_mixer(pool_c, p['pool_w'], p['pool_scale'])
    qn_c, qr_c = mla_queries(qc_c, p)
    o_mla_c = attend(qn_c, qr_c, kn_c, krn_c, v_c).reshape(B, Lc, MLA_WIDTH)
    o_rwkv_c = rwkv_readout(ys_c[0] + ys_c[1], r_c, vr_c, dirs_c[0][1], dirs_c[1][1], gd_c, p)
    out_c = merge_branches(o_pool_c, o_mla_c, o_rwkv_c, gate_c, p)
    return out_l, out_c


def sq_relu_mlp(h, w1, w2):
    return jnp.square(jax.nn.relu(h @ w1)) @ w2


def setup_inputs(seed: int = 0) -> dict:
    key = jax.random.key(seed)
    keys = iter(jax.random.split(key, 48))

    def nrm(shape, scale):
        return scale * jax.random.normal(next(keys), shape, jnp.float32)

    D = D_MODEL
    return {
        'x': nrm((BATCH, SEQ, D), 1.0),
        'c': nrm((BATCH, D), 1.0),
        'ctx': nrm((BATCH, CTX_LEN, D), 1.0),
        'c_ctx': nrm((D,), 1.0),
        'norm1_g': 1.0 + nrm((DEPTH, D), 0.05),
        'norm2_g': 1.0 + nrm((DEPTH, D), 0.05),
        'w_ada': nrm((DEPTH, D, N_MOD * D), D ** -0.5),
        'b_ada': nrm((DEPTH, N_MOD * D), 0.02),
        'w_in': nrm((DEPTH, D, IN_COLS), D ** -0.5),
        'pool_w': nrm((DEPTH, len(POOL_WINDOWS), POOL_GROUP, POOL_GROUP), POOL_GROUP ** -0.5),
        'pool_scale': 1.0 + nrm((DEPTH, POOL_WIDTH), 0.1),
        'mla_q_norm': 1.0 + nrm((DEPTH, MLA_Q_RANK), 0.05),
        'mla_w_uq': nrm((DEPTH, MLA_Q_RANK, MLA_HEADS * (MLA_NOPE + MLA_ROPE)), MLA_Q_RANK ** -0.5),
        'mla_kv_norm': 1.0 + nrm((DEPTH, MLA_KV_RANK), 0.05),
        'mla_w_ukv': nrm((DEPTH, MLA_KV_RANK, MLA_HEADS * (MLA_NOPE + MLA_V)), MLA_KV_RANK ** -0.5),
        'qk_gain_q': 1.0 + nrm((DEPTH, MLA_NOPE + MLA_ROPE), 0.05),
        'qk_gain_k': 1.0 + nrm((DEPTH, MLA_NOPE + MLA_ROPE), 0.05),
        'rwkv_mu': jax.random.uniform(next(keys), (DEPTH, 2, RWKV_IN), jnp.float32, 0.0, 0.5),
        'rwkv_w0': jnp.linspace(-6.0, -1.0, RWKV_WIDTH, dtype=jnp.float32) + nrm((DEPTH, 2, RWKV_WIDTH), 0.3),
        'rwkv_w2': nrm((DEPTH, 2, DECAY_RANK, RWKV_WIDTH), 0.1 * DECAY_RANK ** -0.5),
        'rwkv_a0': nrm((DEPTH, 2, RWKV_WIDTH), 0.1),
        'rwkv_a2': nrm((DEPTH, 2, AAA_RANK, RWKV_WIDTH), 0.5 * AAA_RANK ** -0.5),
        'rwkv_ka': 1.0 + nrm((DEPTH, 2, RWKV_WIDTH), 0.05),
        'rwkv_kk': 0.85 + nrm((DEPTH, RWKV_WIDTH), 0.05),
        'rwkv_rk': nrm((DEPTH, RWKV_HEADS, RWKV_HEAD), 0.1),
        'rwkv_g2': nrm((DEPTH, GATE_RANK, RWKV_WIDTH), GATE_RANK ** -0.5),
        'rwkv_ln_w': 1.0 + nrm((DEPTH, RWKV_WIDTH), 0.05),
        'rwkv_ln_b': nrm((DEPTH, RWKV_WIDTH), 0.02),
        'w_br_pool': nrm((DEPTH, POOL_WIDTH, D), POOL_WIDTH ** -0.5),
        'w_br_mla': nrm((DEPTH, MLA_WIDTH, D), MLA_WIDTH ** -0.5),
        'w_br_rwkv': nrm((DEPTH, RWKV_WIDTH, D), RWKV_WIDTH ** -0.5),
        'w_o': nrm((DEPTH, D, D), D ** -0.5),
        'mlp_w1': nrm((DEPTH, D, D_FF), D ** -0.5),
        'mlp_w2': nrm((DEPTH, D_FF, D), D_FF ** -0.5),
    }


def reference(x, c, ctx, c_ctx, norm1_g, norm2_g, w_ada, b_ada, w_in, pool_w, pool_scale,
              mla_q_norm, mla_w_uq, mla_kv_norm, mla_w_ukv, qk_gain_q, qk_gain_k,
              rwkv_mu, rwkv_w0, rwkv_w2, rwkv_a0, rwkv_a2, rwkv_ka, rwkv_kk, rwkv_rk, rwkv_g2,
              rwkv_ln_w, rwkv_ln_b, w_br_pool, w_br_mla, w_br_rwkv, w_o, mlp_w1, mlp_w2):
    B, L, D = x.shape
    cos, sin = axial_rope_tables(L)
    silu_c = jax.nn.silu(c)
    silu_cc = jax.nn.silu(c_ctx)
    for i in range(DEPTH):
        need_ctx = i < DEPTH - 1
        p = {
            'w_in': w_in[i], 'pool_w': pool_w[i], 'pool_scale': pool_scale[i],
            'mla_q_norm': mla_q_norm[i], 'mla_w_uq': mla_w_uq[i],
            'mla_kv_norm': mla_kv_norm[i], 'mla_w_ukv': mla_w_ukv[i],
            'qk_gain_q': qk_gain_q[i], 'qk_gain_k': qk_gain_k[i],
            'rwkv_mu': rwkv_mu[i], 'rwkv_w0': rwkv_w0[i], 'rwkv_w2': rwkv_w2[i],
            'rwkv_a0': rwkv_a0[i], 'rwkv_a2': rwkv_a2[i], 'rwkv_ka': rwkv_ka[i],
            'rwkv_kk': rwkv_kk[i], 'rwkv_rk': rwkv_rk[i], 'rwkv_g2': rwkv_g2[i],
            'rwkv_ln_w': rwkv_ln_w[i], 'rwkv_ln_b': rwkv_ln_b[i],
            'w_br_pool': w_br_pool[i], 'w_br_mla': w_br_mla[i], 'w_br_rwkv': w_br_rwkv[i],
            'w_o': w_o[i],
        }
        mod_l = (silu_c @ w_ada[i] + b_ada[i]).reshape(B, 1, N_MOD, D)
        sh1, sc1, g1, sh2, sc2, g2 = (mod_l[:, :, j] for j in range(N_MOD))
        mod_c = (silu_cc @ w_ada[i] + b_ada[i]).reshape(N_MOD, D)
        csh1, csc1, cg1, csh2, csc2, cg2 = (mod_c[j] for j in range(N_MOD))

        h_l = modulate(rms_norm(x, norm1_g[i]), sh1, sc1)
        h_c = modulate(rms_norm(ctx, norm1_g[i]), csh1, csc1)
        o_l, o_c = mixer_sublayer(h_l, h_c, p, cos, sin, need_ctx)
        x = x + g1 * o_l
        x = x + g2 * sq_relu_mlp(modulate(rms_norm(x, norm2_g[i]), sh2, sc2), mlp_w1[i], mlp_w2[i])
        if need_ctx:
            ctx = ctx + cg1 * o_c
            ctx = ctx + cg2 * sq_relu_mlp(modulate(rms_norm(ctx, norm2_g[i]), csh2, csc2), mlp_w1[i], mlp_w2[i])
    return x
```

```cpp
#include <hip/hip_runtime.h>
#include <hip/hip_cooperative_groups.h>
#include <stdint.h>
#include <cstdio>
namespace cg = cooperative_groups;

typedef unsigned short u16;
typedef __attribute__((ext_vector_type(8))) short bf16x8;
typedef __attribute__((ext_vector_type(4))) float f32x4;
typedef __attribute__((ext_vector_type(16))) float f32x16;
typedef __bf16 bf16x2_t __attribute__((ext_vector_type(2)));
typedef float float2_t __attribute__((ext_vector_type(2)));

#define DI __device__ __forceinline__

constexpr int D = 1024, NB = 8, L = 4096, LC = 256, LK = 4352;
constexpr int NTL = NB * L;
constexpr int NTC = NB * LC;
constexpr int NT = NTL + NTC;
constexpr int INC = 5152;
constexpr int ZA = 928;
constexpr int ZR = 1152;
constexpr int DFF = 4096;

constexpr size_t al256(size_t x) { return (x + 255) / 256 * 256; }
constexpr size_t OFF_BAR = 0;
constexpr size_t OFF_MODS = 4096;
constexpr size_t OFF_TAB = OFF_MODS + al256(2 * 9 * 6144 * 4);
constexpr size_t OFF_ROPE = OFF_TAB + al256(2 * 2 * 9 * 2 * 1024 * 4);
constexpr size_t OFF_RS1 = OFF_ROPE + 4096;
constexpr size_t OFF_RS2 = OFF_RS1 + al256(NT * 4);
constexpr size_t OFF_RSQ = OFF_RS2 + al256(NT * 4);
constexpr size_t OFF_RSKV = OFF_RSQ + al256(NT * 4);
constexpr size_t OFF_CTX = OFF_RSKV + al256(NT * 4);
constexpr size_t OFF_W = OFF_CTX + (size_t)NTC * D * 4;
constexpr size_t WO_WIN = 0;
constexpr size_t WO_UQ = WO_WIN + (size_t)INC * 1024 * 2;
constexpr size_t WO_UKV = WO_UQ + (size_t)768 * 384 * 2;
constexpr size_t WO_BRP = WO_UKV + (size_t)1024 * 256 * 2;
constexpr size_t WO_BRM = WO_BRP + (size_t)1024 * 256 * 2;
constexpr size_t WO_BRR = WO_BRM + (size_t)1024 * 512 * 2;
constexpr size_t WO_WO = WO_BRR + (size_t)1024 * 256 * 2;
constexpr size_t WO_W1 = WO_WO + (size_t)1024 * 1024 * 2;
constexpr size_t WO_W2 = WO_W1 + (size_t)4096 * 1024 * 2;
constexpr size_t WO_RW2 = WO_W2 + (size_t)1024 * 4096 * 2;
constexpr size_t WO_RA2 = WO_RW2 + (size_t)2 * 256 * 64 * 2;
constexpr size_t WO_RG2 = WO_RA2 + (size_t)2 * 256 * 64 * 2;
constexpr size_t W_LAYER = al256(WO_RG2 + (size_t)256 * 128 * 2);
constexpr size_t OFF_R1 = OFF_W + 2 * W_LAYER;
constexpr size_t SZ_Q = (size_t)NB * 8 * LK * 96 * 2;
constexpr size_t SZ_VT = (size_t)NB * 8 * 64 * LK * 2;
constexpr size_t SZ_R1 = 2 * SZ_Q + SZ_VT;
constexpr size_t OFF_R2 = OFF_R1 + al256(SZ_R1);
constexpr size_t SZ_TOK256 = (size_t)NT * 256 * 2;
constexpr size_t OFF_R3 = OFF_R2 + al256((size_t)NT * ZA * 2);
constexpr size_t OFF_R4 = OFF_R3 + 10 * SZ_TOK256;
constexpr size_t OFF_KR = OFF_R4 + SZ_TOK256;
constexpr size_t WS_END = OFF_KR + (size_t)NT * 32 * 2;
enum { SA_R = 0, SA_V = 1, SA_KDF = 2, SA_KDB = 3, SA_G = 4, SA_KKN = 5, SA_OMWF = 6, SA_BF = 7, SA_OMWB = 8, SA_BB = 9 };

struct Params { const float* in[34]; float* out; char* ws; };

enum { I_X = 0, I_C, I_CTX, I_CCTX, I_N1G, I_N2G, I_WADA, I_BADA, I_WIN, I_POOLW, I_POOLS, I_QNORM, I_WUQ, I_KVNORM, I_WUKV,
       I_GQ, I_GK, I_MU, I_W0, I_W2R, I_A0, I_A2R, I_KA, I_KK, I_RK, I_G2R, I_LNW, I_LNB, I_BRP, I_BRM, I_BRR, I_WO, I_W1, I_W2 };

DI float bf2f(u16 h) { return __uint_as_float(((unsigned)h) << 16); }
DI float bflo(unsigned u) { return __uint_as_float(u << 16); }
DI float bfhi(unsigned u) { return __uint_as_float(u & 0xffff0000u); }
DI unsigned pack2(float a, float b) { float2_t v = {a, b}; bf16x2_t r = __builtin_convertvector(v, bf16x2_t); return __builtin_bit_cast(unsigned, r); }
DI u16 f2bf(float a) { return (u16)(pack2(a, 0.f) & 0xffffu); }
DI float sigmoidf_(float x) { return 1.f / (1.f + __expf(-x)); }
DI float siluf_(float x) { return x / (1.f + __expf(-x)); }
DI float rowsum16(float x) {
  x += __builtin_bit_cast(float, __builtin_amdgcn_update_dpp(0, __builtin_bit_cast(int, x), 0x128, 0xf, 0xf, false));
  x += __builtin_bit_cast(float, __builtin_amdgcn_update_dpp(0, __builtin_bit_cast(int, x), 0x124, 0xf, 0xf, false));
  x += __builtin_bit_cast(float, __builtin_amdgcn_update_dpp(0, __builtin_bit_cast(int, x), 0x122, 0xf, 0xf, false));
  x += __builtin_bit_cast(float, __builtin_amdgcn_update_dpp(0, __builtin_bit_cast(int, x), 0x121, 0xf, 0xf, false));
  return x;
}
DI float wavesum(float x) {
  for (int o = 32; o > 0; o >>= 1) x += __shfl_xor(x, o, 64);
  return x;
}
DI void grid_barrier(unsigned* ctr, unsigned& epoch) {
  asm volatile("s_waitcnt vmcnt(0)" ::: "memory");
  __syncthreads();
  epoch++;
  if (threadIdx.x == 0) {
    __builtin_amdgcn_fence(__ATOMIC_RELEASE, "agent");
    asm volatile("s_waitcnt vmcnt(0)" ::: "memory");
    const unsigned target = epoch * gridDim.x;
    __hip_atomic_fetch_add(ctr, 1u, __ATOMIC_RELAXED, __HIP_MEMORY_SCOPE_AGENT);
    while (__hip_atomic_load(ctr, __ATOMIC_RELAXED, __HIP_MEMORY_SCOPE_AGENT) < target) __builtin_amdgcn_s_sleep(2);
    __builtin_amdgcn_fence(__ATOMIC_ACQUIRE, "agent");
    asm volatile("s_waitcnt vmcnt(0)" ::: "memory");
  }
  __syncthreads();
}

DI int launder_v(int x) { asm volatile("" : "+v"(x)); return x; }
DI int launder_s(int x) { asm volatile("" : "+s"(x)); return x; }
#define LAUNDER_IDS const int tid__ = launder_v((int)threadIdx.x); const int blk__ = launder_s((int)blockIdx.x); (void)tid__; (void)blk__;
DI void do_transpose(const float* __restrict__ src, int K, int N, u16* __restrict__ dst, const float* __restrict__ ksc, int perm, int tile, float* tl) {
  LAUNDER_IDS
  const int ntn = (N + 63) >> 6;
  const int kt = tile / ntn, nt = tile - kt * ntn;
  const int k0 = kt * 64, n0 = nt * 64;
  const int tid = tid__;
  __syncthreads();
#pragma unroll 4
  for (int i = 0; i < 16; ++i) {
    const int kk = i * 4 + (tid >> 6), nn = tid & 63;
    float v = 0.f;
    if (n0 + nn < N) v = src[(size_t)(k0 + kk) * N + n0 + nn];
    if (ksc) v *= ksc[k0 + kk];
    tl[kk * 65 + nn] = v;
  }
  __syncthreads();
#pragma unroll 4
  for (int i = 0; i < 16; ++i) {
    const int nn = i * 4 + (tid >> 6), kk = tid & 63;
    int n = n0 + nn;
    if (n < N) {
      if (perm) { const int h = n / 96, d = n - h * 96; n = d < 64 ? h * 64 + d : 512 + h * 32 + (d - 64); }
      dst[(size_t)n * K + k0 + kk] = f2bf(tl[kk * 65 + nn]);
    }
  }
}

DI void phase_prep(const Params& p, char* smem) {
  LAUNDER_IDS
  float* tl = (float*)smem;
  const int tid = tid__;
  constexpr int T_WIN = 16 * 81, T_UQ = 6 * 12, T_UKV = 4 * 16, T_BRM = 8 * 16, T_BRR = 4 * 16, T_WO = 16 * 16, T_W1 = 16 * 64, T_W2 = 64 * 16,
                T_RW2 = 4, T_RA2 = 4, T_RG2 = 2 * 4;
  constexpr int T_LAYER = T_WIN + T_UQ + T_UKV + T_BRM + T_BRR + T_WO + T_W1 + T_W2 + 2 * T_RW2 + 2 * T_RA2 + T_RG2;
  for (int g = blk__; g < 2 * T_LAYER; g += gridDim.x) {
    const int l = g / T_LAYER; int t = g - l * T_LAYER;
    char* wl = p.ws + OFF_W + (size_t)l * W_LAYER;
#define JOB(SRC, KK, NN, DSTOFF, SC, PERM, CNT) if (t < (CNT)) { do_transpose((SRC), (KK), (NN), (u16*)(wl + (DSTOFF)), (SC), (PERM), t, tl); continue; } t -= (CNT);
    JOB(p.in[I_WIN] + (size_t)l * 1024 * INC, 1024, INC, WO_WIN, nullptr, 0, T_WIN)
    JOB(p.in[I_WUQ] + (size_t)l * 384 * 768, 384, 768, WO_UQ, p.in[I_QNORM] + l * 384, 1, T_UQ)
    JOB(p.in[I_WUKV] + (size_t)l * 256 * 1024, 256, 1024, WO_UKV, p.in[I_KVNORM] + l * 256, 0, T_UKV)
    JOB(p.in[I_BRM] + (size_t)l * 512 * 1024, 512, 1024, WO_BRM, nullptr, 0, T_BRM)
    JOB(p.in[I_BRR] + (size_t)l * 256 * 1024, 256, 1024, WO_BRR, nullptr, 0, T_BRR)
    JOB(p.in[I_WO] + (size_t)l * 1024 * 1024, 1024, 1024, WO_WO, nullptr, 0, T_WO)
    JOB(p.in[I_W1] + (size_t)l * 1024 * 4096, 1024, 4096, WO_W1, nullptr, 0, T_W1)
    JOB(p.in[I_W2] + (size_t)l * 4096 * 1024, 4096, 1024, WO_W2, nullptr, 0, T_W2)
    JOB(p.in[I_W2R] + (size_t)(l * 2 + 0) * 64 * 256, 64, 256, WO_RW2, nullptr, 0, T_RW2)
    JOB(p.in[I_W2R] + (size_t)(l * 2 + 1) * 64 * 256, 64, 256, WO_RW2 + 256 * 64 * 2, nullptr, 0, T_RW2)
    JOB(p.in[I_A2R] + (size_t)(l * 2 + 0) * 64 * 256, 64, 256, WO_RA2, nullptr, 0, T_RA2)
    JOB(p.in[I_A2R] + (size_t)(l * 2 + 1) * 64 * 256, 64, 256, WO_RA2 + 256 * 64 * 2, nullptr, 0, T_RA2)
    JOB(p.in[I_G2R] + (size_t)l * 128 * 256, 128, 256, WO_RG2, nullptr, 0, T_RG2)
#undef JOB
  }
  for (int e = blk__ * 256 + tid; e < 2 * 256 * 1024; e += gridDim.x * 256) {
    const int l = e >> 18, r = e & 262143, cin = r >> 10, n = r & 1023, g = cin >> 6, c = cin & 63;
    const float* pw = p.in[I_POOLW] + ((size_t)(l * 4 + g) * 64 + c) * 64;
    const float* ps = p.in[I_POOLS] + l * 256 + g * 64;
    const float* wb = p.in[I_BRP] + ((size_t)l * 256 + g * 64) * 1024 + n;
    float s = 0.f;
    for (int d = 0; d < 64; ++d) s += pw[d] * ps[d] * wb[(size_t)d * 1024];
    ((u16*)(p.ws + OFF_W + (size_t)l * W_LAYER + WO_BRP))[(size_t)n * 256 + cin] = f2bf(s);
  }
  if (blk__ == gridDim.x - 1) {
    for (int e = tid; e < 512; e += 256) {
      const int pos = e >> 3, f = e & 7;
      const float inv = powf(10000.f, -(float)f / 8.f);
      const float ang = (float)pos * inv;
      float* rt = (float*)(p.ws + OFF_ROPE);
      rt[e * 2] = cosf(ang); rt[e * 2 + 1] = sinf(ang);
    }
  }
  {
    float* sl = (float*)smem;
    float* red = sl + 9 * 1024;
    __syncthreads();
    for (int e = tid; e < 9 * 1024; e += 256) {
      const int b = e >> 10, k = e & 1023;
      const float v = b < 8 ? p.in[I_C][b * 1024 + k] : p.in[I_CCTX][k];
      sl[e] = siluf_(v);
    }
    __syncthreads();
    const int wave = tid >> 6, lane = tid & 63;
    for (int it = blk__; it < 192; it += gridDim.x) {
      const int l = it / 96, cg_ = it - l * 96;
      const int col = cg_ * 64 + lane;
      const float* wa = p.in[I_WADA] + (size_t)l * 1024 * 6144 + col;
      float acc[9];
#pragma unroll
      for (int b = 0; b < 9; ++b) acc[b] = 0.f;
#pragma unroll 8
      for (int k = wave * 256; k < wave * 256 + 256; ++k) {
        const float w = wa[(size_t)k * 6144];
#pragma unroll
        for (int b = 0; b < 9; ++b) acc[b] += sl[b * 1024 + k] * w;
      }
#pragma unroll
      for (int b = 0; b < 9; ++b) red[(wave * 9 + b) * 64 + lane] = acc[b];
      __syncthreads();
      for (int e = tid; e < 9 * 64; e += 256) {
        const int b = e >> 6, c = e & 63;
        const float s = red[(0 * 9 + b) * 64 + c] + red[(1 * 9 + b) * 64 + c] + red[(2 * 9 + b) * 64 + c] + red[(3 * 9 + b) * 64 + c];
        ((float*)(p.ws + OFF_MODS))[(size_t)(l * 9 + b) * 6144 + cg_ * 64 + c] = s + p.in[I_BADA][l * 6144 + cg_ * 64 + c];
      }
      __syncthreads();
    }
  }
}

DI const float* xrow(const float* xl, const float* xc, int r) { return r < NTL ? xl + (size_t)r * D : xc + (size_t)(r - NTL) * D; }

DI void phase_stats(const float* xl, const float* xc, float* rs, int M) {
  LAUNDER_IDS
  const int wave = tid__ >> 6, lane = tid__ & 63;
  for (int r = blk__ * 4 + wave; r < M; r += gridDim.x * 4) {
    const float* xp = xrow(xl, xc, r);
    float s = 0.f;
#pragma unroll
    for (int i = 0; i < 4; ++i) { const float4 v = *(const float4*)(xp + i * 256 + lane * 4); s += v.x * v.x + v.y * v.y + v.z * v.z + v.w * v.w; }
    s = wavesum(s);
    if (lane == 0) rs[r] = rsqrtf(s * (1.f / 1024.f) + 1e-6f);
  }
}
DI void phase_tables(const Params& p) {
  LAUNDER_IDS
  const float* mods = (const float*)(p.ws + OFF_MODS);
  float* tab = (float*)(p.ws + OFF_TAB);
  for (int e = blk__ * 256 + tid__; e < 2 * 2 * 9 * 1024; e += gridDim.x * 256) {
    const int k = e & 1023, b9 = (e >> 10) % 9, ln = (e >> 10) / 9, l = ln >> 1, nrm = ln & 1;
    const float g = p.in[nrm ? I_N2G : I_N1G][l * 1024 + k];
    const float sh = mods[(size_t)(l * 9 + b9) * 6144 + (nrm * 3 + 0) * 1024 + k];
    const float sc = mods[(size_t)(l * 9 + b9) * 6144 + (nrm * 3 + 1) * 1024 + k];
    float* t = tab + ((size_t)(l * 2 + nrm) * 9 + b9) * 2048;
    t[k] = g * (1.f + sc); t[1024 + k] = sh;
  }
}

struct LoadBf16 {
  const u16* A; int lda;
  DI void init(int m0) {}
  DI uint4 load(int i, int m0, int k0) const {
    LAUNDER_IDS
    const int tid = tid__, kc = (tid & 7) * 8;
    return *(const uint4*)(A + (size_t)(m0 + (tid >> 3) + i * 32) * lda + k0 + kc);
  }
};
struct LoadNorm {
  const float* xl; const float* xc; const float* rs; const float* tab;
  float r0, r1, r2, r3;
  DI void init(int m0) {
    LAUNDER_IDS
    const int tid = tid__;
    r0 = rs[m0 + (tid >> 3)]; r1 = rs[m0 + (tid >> 3) + 32]; r2 = rs[m0 + (tid >> 3) + 64]; r3 = rs[m0 + (tid >> 3) + 96];
  }
  DI uint4 load(int i, int m0, int k0) const {
    LAUNDER_IDS
    const int tid = tid__, kc = (tid & 7) * 8;
    const int b9 = m0 < NTL ? m0 >> 12 : 8;
    const float* t = tab + b9 * 2048 + k0 + kc;
    const float4 g0 = *(const float4*)t, g1 = *(const float4*)(t + 4), s0 = *(const float4*)(t + 1024), s1 = *(const float4*)(t + 1028);
    const float* xp = xrow(xl, xc, m0 + (tid >> 3)) + k0 + kc + (size_t)i * 32 * D;
    const float4 x0 = *(const float4*)xp, x1 = *(const float4*)(xp + 4);
    const float rr = i == 0 ? r0 : i == 1 ? r1 : i == 2 ? r2 : r3;
    uint4 o;
    o.x = pack2(x0.x * rr * g0.x + s0.x, x0.y * rr * g0.y + s0.y);
    o.y = pack2(x0.z * rr * g0.z + s0.z, x0.w * rr * g0.w + s0.w);
    o.z = pack2(x1.x * rr * g1.x + s1.x, x1.y * rr * g1.y + s1.y);
    o.w = pack2(x1.z * rr * g1.z + s1.z, x1.w * rr * g1.w + s1.w);
    return o;
  }
};

constexpr int LDT = 72;
template <int NI, class LA>
DI void gemm_mainloop(f32x4 (&acc)[4][NI], LA la, const u16* __restrict__ Bt, int ldb, int K, int m0, int n0, char* smem) {
  LAUNDER_IDS
  constexpr int NBI = NI;
  u16* As = (u16*)smem; u16* Bs = As + 2 * 128 * LDT;
  const int tid = tid__, lane = tid & 63, wave = tid >> 6, wr = wave >> 1, wc = wave & 1, lr = lane & 15, lq = lane >> 4;
  uint4 ra[4], rb[NBI];
  la.init(m0);
#pragma unroll
  for (int i = 0; i < 4; ++i) ra[i] = la.load(i, m0, 0);
#pragma unroll
  for (int i = 0; i < NBI; ++i) {
    const int c = tid + i * 256, row = c >> 3, kc = (c & 7) * 8;
    rb[i] = *(const uint4*)(Bt + (size_t)(n0 + row) * ldb + kc);
  }
#pragma unroll
  for (int i = 0; i < 4; ++i) {
    const int c = tid + i * 256, row = c >> 3, kc = (c & 7) * 8;
    *(uint4*)(As + row * LDT + kc) = ra[i];
    if (i < NBI) *(uint4*)(Bs + row * LDT + kc) = rb[i];
  }
  __syncthreads();
  const int nk = K >> 6;
  for (int kt = 0; kt < nk; ++kt) {
    const int cur = kt & 1;
    if (kt + 1 < nk) {
      const int k0 = (kt + 1) * 64;
#pragma unroll
      for (int i = 0; i < 4; ++i) ra[i] = la.load(i, m0, k0);
#pragma unroll
      for (int i = 0; i < NBI; ++i) {
        const int c = tid + i * 256, row = c >> 3, kc = (c & 7) * 8;
        rb[i] = *(const uint4*)(Bt + (size_t)(n0 + row) * ldb + k0 + kc);
      }
    }
    const u16* Ac = As + cur * 128 * LDT + (wr * 64 + lr) * LDT + lq * 8;
    const u16* Bc = Bs + cur * 128 * LDT + (wc * 16 * NI + lr) * LDT + lq * 8;
#pragma unroll
    for (int ks = 0; ks < 2; ++ks) {
      bf16x8 af[4], bfr[NI];
#pragma unroll
      for (int mi = 0; mi < 4; ++mi) af[mi] = *(const bf16x8*)(Ac + mi * 16 * LDT + ks * 32);
#pragma unroll
      for (int ni = 0; ni < NI; ++ni) bfr[ni] = *(const bf16x8*)(Bc + ni * 16 * LDT + ks * 32);
#pragma unroll
      for (int mi = 0; mi < 4; ++mi)
#pragma unroll
        for (int ni = 0; ni < NI; ++ni)
          acc[mi][ni] = __builtin_amdgcn_mfma_f32_16x16x32_bf16(bfr[ni], af[mi], acc[mi][ni], 0, 0, 0);
    }
    if (kt + 1 < nk) {
      const int nxt = cur ^ 1;
#pragma unroll
      for (int i = 0; i < 4; ++i) {
        const int c = tid + i * 256, row = c >> 3, kc = (c & 7) * 8;
        *(uint4*)(As + nxt * 128 * LDT + row * LDT + kc) = ra[i];
        if (i < NBI) *(uint4*)(Bs + nxt * 128 * LDT + row * LDT + kc) = rb[i];
      }
    }
    __syncthreads();
  }
}
template <int NI>
DI void zero_acc(f32x4 (&acc)[4][NI]) {
#pragma unroll
  for (int i = 0; i < 4; ++i)
#pragma unroll
    for (int j = 0; j < NI; ++j) acc[i][j] = f32x4{0.f, 0.f, 0.f, 0.f};
}
#define WAVE_COORDS const int lane = tid__ & 63, wave = tid__ >> 6, wr = wave >> 1, wc = wave & 1, lr = lane & 15, lq = lane >> 4; (void)wr; (void)wc; (void)lr; (void)lq;

DI void phase_zgemm(const Params& p, int l, const float* xl, const float* xc, char* smem) {
  LAUNDER_IDS
  WAVE_COORDS
  const u16* Wt = (const u16*)(p.ws + OFF_W + (size_t)l * W_LAYER + WO_WIN);
  LoadNorm la{xl, xc, (const float*)(p.ws + OFF_RS1), (const float*)(p.ws + OFF_TAB) + (size_t)(l * 2 + 0) * 9 * 2048};
  u16* za = (u16*)(p.ws + OFF_R2); u16* zr = (u16*)(p.ws + OFF_R1);
  constexpr int NTN = 17, NTM = NT / 128;
  for (int t = blk__; t < NTN * NTM; t += gridDim.x) {
    const int tm = t / NTN, tn = t - tm * NTN;
    const int m0 = tm * 128, n0 = tn * 128;
    f32x4 acc[4][4]; zero_acc<4>(acc);
    gemm_mainloop<4>(acc, la, Wt, 1024, 1024, m0, n0, smem);
#pragma unroll
    for (int mi = 0; mi < 4; ++mi) {
      const int m = m0 + wr * 64 + mi * 16 + lr;
#pragma unroll
      for (int ni = 0; ni < 4; ++ni) {
        const int n = n0 + wc * 64 + ni * 16 + lq * 4;
        uint2 v; v.x = pack2(acc[mi][ni][0], acc[mi][ni][1]); v.y = pack2(acc[mi][ni][2], acc[mi][ni][3]);
        if (n < ZA) *(uint2*)(za + (size_t)m * ZA + n) = v;
        else if (n < ZA + ZR) *(uint2*)(zr + (size_t)m * ZR + (n - ZA)) = v;
      }
    }
  }
}

DI void phase_tokA(const Params& p, int l) {
  LAUNDER_IDS
  const int wave = tid__ >> 6, lane = tid__ & 63;
  const u16* za = (const u16*)(p.ws + OFF_R2);
  float* rsq = (float*)(p.ws + OFF_RSQ); float* rskv = (float*)(p.ws + OFF_RSKV);
  u16* krb = (u16*)(p.ws + OFF_KR);
  u16* pooled = (u16*)(p.ws + OFF_R4);
  const float* rt = (const float*)(p.ws + OFF_ROPE);
  const float* gk = p.in[I_GK] + l * 96;
  for (int r = blk__ * 4 + wave; r < NT; r += gridDim.x * 4) {
    const u16* z = za + (size_t)r * ZA;
    const bool lat = r < NTL;
    const int b = lat ? r >> 12 : (r - NTL) >> 8;
    const int t = lat ? r & 4095 : (r - NTL) & 255;
    const int Ls = lat ? L : LC;
    const int pos = lat ? t : 4096 + t;
    float sq = 0.f, skv = 0.f;
#pragma unroll
    for (int i = 0; i < 6; ++i) { const float v = bf2f(z[256 + i * 64 + lane]); sq += v * v; }
#pragma unroll
    for (int i = 0; i < 4; ++i) { const float v = bf2f(z[640 + i * 64 + lane]); skv += v * v; }
    sq = wavesum(sq); skv = wavesum(skv);
    if (lane == 0) { rsq[r] = rsqrtf(sq * (1.f / 384.f) + 1e-6f); rskv[r] = rsqrtf(skv * (1.f / 256.f) + 1e-6f); }
    {
      const int d = lane & 31;
      float kr = bf2f(z[896 + d]);
      float ss = kr * kr;
      for (int o = 16; o > 0; o >>= 1) ss += __shfl_xor(ss, o, 64);
      kr = kr * rsqrtf(ss * (1.f / 32.f) + 1e-6f) * gk[64 + d];
      const float other = __shfl_xor(kr, 16, 64);
      float outv = kr;
      if (lat) {
        const int i = d & 15;
        const int pp = i < 8 ? (t >> 6) : (t & 63);
        const float cs = rt[(pp * 8 + (i & 7)) * 2], sn = rt[(pp * 8 + (i & 7)) * 2 + 1];
        outv = d < 16 ? kr * cs - other * sn : other * sn + kr * cs;
      }
      if (lane < 32) krb[(size_t)r * 32 + d] = f2bf(outv);
    }
#pragma unroll
    for (int gi = 0; gi < 4; ++gi) {
      const int half = 1 << gi;
      const int lo = max(t - half, 0), hi = min(t + half, Ls);
      const int ch = gi * 64 + lane;
      float s = 0.f;
      for (int q = lo; q < hi; ++q) s += bf2f(z[(ptrdiff_t)(q - t) * ZA + ch]);
      const float mean = s / (float)(hi - lo);
      pooled[(size_t)r * 256 + ch] = f2bf(mean - bf2f(z[ch]));
    }
  }
}

constexpr int ZSL = 1160, TAL = 392;
DI void phase_tokB(const Params& p, int l, char* smem) {
  LAUNDER_IDS
  WAVE_COORDS
  const int tid = tid__;
  u16* Zs = (u16*)smem;
  u16* TA = Zs + 18 * ZSL;
  const u16* zr = (const u16*)(p.ws + OFF_R1);
  const char* wl = p.ws + OFF_W + (size_t)l * W_LAYER;
  const float* mu0 = p.in[I_MU] + (size_t)(l * 2 + 0) * ZR;
  const float* mu1 = p.in[I_MU] + (size_t)(l * 2 + 1) * ZR;
  u16* sc = (u16*)(p.ws + OFF_R3);
  for (int tile = blk__; tile < NT / 16; tile += gridDim.x) {
    const int r0 = tile * 16;
    const bool lat = r0 < NTL;
    const int t0 = lat ? r0 & 4095 : (r0 - NTL) & 255;
    const int Ls = lat ? L : LC;
    __syncthreads();
    for (int c = tid; c < 18 * 144; c += 256) {
      const int i = c / 144, ch = c - i * 144;
      const int tt = t0 - 1 + i;
      uint4 v = make_uint4(0, 0, 0, 0);
      if (tt >= 0 && tt < Ls) v = *(const uint4*)(zr + (size_t)(r0 - 1 + i) * ZR + ch * 8);
      *(uint2*)(Zs + i * ZSL + ch * 8) = make_uint2(v.x, v.y);
      *(uint2*)(Zs + i * ZSL + ch * 8 + 4) = make_uint2(v.z, v.w);
    }
    __syncthreads();
    for (int e = tid; e < 16 * 384; e += 256) {
      const int i = e / 384, c = e - i * 384, zc = 768 + c;
      const float z = bf2f(Zs[(i + 1) * ZSL + zc]), zp = bf2f(Zs[i * ZSL + zc]), zn = bf2f(Zs[(i + 2) * ZSL + zc]);
      float v = z + mu0[zc] * (zp - z) + mu1[zc] * (zn - z);
      if (c < 128) v = tanhf(v); else if (c >= 256) v = sigmoidf_(v);
      TA[i * TAL + c] = f2bf(v);
    }
    __syncthreads();
    const int row = r0 + lr;
    auto shifted4 = [&](int zc, float (&out)[4]) {
      const uint2 c0 = *(const uint2*)(Zs + (lr + 1) * ZSL + zc), cp = *(const uint2*)(Zs + lr * ZSL + zc), cn = *(const uint2*)(Zs + (lr + 2) * ZSL + zc);
      const float4 m0 = *(const float4*)(mu0 + zc), m1 = *(const float4*)(mu1 + zc);
      float z, zp, zn;
      z = bflo(c0.x); zp = bflo(cp.x); zn = bflo(cn.x); out[0] = z + m0.x * (zp - z) + m1.x * (zn - z);
      z = bfhi(c0.x); zp = bfhi(cp.x); zn = bfhi(cn.x); out[1] = z + m0.y * (zp - z) + m1.y * (zn - z);
      z = bflo(c0.y); zp = bflo(cp.y); zn = bflo(cn.y); out[2] = z + m0.z * (zp - z) + m1.z * (zn - z);
      z = bfhi(c0.y); zp = bfhi(cp.y); zn = bfhi(cn.y); out[3] = z + m0.w * (zp - z) + m1.w * (zn - z);
    };
    auto product = [&](f32x4 (&ac)[4], const u16* W, int Kq, int off) {
#pragma unroll
      for (int ni = 0; ni < 4; ++ni) ac[ni] = f32x4{0.f, 0.f, 0.f, 0.f};
      for (int ks = 0; ks < Kq / 32; ++ks) {
        const bf16x8 bop = *(const bf16x8*)(TA + lr * TAL + off + ks * 32 + lq * 8);
#pragma unroll
        for (int ni = 0; ni < 4; ++ni) {
          const bf16x8 aop = *(const bf16x8*)(W + (size_t)(wave * 64 + ni * 16 + lr) * Kq + ks * 32 + lq * 8);
          ac[ni] = __builtin_amdgcn_mfma_f32_16x16x32_bf16(aop, bop, ac[ni], 0, 0, 0);
        }
      }
    };
    float ss = 0.f;
#pragma unroll
    for (int ni = 0; ni < 4; ++ni) {
      const int ch = wave * 64 + ni * 16 + lq * 4;
      float kx[4]; shifted4(256 + ch, kx);
      const float4 kw = *(const float4*)(p.in[I_KK] + l * 256 + ch);
      const float a0 = kx[0] * kw.x, a1 = kx[1] * kw.y, a2 = kx[2] * kw.z, a3 = kx[3] * kw.w;
      ss += a0 * a0 + a1 * a1 + a2 * a2 + a3 * a3;
    }
    ss += __shfl_xor(ss, 16, 64); ss += __shfl_xor(ss, 32, 64);
    const float kinv = rsqrtf(fmaxf(ss, 1e-24f));
    {
      f32x4 ag[4];
      product(ag, (const u16*)(wl + WO_RG2), 128, 256);
#pragma unroll
      for (int ni = 0; ni < 4; ++ni) {
        const int ch = wave * 64 + ni * 16 + lq * 4;
        const size_t o = (size_t)row * 256 + ch;
        float rx[4], kx[4], vx[4];
        shifted4(ch, rx); shifted4(256 + ch, kx); shifted4(512 + ch, vx);
        const float4 kw = *(const float4*)(p.in[I_KK] + l * 256 + ch);
        *(uint2*)(sc + SA_R * (size_t)NT * 256 + o) = make_uint2(pack2(rx[0], rx[1]), pack2(rx[2], rx[3]));
        *(uint2*)(sc + SA_V * (size_t)NT * 256 + o) = make_uint2(pack2(vx[0], vx[1]), pack2(vx[2], vx[3]));
        *(uint2*)(sc + SA_KKN * (size_t)NT * 256 + o) = make_uint2(pack2(-kx[0] * kw.x * kinv, -kx[1] * kw.y * kinv), pack2(-kx[2] * kw.z * kinv, -kx[3] * kw.w * kinv));
        *(uint2*)(sc + SA_G * (size_t)NT * 256 + o) = make_uint2(pack2(ag[ni][0], ag[ni][1]), pack2(ag[ni][2], ag[ni][3]));
      }
    }
#pragma unroll 1
    for (int d = 0; d < 2; ++d) {
      f32x4 aw[4], aa[4];
      product(aw, (const u16*)(wl + WO_RW2) + (size_t)d * 256 * 64, 64, d * 64);
      product(aa, (const u16*)(wl + WO_RA2) + (size_t)d * 256 * 64, 64, 128 + d * 64);
      u16* oOMW = sc + (d ? SA_OMWB : SA_OMWF) * (size_t)NT * 256;
      u16* oKD = sc + (d ? SA_KDB : SA_KDF) * (size_t)NT * 256;
      u16* oB = sc + (d ? SA_BB : SA_BF) * (size_t)NT * 256;
#pragma unroll
      for (int ni = 0; ni < 4; ++ni) {
        const int ch = wave * 64 + ni * 16 + lq * 4;
        const size_t o = (size_t)row * 256 + ch;
        float kx[4]; shifted4(256 + ch, kx);
        const float4 kw = *(const float4*)(p.in[I_KK] + l * 256 + ch);
        const float kkn[4] = {kx[0] * kw.x * kinv, kx[1] * kw.y * kinv, kx[2] * kw.z * kinv, kx[3] * kw.w * kinv};
        const float4 w0 = *(const float4*)(p.in[I_W0] + (size_t)(l * 2 + d) * 256 + ch);
        const float4 a0 = *(const float4*)(p.in[I_A0] + (size_t)(l * 2 + d) * 256 + ch);
        const float4 ka = *(const float4*)(p.in[I_KA] + (size_t)(l * 2 + d) * 256 + ch);
        const float w0a[4] = {w0.x, w0.y, w0.z, w0.w}, a0a[4] = {a0.x, a0.y, a0.z, a0.w}, kaa[4] = {ka.x, ka.y, ka.z, ka.w};
        float omw[4], kd[4], bb[4];
#pragma unroll
        for (int j = 0; j < 4; ++j) {
          const float xw = -(w0a[j] + aw[ni][j]);
          const float sp = fmaxf(xw, 0.f) + log1pf(__expf(-fabsf(xw)));
          const float wlog = -sp - 0.5f;
          const float e = __expf(wlog);
          omw[j] = -expm1f(-e);
          const float a = sigmoidf_(a0a[j] + aa[ni][j]);
          kd[j] = kx[j] * (1.f + (a - 1.f) * kaa[j]);
          bb[j] = kkn[j] * a;
        }
        *(uint2*)(oOMW + o) = make_uint2(pack2(omw[0], omw[1]), pack2(omw[2], omw[3]));
        *(uint2*)(oKD + o) = make_uint2(pack2(kd[0], kd[1]), pack2(kd[2], kd[3]));
        *(uint2*)(oB + o) = make_uint2(pack2(bb[0], bb[1]), pack2(bb[2], bb[3]));
      }
    }
  }
}

DI size_t qk_index(int m, int h) {
  const bool lat = m < NTL;
  const int b = lat ? m >> 12 : (m - NTL) >> 8;
  const int pos = lat ? m & 4095 : 4096 + ((m - NTL) & 255);
  return ((size_t)(b * 8 + h) * LK + pos) * 96;
}
DI void phase_qkv(const Params& p, int l, char* smem) {
  LAUNDER_IDS
  WAVE_COORDS
  const char* wl = p.ws + OFF_W + (size_t)l * W_LAYER;
  const u16* za = (const u16*)(p.ws + OFF_R2);
  const float* rsq = (const float*)(p.ws + OFF_RSQ); const float* rskv = (const float*)(p.ws + OFF_RSKV);
  u16* Qb = (u16*)(p.ws + OFF_R1); u16* Kb = (u16*)(p.ws + OFF_R1 + SZ_Q); u16* Vt = (u16*)(p.ws + OFF_R1 + 2 * SZ_Q);
  const float* rt = (const float*)(p.ws + OFF_ROPE);
  const float* gq = p.in[I_GQ] + l * 96; const float* gk = p.in[I_GK] + l * 96;
  const float QS = 0.10206207261596577f * 1.4426950408889634f;
  constexpr int NTM = NT / 128;
  constexpr int TQ = 6 * NTM, TKV = 8 * NTM;
  for (int t = blk__; t < TQ + TKV; t += gridDim.x) {
    f32x4 acc[4][4]; zero_acc<4>(acc);
    if (t < TQ) {
      const int tm = t / 6, tn = t - tm * 6, m0 = tm * 128, n0 = tn * 128;
      LoadBf16 la{za + 256, ZA};
      gemm_mainloop<4>(acc, la, (const u16*)(wl + WO_UQ), 384, 384, m0, n0, smem);
      const int nw = n0 + wc * 64;
#pragma unroll
      for (int mi = 0; mi < 4; ++mi) {
        const int m = m0 + wr * 64 + mi * 16 + lr;
        const float rs = rsq[m];
        if (nw < 512) {
          const int h = nw >> 6;
          float ss = 0.f;
#pragma unroll
          for (int ni = 0; ni < 4; ++ni)
#pragma unroll
            for (int j = 0; j < 4; ++j) { const float v = acc[mi][ni][j] * rs; ss += v * v; }
          ss += __shfl_xor(ss, 16, 64); ss += __shfl_xor(ss, 32, 64);
          const float f = rs * rsqrtf(ss * (1.f / 64.f) + 1e-6f) * QS;
          u16* dst = Qb + qk_index(m, h);
#pragma unroll
          for (int ni = 0; ni < 4; ++ni) {
            const int d = ni * 16 + lq * 4;
            const float4 g = *(const float4*)(gq + d);
            *(uint2*)(dst + d) = make_uint2(pack2(acc[mi][ni][0] * f * g.x, acc[mi][ni][1] * f * g.y), pack2(acc[mi][ni][2] * f * g.z, acc[mi][ni][3] * f * g.w));
          }
        } else {
          const bool lat = m < NTL;
          const int tt = m & 4095;
#pragma unroll
          for (int hh = 0; hh < 2; ++hh) {
            const int h = ((nw - 512) >> 5) + hh;
            float ss = 0.f;
#pragma unroll
            for (int ni = 0; ni < 2; ++ni)
#pragma unroll
              for (int j = 0; j < 4; ++j) { const float v = acc[mi][hh * 2 + ni][j] * rs; ss += v * v; }
            ss += __shfl_xor(ss, 16, 64); ss += __shfl_xor(ss, 32, 64);
            const float f = rs * rsqrtf(ss * (1.f / 32.f) + 1e-6f) * QS;
            const int i0 = lq * 4;
            const float4 g1 = *(const float4*)(gq + 64 + i0), g2 = *(const float4*)(gq + 80 + i0);
            const float g1a[4] = {g1.x, g1.y, g1.z, g1.w}, g2a[4] = {g2.x, g2.y, g2.z, g2.w};
            float o1[4], o2[4];
#pragma unroll
            for (int j = 0; j < 4; ++j) {
              const float x1 = acc[mi][hh * 2][j] * f * g1a[j], x2 = acc[mi][hh * 2 + 1][j] * f * g2a[j];
              float cs = 1.f, sn = 0.f;
              if (lat) {
                const int i = i0 + j;
                const int pp = i < 8 ? (tt >> 6) : (tt & 63);
                cs = rt[(pp * 8 + (i & 7)) * 2]; sn = rt[(pp * 8 + (i & 7)) * 2 + 1];
              }
              o1[j] = x1 * cs - x2 * sn; o2[j] = x1 * sn + x2 * cs;
            }
            u16* dst = Qb + qk_index(m, h) + 64;
            *(uint2*)(dst + i0) = make_uint2(pack2(o1[0], o1[1]), pack2(o1[2], o1[3]));
            *(uint2*)(dst + 16 + i0) = make_uint2(pack2(o2[0], o2[1]), pack2(o2[2], o2[3]));
          }
        }
      }
    } else {
      const int t2 = t - TQ;
      const int tm = t2 >> 3, h = t2 & 7, m0 = tm * 128, n0 = h * 128;
      LoadBf16 la{za + 640, ZA};
      gemm_mainloop<4>(acc, la, (const u16*)(wl + WO_UKV), 256, 256, m0, n0, smem);
#pragma unroll
      for (int mi = 0; mi < 4; ++mi) {
        const int m = m0 + wr * 64 + mi * 16 + lr;
        const float rs = rskv[m];
        if (wc == 0) {
          float ss = 0.f;
#pragma unroll
          for (int ni = 0; ni < 4; ++ni)
#pragma unroll
            for (int j = 0; j < 4; ++j) { const float v = acc[mi][ni][j] * rs; ss += v * v; }
          ss += __shfl_xor(ss, 16, 64); ss += __shfl_xor(ss, 32, 64);
          const float f = rs * rsqrtf(ss * (1.f / 64.f) + 1e-6f);
          u16* dst = Kb + qk_index(m, h);
#pragma unroll
          for (int ni = 0; ni < 4; ++ni) {
            const int d = ni * 16 + lq * 4;
            const float4 g = *(const float4*)(gk + d);
            *(uint2*)(dst + d) = make_uint2(pack2(acc[mi][ni][0] * f * g.x, acc[mi][ni][1] * f * g.y), pack2(acc[mi][ni][2] * f * g.z, acc[mi][ni][3] * f * g.w));
          }
          *(uint4*)(dst + 64 + lq * 8) = *(const uint4*)((const u16*)(p.ws + OFF_KR) + (size_t)m * 32 + lq * 8);
        } else {
          const bool lat = m < NTL;
          const int b = lat ? m >> 12 : (m - NTL) >> 8;
          const int pos = lat ? m & 4095 : 4096 + ((m - NTL) & 255);
          u16* dst = Vt + (size_t)(b * 8 + h) * 64 * LK + pos;
#pragma unroll
          for (int ni = 0; ni < 4; ++ni)
#pragma unroll
            for (int j = 0; j < 4; ++j) dst[(size_t)(ni * 16 + lq * 4 + j) * LK] = f2bf(acc[mi][ni][j] * rs);
        }
      }
    }
  }
}

DI int scan_row(int b, int dir, int s) {
  if (s < LC) return NTL + b * LC + (dir ? LC - 1 - s : s);
  const int t = s - LC;
  return b * L + (dir ? L - 1 - t : t);
}
DI void phase_scan(const Params& p, char* smem) {
  LAUNDER_IDS
  const int blk = blk__;
  if (blk >= 256) return;
  const int tid = tid__, lane = tid & 63, wave = tid >> 6, kq = lane & 15, rg = lane >> 4;
  const int chain = (blk & 7) + 8 * (blk >> 5), quarter = (blk >> 3) & 3;
  const int b = chain >> 3, h = (chain >> 1) & 3, dir = chain & 1;
  const u16* sc = (const u16*)(p.ws + OFF_R3);
  const size_t AS = (size_t)NT * 256;
  const u16* aOMW = sc + (dir ? SA_OMWB : SA_OMWF) * AS;
  const u16* aKD = sc + (dir ? SA_KDB : SA_KDF) * AS;
  const u16* aB = sc + (dir ? SA_BB : SA_BF) * AS;
  const u16* aKKN = sc + SA_KKN * AS;
  const u16* aR = sc + SA_R * AS;
  const u16* aV = sc + SA_V * AS;
  u16* Y = (u16*)(p.ws + OFF_R2) + (dir ? AS : 0);
  u16* buf = (u16*)smem;
  constexpr int BSZ = 5 * 2048 + 512;
  const int st_ld = tid >> 3, k8 = (tid & 7) * 8;
  const int vrow = quarter * 16 + wave * 4 + rg;
  uint4 r0, r1, r2, r3, r4, rv;
  rv = make_uint4(0, 0, 0, 0);
  auto gload = [&](int chunk) {
    const int row = scan_row(b, dir, chunk * 32 + st_ld);
    const size_t o = (size_t)row * 256 + h * 64 + k8;
    r0 = *(const uint4*)(aOMW + o); r1 = *(const uint4*)(aKD + o); r2 = *(const uint4*)(aB + o); r3 = *(const uint4*)(aKKN + o); r4 = *(const uint4*)(aR + o);
    if (tid < 64) {
      const int rowv = scan_row(b, dir, chunk * 32 + (tid >> 1));
      rv = *(const uint4*)(aV + (size_t)rowv * 256 + h * 64 + quarter * 16 + (tid & 1) * 8);
    }
  };
  auto lstore = [&](int bi) {
    u16* bb = buf + bi * BSZ;
    *(uint4*)(bb + 0 * 2048 + st_ld * 64 + k8) = r0;
    *(uint4*)(bb + 1 * 2048 + st_ld * 64 + k8) = r1;
    *(uint4*)(bb + 2 * 2048 + st_ld * 64 + k8) = r2;
    *(uint4*)(bb + 3 * 2048 + st_ld * 64 + k8) = r3;
    *(uint4*)(bb + 4 * 2048 + st_ld * 64 + k8) = r4;
    if (tid < 64) *(uint4*)(bb + 5 * 2048 + (tid >> 1) * 16 + (tid & 1) * 8) = rv;
  };
  float S0 = 0.f, S1 = 0.f, S2 = 0.f, S3 = 0.f;
  __syncthreads();
  gload(0); lstore(0);
  __syncthreads();
  constexpr int NCH = LK / 32;
  for (int c = 0; c < NCH; ++c) {
    if (c + 1 < NCH) gload(c + 1);
    const u16* bb = buf + (c & 1) * BSZ;
#pragma unroll 4
    for (int s = 0; s < 32; ++s) {
      const uint2 uw = *(const uint2*)(bb + 0 * 2048 + s * 64 + kq * 4);
      const uint2 uk = *(const uint2*)(bb + 1 * 2048 + s * 64 + kq * 4);
      const uint2 ub = *(const uint2*)(bb + 2 * 2048 + s * 64 + kq * 4);
      const uint2 ua = *(const uint2*)(bb + 3 * 2048 + s * 64 + kq * 4);
      const uint2 ur = *(const uint2*)(bb + 4 * 2048 + s * 64 + kq * 4);
      const float vv = bf2f(bb[5 * 2048 + s * 16 + wave * 4 + rg]);
      float sa = S0 * bflo(ua.x) + S1 * bfhi(ua.x) + S2 * bflo(ua.y) + S3 * bfhi(ua.y);
      sa = rowsum16(sa);
      S0 = S0 * (1.f - bflo(uw.x)) + (sa * bflo(ub.x) + vv * bflo(uk.x));
      S1 = S1 * (1.f - bfhi(uw.x)) + (sa * bfhi(ub.x) + vv * bfhi(uk.x));
      S2 = S2 * (1.f - bflo(uw.y)) + (sa * bflo(ub.y) + vv * bflo(uk.y));
      S3 = S3 * (1.f - bfhi(uw.y)) + (sa * bfhi(ub.y) + vv * bfhi(uk.y));
      float y = S0 * bflo(ur.x) + S1 * bfhi(ur.x) + S2 * bflo(ur.y) + S3 * bfhi(ur.y);
      y = rowsum16(y);
      if (kq == 0) {
        const int row = scan_row(b, dir, c * 32 + s);
        Y[(size_t)row * 256 + h * 64 + vrow] = f2bf(y);
      }
    }
    if (c + 1 < NCH) lstore((c + 1) & 1);
    __syncthreads();
  }
}

constexpr int KSL = 104, VSL = 68;
template <int B0>
DI bf16x8 pack8(const f32x16& v) {
  uint4 pw;
  pw.x = pack2(v[B0 + 0], v[B0 + 1]); pw.y = pack2(v[B0 + 2], v[B0 + 3]); pw.z = pack2(v[B0 + 4], v[B0 + 5]); pw.w = pack2(v[B0 + 6], v[B0 + 7]);
  return __builtin_bit_cast(bf16x8, pw);
}
DI void pv_step(f32x16& o0, f32x16& o1, const u16* Vc, int r32, int kb, bf16x8 pf) {
  {
    const uint2 lo = *(const uint2*)(Vc + r32 * VSL + kb), hi2 = *(const uint2*)(Vc + r32 * VSL + kb + 8);
    const bf16x8 va = __builtin_bit_cast(bf16x8, make_uint4(lo.x, lo.y, hi2.x, hi2.y));
    o0 = __builtin_amdgcn_mfma_f32_32x32x16_bf16(va, pf, o0, 0, 0, 0);
  }
  {
    const uint2 lo = *(const uint2*)(Vc + (32 + r32) * VSL + kb), hi2 = *(const uint2*)(Vc + (32 + r32) * VSL + kb + 8);
    const bf16x8 va = __builtin_bit_cast(bf16x8, make_uint4(lo.x, lo.y, hi2.x, hi2.y));
    o1 = __builtin_amdgcn_mfma_f32_32x32x16_bf16(va, pf, o1, 0, 0, 0);
  }
}
DI void attn_item(const Params& p, int item, char* smem) {
  LAUNDER_IDS
  const int tid = tid__, lane = tid & 63, wave = tid >> 6, r32 = lane & 31, hi = lane >> 5;
  int bh, qpos0, key0, nkt, orow0;
  if (item < 2048) { bh = item >> 5; const int qb = item & 31; qpos0 = qb * 128; key0 = 0; nkt = LK / 64; orow0 = (bh >> 3) * L + qpos0; }
  else { const int it = item - 2048; bh = it >> 1; const int qb = it & 1; qpos0 = 4096 + qb * 128; key0 = 4096; nkt = LC / 64; orow0 = NTL + (bh >> 3) * LC + qb * 128; }
  const int h = bh & 7;
  const u16* Qp = (const u16*)(p.ws + OFF_R1) + ((size_t)bh * LK + qpos0 + wave * 32 + r32) * 96 + hi * 8;
  const u16* Kp = (const u16*)(p.ws + OFF_R1 + SZ_Q) + ((size_t)bh * LK + key0) * 96;
  const u16* Vp = (const u16*)(p.ws + OFF_R1 + 2 * SZ_Q) + (size_t)bh * 64 * LK + key0;
  u16* Ks = (u16*)smem;
  u16* Vs = Ks + 2 * 64 * KSL;
  bf16x8 qr[6];
#pragma unroll
  for (int d0 = 0; d0 < 6; ++d0) qr[d0] = *(const bf16x8*)(Qp + d0 * 16);
  uint4 sk0, sk1, sk2, sv0, sv1;
  const int kr0 = tid / 12, kc0 = tid - kr0 * 12, kr1 = (tid + 256) / 12, kc1 = (tid + 256) - kr1 * 12, kr2 = (tid + 512) / 12, kc2 = (tid + 512) - kr2 * 12;
  const int vd0 = tid >> 3, vc0 = tid & 7, vd1 = vd0 + 32;
#define gload(kt) do { \
    sk0 = *(const uint4*)(Kp + (size_t)((kt) * 64 + kr0) * 96 + kc0 * 8); sk1 = *(const uint4*)(Kp + (size_t)((kt) * 64 + kr1) * 96 + kc1 * 8); \
    sk2 = *(const uint4*)(Kp + (size_t)((kt) * 64 + kr2) * 96 + kc2 * 8); \
    sv0 = *(const uint4*)(Vp + (size_t)vd0 * LK + (kt) * 64 + vc0 * 8); sv1 = *(const uint4*)(Vp + (size_t)vd1 * LK + (kt) * 64 + vc0 * 8); } while (0)
#define lstore(bi) do { \
    *(uint4*)(Ks + (bi) * 64 * KSL + kr0 * KSL + kc0 * 8) = sk0; *(uint4*)(Ks + (bi) * 64 * KSL + kr1 * KSL + kc1 * 8) = sk1; *(uint4*)(Ks + (bi) * 64 * KSL + kr2 * KSL + kc2 * 8) = sk2; \
    { u16* dst = Vs + (bi) * 64 * VSL + vd0 * VSL + vc0 * 8; *(uint2*)dst = make_uint2(sv0.x, sv0.y); *(uint2*)(dst + 4) = make_uint2(sv0.z, sv0.w); } \
    { u16* dst = Vs + (bi) * 64 * VSL + vd1 * VSL + vc0 * 8; *(uint2*)dst = make_uint2(sv1.x, sv1.y); *(uint2*)(dst + 4) = make_uint2(sv1.z, sv1.w); } } while (0)
  f32x16 o0, o1;
#pragma unroll
  for (int i = 0; i < 16; ++i) { o0[i] = 0.f; o1[i] = 0.f; }
  float mrun = -1e30f, lrun = 0.f;
  __syncthreads();
  gload(0); lstore(0);
  __syncthreads();
  for (int kt = 0; kt < nkt; ++kt) {
    const int cur = kt & 1;
    if (kt + 1 < nkt) gload(kt + 1);
    const u16* Kc = Ks + cur * 64 * KSL;
    const u16* Vc = Vs + cur * 64 * VSL;
    f32x16 p0, p1;
#pragma unroll
    for (int i = 0; i < 16; ++i) { p0[i] = 0.f; p1[i] = 0.f; }
#pragma unroll
    for (int d0 = 0; d0 < 6; ++d0) {
      const bf16x8 a0 = *(const bf16x8*)(Kc + r32 * KSL + d0 * 16 + hi * 8);
      const bf16x8 a1 = *(const bf16x8*)(Kc + (32 + r32) * KSL + d0 * 16 + hi * 8);
      p0 = __builtin_amdgcn_mfma_f32_32x32x16_bf16(a0, qr[d0], p0, 0, 0, 0);
      p1 = __builtin_amdgcn_mfma_f32_32x32x16_bf16(a1, qr[d0], p1, 0, 0, 0);
    }
    float mx = p0[0];
#pragma unroll
    for (int i = 1; i < 16; ++i) mx = fmaxf(mx, p0[i]);
#pragma unroll
    for (int i = 0; i < 16; ++i) mx = fmaxf(mx, p1[i]);
    mx = fmaxf(mx, __shfl_xor(mx, 32, 64));
    if (!__all(mx - mrun <= 8.f)) {
      const float mn = fmaxf(mrun, mx);
      const float alpha = __builtin_amdgcn_exp2f(mrun - mn);
      mrun = mn; lrun *= alpha;
#pragma unroll
      for (int i = 0; i < 16; ++i) { o0[i] *= alpha; o1[i] *= alpha; }
    }
    float ps = 0.f;
#pragma unroll
    for (int i = 0; i < 16; ++i) { p0[i] = __builtin_amdgcn_exp2f(p0[i] - mrun); ps += p0[i]; }
#pragma unroll
    for (int i = 0; i < 16; ++i) { p1[i] = __builtin_amdgcn_exp2f(p1[i] - mrun); ps += p1[i]; }
    lrun += ps;
    pv_step(o0, o1, Vc, r32, 0 + hi * 4, pack8<0>(p0));
    pv_step(o0, o1, Vc, r32, 16 + hi * 4, pack8<8>(p0));
    pv_step(o0, o1, Vc, r32, 32 + hi * 4, pack8<0>(p1));
    pv_step(o0, o1, Vc, r32, 48 + hi * 4, pack8<8>(p1));
    if (kt + 1 < nkt) lstore(cur ^ 1);
    __syncthreads();
  }
  lrun += __shfl_xor(lrun, 32, 64);
  const float inv = 1.f / lrun;
  u16* om = (u16*)(p.ws + OFF_R3 + SA_KKN * SZ_TOK256) + (size_t)(orow0 + wave * 32 + r32) * 512 + h * 64;
#pragma unroll
  for (int g = 0; g < 4; ++g) {
    const int d = 8 * g + 4 * hi;
    *(uint2*)(om + d) = make_uint2(pack2(o0[4 * g] * inv, o0[4 * g + 1] * inv), pack2(o0[4 * g + 2] * inv, o0[4 * g + 3] * inv));
    *(uint2*)(om + 32 + d) = make_uint2(pack2(o1[4 * g] * inv, o1[4 * g + 1] * inv), pack2(o1[4 * g + 2] * inv, o1[4 * g + 3] * inv));
  }
#undef gload
#undef lstore
}

DI void readout_row(const Params& p, int l, int r) {
  LAUNDER_IDS
  const int lane = tid__ & 63;
  const u16* sc = (const u16*)(p.ws + OFF_R3);
  const size_t AS = (size_t)NT * 256;
  const size_t o = (size_t)r * 256 + lane * 4;
  const u16* Yf = (const u16*)(p.ws + OFF_R2);
  const uint2 yf = *(const uint2*)(Yf + o), yb = *(const uint2*)(Yf + AS + o);
  const uint2 ur = *(const uint2*)(sc + SA_R * AS + o), uv = *(const uint2*)(sc + SA_V * AS + o);
  const uint2 kf = *(const uint2*)(sc + SA_KDF * AS + o), kb = *(const uint2*)(sc + SA_KDB * AS + o), ug = *(const uint2*)(sc + SA_G * AS + o);
  float y[4] = {bflo(yf.x) + bflo(yb.x), bfhi(yf.x) + bfhi(yb.x), bflo(yf.y) + bflo(yb.y), bfhi(yf.y) + bfhi(yb.y)};
  const float rr[4] = {bflo(ur.x), bfhi(ur.x), bflo(ur.y), bfhi(ur.y)};
  const float vv[4] = {bflo(uv.x), bfhi(uv.x), bflo(uv.y), bfhi(uv.y)};
  const float km[4] = {0.5f * (bflo(kf.x) + bflo(kb.x)), 0.5f * (bfhi(kf.x) + bfhi(kb.x)), 0.5f * (bflo(kf.y) + bflo(kb.y)), 0.5f * (bfhi(kf.y) + bfhi(kb.y))};
  const float gg[4] = {bflo(ug.x), bfhi(ug.x), bflo(ug.y), bfhi(ug.y)};
  const float4 rk4 = *(const float4*)(p.in[I_RK] + l * 256 + lane * 4);
  const float4 lw4 = *(const float4*)(p.in[I_LNW] + l * 256 + lane * 4);
  const float4 lb4 = *(const float4*)(p.in[I_LNB] + l * 256 + lane * 4);
  const float rk[4] = {rk4.x, rk4.y, rk4.z, rk4.w}, lw[4] = {lw4.x, lw4.y, lw4.z, lw4.w}, lb[4] = {lb4.x, lb4.y, lb4.z, lb4.w};
  float s = y[0] + y[1] + y[2] + y[3];
  s = rowsum16(s);
  const float mu = s * (1.f / 64.f);
  float q = 0.f, bn = 0.f;
#pragma unroll
  for (int j = 0; j < 4; ++j) { const float d = y[j] - mu; q += d * d; bn += rr[j] * km[j] * rk[j]; }
  q = rowsum16(q); bn = rowsum16(bn);
  const float rstd = rsqrtf(q * (1.f / 64.f) + 64e-5f);
  float ov[4];
#pragma unroll
  for (int j = 0; j < 4; ++j) ov[j] = ((y[j] - mu) * rstd * lw[j] + lb[j] + bn * vv[j]) * gg[j];
  u16* orw = (u16*)(p.ws + OFF_R3 + SA_KKN * SZ_TOK256 + (size_t)NT * 512 * 2);
  *(uint2*)(orw + o) = make_uint2(pack2(ov[0], ov[1]), pack2(ov[2], ov[3]));
}

DI void phase_attn(const Params& p, int l, int Mout, char* smem) {
  LAUNDER_IDS
  const int nattn = (l == 0) ? 2048 + 128 : 2048;
  for (int it = blk__; it < nattn; it += gridDim.x) attn_item(p, it, smem);
  const int wave = tid__ >> 6;
  for (int r = blk__ * 4 + wave; r < Mout; r += gridDim.x * 4) readout_row(p, l, r);
}

DI void phase_merge(const Params& p, int l, const float* xl, const float* xc, int Mout, char* smem) {
  LAUNDER_IDS
  WAVE_COORDS
  const char* wl = p.ws + OFF_W + (size_t)l * W_LAYER;
  LoadNorm lg{xl, xc, (const float*)(p.ws + OFF_RS1), (const float*)(p.ws + OFF_TAB) + (size_t)(l * 2 + 0) * 9 * 2048};
  const u16* opool = (const u16*)(p.ws + OFF_R4);
  const u16* omla = (const u16*)(p.ws + OFF_R3 + SA_KKN * SZ_TOK256);
  const u16* orw = omla + (size_t)NT * 512;
  u16* mo = (u16*)(p.ws + OFF_R1);
  const int ntm = Mout / 128;
  for (int t = blk__; t < ntm * 16; t += gridDim.x) {
    const int tm = t >> 4, tn = t & 15, m0 = tm * 128, n0 = tn * 64;
    f32x4 msum[4][2]; zero_acc<2>(msum);
#pragma unroll 1
    for (int br = 0; br < 3; ++br) {
      unsigned gpk[4][2][2];
      {
        f32x4 ag[4][2]; zero_acc<2>(ag);
        gemm_mainloop<2>(ag, lg, (const u16*)(wl + WO_WIN) + (size_t)(2080 + br * 1024) * 1024, 1024, 1024, m0, n0, smem);
#pragma unroll
        for (int mi = 0; mi < 4; ++mi)
#pragma unroll
          for (int ni = 0; ni < 2; ++ni) {
            gpk[mi][ni][0] = pack2(sigmoidf_(ag[mi][ni][0]), sigmoidf_(ag[mi][ni][1]));
            gpk[mi][ni][1] = pack2(sigmoidf_(ag[mi][ni][2]), sigmoidf_(ag[mi][ni][3]));
          }
      }
      __builtin_amdgcn_sched_barrier(0);
      f32x4 ab[4][2]; zero_acc<2>(ab);
      {
        const int Kb = br == 1 ? 512 : 256;
        LoadBf16 la{br == 0 ? opool : br == 1 ? omla : orw, Kb};
        const u16* Wb = (const u16*)(wl + (br == 0 ? WO_BRP : br == 1 ? WO_BRM : WO_BRR));
        gemm_mainloop<2>(ab, la, Wb, Kb, Kb, m0, n0, smem);
      }
#pragma unroll
      for (int mi = 0; mi < 4; ++mi)
#pragma unroll
        for (int ni = 0; ni < 2; ++ni) {
          msum[mi][ni][0] += bflo(gpk[mi][ni][0]) * ab[mi][ni][0];
          msum[mi][ni][1] += bfhi(gpk[mi][ni][0]) * ab[mi][ni][1];
          msum[mi][ni][2] += bflo(gpk[mi][ni][1]) * ab[mi][ni][2];
          msum[mi][ni][3] += bfhi(gpk[mi][ni][1]) * ab[mi][ni][3];
        }
      __builtin_amdgcn_sched_barrier(0);
    }
#pragma unroll
    for (int mi = 0; mi < 4; ++mi) {
      const int m = m0 + wr * 64 + mi * 16 + lr;
#pragma unroll
      for (int ni = 0; ni < 2; ++ni) {
        const int n = n0 + wc * 32 + ni * 16 + lq * 4;
        *(uint2*)(mo + (size_t)m * 1024 + n) = make_uint2(pack2(msum[mi][ni][0], msum[mi][ni][1]), pack2(msum[mi][ni][2], msum[mi][ni][3]));
      }
    }
  }
}

DI void phase_resid(const Params& p, const u16* A, int K, const u16* Bt, const float* gate  ,
                    const float* xl_in, const float* xc_in, float* xl_out, float* xc_out, int Mout, char* smem) {
  LAUNDER_IDS
  WAVE_COORDS
  LoadBf16 la{A, K};
  const int ntm = Mout / 128;
  for (int t = blk__; t < ntm * 8; t += gridDim.x) {
    const int tm = t >> 3, tn = t & 7, m0 = tm * 128, n0 = tn * 128;
    f32x4 acc[4][4]; zero_acc<4>(acc);
    gemm_mainloop<4>(acc, la, Bt, K, K, m0, n0, smem);
#pragma unroll
    for (int mi = 0; mi < 4; ++mi) {
      const int m = m0 + wr * 64 + mi * 16 + lr;
      const int b9 = m < NTL ? m >> 12 : 8;
      const float* xi = xrow(xl_in, xc_in, m);
      float* xo = m < NTL ? xl_out + (size_t)m * D : xc_out + (size_t)(m - NTL) * D;
#pragma unroll
      for (int ni = 0; ni < 4; ++ni) {
        const int n = n0 + wc * 64 + ni * 16 + lq * 4;
        const float4 g = *(const float4*)(gate + (size_t)b9 * 6144 + n);
        const float4 xv = *(const float4*)(xi + n);
        float4 ov;
        ov.x = xv.x + g.x * acc[mi][ni][0]; ov.y = xv.y + g.y * acc[mi][ni][1]; ov.z = xv.z + g.z * acc[mi][ni][2]; ov.w = xv.w + g.w * acc[mi][ni][3];
        *(float4*)(xo + n) = ov;
      }
    }
  }
}
DI void phase_mlp1(const Params& p, int l, const float* xl, const float* xc, int Mout, char* smem) {
  LAUNDER_IDS
  WAVE_COORDS
  const char* wl = p.ws + OFF_W + (size_t)l * W_LAYER;
  LoadNorm la{xl, xc, (const float*)(p.ws + OFF_RS2), (const float*)(p.ws + OFF_TAB) + (size_t)(l * 2 + 1) * 9 * 2048};
  u16* U = (u16*)(p.ws + OFF_R1);
  const int ntm = Mout / 128;
  for (int t = blk__; t < ntm * 32; t += gridDim.x) {
    const int tm = t >> 5, tn = t & 31, m0 = tm * 128, n0 = tn * 128;
    f32x4 acc[4][4]; zero_acc<4>(acc);
    gemm_mainloop<4>(acc, la, (const u16*)(wl + WO_W1), 1024, 1024, m0, n0, smem);
#pragma unroll
    for (int mi = 0; mi < 4; ++mi) {
      const int m = m0 + wr * 64 + mi * 16 + lr;
#pragma unroll
      for (int ni = 0; ni < 4; ++ni) {
        const int n = n0 + wc * 64 + ni * 16 + lq * 4;
        float v[4];
#pragma unroll
        for (int j = 0; j < 4; ++j) { const float a = fmaxf(acc[mi][ni][j], 0.f); v[j] = a * a; }
        *(uint2*)(U + (size_t)m * DFF + n) = make_uint2(pack2(v[0], v[1]), pack2(v[2], v[3]));
      }
    }
  }
}

__global__ void __launch_bounds__(256, 2) fwd_megakernel(Params p) {
  __shared__ __attribute__((aligned(16))) char smem[73728];
  cg::grid_group grid = cg::this_grid();
  unsigned* bar = (unsigned*)(p.ws + OFF_BAR);
  unsigned epoch = 0;
  phase_prep(p, smem);
  grid.sync();
#pragma nounroll
  for (int ph = 0; ph < 22; ++ph) {
    const int l = ph / 11, q = ph - l * 11;
    float* ctxbuf = (float*)(p.ws + OFF_CTX);
    const float* mods = (const float*)(p.ws + OFF_MODS);
    const float* xl = l == 0 ? p.in[I_X] : p.out;
    const float* xc = l == 0 ? p.in[I_CTX] : ctxbuf;
    const int Mout = l == 0 ? NT : NTL;
    const char* wl = p.ws + OFF_W + (size_t)l * W_LAYER;
    switch (q) {
      case 0: phase_stats(xl, xc, (float*)(p.ws + OFF_RS1), NT); if (l == 0) phase_tables(p); break;
      case 1: phase_zgemm(p, l, xl, xc, smem); break;
      case 2: phase_tokA(p, l); phase_tokB(p, l, smem); break;
      case 3: phase_qkv(p, l, smem); break;
      case 4: phase_scan(p, smem); break;
      case 5: phase_attn(p, l, Mout, smem); break;
      case 6: phase_merge(p, l, xl, xc, Mout, smem); break;
      case 7: phase_resid(p, (const u16*)(p.ws + OFF_R1), 1024, (const u16*)(wl + WO_WO), mods + (size_t)l * 9 * 6144 + 2 * 1024, xl, xc, p.out, ctxbuf, Mout, smem); break;
      case 8: phase_stats(p.out, ctxbuf, (float*)(p.ws + OFF_RS2), Mout); break;
      case 9: phase_mlp1(p, l, p.out, ctxbuf, Mout, smem); break;
      default: phase_resid(p, (const u16*)(p.ws + OFF_R1), 4096, (const u16*)(wl + WO_W2), mods + (size_t)l * 9 * 6144 + 5 * 1024, p.out, ctxbuf, p.out, ctxbuf, Mout, smem); break;
    }
    if (ph != 21) grid_barrier(bar, epoch);
  }
}

extern "C" void kernel_launch(void* const* d_in, const int* in_sizes, int n_in, void* d_out, int out_size, void* d_ws, size_t ws_size, hipStream_t stream) {
  static int grid_blocks = 0;
  if (!grid_blocks) {
    int dev = 0, cus = 0, per_cu = 0;
    hipGetDevice(&dev);
    hipDeviceGetAttribute(&cus, hipDeviceAttributeMultiprocessorCount, dev);
    hipOccupancyMaxActiveBlocksPerMultiprocessor(&per_cu, fwd_megakernel, 256, 0);
    if (per_cu > 2) per_cu = 2;
    if (per_cu < 1) per_cu = 1;
    grid_blocks = cus * per_cu;
    if (ws_size < WS_END) fprintf(stderr, "kernel_launch: workspace too small: %zu < %zu\n", ws_size, (size_t)WS_END);
  }
  Params p{};
  for (int i = 0; i < 34; ++i) p.in[i] = (const float*)d_in[i];
  p.out = (float*)d_out;
  p.ws = (char*)d_ws;
  hipMemsetAsync(d_ws, 0, 4096, stream);
  void* args[] = {&p};
  hipError_t e = hipLaunchCooperativeKernel((void*)fwd_megakernel, dim3(grid_blocks), dim3(256), args, 0, stream);
  if (e != hipSuccess) fprintf(stderr, "cooperative launch failed: %s (grid %d)\n", hipGetErrorString(e), grid_blocks);
}
```

```cpp
#include <hip/hip_runtime.h>
#include <hip/hip_cooperative_groups.h>
#include <stdint.h>
#include <cstdio>
namespace cg = cooperative_groups;

typedef unsigned short u16;
typedef __attribute__((ext_vector_type(8))) short bf16x8;
typedef __attribute__((ext_vector_type(4))) float f32x4;
typedef __attribute__((ext_vector_type(16))) float f32x16;
typedef __bf16 bf16x2_t __attribute__((ext_vector_type(2)));
typedef float float2_t __attribute__((ext_vector_type(2)));

#define DI __device__ __forceinline__

constexpr int D = 1024, NB = 8, L = 4096, LC = 256, LK = 4352;
constexpr int NTL = NB * L;
constexpr int NTC = NB * LC;
constexpr int NT = NTL + NTC;
constexpr int INC = 5152;
constexpr int ZA = 928;
constexpr int ZR = 1152;
constexpr int DFF = 4096;

constexpr size_t al256(size_t x) { return (x + 255) / 256 * 256; }
constexpr size_t OFF_BAR = 0;
constexpr size_t OFF_MODS = 4096;
constexpr size_t OFF_TAB = OFF_MODS + al256(2 * 9 * 6144 * 4);
constexpr size_t OFF_ROPE = OFF_TAB + al256(2 * 2 * 9 * 2 * 1024 * 4);
constexpr size_t OFF_RS1 = OFF_ROPE + 4096;
constexpr size_t OFF_RS2 = OFF_RS1 + al256(NT * 4);
constexpr size_t OFF_RSQ = OFF_RS2 + al256(NT * 4);
constexpr size_t OFF_RSKV = OFF_RSQ + al256(NT * 4);
constexpr size_t OFF_CTX = OFF_RSKV + al256(NT * 4);
constexpr size_t OFF_W = OFF_CTX + (size_t)NTC * D * 4;
constexpr size_t WO_WIN = 0;
constexpr size_t WO_UQ = WO_WIN + (size_t)INC * 1024 * 2;
constexpr size_t WO_UKV = WO_UQ + (size_t)768 * 384 * 2;
constexpr size_t WO_BRP = WO_UKV + (size_t)1024 * 256 * 2;
constexpr size_t WO_BRM = WO_BRP + (size_t)1024 * 256 * 2;
constexpr size_t WO_BRR = WO_BRM + (size_t)1024 * 512 * 2;
constexpr size_t WO_WO = WO_BRR + (size_t)1024 * 256 * 2;
constexpr size_t WO_W1 = WO_WO + (size_t)1024 * 1024 * 2;
constexpr size_t WO_W2 = WO_W1 + (size_t)4096 * 1024 * 2;
constexpr size_t WO_RW2 = WO_W2 + (size_t)1024 * 4096 * 2;
constexpr size_t WO_RA2 = WO_RW2 + (size_t)2 * 256 * 64 * 2;
constexpr size_t WO_RG2 = WO_RA2 + (size_t)2 * 256 * 64 * 2;
constexpr size_t W_LAYER = al256(WO_RG2 + (size_t)256 * 128 * 2);
constexpr size_t OFF_R1 = OFF_W + 2 * W_LAYER;
constexpr size_t SZ_Q = (size_t)NB * 8 * LK * 96 * 2;
constexpr size_t SZ_VT = (size_t)NB * 8 * 64 * LK * 2;
constexpr size_t SZ_R1 = 2 * SZ_Q + SZ_VT;
constexpr size_t OFF_R2 = OFF_R1 + al256(SZ_R1);
constexpr size_t SZ_TOK256 = (size_t)NT * 256 * 2;
constexpr size_t OFF_R3 = OFF_R2 + al256((size_t)NT * ZA * 2);
constexpr size_t OFF_R4 = OFF_R3 + 10 * SZ_TOK256;
constexpr size_t OFF_KR = OFF_R4 + SZ_TOK256;
constexpr size_t WS_END = OFF_KR + (size_t)NT * 32 * 2;
constexpr size_t OFF_HB1 = OFF_R3;
constexpr size_t OFF_HBG = OFF_R1 + (size_t)NT * 1024 * 2;
constexpr size_t OFF_HB2 = OFF_R3 + 5 * SZ_TOK256;
enum { SA_R = 0, SA_V = 1, SA_KDF = 2, SA_KDB = 3, SA_G = 4, SA_KKN = 5, SA_OMWF = 6, SA_BF = 7, SA_OMWB = 8, SA_BB = 9 };

struct Params { const float* in[34]; float* out; char* ws; };

enum { I_X = 0, I_C, I_CTX, I_CCTX, I_N1G, I_N2G, I_WADA, I_BADA, I_WIN, I_POOLW, I_POOLS, I_QNORM, I_WUQ, I_KVNORM, I_WUKV,
       I_GQ, I_GK, I_MU, I_W0, I_W2R, I_A0, I_A2R, I_KA, I_KK, I_RK, I_G2R, I_LNW, I_LNB, I_BRP, I_BRM, I_BRR, I_WO, I_W1, I_W2 };

DI float bf2f(u16 h) { return __uint_as_float(((unsigned)h) << 16); }
DI float bflo(unsigned u) { return __uint_as_float(u << 16); }
DI float bfhi(unsigned u) { return __uint_as_float(u & 0xffff0000u); }
DI unsigned pack2(float a, float b) { float2_t v = {a, b}; bf16x2_t r = __builtin_convertvector(v, bf16x2_t); return __builtin_bit_cast(unsigned, r); }
DI u16 f2bf(float a) { return (u16)(pack2(a, 0.f) & 0xffffu); }
DI float sigmoidf_(float x) { return 1.f / (1.f + __expf(-x)); }
DI float siluf_(float x) { return x / (1.f + __expf(-x)); }
DI float rowsum16(float x) {
  x += __builtin_bit_cast(float, __builtin_amdgcn_update_dpp(0, __builtin_bit_cast(int, x), 0x128, 0xf, 0xf, false));
  x += __builtin_bit_cast(float, __builtin_amdgcn_update_dpp(0, __builtin_bit_cast(int, x), 0x124, 0xf, 0xf, false));
  x += __builtin_bit_cast(float, __builtin_amdgcn_update_dpp(0, __builtin_bit_cast(int, x), 0x122, 0xf, 0xf, false));
  x += __builtin_bit_cast(float, __builtin_amdgcn_update_dpp(0, __builtin_bit_cast(int, x), 0x121, 0xf, 0xf, false));
  return x;
}
DI float wavesum(float x) {
  for (int o = 32; o > 0; o >>= 1) x += __shfl_xor(x, o, 64);
  return x;
}
DI void grid_barrier(unsigned* ctr, unsigned& epoch) {
  asm volatile("s_waitcnt vmcnt(0)" ::: "memory");
  __syncthreads();
  epoch++;
  if (threadIdx.x == 0) {
    __builtin_amdgcn_fence(__ATOMIC_RELEASE, "agent");
    asm volatile("s_waitcnt vmcnt(0)" ::: "memory");
    const unsigned target = epoch * gridDim.x;
    __hip_atomic_fetch_add(ctr, 1u, __ATOMIC_RELAXED, __HIP_MEMORY_SCOPE_AGENT);
    while (__hip_atomic_load(ctr, __ATOMIC_RELAXED, __HIP_MEMORY_SCOPE_AGENT) < target) __builtin_amdgcn_s_sleep(2);
    __builtin_amdgcn_fence(__ATOMIC_ACQUIRE, "agent");
    asm volatile("s_waitcnt vmcnt(0)" ::: "memory");
  }
  __syncthreads();
}

DI int launder_v(int x) { asm volatile("" : "+v"(x)); return x; }
DI int launder_s(int x) { asm volatile("" : "+s"(x)); return x; }
#define LAUNDER_IDS const int tid__ = launder_v((int)threadIdx.x); const int blk__ = launder_s((int)blockIdx.x); (void)tid__; (void)blk__;
DI void do_transpose(const float* __restrict__ src, int K, int N, u16* __restrict__ dst, const float* __restrict__ ksc, int perm, int tile, float* tl) {
  LAUNDER_IDS
  const int ntn = (N + 63) >> 6;
  const int kt = tile / ntn, nt = tile - kt * ntn;
  const int k0 = kt * 64, n0 = nt * 64;
  const int tid = tid__;
  __syncthreads();
#pragma unroll 4
  for (int i = 0; i < 16; ++i) {
    const int kk = i * 4 + (tid >> 6), nn = tid & 63;
    float v = 0.f;
    if (n0 + nn < N) v = src[(size_t)(k0 + kk) * N + n0 + nn];
    if (ksc) v *= ksc[k0 + kk];
    tl[kk * 65 + nn] = v;
  }
  __syncthreads();
#pragma unroll 4
  for (int i = 0; i < 16; ++i) {
    const int nn = i * 4 + (tid >> 6), kk = tid & 63;
    int n = n0 + nn;
    if (n < N) {
      if (perm) { const int h = n / 96, d = n - h * 96; n = d < 64 ? h * 64 + d : 512 + h * 32 + (d - 64); }
      dst[(size_t)n * K + k0 + kk] = f2bf(tl[kk * 65 + nn]);
    }
  }
}

DI void phase_prep(const Params& p, char* smem) {
  LAUNDER_IDS
  float* tl = (float*)smem;
  const int tid = tid__;
  constexpr int T_WIN = 16 * 81, T_UQ = 6 * 12, T_UKV = 4 * 16, T_BRM = 8 * 16, T_BRR = 4 * 16, T_WO = 16 * 16, T_W1 = 16 * 64, T_W2 = 64 * 16,
                T_RW2 = 4, T_RA2 = 4, T_RG2 = 2 * 4;
  constexpr int T_LAYER = T_WIN + T_UQ + T_UKV + T_BRM + T_BRR + T_WO + T_W1 + T_W2 + 2 * T_RW2 + 2 * T_RA2 + T_RG2;
  for (int g = blk__; g < 2 * T_LAYER; g += gridDim.x) {
    const int l = g / T_LAYER; int t = g - l * T_LAYER;
    char* wl = p.ws + OFF_W + (size_t)l * W_LAYER;
#define JOB(SRC, KK, NN, DSTOFF, SC, PERM, CNT) if (t < (CNT)) { do_transpose((SRC), (KK), (NN), (u16*)(wl + (DSTOFF)), (SC), (PERM), t, tl); continue; } t -= (CNT);
    JOB(p.in[I_WIN] + (size_t)l * 1024 * INC, 1024, INC, WO_WIN, nullptr, 0, T_WIN)
    JOB(p.in[I_WUQ] + (size_t)l * 384 * 768, 384, 768, WO_UQ, p.in[I_QNORM] + l * 384, 1, T_UQ)
    JOB(p.in[I_WUKV] + (size_t)l * 256 * 1024, 256, 1024, WO_UKV, p.in[I_KVNORM] + l * 256, 0, T_UKV)
    JOB(p.in[I_BRM] + (size_t)l * 512 * 1024, 512, 1024, WO_BRM, nullptr, 0, T_BRM)
    JOB(p.in[I_BRR] + (size_t)l * 256 * 1024, 256, 1024, WO_BRR, nullptr, 0, T_BRR)
    JOB(p.in[I_WO] + (size_t)l * 1024 * 1024, 1024, 1024, WO_WO, nullptr, 0, T_WO)
    JOB(p.in[I_W1] + (size_t)l * 1024 * 4096, 1024, 4096, WO_W1, nullptr, 0, T_W1)
    JOB(p.in[I_W2] + (size_t)l * 4096 * 1024, 4096, 1024, WO_W2, nullptr, 0, T_W2)
    JOB(p.in[I_W2R] + (size_t)(l * 2 + 0) * 64 * 256, 64, 256, WO_RW2, nullptr, 0, T_RW2)
    JOB(p.in[I_W2R] + (size_t)(l * 2 + 1) * 64 * 256, 64, 256, WO_RW2 + 256 * 64 * 2, nullptr, 0, T_RW2)
    JOB(p.in[I_A2R] + (size_t)(l * 2 + 0) * 64 * 256, 64, 256, WO_RA2, nullptr, 0, T_RA2)
    JOB(p.in[I_A2R] + (size_t)(l * 2 + 1) * 64 * 256, 64, 256, WO_RA2 + 256 * 64 * 2, nullptr, 0, T_RA2)
    JOB(p.in[I_G2R] + (size_t)l * 128 * 256, 128, 256, WO_RG2, nullptr, 0, T_RG2)
#undef JOB
  }
  for (int e = blk__ * 256 + tid; e < 2 * 256 * 1024; e += gridDim.x * 256) {
    const int l = e >> 18, r = e & 262143, cin = r >> 10, n = r & 1023, g = cin >> 6, c = cin & 63;
    const float* pw = p.in[I_POOLW] + ((size_t)(l * 4 + g) * 64 + c) * 64;
    const float* ps = p.in[I_POOLS] + l * 256 + g * 64;
    const float* wb = p.in[I_BRP] + ((size_t)l * 256 + g * 64) * 1024 + n;
    float s = 0.f;
    for (int d = 0; d < 64; ++d) s += pw[d] * ps[d] * wb[(size_t)d * 1024];
    ((u16*)(p.ws + OFF_W + (size_t)l * W_LAYER + WO_BRP))[(size_t)n * 256 + cin] = f2bf(s);
  }
  if (blk__ == gridDim.x - 1) {
    for (int e = tid; e < 512; e += 256) {
      const int pos = e >> 3, f = e & 7;
      const float inv = powf(10000.f, -(float)f / 8.f);
      const float ang = (float)pos * inv;
      float* rt = (float*)(p.ws + OFF_ROPE);
      rt[e * 2] = cosf(ang); rt[e * 2 + 1] = sinf(ang);
    }
  }
  {
    float* sl = (float*)smem;
    float* red = sl + 9 * 1024;
    __syncthreads();
    for (int e = tid; e < 9 * 1024; e += 256) {
      const int b = e >> 10, k = e & 1023;
      const float v = b < 8 ? p.in[I_C][b * 1024 + k] : p.in[I_CCTX][k];
      sl[e] = siluf_(v);
    }
    __syncthreads();
    const int wave = tid >> 6, lane = tid & 63;
    for (int it = blk__; it < 192; it += gridDim.x) {
      const int l = it / 96, cg_ = it - l * 96;
      const int col = cg_ * 64 + lane;
      const float* wa = p.in[I_WADA] + (size_t)l * 1024 * 6144 + col;
      float acc[9];
#pragma unroll
      for (int b = 0; b < 9; ++b) acc[b] = 0.f;
#pragma unroll 8
      for (int k = wave * 256; k < wave * 256 + 256; ++k) {
        const float w = wa[(size_t)k * 6144];
#pragma unroll
        for (int b = 0; b < 9; ++b) acc[b] += sl[b * 1024 + k] * w;
      }
#pragma unroll
      for (int b = 0; b < 9; ++b) red[(wave * 9 + b) * 64 + lane] = acc[b];
      __syncthreads();
      for (int e = tid; e < 9 * 64; e += 256) {
        const int b = e >> 6, c = e & 63;
        const float s = red[(0 * 9 + b) * 64 + c] + red[(1 * 9 + b) * 64 + c] + red[(2 * 9 + b) * 64 + c] + red[(3 * 9 + b) * 64 + c];
        ((float*)(p.ws + OFF_MODS))[(size_t)(l * 9 + b) * 6144 + cg_ * 64 + c] = s + p.in[I_BADA][l * 6144 + cg_ * 64 + c];
      }
      __syncthreads();
    }
  }
}

DI const float* xrow(const float* xl, const float* xc, int r) { return r < NTL ? xl + (size_t)r * D : xc + (size_t)(r - NTL) * D; }

DI void phase_norm(const float* xl, const float* xc, const float* tab  , u16* hb, int M) {
  LAUNDER_IDS
  const int wave = tid__ >> 6, lane = tid__ & 63;
  for (int r = blk__ * 4 + wave; r < M; r += gridDim.x * 4) {
    const float* xp = xrow(xl, xc, r);
    const int b9 = r < NTL ? r >> 12 : 8;
    float4 v[4];
    float s = 0.f;
#pragma unroll
    for (int i = 0; i < 4; ++i) { v[i] = *(const float4*)(xp + i * 256 + lane * 4); s += v[i].x * v[i].x + v[i].y * v[i].y + v[i].z * v[i].z + v[i].w * v[i].w; }
    s = wavesum(s);
    const float rs = rsqrtf(s * (1.f / 1024.f) + 1e-6f);
    const float* t = tab + b9 * 2048;
#pragma unroll
    for (int i = 0; i < 4; ++i) {
      const int k = i * 256 + lane * 4;
      const float4 g = *(const float4*)(t + k), sh = *(const float4*)(t + 1024 + k);
      *(uint2*)(hb + (size_t)r * 1024 + k) = make_uint2(pack2(v[i].x * rs * g.x + sh.x, v[i].y * rs * g.y + sh.y), pack2(v[i].z * rs * g.z + sh.z, v[i].w * rs * g.w + sh.w));
    }
  }
}
DI void phase_tables(const Params& p) {
  LAUNDER_IDS
  const float* mods = (const float*)(p.ws + OFF_MODS);
  float* tab = (float*)(p.ws + OFF_TAB);
  for (int e = blk__ * 256 + tid__; e < 2 * 2 * 9 * 1024; e += gridDim.x * 256) {
    const int k = e & 1023, b9 = (e >> 10) % 9, ln = (e >> 10) / 9, l = ln >> 1, nrm = ln & 1;
    const float g = p.in[nrm ? I_N2G : I_N1G][l * 1024 + k];
    const float sh = mods[(size_t)(l * 9 + b9) * 6144 + (nrm * 3 + 0) * 1024 + k];
    const float sc = mods[(size_t)(l * 9 + b9) * 6144 + (nrm * 3 + 1) * 1024 + k];
    float* t = tab + ((size_t)(l * 2 + nrm) * 9 + b9) * 2048;
    t[k] = g * (1.f + sc); t[1024 + k] = sh;
  }
}

struct LoadBf16 {
  const u16* A; int lda;
  DI void init(int m0) {}
  DI uint4 load(int i, int m0, int k0) const {
    LAUNDER_IDS
    const int tid = tid__, kc = (tid & 7) * 8;
    return *(const uint4*)(A + (size_t)(m0 + (tid >> 3) + i * 32) * lda + k0 + kc);
  }
};
struct LoadNorm {
  const float* xl; const float* xc; const float* rs; const float* tab;
  float r0, r1, r2, r3;
  DI void init(int m0) {
    LAUNDER_IDS
    const int tid = tid__;
    r0 = rs[m0 + (tid >> 3)]; r1 = rs[m0 + (tid >> 3) + 32]; r2 = rs[m0 + (tid >> 3) + 64]; r3 = rs[m0 + (tid >> 3) + 96];
  }
  DI uint4 load(int i, int m0, int k0) const {
    LAUNDER_IDS
    const int tid = tid__, kc = (tid & 7) * 8;
    const int b9 = m0 < NTL ? m0 >> 12 : 8;
    const float* t = tab + b9 * 2048 + k0 + kc;
    const float4 g0 = *(const float4*)t, g1 = *(const float4*)(t + 4), s0 = *(const float4*)(t + 1024), s1 = *(const float4*)(t + 1028);
    const float* xp = xrow(xl, xc, m0 + (tid >> 3)) + k0 + kc + (size_t)i * 32 * D;
    const float4 x0 = *(const float4*)xp, x1 = *(const float4*)(xp + 4);
    const float rr = i == 0 ? r0 : i == 1 ? r1 : i == 2 ? r2 : r3;
    uint4 o;
    o.x = pack2(x0.x * rr * g0.x + s0.x, x0.y * rr * g0.y + s0.y);
    o.y = pack2(x0.z * rr * g0.z + s0.z, x0.w * rr * g0.w + s0.w);
    o.z = pack2(x1.x * rr * g1.x + s1.x, x1.y * rr * g1.y + s1.y);
    o.w = pack2(x1.z * rr * g1.z + s1.z, x1.w * rr * g1.w + s1.w);
    return o;
  }
};

DI bool tile_map(int it, int NTM, int NTN, int blk, int nblk, int& tm, int& tn) {
  const int xcd = blk & 7, local = blk >> 3, LB = nblk >> 3;
  const int R = NTM >> 3;
  const int s = it * LB + local;
  if (s >= R * NTN) return false;
  const int F = R >> 3, per_full = 8 * NTN;
  int mg, r, gm;
  if (s < F * per_full) { mg = s / per_full; r = s - mg * per_full; gm = 8; }
  else { mg = F; r = s - F * per_full; gm = R - F * 8; }
  const int ng = r / (gm * 8);
  const int r2 = r - ng * gm * 8;
  const int mi = r2 % gm, ni = r2 / gm;
  tm = xcd * R + mg * 8 + mi; tn = ng * 8 + ni;
  return true;
}
constexpr int LDT = 72;
template <int NI, class LA>
DI void gemm_mainloop(f32x4 (&acc)[4][NI], LA la, const u16* __restrict__ Bt, int ldb, int K, int m0, int n0, char* smem) {
  LAUNDER_IDS
  constexpr int NBI = NI;
  u16* As = (u16*)smem; u16* Bs = As + 2 * 128 * LDT;
  const int tid = tid__, lane = tid & 63, wave = tid >> 6, wr = wave >> 1, wc = wave & 1, lr = lane & 15, lq = lane >> 4;
  uint4 ra[4], rb[NBI];
  la.init(m0);
#pragma unroll
  for (int i = 0; i < 4; ++i) ra[i] = la.load(i, m0, 0);
#pragma unroll
  for (int i = 0; i < NBI; ++i) {
    const int c = tid + i * 256, row = c >> 3, kc = (c & 7) * 8;
    rb[i] = *(const uint4*)(Bt + (size_t)(n0 + row) * ldb + kc);
  }
#pragma unroll
  for (int i = 0; i < 4; ++i) {
    const int c = tid + i * 256, row = c >> 3, kc = (c & 7) * 8;
    *(uint4*)(As + row * LDT + kc) = ra[i];
    if (i < NBI) *(uint4*)(Bs + row * LDT + kc) = rb[i];
  }
  __syncthreads();
  const int nk = K >> 6;
  for (int kt = 0; kt < nk; ++kt) {
    const int cur = kt & 1;
    if (kt + 1 < nk) {
      const int k0 = (kt + 1) * 64;
#pragma unroll
      for (int i = 0; i < 4; ++i) ra[i] = la.load(i, m0, k0);
#pragma unroll
      for (int i = 0; i < NBI; ++i) {
        const int c = tid + i * 256, row = c >> 3, kc = (c & 7) * 8;
        rb[i] = *(const uint4*)(Bt + (size_t)(n0 + row) * ldb + k0 + kc);
      }
    }
    const u16* Ac = As + cur * 128 * LDT + (wr * 64 + lr) * LDT + lq * 8;
    const u16* Bc = Bs + cur * 128 * LDT + (wc * 16 * NI + lr) * LDT + lq * 8;
#pragma unroll
    for (int ks = 0; ks < 2; ++ks) {
      bf16x8 af[4], bfr[NI];
#pragma unroll
      for (int mi = 0; mi < 4; ++mi) af[mi] = *(const bf16x8*)(Ac + mi * 16 * LDT + ks * 32);
#pragma unroll
      for (int ni = 0; ni < NI; ++ni) bfr[ni] = *(const bf16x8*)(Bc + ni * 16 * LDT + ks * 32);
#pragma unroll
      for (int mi = 0; mi < 4; ++mi)
#pragma unroll
        for (int ni = 0; ni < NI; ++ni)
          acc[mi][ni] = __builtin_amdgcn_mfma_f32_16x16x32_bf16(bfr[ni], af[mi], acc[mi][ni], 0, 0, 0);
    }
    if (kt + 1 < nk) {
      const int nxt = cur ^ 1;
#pragma unroll
      for (int i = 0; i < 4; ++i) {
        const int c = tid + i * 256, row = c >> 3, kc = (c & 7) * 8;
        *(uint4*)(As + nxt * 128 * LDT + row * LDT + kc) = ra[i];
        if (i < NBI) *(uint4*)(Bs + nxt * 128 * LDT + row * LDT + kc) = rb[i];
      }
    }
    __syncthreads();
  }
}
template <int NI>
DI void zero_acc(f32x4 (&acc)[4][NI]) {
#pragma unroll
  for (int i = 0; i < 4; ++i)
#pragma unroll
    for (int j = 0; j < NI; ++j) acc[i][j] = f32x4{0.f, 0.f, 0.f, 0.f};
}
#define WAVE_COORDS const int lane = tid__ & 63, wave = tid__ >> 6, wr = wave >> 1, wc = wave & 1, lr = lane & 15, lq = lane >> 4; (void)wr; (void)wc; (void)lr; (void)lq;

DI void phase_zgemm(const Params& p, int l, char* smem) {
  LAUNDER_IDS
  WAVE_COORDS
  const u16* Wt = (const u16*)(p.ws + OFF_W + (size_t)l * W_LAYER + WO_WIN);
  LoadBf16 la{(const u16*)(p.ws + OFF_HB1), 1024};
  u16* za = (u16*)(p.ws + OFF_R2); u16* zr = (u16*)(p.ws + OFF_R1);
  constexpr int NTN = 17, NTM = NT / 128;
  for (int it = 0;; ++it) {
    int tm, tn;
    if (!tile_map(it, NTM, NTN, blk__, gridDim.x, tm, tn)) break;
    const int m0 = tm * 128, n0 = tn * 128;
    f32x4 acc[4][4]; zero_acc<4>(acc);
    gemm_mainloop<4>(acc, la, Wt, 1024, 1024, m0, n0, smem);
#pragma unroll
    for (int mi = 0; mi < 4; ++mi) {
      const int m = m0 + wr * 64 + mi * 16 + lr;
#pragma unroll
      for (int ni = 0; ni < 4; ++ni) {
        const int n = n0 + wc * 64 + ni * 16 + lq * 4;
        uint2 v; v.x = pack2(acc[mi][ni][0], acc[mi][ni][1]); v.y = pack2(acc[mi][ni][2], acc[mi][ni][3]);
        if (n < ZA) *(uint2*)(za + (size_t)m * ZA + n) = v;
        else if (n < ZA + ZR) *(uint2*)(zr + (size_t)m * ZR + (n - ZA)) = v;
      }
    }
  }
}

DI void phase_tokA(const Params& p, int l) {
  LAUNDER_IDS
  const int wave = tid__ >> 6, lane = tid__ & 63;
  const u16* za = (const u16*)(p.ws + OFF_R2);
  float* rsq = (float*)(p.ws + OFF_RSQ); float* rskv = (float*)(p.ws + OFF_RSKV);
  u16* krb = (u16*)(p.ws + OFF_KR);
  u16* pooled = (u16*)(p.ws + OFF_R4);
  const float* rt = (const float*)(p.ws + OFF_ROPE);
  const float* gk = p.in[I_GK] + l * 96;
  for (int r = blk__ * 4 + wave; r < NT; r += gridDim.x * 4) {
    const u16* z = za + (size_t)r * ZA;
    const bool lat = r < NTL;
    const int b = lat ? r >> 12 : (r - NTL) >> 8;
    const int t = lat ? r & 4095 : (r - NTL) & 255;
    const int Ls = lat ? L : LC;
    const int pos = lat ? t : 4096 + t;
    float sq = 0.f, skv = 0.f;
#pragma unroll
    for (int i = 0; i < 6; ++i) { const float v = bf2f(z[256 + i * 64 + lane]); sq += v * v; }
#pragma unroll
    for (int i = 0; i < 4; ++i) { const float v = bf2f(z[640 + i * 64 + lane]); skv += v * v; }
    sq = wavesum(sq); skv = wavesum(skv);
    if (lane == 0) { rsq[r] = rsqrtf(sq * (1.f / 384.f) + 1e-6f); rskv[r] = rsqrtf(skv * (1.f / 256.f) + 1e-6f); }
    {
      const int d = lane & 31;
      float kr = bf2f(z[896 + d]);
      float ss = kr * kr;
      for (int o = 16; o > 0; o >>= 1) ss += __shfl_xor(ss, o, 64);
      kr = kr * rsqrtf(ss * (1.f / 32.f) + 1e-6f) * gk[64 + d];
      const float other = __shfl_xor(kr, 16, 64);
      float outv = kr;
      if (lat) {
        const int i = d & 15;
        const int pp = i < 8 ? (t >> 6) : (t & 63);
        const float cs = rt[(pp * 8 + (i & 7)) * 2], sn = rt[(pp * 8 + (i & 7)) * 2 + 1];
        outv = d < 16 ? kr * cs - other * sn : other * sn + kr * cs;
      }
      if (lane < 32) krb[(size_t)r * 32 + d] = f2bf(outv);
    }
#pragma unroll
    for (int gi = 0; gi < 4; ++gi) {
      const int half = 1 << gi;
      const int lo = max(t - half, 0), hi = min(t + half, Ls);
      const int ch = gi * 64 + lane;
      float s = 0.f;
      for (int q = lo; q < hi; ++q) s += bf2f(z[(ptrdiff_t)(q - t) * ZA + ch]);
      const float mean = s / (float)(hi - lo);
      pooled[(size_t)r * 256 + ch] = f2bf(mean - bf2f(z[ch]));
    }
  }
}

constexpr int ZSL = 1160, TAL = 392;
DI void phase_tokB(const Params& p, int l, char* smem) {
  LAUNDER_IDS
  WAVE_COORDS
  const int tid = tid__;
  u16* Zs = (u16*)smem;
  u16* TA = Zs + 18 * ZSL;
  const u16* zr = (const u16*)(p.ws + OFF_R1);
  const char* wl = p.ws + OFF_W + (size_t)l * W_LAYER;
  const float* mu0 = p.in[I_MU] + (size_t)(l * 2 + 0) * ZR;
  const float* mu1 = p.in[I_MU] + (size_t)(l * 2 + 1) * ZR;
  u16* sc = (u16*)(p.ws + OFF_R3);
  for (int tile = blk__; tile < NT / 16; tile += gridDim.x) {
    const int r0 = tile * 16;
    const bool lat = r0 < NTL;
    const int t0 = lat ? r0 & 4095 : (r0 - NTL) & 255;
    const int Ls = lat ? L : LC;
    __syncthreads();
    for (int c = tid; c < 18 * 144; c += 256) {
      const int i = c / 144, ch = c - i * 144;
      const int tt = t0 - 1 + i;
      uint4 v = make_uint4(0, 0, 0, 0);
      if (tt >= 0 && tt < Ls) v = *(const uint4*)(zr + (size_t)(r0 - 1 + i) * ZR + ch * 8);
      *(uint2*)(Zs + i * ZSL + ch * 8) = make_uint2(v.x, v.y);
      *(uint2*)(Zs + i * ZSL + ch * 8 + 4) = make_uint2(v.z, v.w);
    }
    __syncthreads();
    for (int e = tid; e < 16 * 384; e += 256) {
      const int i = e / 384, c = e - i * 384, zc = 768 + c;
      const float z = bf2f(Zs[(i + 1) * ZSL + zc]), zp = bf2f(Zs[i * ZSL + zc]), zn = bf2f(Zs[(i + 2) * ZSL + zc]);
      float v = z + mu0[zc] * (zp - z) + mu1[zc] * (zn - z);
      if (c < 128) v = 1.f - 2.f / (1.f + __expf(2.f * v)); else if (c >= 256) v = sigmoidf_(v);
      TA[i * TAL + c] = f2bf(v);
    }
    __syncthreads();
    const int row = r0 + lr;
    auto shifted4 = [&](int zc, float (&out)[4]) {
      const uint2 c0 = *(const uint2*)(Zs + (lr + 1) * ZSL + zc), cp = *(const uint2*)(Zs + lr * ZSL + zc), cn = *(const uint2*)(Zs + (lr + 2) * ZSL + zc);
      const float4 m0 = *(const float4*)(mu0 + zc), m1 = *(const float4*)(mu1 + zc);
      float z, zp, zn;
      z = bflo(c0.x); zp = bflo(cp.x); zn = bflo(cn.x); out[0] = z + m0.x * (zp - z) + m1.x * (zn - z);
      z = bfhi(c0.x); zp = bfhi(cp.x); zn = bfhi(cn.x); out[1] = z + m0.y * (zp - z) + m1.y * (zn - z);
      z = bflo(c0.y); zp = bflo(cp.y); zn = bflo(cn.y); out[2] = z + m0.z * (zp - z) + m1.z * (zn - z);
      z = bfhi(c0.y); zp = bfhi(cp.y); zn = bfhi(cn.y); out[3] = z + m0.w * (zp - z) + m1.w * (zn - z);
    };
    auto product = [&](f32x4 (&ac)[4], const u16* W, int Kq, int off) {
#pragma unroll
      for (int ni = 0; ni < 4; ++ni) ac[ni] = f32x4{0.f, 0.f, 0.f, 0.f};
#pragma unroll 1
      for (int ks = 0; ks < Kq / 32; ++ks) {
        const bf16x8 bop = *(const bf16x8*)(TA + lr * TAL + off + ks * 32 + lq * 8);
#pragma unroll
        for (int ni = 0; ni < 4; ++ni) {
          const bf16x8 aop = *(const bf16x8*)(W + (size_t)(wave * 64 + ni * 16 + lr) * Kq + ks * 32 + lq * 8);
          ac[ni] = __builtin_amdgcn_mfma_f32_16x16x32_bf16(aop, bop, ac[ni], 0, 0, 0);
        }
        __builtin_amdgcn_sched_barrier(0);
      }
    };
    float ss = 0.f;
#pragma unroll
    for (int ni = 0; ni < 4; ++ni) {
      const int ch = wave * 64 + ni * 16 + lq * 4;
      float kx[4]; shifted4(256 + ch, kx);
      const float4 kw = *(const float4*)(p.in[I_KK] + l * 256 + ch);
      const float a0 = kx[0] * kw.x, a1 = kx[1] * kw.y, a2 = kx[2] * kw.z, a3 = kx[3] * kw.w;
      ss += a0 * a0 + a1 * a1 + a2 * a2 + a3 * a3;
      __builtin_amdgcn_sched_barrier(0);
    }
    ss += __shfl_xor(ss, 16, 64); ss += __shfl_xor(ss, 32, 64);
    const float kinv = rsqrtf(fmaxf(ss, 1e-24f));
    {
      f32x4 ag[4];
      product(ag, (const u16*)(wl + WO_RG2), 128, 256);
#pragma unroll
      for (int ni = 0; ni < 4; ++ni) {
        const int ch = wave * 64 + ni * 16 + lq * 4;
        const size_t o = (size_t)row * 256 + ch;
        float rx[4], kx[4], vx[4];
        shifted4(ch, rx); shifted4(256 + ch, kx); shifted4(512 + ch, vx);
        const float4 kw = *(const float4*)(p.in[I_KK] + l * 256 + ch);
        *(uint2*)(sc + SA_R * (size_t)NT * 256 + o) = make_uint2(pack2(rx[0], rx[1]), pack2(rx[2], rx[3]));
        *(uint2*)(sc + SA_V * (size_t)NT * 256 + o) = make_uint2(pack2(vx[0], vx[1]), pack2(vx[2], vx[3]));
        *(uint2*)(sc + SA_KKN * (size_t)NT * 256 + o) = make_uint2(pack2(-kx[0] * kw.x * kinv, -kx[1] * kw.y * kinv), pack2(-kx[2] * kw.z * kinv, -kx[3] * kw.w * kinv));
        *(uint2*)(sc + SA_G * (size_t)NT * 256 + o) = make_uint2(pack2(ag[ni][0], ag[ni][1]), pack2(ag[ni][2], ag[ni][3]));
        __builtin_amdgcn_sched_barrier(0);
      }
    }
#pragma unroll 1
    for (int d = 0; d < 2; ++d) {
      f32x4 aw[4], aa[4];
      product(aw, (const u16*)(wl + WO_RW2) + (size_t)d * 256 * 64, 64, d * 64);
      product(aa, (const u16*)(wl + WO_RA2) + (size_t)d * 256 * 64, 64, 128 + d * 64);
      __builtin_amdgcn_sched_barrier(0);
      u16* oOMW = sc + (d ? SA_OMWB : SA_OMWF) * (size_t)NT * 256;
      u16* oKD = sc + (d ? SA_KDB : SA_KDF) * (size_t)NT * 256;
      u16* oB = sc + (d ? SA_BB : SA_BF) * (size_t)NT * 256;
#pragma unroll
      for (int ni = 0; ni < 4; ++ni) {
        const int ch = wave * 64 + ni * 16 + lq * 4;
        const size_t o = (size_t)row * 256 + ch;
        float kx[4]; shifted4(256 + ch, kx);
        const float4 kw = *(const float4*)(p.in[I_KK] + l * 256 + ch);
        const float kkn[4] = {kx[0] * kw.x * kinv, kx[1] * kw.y * kinv, kx[2] * kw.z * kinv, kx[3] * kw.w * kinv};
        const float4 w0 = *(const float4*)(p.in[I_W0] + (size_t)(l * 2 + d) * 256 + ch);
        const float4 a0 = *(const float4*)(p.in[I_A0] + (size_t)(l * 2 + d) * 256 + ch);
        const float4 ka = *(const float4*)(p.in[I_KA] + (size_t)(l * 2 + d) * 256 + ch);
        const float w0a[4] = {w0.x, w0.y, w0.z, w0.w}, a0a[4] = {a0.x, a0.y, a0.z, a0.w}, kaa[4] = {ka.x, ka.y, ka.z, ka.w};
        float omw[4], kd[4], bb[4];
#pragma unroll
        for (int j = 0; j < 4; ++j) {
          const float xw = -(w0a[j] + aw[ni][j]);
          const float sp = fmaxf(xw, 0.f) + __logf(1.f + __expf(-fabsf(xw)));
          const float wlog = -sp - 0.5f;
          const float e = __expf(wlog);
          omw[j] = 1.f - __expf(-e);
          const float a = sigmoidf_(a0a[j] + aa[ni][j]);
          kd[j] = kx[j] * (1.f + (a - 1.f) * kaa[j]);
          bb[j] = kkn[j] * a;
        }
        *(uint2*)(oOMW + o) = make_uint2(pack2(omw[0], omw[1]), pack2(omw[2], omw[3]));
        *(uint2*)(oKD + o) = make_uint2(pack2(kd[0], kd[1]), pack2(kd[2], kd[3]));
        *(uint2*)(oB + o) = make_uint2(pack2(bb[0], bb[1]), pack2(bb[2], bb[3]));
        __builtin_amdgcn_sched_barrier(0);
      }
    }
  }
}

DI size_t qk_index(int m, int h) {
  const bool lat = m < NTL;
  const int b = lat ? m >> 12 : (m - NTL) >> 8;
  const int pos = lat ? m & 4095 : 4096 + ((m - NTL) & 255);
  return ((size_t)(b * 8 + h) * LK + pos) * 96;
}
DI void phase_qkv(const Params& p, int l, char* smem) {
  LAUNDER_IDS
  WAVE_COORDS
  const char* wl = p.ws + OFF_W + (size_t)l * W_LAYER;
  const u16* za = (const u16*)(p.ws + OFF_R2);
  const float* rsq = (const float*)(p.ws + OFF_RSQ); const float* rskv = (const float*)(p.ws + OFF_RSKV);
  u16* Qb = (u16*)(p.ws + OFF_R1); u16* Kb = (u16*)(p.ws + OFF_R1 + SZ_Q); u16* Vt = (u16*)(p.ws + OFF_R1 + 2 * SZ_Q);
  const float* rt = (const float*)(p.ws + OFF_ROPE);
  const float* gq = p.in[I_GQ] + l * 96; const float* gk = p.in[I_GK] + l * 96;
  const float QS = 0.10206207261596577f * 1.4426950408889634f;
  constexpr int NTM = NT / 128;
  for (int it = 0;; ++it) {
    int tm, tn;
    if (!tile_map(it, NTM, 14, blk__, gridDim.x, tm, tn)) break;
    f32x4 acc[4][4]; zero_acc<4>(acc);
    if (tn < 6) {
      const int m0 = tm * 128, n0 = tn * 128;
      LoadBf16 la{za + 256, ZA};
      gemm_mainloop<4>(acc, la, (const u16*)(wl + WO_UQ), 384, 384, m0, n0, smem);
      const int nw = n0 + wc * 64;
#pragma unroll
      for (int mi = 0; mi < 4; ++mi) {
        const int m = m0 + wr * 64 + mi * 16 + lr;
        const float rs = rsq[m];
        if (nw < 512) {
          const int h = nw >> 6;
          float ss = 0.f;
#pragma unroll
          for (int ni = 0; ni < 4; ++ni)
#pragma unroll
            for (int j = 0; j < 4; ++j) { const float v = acc[mi][ni][j] * rs; ss += v * v; }
          ss += __shfl_xor(ss, 16, 64); ss += __shfl_xor(ss, 32, 64);
          const float f = rs * rsqrtf(ss * (1.f / 64.f) + 1e-6f) * QS;
          u16* dst = Qb + qk_index(m, h);
#pragma unroll
          for (int ni = 0; ni < 4; ++ni) {
            const int d = ni * 16 + lq * 4;
            const float4 g = *(const float4*)(gq + d);
            *(uint2*)(dst + d) = make_uint2(pack2(acc[mi][ni][0] * f * g.x, acc[mi][ni][1] * f * g.y), pack2(acc[mi][ni][2] * f * g.z, acc[mi][ni][3] * f * g.w));
          }
        } else {
          const bool lat = m < NTL;
          const int tt = m & 4095;
#pragma unroll
          for (int hh = 0; hh < 2; ++hh) {
            const int h = ((nw - 512) >> 5) + hh;
            float ss = 0.f;
#pragma unroll
            for (int ni = 0; ni < 2; ++ni)
#pragma unroll
              for (int j = 0; j < 4; ++j) { const float v = acc[mi][hh * 2 + ni][j] * rs; ss += v * v; }
            ss += __shfl_xor(ss, 16, 64); ss += __shfl_xor(ss, 32, 64);
            const float f = rs * rsqrtf(ss * (1.f / 32.f) + 1e-6f) * QS;
            const int i0 = lq * 4;
            const float4 g1 = *(const float4*)(gq + 64 + i0), g2 = *(const float4*)(gq + 80 + i0);
            const float g1a[4] = {g1.x, g1.y, g1.z, g1.w}, g2a[4] = {g2.x, g2.y, g2.z, g2.w};
            float o1[4], o2[4];
#pragma unroll
            for (int j = 0; j < 4; ++j) {
              const float x1 = acc[mi][hh * 2][j] * f * g1a[j], x2 = acc[mi][hh * 2 + 1][j] * f * g2a[j];
              float cs = 1.f, sn = 0.f;
              if (lat) {
                const int i = i0 + j;
                const int pp = i < 8 ? (tt >> 6) : (tt & 63);
                cs = rt[(pp * 8 + (i & 7)) * 2]; sn = rt[(pp * 8 + (i & 7)) * 2 + 1];
              }
              o1[j] = x1 * cs - x2 * sn; o2[j] = x1 * sn + x2 * cs;
            }
            u16* dst = Qb + qk_index(m, h) + 64;
            *(uint2*)(dst + i0) = make_uint2(pack2(o1[0], o1[1]), pack2(o1[2], o1[3]));
            *(uint2*)(dst + 16 + i0) = make_uint2(pack2(o2[0], o2[1]), pack2(o2[2], o2[3]));
          }
        }
      }
    } else {
      const int h = tn - 6, m0 = tm * 128, n0 = h * 128;
      LoadBf16 la{za + 640, ZA};
      gemm_mainloop<4>(acc, la, (const u16*)(wl + WO_UKV), 256, 256, m0, n0, smem);
#pragma unroll
      for (int mi = 0; mi < 4; ++mi) {
        const int m = m0 + wr * 64 + mi * 16 + lr;
        const float rs = rskv[m];
        if (wc == 0) {
          float ss = 0.f;
#pragma unroll
          for (int ni = 0; ni < 4; ++ni)
#pragma unroll
            for (int j = 0; j < 4; ++j) { const float v = acc[mi][ni][j] * rs; ss += v * v; }
          ss += __shfl_xor(ss, 16, 64); ss += __shfl_xor(ss, 32, 64);
          const float f = rs * rsqrtf(ss * (1.f / 64.f) + 1e-6f);
          u16* dst = Kb + qk_index(m, h);
#pragma unroll
          for (int ni = 0; ni < 4; ++ni) {
            const int d = ni * 16 + lq * 4;
            const float4 g = *(const float4*)(gk + d);
            *(uint2*)(dst + d) = make_uint2(pack2(acc[mi][ni][0] * f * g.x, acc[mi][ni][1] * f * g.y), pack2(acc[mi][ni][2] * f * g.z, acc[mi][ni][3] * f * g.w));
          }
          *(uint4*)(dst + 64 + lq * 8) = *(const uint4*)((const u16*)(p.ws + OFF_KR) + (size_t)m * 32 + lq * 8);
        } else {
          const bool lat = m < NTL;
          const int b = lat ? m >> 12 : (m - NTL) >> 8;
          const int pos = lat ? m & 4095 : 4096 + ((m - NTL) & 255);
          u16* dst = Vt + (size_t)(b * 8 + h) * 64 * LK + pos;
#pragma unroll
          for (int ni = 0; ni < 4; ++ni)
#pragma unroll
            for (int j = 0; j < 4; ++j) dst[(size_t)(ni * 16 + lq * 4 + j) * LK] = f2bf(acc[mi][ni][j] * rs);
        }
      }
    }
  }
}

DI int scan_row(int b, int dir, int s) {
  if (s < LC) return NTL + b * LC + (dir ? LC - 1 - s : s);
  const int t = s - LC;
  return b * L + (dir ? L - 1 - t : t);
}
DI void phase_scan(const Params& p, char* smem) {
  LAUNDER_IDS
  const int blk = blk__;
  if (blk >= 256) return;
  const int tid = tid__, lane = tid & 63, wave = tid >> 6, kq = lane & 15, rg = lane >> 4;
  const int chain = (blk & 7) + 8 * (blk >> 5), quarter = (blk >> 3) & 3;
  const int b = chain >> 3, h = (chain >> 1) & 3, dir = chain & 1;
  const u16* sc = (const u16*)(p.ws + OFF_R3);
  const size_t AS = (size_t)NT * 256;
  const u16* aOMW = sc + (dir ? SA_OMWB : SA_OMWF) * AS;
  const u16* aKD = sc + (dir ? SA_KDB : SA_KDF) * AS;
  const u16* aB = sc + (dir ? SA_BB : SA_BF) * AS;
  const u16* aKKN = sc + SA_KKN * AS;
  const u16* aR = sc + SA_R * AS;
  const u16* aV = sc + SA_V * AS;
  u16* Y = (u16*)(p.ws + OFF_R2) + (dir ? AS : 0);
  u16* buf = (u16*)smem;
  constexpr int BSZ = 5 * 2048 + 512;
  const int st_ld = tid >> 3, k8 = (tid & 7) * 8;
  const int vrow = quarter * 16 + wave * 4 + rg;
  uint4 r0, r1, r2, r3, r4, rv;
  rv = make_uint4(0, 0, 0, 0);
  auto gload = [&](int chunk) {
    const int row = scan_row(b, dir, chunk * 32 + st_ld);
    const size_t o = (size_t)row * 256 + h * 64 + k8;
    r0 = *(const uint4*)(aOMW + o); r1 = *(const uint4*)(aKD + o); r2 = *(const uint4*)(aB + o); r3 = *(const uint4*)(aKKN + o); r4 = *(const uint4*)(aR + o);
    if (tid < 64) {
      const int rowv = scan_row(b, dir, chunk * 32 + (tid >> 1));
      rv = *(const uint4*)(aV + (size_t)rowv * 256 + h * 64 + quarter * 16 + (tid & 1) * 8);
    }
  };
  auto lstore = [&](int bi) {
    u16* bb = buf + bi * BSZ;
    *(uint4*)(bb + 0 * 2048 + st_ld * 64 + k8) = r0;
    *(uint4*)(bb + 1 * 2048 + st_ld * 64 + k8) = r1;
    *(uint4*)(bb + 2 * 2048 + st_ld * 64 + k8) = r2;
    *(uint4*)(bb + 3 * 2048 + st_ld * 64 + k8) = r3;
    *(uint4*)(bb + 4 * 2048 + st_ld * 64 + k8) = r4;
    if (tid < 64) *(uint4*)(bb + 5 * 2048 + (tid >> 1) * 16 + (tid & 1) * 8) = rv;
  };
  float S0 = 0.f, S1 = 0.f, S2 = 0.f, S3 = 0.f;
  __syncthreads();
  gload(0); lstore(0);
  __syncthreads();
  constexpr int NCH = LK / 32;
  for (int c = 0; c < NCH; ++c) {
    if (c + 1 < NCH) gload(c + 1);
    const u16* bb = buf + (c & 1) * BSZ;
#pragma unroll 4
    for (int s = 0; s < 32; ++s) {
      const uint2 uw = *(const uint2*)(bb + 0 * 2048 + s * 64 + kq * 4);
      const uint2 uk = *(const uint2*)(bb + 1 * 2048 + s * 64 + kq * 4);
      const uint2 ub = *(const uint2*)(bb + 2 * 2048 + s * 64 + kq * 4);
      const uint2 ua = *(const uint2*)(bb + 3 * 2048 + s * 64 + kq * 4);
      const uint2 ur = *(const uint2*)(bb + 4 * 2048 + s * 64 + kq * 4);
      const float vv = bf2f(bb[5 * 2048 + s * 16 + wave * 4 + rg]);
      float sa = S0 * bflo(ua.x) + S1 * bfhi(ua.x) + S2 * bflo(ua.y) + S3 * bfhi(ua.y);
      sa = rowsum16(sa);
      S0 = S0 * (1.f - bflo(uw.x)) + (sa * bflo(ub.x) + vv * bflo(uk.x));
      S1 = S1 * (1.f - bfhi(uw.x)) + (sa * bfhi(ub.x) + vv * bfhi(uk.x));
      S2 = S2 * (1.f - bflo(uw.y)) + (sa * bflo(ub.y) + vv * bflo(uk.y));
      S3 = S3 * (1.f - bfhi(uw.y)) + (sa * bfhi(ub.y) + vv * bfhi(uk.y));
      float y = S0 * bflo(ur.x) + S1 * bfhi(ur.x) + S2 * bflo(ur.y) + S3 * bfhi(ur.y);
      y = rowsum16(y);
      if (kq == 0) {
        const int row = scan_row(b, dir, c * 32 + s);
        Y[(size_t)row * 256 + h * 64 + vrow] = f2bf(y);
      }
    }
    if (c + 1 < NCH) lstore((c + 1) & 1);
    __syncthreads();
  }
}

constexpr int KSL = 104, VSL = 68;
template <int B0>
DI bf16x8 pack8(const f32x16& v) {
  uint4 pw;
  pw.x = pack2(v[B0 + 0], v[B0 + 1]); pw.y = pack2(v[B0 + 2], v[B0 + 3]); pw.z = pack2(v[B0 + 4], v[B0 + 5]); pw.w = pack2(v[B0 + 6], v[B0 + 7]);
  return __builtin_bit_cast(bf16x8, pw);
}
DI void pv_step(f32x16& o0, f32x16& o1, const u16* Vc, int r32, int kb, bf16x8 pf) {
  {
    const uint2 lo = *(const uint2*)(Vc + r32 * VSL + kb), hi2 = *(const uint2*)(Vc + r32 * VSL + kb + 8);
    const bf16x8 va = __builtin_bit_cast(bf16x8, make_uint4(lo.x, lo.y, hi2.x, hi2.y));
    o0 = __builtin_amdgcn_mfma_f32_32x32x16_bf16(va, pf, o0, 0, 0, 0);
  }
  {
    const uint2 lo = *(const uint2*)(Vc + (32 + r32) * VSL + kb), hi2 = *(const uint2*)(Vc + (32 + r32) * VSL + kb + 8);
    const bf16x8 va = __builtin_bit_cast(bf16x8, make_uint4(lo.x, lo.y, hi2.x, hi2.y));
    o1 = __builtin_amdgcn_mfma_f32_32x32x16_bf16(va, pf, o1, 0, 0, 0);
  }
}
DI void attn_item(const Params& p, int item, char* smem) {
  LAUNDER_IDS
  const int tid = tid__, lane = tid & 63, wave = tid >> 6, r32 = lane & 31, hi = lane >> 5;
  int bh, qpos0, key0, nkt, orow0;
  if (item < 2048) { bh = item >> 5; const int qb = item & 31; qpos0 = qb * 128; key0 = 0; nkt = LK / 64; orow0 = (bh >> 3) * L + qpos0; }
  else { const int it = item - 2048; bh = it >> 1; const int qb = it & 1; qpos0 = 4096 + qb * 128; key0 = 4096; nkt = LC / 64; orow0 = NTL + (bh >> 3) * LC + qb * 128; }
  const int h = bh & 7;
  const u16* Qp = (const u16*)(p.ws + OFF_R1) + ((size_t)bh * LK + qpos0 + wave * 32 + r32) * 96 + hi * 8;
  const u16* Kp = (const u16*)(p.ws + OFF_R1 + SZ_Q) + ((size_t)bh * LK + key0) * 96;
  const u16* Vp = (const u16*)(p.ws + OFF_R1 + 2 * SZ_Q) + (size_t)bh * 64 * LK + key0;
  u16* Ks = (u16*)smem;
  u16* Vs = Ks + 2 * 64 * KSL;
  bf16x8 qr[6];
#pragma unroll
  for (int d0 = 0; d0 < 6; ++d0) qr[d0] = *(const bf16x8*)(Qp + d0 * 16);
  uint4 sk0, sk1, sk2, sv0, sv1;
  const int kr0 = tid / 12, kc0 = tid - kr0 * 12, kr1 = (tid + 256) / 12, kc1 = (tid + 256) - kr1 * 12, kr2 = (tid + 512) / 12, kc2 = (tid + 512) - kr2 * 12;
  const int vd0 = tid >> 3, vc0 = tid & 7, vd1 = vd0 + 32;
#define gload(kt) do { \
    sk0 = *(const uint4*)(Kp + (size_t)((kt) * 64 + kr0) * 96 + kc0 * 8); sk1 = *(const uint4*)(Kp + (size_t)((kt) * 64 + kr1) * 96 + kc1 * 8); \
    sk2 = *(const uint4*)(Kp + (size_t)((kt) * 64 + kr2) * 96 + kc2 * 8); \
    sv0 = *(const uint4*)(Vp + (size_t)vd0 * LK + (kt) * 64 + vc0 * 8); sv1 = *(const uint4*)(Vp + (size_t)vd1 * LK + (kt) * 64 + vc0 * 8); } while (0)
#define lstore(bi) do { \
    *(uint4*)(Ks + (bi) * 64 * KSL + kr0 * KSL + kc0 * 8) = sk0; *(uint4*)(Ks + (bi) * 64 * KSL + kr1 * KSL + kc1 * 8) = sk1; *(uint4*)(Ks + (bi) * 64 * KSL + kr2 * KSL + kc2 * 8) = sk2; \
    { u16* dst = Vs + (bi) * 64 * VSL + vd0 * VSL + vc0 * 8; *(uint2*)dst = make_uint2(sv0.x, sv0.y); *(uint2*)(dst + 4) = make_uint2(sv0.z, sv0.w); } \
    { u16* dst = Vs + (bi) * 64 * VSL + vd1 * VSL + vc0 * 8; *(uint2*)dst = make_uint2(sv1.x, sv1.y); *(uint2*)(dst + 4) = make_uint2(sv1.z, sv1.w); } } while (0)
  f32x16 o0, o1;
#pragma unroll
  for (int i = 0; i < 16; ++i) { o0[i] = 0.f; o1[i] = 0.f; }
  float mrun = -1e30f, lrun = 0.f;
  __syncthreads();
  gload(0); lstore(0);
  __syncthreads();
  for (int kt = 0; kt < nkt; ++kt) {
    const int cur = kt & 1;
    if (kt + 1 < nkt) gload(kt + 1);
    const u16* Kc = Ks + cur * 64 * KSL;
    const u16* Vc = Vs + cur * 64 * VSL;
    f32x16 p0, p1;
#pragma unroll
    for (int i = 0; i < 16; ++i) { p0[i] = 0.f; p1[i] = 0.f; }
#pragma unroll
    for (int d0 = 0; d0 < 6; ++d0) {
      const bf16x8 a0 = *(const bf16x8*)(Kc + r32 * KSL + d0 * 16 + hi * 8);
      const bf16x8 a1 = *(const bf16x8*)(Kc + (32 + r32) * KSL + d0 * 16 + hi * 8);
      p0 = __builtin_amdgcn_mfma_f32_32x32x16_bf16(a0, qr[d0], p0, 0, 0, 0);
      p1 = __builtin_amdgcn_mfma_f32_32x32x16_bf16(a1, qr[d0], p1, 0, 0, 0);
    }
    float mx = p0[0];
#pragma unroll
    for (int i = 1; i < 16; ++i) mx = fmaxf(mx, p0[i]);
#pragma unroll
    for (int i = 0; i < 16; ++i) mx = fmaxf(mx, p1[i]);
    mx = fmaxf(mx, __shfl_xor(mx, 32, 64));
    if (!__all(mx - mrun <= 8.f)) {
      const float mn = fmaxf(mrun, mx);
      const float alpha = __builtin_amdgcn_exp2f(mrun - mn);
      mrun = mn; lrun *= alpha;
#pragma unroll
      for (int i = 0; i < 16; ++i) { o0[i] *= alpha; o1[i] *= alpha; }
    }
    float ps = 0.f;
#pragma unroll
    for (int i = 0; i < 16; ++i) { p0[i] = __builtin_amdgcn_exp2f(p0[i] - mrun); ps += p0[i]; }
#pragma unroll
    for (int i = 0; i < 16; ++i) { p1[i] = __builtin_amdgcn_exp2f(p1[i] - mrun); ps += p1[i]; }
    lrun += ps;
    pv_step(o0, o1, Vc, r32, 0 + hi * 4, pack8<0>(p0));
    pv_step(o0, o1, Vc, r32, 16 + hi * 4, pack8<8>(p0));
    pv_step(o0, o1, Vc, r32, 32 + hi * 4, pack8<0>(p1));
    pv_step(o0, o1, Vc, r32, 48 + hi * 4, pack8<8>(p1));
    if (kt + 1 < nkt) lstore(cur ^ 1);
    __syncthreads();
  }
  lrun += __shfl_xor(lrun, 32, 64);
  const float inv = 1.f / lrun;
  u16* om = (u16*)(p.ws + OFF_R3 + SA_KKN * SZ_TOK256) + (size_t)(orow0 + wave * 32 + r32) * 512 + h * 64;
#pragma unroll
  for (int g = 0; g < 4; ++g) {
    const int d = 8 * g + 4 * hi;
    *(uint2*)(om + d) = make_uint2(pack2(o0[4 * g] * inv, o0[4 * g + 1] * inv), pack2(o0[4 * g + 2] * inv, o0[4 * g + 3] * inv));
    *(uint2*)(om + 32 + d) = make_uint2(pack2(o1[4 * g] * inv, o1[4 * g + 1] * inv), pack2(o1[4 * g + 2] * inv, o1[4 * g + 3] * inv));
  }
#undef gload
#undef lstore
}

DI void readout_row(const Params& p, int l, int r) {
  LAUNDER_IDS
  const int lane = tid__ & 63;
  const u16* sc = (const u16*)(p.ws + OFF_R3);
  const size_t AS = (size_t)NT * 256;
  const size_t o = (size_t)r * 256 + lane * 4;
  const u16* Yf = (const u16*)(p.ws + OFF_R2);
  const uint2 yf = *(const uint2*)(Yf + o), yb = *(const uint2*)(Yf + AS + o);
  const uint2 ur = *(const uint2*)(sc + SA_R * AS + o), uv = *(const uint2*)(sc + SA_V * AS + o);
  const uint2 kf = *(const uint2*)(sc + SA_KDF * AS + o), kb = *(const uint2*)(sc + SA_KDB * AS + o), ug = *(const uint2*)(sc + SA_G * AS + o);
  float y[4] = {bflo(yf.x) + bflo(yb.x), bfhi(yf.x) + bfhi(yb.x), bflo(yf.y) + bflo(yb.y), bfhi(yf.y) + bfhi(yb.y)};
  const float rr[4] = {bflo(ur.x), bfhi(ur.x), bflo(ur.y), bfhi(ur.y)};
  const float vv[4] = {bflo(uv.x), bfhi(uv.x), bflo(uv.y), bfhi(uv.y)};
  const float km[4] = {0.5f * (bflo(kf.x) + bflo(kb.x)), 0.5f * (bfhi(kf.x) + bfhi(kb.x)), 0.5f * (bflo(kf.y) + bflo(kb.y)), 0.5f * (bfhi(kf.y) + bfhi(kb.y))};
  const float gg[4] = {bflo(ug.x), bfhi(ug.x), bflo(ug.y), bfhi(ug.y)};
  const float4 rk4 = *(const float4*)(p.in[I_RK] + l * 256 + lane * 4);
  const float4 lw4 = *(const float4*)(p.in[I_LNW] + l * 256 + lane * 4);
  const float4 lb4 = *(const float4*)(p.in[I_LNB] + l * 256 + lane * 4);
  const float rk[4] = {rk4.x, rk4.y, rk4.z, rk4.w}, lw[4] = {lw4.x, lw4.y, lw4.z, lw4.w}, lb[4] = {lb4.x, lb4.y, lb4.z, lb4.w};
  float s = y[0] + y[1] + y[2] + y[3];
  s = rowsum16(s);
  const float mu = s * (1.f / 64.f);
  float q = 0.f, bn = 0.f;
#pragma unroll
  for (int j = 0; j < 4; ++j) { const float d = y[j] - mu; q += d * d; bn += rr[j] * km[j] * rk[j]; }
  q = rowsum16(q); bn = rowsum16(bn);
  const float rstd = rsqrtf(q * (1.f / 64.f) + 64e-5f);
  float ov[4];
#pragma unroll
  for (int j = 0; j < 4; ++j) ov[j] = ((y[j] - mu) * rstd * lw[j] + lb[j] + bn * vv[j]) * gg[j];
  u16* orw = (u16*)(p.ws + OFF_R3 + SA_KKN * SZ_TOK256 + (size_t)NT * 512 * 2);
  *(uint2*)(orw + o) = make_uint2(pack2(ov[0], ov[1]), pack2(ov[2], ov[3]));
}

DI void phase_attn(const Params& p, int l, int Mout, char* smem) {
  LAUNDER_IDS
  const int nattn = (l == 0) ? 2048 + 128 : 2048;
  for (int it = blk__; it < nattn; it += gridDim.x) attn_item(p, it, smem);
  const int wave = tid__ >> 6;
  for (int r = blk__ * 4 + wave; r < Mout; r += gridDim.x * 4) readout_row(p, l, r);
}

DI void phase_merge(const Params& p, int l, int Mout, char* smem) {
  LAUNDER_IDS
  WAVE_COORDS
  const char* wl = p.ws + OFF_W + (size_t)l * W_LAYER;
  LoadBf16 lg{(const u16*)(p.ws + OFF_HBG), 1024};
  const u16* opool = (const u16*)(p.ws + OFF_R4);
  const u16* omla = (const u16*)(p.ws + OFF_R3 + SA_KKN * SZ_TOK256);
  const u16* orw = omla + (size_t)NT * 512;
  u16* mo = (u16*)(p.ws + OFF_R1);
  const int ntm = Mout / 128;
  for (int it = 0;; ++it) {
    int tm, tn;
    if (!tile_map(it, ntm, 16, blk__, gridDim.x, tm, tn)) break;
    const int m0 = tm * 128, n0 = tn * 64;
    f32x4 msum[4][2]; zero_acc<2>(msum);
#pragma unroll 1
    for (int br = 0; br < 3; ++br) {
      unsigned gpk[4][2][2];
      {
        f32x4 ag[4][2]; zero_acc<2>(ag);
        gemm_mainloop<2>(ag, lg, (const u16*)(wl + WO_WIN) + (size_t)(2080 + br * 1024) * 1024, 1024, 1024, m0, n0, smem);
#pragma unroll
        for (int mi = 0; mi < 4; ++mi)
#pragma unroll
          for (int ni = 0; ni < 2; ++ni) {
            gpk[mi][ni][0] = pack2(sigmoidf_(ag[mi][ni][0]), sigmoidf_(ag[mi][ni][1]));
            gpk[mi][ni][1] = pack2(sigmoidf_(ag[mi][ni][2]), sigmoidf_(ag[mi][ni][3]));
          }
      }
      __builtin_amdgcn_sched_barrier(0);
      f32x4 ab[4][2]; zero_acc<2>(ab);
      {
        const int Kb = br == 1 ? 512 : 256;
        LoadBf16 la{br == 0 ? opool : br == 1 ? omla : orw, Kb};
        const u16* Wb = (const u16*)(wl + (br == 0 ? WO_BRP : br == 1 ? WO_BRM : WO_BRR));
        gemm_mainloop<2>(ab, la, Wb, Kb, Kb, m0, n0, smem);
      }
#pragma unroll
      for (int mi = 0; mi < 4; ++mi)
#pragma unroll
        for (int ni = 0; ni < 2; ++ni) {
          msum[mi][ni][0] += bflo(gpk[mi][ni][0]) * ab[mi][ni][0];
          msum[mi][ni][1] += bfhi(gpk[mi][ni][0]) * ab[mi][ni][1];
          msum[mi][ni][2] += bflo(gpk[mi][ni][1]) * ab[mi][ni][2];
          msum[mi][ni][3] += bfhi(gpk[mi][ni][1]) * ab[mi][ni][3];
        }
      __builtin_amdgcn_sched_barrier(0);
    }
#pragma unroll
    for (int mi = 0; mi < 4; ++mi) {
      const int m = m0 + wr * 64 + mi * 16 + lr;
#pragma unroll
      for (int ni = 0; ni < 2; ++ni) {
        const int n = n0 + wc * 32 + ni * 16 + lq * 4;
        *(uint2*)(mo + (size_t)m * 1024 + n) = make_uint2(pack2(msum[mi][ni][0], msum[mi][ni][1]), pack2(msum[mi][ni][2], msum[mi][ni][3]));
      }
    }
  }
}

DI void phase_resid(const Params& p, const u16* A, int K, const u16* Bt, const float* gate  ,
                    const float* xl_in, const float* xc_in, float* xl_out, float* xc_out, int Mout, char* smem) {
  LAUNDER_IDS
  WAVE_COORDS
  LoadBf16 la{A, K};
  const int ntm = Mout / 128;
  for (int it = 0;; ++it) {
    int tm, tn;
    if (!tile_map(it, ntm, 8, blk__, gridDim.x, tm, tn)) break;
    const int m0 = tm * 128, n0 = tn * 128;
    f32x4 acc[4][4]; zero_acc<4>(acc);
    gemm_mainloop<4>(acc, la, Bt, K, K, m0, n0, smem);
#pragma unroll
    for (int mi = 0; mi < 4; ++mi) {
      const int m = m0 + wr * 64 + mi * 16 + lr;
      const int b9 = m < NTL ? m >> 12 : 8;
      const float* xi = xrow(xl_in, xc_in, m);
      float* xo = m < NTL ? xl_out + (size_t)m * D : xc_out + (size_t)(m - NTL) * D;
#pragma unroll
      for (int ni = 0; ni < 4; ++ni) {
        const int n = n0 + wc * 64 + ni * 16 + lq * 4;
        const float4 g = *(const float4*)(gate + (size_t)b9 * 6144 + n);
        const float4 xv = *(const float4*)(xi + n);
        float4 ov;
        ov.x = xv.x + g.x * acc[mi][ni][0]; ov.y = xv.y + g.y * acc[mi][ni][1]; ov.z = xv.z + g.z * acc[mi][ni][2]; ov.w = xv.w + g.w * acc[mi][ni][3];
        *(float4*)(xo + n) = ov;
      }
    }
  }
}
DI void phase_mlp1(const Params& p, int l, int Mout, char* smem) {
  LAUNDER_IDS
  WAVE_COORDS
  const char* wl = p.ws + OFF_W + (size_t)l * W_LAYER;
  LoadBf16 la{(const u16*)(p.ws + OFF_HB2), 1024};
  u16* U = (u16*)(p.ws + OFF_R1);
  const int ntm = Mout / 128;
  for (int it = 0;; ++it) {
    int tm, tn;
    if (!tile_map(it, ntm, 32, blk__, gridDim.x, tm, tn)) break;
    const int m0 = tm * 128, n0 = tn * 128;
    f32x4 acc[4][4]; zero_acc<4>(acc);
    gemm_mainloop<4>(acc, la, (const u16*)(wl + WO_W1), 1024, 1024, m0, n0, smem);
#pragma unroll
    for (int mi = 0; mi < 4; ++mi) {
      const int m = m0 + wr * 64 + mi * 16 + lr;
#pragma unroll
      for (int ni = 0; ni < 4; ++ni) {
        const int n = n0 + wc * 64 + ni * 16 + lq * 4;
        float v[4];
#pragma unroll
        for (int j = 0; j < 4; ++j) { const float a = fmaxf(acc[mi][ni][j], 0.f); v[j] = a * a; }
        *(uint2*)(U + (size_t)m * DFF + n) = make_uint2(pack2(v[0], v[1]), pack2(v[2], v[3]));
      }
    }
  }
}

__global__ void __launch_bounds__(256, 2) fwd_megakernel(Params pk) {
  __shared__ __attribute__((aligned(16))) char smem[73728];
  cg::grid_group grid = cg::this_grid();
  unsigned* bar = (unsigned*)(pk.ws + OFF_BAR);
  unsigned epoch = 0;
  phase_prep(pk, smem);
  grid.sync();
  phase_tables(pk);
  grid_barrier(bar, epoch);
#define CTXBUF ((float*)(p.ws + OFF_CTX))
#define XLP (l == 0 ? p.in[I_X] : (const float*)p.out)
#define XCP (l == 0 ? p.in[I_CTX] : (const float*)CTXBUF)
#define MOUT (l == 0 ? NT : NTL)
#define WLP (p.ws + OFF_W + (size_t)l * W_LAYER)
#define TABP(nrm) ((const float*)(p.ws + OFF_TAB) + (size_t)(l * 2 + (nrm)) * 9 * 2048)
#define MODP(j) ((const float*)(p.ws + OFF_MODS) + (size_t)l * 9 * 6144 + (j) * 1024)
#ifndef PROBE_Q
#define PROBE_Q -1
#endif
#pragma nounroll
  for (int ph = 0; ph < 24; ++ph) {
    const int l = ph >= 12 ? 1 : 0, q = ph - l * 12;
    Params p = pk;
    {
      unsigned long long w_ = (unsigned long long)pk.ws, o_ = (unsigned long long)pk.out;
      unsigned wl_ = (unsigned)w_, wh_ = (unsigned)(w_ >> 32), ol_ = (unsigned)o_, oh_ = (unsigned)(o_ >> 32);
      wl_ = __builtin_amdgcn_readfirstlane(wl_); wh_ = __builtin_amdgcn_readfirstlane(wh_); ol_ = __builtin_amdgcn_readfirstlane(ol_); oh_ = __builtin_amdgcn_readfirstlane(oh_);
      asm volatile("" : "+s"(wl_), "+s"(wh_), "+s"(ol_), "+s"(oh_));
      p.ws = (char*)(((unsigned long long)wh_ << 32) | wl_); p.out = (float*)(((unsigned long long)oh_ << 32) | ol_);
    }
#pragma nounroll
    for (int rep = 0; rep < (q == PROBE_Q ? 2 : 1); ++rep)
    switch (q) {
      case 0: phase_norm(XLP, XCP, TABP(0), (u16*)(p.ws + OFF_HB1), NT); break;
      case 1: phase_zgemm(p, l, smem); break;
      case 2: phase_tokA(p, l); phase_tokB(p, l, smem); break;
      case 3: phase_qkv(p, l, smem); break;
      case 4: phase_scan(p, smem); break;
      case 5: phase_attn(p, l, MOUT, smem); break;
      case 6: phase_norm(XLP, XCP, TABP(0), (u16*)(p.ws + OFF_HBG), MOUT); break;
      case 7: phase_merge(p, l, MOUT, smem); break;
      case 8: phase_resid(p, (const u16*)(p.ws + OFF_R1), 1024, (const u16*)(WLP + WO_WO), MODP(2), XLP, XCP, p.out, CTXBUF, MOUT, smem); break;
      case 9: phase_norm(p.out, CTXBUF, TABP(1), (u16*)(p.ws + OFF_HB2), MOUT); break;
      case 10: phase_mlp1(p, l, MOUT, smem); break;
      default: phase_resid(p, (const u16*)(p.ws + OFF_R1), 4096, (const u16*)(WLP + WO_W2), MODP(5), p.out, CTXBUF, p.out, CTXBUF, MOUT, smem); break;
    }
    if (ph != 23) grid_barrier(bar, epoch);
  }
}

extern "C" void kernel_launch(void* const* d_in, const int* in_sizes, int n_in, void* d_out, int out_size, void* d_ws, size_t ws_size, hipStream_t stream) {
  static int grid_blocks = 0;
  if (!grid_blocks) {
    int dev = 0, cus = 0, per_cu = 0;
    hipGetDevice(&dev);
    hipDeviceGetAttribute(&cus, hipDeviceAttributeMultiprocessorCount, dev);
    hipOccupancyMaxActiveBlocksPerMultiprocessor(&per_cu, fwd_megakernel, 256, 0);
    if (per_cu > 2) per_cu = 2;
    if (per_cu < 1) per_cu = 1;
    grid_blocks = cus * per_cu;
    if (ws_size < WS_END) fprintf(stderr, "kernel_launch: workspace too small: %zu < %zu\n", ws_size, (size_t)WS_END);
  }
  Params p{};
  for (int i = 0; i < 34; ++i) p.in[i] = (const float*)d_in[i];
  p.out = (float*)d_out;
  p.ws = (char*)d_ws;
  hipMemsetAsync(d_ws, 0, 4096, stream);
  void* args[] = {&p};
  hipError_t e = hipLaunchCooperativeKernel((void*)fwd_megakernel, dim3(grid_blocks), dim3(256), args, 0, stream);
  if (e != hipSuccess) fprintf(stderr, "cooperative launch failed: %s (grid %d)\n", hipGetErrorString(e), grid_blocks);
}
```

```cpp
#include <hip/hip_runtime.h>
#include <hip/hip_cooperative_groups.h>
#include <stdint.h>
#include <cstdio>
namespace cg = cooperative_groups;

typedef unsigned short u16;
typedef __attribute__((ext_vector_type(8))) short bf16x8;
typedef __attribute__((ext_vector_type(4))) float f32x4;
typedef __attribute__((ext_vector_type(16))) float f32x16;
typedef __bf16 bf16x2_t __attribute__((ext_vector_type(2)));
typedef float float2_t __attribute__((ext_vector_type(2)));

#define DI __device__ __forceinline__

constexpr int D = 1024, NB = 8, L = 4096, LC = 256, LK = 4352;
constexpr int NTL = NB * L;
constexpr int NTC = NB * LC;
constexpr int NT = NTL + NTC;
constexpr int INC = 5152;
constexpr int ZA = 928;
constexpr int ZR = 1152;
constexpr int DFF = 4096;

constexpr size_t al256(size_t x) { return (x + 255) / 256 * 256; }
constexpr size_t OFF_BAR = 0;
constexpr size_t OFF_MODS = 4096;
constexpr size_t OFF_TAB = OFF_MODS + al256(2 * 9 * 6144 * 4);
constexpr size_t OFF_ROPE = OFF_TAB + al256(2 * 2 * 9 * 2 * 1024 * 4);
constexpr size_t OFF_RS1 = OFF_ROPE + 4096;
constexpr size_t OFF_RS2 = OFF_RS1 + al256(NT * 4);
constexpr size_t OFF_RSQ = OFF_RS2 + al256(NT * 4);
constexpr size_t OFF_RSKV = OFF_RSQ + al256(NT * 4);
constexpr size_t OFF_CTX = OFF_RSKV + al256(NT * 4);
constexpr size_t OFF_W = OFF_CTX + (size_t)NTC * D * 4;
constexpr size_t WO_WIN = 0;
constexpr size_t WO_UQ = WO_WIN + (size_t)INC * 1024 * 2;
constexpr size_t WO_UKV = WO_UQ + (size_t)768 * 384 * 2;
constexpr size_t WO_BRP = WO_UKV + (size_t)1024 * 256 * 2;
constexpr size_t WO_BRM = WO_BRP + (size_t)1024 * 256 * 2;
constexpr size_t WO_BRR = WO_BRM + (size_t)1024 * 512 * 2;
constexpr size_t WO_WO = WO_BRR + (size_t)1024 * 256 * 2;
constexpr size_t WO_W1 = WO_WO + (size_t)1024 * 1024 * 2;
constexpr size_t WO_W2 = WO_W1 + (size_t)4096 * 1024 * 2;
constexpr size_t WO_RW2 = WO_W2 + (size_t)1024 * 4096 * 2;
constexpr size_t WO_RA2 = WO_RW2 + (size_t)2 * 256 * 64 * 2;
constexpr size_t WO_RG2 = WO_RA2 + (size_t)2 * 256 * 64 * 2;
constexpr size_t W_LAYER = al256(WO_RG2 + (size_t)256 * 128 * 2);
constexpr size_t OFF_R1 = OFF_W + 2 * W_LAYER;
constexpr size_t SZ_Q = (size_t)NB * 8 * LK * 96 * 2;
constexpr size_t SZ_VT = (size_t)NB * 8 * 64 * LK * 2;
constexpr size_t SZ_R1 = 2 * SZ_Q + SZ_VT;
constexpr size_t OFF_R2 = OFF_R1 + al256(SZ_R1);
constexpr size_t SZ_TOK256 = (size_t)NT * 256 * 2;
constexpr size_t OFF_R3 = OFF_R2 + al256((size_t)NT * ZA * 2);
constexpr size_t OFF_R4 = OFF_R3 + 10 * SZ_TOK256;
constexpr size_t OFF_KR = OFF_R4 + SZ_TOK256;
constexpr size_t WS_END = OFF_KR + (size_t)NT * 32 * 2;
constexpr size_t OFF_HB1 = OFF_R3;
constexpr size_t OFF_HBG = OFF_R1 + (size_t)NT * 1024 * 2;
constexpr size_t OFF_HB2 = OFF_R3 + 5 * SZ_TOK256;
enum { SA_R = 0, SA_V = 1, SA_KDF = 2, SA_KDB = 3, SA_G = 4, SA_KKN = 5, SA_OMWF = 6, SA_BF = 7, SA_OMWB = 8, SA_BB = 9 };

struct Params { const float* in[34]; float* out; char* ws; };

enum { I_X = 0, I_C, I_CTX, I_CCTX, I_N1G, I_N2G, I_WADA, I_BADA, I_WIN, I_POOLW, I_POOLS, I_QNORM, I_WUQ, I_KVNORM, I_WUKV,
       I_GQ, I_GK, I_MU, I_W0, I_W2R, I_A0, I_A2R, I_KA, I_KK, I_RK, I_G2R, I_LNW, I_LNB, I_BRP, I_BRM, I_BRR, I_WO, I_W1, I_W2 };

DI float bf2f(u16 h) { return __uint_as_float(((unsigned)h) << 16); }
DI float bflo(unsigned u) { return __uint_as_float(u << 16); }
DI float bfhi(unsigned u) { return __uint_as_float(u & 0xffff0000u); }
DI unsigned pack2(float a, float b) { float2_t v = {a, b}; bf16x2_t r = __builtin_convertvector(v, bf16x2_t); return __builtin_bit_cast(unsigned, r); }
DI u16 f2bf(float a) { return (u16)(pack2(a, 0.f) & 0xffffu); }
DI float sigmoidf_(float x) { return 1.f / (1.f + __expf(-x)); }
DI float siluf_(float x) { return x / (1.f + __expf(-x)); }
DI float rowsum16(float x) {
  x += __builtin_bit_cast(float, __builtin_amdgcn_update_dpp(0, __builtin_bit_cast(int, x), 0x128, 0xf, 0xf, false));
  x += __builtin_bit_cast(float, __builtin_amdgcn_update_dpp(0, __builtin_bit_cast(int, x), 0x124, 0xf, 0xf, false));
  x += __builtin_bit_cast(float, __builtin_amdgcn_update_dpp(0, __builtin_bit_cast(int, x), 0x122, 0xf, 0xf, false));
  x += __builtin_bit_cast(float, __builtin_amdgcn_update_dpp(0, __builtin_bit_cast(int, x), 0x121, 0xf, 0xf, false));
  return x;
}
DI float wavesum(float x) {
  for (int o = 32; o > 0; o >>= 1) x += __shfl_xor(x, o, 64);
  return x;
}
DI void grid_barrier(unsigned* ctr, unsigned& epoch) {
  asm volatile("s_waitcnt vmcnt(0)" ::: "memory");
  __syncthreads();
  epoch++;
  if (threadIdx.x == 0) {
    __builtin_amdgcn_fence(__ATOMIC_RELEASE, "agent");
    asm volatile("s_waitcnt vmcnt(0)" ::: "memory");
    const unsigned target = epoch * gridDim.x;
    __hip_atomic_fetch_add(ctr, 1u, __ATOMIC_RELAXED, __HIP_MEMORY_SCOPE_AGENT);
    while (__hip_atomic_load(ctr, __ATOMIC_RELAXED, __HIP_MEMORY_SCOPE_AGENT) < target) __builtin_amdgcn_s_sleep(2);
    __builtin_amdgcn_fence(__ATOMIC_ACQUIRE, "agent");
    asm volatile("s_waitcnt vmcnt(0)" ::: "memory");
  }
  __syncthreads();
}

DI int launder_v(int x) { asm volatile("" : "+v"(x)); return x; }
DI int launder_s(int x) { asm volatile("" : "+s"(x)); return x; }
#define LAUNDER_IDS const int tid__ = launder_v((int)threadIdx.x); const int blk__ = launder_s((int)blockIdx.x); (void)tid__; (void)blk__;
DI void do_transpose(const float* __restrict__ src, int K, int N, u16* __restrict__ dst, const float* __restrict__ ksc, int perm, int tile, float* tl) {
  LAUNDER_IDS
  const int ntn = (N + 63) >> 6;
  const int kt = tile / ntn, nt = tile - kt * ntn;
  const int k0 = kt * 64, n0 = nt * 64;
  const int tid = tid__;
  __syncthreads();
#pragma unroll 4
  for (int i = 0; i < 16; ++i) {
    const int kk = i * 4 + (tid >> 6), nn = tid & 63;
    float v = 0.f;
    if (n0 + nn < N) v = src[(size_t)(k0 + kk) * N + n0 + nn];
    if (ksc) v *= ksc[k0 + kk];
    tl[kk * 65 + nn] = v;
  }
  __syncthreads();
#pragma unroll 4
  for (int i = 0; i < 16; ++i) {
    const int nn = i * 4 + (tid >> 6), kk = tid & 63;
    int n = n0 + nn;
    if (n < N) {
      if (perm) { const int h = n / 96, d = n - h * 96; n = d < 64 ? h * 64 + d : 512 + h * 32 + (d - 64); }
      dst[(size_t)n * K + k0 + kk] = f2bf(tl[kk * 65 + nn]);
    }
  }
}

DI void phase_prep(const Params& p, char* smem) {
  LAUNDER_IDS
  float* tl = (float*)smem;
  const int tid = tid__;
  constexpr int T_WIN = 16 * 81, T_UQ = 6 * 12, T_UKV = 4 * 16, T_BRM = 8 * 16, T_BRR = 4 * 16, T_WO = 16 * 16, T_W1 = 16 * 64, T_W2 = 64 * 16,
                T_RW2 = 4, T_RA2 = 4, T_RG2 = 2 * 4;
  constexpr int T_LAYER = T_WIN + T_UQ + T_UKV + T_BRM + T_BRR + T_WO + T_W1 + T_W2 + 2 * T_RW2 + 2 * T_RA2 + T_RG2;
  for (int g = blk__; g < 2 * T_LAYER; g += gridDim.x) {
    const int l = g / T_LAYER; int t = g - l * T_LAYER;
    char* wl = p.ws + OFF_W + (size_t)l * W_LAYER;
#define JOB(SRC, KK, NN, DSTOFF, SC, PERM, CNT) if (t < (CNT)) { do_transpose((SRC), (KK), (NN), (u16*)(wl + (DSTOFF)), (SC), (PERM), t, tl); continue; } t -= (CNT);
    JOB(p.in[I_WIN] + (size_t)l * 1024 * INC, 1024, INC, WO_WIN, nullptr, 0, T_WIN)
    JOB(p.in[I_WUQ] + (size_t)l * 384 * 768, 384, 768, WO_UQ, p.in[I_QNORM] + l * 384, 1, T_UQ)
    JOB(p.in[I_WUKV] + (size_t)l * 256 * 1024, 256, 1024, WO_UKV, p.in[I_KVNORM] + l * 256, 0, T_UKV)
    JOB(p.in[I_BRM] + (size_t)l * 512 * 1024, 512, 1024, WO_BRM, nullptr, 0, T_BRM)
    JOB(p.in[I_BRR] + (size_t)l * 256 * 1024, 256, 1024, WO_BRR, nullptr, 0, T_BRR)
    JOB(p.in[I_WO] + (size_t)l * 1024 * 1024, 1024, 1024, WO_WO, nullptr, 0, T_WO)
    JOB(p.in[I_W1] + (size_t)l * 1024 * 4096, 1024, 4096, WO_W1, nullptr, 0, T_W1)
    JOB(p.in[I_W2] + (size_t)l * 4096 * 1024, 4096, 1024, WO_W2, nullptr, 0, T_W2)
    JOB(p.in[I_W2R] + (size_t)(l * 2 + 0) * 64 * 256, 64, 256, WO_RW2, nullptr, 0, T_RW2)
    JOB(p.in[I_W2R] + (size_t)(l * 2 + 1) * 64 * 256, 64, 256, WO_RW2 + 256 * 64 * 2, nullptr, 0, T_RW2)
    JOB(p.in[I_A2R] + (size_t)(l * 2 + 0) * 64 * 256, 64, 256, WO_RA2, nullptr, 0, T_RA2)
    JOB(p.in[I_A2R] + (size_t)(l * 2 + 1) * 64 * 256, 64, 256, WO_RA2 + 256 * 64 * 2, nullptr, 0, T_RA2)
    JOB(p.in[I_G2R] + (size_t)l * 128 * 256, 128, 256, WO_RG2, nullptr, 0, T_RG2)
#undef JOB
  }
  for (int e = blk__ * 256 + tid; e < 2 * 256 * 1024; e += gridDim.x * 256) {
    const int l = e >> 18, r = e & 262143, cin = r >> 10, n = r & 1023, g = cin >> 6, c = cin & 63;
    const float* pw = p.in[I_POOLW] + ((size_t)(l * 4 + g) * 64 + c) * 64;
    const float* ps = p.in[I_POOLS] + l * 256 + g * 64;
    const float* wb = p.in[I_BRP] + ((size_t)l * 256 + g * 64) * 1024 + n;
    float s = 0.f;
    for (int d = 0; d < 64; ++d) s += pw[d] * ps[d] * wb[(size_t)d * 1024];
    ((u16*)(p.ws + OFF_W + (size_t)l * W_LAYER + WO_BRP))[(size_t)n * 256 + cin] = f2bf(s);
  }
  if (blk__ == gridDim.x - 1) {
    for (int e = tid; e < 512; e += 256) {
      const int pos = e >> 3, f = e & 7;
      const float inv = powf(10000.f, -(float)f / 8.f);
      const float ang = (float)pos * inv;
      float* rt = (float*)(p.ws + OFF_ROPE);
      rt[e * 2] = cosf(ang); rt[e * 2 + 1] = sinf(ang);
    }
  }
  {
    float* sl = (float*)smem;
    float* red = sl + 9 * 1024;
    __syncthreads();
    for (int e = tid; e < 9 * 1024; e += 256) {
      const int b = e >> 10, k = e & 1023;
      const float v = b < 8 ? p.in[I_C][b * 1024 + k] : p.in[I_CCTX][k];
      sl[e] = siluf_(v);
    }
    __syncthreads();
    const int wave = tid >> 6, lane = tid & 63;
    for (int it = blk__; it < 192; it += gridDim.x) {
      const int l = it / 96, cg_ = it - l * 96;
      const int col = cg_ * 64 + lane;
      const float* wa = p.in[I_WADA] + (size_t)l * 1024 * 6144 + col;
      float acc[9];
#pragma unroll
      for (int b = 0; b < 9; ++b) acc[b] = 0.f;
#pragma unroll 8
      for (int k = wave * 256; k < wave * 256 + 256; ++k) {
        const float w = wa[(size_t)k * 6144];
#pragma unroll
        for (int b = 0; b < 9; ++b) acc[b] += sl[b * 1024 + k] * w;
      }
#pragma unroll
      for (int b = 0; b < 9; ++b) red[(wave * 9 + b) * 64 + lane] = acc[b];
      __syncthreads();
      for (int e = tid; e < 9 * 64; e += 256) {
        const int b = e >> 6, c = e & 63;
        const float s = red[(0 * 9 + b) * 64 + c] + red[(1 * 9 + b) * 64 + c] + red[(2 * 9 + b) * 64 + c] + red[(3 * 9 + b) * 64 + c];
        ((float*)(p.ws + OFF_MODS))[(size_t)(l * 9 + b) * 6144 + cg_ * 64 + c] = s + p.in[I_BADA][l * 6144 + cg_ * 64 + c];
      }
      __syncthreads();
    }
  }
}

DI const float* xrow(const float* xl, const float* xc, int r) { return r < NTL ? xl + (size_t)r * D : xc + (size_t)(r - NTL) * D; }

DI void phase_norm(const float* xl, const float* xc, const float* tab  , u16* hb, int M) {
  LAUNDER_IDS
  const int wave = tid__ >> 6, lane = tid__ & 63;
  for (int r = blk__ * 4 + wave; r < M; r += gridDim.x * 4) {
    const float* xp = xrow(xl, xc, r);
    const int b9 = r < NTL ? r >> 12 : 8;
    float4 v[4];
    float s = 0.f;
#pragma unroll
    for (int i = 0; i < 4; ++i) { v[i] = *(const float4*)(xp + i * 256 + lane * 4); s += v[i].x * v[i].x + v[i].y * v[i].y + v[i].z * v[i].z + v[i].w * v[i].w; }
    s = wavesum(s);
    const float rs = rsqrtf(s * (1.f / 1024.f) + 1e-6f);
    const float* t = tab + b9 * 2048;
#pragma unroll
    for (int i = 0; i < 4; ++i) {
      const int k = i * 256 + lane * 4;
      const float4 g = *(const float4*)(t + k), sh = *(const float4*)(t + 1024 + k);
      *(uint2*)(hb + (size_t)r * 1024 + k) = make_uint2(pack2(v[i].x * rs * g.x + sh.x, v[i].y * rs * g.y + sh.y), pack2(v[i].z * rs * g.z + sh.z, v[i].w * rs * g.w + sh.w));
    }
  }
}
DI void phase_tables(const Params& p) {
  LAUNDER_IDS
  const float* mods = (const float*)(p.ws + OFF_MODS);
  float* tab = (float*)(p.ws + OFF_TAB);
  for (int e = blk__ * 256 + tid__; e < 2 * 2 * 9 * 1024; e += gridDim.x * 256) {
    const int k = e & 1023, b9 = (e >> 10) % 9, ln = (e >> 10) / 9, l = ln >> 1, nrm = ln & 1;
    const float g = p.in[nrm ? I_N2G : I_N1G][l * 1024 + k];
    const float sh = mods[(size_t)(l * 9 + b9) * 6144 + (nrm * 3 + 0) * 1024 + k];
    const float sc = mods[(size_t)(l * 9 + b9) * 6144 + (nrm * 3 + 1) * 1024 + k];
    float* t = tab + ((size_t)(l * 2 + nrm) * 9 + b9) * 2048;
    t[k] = g * (1.f + sc); t[1024 + k] = sh;
  }
}

struct LoadBf16 {
  const u16* A; int lda;
  DI void init(int m0) {}
  DI uint4 load(int i, int m0, int k0) const {
    LAUNDER_IDS
    const int tid = tid__, kc = (tid & 7) * 8;
    return *(const uint4*)(A + (size_t)(m0 + (tid >> 3) + i * 32) * lda + k0 + kc);
  }
};
struct LoadNorm {
  const float* xl; const float* xc; const float* rs; const float* tab;
  float r0, r1, r2, r3;
  DI void init(int m0) {
    LAUNDER_IDS
    const int tid = tid__;
    r0 = rs[m0 + (tid >> 3)]; r1 = rs[m0 + (tid >> 3) + 32]; r2 = rs[m0 + (tid >> 3) + 64]; r3 = rs[m0 + (tid >> 3) + 96];
  }
  DI uint4 load(int i, int m0, int k0) const {
    LAUNDER_IDS
    const int tid = tid__, kc = (tid & 7) * 8;
    const int b9 = m0 < NTL ? m0 >> 12 : 8;
    const float* t = tab + b9 * 2048 + k0 + kc;
    const float4 g0 = *(const float4*)t, g1 = *(const float4*)(t + 4), s0 = *(const float4*)(t + 1024), s1 = *(const float4*)(t + 1028);
    const float* xp = xrow(xl, xc, m0 + (tid >> 3)) + k0 + kc + (size_t)i * 32 * D;
    const float4 x0 = *(const float4*)xp, x1 = *(const float4*)(xp + 4);
    const float rr = i == 0 ? r0 : i == 1 ? r1 : i == 2 ? r2 : r3;
    uint4 o;
    o.x = pack2(x0.x * rr * g0.x + s0.x, x0.y * rr * g0.y + s0.y);
    o.y = pack2(x0.z * rr * g0.z + s0.z, x0.w * rr * g0.w + s0.w);
    o.z = pack2(x1.x * rr * g1.x + s1.x, x1.y * rr * g1.y + s1.y);
    o.w = pack2(x1.z * rr * g1.z + s1.z, x1.w * rr * g1.w + s1.w);
    return o;
  }
};

DI bool tile_map(int it, int NTM, int NTN, int blk, int nblk, int& tm, int& tn) {
  const int xcd = blk & 7, local = blk >> 3, LB = nblk >> 3;
  const int R = NTM >> 3;
  const int s = it * LB + local;
  if (s >= R * NTN) return false;
  const int F = R >> 3, per_full = 8 * NTN;
  int mg, r, gm;
  if (s < F * per_full) { mg = s / per_full; r = s - mg * per_full; gm = 8; }
  else { mg = F; r = s - F * per_full; gm = R - F * 8; }
  const int ng = r / (gm * 8);
  const int r2 = r - ng * gm * 8;
  const int mi = r2 % gm, ni = r2 / gm;
  tm = xcd * R + mg * 8 + mi; tn = ng * 8 + ni;
  return true;
}
constexpr int LDT = 72;
template <int NI, class LA>
DI void gemm_mainloop(f32x4 (&acc)[4][NI], LA la, const u16* __restrict__ Bt, int ldb, int K, int m0, int n0, char* smem) {
  LAUNDER_IDS
  constexpr int NBI = NI;
  u16* As = (u16*)smem; u16* Bs = As + 2 * 128 * LDT;
  const int tid = tid__, lane = tid & 63, wave = tid >> 6, wr = wave >> 1, wc = wave & 1, lr = lane & 15, lq = lane >> 4;
  uint4 ra[4], rb[NBI];
  la.init(m0);
#pragma unroll
  for (int i = 0; i < 4; ++i) ra[i] = la.load(i, m0, 0);
#pragma unroll
  for (int i = 0; i < NBI; ++i) {
    const int c = tid + i * 256, row = c >> 3, kc = (c & 7) * 8;
    rb[i] = *(const uint4*)(Bt + (size_t)(n0 + row) * ldb + kc);
  }
#pragma unroll
  for (int i = 0; i < 4; ++i) {
    const int c = tid + i * 256, row = c >> 3, kc = (c & 7) * 8;
    *(uint4*)(As + row * LDT + kc) = ra[i];
    if (i < NBI) *(uint4*)(Bs + row * LDT + kc) = rb[i];
  }
  __syncthreads();
  const int nk = K >> 6;
  for (int kt = 0; kt < nk; ++kt) {
    const int cur = kt & 1;
    if (kt + 1 < nk) {
      const int k0 = (kt + 1) * 64;
#pragma unroll
      for (int i = 0; i < 4; ++i) ra[i] = la.load(i, m0, k0);
#pragma unroll
      for (int i = 0; i < NBI; ++i) {
        const int c = tid + i * 256, row = c >> 3, kc = (c & 7) * 8;
        rb[i] = *(const uint4*)(Bt + (size_t)(n0 + row) * ldb + k0 + kc);
      }
    }
    const u16* Ac = As + cur * 128 * LDT + (wr * 64 + lr) * LDT + lq * 8;
    const u16* Bc = Bs + cur * 128 * LDT + (wc * 16 * NI + lr) * LDT + lq * 8;
#pragma unroll
    for (int ks = 0; ks < 2; ++ks) {
      bf16x8 af[4], bfr[NI];
#pragma unroll
      for (int mi = 0; mi < 4; ++mi) af[mi] = *(const bf16x8*)(Ac + mi * 16 * LDT + ks * 32);
#pragma unroll
      for (int ni = 0; ni < NI; ++ni) bfr[ni] = *(const bf16x8*)(Bc + ni * 16 * LDT + ks * 32);
#pragma unroll
      for (int mi = 0; mi < 4; ++mi)
#pragma unroll
        for (int ni = 0; ni < NI; ++ni)
          acc[mi][ni] = __builtin_amdgcn_mfma_f32_16x16x32_bf16(bfr[ni], af[mi], acc[mi][ni], 0, 0, 0);
    }
    if (kt + 1 < nk) {
      const int nxt = cur ^ 1;
#pragma unroll
      for (int i = 0; i < 4; ++i) {
        const int c = tid + i * 256, row = c >> 3, kc = (c & 7) * 8;
        *(uint4*)(As + nxt * 128 * LDT + row * LDT + kc) = ra[i];
        if (i < NBI) *(uint4*)(Bs + nxt * 128 * LDT + row * LDT + kc) = rb[i];
      }
    }
    __syncthreads();
  }
}
template <int NI>
DI void zero_acc(f32x4 (&acc)[4][NI]) {
#pragma unroll
  for (int i = 0; i < 4; ++i)
#pragma unroll
    for (int j = 0; j < NI; ++j) acc[i][j] = f32x4{0.f, 0.f, 0.f, 0.f};
}
template <int NI>
DI void gemm256(f32x4 (&acc)[8][NI], const u16* __restrict__ A, int lda, const u16* __restrict__ Bt, int ldb, int K, int m0, int n0, char* smem) {
  LAUNDER_IDS
  const int lane = tid__ & 63, wave = tid__ >> 6, wr = wave >> 1, wc = wave & 1, lr = lane & 15, lq = lane >> 4;
  constexpr int NBW = NI / 2;
  constexpr int STAGE = 16384 + NI * 2 * 1024;
  constexpr int LPS = 4 + NBW;
  const int srow = lane >> 2, scol = ((lane & 3) ^ ((lane >> 5) << 1)) * 8;
  const u16* Ag = A + (size_t)(m0 + wave * 64 + srow) * lda + scol;
  const u16* Bg = Bt + (size_t)(n0 + wave * NBW * 16 + srow) * ldb + scol;
  char* la = smem + (wave * 4) * 1024 + lane * 16;
  char* lb = smem + 16384 + (wave * NBW) * 1024 + lane * 16;
#define G256_ISSUE(S, K0) do { \
    _Pragma("unroll") for (int j_ = 0; j_ < 4; ++j_) \
      __builtin_amdgcn_global_load_lds((const unsigned*)(Ag + (size_t)j_ * 16 * lda + (K0)), (__attribute__((address_space(3))) unsigned*)(la + (S) * STAGE + j_ * 1024), 16, 0, 0); \
    _Pragma("unroll") for (int j_ = 0; j_ < NBW; ++j_) \
      __builtin_amdgcn_global_load_lds((const unsigned*)(Bg + (size_t)j_ * 16 * ldb + (K0)), (__attribute__((address_space(3))) unsigned*)(lb + (S) * STAGE + j_ * 1024), 16, 0, 0); \
  } while (0)
  const int nk = K >> 5;
  G256_ISSUE(0, 0);
  if (nk > 1) G256_ISSUE(1, 32);
  const int foff = lr * 64 + ((lq ^ ((lr >> 3) << 1)) * 16);
  int st = 0;
  for (int kt = 0; kt < nk; ++kt) {
    if (kt + 1 < nk) asm volatile("s_waitcnt vmcnt(%0)" :: "n"(LPS) : "memory");
    else asm volatile("s_waitcnt vmcnt(0)" ::: "memory");
    __builtin_amdgcn_s_barrier();
    if (kt + 2 < nk) { const int s2 = st >= 1 ? st - 1 : 2; G256_ISSUE(s2, (kt + 2) * 32); }
    const char* sb = smem + st * STAGE + foff;
    bf16x8 af[8], bfr[NI];
#pragma unroll
    for (int mi = 0; mi < 8; ++mi) af[mi] = *(const bf16x8*)(sb + (wr * 8 + mi) * 1024);
#pragma unroll
    for (int ni = 0; ni < NI; ++ni) bfr[ni] = *(const bf16x8*)(sb + 16384 + (wc * NI + ni) * 1024);
#pragma unroll
    for (int mi = 0; mi < 8; ++mi)
#pragma unroll
      for (int ni = 0; ni < NI; ++ni)
        acc[mi][ni] = __builtin_amdgcn_mfma_f32_16x16x32_bf16(bfr[ni], af[mi], acc[mi][ni], 0, 0, 0);
    st = st == 2 ? 0 : st + 1;
  }
  __builtin_amdgcn_s_barrier();
#undef G256_ISSUE
}
template <int NI>
DI void zero_acc8(f32x4 (&acc)[8][NI]) {
#pragma unroll
  for (int i = 0; i < 8; ++i)
#pragma unroll
    for (int j = 0; j < NI; ++j) acc[i][j] = f32x4{0.f, 0.f, 0.f, 0.f};
}
#define WAVE_COORDS const int lane = tid__ & 63, wave = tid__ >> 6, wr = wave >> 1, wc = wave & 1, lr = lane & 15, lq = lane >> 4; (void)wr; (void)wc; (void)lr; (void)lq;

DI void phase_zgemm(const Params& p, int l, char* smem) {
  LAUNDER_IDS
  WAVE_COORDS
  const u16* Wt = (const u16*)(p.ws + OFF_W + (size_t)l * W_LAYER + WO_WIN);
  const u16* hb = (const u16*)(p.ws + OFF_HB1);
  u16* za = (u16*)(p.ws + OFF_R2); u16* zr = (u16*)(p.ws + OFF_R1);
  for (int it = 0;; ++it) {
    int tm, tn;
    if (!tile_map(it, NT / 256, 17, blk__, gridDim.x, tm, tn)) break;
    const int m0 = tm * 256, n0 = tn * 128;
    f32x4 acc[8][4]; zero_acc8<4>(acc);
    gemm256<4>(acc, hb, 1024, Wt, 1024, 1024, m0, n0, smem);
#pragma unroll
    for (int mi = 0; mi < 8; ++mi) {
      const int m = m0 + wr * 128 + mi * 16 + lr;
#pragma unroll
      for (int ni = 0; ni < 4; ++ni) {
        const int n = n0 + wc * 64 + ni * 16 + lq * 4;
        uint2 v; v.x = pack2(acc[mi][ni][0], acc[mi][ni][1]); v.y = pack2(acc[mi][ni][2], acc[mi][ni][3]);
        if (n < ZA) *(uint2*)(za + (size_t)m * ZA + n) = v;
        else if (n < ZA + ZR) *(uint2*)(zr + (size_t)m * ZR + (n - ZA)) = v;
      }
    }
  }
}

DI void phase_tokA(const Params& p, int l) {
  LAUNDER_IDS
  const int wave = tid__ >> 6, lane = tid__ & 63;
  const u16* za = (const u16*)(p.ws + OFF_R2);
  float* rsq = (float*)(p.ws + OFF_RSQ); float* rskv = (float*)(p.ws + OFF_RSKV);
  u16* krb = (u16*)(p.ws + OFF_KR);
  u16* pooled = (u16*)(p.ws + OFF_R4);
  const float* rt = (const float*)(p.ws + OFF_ROPE);
  const float* gk = p.in[I_GK] + l * 96;
  for (int r = blk__ * 4 + wave; r < NT; r += gridDim.x * 4) {
    const u16* z = za + (size_t)r * ZA;
    const bool lat = r < NTL;
    const int b = lat ? r >> 12 : (r - NTL) >> 8;
    const int t = lat ? r & 4095 : (r - NTL) & 255;
    const int Ls = lat ? L : LC;
    const int pos = lat ? t : 4096 + t;
    float sq = 0.f, skv = 0.f;
#pragma unroll
    for (int i = 0; i < 6; ++i) { const float v = bf2f(z[256 + i * 64 + lane]); sq += v * v; }
#pragma unroll
    for (int i = 0; i < 4; ++i) { const float v = bf2f(z[640 + i * 64 + lane]); skv += v * v; }
    sq = wavesum(sq); skv = wavesum(skv);
    if (lane == 0) { rsq[r] = rsqrtf(sq * (1.f / 384.f) + 1e-6f); rskv[r] = rsqrtf(skv * (1.f / 256.f) + 1e-6f); }
    {
      const int d = lane & 31;
      float kr = bf2f(z[896 + d]);
      float ss = kr * kr;
      for (int o = 16; o > 0; o >>= 1) ss += __shfl_xor(ss, o, 64);
      kr = kr * rsqrtf(ss * (1.f / 32.f) + 1e-6f) * gk[64 + d];
      const float other = __shfl_xor(kr, 16, 64);
      float outv = kr;
      if (lat) {
        const int i = d & 15;
        const int pp = i < 8 ? (t >> 6) : (t & 63);
        const float cs = rt[(pp * 8 + (i & 7)) * 2], sn = rt[(pp * 8 + (i & 7)) * 2 + 1];
        outv = d < 16 ? kr * cs - other * sn : other * sn + kr * cs;
      }
      if (lane < 32) krb[(size_t)r * 32 + d] = f2bf(outv);
    }
#pragma unroll
    for (int gi = 0; gi < 4; ++gi) {
      const int half = 1 << gi;
      const int lo = max(t - half, 0), hi = min(t + half, Ls);
      const int ch = gi * 64 + lane;
      float s = 0.f;
      for (int q = lo; q < hi; ++q) s += bf2f(z[(ptrdiff_t)(q - t) * ZA + ch]);
      const float mean = s / (float)(hi - lo);
      pooled[(size_t)r * 256 + ch] = f2bf(mean - bf2f(z[ch]));
    }
  }
}

constexpr int ZSL = 1160, TAL = 392;
DI void phase_tokB(const Params& p, int l, char* smem) {
  LAUNDER_IDS
  WAVE_COORDS
  const int tid = tid__;
  u16* Zs = (u16*)smem;
  u16* TA = Zs + 18 * ZSL;
  const u16* zr = (const u16*)(p.ws + OFF_R1);
  const char* wl = p.ws + OFF_W + (size_t)l * W_LAYER;
  const float* mu0 = p.in[I_MU] + (size_t)(l * 2 + 0) * ZR;
  const float* mu1 = p.in[I_MU] + (size_t)(l * 2 + 1) * ZR;
  u16* sc = (u16*)(p.ws + OFF_R3);
  for (int tile = blk__; tile < NT / 16; tile += gridDim.x) {
    const int r0 = tile * 16;
    const bool lat = r0 < NTL;
    const int t0 = lat ? r0 & 4095 : (r0 - NTL) & 255;
    const int Ls = lat ? L : LC;
    __syncthreads();
    for (int c = tid; c < 18 * 144; c += 256) {
      const int i = c / 144, ch = c - i * 144;
      const int tt = t0 - 1 + i;
      uint4 v = make_uint4(0, 0, 0, 0);
      if (tt >= 0 && tt < Ls) v = *(const uint4*)(zr + (size_t)(r0 - 1 + i) * ZR + ch * 8);
      *(uint2*)(Zs + i * ZSL + ch * 8) = make_uint2(v.x, v.y);
      *(uint2*)(Zs + i * ZSL + ch * 8 + 4) = make_uint2(v.z, v.w);
    }
    __syncthreads();
    for (int e = tid; e < 16 * 384; e += 256) {
      const int i = e / 384, c = e - i * 384, zc = 768 + c;
      const float z = bf2f(Zs[(i + 1) * ZSL + zc]), zp = bf2f(Zs[i * ZSL + zc]), zn = bf2f(Zs[(i + 2) * ZSL + zc]);
      float v = z + mu0[zc] * (zp - z) + mu1[zc] * (zn - z);
      if (c < 128) v = 1.f - 2.f / (1.f + __expf(2.f * v)); else if (c >= 256) v = sigmoidf_(v);
      TA[i * TAL + c] = f2bf(v);
    }
    __syncthreads();
    const int row = r0 + lr;
    auto shifted4 = [&](int zc, float (&out)[4]) {
      const uint2 c0 = *(const uint2*)(Zs + (lr + 1) * ZSL + zc), cp = *(const uint2*)(Zs + lr * ZSL + zc), cn = *(const uint2*)(Zs + (lr + 2) * ZSL + zc);
      const float4 m0 = *(const float4*)(mu0 + zc), m1 = *(const float4*)(mu1 + zc);
      float z, zp, zn;
      z = bflo(c0.x); zp = bflo(cp.x); zn = bflo(cn.x); out[0] = z + m0.x * (zp - z) + m1.x * (zn - z);
      z = bfhi(c0.x); zp = bfhi(cp.x); zn = bfhi(cn.x); out[1] = z + m0.y * (zp - z) + m1.y * (zn - z);
      z = bflo(c0.y); zp = bflo(cp.y); zn = bflo(cn.y); out[2] = z + m0.z * (zp - z) + m1.z * (zn - z);
      z = bfhi(c0.y); zp = bfhi(cp.y); zn = bfhi(cn.y); out[3] = z + m0.w * (zp - z) + m1.w * (zn - z);
    };
    auto product = [&](f32x4 (&ac)[4], const u16* W, int Kq, int off) {
#pragma unroll
      for (int ni = 0; ni < 4; ++ni) ac[ni] = f32x4{0.f, 0.f, 0.f, 0.f};
#pragma unroll 1
      for (int ks = 0; ks < Kq / 32; ++ks) {
        const bf16x8 bop = *(const bf16x8*)(TA + lr * TAL + off + ks * 32 + lq * 8);
#pragma unroll
        for (int ni = 0; ni < 4; ++ni) {
          const bf16x8 aop = *(const bf16x8*)(W + (size_t)(wave * 64 + ni * 16 + lr) * Kq + ks * 32 + lq * 8);
          ac[ni] = __builtin_amdgcn_mfma_f32_16x16x32_bf16(aop, bop, ac[ni], 0, 0, 0);
        }
        __builtin_amdgcn_sched_barrier(0);
      }
    };
    float ss = 0.f;
#pragma unroll
    for (int ni = 0; ni < 4; ++ni) {
      const int ch = wave * 64 + ni * 16 + lq * 4;
      float kx[4]; shifted4(256 + ch, kx);
      const float4 kw = *(const float4*)(p.in[I_KK] + l * 256 + ch);
      const float a0 = kx[0] * kw.x, a1 = kx[1] * kw.y, a2 = kx[2] * kw.z, a3 = kx[3] * kw.w;
      ss += a0 * a0 + a1 * a1 + a2 * a2 + a3 * a3;
      __builtin_amdgcn_sched_barrier(0);
    }
    ss += __shfl_xor(ss, 16, 64); ss += __shfl_xor(ss, 32, 64);
    const float kinv = rsqrtf(fmaxf(ss, 1e-24f));
    {
      f32x4 ag[4];
      product(ag, (const u16*)(wl + WO_RG2), 128, 256);
#pragma unroll
      for (int ni = 0; ni < 4; ++ni) {
        const int ch = wave * 64 + ni * 16 + lq * 4;
        const size_t o = (size_t)row * 256 + ch;
        float rx[4], kx[4], vx[4];
        shifted4(ch, rx); shifted4(256 + ch, kx); shifted4(512 + ch, vx);
        const float4 kw = *(const float4*)(p.in[I_KK] + l * 256 + ch);
        *(uint2*)(sc + SA_R * (size_t)NT * 256 + o) = make_uint2(pack2(rx[0], rx[1]), pack2(rx[2], rx[3]));
        *(uint2*)(sc + SA_V * (size_t)NT * 256 + o) = make_uint2(pack2(vx[0], vx[1]), pack2(vx[2], vx[3]));
        *(uint2*)(sc + SA_KKN * (size_t)NT * 256 + o) = make_uint2(pack2(-kx[0] * kw.x * kinv, -kx[1] * kw.y * kinv), pack2(-kx[2] * kw.z * kinv, -kx[3] * kw.w * kinv));
        *(uint2*)(sc + SA_G * (size_t)NT * 256 + o) = make_uint2(pack2(ag[ni][0], ag[ni][1]), pack2(ag[ni][2], ag[ni][3]));
        __builtin_amdgcn_sched_barrier(0);
      }
    }
#pragma unroll 1
    for (int d = 0; d < 2; ++d) {
      f32x4 aw[4], aa[4];
      product(aw, (const u16*)(wl + WO_RW2) + (size_t)d * 256 * 64, 64, d * 64);
      product(aa, (const u16*)(wl + WO_RA2) + (size_t)d * 256 * 64, 64, 128 + d * 64);
      __builtin_amdgcn_sched_barrier(0);
      u16* oOMW = sc + (d ? SA_OMWB : SA_OMWF) * (size_t)NT * 256;
      u16* oKD = sc + (d ? SA_KDB : SA_KDF) * (size_t)NT * 256;
      u16* oB = sc + (d ? SA_BB : SA_BF) * (size_t)NT * 256;
#pragma unroll
      for (int ni = 0; ni < 4; ++ni) {
        const int ch = wave * 64 + ni * 16 + lq * 4;
        const size_t o = (size_t)row * 256 + ch;
        float kx[4]; shifted4(256 + ch, kx);
        const float4 kw = *(const float4*)(p.in[I_KK] + l * 256 + ch);
        const float kkn[4] = {kx[0] * kw.x * kinv, kx[1] * kw.y * kinv, kx[2] * kw.z * kinv, kx[3] * kw.w * kinv};
        const float4 w0 = *(const float4*)(p.in[I_W0] + (size_t)(l * 2 + d) * 256 + ch);
        const float4 a0 = *(const float4*)(p.in[I_A0] + (size_t)(l * 2 + d) * 256 + ch);
        const float4 ka = *(const float4*)(p.in[I_KA] + (size_t)(l * 2 + d) * 256 + ch);
        const float w0a[4] = {w0.x, w0.y, w0.z, w0.w}, a0a[4] = {a0.x, a0.y, a0.z, a0.w}, kaa[4] = {ka.x, ka.y, ka.z, ka.w};
        float omw[4], kd[4], bb[4];
#pragma unroll
        for (int j = 0; j < 4; ++j) {
          const float xw = -(w0a[j] + aw[ni][j]);
          const float sp = fmaxf(xw, 0.f) + __logf(1.f + __expf(-fabsf(xw)));
          const float wlog = -sp - 0.5f;
          const float e = __expf(wlog);
          omw[j] = 1.f - __expf(-e);
          const float a = sigmoidf_(a0a[j] + aa[ni][j]);
          kd[j] = kx[j] * (1.f + (a - 1.f) * kaa[j]);
          bb[j] = kkn[j] * a;
        }
        *(uint2*)(oOMW + o) = make_uint2(pack2(omw[0], omw[1]), pack2(omw[2], omw[3]));
        *(uint2*)(oKD + o) = make_uint2(pack2(kd[0], kd[1]), pack2(kd[2], kd[3]));
        *(uint2*)(oB + o) = make_uint2(pack2(bb[0], bb[1]), pack2(bb[2], bb[3]));
        __builtin_amdgcn_sched_barrier(0);
      }
    }
  }
}

DI size_t qk_index(int m, int h) {
  const bool lat = m < NTL;
  const int b = lat ? m >> 12 : (m - NTL) >> 8;
  const int pos = lat ? m & 4095 : 4096 + ((m - NTL) & 255);
  return ((size_t)(b * 8 + h) * LK + pos) * 96;
}
DI void phase_qkv(const Params& p, int l, char* smem) {
  LAUNDER_IDS
  WAVE_COORDS
  const char* wl = p.ws + OFF_W + (size_t)l * W_LAYER;
  const u16* za = (const u16*)(p.ws + OFF_R2);
  const float* rsq = (const float*)(p.ws + OFF_RSQ); const float* rskv = (const float*)(p.ws + OFF_RSKV);
  u16* Qb = (u16*)(p.ws + OFF_R1); u16* Kb = (u16*)(p.ws + OFF_R1 + SZ_Q); u16* Vt = (u16*)(p.ws + OFF_R1 + 2 * SZ_Q);
  const float* rt = (const float*)(p.ws + OFF_ROPE);
  const float* gq = p.in[I_GQ] + l * 96; const float* gk = p.in[I_GK] + l * 96;
  const float QS = 0.10206207261596577f * 1.4426950408889634f;
  constexpr int NTM = NT / 256;
  for (int it = 0;; ++it) {
    int tm, tn;
    if (!tile_map(it, NTM, 14, blk__, gridDim.x, tm, tn)) break;
    f32x4 acc[8][4]; zero_acc8<4>(acc);
    if (tn < 6) {
      const int m0 = tm * 256, n0 = tn * 128;
      gemm256<4>(acc, za + 256, ZA, (const u16*)(wl + WO_UQ), 384, 384, m0, n0, smem);
      const int nw = n0 + wc * 64;
#pragma unroll
      for (int mi = 0; mi < 8; ++mi) {
        __builtin_amdgcn_sched_barrier(0);
        const int m = m0 + wr * 128 + mi * 16 + lr;
        const float rs = rsq[m];
        if (nw < 512) {
          const int h = nw >> 6;
          float ss = 0.f;
#pragma unroll
          for (int ni = 0; ni < 4; ++ni)
#pragma unroll
            for (int j = 0; j < 4; ++j) { const float v = acc[mi][ni][j] * rs; ss += v * v; }
          ss += __shfl_xor(ss, 16, 64); ss += __shfl_xor(ss, 32, 64);
          const float f = rs * rsqrtf(ss * (1.f / 64.f) + 1e-6f) * QS;
          u16* dst = Qb + qk_index(m, h);
#pragma unroll
          for (int ni = 0; ni < 4; ++ni) {
            const int d = ni * 16 + lq * 4;
            const float4 g = *(const float4*)(gq + d);
            *(uint2*)(dst + d) = make_uint2(pack2(acc[mi][ni][0] * f * g.x, acc[mi][ni][1] * f * g.y), pack2(acc[mi][ni][2] * f * g.z, acc[mi][ni][3] * f * g.w));
          }
        } else {
          const bool lat = m < NTL;
          const int tt = m & 4095;
#pragma unroll
          for (int hh = 0; hh < 2; ++hh) {
            const int h = ((nw - 512) >> 5) + hh;
            float ss = 0.f;
#pragma unroll
            for (int ni = 0; ni < 2; ++ni)
#pragma unroll
              for (int j = 0; j < 4; ++j) { const float v = acc[mi][hh * 2 + ni][j] * rs; ss += v * v; }
            ss += __shfl_xor(ss, 16, 64); ss += __shfl_xor(ss, 32, 64);
            const float f = rs * rsqrtf(ss * (1.f / 32.f) + 1e-6f) * QS;
            const int i0 = lq * 4;
            const float4 g1 = *(const float4*)(gq + 64 + i0), g2 = *(const float4*)(gq + 80 + i0);
            const float g1a[4] = {g1.x, g1.y, g1.z, g1.w}, g2a[4] = {g2.x, g2.y, g2.z, g2.w};
            float o1[4], o2[4];
#pragma unroll
            for (int j = 0; j < 4; ++j) {
              const float x1 = acc[mi][hh * 2][j] * f * g1a[j], x2 = acc[mi][hh * 2 + 1][j] * f * g2a[j];
              float cs = 1.f, sn = 0.f;
              if (lat) {
                const int i = i0 + j;
                const int pp = i < 8 ? (tt >> 6) : (tt & 63);
                cs = rt[(pp * 8 + (i & 7)) * 2]; sn = rt[(pp * 8 + (i & 7)) * 2 + 1];
              }
              o1[j] = x1 * cs - x2 * sn; o2[j] = x1 * sn + x2 * cs;
            }
            u16* dst = Qb + qk_index(m, h) + 64;
            *(uint2*)(dst + i0) = make_uint2(pack2(o1[0], o1[1]), pack2(o1[2], o1[3]));
            *(uint2*)(dst + 16 + i0) = make_uint2(pack2(o2[0], o2[1]), pack2(o2[2], o2[3]));
          }
        }
      }
    } else {
      const int h = tn - 6, m0 = tm * 256, n0 = h * 128;
      gemm256<4>(acc, za + 640, ZA, (const u16*)(wl + WO_UKV), 256, 256, m0, n0, smem);
#pragma unroll
      for (int mi = 0; mi < 8; ++mi) {
        __builtin_amdgcn_sched_barrier(0);
        const int m = m0 + wr * 128 + mi * 16 + lr;
        const float rs = rskv[m];
        if (wc == 0) {
          float ss = 0.f;
#pragma unroll
          for (int ni = 0; ni < 4; ++ni)
#pragma unroll
            for (int j = 0; j < 4; ++j) { const float v = acc[mi][ni][j] * rs; ss += v * v; }
          ss += __shfl_xor(ss, 16, 64); ss += __shfl_xor(ss, 32, 64);
          const float f = rs * rsqrtf(ss * (1.f / 64.f) + 1e-6f);
          u16* dst = Kb + qk_index(m, h);
#pragma unroll
          for (int ni = 0; ni < 4; ++ni) {
            const int d = ni * 16 + lq * 4;
            const float4 g = *(const float4*)(gk + d);
            *(uint2*)(dst + d) = make_uint2(pack2(acc[mi][ni][0] * f * g.x, acc[mi][ni][1] * f * g.y), pack2(acc[mi][ni][2] * f * g.z, acc[mi][ni][3] * f * g.w));
          }
          *(uint4*)(dst + 64 + lq * 8) = *(const uint4*)((const u16*)(p.ws + OFF_KR) + (size_t)m * 32 + lq * 8);
        } else {
          const bool lat = m < NTL;
          const int b = lat ? m >> 12 : (m - NTL) >> 8;
          const int pos = lat ? m & 4095 : 4096 + ((m - NTL) & 255);
          u16* dst = Vt + (size_t)(b * 8 + h) * 64 * LK + pos;
#pragma unroll
          for (int ni = 0; ni < 4; ++ni)
#pragma unroll
            for (int j = 0; j < 4; ++j) dst[(size_t)(ni * 16 + lq * 4 + j) * LK] = f2bf(acc[mi][ni][j] * rs);
        }
      }
    }
  }
}

DI int scan_row(int b, int dir, int s) {
  if (s < LC) return NTL + b * LC + (dir ? LC - 1 - s : s);
  const int t = s - LC;
  return b * L + (dir ? L - 1 - t : t);
}
DI void phase_scan(const Params& p, char* smem) {
  LAUNDER_IDS
  const int blk = blk__;
  if (blk >= 256) return;
  const int tid = tid__, lane = tid & 63, wave = tid >> 6, kq = lane & 15, rg = lane >> 4;
  const int chain = (blk & 7) + 8 * (blk >> 5), quarter = (blk >> 3) & 3;
  const int b = chain >> 3, h = (chain >> 1) & 3, dir = chain & 1;
  const u16* sc = (const u16*)(p.ws + OFF_R3);
  const size_t AS = (size_t)NT * 256;
  const u16* aOMW = sc + (dir ? SA_OMWB : SA_OMWF) * AS;
  const u16* aKD = sc + (dir ? SA_KDB : SA_KDF) * AS;
  const u16* aB = sc + (dir ? SA_BB : SA_BF) * AS;
  const u16* aKKN = sc + SA_KKN * AS;
  const u16* aR = sc + SA_R * AS;
  const u16* aV = sc + SA_V * AS;
  u16* Y = (u16*)(p.ws + OFF_R2) + (dir ? AS : 0);
  u16* buf = (u16*)smem;
  constexpr int BSZ = 5 * 2048 + 512;
  const int st_ld = tid >> 3, k8 = (tid & 7) * 8;
  const int vrow = quarter * 16 + wave * 4 + rg;
  uint4 r0, r1, r2, r3, r4, rv;
  rv = make_uint4(0, 0, 0, 0);
  auto gload = [&](int chunk) {
    const int row = scan_row(b, dir, chunk * 32 + st_ld);
    const size_t o = (size_t)row * 256 + h * 64 + k8;
    r0 = *(const uint4*)(aOMW + o); r1 = *(const uint4*)(aKD + o); r2 = *(const uint4*)(aB + o); r3 = *(const uint4*)(aKKN + o); r4 = *(const uint4*)(aR + o);
    if (tid < 64) {
      const int rowv = scan_row(b, dir, chunk * 32 + (tid >> 1));
      rv = *(const uint4*)(aV + (size_t)rowv * 256 + h * 64 + quarter * 16 + (tid & 1) * 8);
    }
  };
  auto lstore = [&](int bi) {
    u16* bb = buf + bi * BSZ;
    *(uint4*)(bb + 0 * 2048 + st_ld * 64 + k8) = r0;
    *(uint4*)(bb + 1 * 2048 + st_ld * 64 + k8) = r1;
    *(uint4*)(bb + 2 * 2048 + st_ld * 64 + k8) = r2;
    *(uint4*)(bb + 3 * 2048 + st_ld * 64 + k8) = r3;
    *(uint4*)(bb + 4 * 2048 + st_ld * 64 + k8) = r4;
    if (tid < 64) *(uint4*)(bb + 5 * 2048 + (tid >> 1) * 16 + (tid & 1) * 8) = rv;
  };
  float S0 = 0.f, S1 = 0.f, S2 = 0.f, S3 = 0.f;
  __syncthreads();
  gload(0); lstore(0);
  __syncthreads();
  constexpr int NCH = LK / 32;
  for (int c = 0; c < NCH; ++c) {
    if (c + 1 < NCH) gload(c + 1);
    const u16* bb = buf + (c & 1) * BSZ;
#pragma unroll 4
    for (int s = 0; s < 32; ++s) {
      const uint2 uw = *(const uint2*)(bb + 0 * 2048 + s * 64 + kq * 4);
      const uint2 uk = *(const uint2*)(bb + 1 * 2048 + s * 64 + kq * 4);
      const uint2 ub = *(const uint2*)(bb + 2 * 2048 + s * 64 + kq * 4);
      const uint2 ua = *(const uint2*)(bb + 3 * 2048 + s * 64 + kq * 4);
      const uint2 ur = *(const uint2*)(bb + 4 * 2048 + s * 64 + kq * 4);
      const float vv = bf2f(bb[5 * 2048 + s * 16 + wave * 4 + rg]);
      float sa = S0 * bflo(ua.x) + S1 * bfhi(ua.x) + S2 * bflo(ua.y) + S3 * bfhi(ua.y);
      sa = rowsum16(sa);
      S0 = S0 * (1.f - bflo(uw.x)) + (sa * bflo(ub.x) + vv * bflo(uk.x));
      S1 = S1 * (1.f - bfhi(uw.x)) + (sa * bfhi(ub.x) + vv * bfhi(uk.x));
      S2 = S2 * (1.f - bflo(uw.y)) + (sa * bflo(ub.y) + vv * bflo(uk.y));
      S3 = S3 * (1.f - bfhi(uw.y)) + (sa * bfhi(ub.y) + vv * bfhi(uk.y));
      float y = S0 * bflo(ur.x) + S1 * bfhi(ur.x) + S2 * bflo(ur.y) + S3 * bfhi(ur.y);
      y = rowsum16(y);
      if (kq == 0) {
        const int row = scan_row(b, dir, c * 32 + s);
        Y[(size_t)row * 256 + h * 64 + vrow] = f2bf(y);
      }
    }
    if (c + 1 < NCH) lstore((c + 1) & 1);
    __syncthreads();
  }
}

constexpr int KSL = 104, VSL = 68;
template <int B0>
DI bf16x8 pack8(const f32x16& v) {
  uint4 pw;
  pw.x = pack2(v[B0 + 0], v[B0 + 1]); pw.y = pack2(v[B0 + 2], v[B0 + 3]); pw.z = pack2(v[B0 + 4], v[B0 + 5]); pw.w = pack2(v[B0 + 6], v[B0 + 7]);
  return __builtin_bit_cast(bf16x8, pw);
}
DI void pv_step(f32x16& o0, f32x16& o1, const u16* Vc, int r32, int kb, bf16x8 pf) {
  {
    const uint2 lo = *(const uint2*)(Vc + r32 * VSL + kb), hi2 = *(const uint2*)(Vc + r32 * VSL + kb + 8);
    const bf16x8 va = __builtin_bit_cast(bf16x8, make_uint4(lo.x, lo.y, hi2.x, hi2.y));
    o0 = __builtin_amdgcn_mfma_f32_32x32x16_bf16(va, pf, o0, 0, 0, 0);
  }
  {
    const uint2 lo = *(const uint2*)(Vc + (32 + r32) * VSL + kb), hi2 = *(const uint2*)(Vc + (32 + r32) * VSL + kb + 8);
    const bf16x8 va = __builtin_bit_cast(bf16x8, make_uint4(lo.x, lo.y, hi2.x, hi2.y));
    o1 = __builtin_amdgcn_mfma_f32_32x32x16_bf16(va, pf, o1, 0, 0, 0);
  }
}
DI void attn_item(const Params& p, int item, char* smem) {
  LAUNDER_IDS
  const int tid = tid__, lane = tid & 63, wave = tid >> 6, r32 = lane & 31, hi = lane >> 5;
  int bh, qpos0, key0, nkt, orow0;
  if (item < 2048) { bh = item >> 5; const int qb = item & 31; qpos0 = qb * 128; key0 = 0; nkt = LK / 64; orow0 = (bh >> 3) * L + qpos0; }
  else { const int it = item - 2048; bh = it >> 1; const int qb = it & 1; qpos0 = 4096 + qb * 128; key0 = 4096; nkt = LC / 64; orow0 = NTL + (bh >> 3) * LC + qb * 128; }
  const int h = bh & 7;
  const u16* Qp = (const u16*)(p.ws + OFF_R1) + ((size_t)bh * LK + qpos0 + wave * 32 + r32) * 96 + hi * 8;
  const u16* Kp = (const u16*)(p.ws + OFF_R1 + SZ_Q) + ((size_t)bh * LK + key0) * 96;
  const u16* Vp = (const u16*)(p.ws + OFF_R1 + 2 * SZ_Q) + (size_t)bh * 64 * LK + key0;
  u16* Ks = (u16*)smem;
  u16* Vs = Ks + 2 * 64 * KSL;
  bf16x8 qr[6];
#pragma unroll
  for (int d0 = 0; d0 < 6; ++d0) qr[d0] = *(const bf16x8*)(Qp + d0 * 16);
  uint4 sk0, sk1, sk2, sv0, sv1;
  const int kr0 = tid / 12, kc0 = tid - kr0 * 12, kr1 = (tid + 256) / 12, kc1 = (tid + 256) - kr1 * 12, kr2 = (tid + 512) / 12, kc2 = (tid + 512) - kr2 * 12;
  const int vd0 = tid >> 3, vc0 = tid & 7, vd1 = vd0 + 32;
#define gload(kt) do { \
    sk0 = *(const uint4*)(Kp + (size_t)((kt) * 64 + kr0) * 96 + kc0 * 8); sk1 = *(const uint4*)(Kp + (size_t)((kt) * 64 + kr1) * 96 + kc1 * 8); \
    sk2 = *(const uint4*)(Kp + (size_t)((kt) * 64 + kr2) * 96 + kc2 * 8); \
    sv0 = *(const uint4*)(Vp + (size_t)vd0 * LK + (kt) * 64 + vc0 * 8); sv1 = *(const uint4*)(Vp + (size_t)vd1 * LK + (kt) * 64 + vc0 * 8); } while (0)
#define lstore(bi) do { \
    *(uint4*)(Ks + (bi) * 64 * KSL + kr0 * KSL + kc0 * 8) = sk0; *(uint4*)(Ks + (bi) * 64 * KSL + kr1 * KSL + kc1 * 8) = sk1; *(uint4*)(Ks + (bi) * 64 * KSL + kr2 * KSL + kc2 * 8) = sk2; \
    { u16* dst = Vs + (bi) * 64 * VSL + vd0 * VSL + vc0 * 8; *(uint2*)dst = make_uint2(sv0.x, sv0.y); *(uint2*)(dst + 4) = make_uint2(sv0.z, sv0.w); } \
    { u16* dst = Vs + (bi) * 64 * VSL + vd1 * VSL + vc0 * 8; *(uint2*)dst = make_uint2(sv1.x, sv1.y); *(uint2*)(dst + 4) = make_uint2(sv1.z, sv1.w); } } while (0)
  f32x16 o0, o1;
#pragma unroll
  for (int i = 0; i < 16; ++i) { o0[i] = 0.f; o1[i] = 0.f; }
  float mrun = -1e30f, lrun = 0.f;
  __syncthreads();
  gload(0); lstore(0);
  __syncthreads();
  for (int kt = 0; kt < nkt; ++kt) {
    const int cur = kt & 1;
    if (kt + 1 < nkt) gload(kt + 1);
    const u16* Kc = Ks + cur * 64 * KSL;
    const u16* Vc = Vs + cur * 64 * VSL;
    f32x16 p0, p1;
#pragma unroll
    for (int i = 0; i < 16; ++i) { p0[i] = 0.f; p1[i] = 0.f; }
#pragma unroll
    for (int d0 = 0; d0 < 6; ++d0) {
      const bf16x8 a0 = *(const bf16x8*)(Kc + r32 * KSL + d0 * 16 + hi * 8);
      const bf16x8 a1 = *(const bf16x8*)(Kc + (32 + r32) * KSL + d0 * 16 + hi * 8);
      p0 = __builtin_amdgcn_mfma_f32_32x32x16_bf16(a0, qr[d0], p0, 0, 0, 0);
      p1 = __builtin_amdgcn_mfma_f32_32x32x16_bf16(a1, qr[d0], p1, 0, 0, 0);
    }
    float mx = p0[0];
#pragma unroll
    for (int i = 1; i < 16; ++i) mx = fmaxf(mx, p0[i]);
#pragma unroll
    for (int i = 0; i < 16; ++i) mx = fmaxf(mx, p1[i]);
    mx = fmaxf(mx, __shfl_xor(mx, 32, 64));
    if (!__all(mx - mrun <= 8.f)) {
      const float mn = fmaxf(mrun, mx);
      const float alpha = __builtin_amdgcn_exp2f(mrun - mn);
      mrun = mn; lrun *= alpha;
#pragma unroll
      for (int i = 0; i < 16; ++i) { o0[i] *= alpha; o1[i] *= alpha; }
    }
    float ps = 0.f;
#pragma unroll
    for (int i = 0; i < 16; ++i) { p0[i] = __builtin_amdgcn_exp2f(p0[i] - mrun); ps += p0[i]; }
#pragma unroll
    for (int i = 0; i < 16; ++i) { p1[i] = __builtin_amdgcn_exp2f(p1[i] - mrun); ps += p1[i]; }
    lrun += ps;
    pv_step(o0, o1, Vc, r32, 0 + hi * 4, pack8<0>(p0));
    pv_step(o0, o1, Vc, r32, 16 + hi * 4, pack8<8>(p0));
    pv_step(o0, o1, Vc, r32, 32 + hi * 4, pack8<0>(p1));
    pv_step(o0, o1, Vc, r32, 48 + hi * 4, pack8<8>(p1));
    if (kt + 1 < nkt) lstore(cur ^ 1);
    __syncthreads();
  }
  lrun += __shfl_xor(lrun, 32, 64);
  const float inv = 1.f / lrun;
  u16* om = (u16*)(p.ws + OFF_R3 + SA_KKN * SZ_TOK256) + (size_t)(orow0 + wave * 32 + r32) * 512 + h * 64;
#pragma unroll
  for (int g = 0; g < 4; ++g) {
    const int d = 8 * g + 4 * hi;
    *(uint2*)(om + d) = make_uint2(pack2(o0[4 * g] * inv, o0[4 * g + 1] * inv), pack2(o0[4 * g + 2] * inv, o0[4 * g + 3] * inv));
    *(uint2*)(om + 32 + d) = make_uint2(pack2(o1[4 * g] * inv, o1[4 * g + 1] * inv), pack2(o1[4 * g + 2] * inv, o1[4 * g + 3] * inv));
  }
#undef gload
#undef lstore
}

DI void readout_row(const Params& p, int l, int r) {
  LAUNDER_IDS
  const int lane = tid__ & 63;
  const u16* sc = (const u16*)(p.ws + OFF_R3);
  const size_t AS = (size_t)NT * 256;
  const size_t o = (size_t)r * 256 + lane * 4;
  const u16* Yf = (const u16*)(p.ws + OFF_R2);
  const uint2 yf = *(const uint2*)(Yf + o), yb = *(const uint2*)(Yf + AS + o);
  const uint2 ur = *(const uint2*)(sc + SA_R * AS + o), uv = *(const uint2*)(sc + SA_V * AS + o);
  const uint2 kf = *(const uint2*)(sc + SA_KDF * AS + o), kb = *(const uint2*)(sc + SA_KDB * AS + o), ug = *(const uint2*)(sc + SA_G * AS + o);
  float y[4] = {bflo(yf.x) + bflo(yb.x), bfhi(yf.x) + bfhi(yb.x), bflo(yf.y) + bflo(yb.y), bfhi(yf.y) + bfhi(yb.y)};
  const float rr[4] = {bflo(ur.x), bfhi(ur.x), bflo(ur.y), bfhi(ur.y)};
  const float vv[4] = {bflo(uv.x), bfhi(uv.x), bflo(uv.y), bfhi(uv.y)};
  const float km[4] = {0.5f * (bflo(kf.x) + bflo(kb.x)), 0.5f * (bfhi(kf.x) + bfhi(kb.x)), 0.5f * (bflo(kf.y) + bflo(kb.y)), 0.5f * (bfhi(kf.y) + bfhi(kb.y))};
  const float gg[4] = {bflo(ug.x), bfhi(ug.x), bflo(ug.y), bfhi(ug.y)};
  const float4 rk4 = *(const float4*)(p.in[I_RK] + l * 256 + lane * 4);
  const float4 lw4 = *(const float4*)(p.in[I_LNW] + l * 256 + lane * 4);
  const float4 lb4 = *(const float4*)(p.in[I_LNB] + l * 256 + lane * 4);
  const float rk[4] = {rk4.x, rk4.y, rk4.z, rk4.w}, lw[4] = {lw4.x, lw4.y, lw4.z, lw4.w}, lb[4] = {lb4.x, lb4.y, lb4.z, lb4.w};
  float s = y[0] + y[1] + y[2] + y[3];
  s = rowsum16(s);
  const float mu = s * (1.f / 64.f);
  float q = 0.f, bn = 0.f;
#pragma unroll
  for (int j = 0; j < 4; ++j) { const float d = y[j] - mu; q += d * d; bn += rr[j] * km[j] * rk[j]; }
  q = rowsum16(q); bn = rowsum16(bn);
  const float rstd = rsqrtf(q * (1.f / 64.f) + 64e-5f);
  float ov[4];
#pragma unroll
  for (int j = 0; j < 4; ++j) ov[j] = ((y[j] - mu) * rstd * lw[j] + lb[j] + bn * vv[j]) * gg[j];
  u16* orw = (u16*)(p.ws + OFF_R3 + SA_KKN * SZ_TOK256 + (size_t)NT * 512 * 2);
  *(uint2*)(orw + o) = make_uint2(pack2(ov[0], ov[1]), pack2(ov[2], ov[3]));
}

DI void phase_attn(const Params& p, int l, int Mout, char* smem) {
  LAUNDER_IDS
  const int nattn = (l == 0) ? 2048 + 128 : 2048;
  for (int it = blk__; it < nattn; it += gridDim.x) attn_item(p, it, smem);
  const int wave = tid__ >> 6;
  for (int r = blk__ * 4 + wave; r < Mout; r += gridDim.x * 4) readout_row(p, l, r);
}

DI void phase_merge(const Params& p, int l, int Mout, char* smem) {
  LAUNDER_IDS
  WAVE_COORDS
  const char* wl = p.ws + OFF_W + (size_t)l * W_LAYER;
  const u16* hg = (const u16*)(p.ws + OFF_HBG);
  const u16* opool = (const u16*)(p.ws + OFF_R4);
  const u16* omla = (const u16*)(p.ws + OFF_R3 + SA_KKN * SZ_TOK256);
  const u16* orw = omla + (size_t)NT * 512;
  u16* mo = (u16*)(p.ws + OFF_R1);
  const int ntm = Mout / 256;
  for (int it = 0;; ++it) {
    int tm, tn;
    if (!tile_map(it, ntm, 16, blk__, gridDim.x, tm, tn)) break;
    const int m0 = tm * 256, n0 = tn * 64;
    f32x4 msum[8][2]; zero_acc8<2>(msum);
#pragma unroll 1
    for (int br = 0; br < 3; ++br) {
      unsigned gpk[8][2][2];
      {
        f32x4 ag[8][2]; zero_acc8<2>(ag);
        gemm256<2>(ag, hg, 1024, (const u16*)(wl + WO_WIN) + (size_t)(2080 + br * 1024) * 1024, 1024, 1024, m0, n0, smem);
#pragma unroll
        for (int mi = 0; mi < 8; ++mi)
#pragma unroll
          for (int ni = 0; ni < 2; ++ni) {
            gpk[mi][ni][0] = pack2(sigmoidf_(ag[mi][ni][0]), sigmoidf_(ag[mi][ni][1]));
            gpk[mi][ni][1] = pack2(sigmoidf_(ag[mi][ni][2]), sigmoidf_(ag[mi][ni][3]));
          }
      }
      __builtin_amdgcn_sched_barrier(0);
      f32x4 ab[8][2]; zero_acc8<2>(ab);
      {
        const int Kb = br == 1 ? 512 : 256;
        const u16* Ab = br == 0 ? opool : br == 1 ? omla : orw;
        const u16* Wb = (const u16*)(wl + (br == 0 ? WO_BRP : br == 1 ? WO_BRM : WO_BRR));
        gemm256<2>(ab, Ab, Kb, Wb, Kb, Kb, m0, n0, smem);
      }
#pragma unroll
      for (int mi = 0; mi < 8; ++mi)
#pragma unroll
        for (int ni = 0; ni < 2; ++ni) {
          msum[mi][ni][0] += bflo(gpk[mi][ni][0]) * ab[mi][ni][0];
          msum[mi][ni][1] += bfhi(gpk[mi][ni][0]) * ab[mi][ni][1];
          msum[mi][ni][2] += bflo(gpk[mi][ni][1]) * ab[mi][ni][2];
          msum[mi][ni][3] += bfhi(gpk[mi][ni][1]) * ab[mi][ni][3];
        }
      __builtin_amdgcn_sched_barrier(0);
    }
#pragma unroll
    for (int mi = 0; mi < 8; ++mi) {
      const int m = m0 + wr * 128 + mi * 16 + lr;
#pragma unroll
      for (int ni = 0; ni < 2; ++ni) {
        const int n = n0 + wc * 32 + ni * 16 + lq * 4;
        *(uint2*)(mo + (size_t)m * 1024 + n) = make_uint2(pack2(msum[mi][ni][0], msum[mi][ni][1]), pack2(msum[mi][ni][2], msum[mi][ni][3]));
      }
    }
  }
}

DI void phase_resid(const Params& p, const u16* A, int K, const u16* Bt, const float* gate  ,
                    const float* xl_in, const float* xc_in, float* xl_out, float* xc_out, int Mout, char* smem) {
  LAUNDER_IDS
  WAVE_COORDS
  const int ntm = Mout / 256;
  for (int it = 0;; ++it) {
    int tm, tn;
    if (!tile_map(it, ntm, 8, blk__, gridDim.x, tm, tn)) break;
    const int m0 = tm * 256, n0 = tn * 128;
    f32x4 acc[8][4]; zero_acc8<4>(acc);
    gemm256<4>(acc, A, K, Bt, K, K, m0, n0, smem);
#pragma unroll
    for (int mi = 0; mi < 8; ++mi) {
      const int m = m0 + wr * 128 + mi * 16 + lr;
      const int b9 = m < NTL ? m >> 12 : 8;
      const float* xi = xrow(xl_in, xc_in, m);
      float* xo = m < NTL ? xl_out + (size_t)m * D : xc_out + (size_t)(m - NTL) * D;
#pragma unroll
      for (int ni = 0; ni < 4; ++ni) {
        const int n = n0 + wc * 64 + ni * 16 + lq * 4;
        const float4 g = *(const float4*)(gate + (size_t)b9 * 6144 + n);
        const float4 xv = *(const float4*)(xi + n);
        float4 ov;
        ov.x = xv.x + g.x * acc[mi][ni][0]; ov.y = xv.y + g.y * acc[mi][ni][1]; ov.z = xv.z + g.z * acc[mi][ni][2]; ov.w = xv.w + g.w * acc[mi][ni][3];
        *(float4*)(xo + n) = ov;
      }
      __builtin_amdgcn_sched_barrier(0);
    }
  }
}
DI void phase_mlp1(const Params& p, int l, int Mout, char* smem) {
  LAUNDER_IDS
  WAVE_COORDS
  const char* wl = p.ws + OFF_W + (size_t)l * W_LAYER;
  const u16* hb = (const u16*)(p.ws + OFF_HB2);
  u16* U = (u16*)(p.ws + OFF_R1);
  const int ntm = Mout / 256;
  for (int it = 0;; ++it) {
    int tm, tn;
    if (!tile_map(it, ntm, 32, blk__, gridDim.x, tm, tn)) break;
    const int m0 = tm * 256, n0 = tn * 128;
    f32x4 acc[8][4]; zero_acc8<4>(acc);
    gemm256<4>(acc, hb, 1024, (const u16*)(wl + WO_W1), 1024, 1024, m0, n0, smem);
#pragma unroll
    for (int mi = 0; mi < 8; ++mi) {
      const int m = m0 + wr * 128 + mi * 16 + lr;
#pragma unroll
      for (int ni = 0; ni < 4; ++ni) {
        const int n = n0 + wc * 64 + ni * 16 + lq * 4;
        float v[4];
#pragma unroll
        for (int j = 0; j < 4; ++j) { const float a = fmaxf(acc[mi][ni][j], 0.f); v[j] = a * a; }
        *(uint2*)(U + (size_t)m * DFF + n) = make_uint2(pack2(v[0], v[1]), pack2(v[2], v[3]));
      }
      __builtin_amdgcn_sched_barrier(0);
    }
  }
}

__global__ void __launch_bounds__(256, 2) fwd_megakernel(Params pk) {
  __shared__ __attribute__((aligned(16))) char smem[73728];
  cg::grid_group grid = cg::this_grid();
  unsigned* bar = (unsigned*)(pk.ws + OFF_BAR);
  unsigned epoch = 0;
  phase_prep(pk, smem);
  grid.sync();
  phase_tables(pk);
  grid_barrier(bar, epoch);
#define CTXBUF ((float*)(p.ws + OFF_CTX))
#define XLP (l == 0 ? p.in[I_X] : (const float*)p.out)
#define XCP (l == 0 ? p.in[I_CTX] : (const float*)CTXBUF)
#define MOUT (l == 0 ? NT : NTL)
#define WLP (p.ws + OFF_W + (size_t)l * W_LAYER)
#define TABP(nrm) ((const float*)(p.ws + OFF_TAB) + (size_t)(l * 2 + (nrm)) * 9 * 2048)
#define MODP(j) ((const float*)(p.ws + OFF_MODS) + (size_t)l * 9 * 6144 + (j) * 1024)
#ifndef PROBE_Q
#define PROBE_Q -1
#endif
#pragma nounroll
  for (int ph = 0; ph < 24; ++ph) {
    const int l = ph >= 12 ? 1 : 0, q = ph - l * 12;
    Params p = pk;
    {
      unsigned long long w_ = (unsigned long long)pk.ws, o_ = (unsigned long long)pk.out;
      unsigned wl_ = (unsigned)w_, wh_ = (unsigned)(w_ >> 32), ol_ = (unsigned)o_, oh_ = (unsigned)(o_ >> 32);
      wl_ = __builtin_amdgcn_readfirstlane(wl_); wh_ = __builtin_amdgcn_readfirstlane(wh_); ol_ = __builtin_amdgcn_readfirstlane(ol_); oh_ = __builtin_amdgcn_readfirstlane(oh_);
      asm volatile("" : "+s"(wl_), "+s"(wh_), "+s"(ol_), "+s"(oh_));
      p.ws = (char*)(((unsigned long long)wh_ << 32) | wl_); p.out = (float*)(((unsigned long long)oh_ << 32) | ol_);
    }
#pragma nounroll
    for (int rep = 0; rep < (q == PROBE_Q ? 2 : 1); ++rep)
    switch (q) {
      case 0: phase_norm(XLP, XCP, TABP(0), (u16*)(p.ws + OFF_HB1), NT); break;
      case 1: phase_zgemm(p, l, smem); break;
      case 2: phase_tokA(p, l); phase_tokB(p, l, smem); break;
      case 3: phase_qkv(p, l, smem); break;
      case 4: phase_scan(p, smem); break;
      case 5: phase_attn(p, l, MOUT, smem); break;
      case 6: phase_norm(XLP, XCP, TABP(0), (u16*)(p.ws + OFF_HBG), MOUT); break;
      case 7: phase_merge(p, l, MOUT, smem); break;
      case 8: phase_resid(p, (const u16*)(p.ws + OFF_R1), 1024, (const u16*)(WLP + WO_WO), MODP(2), XLP, XCP, p.out, CTXBUF, MOUT, smem); break;
      case 9: phase_norm(p.out, CTXBUF, TABP(1), (u16*)(p.ws + OFF_HB2), MOUT); break;
      case 10: phase_mlp1(p, l, MOUT, smem); break;
      default: phase_resid(p, (const u16*)(p.ws + OFF_R1), 4096, (const u16*)(WLP + WO_W2), MODP(5), p.out, CTXBUF, p.out, CTXBUF, MOUT, smem); break;
    }
    if (ph != 23) grid_barrier(bar, epoch);
  }
}

extern "C" void kernel_launch(void* const* d_in, const int* in_sizes, int n_in, void* d_out, int out_size, void* d_ws, size_t ws_size, hipStream_t stream) {
  static int grid_blocks = 0;
  if (!grid_blocks) {
    int dev = 0, cus = 0, per_cu = 0;
    hipGetDevice(&dev);
    hipDeviceGetAttribute(&cus, hipDeviceAttributeMultiprocessorCount, dev);
    hipOccupancyMaxActiveBlocksPerMultiprocessor(&per_cu, fwd_megakernel, 256, 0);
    if (per_cu > 2) per_cu = 2;
    if (per_cu < 1) per_cu = 1;
    grid_blocks = cus * per_cu;
    if (ws_size < WS_END) fprintf(stderr, "kernel_launch: workspace too small: %zu < %zu\n", ws_size, (size_t)WS_END);
  }
  Params p{};
  for (int i = 0; i < 34; ++i) p.in[i] = (const float*)d_in[i];
  p.out = (float*)d_out;
  p.ws = (char*)d_ws;
  hipMemsetAsync(d_ws, 0, 4096, stream);
  void* args[] = {&p};
  hipError_t e = hipLaunchCooperativeKernel((void*)fwd_megakernel, dim3(grid_blocks), dim3(256), args, 0, stream);
  if (e != hipSuccess) fprintf(stderr, "cooperative launch failed: %s (grid %d)\n", hipGetErrorString(e), grid_blocks);
}
```

```cpp
#include <hip/hip_runtime.h>
#include <hip/hip_cooperative_groups.h>
#include <stdint.h>
#include <cstdio>
namespace cg = cooperative_groups;

typedef unsigned short u16;
typedef __attribute__((ext_vector_type(8))) short bf16x8;
typedef __attribute__((ext_vector_type(4))) float f32x4;
typedef __attribute__((ext_vector_type(16))) float f32x16;
typedef __bf16 bf16x2_t __attribute__((ext_vector_type(2)));
typedef float float2_t __attribute__((ext_vector_type(2)));

#define DI __device__ __forceinline__

constexpr int D = 1024, NB = 8, L = 4096, LC = 256, LK = 4352;
constexpr int NTL = NB * L;
constexpr int NTC = NB * LC;
constexpr int NT = NTL + NTC;
constexpr int INC = 5152;
constexpr int ZA = 928;
constexpr int ZR = 1152;
constexpr int DFF = 4096;

constexpr size_t al256(size_t x) { return (x + 255) / 256 * 256; }
constexpr size_t OFF_BAR = 0;
constexpr size_t OFF_MODS = 4096;
constexpr size_t OFF_TAB = OFF_MODS + al256(2 * 9 * 6144 * 4);
constexpr size_t OFF_ROPE = OFF_TAB + al256(2 * 2 * 9 * 2 * 1024 * 4);
constexpr size_t OFF_RS1 = OFF_ROPE + 4096;
constexpr size_t OFF_RS2 = OFF_RS1 + al256(NT * 4);
constexpr size_t OFF_RSQ = OFF_RS2 + al256(NT * 4);
constexpr size_t OFF_RSKV = OFF_RSQ + al256(NT * 4);
constexpr size_t OFF_CTX = OFF_RSKV + al256(NT * 4);
constexpr size_t OFF_W = OFF_CTX + (size_t)NTC * D * 4;
constexpr size_t WO_WIN = 0;
constexpr size_t WO_UQ = WO_WIN + (size_t)INC * 1024 * 2;
constexpr size_t WO_UKV = WO_UQ + (size_t)768 * 384 * 2;
constexpr size_t WO_BRP = WO_UKV + (size_t)1024 * 256 * 2;
constexpr size_t WO_BRM = WO_BRP + (size_t)1024 * 256 * 2;
constexpr size_t WO_BRR = WO_BRM + (size_t)1024 * 512 * 2;
constexpr size_t WO_WO = WO_BRR + (size_t)1024 * 256 * 2;
constexpr size_t WO_W1 = WO_WO + (size_t)1024 * 1024 * 2;
constexpr size_t WO_W2 = WO_W1 + (size_t)4096 * 1024 * 2;
constexpr size_t WO_RW2 = WO_W2 + (size_t)1024 * 4096 * 2;
constexpr size_t WO_RA2 = WO_RW2 + (size_t)2 * 256 * 64 * 2;
constexpr size_t WO_RG2 = WO_RA2 + (size_t)2 * 256 * 64 * 2;
constexpr size_t W_LAYER = al256(WO_RG2 + (size_t)256 * 128 * 2);
constexpr size_t OFF_R1 = OFF_W + 2 * W_LAYER;
constexpr size_t SZ_Q = (size_t)NB * 8 * LK * 96 * 2;
constexpr size_t SZ_VT = (size_t)NB * 8 * 64 * LK * 2;
constexpr size_t SZ_R1 = 2 * SZ_Q + SZ_VT;
constexpr size_t OFF_R2 = OFF_R1 + al256(SZ_R1);
constexpr size_t SZ_TOK256 = (size_t)NT * 256 * 2;
constexpr size_t OFF_R3 = OFF_R2 + al256((size_t)NT * ZA * 2);
constexpr size_t OFF_R4 = OFF_R3 + 10 * SZ_TOK256;
constexpr size_t OFF_KR = OFF_R4 + SZ_TOK256;
constexpr size_t WS_END = OFF_KR + (size_t)NT * 32 * 2;
constexpr size_t OFF_HB1 = OFF_R3;
constexpr size_t OFF_HBG = OFF_R1 + (size_t)NT * 1024 * 2;
constexpr size_t OFF_HB2 = OFF_R3 + 5 * SZ_TOK256;
enum { SA_R = 0, SA_V = 1, SA_KDF = 2, SA_KDB = 3, SA_G = 4, SA_KKN = 5, SA_OMWF = 6, SA_BF = 7, SA_OMWB = 8, SA_BB = 9 };

struct Params { const float* in[34]; float* out; char* ws; };

enum { I_X = 0, I_C, I_CTX, I_CCTX, I_N1G, I_N2G, I_WADA, I_BADA, I_WIN, I_POOLW, I_POOLS, I_QNORM, I_WUQ, I_KVNORM, I_WUKV,
       I_GQ, I_GK, I_MU, I_W0, I_W2R, I_A0, I_A2R, I_KA, I_KK, I_RK, I_G2R, I_LNW, I_LNB, I_BRP, I_BRM, I_BRR, I_WO, I_W1, I_W2 };

DI float bf2f(u16 h) { return __uint_as_float(((unsigned)h) << 16); }
DI float bflo(unsigned u) { return __uint_as_float(u << 16); }
DI float bfhi(unsigned u) { return __uint_as_float(u & 0xffff0000u); }
DI unsigned pack2(float a, float b) { float2_t v = {a, b}; bf16x2_t r = __builtin_convertvector(v, bf16x2_t); return __builtin_bit_cast(unsigned, r); }
DI u16 f2bf(float a) { return (u16)(pack2(a, 0.f) & 0xffffu); }
DI float sigmoidf_(float x) { return 1.f / (1.f + __expf(-x)); }
DI float siluf_(float x) { return x / (1.f + __expf(-x)); }
DI float rowsum16(float x) {
  x += __builtin_bit_cast(float, __builtin_amdgcn_update_dpp(0, __builtin_bit_cast(int, x), 0x128, 0xf, 0xf, false));
  x += __builtin_bit_cast(float, __builtin_amdgcn_update_dpp(0, __builtin_bit_cast(int, x), 0x124, 0xf, 0xf, false));
  x += __builtin_bit_cast(float, __builtin_amdgcn_update_dpp(0, __builtin_bit_cast(int, x), 0x122, 0xf, 0xf, false));
  x += __builtin_bit_cast(float, __builtin_amdgcn_update_dpp(0, __builtin_bit_cast(int, x), 0x121, 0xf, 0xf, false));
  return x;
}
DI float wavesum(float x) {
  for (int o = 32; o > 0; o >>= 1) x += __shfl_xor(x, o, 64);
  return x;
}
DI void grid_barrier(unsigned* ctr, unsigned& epoch) {
  asm volatile("s_waitcnt vmcnt(0)" ::: "memory");
  __syncthreads();
  epoch++;
  if (threadIdx.x == 0) {
    __builtin_amdgcn_fence(__ATOMIC_RELEASE, "agent");
    asm volatile("s_waitcnt vmcnt(0)" ::: "memory");
    const unsigned target = epoch * gridDim.x;
    __hip_atomic_fetch_add(ctr, 1u, __ATOMIC_RELAXED, __HIP_MEMORY_SCOPE_AGENT);
    while (__hip_atomic_load(ctr, __ATOMIC_RELAXED, __HIP_MEMORY_SCOPE_AGENT) < target) __builtin_amdgcn_s_sleep(2);
    __builtin_amdgcn_fence(__ATOMIC_ACQUIRE, "agent");
    asm volatile("s_waitcnt vmcnt(0)" ::: "memory");
  }
  __syncthreads();
}

DI int launder_v(int x) { asm volatile("" : "+v"(x)); return x; }
DI int launder_s(int x) { asm volatile("" : "+s"(x)); return x; }
#define LAUNDER_IDS const int tid__ = launder_v((int)threadIdx.x); const int blk__ = launder_s((int)blockIdx.x); (void)tid__; (void)blk__;
DI void do_transpose(const float* __restrict__ src, int K, int N, u16* __restrict__ dst, const float* __restrict__ ksc, int perm, int tile, float* tl) {
  LAUNDER_IDS
  const int ntn = (N + 63) >> 6;
  const int kt = tile / ntn, nt = tile - kt * ntn;
  const int k0 = kt * 64, n0 = nt * 64;
  const int tid = tid__;
  __syncthreads();
#pragma unroll 4
  for (int i = 0; i < 16; ++i) {
    const int kk = i * 4 + (tid >> 6), nn = tid & 63;
    float v = 0.f;
    if (n0 + nn < N) v = src[(size_t)(k0 + kk) * N + n0 + nn];
    if (ksc) v *= ksc[k0 + kk];
    tl[kk * 65 + nn] = v;
  }
  __syncthreads();
#pragma unroll 4
  for (int i = 0; i < 16; ++i) {
    const int nn = i * 4 + (tid >> 6), kk = tid & 63;
    int n = n0 + nn;
    if (n < N) {
      if (perm) { const int h = n / 96, d = n - h * 96; n = d < 64 ? h * 64 + d : 512 + h * 32 + (d - 64); }
      dst[(size_t)n * K + k0 + kk] = f2bf(tl[kk * 65 + nn]);
    }
  }
}

DI void phase_prep(const Params& p, char* smem) {
  LAUNDER_IDS
  float* tl = (float*)smem;
  const int tid = tid__;
  constexpr int T_WIN = 16 * 81, T_UQ = 6 * 12, T_UKV = 4 * 16, T_BRM = 8 * 16, T_BRR = 4 * 16, T_WO = 16 * 16, T_W1 = 16 * 64, T_W2 = 64 * 16,
                T_RW2 = 4, T_RA2 = 4, T_RG2 = 2 * 4;
  constexpr int T_LAYER = T_WIN + T_UQ + T_UKV + T_BRM + T_BRR + T_WO + T_W1 + T_W2 + 2 * T_RW2 + 2 * T_RA2 + T_RG2;
  for (int g = blk__; g < 2 * T_LAYER; g += gridDim.x) {
    const int l = g / T_LAYER; int t = g - l * T_LAYER;
    char* wl = p.ws + OFF_W + (size_t)l * W_LAYER;
#define JOB(SRC, KK, NN, DSTOFF, SC, PERM, CNT) if (t < (CNT)) { do_transpose((SRC), (KK), (NN), (u16*)(wl + (DSTOFF)), (SC), (PERM), t, tl); continue; } t -= (CNT);
    JOB(p.in[I_WIN] + (size_t)l * 1024 * INC, 1024, INC, WO_WIN, nullptr, 0, T_WIN)
    JOB(p.in[I_WUQ] + (size_t)l * 384 * 768, 384, 768, WO_UQ, p.in[I_QNORM] + l * 384, 1, T_UQ)
    JOB(p.in[I_WUKV] + (size_t)l * 256 * 1024, 256, 1024, WO_UKV, p.in[I_KVNORM] + l * 256, 0, T_UKV)
    JOB(p.in[I_BRM] + (size_t)l * 512 * 1024, 512, 1024, WO_BRM, nullptr, 0, T_BRM)
    JOB(p.in[I_BRR] + (size_t)l * 256 * 1024, 256, 1024, WO_BRR, nullptr, 0, T_BRR)
    JOB(p.in[I_WO] + (size_t)l * 1024 * 1024, 1024, 1024, WO_WO, nullptr, 0, T_WO)
    JOB(p.in[I_W1] + (size_t)l * 1024 * 4096, 1024, 4096, WO_W1, nullptr, 0, T_W1)
    JOB(p.in[I_W2] + (size_t)l * 4096 * 1024, 4096, 1024, WO_W2, nullptr, 0, T_W2)
    JOB(p.in[I_W2R] + (size_t)(l * 2 + 0) * 64 * 256, 64, 256, WO_RW2, nullptr, 0, T_RW2)
    JOB(p.in[I_W2R] + (size_t)(l * 2 + 1) * 64 * 256, 64, 256, WO_RW2 + 256 * 64 * 2, nullptr, 0, T_RW2)
    JOB(p.in[I_A2R] + (size_t)(l * 2 + 0) * 64 * 256, 64, 256, WO_RA2, nullptr, 0, T_RA2)
    JOB(p.in[I_A2R] + (size_t)(l * 2 + 1) * 64 * 256, 64, 256, WO_RA2 + 256 * 64 * 2, nullptr, 0, T_RA2)
    JOB(p.in[I_G2R] + (size_t)l * 128 * 256, 128, 256, WO_RG2, nullptr, 0, T_RG2)
#undef JOB
  }
  for (int e = blk__ * 256 + tid; e < 2 * 256 * 1024; e += gridDim.x * 256) {
    const int l = e >> 18, r = e & 262143, cin = r >> 10, n = r & 1023, g = cin >> 6, c = cin & 63;
    const float* pw = p.in[I_POOLW] + ((size_t)(l * 4 + g) * 64 + c) * 64;
    const float* ps = p.in[I_POOLS] + l * 256 + g * 64;
    const float* wb = p.in[I_BRP] + ((size_t)l * 256 + g * 64) * 1024 + n;
    float s = 0.f;
    for (int d = 0; d < 64; ++d) s += pw[d] * ps[d] * wb[(size_t)d * 1024];
    ((u16*)(p.ws + OFF_W + (size_t)l * W_LAYER + WO_BRP))[(size_t)n * 256 + cin] = f2bf(s);
  }
  if (blk__ == gridDim.x - 1) {
    for (int e = tid; e < 512; e += 256) {
      const int pos = e >> 3, f = e & 7;
      const float inv = powf(10000.f, -(float)f / 8.f);
      const float ang = (float)pos * inv;
      float* rt = (float*)(p.ws + OFF_ROPE);
      rt[e * 2] = cosf(ang); rt[e * 2 + 1] = sinf(ang);
    }
  }
  {
    float* sl = (float*)smem;
    float* red = sl + 9 * 1024;
    __syncthreads();
    for (int e = tid; e < 9 * 1024; e += 256) {
      const int b = e >> 10, k = e & 1023;
      const float v = b < 8 ? p.in[I_C][b * 1024 + k] : p.in[I_CCTX][k];
      sl[e] = siluf_(v);
    }
    __syncthreads();
    const int wave = tid >> 6, lane = tid & 63;
    for (int it = blk__; it < 192; it += gridDim.x) {
      const int l = it / 96, cg_ = it - l * 96;
      const int col = cg_ * 64 + lane;
      const float* wa = p.in[I_WADA] + (size_t)l * 1024 * 6144 + col;
      float acc[9];
#pragma unroll
      for (int b = 0; b < 9; ++b) acc[b] = 0.f;
#pragma unroll 8
      for (int k = wave * 256; k < wave * 256 + 256; ++k) {
        const float w = wa[(size_t)k * 6144];
#pragma unroll
        for (int b = 0; b < 9; ++b) acc[b] += sl[b * 1024 + k] * w;
      }
#pragma unroll
      for (int b = 0; b < 9; ++b) red[(wave * 9 + b) * 64 + lane] = acc[b];
      __syncthreads();
      for (int e = tid; e < 9 * 64; e += 256) {
        const int b = e >> 6, c = e & 63;
        const float s = red[(0 * 9 + b) * 64 + c] + red[(1 * 9 + b) * 64 + c] + red[(2 * 9 + b) * 64 + c] + red[(3 * 9 + b) * 64 + c];
        ((float*)(p.ws + OFF_MODS))[(size_t)(l * 9 + b) * 6144 + cg_ * 64 + c] = s + p.in[I_BADA][l * 6144 + cg_ * 64 + c];
      }
      __syncthreads();
    }
  }
}

DI const float* xrow(const float* xl, const float* xc, int r) { return r < NTL ? xl + (size_t)r * D : xc + (size_t)(r - NTL) * D; }

DI void phase_norm(const float* xl, const float* xc, const float* tab  , u16* hb, int M) {
  LAUNDER_IDS
  const int wave = tid__ >> 6, lane = tid__ & 63;
  for (int r = blk__ * 4 + wave; r < M; r += gridDim.x * 4) {
    const float* xp = xrow(xl, xc, r);
    const int b9 = r < NTL ? r >> 12 : 8;
    float4 v[4];
    float s = 0.f;
#pragma unroll
    for (int i = 0; i < 4; ++i) { v[i] = *(const float4*)(xp + i * 256 + lane * 4); s += v[i].x * v[i].x + v[i].y * v[i].y + v[i].z * v[i].z + v[i].w * v[i].w; }
    s = wavesum(s);
    const float rs = rsqrtf(s * (1.f / 1024.f) + 1e-6f);
    const float* t = tab + b9 * 2048;
#pragma unroll
    for (int i = 0; i < 4; ++i) {
      const int k = i * 256 + lane * 4;
      const float4 g = *(const float4*)(t + k), sh = *(const float4*)(t + 1024 + k);
      *(uint2*)(hb + (size_t)r * 1024 + k) = make_uint2(pack2(v[i].x * rs * g.x + sh.x, v[i].y * rs * g.y + sh.y), pack2(v[i].z * rs * g.z + sh.z, v[i].w * rs * g.w + sh.w));
    }
  }
}
DI void phase_tables(const Params& p) {
  LAUNDER_IDS
  const float* mods = (const float*)(p.ws + OFF_MODS);
  float* tab = (float*)(p.ws + OFF_TAB);
  for (int e = blk__ * 256 + tid__; e < 2 * 2 * 9 * 1024; e += gridDim.x * 256) {
    const int k = e & 1023, b9 = (e >> 10) % 9, ln = (e >> 10) / 9, l = ln >> 1, nrm = ln & 1;
    const float g = p.in[nrm ? I_N2G : I_N1G][l * 1024 + k];
    const float sh = mods[(size_t)(l * 9 + b9) * 6144 + (nrm * 3 + 0) * 1024 + k];
    const float sc = mods[(size_t)(l * 9 + b9) * 6144 + (nrm * 3 + 1) * 1024 + k];
    float* t = tab + ((size_t)(l * 2 + nrm) * 9 + b9) * 2048;
    t[k] = g * (1.f + sc); t[1024 + k] = sh;
  }
}

struct LoadBf16 {
  const u16* A; int lda;
  DI void init(int m0) {}
  DI uint4 load(int i, int m0, int k0) const {
    LAUNDER_IDS
    const int tid = tid__, kc = (tid & 7) * 8;
    return *(const uint4*)(A + (size_t)(m0 + (tid >> 3) + i * 32) * lda + k0 + kc);
  }
};
struct LoadNorm {
  const float* xl; const float* xc; const float* rs; const float* tab;
  float r0, r1, r2, r3;
  DI void init(int m0) {
    LAUNDER_IDS
    const int tid = tid__;
    r0 = rs[m0 + (tid >> 3)]; r1 = rs[m0 + (tid >> 3) + 32]; r2 = rs[m0 + (tid >> 3) + 64]; r3 = rs[m0 + (tid >> 3) + 96];
  }
  DI uint4 load(int i, int m0, int k0) const {
    LAUNDER_IDS
    const int tid = tid__, kc = (tid & 7) * 8;
    const int b9 = m0 < NTL ? m0 >> 12 : 8;
    const float* t = tab + b9 * 2048 + k0 + kc;
    const float4 g0 = *(const float4*)t, g1 = *(const float4*)(t + 4), s0 = *(const float4*)(t + 1024), s1 = *(const float4*)(t + 1028);
    const float* xp = xrow(xl, xc, m0 + (tid >> 3)) + k0 + kc + (size_t)i * 32 * D;
    const float4 x0 = *(const float4*)xp, x1 = *(const float4*)(xp + 4);
    const float rr = i == 0 ? r0 : i == 1 ? r1 : i == 2 ? r2 : r3;
    uint4 o;
    o.x = pack2(x0.x * rr * g0.x + s0.x, x0.y * rr * g0.y + s0.y);
    o.y = pack2(x0.z * rr * g0.z + s0.z, x0.w * rr * g0.w + s0.w);
    o.z = pack2(x1.x * rr * g1.x + s1.x, x1.y * rr * g1.y + s1.y);
    o.w = pack2(x1.z * rr * g1.z + s1.z, x1.w * rr * g1.w + s1.w);
    return o;
  }
};

DI bool tile_map(int it, int NTM, int NTN, int blk, int nblk, int& tm, int& tn) {
  const int xcd = blk & 7, local = blk >> 3, LB = nblk >> 3;
  const int R = NTM >> 3;
  const int s = it * LB + local;
  if (s >= R * NTN) return false;
  const int F = R >> 3, per_full = 8 * NTN;
  int mg, r, gm;
  if (s < F * per_full) { mg = s / per_full; r = s - mg * per_full; gm = 8; }
  else { mg = F; r = s - F * per_full; gm = R - F * 8; }
  const int ng = r / (gm * 8);
  const int r2 = r - ng * gm * 8;
  const int mi = r2 % gm, ni = r2 / gm;
  tm = xcd * R + mg * 8 + mi; tn = ng * 8 + ni;
  return true;
}
constexpr int LDT = 72;
template <int NI, class LA>
DI void gemm_mainloop(f32x4 (&acc)[4][NI], LA la, const u16* __restrict__ Bt, int ldb, int K, int m0, int n0, char* smem) {
  LAUNDER_IDS
  constexpr int NBI = NI;
  u16* As = (u16*)smem; u16* Bs = As + 2 * 128 * LDT;
  const int tid = tid__, lane = tid & 63, wave = tid >> 6, wr = wave >> 1, wc = wave & 1, lr = lane & 15, lq = lane >> 4;
  uint4 ra[4], rb[NBI];
  la.init(m0);
#pragma unroll
  for (int i = 0; i < 4; ++i) ra[i] = la.load(i, m0, 0);
#pragma unroll
  for (int i = 0; i < NBI; ++i) {
    const int c = tid + i * 256, row = c >> 3, kc = (c & 7) * 8;
    rb[i] = *(const uint4*)(Bt + (size_t)(n0 + row) * ldb + kc);
  }
#pragma unroll
  for (int i = 0; i < 4; ++i) {
    const int c = tid + i * 256, row = c >> 3, kc = (c & 7) * 8;
    *(uint4*)(As + row * LDT + kc) = ra[i];
    if (i < NBI) *(uint4*)(Bs + row * LDT + kc) = rb[i];
  }
  __syncthreads();
  const int nk = K >> 6;
  for (int kt = 0; kt < nk; ++kt) {
    const int cur = kt & 1;
    if (kt + 1 < nk) {
      const int k0 = (kt + 1) * 64;
#pragma unroll
      for (int i = 0; i < 4; ++i) ra[i] = la.load(i, m0, k0);
#pragma unroll
      for (int i = 0; i < NBI; ++i) {
        const int c = tid + i * 256, row = c >> 3, kc = (c & 7) * 8;
        rb[i] = *(const uint4*)(Bt + (size_t)(n0 + row) * ldb + k0 + kc);
      }
    }
    const u16* Ac = As + cur * 128 * LDT + (wr * 64 + lr) * LDT + lq * 8;
    const u16* Bc = Bs + cur * 128 * LDT + (wc * 16 * NI + lr) * LDT + lq * 8;
#pragma unroll
    for (int ks = 0; ks < 2; ++ks) {
      bf16x8 af[4], bfr[NI];
#pragma unroll
      for (int mi = 0; mi < 4; ++mi) af[mi] = *(const bf16x8*)(Ac + mi * 16 * LDT + ks * 32);
#pragma unroll
      for (int ni = 0; ni < NI; ++ni) bfr[ni] = *(const bf16x8*)(Bc + ni * 16 * LDT + ks * 32);
#pragma unroll
      for (int mi = 0; mi < 4; ++mi)
#pragma unroll
        for (int ni = 0; ni < NI; ++ni)
          acc[mi][ni] = __builtin_amdgcn_mfma_f32_16x16x32_bf16(bfr[ni], af[mi], acc[mi][ni], 0, 0, 0);
    }
    if (kt + 1 < nk) {
      const int nxt = cur ^ 1;
#pragma unroll
      for (int i = 0; i < 4; ++i) {
        const int c = tid + i * 256, row = c >> 3, kc = (c & 7) * 8;
        *(uint4*)(As + nxt * 128 * LDT + row * LDT + kc) = ra[i];
        if (i < NBI) *(uint4*)(Bs + nxt * 128 * LDT + row * LDT + kc) = rb[i];
      }
    }
    __syncthreads();
  }
}
template <int NI>
DI void zero_acc(f32x4 (&acc)[4][NI]) {
#pragma unroll
  for (int i = 0; i < 4; ++i)
#pragma unroll
    for (int j = 0; j < NI; ++j) acc[i][j] = f32x4{0.f, 0.f, 0.f, 0.f};
}
template <int NI>
DI void gemm256(f32x4 (&acc)[8][NI], const u16* __restrict__ A, int lda, const u16* __restrict__ Bt, int ldb, int K, int m0, int n0, char* smem) {
  LAUNDER_IDS
  const int lane = tid__ & 63, wave = tid__ >> 6, wr = wave >> 1, wc = wave & 1, lr = lane & 15, lq = lane >> 4;
  constexpr int NBW = NI / 2;
  constexpr int STAGE = 16384 + NI * 2 * 1024;
  constexpr int LPS = 4 + NBW;
  const int srow = lane >> 2, scol = ((lane & 3) ^ ((lane >> 5) << 1)) * 8;
  const u16* Ag = A + (size_t)(m0 + wave * 64 + srow) * lda + scol;
  const u16* Bg = Bt + (size_t)(n0 + wave * NBW * 16 + srow) * ldb + scol;
  char* la = smem + (wave * 4) * 1024 + lane * 16;
  char* lb = smem + 16384 + (wave * NBW) * 1024 + lane * 16;
#define G256_ISSUE(S, K0) do { \
    _Pragma("unroll") for (int j_ = 0; j_ < 4; ++j_) \
      __builtin_amdgcn_global_load_lds((const unsigned*)(Ag + (size_t)j_ * 16 * lda + (K0)), (__attribute__((address_space(3))) unsigned*)(la + (S) * STAGE + j_ * 1024), 16, 0, 0); \
    _Pragma("unroll") for (int j_ = 0; j_ < NBW; ++j_) \
      __builtin_amdgcn_global_load_lds((const unsigned*)(Bg + (size_t)j_ * 16 * ldb + (K0)), (__attribute__((address_space(3))) unsigned*)(lb + (S) * STAGE + j_ * 1024), 16, 0, 0); \
  } while (0)
  const int nk = K >> 5;
  G256_ISSUE(0, 0);
  if (nk > 1) G256_ISSUE(1, 32);
  const int foff = lr * 64 + ((lq ^ ((lr >> 3) << 1)) * 16);
  int st = 0;
  for (int kt = 0; kt < nk; ++kt) {
    if (kt + 1 < nk) asm volatile("s_waitcnt vmcnt(%0) lgkmcnt(0)" :: "n"(LPS) : "memory");
    else asm volatile("s_waitcnt vmcnt(0) lgkmcnt(0)" ::: "memory");
    __builtin_amdgcn_s_barrier();
    if (kt + 2 < nk) { const int s2 = st >= 1 ? st - 1 : 2; G256_ISSUE(s2, (kt + 2) * 32); }
    const char* sb = smem + st * STAGE + foff;
    bf16x8 af[8], bfr[NI];
#pragma unroll
    for (int mi = 0; mi < 8; ++mi) af[mi] = *(const bf16x8*)(sb + (wr * 8 + mi) * 1024);
#pragma unroll
    for (int ni = 0; ni < NI; ++ni) bfr[ni] = *(const bf16x8*)(sb + 16384 + (wc * NI + ni) * 1024);
#pragma unroll
    for (int mi = 0; mi < 8; ++mi)
#pragma unroll
      for (int ni = 0; ni < NI; ++ni)
        acc[mi][ni] = __builtin_amdgcn_mfma_f32_16x16x32_bf16(bfr[ni], af[mi], acc[mi][ni], 0, 0, 0);
    st = st == 2 ? 0 : st + 1;
  }
  asm volatile("s_waitcnt lgkmcnt(0)" ::: "memory");
  __builtin_amdgcn_s_barrier();
#undef G256_ISSUE
}
template <int NI>
DI void zero_acc8(f32x4 (&acc)[8][NI]) {
#pragma unroll
  for (int i = 0; i < 8; ++i)
#pragma unroll
    for (int j = 0; j < NI; ++j) acc[i][j] = f32x4{0.f, 0.f, 0.f, 0.f};
}
#define WAVE_COORDS const int lane = tid__ & 63, wave = tid__ >> 6, wr = wave >> 1, wc = wave & 1, lr = lane & 15, lq = lane >> 4; (void)wr; (void)wc; (void)lr; (void)lq;

DI void phase_zgemm(const Params& p, int l, char* smem) {
  LAUNDER_IDS
  WAVE_COORDS
  const u16* Wt = (const u16*)(p.ws + OFF_W + (size_t)l * W_LAYER + WO_WIN);
  const u16* hb = (const u16*)(p.ws + OFF_HB1);
  u16* za = (u16*)(p.ws + OFF_R2); u16* zr = (u16*)(p.ws + OFF_R1);
  for (int it = 0;; ++it) {
    int tm, tn;
    if (!tile_map(it, NT / 256, 17, blk__, gridDim.x, tm, tn)) break;
    const int m0 = tm * 256, n0 = tn * 128;
    f32x4 acc[8][4]; zero_acc8<4>(acc);
    gemm256<4>(acc, hb, 1024, Wt, 1024, 1024, m0, n0, smem);
#pragma unroll
    for (int mi = 0; mi < 8; ++mi) {
      const int m = m0 + wr * 128 + mi * 16 + lr;
#pragma unroll
      for (int ni = 0; ni < 4; ++ni) {
        const int n = n0 + wc * 64 + ni * 16 + lq * 4;
        uint2 v; v.x = pack2(acc[mi][ni][0], acc[mi][ni][1]); v.y = pack2(acc[mi][ni][2], acc[mi][ni][3]);
        if (n < ZA) *(uint2*)(za + (size_t)m * ZA + n) = v;
        else if (n < ZA + ZR) *(uint2*)(zr + (size_t)m * ZR + (n - ZA)) = v;
      }
    }
  }
}

DI void phase_tokA(const Params& p, int l) {
  LAUNDER_IDS
  const int wave = tid__ >> 6, lane = tid__ & 63;
  const u16* za = (const u16*)(p.ws + OFF_R2);
  float* rsq = (float*)(p.ws + OFF_RSQ); float* rskv = (float*)(p.ws + OFF_RSKV);
  u16* krb = (u16*)(p.ws + OFF_KR);
  u16* pooled = (u16*)(p.ws + OFF_R4);
  const float* rt = (const float*)(p.ws + OFF_ROPE);
  const float* gk = p.in[I_GK] + l * 96;
  for (int r = blk__ * 4 + wave; r < NT; r += gridDim.x * 4) {
    const u16* z = za + (size_t)r * ZA;
    const bool lat = r < NTL;
    const int b = lat ? r >> 12 : (r - NTL) >> 8;
    const int t = lat ? r & 4095 : (r - NTL) & 255;
    const int Ls = lat ? L : LC;
    const int pos = lat ? t : 4096 + t;
    float sq = 0.f, skv = 0.f;
#pragma unroll
    for (int i = 0; i < 6; ++i) { const float v = bf2f(z[256 + i * 64 + lane]); sq += v * v; }
#pragma unroll
    for (int i = 0; i < 4; ++i) { const float v = bf2f(z[640 + i * 64 + lane]); skv += v * v; }
    sq = wavesum(sq); skv = wavesum(skv);
    if (lane == 0) { rsq[r] = rsqrtf(sq * (1.f / 384.f) + 1e-6f); rskv[r] = rsqrtf(skv * (1.f / 256.f) + 1e-6f); }
    {
      const int d = lane & 31;
      float kr = bf2f(z[896 + d]);
      float ss = kr * kr;
      for (int o = 16; o > 0; o >>= 1) ss += __shfl_xor(ss, o, 64);
      kr = kr * rsqrtf(ss * (1.f / 32.f) + 1e-6f) * gk[64 + d];
      const float other = __shfl_xor(kr, 16, 64);
      float outv = kr;
      if (lat) {
        const int i = d & 15;
        const int pp = i < 8 ? (t >> 6) : (t & 63);
        const float cs = rt[(pp * 8 + (i & 7)) * 2], sn = rt[(pp * 8 + (i & 7)) * 2 + 1];
        outv = d < 16 ? kr * cs - other * sn : other * sn + kr * cs;
      }
      if (lane < 32) krb[(size_t)r * 32 + d] = f2bf(outv);
    }
#pragma unroll
    for (int gi = 0; gi < 4; ++gi) {
      const int half = 1 << gi;
      const int lo = max(t - half, 0), hi = min(t + half, Ls);
      const int ch = gi * 64 + lane;
      float s = 0.f;
      for (int q = lo; q < hi; ++q) s += bf2f(z[(ptrdiff_t)(q - t) * ZA + ch]);
      const float mean = s / (float)(hi - lo);
      pooled[(size_t)r * 256 + ch] = f2bf(mean - bf2f(z[ch]));
    }
  }
}

constexpr int ZSL = 1160, TAL = 392;
DI void phase_tokB(const Params& p, int l, char* smem) {
  LAUNDER_IDS
  WAVE_COORDS
  const int tid = tid__;
  u16* Zs = (u16*)smem;
  u16* TA = Zs + 18 * ZSL;
  const u16* zr = (const u16*)(p.ws + OFF_R1);
  const char* wl = p.ws + OFF_W + (size_t)l * W_LAYER;
  const float* mu0 = p.in[I_MU] + (size_t)(l * 2 + 0) * ZR;
  const float* mu1 = p.in[I_MU] + (size_t)(l * 2 + 1) * ZR;
  u16* sc = (u16*)(p.ws + OFF_R3);
  for (int tile = blk__; tile < NT / 16; tile += gridDim.x) {
    const int r0 = tile * 16;
    const bool lat = r0 < NTL;
    const int t0 = lat ? r0 & 4095 : (r0 - NTL) & 255;
    const int Ls = lat ? L : LC;
    __syncthreads();
    for (int c = tid; c < 18 * 144; c += 256) {
      const int i = c / 144, ch = c - i * 144;
      const int tt = t0 - 1 + i;
      uint4 v = make_uint4(0, 0, 0, 0);
      if (tt >= 0 && tt < Ls) v = *(const uint4*)(zr + (size_t)(r0 - 1 + i) * ZR + ch * 8);
      *(uint2*)(Zs + i * ZSL + ch * 8) = make_uint2(v.x, v.y);
      *(uint2*)(Zs + i * ZSL + ch * 8 + 4) = make_uint2(v.z, v.w);
    }
    __syncthreads();
    for (int e = tid; e < 16 * 384; e += 256) {
      const int i = e / 384, c = e - i * 384, zc = 768 + c;
      const float z = bf2f(Zs[(i + 1) * ZSL + zc]), zp = bf2f(Zs[i * ZSL + zc]), zn = bf2f(Zs[(i + 2) * ZSL + zc]);
      float v = z + mu0[zc] * (zp - z) + mu1[zc] * (zn - z);
      if (c < 128) v = 1.f - 2.f / (1.f + __expf(2.f * v)); else if (c >= 256) v = sigmoidf_(v);
      TA[i * TAL + c] = f2bf(v);
    }
    __syncthreads();
    const int row = r0 + lr;
    auto shifted4 = [&](int zc, float (&out)[4]) {
      const uint2 c0 = *(const uint2*)(Zs + (lr + 1) * ZSL + zc), cp = *(const uint2*)(Zs + lr * ZSL + zc), cn = *(const uint2*)(Zs + (lr + 2) * ZSL + zc);
      const float4 m0 = *(const float4*)(mu0 + zc), m1 = *(const float4*)(mu1 + zc);
      float z, zp, zn;
      z = bflo(c0.x); zp = bflo(cp.x); zn = bflo(cn.x); out[0] = z + m0.x * (zp - z) + m1.x * (zn - z);
      z = bfhi(c0.x); zp = bfhi(cp.x); zn = bfhi(cn.x); out[1] = z + m0.y * (zp - z) + m1.y * (zn - z);
      z = bflo(c0.y); zp = bflo(cp.y); zn = bflo(cn.y); out[2] = z + m0.z * (zp - z) + m1.z * (zn - z);
      z = bfhi(c0.y); zp = bfhi(cp.y); zn = bfhi(cn.y); out[3] = z + m0.w * (zp - z) + m1.w * (zn - z);
    };
    auto product = [&](f32x4 (&ac)[4], const u16* W, int Kq, int off) {
#pragma unroll
      for (int ni = 0; ni < 4; ++ni) ac[ni] = f32x4{0.f, 0.f, 0.f, 0.f};
#pragma unroll 1
      for (int ks = 0; ks < Kq / 32; ++ks) {
        const bf16x8 bop = *(const bf16x8*)(TA + lr * TAL + off + ks * 32 + lq * 8);
#pragma unroll
        for (int ni = 0; ni < 4; ++ni) {
          const bf16x8 aop = *(const bf16x8*)(W + (size_t)(wave * 64 + ni * 16 + lr) * Kq + ks * 32 + lq * 8);
          ac[ni] = __builtin_amdgcn_mfma_f32_16x16x32_bf16(aop, bop, ac[ni], 0, 0, 0);
        }
        __builtin_amdgcn_sched_barrier(0);
      }
    };
    float ss = 0.f;
#pragma unroll
    for (int ni = 0; ni < 4; ++ni) {
      const int ch = wave * 64 + ni * 16 + lq * 4;
      float kx[4]; shifted4(256 + ch, kx);
      const float4 kw = *(const float4*)(p.in[I_KK] + l * 256 + ch);
      const float a0 = kx[0] * kw.x, a1 = kx[1] * kw.y, a2 = kx[2] * kw.z, a3 = kx[3] * kw.w;
      ss += a0 * a0 + a1 * a1 + a2 * a2 + a3 * a3;
      __builtin_amdgcn_sched_barrier(0);
    }
    ss += __shfl_xor(ss, 16, 64); ss += __shfl_xor(ss, 32, 64);
    const float kinv = rsqrtf(fmaxf(ss, 1e-24f));
    {
      f32x4 ag[4];
      product(ag, (const u16*)(wl + WO_RG2), 128, 256);
#pragma unroll
      for (int ni = 0; ni < 4; ++ni) {
        const int ch = wave * 64 + ni * 16 + lq * 4;
        const size_t o = (size_t)row * 256 + ch;
        float rx[4], kx[4], vx[4];
        shifted4(ch, rx); shifted4(256 + ch, kx); shifted4(512 + ch, vx);
        const float4 kw = *(const float4*)(p.in[I_KK] + l * 256 + ch);
        *(uint2*)(sc + SA_R * (size_t)NT * 256 + o) = make_uint2(pack2(rx[0], rx[1]), pack2(rx[2], rx[3]));
        *(uint2*)(sc + SA_V * (size_t)NT * 256 + o) = make_uint2(pack2(vx[0], vx[1]), pack2(vx[2], vx[3]));
        *(uint2*)(sc + SA_KKN * (size_t)NT * 256 + o) = make_uint2(pack2(-kx[0] * kw.x * kinv, -kx[1] * kw.y * kinv), pack2(-kx[2] * kw.z * kinv, -kx[3] * kw.w * kinv));
        *(uint2*)(sc + SA_G * (size_t)NT * 256 + o) = make_uint2(pack2(ag[ni][0], ag[ni][1]), pack2(ag[ni][2], ag[ni][3]));
        __builtin_amdgcn_sched_barrier(0);
      }
    }
#pragma unroll 1
    for (int d = 0; d < 2; ++d) {
      f32x4 aw[4], aa[4];
      product(aw, (const u16*)(wl + WO_RW2) + (size_t)d * 256 * 64, 64, d * 64);
      product(aa, (const u16*)(wl + WO_RA2) + (size_t)d * 256 * 64, 64, 128 + d * 64);
      __builtin_amdgcn_sched_barrier(0);
      u16* oOMW = sc + (d ? SA_OMWB : SA_OMWF) * (size_t)NT * 256;
      u16* oKD = sc + (d ? SA_KDB : SA_KDF) * (size_t)NT * 256;
      u16* oB = sc + (d ? SA_BB : SA_BF) * (size_t)NT * 256;
#pragma unroll
      for (int ni = 0; ni < 4; ++ni) {
        const int ch = wave * 64 + ni * 16 + lq * 4;
        const size_t o = (size_t)row * 256 + ch;
        float kx[4]; shifted4(256 + ch, kx);
        const float4 kw = *(const float4*)(p.in[I_KK] + l * 256 + ch);
        const float kkn[4] = {kx[0] * kw.x * kinv, kx[1] * kw.y * kinv, kx[2] * kw.z * kinv, kx[3] * kw.w * kinv};
        const float4 w0 = *(const float4*)(p.in[I_W0] + (size_t)(l * 2 + d) * 256 + ch);
        const float4 a0 = *(const float4*)(p.in[I_A0] + (size_t)(l * 2 + d) * 256 + ch);
        const float4 ka = *(const float4*)(p.in[I_KA] + (size_t)(l * 2 + d) * 256 + ch);
        const float w0a[4] = {w0.x, w0.y, w0.z, w0.w}, a0a[4] = {a0.x, a0.y, a0.z, a0.w}, kaa[4] = {ka.x, ka.y, ka.z, ka.w};
        float omw[4], kd[4], bb[4];
#pragma unroll
        for (int j = 0; j < 4; ++j) {
          const float xw = -(w0a[j] + aw[ni][j]);
          const float sp = fmaxf(xw, 0.f) + __logf(1.f + __expf(-fabsf(xw)));
          const float wlog = -sp - 0.5f;
          const float e = __expf(wlog);
          omw[j] = 1.f - __expf(-e);
          const float a = sigmoidf_(a0a[j] + aa[ni][j]);
          kd[j] = kx[j] * (1.f + (a - 1.f) * kaa[j]);
          bb[j] = kkn[j] * a;
        }
        *(uint2*)(oOMW + o) = make_uint2(pack2(omw[0], omw[1]), pack2(omw[2], omw[3]));
        *(uint2*)(oKD + o) = make_uint2(pack2(kd[0], kd[1]), pack2(kd[2], kd[3]));
        *(uint2*)(oB + o) = make_uint2(pack2(bb[0], bb[1]), pack2(bb[2], bb[3]));
        __builtin_amdgcn_sched_barrier(0);
      }
    }
  }
}

DI size_t qk_index(int m, int h) {
  const bool lat = m < NTL;
  const int b = lat ? m >> 12 : (m - NTL) >> 8;
  const int pos = lat ? m & 4095 : 4096 + ((m - NTL) & 255);
  return ((size_t)(b * 8 + h) * LK + pos) * 96;
}
DI void phase_qkv(const Params& p, int l, char* smem) {
  LAUNDER_IDS
  WAVE_COORDS
  const char* wl = p.ws + OFF_W + (size_t)l * W_LAYER;
  const u16* za = (const u16*)(p.ws + OFF_R2);
  const float* rsq = (const float*)(p.ws + OFF_RSQ); const float* rskv = (const float*)(p.ws + OFF_RSKV);
  u16* Qb = (u16*)(p.ws + OFF_R1); u16* Kb = (u16*)(p.ws + OFF_R1 + SZ_Q); u16* Vt = (u16*)(p.ws + OFF_R1 + 2 * SZ_Q);
  const float* rt = (const float*)(p.ws + OFF_ROPE);
  const float* gq = p.in[I_GQ] + l * 96; const float* gk = p.in[I_GK] + l * 96;
  const float QS = 0.10206207261596577f * 1.4426950408889634f;
  constexpr int NTM = NT / 256;
  for (int it = 0;; ++it) {
    int tm, tn;
    if (!tile_map(it, NTM, 14, blk__, gridDim.x, tm, tn)) break;
    f32x4 acc[8][4]; zero_acc8<4>(acc);
    if (tn < 6) {
      const int m0 = tm * 256, n0 = tn * 128;
      gemm256<4>(acc, za + 256, ZA, (const u16*)(wl + WO_UQ), 384, 384, m0, n0, smem);
      const int nw = n0 + wc * 64;
#pragma unroll
      for (int mi = 0; mi < 8; ++mi) {
        __builtin_amdgcn_sched_barrier(0);
        const int m = m0 + wr * 128 + mi * 16 + lr;
        const float rs = rsq[m];
        if (nw < 512) {
          const int h = nw >> 6;
          float ss = 0.f;
#pragma unroll
          for (int ni = 0; ni < 4; ++ni)
#pragma unroll
            for (int j = 0; j < 4; ++j) { const float v = acc[mi][ni][j] * rs; ss += v * v; }
          ss += __shfl_xor(ss, 16, 64); ss += __shfl_xor(ss, 32, 64);
          const float f = rs * rsqrtf(ss * (1.f / 64.f) + 1e-6f) * QS;
          u16* dst = Qb + qk_index(m, h);
#pragma unroll
          for (int ni = 0; ni < 4; ++ni) {
            const int d = ni * 16 + lq * 4;
            const float4 g = *(const float4*)(gq + d);
            *(uint2*)(dst + d) = make_uint2(pack2(acc[mi][ni][0] * f * g.x, acc[mi][ni][1] * f * g.y), pack2(acc[mi][ni][2] * f * g.z, acc[mi][ni][3] * f * g.w));
          }
        } else {
          const bool lat = m < NTL;
          const int tt = m & 4095;
#pragma unroll
          for (int hh = 0; hh < 2; ++hh) {
            const int h = ((nw - 512) >> 5) + hh;
            float ss = 0.f;
#pragma unroll
            for (int ni = 0; ni < 2; ++ni)
#pragma unroll
              for (int j = 0; j < 4; ++j) { const float v = acc[mi][hh * 2 + ni][j] * rs; ss += v * v; }
            ss += __shfl_xor(ss, 16, 64); ss += __shfl_xor(ss, 32, 64);
            const float f = rs * rsqrtf(ss * (1.f / 32.f) + 1e-6f) * QS;
            const int i0 = lq * 4;
            const float4 g1 = *(const float4*)(gq + 64 + i0), g2 = *(const float4*)(gq + 80 + i0);
            const float g1a[4] = {g1.x, g1.y, g1.z, g1.w}, g2a[4] = {g2.x, g2.y, g2.z, g2.w};
            float o1[4], o2[4];
#pragma unroll
            for (int j = 0; j < 4; ++j) {
              const float x1 = acc[mi][hh * 2][j] * f * g1a[j], x2 = acc[mi][hh * 2 + 1][j] * f * g2a[j];
              float cs = 1.f, sn = 0.f;
              if (lat) {
                const int i = i0 + j;
                const int pp = i < 8 ? (tt >> 6) : (tt & 63);
                cs = rt[(pp * 8 + (i & 7)) * 2]; sn = rt[(pp * 8 + (i & 7)) * 2 + 1];
              }
              o1[j] = x1 * cs - x2 * sn; o2[j] = x1 * sn + x2 * cs;
            }
            u16* dst = Qb + qk_index(m, h) + 64;
            *(uint2*)(dst + i0) = make_uint2(pack2(o1[0], o1[1]), pack2(o1[2], o1[3]));
            *(uint2*)(dst + 16 + i0) = make_uint2(pack2(o2[0], o2[1]), pack2(o2[2], o2[3]));
          }
        }
      }
    } else {
      const int h = tn - 6, m0 = tm * 256, n0 = h * 128;
      gemm256<4>(acc, za + 640, ZA, (const u16*)(wl + WO_UKV), 256, 256, m0, n0, smem);
#pragma unroll
      for (int mi = 0; mi < 8; ++mi) {
        __builtin_amdgcn_sched_barrier(0);
        const int m = m0 + wr * 128 + mi * 16 + lr;
        const float rs = rskv[m];
        if (wc == 0) {
          float ss = 0.f;
#pragma unroll
          for (int ni = 0; ni < 4; ++ni)
#pragma unroll
            for (int j = 0; j < 4; ++j) { const float v = acc[mi][ni][j] * rs; ss += v * v; }
          ss += __shfl_xor(ss, 16, 64); ss += __shfl_xor(ss, 32, 64);
          const float f = rs * rsqrtf(ss * (1.f / 64.f) + 1e-6f);
          u16* dst = Kb + qk_index(m, h);
#pragma unroll
          for (int ni = 0; ni < 4; ++ni) {
            const int d = ni * 16 + lq * 4;
            const float4 g = *(const float4*)(gk + d);
            *(uint2*)(dst + d) = make_uint2(pack2(acc[mi][ni][0] * f * g.x, acc[mi][ni][1] * f * g.y), pack2(acc[mi][ni][2] * f * g.z, acc[mi][ni][3] * f * g.w));
          }
          *(uint4*)(dst + 64 + lq * 8) = *(const uint4*)((const u16*)(p.ws + OFF_KR) + (size_t)m * 32 + lq * 8);
        } else {
          const bool lat = m < NTL;
          const int b = lat ? m >> 12 : (m - NTL) >> 8;
          const int pos = lat ? m & 4095 : 4096 + ((m - NTL) & 255);
          u16* dst = Vt + (size_t)(b * 8 + h) * 64 * LK + pos;
#pragma unroll
          for (int ni = 0; ni < 4; ++ni)
#pragma unroll
            for (int j = 0; j < 4; ++j) dst[(size_t)(ni * 16 + lq * 4 + j) * LK] = f2bf(acc[mi][ni][j] * rs);
        }
      }
    }
  }
}

DI int scan_row(int b, int dir, int s) {
  if (s < LC) return NTL + b * LC + (dir ? LC - 1 - s : s);
  const int t = s - LC;
  return b * L + (dir ? L - 1 - t : t);
}
DI void phase_scan(const Params& p, char* smem) {
  LAUNDER_IDS
  const int blk = blk__;
  if (blk >= 256) return;
  const int tid = tid__, lane = tid & 63, wave = tid >> 6, kq = lane & 15, rg = lane >> 4;
  const int chain = (blk & 7) + 8 * (blk >> 5), quarter = (blk >> 3) & 3;
  const int b = chain >> 3, h = (chain >> 1) & 3, dir = chain & 1;
  const u16* sc = (const u16*)(p.ws + OFF_R3);
  const size_t AS = (size_t)NT * 256;
  const u16* aOMW = sc + (dir ? SA_OMWB : SA_OMWF) * AS;
  const u16* aKD = sc + (dir ? SA_KDB : SA_KDF) * AS;
  const u16* aB = sc + (dir ? SA_BB : SA_BF) * AS;
  const u16* aKKN = sc + SA_KKN * AS;
  const u16* aR = sc + SA_R * AS;
  const u16* aV = sc + SA_V * AS;
  u16* Y = (u16*)(p.ws + OFF_R2) + (dir ? AS : 0);
  constexpr int CH = 16, BSZ = 5 * CH * 64 + CH * 16;
  float* buf = (float*)smem;
  const int st_ld = tid >> 4, k4 = (tid & 15) * 4;
  const int vrow = quarter * 16 + wave * 4 + rg;
  uint2 g0, g1, g2, g3, g4; u16 gv;
#define SCAN_GLOAD(CHUNK) do { \
    const int row_ = scan_row(b, dir, (CHUNK) * CH + st_ld); \
    const size_t o_ = (size_t)row_ * 256 + h * 64 + k4; \
    g0 = *(const uint2*)(aOMW + o_); g1 = *(const uint2*)(aKD + o_); g2 = *(const uint2*)(aB + o_); g3 = *(const uint2*)(aKKN + o_); g4 = *(const uint2*)(aR + o_); \
    gv = aV[(size_t)row_ * 256 + h * 64 + quarter * 16 + (tid & 15)]; } while (0)
#define SCAN_LSTORE(BI) do { \
    float* bb_ = buf + (BI) * BSZ + st_ld * 64 + k4; \
    *(float4*)(bb_ + 0 * CH * 64) = make_float4(1.f - bflo(g0.x), 1.f - bfhi(g0.x), 1.f - bflo(g0.y), 1.f - bfhi(g0.y)); \
    *(float4*)(bb_ + 1 * CH * 64) = make_float4(bflo(g1.x), bfhi(g1.x), bflo(g1.y), bfhi(g1.y)); \
    *(float4*)(bb_ + 2 * CH * 64) = make_float4(bflo(g2.x), bfhi(g2.x), bflo(g2.y), bfhi(g2.y)); \
    *(float4*)(bb_ + 3 * CH * 64) = make_float4(bflo(g3.x), bfhi(g3.x), bflo(g3.y), bfhi(g3.y)); \
    *(float4*)(bb_ + 4 * CH * 64) = make_float4(bflo(g4.x), bfhi(g4.x), bflo(g4.y), bfhi(g4.y)); \
    buf[(BI) * BSZ + 5 * CH * 64 + st_ld * 16 + (tid & 15)] = bf2f(gv); } while (0)
  float2_t S01 = {0.f, 0.f}, S23 = {0.f, 0.f};
  __syncthreads();
  SCAN_GLOAD(0); SCAN_LSTORE(0);
  __syncthreads();
  constexpr int NCH = LK / CH;
  for (int c = 0; c < NCH; ++c) {
    if (c + 1 < NCH) SCAN_GLOAD(c + 1);
    const float* bb = buf + (c & 1) * BSZ;
    const int rowbase = scan_row(b, dir, c * CH);
    const int rstep = dir ? -1 : 1;
#pragma unroll 4
    for (int s = 0; s < CH; ++s) {
      const float4 fw = *(const float4*)(bb + 0 * CH * 64 + s * 64 + kq * 4);
      const float4 fk = *(const float4*)(bb + 1 * CH * 64 + s * 64 + kq * 4);
      const float4 fb = *(const float4*)(bb + 2 * CH * 64 + s * 64 + kq * 4);
      const float4 fa = *(const float4*)(bb + 3 * CH * 64 + s * 64 + kq * 4);
      const float4 fr = *(const float4*)(bb + 4 * CH * 64 + s * 64 + kq * 4);
      const float vv = bb[5 * CH * 64 + s * 16 + wave * 4 + rg];
      const float2_t a01 = {fa.x, fa.y}, a23 = {fa.z, fa.w};
      float2_t t2 = S01 * a01; t2 = S23 * a23 + t2;
      const float sa = rowsum16(t2.x + t2.y);
      const float2_t sa2 = {sa, sa}, vv2 = {vv, vv};
      const float2_t w01 = {fw.x, fw.y}, w23 = {fw.z, fw.w}, k01 = {fk.x, fk.y}, k23 = {fk.z, fk.w}, b01 = {fb.x, fb.y}, b23 = {fb.z, fb.w};
      float2_t u01 = vv2 * k01; u01 = sa2 * b01 + u01; S01 = S01 * w01 + u01;
      float2_t u23 = vv2 * k23; u23 = sa2 * b23 + u23; S23 = S23 * w23 + u23;
      const float2_t r01 = {fr.x, fr.y}, r23 = {fr.z, fr.w};
      float2_t y2 = S01 * r01; y2 = S23 * r23 + y2;
      const float y = rowsum16(y2.x + y2.y);
      if (kq == 0) Y[(size_t)(rowbase + rstep * s) * 256 + h * 64 + vrow] = f2bf(y);
    }
    if (c + 1 < NCH) SCAN_LSTORE((c + 1) & 1);
    __syncthreads();
  }
#undef SCAN_GLOAD
#undef SCAN_LSTORE
}

constexpr int KSL = 104, VSL = 68;
template <int B0>
DI bf16x8 pack8(const f32x16& v) {
  uint4 pw;
  pw.x = pack2(v[B0 + 0], v[B0 + 1]); pw.y = pack2(v[B0 + 2], v[B0 + 3]); pw.z = pack2(v[B0 + 4], v[B0 + 5]); pw.w = pack2(v[B0 + 6], v[B0 + 7]);
  return __builtin_bit_cast(bf16x8, pw);
}
DI void pv_step(f32x16& o0, f32x16& o1, const u16* Vc, int r32, int kb, bf16x8 pf) {
  {
    const uint2 lo = *(const uint2*)(Vc + r32 * VSL + kb), hi2 = *(const uint2*)(Vc + r32 * VSL + kb + 8);
    const bf16x8 va = __builtin_bit_cast(bf16x8, make_uint4(lo.x, lo.y, hi2.x, hi2.y));
    o0 = __builtin_amdgcn_mfma_f32_32x32x16_bf16(va, pf, o0, 0, 0, 0);
  }
  {
    const uint2 lo = *(const uint2*)(Vc + (32 + r32) * VSL + kb), hi2 = *(const uint2*)(Vc + (32 + r32) * VSL + kb + 8);
    const bf16x8 va = __builtin_bit_cast(bf16x8, make_uint4(lo.x, lo.y, hi2.x, hi2.y));
    o1 = __builtin_amdgcn_mfma_f32_32x32x16_bf16(va, pf, o1, 0, 0, 0);
  }
}
DI void attn_item(const Params& p, int item, char* smem) {
  LAUNDER_IDS
  const int tid = tid__, lane = tid & 63, wave = tid >> 6, r32 = lane & 31, hi = lane >> 5;
  int bh, qpos0, key0, nkt, orow0;
  if (item < 2048) { bh = item >> 5; const int qb = item & 31; qpos0 = qb * 128; key0 = 0; nkt = LK / 64; orow0 = (bh >> 3) * L + qpos0; }
  else { const int it = item - 2048; bh = it >> 1; const int qb = it & 1; qpos0 = 4096 + qb * 128; key0 = 4096; nkt = LC / 64; orow0 = NTL + (bh >> 3) * LC + qb * 128; }
  const int h = bh & 7;
  const u16* Qp = (const u16*)(p.ws + OFF_R1) + ((size_t)bh * LK + qpos0 + wave * 32 + r32) * 96 + hi * 8;
  const u16* Kp = (const u16*)(p.ws + OFF_R1 + SZ_Q) + ((size_t)bh * LK + key0) * 96;
  const u16* Vp = (const u16*)(p.ws + OFF_R1 + 2 * SZ_Q) + (size_t)bh * 64 * LK + key0;
  u16* Ks = (u16*)smem;
  u16* Vs = Ks + 2 * 64 * KSL;
  bf16x8 qr[6];
#pragma unroll
  for (int d0 = 0; d0 < 6; ++d0) qr[d0] = *(const bf16x8*)(Qp + d0 * 16);
  uint4 sk0, sk1, sk2, sv0, sv1;
  const int kr0 = tid / 12, kc0 = tid - kr0 * 12, kr1 = (tid + 256) / 12, kc1 = (tid + 256) - kr1 * 12, kr2 = (tid + 512) / 12, kc2 = (tid + 512) - kr2 * 12;
  const int vd0 = tid >> 3, vc0 = tid & 7, vd1 = vd0 + 32;
#define gload(kt) do { \
    sk0 = *(const uint4*)(Kp + (size_t)((kt) * 64 + kr0) * 96 + kc0 * 8); sk1 = *(const uint4*)(Kp + (size_t)((kt) * 64 + kr1) * 96 + kc1 * 8); \
    sk2 = *(const uint4*)(Kp + (size_t)((kt) * 64 + kr2) * 96 + kc2 * 8); \
    sv0 = *(const uint4*)(Vp + (size_t)vd0 * LK + (kt) * 64 + vc0 * 8); sv1 = *(const uint4*)(Vp + (size_t)vd1 * LK + (kt) * 64 + vc0 * 8); } while (0)
#define lstore(bi) do { \
    *(uint4*)(Ks + (bi) * 64 * KSL + kr0 * KSL + kc0 * 8) = sk0; *(uint4*)(Ks + (bi) * 64 * KSL + kr1 * KSL + kc1 * 8) = sk1; *(uint4*)(Ks + (bi) * 64 * KSL + kr2 * KSL + kc2 * 8) = sk2; \
    { u16* dst = Vs + (bi) * 64 * VSL + vd0 * VSL + vc0 * 8; *(uint2*)dst = make_uint2(sv0.x, sv0.y); *(uint2*)(dst + 4) = make_uint2(sv0.z, sv0.w); } \
    { u16* dst = Vs + (bi) * 64 * VSL + vd1 * VSL + vc0 * 8; *(uint2*)dst = make_uint2(sv1.x, sv1.y); *(uint2*)(dst + 4) = make_uint2(sv1.z, sv1.w); } } while (0)
  f32x16 o0, o1;
#pragma unroll
  for (int i = 0; i < 16; ++i) { o0[i] = 0.f; o1[i] = 0.f; }
  float mrun = -1e30f, lrun = 0.f;
  __syncthreads();
  gload(0); lstore(0);
  __syncthreads();
  for (int kt = 0; kt < nkt; ++kt) {
    const int cur = kt & 1;
    if (kt + 1 < nkt) gload(kt + 1);
    const u16* Kc = Ks + cur * 64 * KSL;
    const u16* Vc = Vs + cur * 64 * VSL;
    f32x16 p0, p1;
#pragma unroll
    for (int i = 0; i < 16; ++i) { p0[i] = 0.f; p1[i] = 0.f; }
#pragma unroll
    for (int d0 = 0; d0 < 6; ++d0) {
      const bf16x8 a0 = *(const bf16x8*)(Kc + r32 * KSL + d0 * 16 + hi * 8);
      const bf16x8 a1 = *(const bf16x8*)(Kc + (32 + r32) * KSL + d0 * 16 + hi * 8);
      p0 = __builtin_amdgcn_mfma_f32_32x32x16_bf16(a0, qr[d0], p0, 0, 0, 0);
      p1 = __builtin_amdgcn_mfma_f32_32x32x16_bf16(a1, qr[d0], p1, 0, 0, 0);
    }
    float mx = p0[0];
#pragma unroll
    for (int i = 1; i < 16; ++i) mx = fmaxf(mx, p0[i]);
#pragma unroll
    for (int i = 0; i < 16; ++i) mx = fmaxf(mx, p1[i]);
    mx = fmaxf(mx, __shfl_xor(mx, 32, 64));
    if (!__all(mx - mrun <= 8.f)) {
      const float mn = fmaxf(mrun, mx);
      const float alpha = __builtin_amdgcn_exp2f(mrun - mn);
      mrun = mn; lrun *= alpha;
#pragma unroll
      for (int i = 0; i < 16; ++i) { o0[i] *= alpha; o1[i] *= alpha; }
    }
    float ps = 0.f;
#pragma unroll
    for (int i = 0; i < 16; ++i) { p0[i] = __builtin_amdgcn_exp2f(p0[i] - mrun); ps += p0[i]; }
#pragma unroll
    for (int i = 0; i < 16; ++i) { p1[i] = __builtin_amdgcn_exp2f(p1[i] - mrun); ps += p1[i]; }
    lrun += ps;
    pv_step(o0, o1, Vc, r32, 0 + hi * 4, pack8<0>(p0));
    pv_step(o0, o1, Vc, r32, 16 + hi * 4, pack8<8>(p0));
    pv_step(o0, o1, Vc, r32, 32 + hi * 4, pack8<0>(p1));
    pv_step(o0, o1, Vc, r32, 48 + hi * 4, pack8<8>(p1));
    if (kt + 1 < nkt) lstore(cur ^ 1);
    __syncthreads();
  }
  lrun += __shfl_xor(lrun, 32, 64);
  const float inv = 1.f / lrun;
  u16* om = (u16*)(p.ws + OFF_R3 + SA_KKN * SZ_TOK256) + (size_t)(orow0 + wave * 32 + r32) * 512 + h * 64;
#pragma unroll
  for (int g = 0; g < 4; ++g) {
    const int d = 8 * g + 4 * hi;
    *(uint2*)(om + d) = make_uint2(pack2(o0[4 * g] * inv, o0[4 * g + 1] * inv), pack2(o0[4 * g + 2] * inv, o0[4 * g + 3] * inv));
    *(uint2*)(om + 32 + d) = make_uint2(pack2(o1[4 * g] * inv, o1[4 * g + 1] * inv), pack2(o1[4 * g + 2] * inv, o1[4 * g + 3] * inv));
  }
#undef gload
#undef lstore
}

DI void readout_row(const Params& p, int l, int r) {
  LAUNDER_IDS
  const int lane = tid__ & 63;
  const u16* sc = (const u16*)(p.ws + OFF_R3);
  const size_t AS = (size_t)NT * 256;
  const size_t o = (size_t)r * 256 + lane * 4;
  const u16* Yf = (const u16*)(p.ws + OFF_R2);
  const uint2 yf = *(const uint2*)(Yf + o), yb = *(const uint2*)(Yf + AS + o);
  const uint2 ur = *(const uint2*)(sc + SA_R * AS + o), uv = *(const uint2*)(sc + SA_V * AS + o);
  const uint2 kf = *(const uint2*)(sc + SA_KDF * AS + o), kb = *(const uint2*)(sc + SA_KDB * AS + o), ug = *(const uint2*)(sc + SA_G * AS + o);
  float y[4] = {bflo(yf.x) + bflo(yb.x), bfhi(yf.x) + bfhi(yb.x), bflo(yf.y) + bflo(yb.y), bfhi(yf.y) + bfhi(yb.y)};
  const float rr[4] = {bflo(ur.x), bfhi(ur.x), bflo(ur.y), bfhi(ur.y)};
  const float vv[4] = {bflo(uv.x), bfhi(uv.x), bflo(uv.y), bfhi(uv.y)};
  const float km[4] = {0.5f * (bflo(kf.x) + bflo(kb.x)), 0.5f * (bfhi(kf.x) + bfhi(kb.x)), 0.5f * (bflo(kf.y) + bflo(kb.y)), 0.5f * (bfhi(kf.y) + bfhi(kb.y))};
  const float gg[4] = {bflo(ug.x), bfhi(ug.x), bflo(ug.y), bfhi(ug.y)};
  const float4 rk4 = *(const float4*)(p.in[I_RK] + l * 256 + lane * 4);
  const float4 lw4 = *(const float4*)(p.in[I_LNW] + l * 256 + lane * 4);
  const float4 lb4 = *(const float4*)(p.in[I_LNB] + l * 256 + lane * 4);
  const float rk[4] = {rk4.x, rk4.y, rk4.z, rk4.w}, lw[4] = {lw4.x, lw4.y, lw4.z, lw4.w}, lb[4] = {lb4.x, lb4.y, lb4.z, lb4.w};
  float s = y[0] + y[1] + y[2] + y[3];
  s = rowsum16(s);
  const float mu = s * (1.f / 64.f);
  float q = 0.f, bn = 0.f;
#pragma unroll
  for (int j = 0; j < 4; ++j) { const float d = y[j] - mu; q += d * d; bn += rr[j] * km[j] * rk[j]; }
  q = rowsum16(q); bn = rowsum16(bn);
  const float rstd = rsqrtf(q * (1.f / 64.f) + 64e-5f);
  float ov[4];
#pragma unroll
  for (int j = 0; j < 4; ++j) ov[j] = ((y[j] - mu) * rstd * lw[j] + lb[j] + bn * vv[j]) * gg[j];
  u16* orw = (u16*)(p.ws + OFF_R3 + SA_KKN * SZ_TOK256 + (size_t)NT * 512 * 2);
  *(uint2*)(orw + o) = make_uint2(pack2(ov[0], ov[1]), pack2(ov[2], ov[3]));
}

DI void phase_attn(const Params& p, int l, int Mout, char* smem) {
  LAUNDER_IDS
  const int nattn = (l == 0) ? 2048 + 128 : 2048;
  for (int it = blk__; it < nattn; it += gridDim.x) attn_item(p, it, smem);
  const int wave = tid__ >> 6;
  for (int r = blk__ * 4 + wave; r < Mout; r += gridDim.x * 4) readout_row(p, l, r);
}

DI void phase_merge(const Params& p, int l, int Mout, char* smem) {
  LAUNDER_IDS
  WAVE_COORDS
  const char* wl = p.ws + OFF_W + (size_t)l * W_LAYER;
  const u16* hg = (const u16*)(p.ws + OFF_HBG);
  const u16* opool = (const u16*)(p.ws + OFF_R4);
  const u16* omla = (const u16*)(p.ws + OFF_R3 + SA_KKN * SZ_TOK256);
  const u16* orw = omla + (size_t)NT * 512;
  u16* mo = (u16*)(p.ws + OFF_R1);
  const int ntm = Mout / 256;
  for (int it = 0;; ++it) {
    int tm, tn;
    if (!tile_map(it, ntm, 16, blk__, gridDim.x, tm, tn)) break;
    const int m0 = tm * 256, n0 = tn * 64;
    f32x4 msum[8][2]; zero_acc8<2>(msum);
#pragma unroll 1
    for (int br = 0; br < 3; ++br) {
      unsigned gpk[8][2][2];
      {
        f32x4 ag[8][2]; zero_acc8<2>(ag);
        gemm256<2>(ag, hg, 1024, (const u16*)(wl + WO_WIN) + (size_t)(2080 + br * 1024) * 1024, 1024, 1024, m0, n0, smem);
#pragma unroll
        for (int mi = 0; mi < 8; ++mi)
#pragma unroll
          for (int ni = 0; ni < 2; ++ni) {
            gpk[mi][ni][0] = pack2(sigmoidf_(ag[mi][ni][0]), sigmoidf_(ag[mi][ni][1]));
            gpk[mi][ni][1] = pack2(sigmoidf_(ag[mi][ni][2]), sigmoidf_(ag[mi][ni][3]));
          }
      }
      __builtin_amdgcn_sched_barrier(0);
      f32x4 ab[8][2]; zero_acc8<2>(ab);
      {
        const int Kb = br == 1 ? 512 : 256;
        const u16* Ab = br == 0 ? opool : br == 1 ? omla : orw;
        const u16* Wb = (const u16*)(wl + (br == 0 ? WO_BRP : br == 1 ? WO_BRM : WO_BRR));
        gemm256<2>(ab, Ab, Kb, Wb, Kb, Kb, m0, n0, smem);
      }
#pragma unroll
      for (int mi = 0; mi < 8; ++mi)
#pragma unroll
        for (int ni = 0; ni < 2; ++ni) {
          msum[mi][ni][0] += bflo(gpk[mi][ni][0]) * ab[mi][ni][0];
          msum[mi][ni][1] += bfhi(gpk[mi][ni][0]) * ab[mi][ni][1];
          msum[mi][ni][2] += bflo(gpk[mi][ni][1]) * ab[mi][ni][2];
          msum[mi][ni][3] += bfhi(gpk[mi][ni][1]) * ab[mi][ni][3];
        }
      __builtin_amdgcn_sched_barrier(0);
    }
#pragma unroll
    for (int mi = 0; mi < 8; ++mi) {
      const int m = m0 + wr * 128 + mi * 16 + lr;
#pragma unroll
      for (int ni = 0; ni < 2; ++ni) {
        const int n = n0 + wc * 32 + ni * 16 + lq * 4;
        *(uint2*)(mo + (size_t)m * 1024 + n) = make_uint2(pack2(msum[mi][ni][0], msum[mi][ni][1]), pack2(msum[mi][ni][2], msum[mi][ni][3]));
      }
    }
  }
}

DI void phase_resid(const Params& p, const u16* A, int K, const u16* Bt, const float* gate  ,
                    const float* xl_in, const float* xc_in, float* xl_out, float* xc_out, int Mout, char* smem) {
  LAUNDER_IDS
  WAVE_COORDS
  const int ntm = Mout / 256;
  for (int it = 0;; ++it) {
    int tm, tn;
    if (!tile_map(it, ntm, 8, blk__, gridDim.x, tm, tn)) break;
    const int m0 = tm * 256, n0 = tn * 128;
    f32x4 acc[8][4]; zero_acc8<4>(acc);
    gemm256<4>(acc, A, K, Bt, K, K, m0, n0, smem);
#pragma unroll
    for (int mi = 0; mi < 8; ++mi) {
      const int m = m0 + wr * 128 + mi * 16 + lr;
      const int b9 = m < NTL ? m >> 12 : 8;
      const float* xi = xrow(xl_in, xc_in, m);
      float* xo = m < NTL ? xl_out + (size_t)m * D : xc_out + (size_t)(m - NTL) * D;
#pragma unroll
      for (int ni = 0; ni < 4; ++ni) {
        const int n = n0 + wc * 64 + ni * 16 + lq * 4;
        const float4 g = *(const float4*)(gate + (size_t)b9 * 6144 + n);
        const float4 xv = *(const float4*)(xi + n);
        float4 ov;
        ov.x = xv.x + g.x * acc[mi][ni][0]; ov.y = xv.y + g.y * acc[mi][ni][1]; ov.z = xv.z + g.z * acc[mi][ni][2]; ov.w = xv.w + g.w * acc[mi][ni][3];
        *(float4*)(xo + n) = ov;
      }
      __builtin_amdgcn_sched_barrier(0);
    }
  }
}
DI void phase_mlp1(const Params& p, int l, int Mout, char* smem) {
  LAUNDER_IDS
  WAVE_COORDS
  const char* wl = p.ws + OFF_W + (size_t)l * W_LAYER;
  const u16* hb = (const u16*)(p.ws + OFF_HB2);
  u16* U = (u16*)(p.ws + OFF_R1);
  const int ntm = Mout / 256;
  for (int it = 0;; ++it) {
    int tm, tn;
    if (!tile_map(it, ntm, 32, blk__, gridDim.x, tm, tn)) break;
    const int m0 = tm * 256, n0 = tn * 128;
    f32x4 acc[8][4]; zero_acc8<4>(acc);
    gemm256<4>(acc, hb, 1024, (const u16*)(wl + WO_W1), 1024, 1024, m0, n0, smem);
#pragma unroll
    for (int mi = 0; mi < 8; ++mi) {
      const int m = m0 + wr * 128 + mi * 16 + lr;
#pragma unroll
      for (int ni = 0; ni < 4; ++ni) {
        const int n = n0 + wc * 64 + ni * 16 + lq * 4;
        float v[4];
#pragma unroll
        for (int j = 0; j < 4; ++j) { const float a = fmaxf(acc[mi][ni][j], 0.f); v[j] = a * a; }
        *(uint2*)(U + (size_t)m * DFF + n) = make_uint2(pack2(v[0], v[1]), pack2(v[2], v[3]));
      }
      __builtin_amdgcn_sched_barrier(0);
    }
  }
}

__global__ void __launch_bounds__(256, 2) fwd_megakernel(Params pk) {
  __shared__ __attribute__((aligned(16))) char smem[73728];
  cg::grid_group grid = cg::this_grid();
  unsigned* bar = (unsigned*)(pk.ws + OFF_BAR);
  unsigned epoch = 0;
  phase_prep(pk, smem);
  grid.sync();
  phase_tables(pk);
  grid_barrier(bar, epoch);
#define CTXBUF ((float*)(p.ws + OFF_CTX))
#define XLP (l == 0 ? p.in[I_X] : (const float*)p.out)
#define XCP (l == 0 ? p.in[I_CTX] : (const float*)CTXBUF)
#define MOUT (l == 0 ? NT : NTL)
#define WLP (p.ws + OFF_W + (size_t)l * W_LAYER)
#define TABP(nrm) ((const float*)(p.ws + OFF_TAB) + (size_t)(l * 2 + (nrm)) * 9 * 2048)
#define MODP(j) ((const float*)(p.ws + OFF_MODS) + (size_t)l * 9 * 6144 + (j) * 1024)
#ifndef PROBE_Q
#define PROBE_Q -1
#endif
#pragma nounroll
  for (int ph = 0; ph < 24; ++ph) {
    const int l = ph >= 12 ? 1 : 0, q = ph - l * 12;
    Params p = pk;
    {
      unsigned long long w_ = (unsigned long long)pk.ws, o_ = (unsigned long long)pk.out;
      unsigned wl_ = (unsigned)w_, wh_ = (unsigned)(w_ >> 32), ol_ = (unsigned)o_, oh_ = (unsigned)(o_ >> 32);
      wl_ = __builtin_amdgcn_readfirstlane(wl_); wh_ = __builtin_amdgcn_readfirstlane(wh_); ol_ = __builtin_amdgcn_readfirstlane(ol_); oh_ = __builtin_amdgcn_readfirstlane(oh_);
      asm volatile("" : "+s"(wl_), "+s"(wh_), "+s"(ol_), "+s"(oh_));
      p.ws = (char*)(((unsigned long long)wh_ << 32) | wl_); p.out = (float*)(((unsigned long long)oh_ << 32) | ol_);
    }
#pragma nounroll
    for (int rep = 0; rep < (q == PROBE_Q ? 2 : 1); ++rep)
    switch (q) {
      case 0: phase_norm(XLP, XCP, TABP(0), (u16*)(p.ws + OFF_HB1), NT); break;
      case 1: phase_zgemm(p, l, smem); break;
      case 2: phase_tokA(p, l); phase_tokB(p, l, smem); break;
      case 3: phase_qkv(p, l, smem); break;
      case 4: phase_scan(p, smem); break;
      case 5: phase_attn(p, l, MOUT, smem); break;
      case 6: phase_norm(XLP, XCP, TABP(0), (u16*)(p.ws + OFF_HBG), MOUT); break;
      case 7: phase_merge(p, l, MOUT, smem); break;
      case 8: phase_resid(p, (const u16*)(p.ws + OFF_R1), 1024, (const u16*)(WLP + WO_WO), MODP(2), XLP, XCP, p.out, CTXBUF, MOUT, smem); break;
      case 9: phase_norm(p.out, CTXBUF, TABP(1), (u16*)(p.ws + OFF_HB2), MOUT); break;
      case 10: phase_mlp1(p, l, MOUT, smem); break;
      default: phase_resid(p, (const u16*)(p.ws + OFF_R1), 4096, (const u16*)(WLP + WO_W2), MODP(5), p.out, CTXBUF, p.out, CTXBUF, MOUT, smem); break;
    }
    if (ph != 23) grid_barrier(bar, epoch);
  }
}

extern "C" void kernel_launch(void* const* d_in, const int* in_sizes, int n_in, void* d_out, int out_size, void* d_ws, size_t ws_size, hipStream_t stream) {
  static int grid_blocks = 0;
  if (!grid_blocks) {
    int dev = 0, cus = 0, per_cu = 0;
    hipGetDevice(&dev);
    hipDeviceGetAttribute(&cus, hipDeviceAttributeMultiprocessorCount, dev);
    hipOccupancyMaxActiveBlocksPerMultiprocessor(&per_cu, fwd_megakernel, 256, 0);
    if (per_cu > 2) per_cu = 2;
    if (per_cu < 1) per_cu = 1;
    grid_blocks = cus * per_cu;
    if (ws_size < WS_END) fprintf(stderr, "kernel_launch: workspace too small: %zu < %zu\n", ws_size, (size_t)WS_END);
  }
  Params p{};
  for (int i = 0; i < 34; ++i) p.in[i] = (const float*)d_in[i];
  p.out = (float*)d_out;
  p.ws = (char*)d_ws;
  hipMemsetAsync(d_ws, 0, 4096, stream);
  void* args[] = {&p};
  hipError_t e = hipLaunchCooperativeKernel((void*)fwd_megakernel, dim3(grid_blocks), dim3(256), args, 0, stream);
  if (e != hipSuccess) fprintf(stderr, "cooperative launch failed: %s (grid %d)\n", hipGetErrorString(e), grid_blocks);
}
```

```cpp
#include <hip/hip_runtime.h>
#include <hip/hip_cooperative_groups.h>
#include <stdint.h>
#include <cstdio>
namespace cg = cooperative_groups;

typedef unsigned short u16;
typedef __attribute__((ext_vector_type(8))) short bf16x8;
typedef __attribute__((ext_vector_type(4))) float f32x4;
typedef __attribute__((ext_vector_type(16))) float f32x16;
typedef __bf16 bf16x2_t __attribute__((ext_vector_type(2)));
typedef float float2_t __attribute__((ext_vector_type(2)));

#define DI __device__ __forceinline__

constexpr int D = 1024, NB = 8, L = 4096, LC = 256, LK = 4352;
constexpr int NTL = NB * L;
constexpr int NTC = NB * LC;
constexpr int NT = NTL + NTC;
constexpr int INC = 5152;
constexpr int ZA = 928;
constexpr int ZR = 1152;
constexpr int DFF = 4096;

constexpr size_t al256(size_t x) { return (x + 255) / 256 * 256; }
constexpr size_t OFF_BAR = 0;
constexpr size_t OFF_MODS = 4096;
constexpr size_t OFF_TAB = OFF_MODS + al256(2 * 9 * 6144 * 4);
constexpr size_t OFF_ROPE = OFF_TAB + al256(2 * 2 * 9 * 2 * 1024 * 4);
constexpr size_t OFF_RS1 = OFF_ROPE + 4096;
constexpr size_t OFF_RS2 = OFF_RS1 + al256(NT * 4);
constexpr size_t OFF_RSQ = OFF_RS2 + al256(NT * 4);
constexpr size_t OFF_RSKV = OFF_RSQ + al256(NT * 4);
constexpr size_t OFF_CTX = OFF_RSKV + al256(NT * 4);
constexpr size_t OFF_W = OFF_CTX + (size_t)NTC * D * 4;
constexpr size_t WO_WIN = 0;
constexpr size_t WO_UQ = WO_WIN + (size_t)INC * 1024 * 2;
constexpr size_t WO_UKV = WO_UQ + (size_t)768 * 384 * 2;
constexpr size_t WO_BRP = WO_UKV + (size_t)1024 * 256 * 2;
constexpr size_t WO_BRM = WO_BRP + (size_t)1024 * 256 * 2;
constexpr size_t WO_BRR = WO_BRM + (size_t)1024 * 512 * 2;
constexpr size_t WO_WO = WO_BRR + (size_t)1024 * 256 * 2;
constexpr size_t WO_W1 = WO_WO + (size_t)1024 * 1024 * 2;
constexpr size_t WO_W2 = WO_W1 + (size_t)4096 * 1024 * 2;
constexpr size_t WO_RW2 = WO_W2 + (size_t)1024 * 4096 * 2;
constexpr size_t WO_RA2 = WO_RW2 + (size_t)2 * 256 * 64 * 2;
constexpr size_t WO_RG2 = WO_RA2 + (size_t)2 * 256 * 64 * 2;
constexpr size_t W_LAYER = al256(WO_RG2 + (size_t)256 * 128 * 2);
constexpr size_t OFF_R1 = OFF_W + 2 * W_LAYER;
constexpr size_t SZ_Q = (size_t)NB * 8 * LK * 96 * 2;
constexpr size_t SZ_VT = (size_t)NB * 8 * 64 * LK * 2;
constexpr size_t SZ_R1 = 2 * SZ_Q + SZ_VT;
constexpr size_t OFF_R2 = OFF_R1 + al256(SZ_R1);
constexpr size_t SZ_TOK256 = (size_t)NT * 256 * 2;
constexpr size_t OFF_R3 = OFF_R2 + al256((size_t)NT * ZA * 2);
constexpr size_t OFF_R4 = OFF_R3 + 10 * SZ_TOK256;
constexpr size_t OFF_KR = OFF_R4 + SZ_TOK256;
constexpr size_t OFF_OMLA = OFF_KR + al256((size_t)NT * 32 * 2);
constexpr size_t WS_END = OFF_OMLA + (size_t)NT * 512 * 2;
static_assert(WS_END <= 536870912ull, "workspace map exceeds 4x the largest tensor");
constexpr size_t OFF_HB1 = OFF_R3;
constexpr size_t OFF_HBG = OFF_R1 + (size_t)NT * 1024 * 2;
constexpr size_t OFF_HB2 = OFF_R3 + 5 * SZ_TOK256;
enum { SA_R = 0, SA_V = 1, SA_KDF = 2, SA_KDB = 3, SA_G = 4, SA_KKN = 5, SA_OMWF = 6, SA_BF = 7, SA_OMWB = 8, SA_BB = 9 };

struct Params { const float* in[34]; float* out; char* ws; };

enum { I_X = 0, I_C, I_CTX, I_CCTX, I_N1G, I_N2G, I_WADA, I_BADA, I_WIN, I_POOLW, I_POOLS, I_QNORM, I_WUQ, I_KVNORM, I_WUKV,
       I_GQ, I_GK, I_MU, I_W0, I_W2R, I_A0, I_A2R, I_KA, I_KK, I_RK, I_G2R, I_LNW, I_LNB, I_BRP, I_BRM, I_BRR, I_WO, I_W1, I_W2 };

DI float bf2f(u16 h) { return __uint_as_float(((unsigned)h) << 16); }
DI float bflo(unsigned u) { return __uint_as_float(u << 16); }
DI float bfhi(unsigned u) { return __uint_as_float(u & 0xffff0000u); }
DI unsigned pack2(float a, float b) { float2_t v = {a, b}; bf16x2_t r = __builtin_convertvector(v, bf16x2_t); return __builtin_bit_cast(unsigned, r); }
DI u16 f2bf(float a) { return (u16)(pack2(a, 0.f) & 0xffffu); }
DI float sigmoidf_(float x) { return 1.f / (1.f + __expf(-x)); }
DI float siluf_(float x) { return x / (1.f + __expf(-x)); }
DI float rowsum16(float x) {
  x += __builtin_bit_cast(float, __builtin_amdgcn_update_dpp(0, __builtin_bit_cast(int, x), 0x128, 0xf, 0xf, false));
  x += __builtin_bit_cast(float, __builtin_amdgcn_update_dpp(0, __builtin_bit_cast(int, x), 0x124, 0xf, 0xf, false));
  x += __builtin_bit_cast(float, __builtin_amdgcn_update_dpp(0, __builtin_bit_cast(int, x), 0x122, 0xf, 0xf, false));
  x += __builtin_bit_cast(float, __builtin_amdgcn_update_dpp(0, __builtin_bit_cast(int, x), 0x121, 0xf, 0xf, false));
  return x;
}
DI float wavesum(float x) {
  for (int o = 32; o > 0; o >>= 1) x += __shfl_xor(x, o, 64);
  return x;
}
DI void grid_barrier(unsigned* ctr, unsigned& epoch) {
  asm volatile("s_waitcnt vmcnt(0)" ::: "memory");
  __syncthreads();
  epoch++;
  if (threadIdx.x == 0) {
    __builtin_amdgcn_fence(__ATOMIC_RELEASE, "agent");
    asm volatile("s_waitcnt vmcnt(0)" ::: "memory");
    const unsigned target = epoch * gridDim.x;
    __hip_atomic_fetch_add(ctr, 1u, __ATOMIC_RELAXED, __HIP_MEMORY_SCOPE_AGENT);
    while (__hip_atomic_load(ctr, __ATOMIC_RELAXED, __HIP_MEMORY_SCOPE_AGENT) < target) __builtin_amdgcn_s_sleep(2);
    __builtin_amdgcn_fence(__ATOMIC_ACQUIRE, "agent");
    asm volatile("s_waitcnt vmcnt(0)" ::: "memory");
  }
  __syncthreads();
}

DI int launder_v(int x) { asm volatile("" : "+v"(x)); return x; }
DI int launder_s(int x) { asm volatile("" : "+s"(x)); return x; }
#define LAUNDER_IDS const int tid__ = launder_v((int)threadIdx.x); const int blk__ = launder_s((int)blockIdx.x); (void)tid__; (void)blk__;
DI void do_transpose(const float* __restrict__ src, int K, int N, u16* __restrict__ dst, const float* __restrict__ ksc, int perm, int tile, float* tl) {
  LAUNDER_IDS
  const int ntn = (N + 63) >> 6;
  const int kt = tile / ntn, nt = tile - kt * ntn;
  const int k0 = kt * 64, n0 = nt * 64;
  const int tid = tid__;
  __syncthreads();
#pragma unroll 4
  for (int i = 0; i < 16; ++i) {
    const int kk = i * 4 + (tid >> 6), nn = tid & 63;
    float v = 0.f;
    if (n0 + nn < N) v = src[(size_t)(k0 + kk) * N + n0 + nn];
    if (ksc) v *= ksc[k0 + kk];
    tl[kk * 65 + nn] = v;
  }
  __syncthreads();
#pragma unroll 4
  for (int i = 0; i < 16; ++i) {
    const int nn = i * 4 + (tid >> 6), kk = tid & 63;
    int n = n0 + nn;
    if (n < N) {
      if (perm) { const int h = n / 96, d = n - h * 96; n = d < 64 ? h * 64 + d : 512 + h * 32 + (d - 64); }
      dst[(size_t)n * K + k0 + kk] = f2bf(tl[kk * 65 + nn]);
    }
  }
}

DI void phase_prep(const Params& p, char* smem) {
  LAUNDER_IDS
  float* tl = (float*)smem;
  const int tid = tid__;
  constexpr int T_WIN = 16 * 81, T_UQ = 6 * 12, T_UKV = 4 * 16, T_BRM = 8 * 16, T_BRR = 4 * 16, T_WO = 16 * 16, T_W1 = 16 * 64, T_W2 = 64 * 16,
                T_RW2 = 4, T_RA2 = 4, T_RG2 = 2 * 4;
  constexpr int T_LAYER = T_WIN + T_UQ + T_UKV + T_BRM + T_BRR + T_WO + T_W1 + T_W2 + 2 * T_RW2 + 2 * T_RA2 + T_RG2;
  for (int g = blk__; g < 2 * T_LAYER; g += gridDim.x) {
    const int l = g / T_LAYER; int t = g - l * T_LAYER;
    char* wl = p.ws + OFF_W + (size_t)l * W_LAYER;
#define JOB(SRC, KK, NN, DSTOFF, SC, PERM, CNT) if (t < (CNT)) { do_transpose((SRC), (KK), (NN), (u16*)(wl + (DSTOFF)), (SC), (PERM), t, tl); continue; } t -= (CNT);
    JOB(p.in[I_WIN] + (size_t)l * 1024 * INC, 1024, INC, WO_WIN, nullptr, 0, T_WIN)
    JOB(p.in[I_WUQ] + (size_t)l * 384 * 768, 384, 768, WO_UQ, p.in[I_QNORM] + l * 384, 1, T_UQ)
    JOB(p.in[I_WUKV] + (size_t)l * 256 * 1024, 256, 1024, WO_UKV, p.in[I_KVNORM] + l * 256, 0, T_UKV)
    JOB(p.in[I_BRM] + (size_t)l * 512 * 1024, 512, 1024, WO_BRM, nullptr, 0, T_BRM)
    JOB(p.in[I_BRR] + (size_t)l * 256 * 1024, 256, 1024, WO_BRR, nullptr, 0, T_BRR)
    JOB(p.in[I_WO] + (size_t)l * 1024 * 1024, 1024, 1024, WO_WO, nullptr, 0, T_WO)
    JOB(p.in[I_W1] + (size_t)l * 1024 * 4096, 1024, 4096, WO_W1, nullptr, 0, T_W1)
    JOB(p.in[I_W2] + (size_t)l * 4096 * 1024, 4096, 1024, WO_W2, nullptr, 0, T_W2)
    JOB(p.in[I_W2R] + (size_t)(l * 2 + 0) * 64 * 256, 64, 256, WO_RW2, nullptr, 0, T_RW2)
    JOB(p.in[I_W2R] + (size_t)(l * 2 + 1) * 64 * 256, 64, 256, WO_RW2 + 256 * 64 * 2, nullptr, 0, T_RW2)
    JOB(p.in[I_A2R] + (size_t)(l * 2 + 0) * 64 * 256, 64, 256, WO_RA2, nullptr, 0, T_RA2)
    JOB(p.in[I_A2R] + (size_t)(l * 2 + 1) * 64 * 256, 64, 256, WO_RA2 + 256 * 64 * 2, nullptr, 0, T_RA2)
    JOB(p.in[I_G2R] + (size_t)l * 128 * 256, 128, 256, WO_RG2, nullptr, 0, T_RG2)
#undef JOB
  }
  for (int e = blk__ * 256 + tid; e < 2 * 256 * 1024; e += gridDim.x * 256) {
    const int l = e >> 18, r = e & 262143, cin = r >> 10, n = r & 1023, g = cin >> 6, c = cin & 63;
    const float* pw = p.in[I_POOLW] + ((size_t)(l * 4 + g) * 64 + c) * 64;
    const float* ps = p.in[I_POOLS] + l * 256 + g * 64;
    const float* wb = p.in[I_BRP] + ((size_t)l * 256 + g * 64) * 1024 + n;
    float s = 0.f;
    for (int d = 0; d < 64; ++d) s += pw[d] * ps[d] * wb[(size_t)d * 1024];
    ((u16*)(p.ws + OFF_W + (size_t)l * W_LAYER + WO_BRP))[(size_t)n * 256 + cin] = f2bf(s);
  }
  if (blk__ == gridDim.x - 1) {
    for (int e = tid; e < 512; e += 256) {
      const int pos = e >> 3, f = e & 7;
      const float inv = powf(10000.f, -(float)f / 8.f);
      const float ang = (float)pos * inv;
      float* rt = (float*)(p.ws + OFF_ROPE);
      rt[e * 2] = cosf(ang); rt[e * 2 + 1] = sinf(ang);
    }
  }
  {
    float* sl = (float*)smem;
    float* red = sl + 9 * 1024;
    __syncthreads();
    for (int e = tid; e < 9 * 1024; e += 256) {
      const int b = e >> 10, k = e & 1023;
      const float v = b < 8 ? p.in[I_C][b * 1024 + k] : p.in[I_CCTX][k];
      sl[e] = siluf_(v);
    }
    __syncthreads();
    const int wave = tid >> 6, lane = tid & 63;
    for (int it = blk__; it < 192; it += gridDim.x) {
      const int l = it / 96, cg_ = it - l * 96;
      const int col = cg_ * 64 + lane;
      const float* wa = p.in[I_WADA] + (size_t)l * 1024 * 6144 + col;
      float acc[9];
#pragma unroll
      for (int b = 0; b < 9; ++b) acc[b] = 0.f;
#pragma unroll 8
      for (int k = wave * 256; k < wave * 256 + 256; ++k) {
        const float w = wa[(size_t)k * 6144];
#pragma unroll
        for (int b = 0; b < 9; ++b) acc[b] += sl[b * 1024 + k] * w;
      }
#pragma unroll
      for (int b = 0; b < 9; ++b) red[(wave * 9 + b) * 64 + lane] = acc[b];
      __syncthreads();
      for (int e = tid; e < 9 * 64; e += 256) {
        const int b = e >> 6, c = e & 63;
        const float s = red[(0 * 9 + b) * 64 + c] + red[(1 * 9 + b) * 64 + c] + red[(2 * 9 + b) * 64 + c] + red[(3 * 9 + b) * 64 + c];
        ((float*)(p.ws + OFF_MODS))[(size_t)(l * 9 + b) * 6144 + cg_ * 64 + c] = s + p.in[I_BADA][l * 6144 + cg_ * 64 + c];
      }
      __syncthreads();
    }
  }
}

DI const float* xrow(const float* xl, const float* xc, int r) { return r < NTL ? xl + (size_t)r * D : xc + (size_t)(r - NTL) * D; }

DI void phase_norm(const float* xl, const float* xc, const float* tab  , u16* hb, int M) {
  LAUNDER_IDS
  const int wave = tid__ >> 6, lane = tid__ & 63;
  for (int r = blk__ * 4 + wave; r < M; r += gridDim.x * 4) {
    const float* xp = xrow(xl, xc, r);
    const int b9 = r < NTL ? r >> 12 : 8;
    float4 v[4];
    float s = 0.f;
#pragma unroll
    for (int i = 0; i < 4; ++i) { v[i] = *(const float4*)(xp + i * 256 + lane * 4); s += v[i].x * v[i].x + v[i].y * v[i].y + v[i].z * v[i].z + v[i].w * v[i].w; }
    s = wavesum(s);
    const float rs = rsqrtf(s * (1.f / 1024.f) + 1e-6f);
    const float* t = tab + b9 * 2048;
#pragma unroll
    for (int i = 0; i < 4; ++i) {
      const int k = i * 256 + lane * 4;
      const float4 g = *(const float4*)(t + k), sh = *(const float4*)(t + 1024 + k);
      *(uint2*)(hb + (size_t)r * 1024 + k) = make_uint2(pack2(v[i].x * rs * g.x + sh.x, v[i].y * rs * g.y + sh.y), pack2(v[i].z * rs * g.z + sh.z, v[i].w * rs * g.w + sh.w));
    }
  }
}
DI void phase_tables(const Params& p) {
  LAUNDER_IDS
  const float* mods = (const float*)(p.ws + OFF_MODS);
  float* tab = (float*)(p.ws + OFF_TAB);
  for (int e = blk__ * 256 + tid__; e < 2 * 2 * 9 * 1024; e += gridDim.x * 256) {
    const int k = e & 1023, b9 = (e >> 10) % 9, ln = (e >> 10) / 9, l = ln >> 1, nrm = ln & 1;
    const float g = p.in[nrm ? I_N2G : I_N1G][l * 1024 + k];
    const float sh = mods[(size_t)(l * 9 + b9) * 6144 + (nrm * 3 + 0) * 1024 + k];
    const float sc = mods[(size_t)(l * 9 + b9) * 6144 + (nrm * 3 + 1) * 1024 + k];
    float* t = tab + ((size_t)(l * 2 + nrm) * 9 + b9) * 2048;
    t[k] = g * (1.f + sc); t[1024 + k] = sh;
  }
}

struct LoadBf16 {
  const u16* A; int lda;
  DI void init(int m0) {}
  DI uint4 load(int i, int m0, int k0) const {
    LAUNDER_IDS
    const int tid = tid__, kc = (tid & 7) * 8;
    return *(const uint4*)(A + (size_t)(m0 + (tid >> 3) + i * 32) * lda + k0 + kc);
  }
};
struct LoadNorm {
  const float* xl; const float* xc; const float* rs; const float* tab;
  float r0, r1, r2, r3;
  DI void init(int m0) {
    LAUNDER_IDS
    const int tid = tid__;
    r0 = rs[m0 + (tid >> 3)]; r1 = rs[m0 + (tid >> 3) + 32]; r2 = rs[m0 + (tid >> 3) + 64]; r3 = rs[m0 + (tid >> 3) + 96];
  }
  DI uint4 load(int i, int m0, int k0) const {
    LAUNDER_IDS
    const int tid = tid__, kc = (tid & 7) * 8;
    const int b9 = m0 < NTL ? m0 >> 12 : 8;
    const float* t = tab + b9 * 2048 + k0 + kc;
    const float4 g0 = *(const float4*)t, g1 = *(const float4*)(t + 4), s0 = *(const float4*)(t + 1024), s1 = *(const float4*)(t + 1028);
    const float* xp = xrow(xl, xc, m0 + (tid >> 3)) + k0 + kc + (size_t)i * 32 * D;
    const float4 x0 = *(const float4*)xp, x1 = *(const float4*)(xp + 4);
    const float rr = i == 0 ? r0 : i == 1 ? r1 : i == 2 ? r2 : r3;
    uint4 o;
    o.x = pack2(x0.x * rr * g0.x + s0.x, x0.y * rr * g0.y + s0.y);
    o.y = pack2(x0.z * rr * g0.z + s0.z, x0.w * rr * g0.w + s0.w);
    o.z = pack2(x1.x * rr * g1.x + s1.x, x1.y * rr * g1.y + s1.y);
    o.w = pack2(x1.z * rr * g1.z + s1.z, x1.w * rr * g1.w + s1.w);
    return o;
  }
};

DI bool tile_map(int it, int NTM, int NTN, int blk, int nblk, int& tm, int& tn) {
  const int xcd = blk & 7, local = blk >> 3, LB = nblk >> 3;
  const int R = NTM >> 3;
  const int s = it * LB + local;
  if (s >= R * NTN) return false;
  const int F = R >> 3, per_full = 8 * NTN;
  int mg, r, gm;
  if (s < F * per_full) { mg = s / per_full; r = s - mg * per_full; gm = 8; }
  else { mg = F; r = s - F * per_full; gm = R - F * 8; }
  const int ng = r / (gm * 8);
  const int r2 = r - ng * gm * 8;
  const int mi = r2 % gm, ni = r2 / gm;
  tm = xcd * R + mg * 8 + mi; tn = ng * 8 + ni;
  return true;
}
constexpr int LDT = 72;
template <int NI, class LA>
DI void gemm_mainloop(f32x4 (&acc)[4][NI], LA la, const u16* __restrict__ Bt, int ldb, int K, int m0, int n0, char* smem) {
  LAUNDER_IDS
  constexpr int NBI = NI;
  u16* As = (u16*)smem; u16* Bs = As + 2 * 128 * LDT;
  const int tid = tid__, lane = tid & 63, wave = tid >> 6, wr = wave >> 1, wc = wave & 1, lr = lane & 15, lq = lane >> 4;
  uint4 ra[4], rb[NBI];
  la.init(m0);
#pragma unroll
  for (int i = 0; i < 4; ++i) ra[i] = la.load(i, m0, 0);
#pragma unroll
  for (int i = 0; i < NBI; ++i) {
    const int c = tid + i * 256, row = c >> 3, kc = (c & 7) * 8;
    rb[i] = *(const uint4*)(Bt + (size_t)(n0 + row) * ldb + kc);
  }
#pragma unroll
  for (int i = 0; i < 4; ++i) {
    const int c = tid + i * 256, row = c >> 3, kc = (c & 7) * 8;
    *(uint4*)(As + row * LDT + kc) = ra[i];
    if (i < NBI) *(uint4*)(Bs + row * LDT + kc) = rb[i];
  }
  __syncthreads();
  const int nk = K >> 6;
  for (int kt = 0; kt < nk; ++kt) {
    const int cur = kt & 1;
    if (kt + 1 < nk) {
      const int k0 = (kt + 1) * 64;
#pragma unroll
      for (int i = 0; i < 4; ++i) ra[i] = la.load(i, m0, k0);
#pragma unroll
      for (int i = 0; i < NBI; ++i) {
        const int c = tid + i * 256, row = c >> 3, kc = (c & 7) * 8;
        rb[i] = *(const uint4*)(Bt + (size_t)(n0 + row) * ldb + k0 + kc);
      }
    }
    const u16* Ac = As + cur * 128 * LDT + (wr * 64 + lr) * LDT + lq * 8;
    const u16* Bc = Bs + cur * 128 * LDT + (wc * 16 * NI + lr) * LDT + lq * 8;
#pragma unroll
    for (int ks = 0; ks < 2; ++ks) {
      bf16x8 af[4], bfr[NI];
#pragma unroll
      for (int mi = 0; mi < 4; ++mi) af[mi] = *(const bf16x8*)(Ac + mi * 16 * LDT + ks * 32);
#pragma unroll
      for (int ni = 0; ni < NI; ++ni) bfr[ni] = *(const bf16x8*)(Bc + ni * 16 * LDT + ks * 32);
#pragma unroll
      for (int mi = 0; mi < 4; ++mi)
#pragma unroll
        for (int ni = 0; ni < NI; ++ni)
          acc[mi][ni] = __builtin_amdgcn_mfma_f32_16x16x32_bf16(bfr[ni], af[mi], acc[mi][ni], 0, 0, 0);
    }
    if (kt + 1 < nk) {
      const int nxt = cur ^ 1;
#pragma unroll
      for (int i = 0; i < 4; ++i) {
        const int c = tid + i * 256, row = c >> 3, kc = (c & 7) * 8;
        *(uint4*)(As + nxt * 128 * LDT + row * LDT + kc) = ra[i];
        if (i < NBI) *(uint4*)(Bs + nxt * 128 * LDT + row * LDT + kc) = rb[i];
      }
    }
    __syncthreads();
  }
}
template <int NI>
DI void zero_acc(f32x4 (&acc)[4][NI]) {
#pragma unroll
  for (int i = 0; i < 4; ++i)
#pragma unroll
    for (int j = 0; j < NI; ++j) acc[i][j] = f32x4{0.f, 0.f, 0.f, 0.f};
}
template <int NI>
DI void gemm256(f32x4 (&acc)[8][NI], const u16* __restrict__ A, int lda, const u16* __restrict__ Bt, int ldb, int K, int m0, int n0, char* smem) {
  LAUNDER_IDS
  const int lane = tid__ & 63, wave = tid__ >> 6, wr = wave >> 1, wc = wave & 1, lr = lane & 15, lq = lane >> 4;
  constexpr int NBW = NI / 2;
  constexpr int STAGE = 16384 + NI * 2 * 1024;
  constexpr int LPS = 4 + NBW;
  const int srow = lane >> 2, scol = ((lane & 3) ^ ((lane >> 5) << 1)) * 8;
  const u16* Ag = A + (size_t)(m0 + wave * 64 + srow) * lda + scol;
  const u16* Bg = Bt + (size_t)(n0 + wave * NBW * 16 + srow) * ldb + scol;
  char* la = smem + (wave * 4) * 1024 + lane * 16;
  char* lb = smem + 16384 + (wave * NBW) * 1024 + lane * 16;
#define G256_ISSUE(S, K0) do { \
    _Pragma("unroll") for (int j_ = 0; j_ < 4; ++j_) \
      __builtin_amdgcn_global_load_lds((const unsigned*)(Ag + (size_t)j_ * 16 * lda + (K0)), (__attribute__((address_space(3))) unsigned*)(la + (S) * STAGE + j_ * 1024), 16, 0, 0); \
    _Pragma("unroll") for (int j_ = 0; j_ < NBW; ++j_) \
      __builtin_amdgcn_global_load_lds((const unsigned*)(Bg + (size_t)j_ * 16 * ldb + (K0)), (__attribute__((address_space(3))) unsigned*)(lb + (S) * STAGE + j_ * 1024), 16, 0, 0); \
  } while (0)
  const int nk = K >> 5;
  G256_ISSUE(0, 0);
  if (nk > 1) G256_ISSUE(1, 32);
  const int foff = lr * 64 + ((lq ^ ((lr >> 3) << 1)) * 16);
  int st = 0;
  for (int kt = 0; kt < nk; ++kt) {
    if (kt + 1 < nk) asm volatile("s_waitcnt vmcnt(%0) lgkmcnt(0)" :: "n"(LPS) : "memory");
    else asm volatile("s_waitcnt vmcnt(0) lgkmcnt(0)" ::: "memory");
    __builtin_amdgcn_s_barrier();
    if (kt + 2 < nk) { const int s2 = st >= 1 ? st - 1 : 2; G256_ISSUE(s2, (kt + 2) * 32); }
    const char* sb = smem + st * STAGE + foff;
    bf16x8 af[8], bfr[NI];
#pragma unroll
    for (int mi = 0; mi < 8; ++mi) af[mi] = *(const bf16x8*)(sb + (wr * 8 + mi) * 1024);
#pragma unroll
    for (int ni = 0; ni < NI; ++ni) bfr[ni] = *(const bf16x8*)(sb + 16384 + (wc * NI + ni) * 1024);
#pragma unroll
    for (int mi = 0; mi < 8; ++mi)
#pragma unroll
      for (int ni = 0; ni < NI; ++ni)
        acc[mi][ni] = __builtin_amdgcn_mfma_f32_16x16x32_bf16(bfr[ni], af[mi], acc[mi][ni], 0, 0, 0);
    st = st == 2 ? 0 : st + 1;
  }
  asm volatile("s_waitcnt lgkmcnt(0)" ::: "memory");
  __builtin_amdgcn_s_barrier();
#undef G256_ISSUE
}
template <int NI>
DI void zero_acc8(f32x4 (&acc)[8][NI]) {
#pragma unroll
  for (int i = 0; i < 8; ++i)
#pragma unroll
    for (int j = 0; j < NI; ++j) acc[i][j] = f32x4{0.f, 0.f, 0.f, 0.f};
}
#define WAVE_COORDS const int lane = tid__ & 63, wave = tid__ >> 6, wr = wave >> 1, wc = wave & 1, lr = lane & 15, lq = lane >> 4; (void)wr; (void)wc; (void)lr; (void)lq;

DI void phase_zgemm(const Params& p, int l, char* smem) {
  LAUNDER_IDS
  WAVE_COORDS
  const u16* Wt = (const u16*)(p.ws + OFF_W + (size_t)l * W_LAYER + WO_WIN);
  const u16* hb = (const u16*)(p.ws + OFF_HB1);
  u16* za = (u16*)(p.ws + OFF_R2); u16* zr = (u16*)(p.ws + OFF_R1);
  for (int it = 0;; ++it) {
    int tm, tn;
    if (!tile_map(it, NT / 256, 17, blk__, gridDim.x, tm, tn)) break;
    const int m0 = tm * 256, n0 = tn * 128;
    f32x4 acc[8][4]; zero_acc8<4>(acc);
    gemm256<4>(acc, hb, 1024, Wt, 1024, 1024, m0, n0, smem);
#pragma unroll
    for (int mi = 0; mi < 8; ++mi) {
      const int m = m0 + wr * 128 + mi * 16 + lr;
#pragma unroll
      for (int ni = 0; ni < 4; ++ni) {
        const int n = n0 + wc * 64 + ni * 16 + lq * 4;
        uint2 v; v.x = pack2(acc[mi][ni][0], acc[mi][ni][1]); v.y = pack2(acc[mi][ni][2], acc[mi][ni][3]);
        if (n < ZA) *(uint2*)(za + (size_t)m * ZA + n) = v;
        else if (n < ZA + ZR) *(uint2*)(zr + (size_t)m * ZR + (n - ZA)) = v;
      }
    }
  }
}

DI void phase_tokA(const Params& p, int l) {
  LAUNDER_IDS
  const int wave = tid__ >> 6, lane = tid__ & 63;
  const u16* za = (const u16*)(p.ws + OFF_R2);
  float* rsq = (float*)(p.ws + OFF_RSQ); float* rskv = (float*)(p.ws + OFF_RSKV);
  u16* krb = (u16*)(p.ws + OFF_KR);
  u16* pooled = (u16*)(p.ws + OFF_R4);
  const float* rt = (const float*)(p.ws + OFF_ROPE);
  const float* gk = p.in[I_GK] + l * 96;
  for (int r = blk__ * 4 + wave; r < NT; r += gridDim.x * 4) {
    const u16* z = za + (size_t)r * ZA;
    const bool lat = r < NTL;
    const int b = lat ? r >> 12 : (r - NTL) >> 8;
    const int t = lat ? r & 4095 : (r - NTL) & 255;
    const int Ls = lat ? L : LC;
    const int pos = lat ? t : 4096 + t;
    float sq = 0.f, skv = 0.f;
#pragma unroll
    for (int i = 0; i < 6; ++i) { const float v = bf2f(z[256 + i * 64 + lane]); sq += v * v; }
#pragma unroll
    for (int i = 0; i < 4; ++i) { const float v = bf2f(z[640 + i * 64 + lane]); skv += v * v; }
    sq = wavesum(sq); skv = wavesum(skv);
    if (lane == 0) { rsq[r] = rsqrtf(sq * (1.f / 384.f) + 1e-6f); rskv[r] = rsqrtf(skv * (1.f / 256.f) + 1e-6f); }
    {
      const int d = lane & 31;
      float kr = bf2f(z[896 + d]);
      float ss = kr * kr;
      for (int o = 16; o > 0; o >>= 1) ss += __shfl_xor(ss, o, 64);
      kr = kr * rsqrtf(ss * (1.f / 32.f) + 1e-6f) * gk[64 + d];
      const float other = __shfl_xor(kr, 16, 64);
      float outv = kr;
      if (lat) {
        const int i = d & 15;
        const int pp = i < 8 ? (t >> 6) : (t & 63);
        const float cs = rt[(pp * 8 + (i & 7)) * 2], sn = rt[(pp * 8 + (i & 7)) * 2 + 1];
        outv = d < 16 ? kr * cs - other * sn : other * sn + kr * cs;
      }
      if (lane < 32) krb[(size_t)r * 32 + d] = f2bf(outv);
    }
#pragma unroll
    for (int gi = 0; gi < 4; ++gi) {
      const int half = 1 << gi;
      const int lo = max(t - half, 0), hi = min(t + half, Ls);
      const int ch = gi * 64 + lane;
      float s = 0.f;
      for (int q = lo; q < hi; ++q) s += bf2f(z[(ptrdiff_t)(q - t) * ZA + ch]);
      const float mean = s / (float)(hi - lo);
      pooled[(size_t)r * 256 + ch] = f2bf(mean - bf2f(z[ch]));
    }
  }
}

constexpr int ZSL = 1160, TAL = 392;
DI void phase_tokB(const Params& p, int l, char* smem) {
  LAUNDER_IDS
  WAVE_COORDS
  const int tid = tid__;
  u16* Zs = (u16*)smem;
  u16* TA = Zs + 18 * ZSL;
  const u16* zr = (const u16*)(p.ws + OFF_R1);
  const char* wl = p.ws + OFF_W + (size_t)l * W_LAYER;
  const float* mu0 = p.in[I_MU] + (size_t)(l * 2 + 0) * ZR;
  const float* mu1 = p.in[I_MU] + (size_t)(l * 2 + 1) * ZR;
  u16* sc = (u16*)(p.ws + OFF_R3);
  for (int tile = blk__; tile < NT / 16; tile += gridDim.x) {
    const int r0 = tile * 16;
    const bool lat = r0 < NTL;
    const int t0 = lat ? r0 & 4095 : (r0 - NTL) & 255;
    const int Ls = lat ? L : LC;
    __syncthreads();
    for (int c = tid; c < 18 * 144; c += 256) {
      const int i = c / 144, ch = c - i * 144;
      const int tt = t0 - 1 + i;
      uint4 v = make_uint4(0, 0, 0, 0);
      if (tt >= 0 && tt < Ls) v = *(const uint4*)(zr + (size_t)(r0 - 1 + i) * ZR + ch * 8);
      *(uint2*)(Zs + i * ZSL + ch * 8) = make_uint2(v.x, v.y);
      *(uint2*)(Zs + i * ZSL + ch * 8 + 4) = make_uint2(v.z, v.w);
    }
    __syncthreads();
    for (int e = tid; e < 16 * 384; e += 256) {
      const int i = e / 384, c = e - i * 384, zc = 768 + c;
      const float z = bf2f(Zs[(i + 1) * ZSL + zc]), zp = bf2f(Zs[i * ZSL + zc]), zn = bf2f(Zs[(i + 2) * ZSL + zc]);
      float v = z + mu0[zc] * (zp - z) + mu1[zc] * (zn - z);
      if (c < 128) v = 1.f - 2.f / (1.f + __expf(2.f * v)); else if (c >= 256) v = sigmoidf_(v);
      TA[i * TAL + c] = f2bf(v);
    }
    __syncthreads();
    const int row = r0 + lr;
    auto shifted4 = [&](int zc, float (&out)[4]) {
      const uint2 c0 = *(const uint2*)(Zs + (lr + 1) * ZSL + zc), cp = *(const uint2*)(Zs + lr * ZSL + zc), cn = *(const uint2*)(Zs + (lr + 2) * ZSL + zc);
      const float4 m0 = *(const float4*)(mu0 + zc), m1 = *(const float4*)(mu1 + zc);
      float z, zp, zn;
      z = bflo(c0.x); zp = bflo(cp.x); zn = bflo(cn.x); out[0] = z + m0.x * (zp - z) + m1.x * (zn - z);
      z = bfhi(c0.x); zp = bfhi(cp.x); zn = bfhi(cn.x); out[1] = z + m0.y * (zp - z) + m1.y * (zn - z);
      z = bflo(c0.y); zp = bflo(cp.y); zn = bflo(cn.y); out[2] = z + m0.z * (zp - z) + m1.z * (zn - z);
      z = bfhi(c0.y); zp = bfhi(cp.y); zn = bfhi(cn.y); out[3] = z + m0.w * (zp - z) + m1.w * (zn - z);
    };
    auto product = [&](f32x4 (&ac)[4], const u16* W, int Kq, int off) {
#pragma unroll
      for (int ni = 0; ni < 4; ++ni) ac[ni] = f32x4{0.f, 0.f, 0.f, 0.f};
#pragma unroll 1
      for (int ks = 0; ks < Kq / 32; ++ks) {
        const bf16x8 bop = *(const bf16x8*)(TA + lr * TAL + off + ks * 32 + lq * 8);
#pragma unroll
        for (int ni = 0; ni < 4; ++ni) {
          const bf16x8 aop = *(const bf16x8*)(W + (size_t)(wave * 64 + ni * 16 + lr) * Kq + ks * 32 + lq * 8);
          ac[ni] = __builtin_amdgcn_mfma_f32_16x16x32_bf16(aop, bop, ac[ni], 0, 0, 0);
        }
        __builtin_amdgcn_sched_barrier(0);
      }
    };
    float ss = 0.f;
#pragma unroll
    for (int ni = 0; ni < 4; ++ni) {
      const int ch = wave * 64 + ni * 16 + lq * 4;
      float kx[4]; shifted4(256 + ch, kx);
      const float4 kw = *(const float4*)(p.in[I_KK] + l * 256 + ch);
      const float a0 = kx[0] * kw.x, a1 = kx[1] * kw.y, a2 = kx[2] * kw.z, a3 = kx[3] * kw.w;
      ss += a0 * a0 + a1 * a1 + a2 * a2 + a3 * a3;
      __builtin_amdgcn_sched_barrier(0);
    }
    ss += __shfl_xor(ss, 16, 64); ss += __shfl_xor(ss, 32, 64);
    const float kinv = rsqrtf(fmaxf(ss, 1e-24f));
    {
      f32x4 ag[4];
      product(ag, (const u16*)(wl + WO_RG2), 128, 256);
#pragma unroll
      for (int ni = 0; ni < 4; ++ni) {
        const int ch = wave * 64 + ni * 16 + lq * 4;
        const size_t o = (size_t)row * 256 + ch;
        float rx[4], kx[4], vx[4];
        shifted4(ch, rx); shifted4(256 + ch, kx); shifted4(512 + ch, vx);
        const float4 kw = *(const float4*)(p.in[I_KK] + l * 256 + ch);
        *(uint2*)(sc + SA_R * (size_t)NT * 256 + o) = make_uint2(pack2(rx[0], rx[1]), pack2(rx[2], rx[3]));
        *(uint2*)(sc + SA_V * (size_t)NT * 256 + o) = make_uint2(pack2(vx[0], vx[1]), pack2(vx[2], vx[3]));
        *(uint2*)(sc + SA_KKN * (size_t)NT * 256 + o) = make_uint2(pack2(-kx[0] * kw.x * kinv, -kx[1] * kw.y * kinv), pack2(-kx[2] * kw.z * kinv, -kx[3] * kw.w * kinv));
        *(uint2*)(sc + SA_G * (size_t)NT * 256 + o) = make_uint2(pack2(ag[ni][0], ag[ni][1]), pack2(ag[ni][2], ag[ni][3]));
        __builtin_amdgcn_sched_barrier(0);
      }
    }
#pragma unroll 1
    for (int d = 0; d < 2; ++d) {
      f32x4 aw[4], aa[4];
      product(aw, (const u16*)(wl + WO_RW2) + (size_t)d * 256 * 64, 64, d * 64);
      product(aa, (const u16*)(wl + WO_RA2) + (size_t)d * 256 * 64, 64, 128 + d * 64);
      __builtin_amdgcn_sched_barrier(0);
      u16* oOMW = sc + (d ? SA_OMWB : SA_OMWF) * (size_t)NT * 256;
      u16* oKD = sc + (d ? SA_KDB : SA_KDF) * (size_t)NT * 256;
      u16* oB = sc + (d ? SA_BB : SA_BF) * (size_t)NT * 256;
#pragma unroll
      for (int ni = 0; ni < 4; ++ni) {
        const int ch = wave * 64 + ni * 16 + lq * 4;
        const size_t o = (size_t)row * 256 + ch;
        float kx[4]; shifted4(256 + ch, kx);
        const float4 kw = *(const float4*)(p.in[I_KK] + l * 256 + ch);
        const float kkn[4] = {kx[0] * kw.x * kinv, kx[1] * kw.y * kinv, kx[2] * kw.z * kinv, kx[3] * kw.w * kinv};
        const float4 w0 = *(const float4*)(p.in[I_W0] + (size_t)(l * 2 + d) * 256 + ch);
        const float4 a0 = *(const float4*)(p.in[I_A0] + (size_t)(l * 2 + d) * 256 + ch);
        const float4 ka = *(const float4*)(p.in[I_KA] + (size_t)(l * 2 + d) * 256 + ch);
        const float w0a[4] = {w0.x, w0.y, w0.z, w0.w}, a0a[4] = {a0.x, a0.y, a0.z, a0.w}, kaa[4] = {ka.x, ka.y, ka.z, ka.w};
        float omw[4], kd[4], bb[4];
#pragma unroll
        for (int j = 0; j < 4; ++j) {
          const float xw = -(w0a[j] + aw[ni][j]);
          const float sp = fmaxf(xw, 0.f) + __logf(1.f + __expf(-fabsf(xw)));
          const float wlog = -sp - 0.5f;
          const float e = __expf(wlog);
          omw[j] = 1.f - __expf(-e);
          const float a = sigmoidf_(a0a[j] + aa[ni][j]);
          kd[j] = kx[j] * (1.f + (a - 1.f) * kaa[j]);
          bb[j] = kkn[j] * a;
        }
        *(uint2*)(oOMW + o) = make_uint2(pack2(omw[0], omw[1]), pack2(omw[2], omw[3]));
        *(uint2*)(oKD + o) = make_uint2(pack2(kd[0], kd[1]), pack2(kd[2], kd[3]));
        *(uint2*)(oB + o) = make_uint2(pack2(bb[0], bb[1]), pack2(bb[2], bb[3]));
        __builtin_amdgcn_sched_barrier(0);
      }
    }
  }
}

DI size_t qk_index(int m, int h) {
  const bool lat = m < NTL;
  const int b = lat ? m >> 12 : (m - NTL) >> 8;
  const int pos = lat ? m & 4095 : 4096 + ((m - NTL) & 255);
  return ((size_t)(b * 8 + h) * LK + pos) * 96;
}
DI void phase_qkv(const Params& p, int l, char* smem) {
  LAUNDER_IDS
  WAVE_COORDS
  const char* wl = p.ws + OFF_W + (size_t)l * W_LAYER;
  const u16* za = (const u16*)(p.ws + OFF_R2);
  const float* rsq0 = (const float*)(p.ws + OFF_RSQ); const float* rskv0 = (const float*)(p.ws + OFF_RSKV);
  u16* Qb = (u16*)(p.ws + OFF_R1); u16* Kb = (u16*)(p.ws + OFF_R1 + SZ_Q); u16* Vt = (u16*)(p.ws + OFF_R1 + 2 * SZ_Q);
  const float* rt0 = (const float*)(p.ws + OFF_ROPE);
  const float* gq0 = p.in[I_GQ] + l * 96; const float* gk0 = p.in[I_GK] + l * 96;
  const float QS = 0.10206207261596577f * 1.4426950408889634f;
  constexpr int NTM = NT / 256;
  for (int it = 0;; ++it) {
    int tm, tn;
    if (!tile_map(it, NTM, 6, blk__, gridDim.x, tm, tn)) break;
    f32x4 acc[8][4]; zero_acc8<4>(acc);
    {
      const int m0 = tm * 256, n0 = tn * 128;
      gemm256<4>(acc, za + 256, ZA, (const u16*)(wl + WO_UQ), 384, 384, m0, n0, smem);
      const float* gq = gq0; const float* rt = rt0; const float* rsq = rsq0;
      asm volatile("" : "+v"(gq), "+v"(rt), "+v"(rsq));
      const int nw = n0 + wc * 64;
#pragma unroll
      for (int mi = 0; mi < 8; ++mi) {
        __builtin_amdgcn_sched_barrier(0);
        const int m = m0 + wr * 128 + mi * 16 + lr;
        const float rs = rsq[m];
        if (nw < 512) {
          const int h = nw >> 6;
          float ss = 0.f;
#pragma unroll
          for (int ni = 0; ni < 4; ++ni)
#pragma unroll
            for (int j = 0; j < 4; ++j) { const float v = acc[mi][ni][j] * rs; ss += v * v; }
          ss += __shfl_xor(ss, 16, 64); ss += __shfl_xor(ss, 32, 64);
          const float f = rs * rsqrtf(ss * (1.f / 64.f) + 1e-6f) * QS;
          u16* dst = Qb + qk_index(m, h);
#pragma unroll
          for (int ni = 0; ni < 4; ++ni) {
            const int d = ni * 16 + lq * 4;
            const float4 g = *(const float4*)(gq + d);
            *(uint2*)(dst + d) = make_uint2(pack2(acc[mi][ni][0] * f * g.x, acc[mi][ni][1] * f * g.y), pack2(acc[mi][ni][2] * f * g.z, acc[mi][ni][3] * f * g.w));
          }
        } else {
          const bool lat = m < NTL;
          const int tt = m & 4095;
#pragma unroll
          for (int hh = 0; hh < 2; ++hh) {
            __builtin_amdgcn_sched_barrier(0);
            const int h = ((nw - 512) >> 5) + hh;
            float ss = 0.f;
#pragma unroll
            for (int ni = 0; ni < 2; ++ni)
#pragma unroll
              for (int j = 0; j < 4; ++j) { const float v = acc[mi][hh * 2 + ni][j] * rs; ss += v * v; }
            ss += __shfl_xor(ss, 16, 64); ss += __shfl_xor(ss, 32, 64);
            const float f = rs * rsqrtf(ss * (1.f / 32.f) + 1e-6f) * QS;
            const int i0 = lq * 4;
            const float4 g1 = *(const float4*)(gq + 64 + i0), g2 = *(const float4*)(gq + 80 + i0);
            const float g1a[4] = {g1.x, g1.y, g1.z, g1.w}, g2a[4] = {g2.x, g2.y, g2.z, g2.w};
            float o1[4], o2[4];
#pragma unroll
            for (int j = 0; j < 4; ++j) {
              const float x1 = acc[mi][hh * 2][j] * f * g1a[j], x2 = acc[mi][hh * 2 + 1][j] * f * g2a[j];
              float cs = 1.f, sn = 0.f;
              if (lat) {
                const int i = i0 + j;
                const int pp = i < 8 ? (tt >> 6) : (tt & 63);
                cs = rt[(pp * 8 + (i & 7)) * 2]; sn = rt[(pp * 8 + (i & 7)) * 2 + 1];
              }
              o1[j] = x1 * cs - x2 * sn; o2[j] = x1 * sn + x2 * cs;
            }
            u16* dst = Qb + qk_index(m, h) + 64;
            *(uint2*)(dst + i0) = make_uint2(pack2(o1[0], o1[1]), pack2(o1[2], o1[3]));
            *(uint2*)(dst + 16 + i0) = make_uint2(pack2(o2[0], o2[1]), pack2(o2[2], o2[3]));
          }
        }
      }
    }
  }
  __builtin_amdgcn_sched_barrier(0);
  for (int it = 0;; ++it) {
    int tm, tn;
    if (!tile_map(it, NTM, 8, blk__, gridDim.x, tm, tn)) break;
    f32x4 acc[8][4]; zero_acc8<4>(acc);
    {
      const int h = tn, m0 = tm * 256, n0 = h * 128;
      gemm256<4>(acc, za + 640, ZA, (const u16*)(wl + WO_UKV), 256, 256, m0, n0, smem);
      const float* gk = gk0; const float* rskv = rskv0;
      asm volatile("" : "+v"(gk), "+v"(rskv));
#pragma unroll
      for (int mi = 0; mi < 8; ++mi) {
        __builtin_amdgcn_sched_barrier(0);
        const int m = m0 + wr * 128 + mi * 16 + lr;
        const float rs = rskv[m];
        if (wc == 0) {
          float ss = 0.f;
#pragma unroll
          for (int ni = 0; ni < 4; ++ni)
#pragma unroll
            for (int j = 0; j < 4; ++j) { const float v = acc[mi][ni][j] * rs; ss += v * v; }
          ss += __shfl_xor(ss, 16, 64); ss += __shfl_xor(ss, 32, 64);
          const float f = rs * rsqrtf(ss * (1.f / 64.f) + 1e-6f);
          u16* dst = Kb + qk_index(m, h);
#pragma unroll
          for (int ni = 0; ni < 4; ++ni) {
            const int d = ni * 16 + lq * 4;
            const float4 g = *(const float4*)(gk + d);
            *(uint2*)(dst + d) = make_uint2(pack2(acc[mi][ni][0] * f * g.x, acc[mi][ni][1] * f * g.y), pack2(acc[mi][ni][2] * f * g.z, acc[mi][ni][3] * f * g.w));
          }
          *(uint4*)(dst + 64 + lq * 8) = *(const uint4*)((const u16*)(p.ws + OFF_KR) + (size_t)m * 32 + lq * 8);
        } else {
          const bool lat = m < NTL;
          const int b = lat ? m >> 12 : (m - NTL) >> 8;
          const int pos = lat ? m & 4095 : 4096 + ((m - NTL) & 255);
          u16* dst = Vt + (size_t)(b * 8 + h) * 64 * LK + pos + (size_t)(lq * 4) * LK;
#pragma unroll
          for (int ni = 0; ni < 4; ++ni) {
            asm volatile("" : "+v"(dst));
#pragma unroll
            for (int j = 0; j < 4; ++j) dst[j * LK] = f2bf(acc[mi][ni][j] * rs);
            dst += 16 * LK;
          }
        }
      }
    }
  }
}

DI int scan_row(int b, int dir, int s) {
  if (s < LC) return NTL + b * LC + (dir ? LC - 1 - s : s);
  const int t = s - LC;
  return b * L + (dir ? L - 1 - t : t);
}
DI void phase_scan(const Params& p, char* smem) {
  LAUNDER_IDS
  const int blk = blk__;
  if (blk >= 256) return;
  const int tid = tid__, lane = tid & 63, wave = tid >> 6, kq = lane & 15, rg = lane >> 4;
  const int chain = (blk & 7) + 8 * (blk >> 5), quarter = (blk >> 3) & 3;
  const int b = chain >> 3, h = (chain >> 1) & 3, dir = chain & 1;
  const u16* sc = (const u16*)(p.ws + OFF_R3);
  const size_t AS = (size_t)NT * 256;
  const u16* aOMW = sc + (dir ? SA_OMWB : SA_OMWF) * AS;
  const u16* aKD = sc + (dir ? SA_KDB : SA_KDF) * AS;
  const u16* aB = sc + (dir ? SA_BB : SA_BF) * AS;
  const u16* aKKN = sc + SA_KKN * AS;
  const u16* aR = sc + SA_R * AS;
  const u16* aV = sc + SA_V * AS;
  u16* Y = (u16*)(p.ws + OFF_R2) + (dir ? AS : 0);
  constexpr int CH = 16, BSZ = 5 * CH * 64 + CH * 16;
  float* buf = (float*)smem;
  const int st_ld = tid >> 4, k4 = (tid & 15) * 4;
  const int vrow = quarter * 16 + wave * 4 + rg;
  uint2 g0, g1, g2, g3, g4; u16 gv;
#define SCAN_GLOAD(CHUNK) do { \
    const int row_ = scan_row(b, dir, (CHUNK) * CH + st_ld); \
    const size_t o_ = (size_t)row_ * 256 + h * 64 + k4; \
    g0 = *(const uint2*)(aOMW + o_); g1 = *(const uint2*)(aKD + o_); g2 = *(const uint2*)(aB + o_); g3 = *(const uint2*)(aKKN + o_); g4 = *(const uint2*)(aR + o_); \
    gv = aV[(size_t)row_ * 256 + h * 64 + quarter * 16 + (tid & 15)]; } while (0)
#define SCAN_LSTORE(BI) do { \
    float* bb_ = buf + (BI) * BSZ + st_ld * 64 + k4; \
    *(float4*)(bb_ + 0 * CH * 64) = make_float4(1.f - bflo(g0.x), 1.f - bfhi(g0.x), 1.f - bflo(g0.y), 1.f - bfhi(g0.y)); \
    *(float4*)(bb_ + 1 * CH * 64) = make_float4(bflo(g1.x), bfhi(g1.x), bflo(g1.y), bfhi(g1.y)); \
    *(float4*)(bb_ + 2 * CH * 64) = make_float4(bflo(g2.x), bfhi(g2.x), bflo(g2.y), bfhi(g2.y)); \
    *(float4*)(bb_ + 3 * CH * 64) = make_float4(bflo(g3.x), bfhi(g3.x), bflo(g3.y), bfhi(g3.y)); \
    *(float4*)(bb_ + 4 * CH * 64) = make_float4(bflo(g4.x), bfhi(g4.x), bflo(g4.y), bfhi(g4.y)); \
    buf[(BI) * BSZ + 5 * CH * 64 + st_ld * 16 + (tid & 15)] = bf2f(gv); } while (0)
  float2_t S01 = {0.f, 0.f}, S23 = {0.f, 0.f};
  __builtin_amdgcn_s_setprio(3);
  __syncthreads();
  SCAN_GLOAD(0); SCAN_LSTORE(0);
  __syncthreads();
  constexpr int NCH = LK / CH;
  for (int c = 0; c < NCH; ++c) {
    if (c + 1 < NCH) SCAN_GLOAD(c + 1);
    const float* bb = buf + (c & 1) * BSZ;
    const int rowbase = scan_row(b, dir, c * CH);
    const int rstep = dir ? -1 : 1;
    const float* bl = bb + kq * 4;
    const float* bv = bb + 5 * CH * 64 + wave * 4 + rg;
    float4 fw = *(const float4*)(bl + 0 * CH * 64), fk = *(const float4*)(bl + 1 * CH * 64), fb = *(const float4*)(bl + 2 * CH * 64),
           fa = *(const float4*)(bl + 3 * CH * 64), fr = *(const float4*)(bl + 4 * CH * 64);
    float vv = bv[0];
    float ysel = 0.f;
#pragma unroll
    for (int s = 0; s < CH; ++s) {
      const float2_t a01 = {fa.x, fa.y}, a23 = {fa.z, fa.w};
      const float2_t w01 = {fw.x, fw.y}, w23 = {fw.z, fw.w}, k01 = {fk.x, fk.y}, k23 = {fk.z, fk.w}, b01 = {fb.x, fb.y}, b23 = {fb.z, fb.w};
      const float2_t r01 = {fr.x, fr.y}, r23 = {fr.z, fr.w};
      const float2_t vv2 = {vv, vv};
      if (s + 1 < CH) {
        fw = *(const float4*)(bl + 0 * CH * 64 + (s + 1) * 64); fk = *(const float4*)(bl + 1 * CH * 64 + (s + 1) * 64); fb = *(const float4*)(bl + 2 * CH * 64 + (s + 1) * 64);
        fa = *(const float4*)(bl + 3 * CH * 64 + (s + 1) * 64); fr = *(const float4*)(bl + 4 * CH * 64 + (s + 1) * 64);
        vv = bv[(s + 1) * 16];
      }
      float2_t t2 = S01 * a01; t2 = S23 * a23 + t2;
      const float sa = rowsum16(t2.x + t2.y);
      const float2_t sa2 = {sa, sa};
      float2_t u01 = vv2 * k01; u01 = sa2 * b01 + u01; S01 = S01 * w01 + u01;
      float2_t u23 = vv2 * k23; u23 = sa2 * b23 + u23; S23 = S23 * w23 + u23;
      float2_t y2 = S01 * r01; y2 = S23 * r23 + y2;
      const float y = rowsum16(y2.x + y2.y);
      ysel = (kq == s) ? y : ysel;
    }
    Y[(size_t)(rowbase + rstep * kq) * 256 + h * 64 + vrow] = f2bf(ysel);
    if (c + 1 < NCH) SCAN_LSTORE((c + 1) & 1);
    __syncthreads();
  }
  __builtin_amdgcn_s_setprio(0);
#undef SCAN_GLOAD
#undef SCAN_LSTORE
}

constexpr int KSL = 104, VSL = 68;
template <int B0>
DI bf16x8 pack8(const f32x16& v) {
  uint4 pw;
  pw.x = pack2(v[B0 + 0], v[B0 + 1]); pw.y = pack2(v[B0 + 2], v[B0 + 3]); pw.z = pack2(v[B0 + 4], v[B0 + 5]); pw.w = pack2(v[B0 + 6], v[B0 + 7]);
  return __builtin_bit_cast(bf16x8, pw);
}
DI void pv_step(f32x16& o0, f32x16& o1, const u16* Vc, int r32, int kb, bf16x8 pf) {
  {
    const uint2 lo = *(const uint2*)(Vc + r32 * VSL + kb), hi2 = *(const uint2*)(Vc + r32 * VSL + kb + 8);
    const bf16x8 va = __builtin_bit_cast(bf16x8, make_uint4(lo.x, lo.y, hi2.x, hi2.y));
    o0 = __builtin_amdgcn_mfma_f32_32x32x16_bf16(va, pf, o0, 0, 0, 0);
  }
  {
    const uint2 lo = *(const uint2*)(Vc + (32 + r32) * VSL + kb), hi2 = *(const uint2*)(Vc + (32 + r32) * VSL + kb + 8);
    const bf16x8 va = __builtin_bit_cast(bf16x8, make_uint4(lo.x, lo.y, hi2.x, hi2.y));
    o1 = __builtin_amdgcn_mfma_f32_32x32x16_bf16(va, pf, o1, 0, 0, 0);
  }
}
DI void attn_item(const Params& p, int item, char* smem) {
  LAUNDER_IDS
  const int tid = tid__, lane = tid & 63, wave = tid >> 6, r32 = lane & 31, hi = lane >> 5;
  int bh, qpos0, key0, nkt, orow0;
  if (item < 2048) { bh = item >> 5; const int qb = item & 31; qpos0 = qb * 128; key0 = 0; nkt = LK / 64; orow0 = (bh >> 3) * L + qpos0; }
  else { const int it = item - 2048; bh = it >> 1; const int qb = it & 1; qpos0 = 4096 + qb * 128; key0 = 4096; nkt = LC / 64; orow0 = NTL + (bh >> 3) * LC + qb * 128; }
  const int h = bh & 7;
  const u16* Qp = (const u16*)(p.ws + OFF_R1) + ((size_t)bh * LK + qpos0 + wave * 32 + r32) * 96 + hi * 8;
  const u16* Kp = (const u16*)(p.ws + OFF_R1 + SZ_Q) + ((size_t)bh * LK + key0) * 96;
  const u16* Vp = (const u16*)(p.ws + OFF_R1 + 2 * SZ_Q) + (size_t)bh * 64 * LK + key0;
  u16* Ks = (u16*)smem;
  u16* Vs = Ks + 2 * 64 * KSL;
  bf16x8 qr[6];
#pragma unroll
  for (int d0 = 0; d0 < 6; ++d0) qr[d0] = *(const bf16x8*)(Qp + d0 * 16);
  uint4 sk0, sk1, sk2, sv0, sv1;
  const int kr0 = tid / 12, kc0 = tid - kr0 * 12, kr1 = (tid + 256) / 12, kc1 = (tid + 256) - kr1 * 12, kr2 = (tid + 512) / 12, kc2 = (tid + 512) - kr2 * 12;
  const int vd0 = tid >> 3, vc0 = tid & 7, vd1 = vd0 + 32;
#define gload(kt) do { \
    sk0 = *(const uint4*)(Kp + (size_t)((kt) * 64 + kr0) * 96 + kc0 * 8); sk1 = *(const uint4*)(Kp + (size_t)((kt) * 64 + kr1) * 96 + kc1 * 8); \
    sk2 = *(const uint4*)(Kp + (size_t)((kt) * 64 + kr2) * 96 + kc2 * 8); \
    sv0 = *(const uint4*)(Vp + (size_t)vd0 * LK + (kt) * 64 + vc0 * 8); sv1 = *(const uint4*)(Vp + (size_t)vd1 * LK + (kt) * 64 + vc0 * 8); } while (0)
#define lstore(bi) do { \
    *(uint4*)(Ks + (bi) * 64 * KSL + kr0 * KSL + kc0 * 8) = sk0; *(uint4*)(Ks + (bi) * 64 * KSL + kr1 * KSL + kc1 * 8) = sk1; *(uint4*)(Ks + (bi) * 64 * KSL + kr2 * KSL + kc2 * 8) = sk2; \
    { u16* dst = Vs + (bi) * 64 * VSL + vd0 * VSL + vc0 * 8; *(uint2*)dst = make_uint2(sv0.x, sv0.y); *(uint2*)(dst + 4) = make_uint2(sv0.z, sv0.w); } \
    { u16* dst = Vs + (bi) * 64 * VSL + vd1 * VSL + vc0 * 8; *(uint2*)dst = make_uint2(sv1.x, sv1.y); *(uint2*)(dst + 4) = make_uint2(sv1.z, sv1.w); } } while (0)
  f32x16 o0, o1;
#pragma unroll
  for (int i = 0; i < 16; ++i) { o0[i] = 0.f; o1[i] = 0.f; }
  float mrun = -1e30f, lrun = 0.f;
  __syncthreads();
  gload(0); lstore(0);
  __syncthreads();
  for (int kt = 0; kt < nkt; ++kt) {
    const int cur = kt & 1;
    if (kt + 1 < nkt) gload(kt + 1);
    const u16* Kc = Ks + cur * 64 * KSL;
    const u16* Vc = Vs + cur * 64 * VSL;
    f32x16 p0, p1;
#pragma unroll
    for (int i = 0; i < 16; ++i) { p0[i] = 0.f; p1[i] = 0.f; }
#pragma unroll
    for (int d0 = 0; d0 < 6; ++d0) {
      const bf16x8 a0 = *(const bf16x8*)(Kc + r32 * KSL + d0 * 16 + hi * 8);
      const bf16x8 a1 = *(const bf16x8*)(Kc + (32 + r32) * KSL + d0 * 16 + hi * 8);
      p0 = __builtin_amdgcn_mfma_f32_32x32x16_bf16(a0, qr[d0], p0, 0, 0, 0);
      p1 = __builtin_amdgcn_mfma_f32_32x32x16_bf16(a1, qr[d0], p1, 0, 0, 0);
    }
    float mx = p0[0];
#pragma unroll
    for (int i = 1; i < 16; ++i) mx = fmaxf(mx, p0[i]);
#pragma unroll
    for (int i = 0; i < 16; ++i) mx = fmaxf(mx, p1[i]);
    mx = fmaxf(mx, __shfl_xor(mx, 32, 64));
    if (!__all(mx - mrun <= 8.f)) {
      const float mn = fmaxf(mrun, mx);
      const float alpha = __builtin_amdgcn_exp2f(mrun - mn);
      mrun = mn; lrun *= alpha;
#pragma unroll
      for (int i = 0; i < 16; ++i) { o0[i] *= alpha; o1[i] *= alpha; }
    }
    float ps = 0.f;
#pragma unroll
    for (int i = 0; i < 16; ++i) { p0[i] = __builtin_amdgcn_exp2f(p0[i] - mrun); ps += p0[i]; }
#pragma unroll
    for (int i = 0; i < 16; ++i) { p1[i] = __builtin_amdgcn_exp2f(p1[i] - mrun); ps += p1[i]; }
    lrun += ps;
    pv_step(o0, o1, Vc, r32, 0 + hi * 4, pack8<0>(p0));
    pv_step(o0, o1, Vc, r32, 16 + hi * 4, pack8<8>(p0));
    pv_step(o0, o1, Vc, r32, 32 + hi * 4, pack8<0>(p1));
    pv_step(o0, o1, Vc, r32, 48 + hi * 4, pack8<8>(p1));
    if (kt + 1 < nkt) lstore(cur ^ 1);
    __syncthreads();
  }
  lrun += __shfl_xor(lrun, 32, 64);
  const float inv = 1.f / lrun;
  u16* om = (u16*)(p.ws + OFF_OMLA) + (size_t)(orow0 + wave * 32 + r32) * 512 + h * 64;
#pragma unroll
  for (int g = 0; g < 4; ++g) {
    const int d = 8 * g + 4 * hi;
    *(uint2*)(om + d) = make_uint2(pack2(o0[4 * g] * inv, o0[4 * g + 1] * inv), pack2(o0[4 * g + 2] * inv, o0[4 * g + 3] * inv));
    *(uint2*)(om + 32 + d) = make_uint2(pack2(o1[4 * g] * inv, o1[4 * g + 1] * inv), pack2(o1[4 * g + 2] * inv, o1[4 * g + 3] * inv));
  }
#undef gload
#undef lstore
}

DI void readout_row(const Params& p, int l, int r) {
  LAUNDER_IDS
  const int lane = tid__ & 63;
  const u16* sc = (const u16*)(p.ws + OFF_R3);
  const size_t AS = (size_t)NT * 256;
  const size_t o = (size_t)r * 256 + lane * 4;
  const u16* Yf = (const u16*)(p.ws + OFF_R2);
  const uint2 yf = *(const uint2*)(Yf + o), yb = *(const uint2*)(Yf + AS + o);
  const uint2 ur = *(const uint2*)(sc + SA_R * AS + o), uv = *(const uint2*)(sc + SA_V * AS + o);
  const uint2 kf = *(const uint2*)(sc + SA_KDF * AS + o), kb = *(const uint2*)(sc + SA_KDB * AS + o), ug = *(const uint2*)(sc + SA_G * AS + o);
  float y[4] = {bflo(yf.x) + bflo(yb.x), bfhi(yf.x) + bfhi(yb.x), bflo(yf.y) + bflo(yb.y), bfhi(yf.y) + bfhi(yb.y)};
  const float rr[4] = {bflo(ur.x), bfhi(ur.x), bflo(ur.y), bfhi(ur.y)};
  const float vv[4] = {bflo(uv.x), bfhi(uv.x), bflo(uv.y), bfhi(uv.y)};
  const float km[4] = {0.5f * (bflo(kf.x) + bflo(kb.x)), 0.5f * (bfhi(kf.x) + bfhi(kb.x)), 0.5f * (bflo(kf.y) + bflo(kb.y)), 0.5f * (bfhi(kf.y) + bfhi(kb.y))};
  const float gg[4] = {bflo(ug.x), bfhi(ug.x), bflo(ug.y), bfhi(ug.y)};
  const float4 rk4 = *(const float4*)(p.in[I_RK] + l * 256 + lane * 4);
  const float4 lw4 = *(const float4*)(p.in[I_LNW] + l * 256 + lane * 4);
  const float4 lb4 = *(const float4*)(p.in[I_LNB] + l * 256 + lane * 4);
  const float rk[4] = {rk4.x, rk4.y, rk4.z, rk4.w}, lw[4] = {lw4.x, lw4.y, lw4.z, lw4.w}, lb[4] = {lb4.x, lb4.y, lb4.z, lb4.w};
  float s = y[0] + y[1] + y[2] + y[3];
  s = rowsum16(s);
  const float mu = s * (1.f / 64.f);
  float q = 0.f, bn = 0.f;
#pragma unroll
  for (int j = 0; j < 4; ++j) { const float d = y[j] - mu; q += d * d; bn += rr[j] * km[j] * rk[j]; }
  q = rowsum16(q); bn = rowsum16(bn);
  const float rstd = rsqrtf(q * (1.f / 64.f) + 64e-5f);
  float ov[4];
#pragma unroll
  for (int j = 0; j < 4; ++j) ov[j] = ((y[j] - mu) * rstd * lw[j] + lb[j] + bn * vv[j]) * gg[j];
  u16* orw = (u16*)(p.ws + OFF_R3 + SA_KKN * SZ_TOK256 + (size_t)NT * 512 * 2);
  *(uint2*)(orw + o) = make_uint2(pack2(ov[0], ov[1]), pack2(ov[2], ov[3]));
}

DI void phase_attn(const Params& p, int l, char* smem) {
  LAUNDER_IDS
  __shared__ int qslot_sh;
  const int nattn = (l == 0) ? 2048 + 128 : 2048;
  unsigned* ctr = (unsigned*)(p.ws + OFF_BAR) + 64 + l * 64;
  for (;;) {
    __syncthreads();
    if (tid__ == 0) qslot_sh = (int)__hip_atomic_fetch_add(ctr, 1u, __ATOMIC_RELAXED, __HIP_MEMORY_SCOPE_AGENT);
    __syncthreads();
    const int it = qslot_sh;
    if (it >= nattn) break;
    attn_item(p, it, smem);
  }
}
DI void phase_readout(const Params& p, int l, int Mout) {
  LAUNDER_IDS
  const int wave = tid__ >> 6;
  for (int r = blk__ * 4 + wave; r < Mout; r += gridDim.x * 4) readout_row(p, l, r);
}

DI void phase_merge(const Params& p, int l, int Mout, char* smem) {
  LAUNDER_IDS
  WAVE_COORDS
  const char* wl = p.ws + OFF_W + (size_t)l * W_LAYER;
  const u16* hg = (const u16*)(p.ws + OFF_HBG);
  const u16* opool = (const u16*)(p.ws + OFF_R4);
  const u16* omla = (const u16*)(p.ws + OFF_OMLA);
  const u16* orw = (const u16*)(p.ws + OFF_R3 + SA_KKN * SZ_TOK256) + (size_t)NT * 512;
  u16* mo = (u16*)(p.ws + OFF_R1);
  const int ntm = Mout / 256;
  for (int it = 0;; ++it) {
    int tm, tn;
    if (!tile_map(it, ntm, 16, blk__, gridDim.x, tm, tn)) break;
    const int m0 = tm * 256, n0 = tn * 64;
    f32x4 msum[8][2]; zero_acc8<2>(msum);
#pragma unroll 1
    for (int br = 0; br < 3; ++br) {
      unsigned gpk[8][2][2];
      {
        f32x4 ag[8][2]; zero_acc8<2>(ag);
        gemm256<2>(ag, hg, 1024, (const u16*)(wl + WO_WIN) + (size_t)(2080 + br * 1024) * 1024, 1024, 1024, m0, n0, smem);
#pragma unroll
        for (int mi = 0; mi < 8; ++mi)
#pragma unroll
          for (int ni = 0; ni < 2; ++ni) {
            gpk[mi][ni][0] = pack2(sigmoidf_(ag[mi][ni][0]), sigmoidf_(ag[mi][ni][1]));
            gpk[mi][ni][1] = pack2(sigmoidf_(ag[mi][ni][2]), sigmoidf_(ag[mi][ni][3]));
          }
      }
      __builtin_amdgcn_sched_barrier(0);
      f32x4 ab[8][2]; zero_acc8<2>(ab);
      {
        const int Kb = br == 1 ? 512 : 256;
        const u16* Ab = br == 0 ? opool : br == 1 ? omla : orw;
        const u16* Wb = (const u16*)(wl + (br == 0 ? WO_BRP : br == 1 ? WO_BRM : WO_BRR));
        gemm256<2>(ab, Ab, Kb, Wb, Kb, Kb, m0, n0, smem);
      }
#pragma unroll
      for (int mi = 0; mi < 8; ++mi)
#pragma unroll
        for (int ni = 0; ni < 2; ++ni) {
          msum[mi][ni][0] += bflo(gpk[mi][ni][0]) * ab[mi][ni][0];
          msum[mi][ni][1] += bfhi(gpk[mi][ni][0]) * ab[mi][ni][1];
          msum[mi][ni][2] += bflo(gpk[mi][ni][1]) * ab[mi][ni][2];
          msum[mi][ni][3] += bfhi(gpk[mi][ni][1]) * ab[mi][ni][3];
        }
      __builtin_amdgcn_sched_barrier(0);
    }
#pragma unroll
    for (int mi = 0; mi < 8; ++mi) {
      const int m = m0 + wr * 128 + mi * 16 + lr;
#pragma unroll
      for (int ni = 0; ni < 2; ++ni) {
        const int n = n0 + wc * 32 + ni * 16 + lq * 4;
        *(uint2*)(mo + (size_t)m * 1024 + n) = make_uint2(pack2(msum[mi][ni][0], msum[mi][ni][1]), pack2(msum[mi][ni][2], msum[mi][ni][3]));
      }
    }
  }
}

DI void phase_resid(const Params& p, const u16* A, int K, const u16* Bt, const float* gate  ,
                    const float* xl_in, const float* xc_in, float* xl_out, float* xc_out, int Mout, char* smem) {
  LAUNDER_IDS
  WAVE_COORDS
  const int ntm = Mout / 256;
  for (int it = 0;; ++it) {
    int tm, tn;
    if (!tile_map(it, ntm, 8, blk__, gridDim.x, tm, tn)) break;
    const int m0 = tm * 256, n0 = tn * 128;
    f32x4 acc[8][4]; zero_acc8<4>(acc);
    gemm256<4>(acc, A, K, Bt, K, K, m0, n0, smem);
#pragma unroll
    for (int mi = 0; mi < 8; ++mi) {
      const int m = m0 + wr * 128 + mi * 16 + lr;
      const int b9 = m < NTL ? m >> 12 : 8;
      const float* xi = xrow(xl_in, xc_in, m);
      float* xo = m < NTL ? xl_out + (size_t)m * D : xc_out + (size_t)(m - NTL) * D;
#pragma unroll
      for (int ni = 0; ni < 4; ++ni) {
        const int n = n0 + wc * 64 + ni * 16 + lq * 4;
        const float4 g = *(const float4*)(gate + (size_t)b9 * 6144 + n);
        const float4 xv = *(const float4*)(xi + n);
        float4 ov;
        ov.x = xv.x + g.x * acc[mi][ni][0]; ov.y = xv.y + g.y * acc[mi][ni][1]; ov.z = xv.z + g.z * acc[mi][ni][2]; ov.w = xv.w + g.w * acc[mi][ni][3];
        *(float4*)(xo + n) = ov;
      }
      __builtin_amdgcn_sched_barrier(0);
    }
  }
}
DI void phase_mlp1(const Params& p, int l, int Mout, char* smem) {
  LAUNDER_IDS
  WAVE_COORDS
  const char* wl = p.ws + OFF_W + (size_t)l * W_LAYER;
  const u16* hb = (const u16*)(p.ws + OFF_HB2);
  u16* U = (u16*)(p.ws + OFF_R1);
  const int ntm = Mout / 256;
  for (int it = 0;; ++it) {
    int tm, tn;
    if (!tile_map(it, ntm, 32, blk__, gridDim.x, tm, tn)) break;
    const int m0 = tm * 256, n0 = tn * 128;
    f32x4 acc[8][4]; zero_acc8<4>(acc);
    gemm256<4>(acc, hb, 1024, (const u16*)(wl + WO_W1), 1024, 1024, m0, n0, smem);
#pragma unroll
    for (int mi = 0; mi < 8; ++mi) {
      const int m = m0 + wr * 128 + mi * 16 + lr;
#pragma unroll
      for (int ni = 0; ni < 4; ++ni) {
        const int n = n0 + wc * 64 + ni * 16 + lq * 4;
        float v[4];
#pragma unroll
        for (int j = 0; j < 4; ++j) { const float a = fmaxf(acc[mi][ni][j], 0.f); v[j] = a * a; }
        *(uint2*)(U + (size_t)m * DFF + n) = make_uint2(pack2(v[0], v[1]), pack2(v[2], v[3]));
      }
      __builtin_amdgcn_sched_barrier(0);
    }
  }
}

__global__ void __launch_bounds__(256, 2) fwd_megakernel(Params pk) {
  __shared__ __attribute__((aligned(16))) char smem[73728];
  __shared__ unsigned long long base_sh[2];
  if (threadIdx.x == 0) { base_sh[0] = (unsigned long long)pk.ws; base_sh[1] = (unsigned long long)pk.out; }
  __syncthreads();
  cg::grid_group grid = cg::this_grid();
  unsigned* bar = (unsigned*)(pk.ws + OFF_BAR);
  unsigned epoch = 0;
  phase_prep(pk, smem);
  grid.sync();
  phase_tables(pk);
  grid_barrier(bar, epoch);
#define CTXBUF ((float*)(p.ws + OFF_CTX))
#define XLP (l == 0 ? p.in[I_X] : (const float*)p.out)
#define XCP (l == 0 ? p.in[I_CTX] : (const float*)CTXBUF)
#define MOUT (l == 0 ? NT : NTL)
#define WLP (p.ws + OFF_W + (size_t)l * W_LAYER)
#define TABP(nrm) ((const float*)(p.ws + OFF_TAB) + (size_t)(l * 2 + (nrm)) * 9 * 2048)
#define MODP(j) ((const float*)(p.ws + OFF_MODS) + (size_t)l * 9 * 6144 + (j) * 1024)
#ifndef PROBE_Q
#define PROBE_Q -1
#endif
#pragma nounroll
  for (int ph = 0; ph < 22; ++ph) {
    const int l = ph >= 11 ? 1 : 0, q = ph - l * 11;
    Params p = pk;
    {
      asm volatile("" ::: "memory");
      unsigned long long w_ = base_sh[0], o_ = base_sh[1];
      unsigned wl_ = (unsigned)w_, wh_ = (unsigned)(w_ >> 32), ol_ = (unsigned)o_, oh_ = (unsigned)(o_ >> 32);
      wl_ = __builtin_amdgcn_readfirstlane(wl_); wh_ = __builtin_amdgcn_readfirstlane(wh_); ol_ = __builtin_amdgcn_readfirstlane(ol_); oh_ = __builtin_amdgcn_readfirstlane(oh_);
      asm volatile("" : "+s"(wl_), "+s"(wh_), "+s"(ol_), "+s"(oh_));
      p.ws = (char*)(((unsigned long long)wh_ << 32) | wl_); p.out = (float*)(((unsigned long long)oh_ << 32) | ol_);
    }
#pragma nounroll
    for (int rep = 0; rep < (q == PROBE_Q ? 2 : 1); ++rep)
    switch (q) {
      case 0: phase_norm(XLP, XCP, TABP(0), (u16*)(p.ws + OFF_HB1), NT); break;
      case 1: phase_zgemm(p, l, smem); break;
      case 2: phase_tokA(p, l); phase_tokB(p, l, smem); break;
      case 3: phase_qkv(p, l, smem); break;
      case 4: phase_scan(p, smem); phase_attn(p, l, smem); break;
      case 5: phase_norm(XLP, XCP, TABP(0), (u16*)(p.ws + OFF_HBG), MOUT); phase_readout(p, l, MOUT); break;
      case 6: phase_merge(p, l, MOUT, smem); break;
      case 7: phase_resid(p, (const u16*)(p.ws + OFF_R1), 1024, (const u16*)(WLP + WO_WO), MODP(2), XLP, XCP, p.out, CTXBUF, MOUT, smem); break;
      case 8: phase_norm(p.out, CTXBUF, TABP(1), (u16*)(p.ws + OFF_HB2), MOUT); break;
      case 9: phase_mlp1(p, l, MOUT, smem); break;
      default: phase_resid(p, (const u16*)(p.ws + OFF_R1), 4096, (const u16*)(WLP + WO_W2), MODP(5), p.out, CTXBUF, p.out, CTXBUF, MOUT, smem); break;
    }
    if (ph != 21) grid_barrier(bar, epoch);
  }
}

extern "C" void kernel_launch(void* const* d_in, const int* in_sizes, int n_in, void* d_out, int out_size, void* d_ws, size_t ws_size, hipStream_t stream) {
  static int grid_blocks = 0;
  if (!grid_blocks) {
    int dev = 0, cus = 0, per_cu = 0;
    hipGetDevice(&dev);
    hipDeviceGetAttribute(&cus, hipDeviceAttributeMultiprocessorCount, dev);
    hipOccupancyMaxActiveBlocksPerMultiprocessor(&per_cu, fwd_megakernel, 256, 0);
    if (per_cu > 2) per_cu = 2;
    if (per_cu < 1) per_cu = 1;
    grid_blocks = cus * per_cu;
    if (ws_size < WS_END) fprintf(stderr, "kernel_launch: workspace too small: %zu < %zu\n", ws_size, (size_t)WS_END);
  }
  Params p{};
  for (int i = 0; i < 34; ++i) p.in[i] = (const float*)d_in[i];
  p.out = (float*)d_out;
  p.ws = (char*)d_ws;
  hipMemsetAsync(d_ws, 0, 4096, stream);
  void* args[] = {&p};
  hipError_t e = hipLaunchCooperativeKernel((void*)fwd_megakernel, dim3(grid_blocks), dim3(256), args, 0, stream);
  if (e != hipSuccess) fprintf(stderr, "cooperative launch failed: %s (grid %d)\n", hipGetErrorString(e), grid_blocks);
}
```

```cpp
#include <hip/hip_runtime.h>
#include <hip/hip_cooperative_groups.h>
#include <stdint.h>
#include <cstdio>
namespace cg = cooperative_groups;

typedef unsigned short u16;
typedef __attribute__((ext_vector_type(8))) short bf16x8;
typedef __attribute__((ext_vector_type(4))) float f32x4;
typedef __attribute__((ext_vector_type(16))) float f32x16;
typedef __bf16 bf16x2_t __attribute__((ext_vector_type(2)));
typedef float float2_t __attribute__((ext_vector_type(2)));

#define DI __device__ __forceinline__

constexpr int D = 1024, NB = 8, L = 4096, LC = 256, LK = 4352;
constexpr int NTL = NB * L;
constexpr int NTC = NB * LC;
constexpr int NT = NTL + NTC;
constexpr int INC = 5152;
constexpr int ZA = 928;
constexpr int ZR = 1152;
constexpr int DFF = 4096;

constexpr size_t al256(size_t x) { return (x + 255) / 256 * 256; }
constexpr size_t OFF_BAR = 0;
constexpr size_t OFF_MODS = 16384;
constexpr size_t OFF_TAB = OFF_MODS + al256(2 * 9 * 6144 * 4);
constexpr size_t OFF_ROPE = OFF_TAB + al256(2 * 2 * 9 * 2 * 1024 * 4);
constexpr size_t OFF_RS1 = OFF_ROPE + 4096;
constexpr size_t OFF_RS2 = OFF_RS1 + al256(NT * 4);
constexpr size_t OFF_RSQ = OFF_RS2 + al256(NT * 4);
constexpr size_t OFF_RSKV = OFF_RSQ + al256(NT * 4);
constexpr size_t OFF_CTX = OFF_RSKV + al256(NT * 4);
constexpr size_t OFF_W = OFF_CTX + (size_t)NTC * D * 4;
constexpr size_t WO_WIN = 0;
constexpr size_t WO_UQ = WO_WIN + (size_t)INC * 1024 * 2;
constexpr size_t WO_UKV = WO_UQ + (size_t)768 * 384 * 2;
constexpr size_t WO_BRP = WO_UKV + (size_t)1024 * 256 * 2;
constexpr size_t WO_BRM = WO_BRP + (size_t)1024 * 256 * 2;
constexpr size_t WO_BRR = WO_BRM + (size_t)1024 * 512 * 2;
constexpr size_t WO_WO = WO_BRR + (size_t)1024 * 256 * 2;
constexpr size_t WO_W1 = WO_WO + (size_t)1024 * 1024 * 2;
constexpr size_t WO_W2 = WO_W1 + (size_t)4096 * 1024 * 2;
constexpr size_t WO_RW2 = WO_W2 + (size_t)1024 * 4096 * 2;
constexpr size_t WO_RA2 = WO_RW2 + (size_t)2 * 256 * 64 * 2;
constexpr size_t WO_RG2 = WO_RA2 + (size_t)2 * 256 * 64 * 2;
constexpr size_t W_LAYER = al256(WO_RG2 + (size_t)256 * 128 * 2);
constexpr size_t OFF_R1 = OFF_W + 2 * W_LAYER;
constexpr size_t SZ_Q = (size_t)NB * 8 * LK * 96 * 2;
constexpr size_t SZ_VT = (size_t)NB * 8 * 64 * LK * 2;
constexpr size_t SZ_R1 = 2 * SZ_Q + SZ_VT;
constexpr size_t OFF_R2 = OFF_R1 + al256(SZ_R1);
constexpr size_t SZ_TOK256 = (size_t)NT * 256 * 2;
constexpr size_t OFF_R3 = OFF_R2 + al256((size_t)NT * ZA * 2);
constexpr size_t OFF_R4 = OFF_R3 + 10 * SZ_TOK256;
constexpr size_t OFF_KR = OFF_R4 + SZ_TOK256;
constexpr size_t OFF_OMLA = OFF_KR + al256((size_t)NT * 32 * 2);
constexpr size_t WS_END = OFF_OMLA + (size_t)NT * 512 * 2;
static_assert(WS_END <= 536870912ull, "workspace map exceeds 4x the largest tensor");
constexpr size_t OFF_HB1 = OFF_R3;
constexpr size_t OFF_HBG = OFF_R1 + (size_t)NT * 1024 * 2;
constexpr size_t OFF_HB2 = OFF_R3 + 5 * SZ_TOK256;
enum { SA_R = 0, SA_V = 1, SA_KDF = 2, SA_KDB = 3, SA_G = 4, SA_KKN = 5, SA_OMWF = 6, SA_BF = 7, SA_OMWB = 8, SA_BB = 9 };

struct Params { const float* in[34]; float* out; char* ws; };

enum { I_X = 0, I_C, I_CTX, I_CCTX, I_N1G, I_N2G, I_WADA, I_BADA, I_WIN, I_POOLW, I_POOLS, I_QNORM, I_WUQ, I_KVNORM, I_WUKV,
       I_GQ, I_GK, I_MU, I_W0, I_W2R, I_A0, I_A2R, I_KA, I_KK, I_RK, I_G2R, I_LNW, I_LNB, I_BRP, I_BRM, I_BRR, I_WO, I_W1, I_W2 };

DI float bf2f(u16 h) { return __uint_as_float(((unsigned)h) << 16); }
DI float bflo(unsigned u) { return __uint_as_float(u << 16); }
DI float bfhi(unsigned u) { return __uint_as_float(u & 0xffff0000u); }
DI unsigned pack2(float a, float b) { float2_t v = {a, b}; bf16x2_t r = __builtin_convertvector(v, bf16x2_t); return __builtin_bit_cast(unsigned, r); }
DI u16 f2bf(float a) { return (u16)(pack2(a, 0.f) & 0xffffu); }
DI float sigmoidf_(float x) { return 1.f / (1.f + __expf(-x)); }
DI float siluf_(float x) { return x / (1.f + __expf(-x)); }
DI float rowsum16(float x) {
  x += __builtin_bit_cast(float, __builtin_amdgcn_update_dpp(0, __builtin_bit_cast(int, x), 0x128, 0xf, 0xf, false));
  x += __builtin_bit_cast(float, __builtin_amdgcn_update_dpp(0, __builtin_bit_cast(int, x), 0x124, 0xf, 0xf, false));
  x += __builtin_bit_cast(float, __builtin_amdgcn_update_dpp(0, __builtin_bit_cast(int, x), 0x122, 0xf, 0xf, false));
  x += __builtin_bit_cast(float, __builtin_amdgcn_update_dpp(0, __builtin_bit_cast(int, x), 0x121, 0xf, 0xf, false));
  return x;
}
DI float wavesum(float x) {
  for (int o = 32; o > 0; o >>= 1) x += __shfl_xor(x, o, 64);
  return x;
}
DI void grid_barrier(unsigned* ctr, unsigned& epoch) {
  asm volatile("s_waitcnt vmcnt(0)" ::: "memory");
  __syncthreads();
  epoch++;
  if (threadIdx.x == 0) {
    __builtin_amdgcn_fence(__ATOMIC_RELEASE, "agent");
    asm volatile("s_waitcnt vmcnt(0)" ::: "memory");
    const unsigned target = epoch * gridDim.x;
    __hip_atomic_fetch_add(ctr, 1u, __ATOMIC_RELAXED, __HIP_MEMORY_SCOPE_AGENT);
    while (__hip_atomic_load(ctr, __ATOMIC_RELAXED, __HIP_MEMORY_SCOPE_AGENT) < target) __builtin_amdgcn_s_sleep(2);
    __builtin_amdgcn_fence(__ATOMIC_ACQUIRE, "agent");
    asm volatile("s_waitcnt vmcnt(0)" ::: "memory");
  }
  __syncthreads();
}


#define XB_TMO      128
#define XB_XCNT(j)  (256  + 64 * (j))
#define XB_XSUB(j)  (1280 + 64 * (j))
#define XB_XGEN(j)  (2304 + 64 * (j))
#define XB_TOP      3328
#define XB_TOPGEN   3392
#define XB_SPIN_CAP (1u << 22)
#define LAS __attribute__((address_space(3)))
DI unsigned xb_ld(unsigned* p)              { return __hip_atomic_load(p, __ATOMIC_RELAXED, __HIP_MEMORY_SCOPE_AGENT); }
DI unsigned xb_add(unsigned* p, unsigned v) { return __hip_atomic_fetch_add(p, v, __ATOMIC_RELAXED, __HIP_MEMORY_SCOPE_AGENT); }
DI unsigned xb_xcc_id() { return (unsigned)__builtin_amdgcn_s_getreg((3 << 11) | 20) & 0xFu; }
#define XB_SPIN(cond, bar) do { unsigned _sp = 0; while (cond) { __builtin_amdgcn_s_sleep(1); \
    if ((++_sp & 255u) == 0u) { if (xb_ld(&(bar)[XB_TMO])) break; if (_sp > XB_SPIN_CAP) { atomicAdd(&(bar)[XB_TMO], 1u); break; } } } } while (0)
__shared__ uint4 g_xb_words;
__shared__ unsigned long long g_base_sh[2];
DI void xcd_barrier_post(unsigned* bar) {
  const unsigned x = xb_xcc_id();
  if (threadIdx.x == 0) { g_xb_words = make_uint4(0u, 0u, x, 0u); (void)xb_add(&bar[XB_XCNT(x)], 1u); }
}
DI void xcd_barrier_complete(unsigned* bar, unsigned x, unsigned& nloc, unsigned& nx) {
  const unsigned G = gridDim.x;
  unsigned sum, cnt, mine, sp = 0u;
  for (;;) {
    sum = 0u; cnt = 0u; mine = 0u;
#pragma unroll
    for (unsigned j = 0; j < 16; ++j) { const unsigned c = xb_ld(&bar[XB_XCNT(j)]); sum += c; cnt += (c > 0u) ? 1u : 0u; mine = (j == x) ? c : mine; }
    if (sum == G) break;
    __builtin_amdgcn_s_sleep(1);
    if ((++sp & 255u) == 0u) { if (xb_ld(&bar[XB_TMO])) break; if (sp > XB_SPIN_CAP) { atomicAdd(&bar[XB_TMO], 1u); break; } }
  }
  nloc = mine > 0u ? mine : 1u; nx = cnt > 0u ? cnt : 1u;
}
DI void xcd_barrier() {
  asm volatile("s_waitcnt vmcnt(0)" ::: "memory");
  __syncthreads();
  if (threadIdx.x == 0) {
    unsigned* bar = (unsigned*)(g_base_sh[0] + OFF_BAR);
    __builtin_amdgcn_s_waitcnt(0);
    unsigned nloc = g_xb_words.x, nx = g_xb_words.y; const unsigned x = g_xb_words.z;
    if (nloc == 0u) { xcd_barrier_complete(bar, x, nloc, nx); g_xb_words.x = nloc; g_xb_words.y = nx; }
    const unsigned old = xb_add(&bar[XB_XSUB(x)], 1u);
    const unsigned gen = old / nloc;
    if (old + 1u == (gen + 1u) * nloc) {
      __builtin_amdgcn_fence(__ATOMIC_RELEASE, "agent");
      asm volatile("s_waitcnt vmcnt(0)" ::: "memory");
      const unsigned og = xb_add(&bar[XB_TOP], 1u);
      const unsigned tg = og / nx;
      if (og + 1u == (tg + 1u) * nx) xb_add(&bar[XB_TOPGEN], 1u);
      else XB_SPIN(xb_ld(&bar[XB_TOPGEN]) == tg, bar);
      __builtin_amdgcn_fence(__ATOMIC_ACQUIRE, "agent");
      xb_add(&bar[XB_XGEN(x)], 1u);
      asm volatile("s_waitcnt vmcnt(0)" ::: "memory");
    } else {
      XB_SPIN(xb_ld(&bar[XB_XGEN(x)]) == gen, bar);
      __builtin_amdgcn_fence(__ATOMIC_ACQUIRE, "agent");
      asm volatile("s_waitcnt vmcnt(0)" ::: "memory");
    }
  }
  __syncthreads();
}
DI int launder_v(int x) { asm volatile("" : "+v"(x)); return x; }
DI int launder_s(int x) { asm volatile("" : "+s"(x)); return x; }
#define LAUNDER_IDS const int tid__ = launder_v((int)threadIdx.x); const int blk__ = launder_s((int)blockIdx.x); (void)tid__; (void)blk__;
DI void do_transpose(const float* __restrict__ src, int K, int N, u16* __restrict__ dst, const float* __restrict__ ksc, int perm, int tile, float* tl) {
  LAUNDER_IDS
  const int ntn = (N + 63) >> 6;
  const int kt = tile / ntn, nt = tile - kt * ntn;
  const int k0 = kt * 64, n0 = nt * 64;
  const int tid = tid__;
  __syncthreads();
#pragma unroll 4
  for (int i = 0; i < 16; ++i) {
    const int kk = i * 4 + (tid >> 6), nn = tid & 63;
    float v = 0.f;
    if (n0 + nn < N) v = src[(size_t)(k0 + kk) * N + n0 + nn];
    if (ksc) v *= ksc[k0 + kk];
    tl[kk * 65 + nn] = v;
  }
  __syncthreads();
#pragma unroll 4
  for (int i = 0; i < 16; ++i) {
    const int nn = i * 4 + (tid >> 6), kk = tid & 63;
    int n = n0 + nn;
    if (n < N) {
      if (perm) { const int h = n / 96, d = n - h * 96; n = d < 64 ? h * 64 + d : 512 + h * 32 + (d - 64); }
      dst[(size_t)n * K + k0 + kk] = f2bf(tl[kk * 65 + nn]);
    }
  }
}

DI void phase_prep(const Params& p, char* smem) {
  LAUNDER_IDS
  float* tl = (float*)smem;
  const int tid = tid__;
  constexpr int T_WIN = 16 * 81, T_UQ = 6 * 12, T_UKV = 4 * 16, T_BRM = 8 * 16, T_BRR = 4 * 16, T_WO = 16 * 16, T_W1 = 16 * 64, T_W2 = 64 * 16,
                T_RW2 = 4, T_RA2 = 4, T_RG2 = 2 * 4;
  constexpr int T_LAYER = T_WIN + T_UQ + T_UKV + T_BRM + T_BRR + T_WO + T_W1 + T_W2 + 2 * T_RW2 + 2 * T_RA2 + T_RG2;
  for (int g = blk__; g < 2 * T_LAYER; g += gridDim.x) {
    const int l = g / T_LAYER; int t = g - l * T_LAYER;
    char* wl = p.ws + OFF_W + (size_t)l * W_LAYER;
#define JOB(SRC, KK, NN, DSTOFF, SC, PERM, CNT) if (t < (CNT)) { do_transpose((SRC), (KK), (NN), (u16*)(wl + (DSTOFF)), (SC), (PERM), t, tl); continue; } t -= (CNT);
    JOB(p.in[I_WIN] + (size_t)l * 1024 * INC, 1024, INC, WO_WIN, nullptr, 0, T_WIN)
    JOB(p.in[I_WUQ] + (size_t)l * 384 * 768, 384, 768, WO_UQ, p.in[I_QNORM] + l * 384, 1, T_UQ)
    JOB(p.in[I_WUKV] + (size_t)l * 256 * 1024, 256, 1024, WO_UKV, p.in[I_KVNORM] + l * 256, 0, T_UKV)
    JOB(p.in[I_BRM] + (size_t)l * 512 * 1024, 512, 1024, WO_BRM, nullptr, 0, T_BRM)
    JOB(p.in[I_BRR] + (size_t)l * 256 * 1024, 256, 1024, WO_BRR, nullptr, 0, T_BRR)
    JOB(p.in[I_WO] + (size_t)l * 1024 * 1024, 1024, 1024, WO_WO, nullptr, 0, T_WO)
    JOB(p.in[I_W1] + (size_t)l * 1024 * 4096, 1024, 4096, WO_W1, nullptr, 0, T_W1)
    JOB(p.in[I_W2] + (size_t)l * 4096 * 1024, 4096, 1024, WO_W2, nullptr, 0, T_W2)
    JOB(p.in[I_W2R] + (size_t)(l * 2 + 0) * 64 * 256, 64, 256, WO_RW2, nullptr, 0, T_RW2)
    JOB(p.in[I_W2R] + (size_t)(l * 2 + 1) * 64 * 256, 64, 256, WO_RW2 + 256 * 64 * 2, nullptr, 0, T_RW2)
    JOB(p.in[I_A2R] + (size_t)(l * 2 + 0) * 64 * 256, 64, 256, WO_RA2, nullptr, 0, T_RA2)
    JOB(p.in[I_A2R] + (size_t)(l * 2 + 1) * 64 * 256, 64, 256, WO_RA2 + 256 * 64 * 2, nullptr, 0, T_RA2)
    JOB(p.in[I_G2R] + (size_t)l * 128 * 256, 128, 256, WO_RG2, nullptr, 0, T_RG2)
#undef JOB
  }
  for (int e = blk__ * 256 + tid; e < 2 * 256 * 1024; e += gridDim.x * 256) {
    const int l = e >> 18, r = e & 262143, cin = r >> 10, n = r & 1023, g = cin >> 6, c = cin & 63;
    const float* pw = p.in[I_POOLW] + ((size_t)(l * 4 + g) * 64 + c) * 64;
    const float* ps = p.in[I_POOLS] + l * 256 + g * 64;
    const float* wb = p.in[I_BRP] + ((size_t)l * 256 + g * 64) * 1024 + n;
    float s = 0.f;
    for (int d = 0; d < 64; ++d) s += pw[d] * ps[d] * wb[(size_t)d * 1024];
    ((u16*)(p.ws + OFF_W + (size_t)l * W_LAYER + WO_BRP))[(size_t)n * 256 + cin] = f2bf(s);
  }
  if (blk__ == gridDim.x - 1) {
    for (int e = tid; e < 512; e += 256) {
      const int pos = e >> 3, f = e & 7;
      const float inv = powf(10000.f, -(float)f / 8.f);
      const float ang = (float)pos * inv;
      float* rt = (float*)(p.ws + OFF_ROPE);
      rt[e * 2] = cosf(ang); rt[e * 2 + 1] = sinf(ang);
    }
  }
  {
    float* sl = (float*)smem;
    float* red = sl + 9 * 1024;
    __syncthreads();
    for (int e = tid; e < 9 * 1024; e += 256) {
      const int b = e >> 10, k = e & 1023;
      const float v = b < 8 ? p.in[I_C][b * 1024 + k] : p.in[I_CCTX][k];
      sl[e] = siluf_(v);
    }
    __syncthreads();
    const int wave = tid >> 6, lane = tid & 63;
    for (int it = blk__; it < 192; it += gridDim.x) {
      const int l = it / 96, cg_ = it - l * 96;
      const int col = cg_ * 64 + lane;
      const float* wa = p.in[I_WADA] + (size_t)l * 1024 * 6144 + col;
      float acc[9];
#pragma unroll
      for (int b = 0; b < 9; ++b) acc[b] = 0.f;
#pragma unroll 8
      for (int k = wave * 256; k < wave * 256 + 256; ++k) {
        const float w = wa[(size_t)k * 6144];
#pragma unroll
        for (int b = 0; b < 9; ++b) acc[b] += sl[b * 1024 + k] * w;
      }
#pragma unroll
      for (int b = 0; b < 9; ++b) red[(wave * 9 + b) * 64 + lane] = acc[b];
      __syncthreads();
      for (int e = tid; e < 9 * 64; e += 256) {
        const int b = e >> 6, c = e & 63;
        const float s = red[(0 * 9 + b) * 64 + c] + red[(1 * 9 + b) * 64 + c] + red[(2 * 9 + b) * 64 + c] + red[(3 * 9 + b) * 64 + c];
        ((float*)(p.ws + OFF_MODS))[(size_t)(l * 9 + b) * 6144 + cg_ * 64 + c] = s + p.in[I_BADA][l * 6144 + cg_ * 64 + c];
      }
      __syncthreads();
    }
  }
}

DI const float* xrow(const float* xl, const float* xc, int r) { return r < NTL ? xl + (size_t)r * D : xc + (size_t)(r - NTL) * D; }

DI void phase_norm(const float* xl, const float* xc, const float* tab  , u16* hb, int M) {
  LAUNDER_IDS
  const int wave = tid__ >> 6, lane = tid__ & 63;
  for (int r = blk__ * 4 + wave; r < M; r += gridDim.x * 4) {
    const float* xp = xrow(xl, xc, r);
    const int b9 = r < NTL ? r >> 12 : 8;
    float4 v[4];
    float s = 0.f;
#pragma unroll
    for (int i = 0; i < 4; ++i) { v[i] = *(const float4*)(xp + i * 256 + lane * 4); s += v[i].x * v[i].x + v[i].y * v[i].y + v[i].z * v[i].z + v[i].w * v[i].w; }
    s = wavesum(s);
    const float rs = rsqrtf(s * (1.f / 1024.f) + 1e-6f);
    const float* t = tab + b9 * 2048;
#pragma unroll
    for (int i = 0; i < 4; ++i) {
      const int k = i * 256 + lane * 4;
      const float4 g = *(const float4*)(t + k), sh = *(const float4*)(t + 1024 + k);
      *(uint2*)(hb + (size_t)r * 1024 + k) = make_uint2(pack2(v[i].x * rs * g.x + sh.x, v[i].y * rs * g.y + sh.y), pack2(v[i].z * rs * g.z + sh.z, v[i].w * rs * g.w + sh.w));
    }
  }
}
DI void phase_tables(const Params& p) {
  LAUNDER_IDS
  const float* mods = (const float*)(p.ws + OFF_MODS);
  float* tab = (float*)(p.ws + OFF_TAB);
  for (int e = blk__ * 256 + tid__; e < 2 * 2 * 9 * 1024; e += gridDim.x * 256) {
    const int k = e & 1023, b9 = (e >> 10) % 9, ln = (e >> 10) / 9, l = ln >> 1, nrm = ln & 1;
    const float g = p.in[nrm ? I_N2G : I_N1G][l * 1024 + k];
    const float sh = mods[(size_t)(l * 9 + b9) * 6144 + (nrm * 3 + 0) * 1024 + k];
    const float sc = mods[(size_t)(l * 9 + b9) * 6144 + (nrm * 3 + 1) * 1024 + k];
    float* t = tab + ((size_t)(l * 2 + nrm) * 9 + b9) * 2048;
    t[k] = g * (1.f + sc); t[1024 + k] = sh;
  }
}

struct LoadBf16 {
  const u16* A; int lda;
  DI void init(int m0) {}
  DI uint4 load(int i, int m0, int k0) const {
    LAUNDER_IDS
    const int tid = tid__, kc = (tid & 7) * 8;
    return *(const uint4*)(A + (size_t)(m0 + (tid >> 3) + i * 32) * lda + k0 + kc);
  }
};
struct LoadNorm {
  const float* xl; const float* xc; const float* rs; const float* tab;
  float r0, r1, r2, r3;
  DI void init(int m0) {
    LAUNDER_IDS
    const int tid = tid__;
    r0 = rs[m0 + (tid >> 3)]; r1 = rs[m0 + (tid >> 3) + 32]; r2 = rs[m0 + (tid >> 3) + 64]; r3 = rs[m0 + (tid >> 3) + 96];
  }
  DI uint4 load(int i, int m0, int k0) const {
    LAUNDER_IDS
    const int tid = tid__, kc = (tid & 7) * 8;
    const int b9 = m0 < NTL ? m0 >> 12 : 8;
    const float* t = tab + b9 * 2048 + k0 + kc;
    const float4 g0 = *(const float4*)t, g1 = *(const float4*)(t + 4), s0 = *(const float4*)(t + 1024), s1 = *(const float4*)(t + 1028);
    const float* xp = xrow(xl, xc, m0 + (tid >> 3)) + k0 + kc + (size_t)i * 32 * D;
    const float4 x0 = *(const float4*)xp, x1 = *(const float4*)(xp + 4);
    const float rr = i == 0 ? r0 : i == 1 ? r1 : i == 2 ? r2 : r3;
    uint4 o;
    o.x = pack2(x0.x * rr * g0.x + s0.x, x0.y * rr * g0.y + s0.y);
    o.y = pack2(x0.z * rr * g0.z + s0.z, x0.w * rr * g0.w + s0.w);
    o.z = pack2(x1.x * rr * g1.x + s1.x, x1.y * rr * g1.y + s1.y);
    o.w = pack2(x1.z * rr * g1.z + s1.z, x1.w * rr * g1.w + s1.w);
    return o;
  }
};

DI bool tile_map(int it, int NTM, int NTN, int blk, int nblk, int& tm, int& tn) {
  const int xcd = blk & 7, local = blk >> 3, LB = nblk >> 3;
  const int R = NTM >> 3;
  const int s = it * LB + local;
  if (s >= R * NTN) return false;
  const int F = R >> 3, per_full = 8 * NTN;
  int mg, r, gm;
  if (s < F * per_full) { mg = s / per_full; r = s - mg * per_full; gm = 8; }
  else { mg = F; r = s - F * per_full; gm = R - F * 8; }
  const int ng = r / (gm * 8);
  const int r2 = r - ng * gm * 8;
  const int mi = r2 % gm, ni = r2 / gm;
  tm = xcd * R + mg * 8 + mi; tn = ng * 8 + ni;
  return true;
}
constexpr int LDT = 72;
template <int NI, class LA>
DI void gemm_mainloop(f32x4 (&acc)[4][NI], LA la, const u16* __restrict__ Bt, int ldb, int K, int m0, int n0, char* smem) {
  LAUNDER_IDS
  constexpr int NBI = NI;
  u16* As = (u16*)smem; u16* Bs = As + 2 * 128 * LDT;
  const int tid = tid__, lane = tid & 63, wave = tid >> 6, wr = wave >> 1, wc = wave & 1, lr = lane & 15, lq = lane >> 4;
  uint4 ra[4], rb[NBI];
  la.init(m0);
#pragma unroll
  for (int i = 0; i < 4; ++i) ra[i] = la.load(i, m0, 0);
#pragma unroll
  for (int i = 0; i < NBI; ++i) {
    const int c = tid + i * 256, row = c >> 3, kc = (c & 7) * 8;
    rb[i] = *(const uint4*)(Bt + (size_t)(n0 + row) * ldb + kc);
  }
#pragma unroll
  for (int i = 0; i < 4; ++i) {
    const int c = tid + i * 256, row = c >> 3, kc = (c & 7) * 8;
    *(uint4*)(As + row * LDT + kc) = ra[i];
    if (i < NBI) *(uint4*)(Bs + row * LDT + kc) = rb[i];
  }
  __syncthreads();
  const int nk = K >> 6;
  for (int kt = 0; kt < nk; ++kt) {
    const int cur = kt & 1;
    if (kt + 1 < nk) {
      const int k0 = (kt + 1) * 64;
#pragma unroll
      for (int i = 0; i < 4; ++i) ra[i] = la.load(i, m0, k0);
#pragma unroll
      for (int i = 0; i < NBI; ++i) {
        const int c = tid + i * 256, row = c >> 3, kc = (c & 7) * 8;
        rb[i] = *(const uint4*)(Bt + (size_t)(n0 + row) * ldb + k0 + kc);
      }
    }
    const u16* Ac = As + cur * 128 * LDT + (wr * 64 + lr) * LDT + lq * 8;
    const u16* Bc = Bs + cur * 128 * LDT + (wc * 16 * NI + lr) * LDT + lq * 8;
#pragma unroll
    for (int ks = 0; ks < 2; ++ks) {
      bf16x8 af[4], bfr[NI];
#pragma unroll
      for (int mi = 0; mi < 4; ++mi) af[mi] = *(const bf16x8*)(Ac + mi * 16 * LDT + ks * 32);
#pragma unroll
      for (int ni = 0; ni < NI; ++ni) bfr[ni] = *(const bf16x8*)(Bc + ni * 16 * LDT + ks * 32);
#pragma unroll
      for (int mi = 0; mi < 4; ++mi)
#pragma unroll
        for (int ni = 0; ni < NI; ++ni)
          acc[mi][ni] = __builtin_amdgcn_mfma_f32_16x16x32_bf16(bfr[ni], af[mi], acc[mi][ni], 0, 0, 0);
    }
    if (kt + 1 < nk) {
      const int nxt = cur ^ 1;
#pragma unroll
      for (int i = 0; i < 4; ++i) {
        const int c = tid + i * 256, row = c >> 3, kc = (c & 7) * 8;
        *(uint4*)(As + nxt * 128 * LDT + row * LDT + kc) = ra[i];
        if (i < NBI) *(uint4*)(Bs + nxt * 128 * LDT + row * LDT + kc) = rb[i];
      }
    }
    __syncthreads();
  }
}
template <int NI>
DI void zero_acc(f32x4 (&acc)[4][NI]) {
#pragma unroll
  for (int i = 0; i < 4; ++i)
#pragma unroll
    for (int j = 0; j < NI; ++j) acc[i][j] = f32x4{0.f, 0.f, 0.f, 0.f};
}
template <int NI>
DI void gemm256(f32x4 (&acc)[8][NI], const u16* __restrict__ A, int lda, const u16* __restrict__ Bt, int ldb, int K, int m0, int n0, char* smem) {
  LAUNDER_IDS
  const int lane = tid__ & 63, wave = tid__ >> 6, wr = wave >> 1, wc = wave & 1, lr = lane & 15, lq = lane >> 4;
  constexpr int NBW = NI / 2;
  constexpr int STAGE = 16384 + NI * 2 * 1024;
  constexpr int LPS = 4 + NBW;
  const int srow = lane >> 2, scol = ((lane & 3) ^ ((lane >> 5) << 1)) * 8;
  const u16* Ag = A + (size_t)(m0 + wave * 64 + srow) * lda + scol;
  const u16* Bg = Bt + (size_t)(n0 + wave * NBW * 16 + srow) * ldb + scol;
  char* la = smem + (wave * 4) * 1024 + lane * 16;
  char* lb = smem + 16384 + (wave * NBW) * 1024 + lane * 16;
#define G256_ISSUE(S, K0) do { \
    _Pragma("unroll") for (int j_ = 0; j_ < 4; ++j_) \
      __builtin_amdgcn_global_load_lds((const unsigned*)(Ag + (size_t)j_ * 16 * lda + (K0)), (__attribute__((address_space(3))) unsigned*)(la + (S) * STAGE + j_ * 1024), 16, 0, 0); \
    _Pragma("unroll") for (int j_ = 0; j_ < NBW; ++j_) \
      __builtin_amdgcn_global_load_lds((const unsigned*)(Bg + (size_t)j_ * 16 * ldb + (K0)), (__attribute__((address_space(3))) unsigned*)(lb + (S) * STAGE + j_ * 1024), 16, 0, 0); \
  } while (0)
  const int nk = K >> 5;
  G256_ISSUE(0, 0);
  if (nk > 1) G256_ISSUE(1, 32);
  const int foff = lr * 64 + ((lq ^ ((lr >> 3) << 1)) * 16);
  int st = 0;
  for (int kt = 0; kt < nk; ++kt) {
    if (kt + 1 < nk) asm volatile("s_waitcnt vmcnt(%0) lgkmcnt(0)" :: "n"(LPS) : "memory");
    else asm volatile("s_waitcnt vmcnt(0) lgkmcnt(0)" ::: "memory");
    __builtin_amdgcn_s_barrier();
    if (kt + 2 < nk) { const int s2 = st >= 1 ? st - 1 : 2; G256_ISSUE(s2, (kt + 2) * 32); }
    const char* sb = smem + st * STAGE + foff;
    bf16x8 af[8], bfr[NI];
#pragma unroll
    for (int mi = 0; mi < 8; ++mi) af[mi] = *(const bf16x8*)(sb + (wr * 8 + mi) * 1024);
#pragma unroll
    for (int ni = 0; ni < NI; ++ni) bfr[ni] = *(const bf16x8*)(sb + 16384 + (wc * NI + ni) * 1024);
#pragma unroll
    for (int mi = 0; mi < 8; ++mi)
#pragma unroll
      for (int ni = 0; ni < NI; ++ni)
        acc[mi][ni] = __builtin_amdgcn_mfma_f32_16x16x32_bf16(bfr[ni], af[mi], acc[mi][ni], 0, 0, 0);
    st = st == 2 ? 0 : st + 1;
  }
  asm volatile("s_waitcnt lgkmcnt(0)" ::: "memory");
  __builtin_amdgcn_s_barrier();
#undef G256_ISSUE
}
template <int NI>
DI void zero_acc8(f32x4 (&acc)[8][NI]) {
#pragma unroll
  for (int i = 0; i < 8; ++i)
#pragma unroll
    for (int j = 0; j < NI; ++j) acc[i][j] = f32x4{0.f, 0.f, 0.f, 0.f};
}
#define WAVE_COORDS const int lane = tid__ & 63, wave = tid__ >> 6, wr = wave >> 1, wc = wave & 1, lr = lane & 15, lq = lane >> 4; (void)wr; (void)wc; (void)lr; (void)lq;

DI void phase_zgemm(const Params& p, int l, char* smem) {
  LAUNDER_IDS
  WAVE_COORDS
  const u16* Wt = (const u16*)(p.ws + OFF_W + (size_t)l * W_LAYER + WO_WIN);
  const u16* hb = (const u16*)(p.ws + OFF_HB1);
  u16* za = (u16*)(p.ws + OFF_R2); u16* zr = (u16*)(p.ws + OFF_R1);
  for (int it = 0;; ++it) {
    int tm, tn;
    if (!tile_map(it, NT / 256, 17, blk__, gridDim.x, tm, tn)) break;
    const int m0 = tm * 256, n0 = tn * 128;
    f32x4 acc[8][4]; zero_acc8<4>(acc);
    gemm256<4>(acc, hb, 1024, Wt, 1024, 1024, m0, n0, smem);
#pragma unroll
    for (int mi = 0; mi < 8; ++mi) {
      const int m = m0 + wr * 128 + mi * 16 + lr;
#pragma unroll
      for (int ni = 0; ni < 4; ++ni) {
        const int n = n0 + wc * 64 + ni * 16 + lq * 4;
        uint2 v; v.x = pack2(acc[mi][ni][0], acc[mi][ni][1]); v.y = pack2(acc[mi][ni][2], acc[mi][ni][3]);
        if (n < ZA) *(uint2*)(za + (size_t)m * ZA + n) = v;
        else if (n < ZA + ZR) *(uint2*)(zr + (size_t)m * ZR + (n - ZA)) = v;
      }
    }
  }
}

DI void phase_tokA(const Params& p, int l) {
  LAUNDER_IDS
  const int wave = tid__ >> 6, lane = tid__ & 63;
  const u16* za = (const u16*)(p.ws + OFF_R2);
  float* rsq = (float*)(p.ws + OFF_RSQ); float* rskv = (float*)(p.ws + OFF_RSKV);
  u16* krb = (u16*)(p.ws + OFF_KR);
  u16* pooled = (u16*)(p.ws + OFF_R4);
  const float* rt = (const float*)(p.ws + OFF_ROPE);
  const float* gk = p.in[I_GK] + l * 96;
  for (int r = blk__ * 4 + wave; r < NT; r += gridDim.x * 4) {
    const u16* z = za + (size_t)r * ZA;
    const bool lat = r < NTL;
    const int b = lat ? r >> 12 : (r - NTL) >> 8;
    const int t = lat ? r & 4095 : (r - NTL) & 255;
    const int Ls = lat ? L : LC;
    const int pos = lat ? t : 4096 + t;
    float sq = 0.f, skv = 0.f;
#pragma unroll
    for (int i = 0; i < 6; ++i) { const float v = bf2f(z[256 + i * 64 + lane]); sq += v * v; }
#pragma unroll
    for (int i = 0; i < 4; ++i) { const float v = bf2f(z[640 + i * 64 + lane]); skv += v * v; }
    sq = wavesum(sq); skv = wavesum(skv);
    if (lane == 0) { rsq[r] = rsqrtf(sq * (1.f / 384.f) + 1e-6f); rskv[r] = rsqrtf(skv * (1.f / 256.f) + 1e-6f); }
    {
      const int d = lane & 31;
      float kr = bf2f(z[896 + d]);
      float ss = kr * kr;
      for (int o = 16; o > 0; o >>= 1) ss += __shfl_xor(ss, o, 64);
      kr = kr * rsqrtf(ss * (1.f / 32.f) + 1e-6f) * gk[64 + d];
      const float other = __shfl_xor(kr, 16, 64);
      float outv = kr;
      if (lat) {
        const int i = d & 15;
        const int pp = i < 8 ? (t >> 6) : (t & 63);
        const float cs = rt[(pp * 8 + (i & 7)) * 2], sn = rt[(pp * 8 + (i & 7)) * 2 + 1];
        outv = d < 16 ? kr * cs - other * sn : other * sn + kr * cs;
      }
      if (lane < 32) krb[(size_t)r * 32 + d] = f2bf(outv);
    }
#pragma unroll
    for (int gi = 0; gi < 4; ++gi) {
      const int half = 1 << gi;
      const int lo = max(t - half, 0), hi = min(t + half, Ls);
      const int ch = gi * 64 + lane;
      float s = 0.f;
#pragma unroll
      for (int j = 0; j < 2 * half; ++j) {
        const int q = t - half + j;
        const int qc = min(max(q, 0), Ls - 1);
        const float v = bf2f(z[(ptrdiff_t)(qc - t) * ZA + ch]);
        s += (q == qc) ? v : 0.f;
      }
      const float mean = s / (float)(hi - lo);
      pooled[(size_t)r * 256 + ch] = f2bf(mean - bf2f(z[ch]));
    }
  }
}

constexpr int ZSL = 1160, TAL = 392;
DI void phase_tokB(const Params& p, int l, char* smem) {
  LAUNDER_IDS
  WAVE_COORDS
  const int tid = tid__;
  u16* Zs = (u16*)smem;
  u16* TA = Zs + 18 * ZSL;
  float* PV = (float*)(TA + 16 * TAL);
  const u16* zr = (const u16*)(p.ws + OFF_R1);
  const char* wl = p.ws + OFF_W + (size_t)l * W_LAYER;
  u16* sc = (u16*)(p.ws + OFF_R3);
  __syncthreads();
  for (int e = tid; e < 2 * ZR + 7 * 256; e += 256) {
    float v;
    if (e < 2 * ZR) v = p.in[I_MU][(size_t)l * 2 * ZR + e];
    else { const int f = e - 2 * ZR, a = f >> 8, c = f & 255;
      v = a == 0 ? p.in[I_KK][l * 256 + c] : a < 3 ? p.in[I_W0][(size_t)(l * 2 + a - 1) * 256 + c] : a < 5 ? p.in[I_A0][(size_t)(l * 2 + a - 3) * 256 + c] : p.in[I_KA][(size_t)(l * 2 + a - 5) * 256 + c]; }
    PV[e] = v;
  }
  const float* mu0 = PV; const float* mu1 = PV + ZR; const float* kkw = PV + 2 * ZR;
  const float* w0p = kkw + 256; const float* a0p = w0p + 512; const float* kap = a0p + 512;
  for (int tile = blk__; tile < NT / 16; tile += gridDim.x) {
    const int r0 = tile * 16;
    const bool lat = r0 < NTL;
    const int t0 = lat ? r0 & 4095 : (r0 - NTL) & 255;
    const int Ls = lat ? L : LC;
    __syncthreads();
    {
      uint4 v[11];
#pragma unroll
      for (int i = 0; i < 11; ++i) {
        const int c = tid + i * 256;
        const int ri = c / 144, ch = c - ri * 144;
        const int tt = t0 - 1 + ri;
        const int cc = min(c, 18 * 144 - 1);
        const int rc = cc / 144, chc = cc - rc * 144;
        const int ttc = min(max(t0 - 1 + rc, 0), Ls - 1);
        const uint4 ld = *(const uint4*)(zr + (size_t)(r0 - t0 + ttc) * ZR + chc * 8);
        const bool ok = (c < 18 * 144) && (tt >= 0) && (tt < Ls);
        v[i] = ok ? ld : make_uint4(0, 0, 0, 0);
      }
#pragma unroll
      for (int i = 0; i < 11; ++i) {
        const int c = tid + i * 256;
        const int ri = c / 144, ch = c - ri * 144;
        if (c < 18 * 144) {
          *(uint2*)(Zs + ri * ZSL + ch * 8) = make_uint2(v[i].x, v[i].y);
          *(uint2*)(Zs + ri * ZSL + ch * 8 + 4) = make_uint2(v[i].z, v[i].w);
        }
      }
    }
    __syncthreads();
#pragma unroll 4
    for (int e = tid; e < 16 * 384; e += 256) {
      const int i = e / 384, c = e - i * 384, zc = 768 + c;
      const float z = bf2f(Zs[(i + 1) * ZSL + zc]), zp = bf2f(Zs[i * ZSL + zc]), zn = bf2f(Zs[(i + 2) * ZSL + zc]);
      float v = z + mu0[zc] * (zp - z) + mu1[zc] * (zn - z);
      if (c < 128) v = 1.f - 2.f / (1.f + __expf(2.f * v)); else if (c >= 256) v = sigmoidf_(v);
      TA[i * TAL + c] = f2bf(v);
    }
    __syncthreads();
    const int row = r0 + lr;
    auto shifted4 = [&](int zc, float (&out)[4]) {
      const uint2 c0 = *(const uint2*)(Zs + (lr + 1) * ZSL + zc), cp = *(const uint2*)(Zs + lr * ZSL + zc), cn = *(const uint2*)(Zs + (lr + 2) * ZSL + zc);
      const float4 m0 = *(const float4*)(mu0 + zc), m1 = *(const float4*)(mu1 + zc);
      float z, zp, zn;
      z = bflo(c0.x); zp = bflo(cp.x); zn = bflo(cn.x); out[0] = z + m0.x * (zp - z) + m1.x * (zn - z);
      z = bfhi(c0.x); zp = bfhi(cp.x); zn = bfhi(cn.x); out[1] = z + m0.y * (zp - z) + m1.y * (zn - z);
      z = bflo(c0.y); zp = bflo(cp.y); zn = bflo(cn.y); out[2] = z + m0.z * (zp - z) + m1.z * (zn - z);
      z = bfhi(c0.y); zp = bfhi(cp.y); zn = bfhi(cn.y); out[3] = z + m0.w * (zp - z) + m1.w * (zn - z);
    };
    auto product = [&](f32x4 (&ac)[4], const u16* W, int Kq, int off) {
#pragma unroll
      for (int ni = 0; ni < 4; ++ni) ac[ni] = f32x4{0.f, 0.f, 0.f, 0.f};
#pragma unroll 2
      for (int ks = 0; ks < Kq / 32; ++ks) {
        const bf16x8 bop = *(const bf16x8*)(TA + lr * TAL + off + ks * 32 + lq * 8);
#pragma unroll
        for (int ni = 0; ni < 4; ++ni) {
          const bf16x8 aop = *(const bf16x8*)(W + (size_t)(wave * 64 + ni * 16 + lr) * Kq + ks * 32 + lq * 8);
          ac[ni] = __builtin_amdgcn_mfma_f32_16x16x32_bf16(aop, bop, ac[ni], 0, 0, 0);
        }
      }
      __builtin_amdgcn_sched_barrier(0);
    };
    float ss = 0.f;
#pragma unroll
    for (int ni = 0; ni < 4; ++ni) {
      const int ch = wave * 64 + ni * 16 + lq * 4;
      float kx[4]; shifted4(256 + ch, kx);
      const float4 kw = *(const float4*)(kkw + ch);
      const float a0 = kx[0] * kw.x, a1 = kx[1] * kw.y, a2 = kx[2] * kw.z, a3 = kx[3] * kw.w;
      ss += a0 * a0 + a1 * a1 + a2 * a2 + a3 * a3;
    }
    ss += __shfl_xor(ss, 16, 64); ss += __shfl_xor(ss, 32, 64);
    const float kinv = rsqrtf(fmaxf(ss, 1e-24f));
    {
      f32x4 ag[4];
      product(ag, (const u16*)(wl + WO_RG2), 128, 256);
#pragma unroll
      for (int ni = 0; ni < 4; ++ni) {
        const int ch = wave * 64 + ni * 16 + lq * 4;
        const size_t o = (size_t)row * 256 + ch;
        float rx[4], kx[4], vx[4];
        shifted4(ch, rx); shifted4(256 + ch, kx); shifted4(512 + ch, vx);
        const float4 kw = *(const float4*)(kkw + ch);
        *(uint2*)(sc + SA_R * (size_t)NT * 256 + o) = make_uint2(pack2(rx[0], rx[1]), pack2(rx[2], rx[3]));
        *(uint2*)(sc + SA_V * (size_t)NT * 256 + o) = make_uint2(pack2(vx[0], vx[1]), pack2(vx[2], vx[3]));
        *(uint2*)(sc + SA_KKN * (size_t)NT * 256 + o) = make_uint2(pack2(-kx[0] * kw.x * kinv, -kx[1] * kw.y * kinv), pack2(-kx[2] * kw.z * kinv, -kx[3] * kw.w * kinv));
        *(uint2*)(sc + SA_G * (size_t)NT * 256 + o) = make_uint2(pack2(ag[ni][0], ag[ni][1]), pack2(ag[ni][2], ag[ni][3]));
        __builtin_amdgcn_sched_barrier(0);
      }
    }
#pragma unroll 1
    for (int d = 0; d < 2; ++d) {
      f32x4 aw[4], aa[4];
      product(aw, (const u16*)(wl + WO_RW2) + (size_t)d * 256 * 64, 64, d * 64);
      product(aa, (const u16*)(wl + WO_RA2) + (size_t)d * 256 * 64, 64, 128 + d * 64);
      __builtin_amdgcn_sched_barrier(0);
      u16* oOMW = sc + (d ? SA_OMWB : SA_OMWF) * (size_t)NT * 256;
      u16* oKD = sc + (d ? SA_KDB : SA_KDF) * (size_t)NT * 256;
      u16* oB = sc + (d ? SA_BB : SA_BF) * (size_t)NT * 256;
#pragma unroll
      for (int ni = 0; ni < 4; ++ni) {
        const int ch = wave * 64 + ni * 16 + lq * 4;
        const size_t o = (size_t)row * 256 + ch;
        float kx[4]; shifted4(256 + ch, kx);
        const float4 kw = *(const float4*)(kkw + ch);
        const float kkn[4] = {kx[0] * kw.x * kinv, kx[1] * kw.y * kinv, kx[2] * kw.z * kinv, kx[3] * kw.w * kinv};
        const float4 w0 = *(const float4*)(w0p + d * 256 + ch);
        const float4 a0 = *(const float4*)(a0p + d * 256 + ch);
        const float4 ka = *(const float4*)(kap + d * 256 + ch);
        const float w0a[4] = {w0.x, w0.y, w0.z, w0.w}, a0a[4] = {a0.x, a0.y, a0.z, a0.w}, kaa[4] = {ka.x, ka.y, ka.z, ka.w};
        float omw[4], kd[4], bb[4];
#pragma unroll
        for (int j = 0; j < 4; ++j) {
          const float xw = -(w0a[j] + aw[ni][j]);
          const float sp = fmaxf(xw, 0.f) + __logf(1.f + __expf(-fabsf(xw)));
          const float wlog = -sp - 0.5f;
          const float e = __expf(wlog);
          omw[j] = 1.f - __expf(-e);
          const float a = sigmoidf_(a0a[j] + aa[ni][j]);
          kd[j] = kx[j] * (1.f + (a - 1.f) * kaa[j]);
          bb[j] = kkn[j] * a;
        }
        *(uint2*)(oOMW + o) = make_uint2(pack2(omw[0], omw[1]), pack2(omw[2], omw[3]));
        *(uint2*)(oKD + o) = make_uint2(pack2(kd[0], kd[1]), pack2(kd[2], kd[3]));
        *(uint2*)(oB + o) = make_uint2(pack2(bb[0], bb[1]), pack2(bb[2], bb[3]));
        __builtin_amdgcn_sched_barrier(0);
      }
    }
  }
}

DI size_t qk_index(int m, int h) {
  const bool lat = m < NTL;
  const int b = lat ? m >> 12 : (m - NTL) >> 8;
  const int pos = lat ? m & 4095 : 4096 + ((m - NTL) & 255);
  return ((size_t)(b * 8 + h) * LK + pos) * 96;
}
DI void phase_qkv(const Params& p, int l, char* smem) {
  LAUNDER_IDS
  WAVE_COORDS
  const char* wl = p.ws + OFF_W + (size_t)l * W_LAYER;
  const u16* za = (const u16*)(p.ws + OFF_R2);
  const float* rsq0 = (const float*)(p.ws + OFF_RSQ); const float* rskv0 = (const float*)(p.ws + OFF_RSKV);
  u16* Qb = (u16*)(p.ws + OFF_R1); u16* Kb = (u16*)(p.ws + OFF_R1 + SZ_Q); u16* Vt = (u16*)(p.ws + OFF_R1 + 2 * SZ_Q);
  const float* rt0 = (const float*)(p.ws + OFF_ROPE);
  const float* gq0 = p.in[I_GQ] + l * 96; const float* gk0 = p.in[I_GK] + l * 96;
  const float QS = 0.10206207261596577f * 1.4426950408889634f;
  constexpr int NTM = NT / 256;
  for (int it = 0;; ++it) {
    int tm, tn;
    if (!tile_map(it, NTM, 6, blk__, gridDim.x, tm, tn)) break;
    f32x4 acc[8][4]; zero_acc8<4>(acc);
    {
      const int m0 = tm * 256, n0 = tn * 128;
      gemm256<4>(acc, za + 256, ZA, (const u16*)(wl + WO_UQ), 384, 384, m0, n0, smem);
      const float* gq = gq0; const float* rt = rt0; const float* rsq = rsq0;
      asm volatile("" : "+v"(gq), "+v"(rt), "+v"(rsq));
      const int nw = n0 + wc * 64;
#pragma unroll
      for (int mi = 0; mi < 8; ++mi) {
        __builtin_amdgcn_sched_barrier(0);
        const int m = m0 + wr * 128 + mi * 16 + lr;
        const float rs = rsq[m];
        if (nw < 512) {
          const int h = nw >> 6;
          float ss = 0.f;
#pragma unroll
          for (int ni = 0; ni < 4; ++ni)
#pragma unroll
            for (int j = 0; j < 4; ++j) { const float v = acc[mi][ni][j] * rs; ss += v * v; }
          ss += __shfl_xor(ss, 16, 64); ss += __shfl_xor(ss, 32, 64);
          const float f = rs * rsqrtf(ss * (1.f / 64.f) + 1e-6f) * QS;
          u16* dst = Qb + qk_index(m, h);
#pragma unroll
          for (int ni = 0; ni < 4; ++ni) {
            const int d = ni * 16 + lq * 4;
            const float4 g = *(const float4*)(gq + d);
            *(uint2*)(dst + d) = make_uint2(pack2(acc[mi][ni][0] * f * g.x, acc[mi][ni][1] * f * g.y), pack2(acc[mi][ni][2] * f * g.z, acc[mi][ni][3] * f * g.w));
          }
        } else {
          const bool lat = m < NTL;
          const int tt = m & 4095;
#pragma unroll
          for (int hh = 0; hh < 2; ++hh) {
            __builtin_amdgcn_sched_barrier(0);
            const int h = ((nw - 512) >> 5) + hh;
            float ss = 0.f;
#pragma unroll
            for (int ni = 0; ni < 2; ++ni)
#pragma unroll
              for (int j = 0; j < 4; ++j) { const float v = acc[mi][hh * 2 + ni][j] * rs; ss += v * v; }
            ss += __shfl_xor(ss, 16, 64); ss += __shfl_xor(ss, 32, 64);
            const float f = rs * rsqrtf(ss * (1.f / 32.f) + 1e-6f) * QS;
            const int i0 = lq * 4;
            const float4 g1 = *(const float4*)(gq + 64 + i0), g2 = *(const float4*)(gq + 80 + i0);
            const float g1a[4] = {g1.x, g1.y, g1.z, g1.w}, g2a[4] = {g2.x, g2.y, g2.z, g2.w};
            float o1[4], o2[4];
#pragma unroll
            for (int j = 0; j < 4; ++j) {
              const float x1 = acc[mi][hh * 2][j] * f * g1a[j], x2 = acc[mi][hh * 2 + 1][j] * f * g2a[j];
              float cs = 1.f, sn = 0.f;
              if (lat) {
                const int i = i0 + j;
                const int pp = i < 8 ? (tt >> 6) : (tt & 63);
                cs = rt[(pp * 8 + (i & 7)) * 2]; sn = rt[(pp * 8 + (i & 7)) * 2 + 1];
              }
              o1[j] = x1 * cs - x2 * sn; o2[j] = x1 * sn + x2 * cs;
            }
            u16* dst = Qb + qk_index(m, h) + 64;
            *(uint2*)(dst + i0) = make_uint2(pack2(o1[0], o1[1]), pack2(o1[2], o1[3]));
            *(uint2*)(dst + 16 + i0) = make_uint2(pack2(o2[0], o2[1]), pack2(o2[2], o2[3]));
          }
        }
      }
    }
  }
  __builtin_amdgcn_sched_barrier(0);
  for (int it = 0;; ++it) {
    int tm, tn;
    if (!tile_map(it, NTM, 8, blk__, gridDim.x, tm, tn)) break;
    f32x4 acc[8][4]; zero_acc8<4>(acc);
    {
      const int h = tn, m0 = tm * 256, n0 = h * 128;
      gemm256<4>(acc, za + 640, ZA, (const u16*)(wl + WO_UKV), 256, 256, m0, n0, smem);
      const float* gk = gk0; const float* rskv = rskv0;
      asm volatile("" : "+v"(gk), "+v"(rskv));
#pragma unroll
      for (int mi = 0; mi < 8; ++mi) {
        __builtin_amdgcn_sched_barrier(0);
        const int m = m0 + wr * 128 + mi * 16 + lr;
        const float rs = rskv[m];
        if (wc == 0) {
          float ss = 0.f;
#pragma unroll
          for (int ni = 0; ni < 4; ++ni)
#pragma unroll
            for (int j = 0; j < 4; ++j) { const float v = acc[mi][ni][j] * rs; ss += v * v; }
          ss += __shfl_xor(ss, 16, 64); ss += __shfl_xor(ss, 32, 64);
          const float f = rs * rsqrtf(ss * (1.f / 64.f) + 1e-6f);
          u16* dst = Kb + qk_index(m, h);
#pragma unroll
          for (int ni = 0; ni < 4; ++ni) {
            const int d = ni * 16 + lq * 4;
            const float4 g = *(const float4*)(gk + d);
            *(uint2*)(dst + d) = make_uint2(pack2(acc[mi][ni][0] * f * g.x, acc[mi][ni][1] * f * g.y), pack2(acc[mi][ni][2] * f * g.z, acc[mi][ni][3] * f * g.w));
          }
          *(uint4*)(dst + 64 + lq * 8) = *(const uint4*)((const u16*)(p.ws + OFF_KR) + (size_t)m * 32 + lq * 8);
        } else {
          const bool lat = m < NTL;
          const int b = lat ? m >> 12 : (m - NTL) >> 8;
          const int pos = lat ? m & 4095 : 4096 + ((m - NTL) & 255);
          u16* dst = Vt + (size_t)(b * 8 + h) * 64 * LK + pos + (size_t)(lq * 4) * LK;
#pragma unroll
          for (int ni = 0; ni < 4; ++ni) {
            asm volatile("" : "+v"(dst));
#pragma unroll
            for (int j = 0; j < 4; ++j) dst[j * LK] = f2bf(acc[mi][ni][j] * rs);
            dst += 16 * LK;
          }
        }
      }
    }
  }
}

DI int scan_row(int b, int dir, int s) {
  if (s < LC) return NTL + b * LC + (dir ? LC - 1 - s : s);
  const int t = s - LC;
  return b * L + (dir ? L - 1 - t : t);
}
DI void phase_scan(const Params& p, char* smem) {
  LAUNDER_IDS
  const int blk = blk__;
  if (blk >= 256) return;
  const int tid = tid__, lane = tid & 63, wave = tid >> 6, kq = lane & 15, rg = lane >> 4;
  const int chain = (blk & 7) + 8 * (blk >> 5), quarter = (blk >> 3) & 3;
  const int b = chain >> 3, h = (chain >> 1) & 3, dir = chain & 1;
  const u16* sc = (const u16*)(p.ws + OFF_R3);
  const size_t AS = (size_t)NT * 256;
  const u16* aOMW = sc + (dir ? SA_OMWB : SA_OMWF) * AS;
  const u16* aKD = sc + (dir ? SA_KDB : SA_KDF) * AS;
  const u16* aB = sc + (dir ? SA_BB : SA_BF) * AS;
  const u16* aKKN = sc + SA_KKN * AS;
  const u16* aR = sc + SA_R * AS;
  const u16* aV = sc + SA_V * AS;
  u16* Y = (u16*)(p.ws + OFF_R2) + (dir ? AS : 0);
  constexpr int CH = 16, BSZ = 5 * CH * 64 + CH * 16;
  float* buf = (float*)smem;
  const int st_ld = tid >> 4, k4 = (tid & 15) * 4;
  const int vrow = quarter * 16 + wave * 4 + rg;
  uint2 g0, g1, g2, g3, g4; u16 gv;
#define SCAN_GLOAD(CHUNK) do { \
    const int row_ = scan_row(b, dir, (CHUNK) * CH + st_ld); \
    const size_t o_ = (size_t)row_ * 256 + h * 64 + k4; \
    g0 = *(const uint2*)(aOMW + o_); g1 = *(const uint2*)(aKD + o_); g2 = *(const uint2*)(aB + o_); g3 = *(const uint2*)(aKKN + o_); g4 = *(const uint2*)(aR + o_); \
    gv = aV[(size_t)row_ * 256 + h * 64 + quarter * 16 + (tid & 15)]; } while (0)
#define SCAN_LSTORE(BI) do { \
    float* bb_ = buf + (BI) * BSZ + st_ld * 64 + k4; \
    *(float4*)(bb_ + 0 * CH * 64) = make_float4(1.f - bflo(g0.x), 1.f - bfhi(g0.x), 1.f - bflo(g0.y), 1.f - bfhi(g0.y)); \
    *(float4*)(bb_ + 1 * CH * 64) = make_float4(bflo(g1.x), bfhi(g1.x), bflo(g1.y), bfhi(g1.y)); \
    *(float4*)(bb_ + 2 * CH * 64) = make_float4(bflo(g2.x), bfhi(g2.x), bflo(g2.y), bfhi(g2.y)); \
    *(float4*)(bb_ + 3 * CH * 64) = make_float4(bflo(g3.x), bfhi(g3.x), bflo(g3.y), bfhi(g3.y)); \
    *(float4*)(bb_ + 4 * CH * 64) = make_float4(bflo(g4.x), bfhi(g4.x), bflo(g4.y), bfhi(g4.y)); \
    buf[(BI) * BSZ + 5 * CH * 64 + st_ld * 16 + (tid & 15)] = bf2f(gv); } while (0)
  float2_t S01 = {0.f, 0.f}, S23 = {0.f, 0.f};
  __builtin_amdgcn_s_setprio(3);
  __syncthreads();
  SCAN_GLOAD(0); SCAN_LSTORE(0);
  __syncthreads();
  constexpr int NCH = LK / CH;
  for (int c = 0; c < NCH; ++c) {
    if (c + 1 < NCH) SCAN_GLOAD(c + 1);
    const float* bb = buf + (c & 1) * BSZ;
    const int rowbase = scan_row(b, dir, c * CH);
    const int rstep = dir ? -1 : 1;
    const float* bl = bb + kq * 4;
    const float* bv = bb + 5 * CH * 64 + wave * 4 + rg;
    float4 fw = *(const float4*)(bl + 0 * CH * 64), fk = *(const float4*)(bl + 1 * CH * 64), fb = *(const float4*)(bl + 2 * CH * 64),
           fa = *(const float4*)(bl + 3 * CH * 64), fr = *(const float4*)(bl + 4 * CH * 64);
    float vv = bv[0];
    float ysel = 0.f;
#pragma unroll
    for (int s = 0; s < CH; ++s) {
      const float2_t a01 = {fa.x, fa.y}, a23 = {fa.z, fa.w};
      const float2_t w01 = {fw.x, fw.y}, w23 = {fw.z, fw.w}, k01 = {fk.x, fk.y}, k23 = {fk.z, fk.w}, b01 = {fb.x, fb.y}, b23 = {fb.z, fb.w};
      const float2_t r01 = {fr.x, fr.y}, r23 = {fr.z, fr.w};
      const float2_t vv2 = {vv, vv};
      if (s + 1 < CH) {
        fw = *(const float4*)(bl + 0 * CH * 64 + (s + 1) * 64); fk = *(const float4*)(bl + 1 * CH * 64 + (s + 1) * 64); fb = *(const float4*)(bl + 2 * CH * 64 + (s + 1) * 64);
        fa = *(const float4*)(bl + 3 * CH * 64 + (s + 1) * 64); fr = *(const float4*)(bl + 4 * CH * 64 + (s + 1) * 64);
        vv = bv[(s + 1) * 16];
      }
      float2_t t2 = S01 * a01; t2 = S23 * a23 + t2;
      const float sa = rowsum16(t2.x + t2.y);
      const float2_t sa2 = {sa, sa};
      float2_t u01 = vv2 * k01; u01 = sa2 * b01 + u01; S01 = S01 * w01 + u01;
      float2_t u23 = vv2 * k23; u23 = sa2 * b23 + u23; S23 = S23 * w23 + u23;
      float2_t y2 = S01 * r01; y2 = S23 * r23 + y2;
      const float y = rowsum16(y2.x + y2.y);
      ysel = (kq == s) ? y : ysel;
    }
    Y[(size_t)(rowbase + rstep * kq) * 256 + h * 64 + vrow] = f2bf(ysel);
    if (c + 1 < NCH) SCAN_LSTORE((c + 1) & 1);
    __syncthreads();
  }
  __builtin_amdgcn_s_setprio(0);
#undef SCAN_GLOAD
#undef SCAN_LSTORE
}

constexpr int KSL = 104, VSL = 68;
template <int B0>
DI bf16x8 pack8(const f32x16& v) {
  uint4 pw;
  pw.x = pack2(v[B0 + 0], v[B0 + 1]); pw.y = pack2(v[B0 + 2], v[B0 + 3]); pw.z = pack2(v[B0 + 4], v[B0 + 5]); pw.w = pack2(v[B0 + 6], v[B0 + 7]);
  return __builtin_bit_cast(bf16x8, pw);
}
DI void pv_step(f32x16& o0, f32x16& o1, const u16* Vc, int r32, int kb, bf16x8 pf) {
  {
    const uint2 lo = *(const uint2*)(Vc + r32 * VSL + kb), hi2 = *(const uint2*)(Vc + r32 * VSL + kb + 8);
    const bf16x8 va = __builtin_bit_cast(bf16x8, make_uint4(lo.x, lo.y, hi2.x, hi2.y));
    o0 = __builtin_amdgcn_mfma_f32_32x32x16_bf16(va, pf, o0, 0, 0, 0);
  }
  {
    const uint2 lo = *(const uint2*)(Vc + (32 + r32) * VSL + kb), hi2 = *(const uint2*)(Vc + (32 + r32) * VSL + kb + 8);
    const bf16x8 va = __builtin_bit_cast(bf16x8, make_uint4(lo.x, lo.y, hi2.x, hi2.y));
    o1 = __builtin_amdgcn_mfma_f32_32x32x16_bf16(va, pf, o1, 0, 0, 0);
  }
}
DI void attn_item(const Params& p, int item, char* smem) {
  LAUNDER_IDS
  const int tid = tid__, lane = tid & 63, wave = tid >> 6, r32 = lane & 31, hi = lane >> 5;
  int bh, qpos0, key0, nkt, orow0;
  if (item < 2048) { bh = item >> 5; const int qb = item & 31; qpos0 = qb * 128; key0 = 0; nkt = LK / 64; orow0 = (bh >> 3) * L + qpos0; }
  else { const int it = item - 2048; bh = it >> 1; const int qb = it & 1; qpos0 = 4096 + qb * 128; key0 = 4096; nkt = LC / 64; orow0 = NTL + (bh >> 3) * LC + qb * 128; }
  const int h = bh & 7;
  const u16* Qp = (const u16*)(p.ws + OFF_R1) + ((size_t)bh * LK + qpos0 + wave * 32 + r32) * 96 + hi * 8;
  const u16* Kp = (const u16*)(p.ws + OFF_R1 + SZ_Q) + ((size_t)bh * LK + key0) * 96;
  const u16* Vp = (const u16*)(p.ws + OFF_R1 + 2 * SZ_Q) + (size_t)bh * 64 * LK + key0;
  u16* Ks = (u16*)smem;
  u16* Vs = Ks + 2 * 64 * KSL;
  bf16x8 qr[6];
#pragma unroll
  for (int d0 = 0; d0 < 6; ++d0) qr[d0] = *(const bf16x8*)(Qp + d0 * 16);
  uint4 sk0, sk1, sk2, sv0, sv1;
  const int kr0 = tid / 12, kc0 = tid - kr0 * 12, kr1 = (tid + 256) / 12, kc1 = (tid + 256) - kr1 * 12, kr2 = (tid + 512) / 12, kc2 = (tid + 512) - kr2 * 12;
  const int vd0 = tid >> 3, vc0 = tid & 7, vd1 = vd0 + 32;
#define gload(kt) do { \
    sk0 = *(const uint4*)(Kp + (size_t)((kt) * 64 + kr0) * 96 + kc0 * 8); sk1 = *(const uint4*)(Kp + (size_t)((kt) * 64 + kr1) * 96 + kc1 * 8); \
    sk2 = *(const uint4*)(Kp + (size_t)((kt) * 64 + kr2) * 96 + kc2 * 8); \
    sv0 = *(const uint4*)(Vp + (size_t)vd0 * LK + (kt) * 64 + vc0 * 8); sv1 = *(const uint4*)(Vp + (size_t)vd1 * LK + (kt) * 64 + vc0 * 8); } while (0)
#define lstore(bi) do { \
    *(uint4*)(Ks + (bi) * 64 * KSL + kr0 * KSL + kc0 * 8) = sk0; *(uint4*)(Ks + (bi) * 64 * KSL + kr1 * KSL + kc1 * 8) = sk1; *(uint4*)(Ks + (bi) * 64 * KSL + kr2 * KSL + kc2 * 8) = sk2; \
    { u16* dst = Vs + (bi) * 64 * VSL + vd0 * VSL + vc0 * 8; *(uint2*)dst = make_uint2(sv0.x, sv0.y); *(uint2*)(dst + 4) = make_uint2(sv0.z, sv0.w); } \
    { u16* dst = Vs + (bi) * 64 * VSL + vd1 * VSL + vc0 * 8; *(uint2*)dst = make_uint2(sv1.x, sv1.y); *(uint2*)(dst + 4) = make_uint2(sv1.z, sv1.w); } } while (0)
  f32x16 o0, o1;
#pragma unroll
  for (int i = 0; i < 16; ++i) { o0[i] = 0.f; o1[i] = 0.f; }
  float mrun = -1e30f, lrun = 0.f;
  __syncthreads();
  gload(0); lstore(0);
  __syncthreads();
  for (int kt = 0; kt < nkt; ++kt) {
    const int cur = kt & 1;
    if (kt + 1 < nkt) gload(kt + 1);
    const u16* Kc = Ks + cur * 64 * KSL;
    const u16* Vc = Vs + cur * 64 * VSL;
    f32x16 p0, p1;
#pragma unroll
    for (int i = 0; i < 16; ++i) { p0[i] = 0.f; p1[i] = 0.f; }
#pragma unroll
    for (int d0 = 0; d0 < 6; ++d0) {
      const bf16x8 a0 = *(const bf16x8*)(Kc + r32 * KSL + d0 * 16 + hi * 8);
      const bf16x8 a1 = *(const bf16x8*)(Kc + (32 + r32) * KSL + d0 * 16 + hi * 8);
      p0 = __builtin_amdgcn_mfma_f32_32x32x16_bf16(a0, qr[d0], p0, 0, 0, 0);
      p1 = __builtin_amdgcn_mfma_f32_32x32x16_bf16(a1, qr[d0], p1, 0, 0, 0);
    }
    float mx = p0[0];
#pragma unroll
    for (int i = 1; i < 16; ++i) mx = fmaxf(mx, p0[i]);
#pragma unroll
    for (int i = 0; i < 16; ++i) mx = fmaxf(mx, p1[i]);
    mx = fmaxf(mx, __shfl_xor(mx, 32, 64));
    if (!__all(mx - mrun <= 8.f)) {
      const float mn = fmaxf(mrun, mx);
      const float alpha = __builtin_amdgcn_exp2f(mrun - mn);
      mrun = mn; lrun *= alpha;
#pragma unroll
      for (int i = 0; i < 16; ++i) { o0[i] *= alpha; o1[i] *= alpha; }
    }
    float ps = 0.f;
#pragma unroll
    for (int i = 0; i < 16; ++i) { p0[i] = __builtin_amdgcn_exp2f(p0[i] - mrun); ps += p0[i]; }
#pragma unroll
    for (int i = 0; i < 16; ++i) { p1[i] = __builtin_amdgcn_exp2f(p1[i] - mrun); ps += p1[i]; }
    lrun += ps;
    pv_step(o0, o1, Vc, r32, 0 + hi * 4, pack8<0>(p0));
    pv_step(o0, o1, Vc, r32, 16 + hi * 4, pack8<8>(p0));
    pv_step(o0, o1, Vc, r32, 32 + hi * 4, pack8<0>(p1));
    pv_step(o0, o1, Vc, r32, 48 + hi * 4, pack8<8>(p1));
    if (kt + 1 < nkt) lstore(cur ^ 1);
    __syncthreads();
  }
  lrun += __shfl_xor(lrun, 32, 64);
  const float inv = 1.f / lrun;
  u16* om = (u16*)(p.ws + OFF_OMLA) + (size_t)(orow0 + wave * 32 + r32) * 512 + h * 64;
#pragma unroll
  for (int g = 0; g < 4; ++g) {
    const int d = 8 * g + 4 * hi;
    *(uint2*)(om + d) = make_uint2(pack2(o0[4 * g] * inv, o0[4 * g + 1] * inv), pack2(o0[4 * g + 2] * inv, o0[4 * g + 3] * inv));
    *(uint2*)(om + 32 + d) = make_uint2(pack2(o1[4 * g] * inv, o1[4 * g + 1] * inv), pack2(o1[4 * g + 2] * inv, o1[4 * g + 3] * inv));
  }
#undef gload
#undef lstore
}

DI void readout_row(const Params& p, int l, int r) {
  LAUNDER_IDS
  const int lane = tid__ & 63;
  const u16* sc = (const u16*)(p.ws + OFF_R3);
  const size_t AS = (size_t)NT * 256;
  const size_t o = (size_t)r * 256 + lane * 4;
  const u16* Yf = (const u16*)(p.ws + OFF_R2);
  const uint2 yf = *(const uint2*)(Yf + o), yb = *(const uint2*)(Yf + AS + o);
  const uint2 ur = *(const uint2*)(sc + SA_R * AS + o), uv = *(const uint2*)(sc + SA_V * AS + o);
  const uint2 kf = *(const uint2*)(sc + SA_KDF * AS + o), kb = *(const uint2*)(sc + SA_KDB * AS + o), ug = *(const uint2*)(sc + SA_G * AS + o);
  float y[4] = {bflo(yf.x) + bflo(yb.x), bfhi(yf.x) + bfhi(yb.x), bflo(yf.y) + bflo(yb.y), bfhi(yf.y) + bfhi(yb.y)};
  const float rr[4] = {bflo(ur.x), bfhi(ur.x), bflo(ur.y), bfhi(ur.y)};
  const float vv[4] = {bflo(uv.x), bfhi(uv.x), bflo(uv.y), bfhi(uv.y)};
  const float km[4] = {0.5f * (bflo(kf.x) + bflo(kb.x)), 0.5f * (bfhi(kf.x) + bfhi(kb.x)), 0.5f * (bflo(kf.y) + bflo(kb.y)), 0.5f * (bfhi(kf.y) + bfhi(kb.y))};
  const float gg[4] = {bflo(ug.x), bfhi(ug.x), bflo(ug.y), bfhi(ug.y)};
  const float4 rk4 = *(const float4*)(p.in[I_RK] + l * 256 + lane * 4);
  const float4 lw4 = *(const float4*)(p.in[I_LNW] + l * 256 + lane * 4);
  const float4 lb4 = *(const float4*)(p.in[I_LNB] + l * 256 + lane * 4);
  const float rk[4] = {rk4.x, rk4.y, rk4.z, rk4.w}, lw[4] = {lw4.x, lw4.y, lw4.z, lw4.w}, lb[4] = {lb4.x, lb4.y, lb4.z, lb4.w};
  float s = y[0] + y[1] + y[2] + y[3];
  s = rowsum16(s);
  const float mu = s * (1.f / 64.f);
  float q = 0.f, bn = 0.f;
#pragma unroll
  for (int j = 0; j < 4; ++j) { const float d = y[j] - mu; q += d * d; bn += rr[j] * km[j] * rk[j]; }
  q = rowsum16(q); bn = rowsum16(bn);
  const float rstd = rsqrtf(q * (1.f / 64.f) + 64e-5f);
  float ov[4];
#pragma unroll
  for (int j = 0; j < 4; ++j) ov[j] = ((y[j] - mu) * rstd * lw[j] + lb[j] + bn * vv[j]) * gg[j];
  u16* orw = (u16*)(p.ws + OFF_R3 + SA_KKN * SZ_TOK256 + (size_t)NT * 512 * 2);
  *(uint2*)(orw + o) = make_uint2(pack2(ov[0], ov[1]), pack2(ov[2], ov[3]));
}

DI void phase_attn(const Params& p, int l, char* smem) {
  LAUNDER_IDS
  __shared__ int qslot_sh;
  const int nattn = (l == 0) ? 2048 + 128 : 2048;
  unsigned* ctr = (unsigned*)(p.ws + OFF_BAR) + 16 + l * 16;
  for (;;) {
    __syncthreads();
    if (tid__ == 0) qslot_sh = (int)__hip_atomic_fetch_add(ctr, 1u, __ATOMIC_RELAXED, __HIP_MEMORY_SCOPE_AGENT);
    __syncthreads();
    const int it = qslot_sh;
    if (it >= nattn) break;
    attn_item(p, it, smem);
  }
}
DI void phase_readout(const Params& p, int l, int Mout) {
  LAUNDER_IDS
  const int wave = tid__ >> 6;
  for (int r = blk__ * 4 + wave; r < Mout; r += gridDim.x * 4) readout_row(p, l, r);
}

DI void phase_merge(const Params& p, int l, int Mout, char* smem) {
  LAUNDER_IDS
  WAVE_COORDS
  const char* wl = p.ws + OFF_W + (size_t)l * W_LAYER;
  const u16* hg = (const u16*)(p.ws + OFF_HBG);
  const u16* opool = (const u16*)(p.ws + OFF_R4);
  const u16* omla = (const u16*)(p.ws + OFF_OMLA);
  const u16* orw = (const u16*)(p.ws + OFF_R3 + SA_KKN * SZ_TOK256) + (size_t)NT * 512;
  u16* mo = (u16*)(p.ws + OFF_R1);
  const int ntm = Mout / 256;
  for (int it = 0;; ++it) {
    int tm, tn;
    if (!tile_map(it, ntm, 16, blk__, gridDim.x, tm, tn)) break;
    const int m0 = tm * 256, n0 = tn * 64;
    f32x4 msum[8][2]; zero_acc8<2>(msum);
#pragma unroll 1
    for (int br = 0; br < 3; ++br) {
      unsigned gpk[8][2][2];
      {
        f32x4 ag[8][2]; zero_acc8<2>(ag);
        gemm256<2>(ag, hg, 1024, (const u16*)(wl + WO_WIN) + (size_t)(2080 + br * 1024) * 1024, 1024, 1024, m0, n0, smem);
#pragma unroll
        for (int mi = 0; mi < 8; ++mi)
#pragma unroll
          for (int ni = 0; ni < 2; ++ni) {
            gpk[mi][ni][0] = pack2(sigmoidf_(ag[mi][ni][0]), sigmoidf_(ag[mi][ni][1]));
            gpk[mi][ni][1] = pack2(sigmoidf_(ag[mi][ni][2]), sigmoidf_(ag[mi][ni][3]));
          }
      }
      __builtin_amdgcn_sched_barrier(0);
      f32x4 ab[8][2]; zero_acc8<2>(ab);
      {
        const int Kb = br == 1 ? 512 : 256;
        const u16* Ab = br == 0 ? opool : br == 1 ? omla : orw;
        const u16* Wb = (const u16*)(wl + (br == 0 ? WO_BRP : br == 1 ? WO_BRM : WO_BRR));
        gemm256<2>(ab, Ab, Kb, Wb, Kb, Kb, m0, n0, smem);
      }
#pragma unroll
      for (int mi = 0; mi < 8; ++mi)
#pragma unroll
        for (int ni = 0; ni < 2; ++ni) {
          msum[mi][ni][0] += bflo(gpk[mi][ni][0]) * ab[mi][ni][0];
          msum[mi][ni][1] += bfhi(gpk[mi][ni][0]) * ab[mi][ni][1];
          msum[mi][ni][2] += bflo(gpk[mi][ni][1]) * ab[mi][ni][2];
          msum[mi][ni][3] += bfhi(gpk[mi][ni][1]) * ab[mi][ni][3];
        }
      __builtin_amdgcn_sched_barrier(0);
    }
#pragma unroll
    for (int mi = 0; mi < 8; ++mi) {
      const int m = m0 + wr * 128 + mi * 16 + lr;
#pragma unroll
      for (int ni = 0; ni < 2; ++ni) {
        const int n = n0 + wc * 32 + ni * 16 + lq * 4;
        *(uint2*)(mo + (size_t)m * 1024 + n) = make_uint2(pack2(msum[mi][ni][0], msum[mi][ni][1]), pack2(msum[mi][ni][2], msum[mi][ni][3]));
      }
    }
  }
}

DI void phase_resid(const Params& p, const u16* A, int K, const u16* Bt, const float* gate  ,
                    const float* xl_in, const float* xc_in, float* xl_out, float* xc_out, int Mout, char* smem) {
  LAUNDER_IDS
  WAVE_COORDS
  const int ntm = Mout / 256;
  for (int it = 0;; ++it) {
    int tm, tn;
    if (!tile_map(it, ntm, 8, blk__, gridDim.x, tm, tn)) break;
    const int m0 = tm * 256, n0 = tn * 128;
    f32x4 acc[8][4]; zero_acc8<4>(acc);
    gemm256<4>(acc, A, K, Bt, K, K, m0, n0, smem);
#pragma unroll
    for (int mi = 0; mi < 8; ++mi) {
      const int m = m0 + wr * 128 + mi * 16 + lr;
      const int b9 = m < NTL ? m >> 12 : 8;
      const float* xi = xrow(xl_in, xc_in, m);
      float* xo = m < NTL ? xl_out + (size_t)m * D : xc_out + (size_t)(m - NTL) * D;
#pragma unroll
      for (int ni = 0; ni < 4; ++ni) {
        const int n = n0 + wc * 64 + ni * 16 + lq * 4;
        const float4 g = *(const float4*)(gate + (size_t)b9 * 6144 + n);
        const float4 xv = *(const float4*)(xi + n);
        float4 ov;
        ov.x = xv.x + g.x * acc[mi][ni][0]; ov.y = xv.y + g.y * acc[mi][ni][1]; ov.z = xv.z + g.z * acc[mi][ni][2]; ov.w = xv.w + g.w * acc[mi][ni][3];
        *(float4*)(xo + n) = ov;
      }
      __builtin_amdgcn_sched_barrier(0);
    }
  }
}
DI void phase_mlp1(const Params& p, int l, int Mout, char* smem) {
  LAUNDER_IDS
  WAVE_COORDS
  const char* wl = p.ws + OFF_W + (size_t)l * W_LAYER;
  const u16* hb = (const u16*)(p.ws + OFF_HB2);
  u16* U = (u16*)(p.ws + OFF_R1);
  const int ntm = Mout / 256;
  for (int it = 0;; ++it) {
    int tm, tn;
    if (!tile_map(it, ntm, 32, blk__, gridDim.x, tm, tn)) break;
    const int m0 = tm * 256, n0 = tn * 128;
    f32x4 acc[8][4]; zero_acc8<4>(acc);
    gemm256<4>(acc, hb, 1024, (const u16*)(wl + WO_W1), 1024, 1024, m0, n0, smem);
#pragma unroll
    for (int mi = 0; mi < 8; ++mi) {
      const int m = m0 + wr * 128 + mi * 16 + lr;
#pragma unroll
      for (int ni = 0; ni < 4; ++ni) {
        const int n = n0 + wc * 64 + ni * 16 + lq * 4;
        float v[4];
#pragma unroll
        for (int j = 0; j < 4; ++j) { const float a = fmaxf(acc[mi][ni][j], 0.f); v[j] = a * a; }
        *(uint2*)(U + (size_t)m * DFF + n) = make_uint2(pack2(v[0], v[1]), pack2(v[2], v[3]));
      }
      __builtin_amdgcn_sched_barrier(0);
    }
  }
}

__global__ void __launch_bounds__(256, 2) fwd_megakernel(Params pk) {
  __shared__ __attribute__((aligned(16))) char smem[73728];
  cg::grid_group grid = cg::this_grid();
  if (threadIdx.x == 0) { g_base_sh[0] = (unsigned long long)pk.ws; g_base_sh[1] = (unsigned long long)pk.out; }
  xcd_barrier_post((unsigned*)(pk.ws + OFF_BAR));
  __syncthreads();
  phase_prep(pk, smem);
  grid.sync();
  phase_tables(pk);
  xcd_barrier();
#define CTXBUF ((float*)(p.ws + OFF_CTX))
#define XLP (l == 0 ? p.in[I_X] : (const float*)p.out)
#define XCP (l == 0 ? p.in[I_CTX] : (const float*)CTXBUF)
#define MOUT (l == 0 ? NT : NTL)
#define WLP (p.ws + OFF_W + (size_t)l * W_LAYER)
#define TABP(nrm) ((const float*)(p.ws + OFF_TAB) + (size_t)(l * 2 + (nrm)) * 9 * 2048)
#define MODP(j) ((const float*)(p.ws + OFF_MODS) + (size_t)l * 9 * 6144 + (j) * 1024)
#ifndef PROBE_Q
#define PROBE_Q -1
#endif
#pragma nounroll
  for (int ph = 0; ph < 22; ++ph) {
    const int l = ph >= 11 ? 1 : 0, q = ph - l * 11;
    Params p = pk;
    {
      asm volatile("" ::: "memory");
      unsigned long long w_ = g_base_sh[0], o_ = g_base_sh[1];
      unsigned wl_ = (unsigned)w_, wh_ = (unsigned)(w_ >> 32), ol_ = (unsigned)o_, oh_ = (unsigned)(o_ >> 32);
      wl_ = __builtin_amdgcn_readfirstlane(wl_); wh_ = __builtin_amdgcn_readfirstlane(wh_); ol_ = __builtin_amdgcn_readfirstlane(ol_); oh_ = __builtin_amdgcn_readfirstlane(oh_);
      asm volatile("" : "+s"(wl_), "+s"(wh_), "+s"(ol_), "+s"(oh_));
      p.ws = (char*)(((unsigned long long)wh_ << 32) | wl_); p.out = (float*)(((unsigned long long)oh_ << 32) | ol_);
    }
#pragma nounroll
    for (int rep = 0; rep < (q == PROBE_Q ? 2 : 1); ++rep)
    switch (q) {
      case 0: phase_norm(XLP, XCP, TABP(0), (u16*)(p.ws + OFF_HB1), NT); break;
      case 1: phase_zgemm(p, l, smem); break;
      case 2: phase_tokA(p, l); phase_tokB(p, l, smem); break;
      case 3: phase_qkv(p, l, smem); break;
      case 4: phase_scan(p, smem); phase_attn(p, l, smem); break;
      case 5: phase_norm(XLP, XCP, TABP(0), (u16*)(p.ws + OFF_HBG), MOUT); phase_readout(p, l, MOUT); break;
      case 6: phase_merge(p, l, MOUT, smem); break;
      case 7: phase_resid(p, (const u16*)(p.ws + OFF_R1), 1024, (const u16*)(WLP + WO_WO), MODP(2), XLP, XCP, p.out, CTXBUF, MOUT, smem); break;
      case 8: phase_norm(p.out, CTXBUF, TABP(1), (u16*)(p.ws + OFF_HB2), MOUT); break;
      case 9: phase_mlp1(p, l, MOUT, smem); break;
      default: phase_resid(p, (const u16*)(p.ws + OFF_R1), 4096, (const u16*)(WLP + WO_W2), MODP(5), p.out, CTXBUF, p.out, CTXBUF, MOUT, smem); break;
    }
    if (ph != 21) xcd_barrier();
  }
}

extern "C" void kernel_launch(void* const* d_in, const int* in_sizes, int n_in, void* d_out, int out_size, void* d_ws, size_t ws_size, hipStream_t stream) {
  static int grid_blocks = 0;
  if (!grid_blocks) {
    int dev = 0, cus = 0, per_cu = 0;
    hipGetDevice(&dev);
    hipDeviceGetAttribute(&cus, hipDeviceAttributeMultiprocessorCount, dev);
    hipOccupancyMaxActiveBlocksPerMultiprocessor(&per_cu, fwd_megakernel, 256, 0);
    if (per_cu > 2) per_cu = 2;
    if (per_cu < 1) per_cu = 1;
    grid_blocks = cus * per_cu;
    if (ws_size < WS_END) fprintf(stderr, "kernel_launch: workspace too small: %zu < %zu\n", ws_size, (size_t)WS_END);
  }
  Params p{};
  for (int i = 0; i < 34; ++i) p.in[i] = (const float*)d_in[i];
  p.out = (float*)d_out;
  p.ws = (char*)d_ws;
  hipMemsetAsync(d_ws, 0, 16384, stream);
  void* args[] = {&p};
  hipError_t e = hipLaunchCooperativeKernel((void*)fwd_megakernel, dim3(grid_blocks), dim3(256), args, 0, stream);
  if (e != hipSuccess) fprintf(stderr, "cooperative launch failed: %s (grid %d)\n", hipGetErrorString(e), grid_blocks);
}
```

```cpp
#include <hip/hip_runtime.h>
#include <hip/hip_cooperative_groups.h>
#include <stdint.h>
#include <cstdio>
namespace cg = cooperative_groups;

typedef unsigned short u16;
typedef __attribute__((ext_vector_type(8))) short bf16x8;
typedef __attribute__((ext_vector_type(4))) float f32x4;
typedef __attribute__((ext_vector_type(16))) float f32x16;
typedef __bf16 bf16x2_t __attribute__((ext_vector_type(2)));
typedef float float2_t __attribute__((ext_vector_type(2)));

#define DI __device__ __forceinline__

constexpr int D = 1024, NB = 8, L = 4096, LC = 256, LK = 4352;
constexpr int NTL = NB * L;
constexpr int NTC = NB * LC;
constexpr int NT = NTL + NTC;
constexpr int INC = 5152;
constexpr int ZA = 928;
constexpr int ZR = 1152;
constexpr int DFF = 4096;

constexpr size_t al256(size_t x) { return (x + 255) / 256 * 256; }
constexpr size_t OFF_BAR = 0;
constexpr size_t OFF_MODS = 16384;
constexpr size_t OFF_TAB = OFF_MODS + al256(2 * 9 * 6144 * 4);
constexpr size_t OFF_ROPE = OFF_TAB + al256(2 * 2 * 9 * 2 * 1024 * 4);
constexpr size_t OFF_RS1 = OFF_ROPE + 4096;
constexpr size_t OFF_RS2 = OFF_RS1 + al256(NT * 4);
constexpr size_t OFF_RSQ = OFF_RS2 + al256(NT * 4);
constexpr size_t OFF_RSKV = OFF_RSQ + al256(NT * 4);
constexpr size_t OFF_CTX = OFF_RSKV + al256(NT * 4);
constexpr size_t OFF_W = OFF_CTX + (size_t)NTC * D * 4;
constexpr size_t WO_WIN = 0;
constexpr size_t WO_UQ = WO_WIN + (size_t)INC * 1024 * 2;
constexpr size_t WO_UKV = WO_UQ + (size_t)768 * 384 * 2;
constexpr size_t WO_BRP = WO_UKV + (size_t)1024 * 256 * 2;
constexpr size_t WO_BRM = WO_BRP + (size_t)1024 * 256 * 2;
constexpr size_t WO_BRR = WO_BRM + (size_t)1024 * 512 * 2;
constexpr size_t WO_WO = WO_BRR + (size_t)1024 * 256 * 2;
constexpr size_t WO_W1 = WO_WO + (size_t)1024 * 1024 * 2;
constexpr size_t WO_W2 = WO_W1 + (size_t)4096 * 1024 * 2;
constexpr size_t WO_RW2 = WO_W2 + (size_t)1024 * 4096 * 2;
constexpr size_t WO_RA2 = WO_RW2 + (size_t)2 * 256 * 64 * 2;
constexpr size_t WO_RG2 = WO_RA2 + (size_t)2 * 256 * 64 * 2;
constexpr size_t W_LAYER = al256(WO_RG2 + (size_t)256 * 128 * 2);
constexpr size_t OFF_R1 = OFF_W + 2 * W_LAYER;
constexpr size_t SZ_Q = (size_t)NB * 8 * LK * 96 * 2;
constexpr size_t SZ_VT = (size_t)NB * 8 * 64 * LK * 2;
constexpr size_t SZ_R1 = 2 * SZ_Q + SZ_VT;
constexpr size_t OFF_R2 = OFF_R1 + al256(SZ_R1);
constexpr size_t SZ_TOK256 = (size_t)NT * 256 * 2;
constexpr size_t OFF_R3 = OFF_R2 + al256((size_t)NT * ZA * 2);
constexpr size_t OFF_R4 = OFF_R3 + 10 * SZ_TOK256;
constexpr size_t OFF_KR = OFF_R4 + SZ_TOK256;
constexpr size_t OFF_OMLA = OFF_KR + al256((size_t)NT * 32 * 2);
constexpr size_t WS_END = OFF_OMLA + (size_t)NT * 512 * 2;
static_assert(WS_END <= 536870912ull, "workspace map exceeds 4x the largest tensor");
constexpr size_t OFF_HB1 = OFF_R3;
constexpr size_t OFF_HBG = OFF_R1 + (size_t)NT * 1024 * 2;
constexpr size_t OFF_HB2 = OFF_R3 + 5 * SZ_TOK256;
enum { SA_R = 0, SA_V = 1, SA_KDF = 2, SA_KDB = 3, SA_G = 4, SA_KKN = 5, SA_OMWF = 6, SA_BF = 7, SA_OMWB = 8, SA_BB = 9 };

struct Params { const float* in[34]; float* out; char* ws; };

enum { I_X = 0, I_C, I_CTX, I_CCTX, I_N1G, I_N2G, I_WADA, I_BADA, I_WIN, I_POOLW, I_POOLS, I_QNORM, I_WUQ, I_KVNORM, I_WUKV,
       I_GQ, I_GK, I_MU, I_W0, I_W2R, I_A0, I_A2R, I_KA, I_KK, I_RK, I_G2R, I_LNW, I_LNB, I_BRP, I_BRM, I_BRR, I_WO, I_W1, I_W2 };

DI float bf2f(u16 h) { return __uint_as_float(((unsigned)h) << 16); }
DI float bflo(unsigned u) { return __uint_as_float(u << 16); }
DI float bfhi(unsigned u) { return __uint_as_float(u & 0xffff0000u); }
DI unsigned pack2(float a, float b) { float2_t v = {a, b}; bf16x2_t r = __builtin_convertvector(v, bf16x2_t); return __builtin_bit_cast(unsigned, r); }
DI u16 f2bf(float a) { return (u16)(pack2(a, 0.f) & 0xffffu); }
DI float sigmoidf_(float x) { return 1.f / (1.f + __expf(-x)); }
DI float siluf_(float x) { return x / (1.f + __expf(-x)); }
DI float rowsum16(float x) {
  x += __builtin_bit_cast(float, __builtin_amdgcn_update_dpp(0, __builtin_bit_cast(int, x), 0x128, 0xf, 0xf, false));
  x += __builtin_bit_cast(float, __builtin_amdgcn_update_dpp(0, __builtin_bit_cast(int, x), 0x124, 0xf, 0xf, false));
  x += __builtin_bit_cast(float, __builtin_amdgcn_update_dpp(0, __builtin_bit_cast(int, x), 0x122, 0xf, 0xf, false));
  x += __builtin_bit_cast(float, __builtin_amdgcn_update_dpp(0, __builtin_bit_cast(int, x), 0x121, 0xf, 0xf, false));
  return x;
}
DI float wavesum(float x) {
  x = rowsum16(x);
  const int xi = __builtin_bit_cast(int, x);
  return __builtin_bit_cast(float, __builtin_amdgcn_readlane(xi, 0)) + __builtin_bit_cast(float, __builtin_amdgcn_readlane(xi, 16)) +
         __builtin_bit_cast(float, __builtin_amdgcn_readlane(xi, 32)) + __builtin_bit_cast(float, __builtin_amdgcn_readlane(xi, 48));
}
DI void grid_barrier(unsigned* ctr, unsigned& epoch) {
  asm volatile("s_waitcnt vmcnt(0)" ::: "memory");
  __syncthreads();
  epoch++;
  if (threadIdx.x == 0) {
    __builtin_amdgcn_fence(__ATOMIC_RELEASE, "agent");
    asm volatile("s_waitcnt vmcnt(0)" ::: "memory");
    const unsigned target = epoch * gridDim.x;
    __hip_atomic_fetch_add(ctr, 1u, __ATOMIC_RELAXED, __HIP_MEMORY_SCOPE_AGENT);
    while (__hip_atomic_load(ctr, __ATOMIC_RELAXED, __HIP_MEMORY_SCOPE_AGENT) < target) __builtin_amdgcn_s_sleep(2);
    __builtin_amdgcn_fence(__ATOMIC_ACQUIRE, "agent");
    asm volatile("s_waitcnt vmcnt(0)" ::: "memory");
  }
  __syncthreads();
}


#define XB_TMO      128
#define XB_XCNT(j)  (256  + 64 * (j))
#define XB_XSUB(j)  (1280 + 64 * (j))
#define XB_XGEN(j)  (2304 + 64 * (j))
#define XB_TOP      3328
#define XB_TOPGEN   3392
#define XB_SPIN_CAP (1u << 22)
#define LAS __attribute__((address_space(3)))
DI unsigned xb_ld(unsigned* p)              { return __hip_atomic_load(p, __ATOMIC_RELAXED, __HIP_MEMORY_SCOPE_AGENT); }
DI unsigned xb_add(unsigned* p, unsigned v) { return __hip_atomic_fetch_add(p, v, __ATOMIC_RELAXED, __HIP_MEMORY_SCOPE_AGENT); }
DI unsigned xb_xcc_id() { return (unsigned)__builtin_amdgcn_s_getreg((3 << 11) | 20) & 0xFu; }
#define XB_SPIN(cond, bar) do { unsigned _sp = 0; while (cond) { __builtin_amdgcn_s_sleep(1); \
    if ((++_sp & 255u) == 0u) { if (xb_ld(&(bar)[XB_TMO])) break; if (_sp > XB_SPIN_CAP) { atomicAdd(&(bar)[XB_TMO], 1u); break; } } } } while (0)
__shared__ uint4 g_xb_words;
__shared__ unsigned long long g_base_sh[2];
DI void xcd_barrier_post(unsigned* bar) {
  const unsigned x = xb_xcc_id();
  if (threadIdx.x == 0) { g_xb_words = make_uint4(0u, 0u, x, 0u); (void)xb_add(&bar[XB_XCNT(x)], 1u); }
}
DI void xcd_barrier_complete(unsigned* bar, unsigned x, unsigned& nloc, unsigned& nx) {
  const unsigned G = gridDim.x;
  unsigned sum, cnt, mine, sp = 0u;
  for (;;) {
    sum = 0u; cnt = 0u; mine = 0u;
#pragma unroll
    for (unsigned j = 0; j < 16; ++j) { const unsigned c = xb_ld(&bar[XB_XCNT(j)]); sum += c; cnt += (c > 0u) ? 1u : 0u; mine = (j == x) ? c : mine; }
    if (sum == G) break;
    __builtin_amdgcn_s_sleep(1);
    if ((++sp & 255u) == 0u) { if (xb_ld(&bar[XB_TMO])) break; if (sp > XB_SPIN_CAP) { atomicAdd(&bar[XB_TMO], 1u); break; } }
  }
  nloc = mine > 0u ? mine : 1u; nx = cnt > 0u ? cnt : 1u;
}
DI void xcd_barrier() {
  asm volatile("s_waitcnt vmcnt(0)" ::: "memory");
  __syncthreads();
  if (threadIdx.x == 0) {
    unsigned* bar = (unsigned*)(g_base_sh[0] + OFF_BAR);
    __builtin_amdgcn_s_waitcnt(0);
    unsigned nloc = g_xb_words.x, nx = g_xb_words.y; const unsigned x = g_xb_words.z;
    if (nloc == 0u) { xcd_barrier_complete(bar, x, nloc, nx); g_xb_words.x = nloc; g_xb_words.y = nx; }
    const unsigned old = xb_add(&bar[XB_XSUB(x)], 1u);
    const unsigned gen = old / nloc;
    if (old + 1u == (gen + 1u) * nloc) {
      __builtin_amdgcn_fence(__ATOMIC_RELEASE, "agent");
      asm volatile("s_waitcnt vmcnt(0)" ::: "memory");
      const unsigned og = xb_add(&bar[XB_TOP], 1u);
      const unsigned tg = og / nx;
      if (og + 1u == (tg + 1u) * nx) xb_add(&bar[XB_TOPGEN], 1u);
      else XB_SPIN(xb_ld(&bar[XB_TOPGEN]) == tg, bar);
      __builtin_amdgcn_fence(__ATOMIC_ACQUIRE, "agent");
      xb_add(&bar[XB_XGEN(x)], 1u);
      asm volatile("s_waitcnt vmcnt(0)" ::: "memory");
    } else {
      XB_SPIN(xb_ld(&bar[XB_XGEN(x)]) == gen, bar);
      __builtin_amdgcn_fence(__ATOMIC_ACQUIRE, "agent");
      asm volatile("s_waitcnt vmcnt(0)" ::: "memory");
    }
  }
  __syncthreads();
}
DI int launder_v(int x) { asm volatile("" : "+v"(x)); return x; }
DI int launder_s(int x) { asm volatile("" : "+s"(x)); return x; }
#define LAUNDER_IDS const int tid__ = launder_v((int)threadIdx.x); const int blk__ = launder_s((int)blockIdx.x); (void)tid__; (void)blk__;
DI void do_transpose(const float* __restrict__ src, int K, int N, u16* __restrict__ dst, const float* __restrict__ ksc, int perm, int tile, float* tl) {
  LAUNDER_IDS
  const int ntn = (N + 63) >> 6;
  const int kt = tile / ntn, nt = tile - kt * ntn;
  const int k0 = kt * 64, n0 = nt * 64;
  const int tid = tid__;
  __syncthreads();
#pragma unroll 4
  for (int i = 0; i < 16; ++i) {
    const int kk = i * 4 + (tid >> 6), nn = tid & 63;
    float v = 0.f;
    if (n0 + nn < N) v = src[(size_t)(k0 + kk) * N + n0 + nn];
    if (ksc) v *= ksc[k0 + kk];
    tl[kk * 65 + nn] = v;
  }
  __syncthreads();
#pragma unroll 4
  for (int i = 0; i < 16; ++i) {
    const int nn = i * 4 + (tid >> 6), kk = tid & 63;
    int n = n0 + nn;
    if (n < N) {
      if (perm) { const int h = n / 96, d = n - h * 96; n = d < 64 ? h * 64 + d : 512 + h * 32 + (d - 64); }
      dst[(size_t)n * K + k0 + kk] = f2bf(tl[kk * 65 + nn]);
    }
  }
}

DI void phase_prep(const Params& p, char* smem) {
  LAUNDER_IDS
  float* tl = (float*)smem;
  const int tid = tid__;
  constexpr int T_WIN = 16 * 81, T_UQ = 6 * 12, T_UKV = 4 * 16, T_BRM = 8 * 16, T_BRR = 4 * 16, T_WO = 16 * 16, T_W1 = 16 * 64, T_W2 = 64 * 16,
                T_RW2 = 4, T_RA2 = 4, T_RG2 = 2 * 4;
  constexpr int T_LAYER = T_WIN + T_UQ + T_UKV + T_BRM + T_BRR + T_WO + T_W1 + T_W2 + 2 * T_RW2 + 2 * T_RA2 + T_RG2;
  for (int g = blk__; g < 2 * T_LAYER; g += gridDim.x) {
    const int l = g / T_LAYER; int t = g - l * T_LAYER;
    char* wl = p.ws + OFF_W + (size_t)l * W_LAYER;
#define JOB(SRC, KK, NN, DSTOFF, SC, PERM, CNT) if (t < (CNT)) { do_transpose((SRC), (KK), (NN), (u16*)(wl + (DSTOFF)), (SC), (PERM), t, tl); continue; } t -= (CNT);
    JOB(p.in[I_WIN] + (size_t)l * 1024 * INC, 1024, INC, WO_WIN, nullptr, 0, T_WIN)
    JOB(p.in[I_WUQ] + (size_t)l * 384 * 768, 384, 768, WO_UQ, p.in[I_QNORM] + l * 384, 1, T_UQ)
    JOB(p.in[I_WUKV] + (size_t)l * 256 * 1024, 256, 1024, WO_UKV, p.in[I_KVNORM] + l * 256, 0, T_UKV)
    JOB(p.in[I_BRM] + (size_t)l * 512 * 1024, 512, 1024, WO_BRM, nullptr, 0, T_BRM)
    JOB(p.in[I_BRR] + (size_t)l * 256 * 1024, 256, 1024, WO_BRR, nullptr, 0, T_BRR)
    JOB(p.in[I_WO] + (size_t)l * 1024 * 1024, 1024, 1024, WO_WO, nullptr, 0, T_WO)
    JOB(p.in[I_W1] + (size_t)l * 1024 * 4096, 1024, 4096, WO_W1, nullptr, 0, T_W1)
    JOB(p.in[I_W2] + (size_t)l * 4096 * 1024, 4096, 1024, WO_W2, nullptr, 0, T_W2)
    JOB(p.in[I_W2R] + (size_t)(l * 2 + 0) * 64 * 256, 64, 256, WO_RW2, nullptr, 0, T_RW2)
    JOB(p.in[I_W2R] + (size_t)(l * 2 + 1) * 64 * 256, 64, 256, WO_RW2 + 256 * 64 * 2, nullptr, 0, T_RW2)
    JOB(p.in[I_A2R] + (size_t)(l * 2 + 0) * 64 * 256, 64, 256, WO_RA2, nullptr, 0, T_RA2)
    JOB(p.in[I_A2R] + (size_t)(l * 2 + 1) * 64 * 256, 64, 256, WO_RA2 + 256 * 64 * 2, nullptr, 0, T_RA2)
    JOB(p.in[I_G2R] + (size_t)l * 128 * 256, 128, 256, WO_RG2, nullptr, 0, T_RG2)
#undef JOB
  }
  for (int e = blk__ * 256 + tid; e < 2 * 256 * 1024; e += gridDim.x * 256) {
    const int l = e >> 18, r = e & 262143, cin = r >> 10, n = r & 1023, g = cin >> 6, c = cin & 63;
    const float* pw = p.in[I_POOLW] + ((size_t)(l * 4 + g) * 64 + c) * 64;
    const float* ps = p.in[I_POOLS] + l * 256 + g * 64;
    const float* wb = p.in[I_BRP] + ((size_t)l * 256 + g * 64) * 1024 + n;
    float s = 0.f;
    for (int d = 0; d < 64; ++d) s += pw[d] * ps[d] * wb[(size_t)d * 1024];
    ((u16*)(p.ws + OFF_W + (size_t)l * W_LAYER + WO_BRP))[(size_t)n * 256 + cin] = f2bf(s);
  }
  if (blk__ == gridDim.x - 1) {
    for (int e = tid; e < 512; e += 256) {
      const int pos = e >> 3, f = e & 7;
      const float inv = powf(10000.f, -(float)f / 8.f);
      const float ang = (float)pos * inv;
      float* rt = (float*)(p.ws + OFF_ROPE);
      rt[e * 2] = cosf(ang); rt[e * 2 + 1] = sinf(ang);
    }
  }
  {
    float* sl = (float*)smem;
    float* red = sl + 9 * 1024;
    __syncthreads();
    for (int e = tid; e < 9 * 1024; e += 256) {
      const int b = e >> 10, k = e & 1023;
      const float v = b < 8 ? p.in[I_C][b * 1024 + k] : p.in[I_CCTX][k];
      sl[e] = siluf_(v);
    }
    __syncthreads();
    const int wave = tid >> 6, lane = tid & 63;
    for (int it = blk__; it < 192; it += gridDim.x) {
      const int l = it / 96, cg_ = it - l * 96;
      const int col = cg_ * 64 + lane;
      const float* wa = p.in[I_WADA] + (size_t)l * 1024 * 6144 + col;
      float acc[9];
#pragma unroll
      for (int b = 0; b < 9; ++b) acc[b] = 0.f;
#pragma unroll 8
      for (int k = wave * 256; k < wave * 256 + 256; ++k) {
        const float w = wa[(size_t)k * 6144];
#pragma unroll
        for (int b = 0; b < 9; ++b) acc[b] += sl[b * 1024 + k] * w;
      }
#pragma unroll
      for (int b = 0; b < 9; ++b) red[(wave * 9 + b) * 64 + lane] = acc[b];
      __syncthreads();
      for (int e = tid; e < 9 * 64; e += 256) {
        const int b = e >> 6, c = e & 63;
        const float s = red[(0 * 9 + b) * 64 + c] + red[(1 * 9 + b) * 64 + c] + red[(2 * 9 + b) * 64 + c] + red[(3 * 9 + b) * 64 + c];
        ((float*)(p.ws + OFF_MODS))[(size_t)(l * 9 + b) * 6144 + cg_ * 64 + c] = s + p.in[I_BADA][l * 6144 + cg_ * 64 + c];
      }
      __syncthreads();
    }
  }
}

DI const float* xrow(const float* xl, const float* xc, int r) { return r < NTL ? xl + (size_t)r * D : xc + (size_t)(r - NTL) * D; }

DI void phase_norm(const float* xl, const float* xc, const float* tab  , u16* hb, int M) {
  LAUNDER_IDS
  const int wave = tid__ >> 6, lane = tid__ & 63;
  for (int r = blk__ * 4 + wave; r < M; r += gridDim.x * 4) {
    const float* xp = xrow(xl, xc, r);
    const int b9 = r < NTL ? r >> 12 : 8;
    float4 v[4];
    float s = 0.f;
#pragma unroll
    for (int i = 0; i < 4; ++i) { v[i] = *(const float4*)(xp + i * 256 + lane * 4); s += v[i].x * v[i].x + v[i].y * v[i].y + v[i].z * v[i].z + v[i].w * v[i].w; }
    s = wavesum(s);
    const float rs = rsqrtf(s * (1.f / 1024.f) + 1e-6f);
    const float* t = tab + b9 * 2048;
#pragma unroll
    for (int i = 0; i < 4; ++i) {
      const int k = i * 256 + lane * 4;
      const float4 g = *(const float4*)(t + k), sh = *(const float4*)(t + 1024 + k);
      *(uint2*)(hb + (size_t)r * 1024 + k) = make_uint2(pack2(v[i].x * rs * g.x + sh.x, v[i].y * rs * g.y + sh.y), pack2(v[i].z * rs * g.z + sh.z, v[i].w * rs * g.w + sh.w));
    }
  }
}
DI void phase_tables(const Params& p) {
  LAUNDER_IDS
  const float* mods = (const float*)(p.ws + OFF_MODS);
  float* tab = (float*)(p.ws + OFF_TAB);
  for (int e = blk__ * 256 + tid__; e < 2 * 2 * 9 * 1024; e += gridDim.x * 256) {
    const int k = e & 1023, b9 = (e >> 10) % 9, ln = (e >> 10) / 9, l = ln >> 1, nrm = ln & 1;
    const float g = p.in[nrm ? I_N2G : I_N1G][l * 1024 + k];
    const float sh = mods[(size_t)(l * 9 + b9) * 6144 + (nrm * 3 + 0) * 1024 + k];
    const float sc = mods[(size_t)(l * 9 + b9) * 6144 + (nrm * 3 + 1) * 1024 + k];
    float* t = tab + ((size_t)(l * 2 + nrm) * 9 + b9) * 2048;
    t[k] = g * (1.f + sc); t[1024 + k] = sh;
  }
}

struct LoadBf16 {
  const u16* A; int lda;
  DI void init(int m0) {}
  DI uint4 load(int i, int m0, int k0) const {
    LAUNDER_IDS
    const int tid = tid__, kc = (tid & 7) * 8;
    return *(const uint4*)(A + (size_t)(m0 + (tid >> 3) + i * 32) * lda + k0 + kc);
  }
};
struct LoadNorm {
  const float* xl; const float* xc; const float* rs; const float* tab;
  float r0, r1, r2, r3;
  DI void init(int m0) {
    LAUNDER_IDS
    const int tid = tid__;
    r0 = rs[m0 + (tid >> 3)]; r1 = rs[m0 + (tid >> 3) + 32]; r2 = rs[m0 + (tid >> 3) + 64]; r3 = rs[m0 + (tid >> 3) + 96];
  }
  DI uint4 load(int i, int m0, int k0) const {
    LAUNDER_IDS
    const int tid = tid__, kc = (tid & 7) * 8;
    const int b9 = m0 < NTL ? m0 >> 12 : 8;
    const float* t = tab + b9 * 2048 + k0 + kc;
    const float4 g0 = *(const float4*)t, g1 = *(const float4*)(t + 4), s0 = *(const float4*)(t + 1024), s1 = *(const float4*)(t + 1028);
    const float* xp = xrow(xl, xc, m0 + (tid >> 3)) + k0 + kc + (size_t)i * 32 * D;
    const float4 x0 = *(const float4*)xp, x1 = *(const float4*)(xp + 4);
    const float rr = i == 0 ? r0 : i == 1 ? r1 : i == 2 ? r2 : r3;
    uint4 o;
    o.x = pack2(x0.x * rr * g0.x + s0.x, x0.y * rr * g0.y + s0.y);
    o.y = pack2(x0.z * rr * g0.z + s0.z, x0.w * rr * g0.w + s0.w);
    o.z = pack2(x1.x * rr * g1.x + s1.x, x1.y * rr * g1.y + s1.y);
    o.w = pack2(x1.z * rr * g1.z + s1.z, x1.w * rr * g1.w + s1.w);
    return o;
  }
};

DI bool tile_map(int it, int NTM, int NTN, int blk, int nblk, int& tm, int& tn) {
  const int xcd = blk & 7, local = blk >> 3, LB = nblk >> 3;
  const int R = NTM >> 3;
  const int s = it * LB + local;
  if (s >= R * NTN) return false;
  const int F = R >> 3, per_full = 8 * NTN;
  int mg, r, gm;
  if (s < F * per_full) { mg = s / per_full; r = s - mg * per_full; gm = 8; }
  else { mg = F; r = s - F * per_full; gm = R - F * 8; }
  const int ng = r / (gm * 8);
  const int r2 = r - ng * gm * 8;
  const int mi = r2 % gm, ni = r2 / gm;
  tm = xcd * R + mg * 8 + mi; tn = ng * 8 + ni;
  return true;
}
constexpr int LDT = 72;
template <int NI, class LA>
DI void gemm_mainloop(f32x4 (&acc)[4][NI], LA la, const u16* __restrict__ Bt, int ldb, int K, int m0, int n0, char* smem) {
  LAUNDER_IDS
  constexpr int NBI = NI;
  u16* As = (u16*)smem; u16* Bs = As + 2 * 128 * LDT;
  const int tid = tid__, lane = tid & 63, wave = tid >> 6, wr = wave >> 1, wc = wave & 1, lr = lane & 15, lq = lane >> 4;
  uint4 ra[4], rb[NBI];
  la.init(m0);
#pragma unroll
  for (int i = 0; i < 4; ++i) ra[i] = la.load(i, m0, 0);
#pragma unroll
  for (int i = 0; i < NBI; ++i) {
    const int c = tid + i * 256, row = c >> 3, kc = (c & 7) * 8;
    rb[i] = *(const uint4*)(Bt + (size_t)(n0 + row) * ldb + kc);
  }
#pragma unroll
  for (int i = 0; i < 4; ++i) {
    const int c = tid + i * 256, row = c >> 3, kc = (c & 7) * 8;
    *(uint4*)(As + row * LDT + kc) = ra[i];
    if (i < NBI) *(uint4*)(Bs + row * LDT + kc) = rb[i];
  }
  __syncthreads();
  const int nk = K >> 6;
  for (int kt = 0; kt < nk; ++kt) {
    const int cur = kt & 1;
    if (kt + 1 < nk) {
      const int k0 = (kt + 1) * 64;
#pragma unroll
      for (int i = 0; i < 4; ++i) ra[i] = la.load(i, m0, k0);
#pragma unroll
      for (int i = 0; i < NBI; ++i) {
        const int c = tid + i * 256, row = c >> 3, kc = (c & 7) * 8;
        rb[i] = *(const uint4*)(Bt + (size_t)(n0 + row) * ldb + k0 + kc);
      }
    }
    const u16* Ac = As + cur * 128 * LDT + (wr * 64 + lr) * LDT + lq * 8;
    const u16* Bc = Bs + cur * 128 * LDT + (wc * 16 * NI + lr) * LDT + lq * 8;
#pragma unroll
    for (int ks = 0; ks < 2; ++ks) {
      bf16x8 af[4], bfr[NI];
#pragma unroll
      for (int mi = 0; mi < 4; ++mi) af[mi] = *(const bf16x8*)(Ac + mi * 16 * LDT + ks * 32);
#pragma unroll
      for (int ni = 0; ni < NI; ++ni) bfr[ni] = *(const bf16x8*)(Bc + ni * 16 * LDT + ks * 32);
#pragma unroll
      for (int mi = 0; mi < 4; ++mi)
#pragma unroll
        for (int ni = 0; ni < NI; ++ni)
          acc[mi][ni] = __builtin_amdgcn_mfma_f32_16x16x32_bf16(bfr[ni], af[mi], acc[mi][ni], 0, 0, 0);
    }
    if (kt + 1 < nk) {
      const int nxt = cur ^ 1;
#pragma unroll
      for (int i = 0; i < 4; ++i) {
        const int c = tid + i * 256, row = c >> 3, kc = (c & 7) * 8;
        *(uint4*)(As + nxt * 128 * LDT + row * LDT + kc) = ra[i];
        if (i < NBI) *(uint4*)(Bs + nxt * 128 * LDT + row * LDT + kc) = rb[i];
      }
    }
    __syncthreads();
  }
}
template <int NI>
DI void zero_acc(f32x4 (&acc)[4][NI]) {
#pragma unroll
  for (int i = 0; i < 4; ++i)
#pragma unroll
    for (int j = 0; j < NI; ++j) acc[i][j] = f32x4{0.f, 0.f, 0.f, 0.f};
}
template <int NI, bool BATCH = false>
DI void gemm256(f32x4 (&acc)[8][NI], const u16* __restrict__ A, int lda, const u16* __restrict__ Bt, int ldb, int K, int m0, int n0, char* smem) {
  LAUNDER_IDS
  const int lane = tid__ & 63, wave = tid__ >> 6, wr = wave >> 1, wc = wave & 1, lr = lane & 15, lq = lane >> 4;
  constexpr int NBW = NI / 2;
  constexpr int STAGE = 16384 + NI * 2 * 1024;
  constexpr int LPS = 4 + NBW;
  const int srow = lane >> 2, scol = ((lane & 3) ^ ((lane >> 5) << 1)) * 8;
  const u16* Ag = A + (size_t)(m0 + wave * 64 + srow) * lda + scol;
  const u16* Bg = Bt + (size_t)(n0 + wave * NBW * 16 + srow) * ldb + scol;
  char* la = smem + (wave * 4) * 1024 + lane * 16;
  char* lb = smem + 16384 + (wave * NBW) * 1024 + lane * 16;
#define G256_ISSUE(S, K0) do { \
    _Pragma("unroll") for (int j_ = 0; j_ < 4; ++j_) \
      __builtin_amdgcn_global_load_lds((const unsigned*)(Ag + (size_t)j_ * 16 * lda + (K0)), (__attribute__((address_space(3))) unsigned*)(la + (S) * STAGE + j_ * 1024), 16, 0, 0); \
    _Pragma("unroll") for (int j_ = 0; j_ < NBW; ++j_) \
      __builtin_amdgcn_global_load_lds((const unsigned*)(Bg + (size_t)j_ * 16 * ldb + (K0)), (__attribute__((address_space(3))) unsigned*)(lb + (S) * STAGE + j_ * 1024), 16, 0, 0); \
  } while (0)
  const int nk = K >> 5;
  G256_ISSUE(0, 0);
  if (nk > 1) G256_ISSUE(1, 32);
  const int foff = lr * 64 + ((lq ^ ((lr >> 3) << 1)) * 16);
  int st = 0;
  for (int kt = 0; kt < nk; ++kt) {
    if (kt + 1 < nk) asm volatile("s_waitcnt vmcnt(%0) lgkmcnt(0)" :: "n"(LPS) : "memory");
    else asm volatile("s_waitcnt vmcnt(0) lgkmcnt(0)" ::: "memory");
    __builtin_amdgcn_s_barrier();
    if (kt + 2 < nk) { const int s2 = st >= 1 ? st - 1 : 2; G256_ISSUE(s2, (kt + 2) * 32); }
    const char* sb = smem + st * STAGE + foff;
    bf16x8 af[8], bfr[NI];
#pragma unroll
    for (int mi = 0; mi < 8; ++mi) af[mi] = *(const bf16x8*)(sb + (wr * 8 + mi) * 1024);
#pragma unroll
    for (int ni = 0; ni < NI; ++ni) bfr[ni] = *(const bf16x8*)(sb + 16384 + (wc * NI + ni) * 1024);
#pragma unroll
    for (int mi = 0; mi < 8; ++mi)
#pragma unroll
      for (int ni = 0; ni < NI; ++ni)
        acc[mi][ni] = __builtin_amdgcn_mfma_f32_16x16x32_bf16(bfr[ni], af[mi], acc[mi][ni], 0, 0, 0);
    st = st == 2 ? 0 : st + 1;
  }
  asm volatile("s_waitcnt lgkmcnt(0)" ::: "memory");
  __builtin_amdgcn_s_barrier();
#undef G256_ISSUE
}
template <int NI>
DI void zero_acc8(f32x4 (&acc)[8][NI]) {
#pragma unroll
  for (int i = 0; i < 8; ++i)
#pragma unroll
    for (int j = 0; j < NI; ++j) acc[i][j] = f32x4{0.f, 0.f, 0.f, 0.f};
}
#define EPI_BEGIN const int lr1_ = launder_v(lr), lq1_ = launder_v(lq), wr1_ = launder_v(wr), wc1_ = launder_v(wc); { const int lr = lr1_, lq = lq1_, wr = wr1_, wc = wc1_; (void)lr; (void)lq; (void)wr; (void)wc;
#define EPI_END }
#define WAVE_COORDS const int lane = tid__ & 63, wave = tid__ >> 6, wr = wave >> 1, wc = wave & 1, lr = lane & 15, lq = lane >> 4; (void)wr; (void)wc; (void)lr; (void)lq;

DI void phase_zgemm(const Params& p, int l, char* smem) {
  LAUNDER_IDS
  WAVE_COORDS
  const u16* Wt = (const u16*)(p.ws + OFF_W + (size_t)l * W_LAYER + WO_WIN);
  const u16* hb = (const u16*)(p.ws + OFF_HB1);
  u16* za = (u16*)(p.ws + OFF_R2); u16* zr = (u16*)(p.ws + OFF_R1);
  for (int it = 0;; ++it) {
    int tm, tn;
    if (!tile_map(it, NT / 256, 17, blk__, gridDim.x, tm, tn)) break;
    const int m0 = tm * 256, n0 = tn * 128;
    f32x4 acc[8][4]; zero_acc8<4>(acc);
    gemm256<4, false>(acc, hb, 1024, Wt, 1024, 1024, m0, n0, smem);
    EPI_BEGIN
#pragma unroll
    for (int mi = 0; mi < 8; ++mi) {
      const int m = m0 + wr * 128 + mi * 16 + lr;
#pragma unroll
      for (int ni = 0; ni < 4; ++ni) {
        const int n = n0 + wc * 64 + ni * 16 + lq * 4;
        uint2 v; v.x = pack2(acc[mi][ni][0], acc[mi][ni][1]); v.y = pack2(acc[mi][ni][2], acc[mi][ni][3]);
        if (n < ZA) *(uint2*)(za + (size_t)m * ZA + n) = v;
        else if (n < ZA + ZR) *(uint2*)(zr + (size_t)m * ZR + (n - ZA)) = v;
      }
    }
    EPI_END
  }
}

DI void phase_tokA(const Params& p, int l) {
  LAUNDER_IDS
  const int wave = tid__ >> 6, lane = tid__ & 63;
  const u16* za = (const u16*)(p.ws + OFF_R2);
  float* rsq = (float*)(p.ws + OFF_RSQ); float* rskv = (float*)(p.ws + OFF_RSKV);
  u16* krb = (u16*)(p.ws + OFF_KR);
  u16* pooled = (u16*)(p.ws + OFF_R4);
  const float* rt = (const float*)(p.ws + OFF_ROPE);
  const float* gk = p.in[I_GK] + l * 96;
  for (int r = blk__ * 4 + wave; r < NT; r += gridDim.x * 4) {
    const u16* z = za + (size_t)r * ZA;
    const bool lat = r < NTL;
    const int b = lat ? r >> 12 : (r - NTL) >> 8;
    const int t = lat ? r & 4095 : (r - NTL) & 255;
    const int Ls = lat ? L : LC;
    const int pos = lat ? t : 4096 + t;
    float sq = 0.f, skv = 0.f;
#pragma unroll
    for (int i = 0; i < 6; ++i) { const float v = bf2f(z[256 + i * 64 + lane]); sq += v * v; }
#pragma unroll
    for (int i = 0; i < 4; ++i) { const float v = bf2f(z[640 + i * 64 + lane]); skv += v * v; }
    sq = wavesum(sq); skv = wavesum(skv);
    if (lane == 0) { rsq[r] = rsqrtf(sq * (1.f / 384.f) + 1e-6f); rskv[r] = rsqrtf(skv * (1.f / 256.f) + 1e-6f); }
    {
      const int d = lane & 31;
      float kr = bf2f(z[896 + d]);
      float ss = rowsum16(kr * kr);
      { const int si = __builtin_bit_cast(int, ss);
        ss = __builtin_bit_cast(float, __builtin_amdgcn_readlane(si, 0)) + __builtin_bit_cast(float, __builtin_amdgcn_readlane(si, 16)); }
      kr = kr * rsqrtf(ss * (1.f / 32.f) + 1e-6f) * gk[64 + d];
      const float other = __shfl_xor(kr, 16, 64);
      float outv = kr;
      if (lat) {
        const int i = d & 15;
        const int pp = i < 8 ? (t >> 6) : (t & 63);
        const float cs = rt[(pp * 8 + (i & 7)) * 2], sn = rt[(pp * 8 + (i & 7)) * 2 + 1];
        outv = d < 16 ? kr * cs - other * sn : other * sn + kr * cs;
      }
      if (lane < 32) krb[(size_t)r * 32 + d] = f2bf(outv);
    }
#pragma unroll
    for (int gi = 0; gi < 4; ++gi) {
      const int half = 1 << gi;
      const int lo = max(t - half, 0), hi = min(t + half, Ls);
      const int ch = gi * 64 + lane;
      float s = 0.f;
#pragma unroll
      for (int j = 0; j < 2 * half; ++j) {
        const int q = t - half + j;
        const int qc = min(max(q, 0), Ls - 1);
        const float v = bf2f(z[(ptrdiff_t)(qc - t) * ZA + ch]);
        s += (q == qc) ? v : 0.f;
      }
      const float mean = s / (float)(hi - lo);
      pooled[(size_t)r * 256 + ch] = f2bf(mean - bf2f(z[ch]));
    }
  }
}

constexpr int ZSL = 1160, TAL = 392;
DI void phase_tokB(const Params& p, int l, char* smem) {
  LAUNDER_IDS
  WAVE_COORDS
  const int tid = tid__;
  u16* Zs = (u16*)smem;
  u16* TA = Zs + 18 * ZSL;
  float* PV = (float*)(TA + 16 * TAL);
  const u16* zr = (const u16*)(p.ws + OFF_R1);
  const char* wl = p.ws + OFF_W + (size_t)l * W_LAYER;
  u16* sc = (u16*)(p.ws + OFF_R3);
  __syncthreads();
  for (int e = tid; e < 2 * ZR + 7 * 256; e += 256) {
    float v;
    if (e < 2 * ZR) v = p.in[I_MU][(size_t)l * 2 * ZR + e];
    else { const int f = e - 2 * ZR, a = f >> 8, c = f & 255;
      v = a == 0 ? p.in[I_KK][l * 256 + c] : a < 3 ? p.in[I_W0][(size_t)(l * 2 + a - 1) * 256 + c] : a < 5 ? p.in[I_A0][(size_t)(l * 2 + a - 3) * 256 + c] : p.in[I_KA][(size_t)(l * 2 + a - 5) * 256 + c]; }
    PV[e] = v;
  }
  const float* mu0 = PV; const float* mu1 = PV + ZR; const float* kkw = PV + 2 * ZR;
  const float* w0p = kkw + 256; const float* a0p = w0p + 512; const float* kap = a0p + 512;
  for (int tile = blk__; tile < NT / 16; tile += gridDim.x) {
    const int r0 = tile * 16;
    const bool lat = r0 < NTL;
    const int t0 = lat ? r0 & 4095 : (r0 - NTL) & 255;
    const int Ls = lat ? L : LC;
    __syncthreads();
    {
      uint4 v[11];
#pragma unroll
      for (int i = 0; i < 11; ++i) {
        const int c = tid + i * 256;
        const int ri = c / 144, ch = c - ri * 144;
        const int tt = t0 - 1 + ri;
        const int cc = min(c, 18 * 144 - 1);
        const int rc = cc / 144, chc = cc - rc * 144;
        const int ttc = min(max(t0 - 1 + rc, 0), Ls - 1);
        const uint4 ld = *(const uint4*)(zr + (size_t)(r0 - t0 + ttc) * ZR + chc * 8);
        const bool ok = (c < 18 * 144) && (tt >= 0) && (tt < Ls);
        v[i] = ok ? ld : make_uint4(0, 0, 0, 0);
      }
#pragma unroll
      for (int i = 0; i < 11; ++i) {
        const int c = tid + i * 256;
        const int ri = c / 144, ch = c - ri * 144;
        if (c < 18 * 144) {
          *(uint2*)(Zs + ri * ZSL + ch * 8) = make_uint2(v[i].x, v[i].y);
          *(uint2*)(Zs + ri * ZSL + ch * 8 + 4) = make_uint2(v[i].z, v[i].w);
        }
      }
    }
    __syncthreads();
#pragma unroll 4
    for (int e = tid; e < 16 * 384; e += 256) {
      const int i = e / 384, c = e - i * 384, zc = 768 + c;
      const float z = bf2f(Zs[(i + 1) * ZSL + zc]), zp = bf2f(Zs[i * ZSL + zc]), zn = bf2f(Zs[(i + 2) * ZSL + zc]);
      float v = z + mu0[zc] * (zp - z) + mu1[zc] * (zn - z);
      if (c < 128) v = 1.f - 2.f / (1.f + __expf(2.f * v)); else if (c >= 256) v = sigmoidf_(v);
      TA[i * TAL + c] = f2bf(v);
    }
    __syncthreads();
    const int row = r0 + lr;
    auto shifted4 = [&](int zc, float (&out)[4]) {
      const uint2 c0 = *(const uint2*)(Zs + (lr + 1) * ZSL + zc), cp = *(const uint2*)(Zs + lr * ZSL + zc), cn = *(const uint2*)(Zs + (lr + 2) * ZSL + zc);
      const float4 m0 = *(const float4*)(mu0 + zc), m1 = *(const float4*)(mu1 + zc);
      float z, zp, zn;
      z = bflo(c0.x); zp = bflo(cp.x); zn = bflo(cn.x); out[0] = z + m0.x * (zp - z) + m1.x * (zn - z);
      z = bfhi(c0.x); zp = bfhi(cp.x); zn = bfhi(cn.x); out[1] = z + m0.y * (zp - z) + m1.y * (zn - z);
      z = bflo(c0.y); zp = bflo(cp.y); zn = bflo(cn.y); out[2] = z + m0.z * (zp - z) + m1.z * (zn - z);
      z = bfhi(c0.y); zp = bfhi(cp.y); zn = bfhi(cn.y); out[3] = z + m0.w * (zp - z) + m1.w * (zn - z);
    };
    auto product = [&](f32x4 (&ac)[4], const u16* W, int Kq, int off) {
#pragma unroll
      for (int ni = 0; ni < 4; ++ni) ac[ni] = f32x4{0.f, 0.f, 0.f, 0.f};
#pragma unroll 2
      for (int ks = 0; ks < Kq / 32; ++ks) {
        const bf16x8 bop = *(const bf16x8*)(TA + lr * TAL + off + ks * 32 + lq * 8);
#pragma unroll
        for (int ni = 0; ni < 4; ++ni) {
          const bf16x8 aop = *(const bf16x8*)(W + (size_t)(wave * 64 + ni * 16 + lr) * Kq + ks * 32 + lq * 8);
          ac[ni] = __builtin_amdgcn_mfma_f32_16x16x32_bf16(aop, bop, ac[ni], 0, 0, 0);
        }
      }
      __builtin_amdgcn_sched_barrier(0);
    };
    float ss = 0.f;
#pragma unroll
    for (int ni = 0; ni < 4; ++ni) {
      const int ch = wave * 64 + ni * 16 + lq * 4;
      float kx[4]; shifted4(256 + ch, kx);
      const float4 kw = *(const float4*)(kkw + ch);
      const float a0 = kx[0] * kw.x, a1 = kx[1] * kw.y, a2 = kx[2] * kw.z, a3 = kx[3] * kw.w;
      ss += a0 * a0 + a1 * a1 + a2 * a2 + a3 * a3;
    }
    ss += __shfl_xor(ss, 16, 64); ss += __shfl_xor(ss, 32, 64);
    const float kinv = rsqrtf(fmaxf(ss, 1e-24f));
    {
      f32x4 ag[4];
      product(ag, (const u16*)(wl + WO_RG2), 128, 256);
#pragma unroll
      for (int ni = 0; ni < 4; ++ni) {
        const int ch = wave * 64 + ni * 16 + lq * 4;
        const size_t o = (size_t)row * 256 + ch;
        float rx[4], kx[4], vx[4];
        shifted4(ch, rx); shifted4(256 + ch, kx); shifted4(512 + ch, vx);
        const float4 kw = *(const float4*)(kkw + ch);
        *(uint2*)(sc + SA_R * (size_t)NT * 256 + o) = make_uint2(pack2(rx[0], rx[1]), pack2(rx[2], rx[3]));
        *(uint2*)(sc + SA_V * (size_t)NT * 256 + o) = make_uint2(pack2(vx[0], vx[1]), pack2(vx[2], vx[3]));
        *(uint2*)(sc + SA_KKN * (size_t)NT * 256 + o) = make_uint2(pack2(-kx[0] * kw.x * kinv, -kx[1] * kw.y * kinv), pack2(-kx[2] * kw.z * kinv, -kx[3] * kw.w * kinv));
        *(uint2*)(sc + SA_G * (size_t)NT * 256 + o) = make_uint2(pack2(ag[ni][0], ag[ni][1]), pack2(ag[ni][2], ag[ni][3]));
        __builtin_amdgcn_sched_barrier(0);
      }
    }
#pragma unroll 1
    for (int d = 0; d < 2; ++d) {
      f32x4 aw[4], aa[4];
      product(aw, (const u16*)(wl + WO_RW2) + (size_t)d * 256 * 64, 64, d * 64);
      product(aa, (const u16*)(wl + WO_RA2) + (size_t)d * 256 * 64, 64, 128 + d * 64);
      __builtin_amdgcn_sched_barrier(0);
      u16* oOMW = sc + (d ? SA_OMWB : SA_OMWF) * (size_t)NT * 256;
      u16* oKD = sc + (d ? SA_KDB : SA_KDF) * (size_t)NT * 256;
      u16* oB = sc + (d ? SA_BB : SA_BF) * (size_t)NT * 256;
#pragma unroll
      for (int ni = 0; ni < 4; ++ni) {
        const int ch = wave * 64 + ni * 16 + lq * 4;
        const size_t o = (size_t)row * 256 + ch;
        float kx[4]; shifted4(256 + ch, kx);
        const float4 kw = *(const float4*)(kkw + ch);
        const float kkn[4] = {kx[0] * kw.x * kinv, kx[1] * kw.y * kinv, kx[2] * kw.z * kinv, kx[3] * kw.w * kinv};
        const float4 w0 = *(const float4*)(w0p + d * 256 + ch);
        const float4 a0 = *(const float4*)(a0p + d * 256 + ch);
        const float4 ka = *(const float4*)(kap + d * 256 + ch);
        const float w0a[4] = {w0.x, w0.y, w0.z, w0.w}, a0a[4] = {a0.x, a0.y, a0.z, a0.w}, kaa[4] = {ka.x, ka.y, ka.z, ka.w};
        float omw[4], kd[4], bb[4];
#pragma unroll
        for (int j = 0; j < 4; ++j) {
          const float xw = -(w0a[j] + aw[ni][j]);
          const float sp = fmaxf(xw, 0.f) + __logf(1.f + __expf(-fabsf(xw)));
          const float wlog = -sp - 0.5f;
          const float e = __expf(wlog);
          omw[j] = 1.f - __expf(-e);
          const float a = sigmoidf_(a0a[j] + aa[ni][j]);
          kd[j] = kx[j] * (1.f + (a - 1.f) * kaa[j]);
          bb[j] = kkn[j] * a;
        }
        *(uint2*)(oOMW + o) = make_uint2(pack2(omw[0], omw[1]), pack2(omw[2], omw[3]));
        *(uint2*)(oKD + o) = make_uint2(pack2(kd[0], kd[1]), pack2(kd[2], kd[3]));
        *(uint2*)(oB + o) = make_uint2(pack2(bb[0], bb[1]), pack2(bb[2], bb[3]));
        __builtin_amdgcn_sched_barrier(0);
      }
    }
  }
}

DI size_t qk_index(int m, int h) {
  const bool lat = m < NTL;
  const int b = lat ? m >> 12 : (m - NTL) >> 8;
  const int pos = lat ? m & 4095 : 4096 + ((m - NTL) & 255);
  return ((size_t)(b * 8 + h) * LK + pos) * 96;
}
DI void phase_qkv(const Params& p, int l, char* smem) {
  LAUNDER_IDS
  WAVE_COORDS
  const char* wl = p.ws + OFF_W + (size_t)l * W_LAYER;
  const u16* za = (const u16*)(p.ws + OFF_R2);
  const float* rsq0 = (const float*)(p.ws + OFF_RSQ); const float* rskv0 = (const float*)(p.ws + OFF_RSKV);
  u16* Qb = (u16*)(p.ws + OFF_R1); u16* Kb = (u16*)(p.ws + OFF_R1 + SZ_Q); u16* Vt = (u16*)(p.ws + OFF_R1 + 2 * SZ_Q);
  const float* rt0 = (const float*)(p.ws + OFF_ROPE);
  const float* gq0 = p.in[I_GQ] + l * 96; const float* gk0 = p.in[I_GK] + l * 96;
  const float QS = 0.10206207261596577f * 1.4426950408889634f;
  constexpr int NTM = NT / 256;
  for (int it = 0;; ++it) {
    int tm, tn;
    if (!tile_map(it, NTM, 6, blk__, gridDim.x, tm, tn)) break;
    f32x4 acc[8][4]; zero_acc8<4>(acc);
    {
      const int m0 = tm * 256, n0 = tn * 128;
      gemm256<4>(acc, za + 256, ZA, (const u16*)(wl + WO_UQ), 384, 384, m0, n0, smem);
      EPI_BEGIN
      const float* gq = gq0; const float* rt = rt0; const float* rsq = rsq0;
      asm volatile("" : "+v"(gq), "+v"(rt), "+v"(rsq));
      const int nw = n0 + wc * 64;
#pragma unroll
      for (int mi = 0; mi < 8; ++mi) {
        __builtin_amdgcn_sched_barrier(0);
        const int m = m0 + wr * 128 + mi * 16 + lr;
        const float rs = rsq[m];
        if (nw < 512) {
          const int h = nw >> 6;
          float ss = 0.f;
#pragma unroll
          for (int ni = 0; ni < 4; ++ni)
#pragma unroll
            for (int j = 0; j < 4; ++j) { const float v = acc[mi][ni][j] * rs; ss += v * v; }
          ss += __shfl_xor(ss, 16, 64); ss += __shfl_xor(ss, 32, 64);
          const float f = rs * rsqrtf(ss * (1.f / 64.f) + 1e-6f) * QS;
          u16* dst = Qb + qk_index(m, h);
#pragma unroll
          for (int ni = 0; ni < 4; ++ni) {
            const int d = ni * 16 + lq * 4;
            const float4 g = *(const float4*)(gq + d);
            *(uint2*)(dst + d) = make_uint2(pack2(acc[mi][ni][0] * f * g.x, acc[mi][ni][1] * f * g.y), pack2(acc[mi][ni][2] * f * g.z, acc[mi][ni][3] * f * g.w));
          }
        } else {
          const bool lat = m < NTL;
          const int tt = m & 4095;
#pragma unroll
          for (int hh = 0; hh < 2; ++hh) {
            __builtin_amdgcn_sched_barrier(0);
            const int h = ((nw - 512) >> 5) + hh;
            float ss = 0.f;
#pragma unroll
            for (int ni = 0; ni < 2; ++ni)
#pragma unroll
              for (int j = 0; j < 4; ++j) { const float v = acc[mi][hh * 2 + ni][j] * rs; ss += v * v; }
            ss += __shfl_xor(ss, 16, 64); ss += __shfl_xor(ss, 32, 64);
            const float f = rs * rsqrtf(ss * (1.f / 32.f) + 1e-6f) * QS;
            const int i0 = lq * 4;
            const float4 g1 = *(const float4*)(gq + 64 + i0), g2 = *(const float4*)(gq + 80 + i0);
            const float g1a[4] = {g1.x, g1.y, g1.z, g1.w}, g2a[4] = {g2.x, g2.y, g2.z, g2.w};
            float o1[4], o2[4];
#pragma unroll
            for (int j = 0; j < 4; ++j) {
              const float x1 = acc[mi][hh * 2][j] * f * g1a[j], x2 = acc[mi][hh * 2 + 1][j] * f * g2a[j];
              float cs = 1.f, sn = 0.f;
              if (lat) {
                const int i = i0 + j;
                const int pp = i < 8 ? (tt >> 6) : (tt & 63);
                cs = rt[(pp * 8 + (i & 7)) * 2]; sn = rt[(pp * 8 + (i & 7)) * 2 + 1];
              }
              o1[j] = x1 * cs - x2 * sn; o2[j] = x1 * sn + x2 * cs;
            }
            u16* dst = Qb + qk_index(m, h) + 64;
            *(uint2*)(dst + i0) = make_uint2(pack2(o1[0], o1[1]), pack2(o1[2], o1[3]));
            *(uint2*)(dst + 16 + i0) = make_uint2(pack2(o2[0], o2[1]), pack2(o2[2], o2[3]));
          }
        }
      }
      EPI_END
    }
  }
  __builtin_amdgcn_sched_barrier(0);
  for (int it = 0;; ++it) {
    int tm, tn;
    if (!tile_map(it, NTM, 8, blk__, gridDim.x, tm, tn)) break;
    f32x4 acc[8][4]; zero_acc8<4>(acc);
    {
      const int h = tn, m0 = tm * 256, n0 = h * 128;
      gemm256<4>(acc, za + 640, ZA, (const u16*)(wl + WO_UKV), 256, 256, m0, n0, smem);
      EPI_BEGIN
      const float* gk = gk0; const float* rskv = rskv0;
      asm volatile("" : "+v"(gk), "+v"(rskv));
#pragma unroll
      for (int mi = 0; mi < 8; ++mi) {
        __builtin_amdgcn_sched_barrier(0);
        const int m = m0 + wr * 128 + mi * 16 + lr;
        const float rs = rskv[m];
        if (wc == 0) {
          float ss = 0.f;
#pragma unroll
          for (int ni = 0; ni < 4; ++ni)
#pragma unroll
            for (int j = 0; j < 4; ++j) { const float v = acc[mi][ni][j] * rs; ss += v * v; }
          ss += __shfl_xor(ss, 16, 64); ss += __shfl_xor(ss, 32, 64);
          const float f = rs * rsqrtf(ss * (1.f / 64.f) + 1e-6f);
          u16* dst = Kb + qk_index(m, h);
#pragma unroll
          for (int ni = 0; ni < 4; ++ni) {
            const int d = ni * 16 + lq * 4;
            const float4 g = *(const float4*)(gk + d);
            *(uint2*)(dst + d) = make_uint2(pack2(acc[mi][ni][0] * f * g.x, acc[mi][ni][1] * f * g.y), pack2(acc[mi][ni][2] * f * g.z, acc[mi][ni][3] * f * g.w));
          }
          *(uint4*)(dst + 64 + lq * 8) = *(const uint4*)((const u16*)(p.ws + OFF_KR) + (size_t)m * 32 + lq * 8);
        } else {
          const bool lat = m < NTL;
          const int b = lat ? m >> 12 : (m - NTL) >> 8;
          const int pos = lat ? m & 4095 : 4096 + ((m - NTL) & 255);
          u16* dst = Vt + (size_t)(b * 8 + h) * 64 * LK + pos + (size_t)(lq * 4) * LK;
#pragma unroll
          for (int ni = 0; ni < 4; ++ni) {
            asm volatile("" : "+v"(dst));
#pragma unroll
            for (int j = 0; j < 4; ++j) dst[j * LK] = f2bf(acc[mi][ni][j] * rs);
            dst += 16 * LK;
          }
        }
      }
      EPI_END
    }
  }
}

DI int scan_row(int b, int dir, int s) {
  if (s < LC) return NTL + b * LC + (dir ? LC - 1 - s : s);
  const int t = s - LC;
  return b * L + (dir ? L - 1 - t : t);
}
DI void phase_scan(const Params& p, char* smem) {
  LAUNDER_IDS
  const int blk = blk__;
  if (blk >= 256) return;
  const int tid = tid__, lane = tid & 63, wave = tid >> 6, kq = lane & 15, rg = lane >> 4;
  const int chain = (blk & 7) + 8 * (blk >> 5), quarter = (blk >> 3) & 3;
  const int b = chain >> 3, h = (chain >> 1) & 3, dir = chain & 1;
  const u16* sc = (const u16*)(p.ws + OFF_R3);
  const size_t AS = (size_t)NT * 256;
  const u16* aOMW = sc + (dir ? SA_OMWB : SA_OMWF) * AS;
  const u16* aKD = sc + (dir ? SA_KDB : SA_KDF) * AS;
  const u16* aB = sc + (dir ? SA_BB : SA_BF) * AS;
  const u16* aKKN = sc + SA_KKN * AS;
  const u16* aR = sc + SA_R * AS;
  const u16* aV = sc + SA_V * AS;
  u16* Y = (u16*)(p.ws + OFF_R2) + (dir ? AS : 0);
  constexpr int CH = 16, BSZ = 5 * CH * 64 + CH * 16;
  float* buf = (float*)smem;
  const int st_ld = tid >> 4, k4 = (tid & 15) * 4;
  const int vrow = quarter * 16 + wave * 4 + rg;
  uint2 g0, g1, g2, g3, g4; u16 gv;
#define SCAN_GLOAD(CHUNK) do { \
    const int row_ = scan_row(b, dir, (CHUNK) * CH + st_ld); \
    const size_t o_ = (size_t)row_ * 256 + h * 64 + k4; \
    g0 = *(const uint2*)(aOMW + o_); g1 = *(const uint2*)(aKD + o_); g2 = *(const uint2*)(aB + o_); g3 = *(const uint2*)(aKKN + o_); g4 = *(const uint2*)(aR + o_); \
    gv = aV[(size_t)row_ * 256 + h * 64 + quarter * 16 + (tid & 15)]; } while (0)
#define SCAN_LSTORE(BI) do { \
    float* bb_ = buf + (BI) * BSZ + st_ld * 64 + k4; \
    *(float4*)(bb_ + 0 * CH * 64) = make_float4(1.f - bflo(g0.x), 1.f - bfhi(g0.x), 1.f - bflo(g0.y), 1.f - bfhi(g0.y)); \
    *(float4*)(bb_ + 1 * CH * 64) = make_float4(bflo(g1.x), bfhi(g1.x), bflo(g1.y), bfhi(g1.y)); \
    *(float4*)(bb_ + 2 * CH * 64) = make_float4(bflo(g2.x), bfhi(g2.x), bflo(g2.y), bfhi(g2.y)); \
    *(float4*)(bb_ + 3 * CH * 64) = make_float4(bflo(g3.x), bfhi(g3.x), bflo(g3.y), bfhi(g3.y)); \
    *(float4*)(bb_ + 4 * CH * 64) = make_float4(bflo(g4.x), bfhi(g4.x), bflo(g4.y), bfhi(g4.y)); \
    buf[(BI) * BSZ + 5 * CH * 64 + st_ld * 16 + (tid & 15)] = bf2f(gv); } while (0)
  float2_t S01 = {0.f, 0.f}, S23 = {0.f, 0.f};
  __builtin_amdgcn_s_setprio(3);
  __syncthreads();
  SCAN_GLOAD(0); SCAN_LSTORE(0);
  __syncthreads();
  constexpr int NCH = LK / CH;
  for (int c = 0; c < NCH; ++c) {
    if (c + 1 < NCH) SCAN_GLOAD(c + 1);
    const float* bb = buf + (c & 1) * BSZ;
    const int rowbase = scan_row(b, dir, c * CH);
    const int rstep = dir ? -1 : 1;
    const float* bl = bb + kq * 4;
    const float* bv = bb + 5 * CH * 64 + wave * 4 + rg;
    float4 fw = *(const float4*)(bl + 0 * CH * 64), fk = *(const float4*)(bl + 1 * CH * 64), fb = *(const float4*)(bl + 2 * CH * 64),
           fa = *(const float4*)(bl + 3 * CH * 64), fr = *(const float4*)(bl + 4 * CH * 64);
    float vv = bv[0];
    float ysel = 0.f;
#pragma unroll
    for (int s = 0; s < CH; ++s) {
      const float2_t a01 = {fa.x, fa.y}, a23 = {fa.z, fa.w};
      const float2_t w01 = {fw.x, fw.y}, w23 = {fw.z, fw.w}, k01 = {fk.x, fk.y}, k23 = {fk.z, fk.w}, b01 = {fb.x, fb.y}, b23 = {fb.z, fb.w};
      const float2_t r01 = {fr.x, fr.y}, r23 = {fr.z, fr.w};
      const float2_t vv2 = {vv, vv};
      if (s + 1 < CH) {
        fw = *(const float4*)(bl + 0 * CH * 64 + (s + 1) * 64); fk = *(const float4*)(bl + 1 * CH * 64 + (s + 1) * 64); fb = *(const float4*)(bl + 2 * CH * 64 + (s + 1) * 64);
        fa = *(const float4*)(bl + 3 * CH * 64 + (s + 1) * 64); fr = *(const float4*)(bl + 4 * CH * 64 + (s + 1) * 64);
        vv = bv[(s + 1) * 16];
      }
      float2_t t2 = S01 * a01; t2 = S23 * a23 + t2;
      const float sa = rowsum16(t2.x + t2.y);
      const float2_t sa2 = {sa, sa};
      float2_t u01 = vv2 * k01; u01 = sa2 * b01 + u01; S01 = S01 * w01 + u01;
      float2_t u23 = vv2 * k23; u23 = sa2 * b23 + u23; S23 = S23 * w23 + u23;
      float2_t y2 = S01 * r01; y2 = S23 * r23 + y2;
      const float y = rowsum16(y2.x + y2.y);
      ysel = (kq == s) ? y : ysel;
    }
    Y[(size_t)(rowbase + rstep * kq) * 256 + h * 64 + vrow] = f2bf(ysel);
    if (c + 1 < NCH) SCAN_LSTORE((c + 1) & 1);
    __syncthreads();
  }
  __builtin_amdgcn_s_setprio(0);
#undef SCAN_GLOAD
#undef SCAN_LSTORE
}

constexpr int KSL = 104, VSL = 68;
template <int B0>
DI bf16x8 pack8(const f32x16& v) {
  uint4 pw;
  pw.x = pack2(v[B0 + 0], v[B0 + 1]); pw.y = pack2(v[B0 + 2], v[B0 + 3]); pw.z = pack2(v[B0 + 4], v[B0 + 5]); pw.w = pack2(v[B0 + 6], v[B0 + 7]);
  return __builtin_bit_cast(bf16x8, pw);
}
DI void pv_step(f32x16& o0, f32x16& o1, const u16* Vc, int r32, int kb, bf16x8 pf) {
  {
    const uint2 lo = *(const uint2*)(Vc + r32 * VSL + kb), hi2 = *(const uint2*)(Vc + r32 * VSL + kb + 8);
    const bf16x8 va = __builtin_bit_cast(bf16x8, make_uint4(lo.x, lo.y, hi2.x, hi2.y));
    o0 = __builtin_amdgcn_mfma_f32_32x32x16_bf16(va, pf, o0, 0, 0, 0);
  }
  {
    const uint2 lo = *(const uint2*)(Vc + (32 + r32) * VSL + kb), hi2 = *(const uint2*)(Vc + (32 + r32) * VSL + kb + 8);
    const bf16x8 va = __builtin_bit_cast(bf16x8, make_uint4(lo.x, lo.y, hi2.x, hi2.y));
    o1 = __builtin_amdgcn_mfma_f32_32x32x16_bf16(va, pf, o1, 0, 0, 0);
  }
}
DI void attn_item(const Params& p, int item, char* smem) {
  LAUNDER_IDS
  const int tid = tid__, lane = tid & 63, wave = tid >> 6, r32 = lane & 31, hi = lane >> 5;
  int bh, qpos0, key0, nkt, orow0;
  if (item < 2048) { bh = item >> 5; const int qb = item & 31; qpos0 = qb * 128; key0 = 0; nkt = LK / 64; orow0 = (bh >> 3) * L + qpos0; }
  else { const int it = item - 2048; bh = it >> 1; const int qb = it & 1; qpos0 = 4096 + qb * 128; key0 = 4096; nkt = LC / 64; orow0 = NTL + (bh >> 3) * LC + qb * 128; }
  const int h = bh & 7;
  const u16* Qp = (const u16*)(p.ws + OFF_R1) + ((size_t)bh * LK + qpos0 + wave * 32 + r32) * 96 + hi * 8;
  const u16* Kp = (const u16*)(p.ws + OFF_R1 + SZ_Q) + ((size_t)bh * LK + key0) * 96;
  const u16* Vp = (const u16*)(p.ws + OFF_R1 + 2 * SZ_Q) + (size_t)bh * 64 * LK + key0;
  u16* Ks = (u16*)smem;
  u16* Vs = Ks + 2 * 64 * KSL;
  bf16x8 qr[6];
#pragma unroll
  for (int d0 = 0; d0 < 6; ++d0) qr[d0] = *(const bf16x8*)(Qp + d0 * 16);
  uint4 sk0, sk1, sk2, sv0, sv1;
  const int kr0 = tid / 12, kc0 = tid - kr0 * 12, kr1 = (tid + 256) / 12, kc1 = (tid + 256) - kr1 * 12, kr2 = (tid + 512) / 12, kc2 = (tid + 512) - kr2 * 12;
  const int vd0 = tid >> 3, vc0 = tid & 7, vd1 = vd0 + 32;
#define gload(kt) do { \
    sk0 = *(const uint4*)(Kp + (size_t)((kt) * 64 + kr0) * 96 + kc0 * 8); sk1 = *(const uint4*)(Kp + (size_t)((kt) * 64 + kr1) * 96 + kc1 * 8); \
    sk2 = *(const uint4*)(Kp + (size_t)((kt) * 64 + kr2) * 96 + kc2 * 8); \
    sv0 = *(const uint4*)(Vp + (size_t)vd0 * LK + (kt) * 64 + vc0 * 8); sv1 = *(const uint4*)(Vp + (size_t)vd1 * LK + (kt) * 64 + vc0 * 8); } while (0)
#define lstore(bi) do { \
    *(uint4*)(Ks + (bi) * 64 * KSL + kr0 * KSL + kc0 * 8) = sk0; *(uint4*)(Ks + (bi) * 64 * KSL + kr1 * KSL + kc1 * 8) = sk1; *(uint4*)(Ks + (bi) * 64 * KSL + kr2 * KSL + kc2 * 8) = sk2; \
    { u16* dst = Vs + (bi) * 64 * VSL + vd0 * VSL + vc0 * 8; *(uint2*)dst = make_uint2(sv0.x, sv0.y); *(uint2*)(dst + 4) = make_uint2(sv0.z, sv0.w); } \
    { u16* dst = Vs + (bi) * 64 * VSL + vd1 * VSL + vc0 * 8; *(uint2*)dst = make_uint2(sv1.x, sv1.y); *(uint2*)(dst + 4) = make_uint2(sv1.z, sv1.w); } } while (0)
  f32x16 o0, o1;
#pragma unroll
  for (int i = 0; i < 16; ++i) { o0[i] = 0.f; o1[i] = 0.f; }
  float mrun = -1e30f, lrun = 0.f;
  __syncthreads();
  gload(0); lstore(0);
  __syncthreads();
  for (int kt = 0; kt < nkt; ++kt) {
    const int cur = kt & 1;
    if (kt + 1 < nkt) gload(kt + 1);
    const u16* Kc = Ks + cur * 64 * KSL;
    const u16* Vc = Vs + cur * 64 * VSL;
    f32x16 p0, p1;
#pragma unroll
    for (int i = 0; i < 16; ++i) { p0[i] = 0.f; p1[i] = 0.f; }
#pragma unroll
    for (int d0 = 0; d0 < 6; ++d0) {
      const bf16x8 a0 = *(const bf16x8*)(Kc + r32 * KSL + d0 * 16 + hi * 8);
      const bf16x8 a1 = *(const bf16x8*)(Kc + (32 + r32) * KSL + d0 * 16 + hi * 8);
      p0 = __builtin_amdgcn_mfma_f32_32x32x16_bf16(a0, qr[d0], p0, 0, 0, 0);
      p1 = __builtin_amdgcn_mfma_f32_32x32x16_bf16(a1, qr[d0], p1, 0, 0, 0);
    }
    float mx = p0[0];
#pragma unroll
    for (int i = 1; i < 16; ++i) mx = fmaxf(mx, p0[i]);
#pragma unroll
    for (int i = 0; i < 16; ++i) mx = fmaxf(mx, p1[i]);
    mx = fmaxf(mx, __shfl_xor(mx, 32, 64));
    if (!__all(mx - mrun <= 8.f)) {
      const float mn = fmaxf(mrun, mx);
      const float alpha = __builtin_amdgcn_exp2f(mrun - mn);
      mrun = mn; lrun *= alpha;
#pragma unroll
      for (int i = 0; i < 16; ++i) { o0[i] *= alpha; o1[i] *= alpha; }
    }
    float ps = 0.f;
#pragma unroll
    for (int i = 0; i < 16; ++i) { p0[i] = __builtin_amdgcn_exp2f(p0[i] - mrun); ps += p0[i]; }
#pragma unroll
    for (int i = 0; i < 16; ++i) { p1[i] = __builtin_amdgcn_exp2f(p1[i] - mrun); ps += p1[i]; }
    lrun += ps;
    pv_step(o0, o1, Vc, r32, 0 + hi * 4, pack8<0>(p0));
    pv_step(o0, o1, Vc, r32, 16 + hi * 4, pack8<8>(p0));
    pv_step(o0, o1, Vc, r32, 32 + hi * 4, pack8<0>(p1));
    pv_step(o0, o1, Vc, r32, 48 + hi * 4, pack8<8>(p1));
    if (kt + 1 < nkt) lstore(cur ^ 1);
    __syncthreads();
  }
  lrun += __shfl_xor(lrun, 32, 64);
  const float inv = 1.f / lrun;
  u16* om = (u16*)(p.ws + OFF_OMLA) + (size_t)(orow0 + wave * 32 + r32) * 512 + h * 64;
#pragma unroll
  for (int g = 0; g < 4; ++g) {
    const int d = 8 * g + 4 * hi;
    *(uint2*)(om + d) = make_uint2(pack2(o0[4 * g] * inv, o0[4 * g + 1] * inv), pack2(o0[4 * g + 2] * inv, o0[4 * g + 3] * inv));
    *(uint2*)(om + 32 + d) = make_uint2(pack2(o1[4 * g] * inv, o1[4 * g + 1] * inv), pack2(o1[4 * g + 2] * inv, o1[4 * g + 3] * inv));
  }
#undef gload
#undef lstore
}

DI void readout_row(const Params& p, int l, int r) {
  LAUNDER_IDS
  const int lane = tid__ & 63;
  const u16* sc = (const u16*)(p.ws + OFF_R3);
  const size_t AS = (size_t)NT * 256;
  const size_t o = (size_t)r * 256 + lane * 4;
  const u16* Yf = (const u16*)(p.ws + OFF_R2);
  const uint2 yf = *(const uint2*)(Yf + o), yb = *(const uint2*)(Yf + AS + o);
  const uint2 ur = *(const uint2*)(sc + SA_R * AS + o), uv = *(const uint2*)(sc + SA_V * AS + o);
  const uint2 kf = *(const uint2*)(sc + SA_KDF * AS + o), kb = *(const uint2*)(sc + SA_KDB * AS + o), ug = *(const uint2*)(sc + SA_G * AS + o);
  float y[4] = {bflo(yf.x) + bflo(yb.x), bfhi(yf.x) + bfhi(yb.x), bflo(yf.y) + bflo(yb.y), bfhi(yf.y) + bfhi(yb.y)};
  const float rr[4] = {bflo(ur.x), bfhi(ur.x), bflo(ur.y), bfhi(ur.y)};
  const float vv[4] = {bflo(uv.x), bfhi(uv.x), bflo(uv.y), bfhi(uv.y)};
  const float km[4] = {0.5f * (bflo(kf.x) + bflo(kb.x)), 0.5f * (bfhi(kf.x) + bfhi(kb.x)), 0.5f * (bflo(kf.y) + bflo(kb.y)), 0.5f * (bfhi(kf.y) + bfhi(kb.y))};
  const float gg[4] = {bflo(ug.x), bfhi(ug.x), bflo(ug.y), bfhi(ug.y)};
  const float4 rk4 = *(const float4*)(p.in[I_RK] + l * 256 + lane * 4);
  const float4 lw4 = *(const float4*)(p.in[I_LNW] + l * 256 + lane * 4);
  const float4 lb4 = *(const float4*)(p.in[I_LNB] + l * 256 + lane * 4);
  const float rk[4] = {rk4.x, rk4.y, rk4.z, rk4.w}, lw[4] = {lw4.x, lw4.y, lw4.z, lw4.w}, lb[4] = {lb4.x, lb4.y, lb4.z, lb4.w};
  float s = y[0] + y[1] + y[2] + y[3];
  s = rowsum16(s);
  const float mu = s * (1.f / 64.f);
  float q = 0.f, bn = 0.f;
#pragma unroll
  for (int j = 0; j < 4; ++j) { const float d = y[j] - mu; q += d * d; bn += rr[j] * km[j] * rk[j]; }
  q = rowsum16(q); bn = rowsum16(bn);
  const float rstd = rsqrtf(q * (1.f / 64.f) + 64e-5f);
  float ov[4];
#pragma unroll
  for (int j = 0; j < 4; ++j) ov[j] = ((y[j] - mu) * rstd * lw[j] + lb[j] + bn * vv[j]) * gg[j];
  u16* orw = (u16*)(p.ws + OFF_R3 + SA_KKN * SZ_TOK256 + (size_t)NT * 512 * 2);
  *(uint2*)(orw + o) = make_uint2(pack2(ov[0], ov[1]), pack2(ov[2], ov[3]));
}

DI void phase_attn(const Params& p, int l, char* smem) {
  LAUNDER_IDS
  __shared__ int qslot_sh;
  const int nattn = (l == 0) ? 2048 + 128 : 2048;
  unsigned* ctr = (unsigned*)(p.ws + OFF_BAR) + 16 + l * 16;
  for (;;) {
    __syncthreads();
    if (tid__ == 0) qslot_sh = (int)__hip_atomic_fetch_add(ctr, 1u, __ATOMIC_RELAXED, __HIP_MEMORY_SCOPE_AGENT);
    __syncthreads();
    const int it = qslot_sh;
    if (it >= nattn) break;
    attn_item(p, it, smem);
  }
}
DI void phase_readout(const Params& p, int l, int Mout) {
  LAUNDER_IDS
  const int wave = tid__ >> 6;
  for (int r = blk__ * 4 + wave; r < Mout; r += gridDim.x * 4) readout_row(p, l, r);
}

DI void phase_merge(const Params& p, int l, int Mout, char* smem) {
  LAUNDER_IDS
  WAVE_COORDS
  const char* wl = p.ws + OFF_W + (size_t)l * W_LAYER;
  const u16* hg = (const u16*)(p.ws + OFF_HBG);
  const u16* opool = (const u16*)(p.ws + OFF_R4);
  const u16* omla = (const u16*)(p.ws + OFF_OMLA);
  const u16* orw = (const u16*)(p.ws + OFF_R3 + SA_KKN * SZ_TOK256) + (size_t)NT * 512;
  u16* mo = (u16*)(p.ws + OFF_R1);
  const int ntm = Mout / 256;
  for (int it = 0;; ++it) {
    int tm, tn;
    if (!tile_map(it, ntm, 16, blk__, gridDim.x, tm, tn)) break;
    const int m0 = tm * 256, n0 = tn * 64;
    f32x4 msum[8][2]; zero_acc8<2>(msum);
#pragma unroll 1
    for (int br = 0; br < 3; ++br) {
      unsigned gpk[8][2][2];
      {
        f32x4 ag[8][2]; zero_acc8<2>(ag);
        gemm256<2>(ag, hg, 1024, (const u16*)(wl + WO_WIN) + (size_t)(2080 + br * 1024) * 1024, 1024, 1024, m0, n0, smem);
#pragma unroll
        for (int mi = 0; mi < 8; ++mi)
#pragma unroll
          for (int ni = 0; ni < 2; ++ni) {
            gpk[mi][ni][0] = pack2(sigmoidf_(ag[mi][ni][0]), sigmoidf_(ag[mi][ni][1]));
            gpk[mi][ni][1] = pack2(sigmoidf_(ag[mi][ni][2]), sigmoidf_(ag[mi][ni][3]));
          }
      }
      __builtin_amdgcn_sched_barrier(0);
      f32x4 ab[8][2]; zero_acc8<2>(ab);
      {
        const int Kb = br == 1 ? 512 : 256;
        const u16* Ab = br == 0 ? opool : br == 1 ? omla : orw;
        const u16* Wb = (const u16*)(wl + (br == 0 ? WO_BRP : br == 1 ? WO_BRM : WO_BRR));
        gemm256<2>(ab, Ab, Kb, Wb, Kb, Kb, m0, n0, smem);
      }
#pragma unroll
      for (int mi = 0; mi < 8; ++mi)
#pragma unroll
        for (int ni = 0; ni < 2; ++ni) {
          msum[mi][ni][0] += bflo(gpk[mi][ni][0]) * ab[mi][ni][0];
          msum[mi][ni][1] += bfhi(gpk[mi][ni][0]) * ab[mi][ni][1];
          msum[mi][ni][2] += bflo(gpk[mi][ni][1]) * ab[mi][ni][2];
          msum[mi][ni][3] += bfhi(gpk[mi][ni][1]) * ab[mi][ni][3];
        }
      __builtin_amdgcn_sched_barrier(0);
    }
#pragma unroll
    for (int mi = 0; mi < 8; ++mi) {
      const int m = m0 + wr * 128 + mi * 16 + lr;
#pragma unroll
      for (int ni = 0; ni < 2; ++ni) {
        const int n = n0 + wc * 32 + ni * 16 + lq * 4;
        *(uint2*)(mo + (size_t)m * 1024 + n) = make_uint2(pack2(msum[mi][ni][0], msum[mi][ni][1]), pack2(msum[mi][ni][2], msum[mi][ni][3]));
      }
    }
  }
}

DI void phase_resid(const Params& p, const u16* A, int K, const u16* Bt, const float* gate  ,
                    const float* xl_in, const float* xc_in, float* xl_out, float* xc_out, int Mout, char* smem) {
  LAUNDER_IDS
  WAVE_COORDS
  const int ntm = Mout / 256;
  for (int it = 0;; ++it) {
    int tm, tn;
    if (!tile_map(it, ntm, 8, blk__, gridDim.x, tm, tn)) break;
    const int m0 = tm * 256, n0 = tn * 128;
    f32x4 acc[8][4]; zero_acc8<4>(acc);
    gemm256<4, false>(acc, A, K, Bt, K, K, m0, n0, smem);
    EPI_BEGIN
#pragma unroll
    for (int mi = 0; mi < 8; ++mi) {
      const int m = m0 + wr * 128 + mi * 16 + lr;
      const int b9 = m < NTL ? m >> 12 : 8;
      const float* xi = xrow(xl_in, xc_in, m);
      float* xo = m < NTL ? xl_out + (size_t)m * D : xc_out + (size_t)(m - NTL) * D;
#pragma unroll
      for (int ni = 0; ni < 4; ++ni) {
        const int n = n0 + wc * 64 + ni * 16 + lq * 4;
        const float4 g = *(const float4*)(gate + (size_t)b9 * 6144 + n);
        const float4 xv = *(const float4*)(xi + n);
        float4 ov;
        ov.x = xv.x + g.x * acc[mi][ni][0]; ov.y = xv.y + g.y * acc[mi][ni][1]; ov.z = xv.z + g.z * acc[mi][ni][2]; ov.w = xv.w + g.w * acc[mi][ni][3];
        *(float4*)(xo + n) = ov;
      }
      __builtin_amdgcn_sched_barrier(0);
    }
    EPI_END
  }
}
DI void phase_mlp1(const Params& p, int l, int Mout, char* smem) {
  LAUNDER_IDS
  WAVE_COORDS
  const char* wl = p.ws + OFF_W + (size_t)l * W_LAYER;
  const u16* hb = (const u16*)(p.ws + OFF_HB2);
  u16* U = (u16*)(p.ws + OFF_R1);
  const int ntm = Mout / 256;
  for (int it = 0;; ++it) {
    int tm, tn;
    if (!tile_map(it, ntm, 32, blk__, gridDim.x, tm, tn)) break;
    const int m0 = tm * 256, n0 = tn * 128;
    f32x4 acc[8][4]; zero_acc8<4>(acc);
    gemm256<4, false>(acc, hb, 1024, (const u16*)(wl + WO_W1), 1024, 1024, m0, n0, smem);
    EPI_BEGIN
#pragma unroll
    for (int mi = 0; mi < 8; ++mi) {
      const int m = m0 + wr * 128 + mi * 16 + lr;
#pragma unroll
      for (int ni = 0; ni < 4; ++ni) {
        const int n = n0 + wc * 64 + ni * 16 + lq * 4;
        float v[4];
#pragma unroll
        for (int j = 0; j < 4; ++j) { const float a = fmaxf(acc[mi][ni][j], 0.f); v[j] = a * a; }
        *(uint2*)(U + (size_t)m * DFF + n) = make_uint2(pack2(v[0], v[1]), pack2(v[2], v[3]));
      }
      __builtin_amdgcn_sched_barrier(0);
    }
    EPI_END
  }
}

__global__ void __launch_bounds__(256, 2) fwd_megakernel(Params pk) {
  __shared__ __attribute__((aligned(16))) char smem[73728];
  cg::grid_group grid = cg::this_grid();
  if (threadIdx.x == 0) { g_base_sh[0] = (unsigned long long)pk.ws; g_base_sh[1] = (unsigned long long)pk.out; }
  xcd_barrier_post((unsigned*)(pk.ws + OFF_BAR));
  __syncthreads();
  phase_prep(pk, smem);
  if (pk.ws == nullptr) grid.sync();
  xcd_barrier();
  phase_tables(pk);
  xcd_barrier();
#define CTXBUF ((float*)(p.ws + OFF_CTX))
#define XLP (l == 0 ? p.in[I_X] : (const float*)p.out)
#define XCP (l == 0 ? p.in[I_CTX] : (const float*)CTXBUF)
#define MOUT (l == 0 ? NT : NTL)
#define WLP (p.ws + OFF_W + (size_t)l * W_LAYER)
#define TABP(nrm) ((const float*)(p.ws + OFF_TAB) + (size_t)(l * 2 + (nrm)) * 9 * 2048)
#define MODP(j) ((const float*)(p.ws + OFF_MODS) + (size_t)l * 9 * 6144 + (j) * 1024)
#ifndef PROBE_Q
#define PROBE_Q -1
#endif
#pragma nounroll
  for (int ph = 0; ph < 22; ++ph) {
    const int l = ph >= 11 ? 1 : 0, q = ph - l * 11;
    Params p = pk;
    {
      asm volatile("" ::: "memory");
      unsigned long long w_ = g_base_sh[0], o_ = g_base_sh[1];
      unsigned wl_ = (unsigned)w_, wh_ = (unsigned)(w_ >> 32), ol_ = (unsigned)o_, oh_ = (unsigned)(o_ >> 32);
      wl_ = __builtin_amdgcn_readfirstlane(wl_); wh_ = __builtin_amdgcn_readfirstlane(wh_); ol_ = __builtin_amdgcn_readfirstlane(ol_); oh_ = __builtin_amdgcn_readfirstlane(oh_);
      asm volatile("" : "+s"(wl_), "+s"(wh_), "+s"(ol_), "+s"(oh_));
      p.ws = (char*)(((unsigned long long)wh_ << 32) | wl_); p.out = (float*)(((unsigned long long)oh_ << 32) | ol_);
    }
#pragma nounroll
    for (int rep = 0; rep < (q == PROBE_Q ? 2 : 1); ++rep)
    switch (q) {
      case 0: phase_norm(XLP, XCP, TABP(0), (u16*)(p.ws + OFF_HB1), NT); break;
      case 1: phase_zgemm(p, l, smem); break;
      case 2: phase_tokA(p, l); phase_tokB(p, l, smem); break;
      case 3: phase_qkv(p, l, smem); break;
      case 4: phase_scan(p, smem); phase_attn(p, l, smem); break;
      case 5: phase_norm(XLP, XCP, TABP(0), (u16*)(p.ws + OFF_HBG), MOUT); phase_readout(p, l, MOUT); break;
      case 6: phase_merge(p, l, MOUT, smem); break;
      case 7: phase_resid(p, (const u16*)(p.ws + OFF_R1), 1024, (const u16*)(WLP + WO_WO), MODP(2), XLP, XCP, p.out, CTXBUF, MOUT, smem); break;
      case 8: phase_norm(p.out, CTXBUF, TABP(1), (u16*)(p.ws + OFF_HB2), MOUT); break;
      case 9: phase_mlp1(p, l, MOUT, smem); break;
      default: phase_resid(p, (const u16*)(p.ws + OFF_R1), 4096, (const u16*)(WLP + WO_W2), MODP(5), p.out, CTXBUF, p.out, CTXBUF, MOUT, smem); break;
    }
    if (ph != 21) xcd_barrier();
  }
}

extern "C" void kernel_launch(void* const* d_in, const int* in_sizes, int n_in, void* d_out, int out_size, void* d_ws, size_t ws_size, hipStream_t stream) {
  static int grid_blocks = 0;
  if (!grid_blocks) {
    int dev = 0, cus = 0, per_cu = 0;
    hipGetDevice(&dev);
    hipDeviceGetAttribute(&cus, hipDeviceAttributeMultiprocessorCount, dev);
    hipOccupancyMaxActiveBlocksPerMultiprocessor(&per_cu, fwd_megakernel, 256, 0);
    if (per_cu > 2) per_cu = 2;
    if (per_cu < 1) per_cu = 1;
    grid_blocks = cus * per_cu;
    if (ws_size < WS_END) fprintf(stderr, "kernel_launch: workspace too small: %zu < %zu\n", ws_size, (size_t)WS_END);
  }
  Params p{};
  for (int i = 0; i < 34; ++i) p.in[i] = (const float*)d_in[i];
  p.out = (float*)d_out;
  p.ws = (char*)d_ws;
  hipMemsetAsync(d_ws, 0, 16384, stream);
  void* args[] = {&p};
  hipError_t e = hipLaunchCooperativeKernel((void*)fwd_megakernel, dim3(grid_blocks), dim3(256), args, 0, stream);
  if (e != hipSuccess) fprintf(stderr, "cooperative launch failed: %s (grid %d)\n", hipGetErrorString(e), grid_blocks);
}
```

```cpp
#include <hip/hip_runtime.h>
#include <hip/hip_cooperative_groups.h>
#include <stdint.h>
#include <cstdio>
namespace cg = cooperative_groups;

typedef unsigned short u16;
typedef __attribute__((ext_vector_type(8))) short bf16x8;
typedef __attribute__((ext_vector_type(4))) float f32x4;
typedef __attribute__((ext_vector_type(16))) float f32x16;
typedef __bf16 bf16x2_t __attribute__((ext_vector_type(2)));
typedef float float2_t __attribute__((ext_vector_type(2)));

#define DI __device__ __forceinline__

constexpr int D = 1024, NB = 8, L = 4096, LC = 256, LK = 4352;
constexpr int NTL = NB * L;
constexpr int NTC = NB * LC;
constexpr int NT = NTL + NTC;
constexpr int INC = 5152;
constexpr int ZA = 928;
constexpr int ZR = 1152;
constexpr int DFF = 4096;

constexpr size_t al256(size_t x) { return (x + 255) / 256 * 256; }
constexpr size_t OFF_BAR = 0;
constexpr size_t OFF_MODS = 16384;
constexpr size_t OFF_TAB = OFF_MODS + al256(2 * 9 * 6144 * 4);
constexpr size_t OFF_ROPE = OFF_TAB + al256(2 * 2 * 9 * 2 * 1024 * 4);
constexpr size_t OFF_RS1 = OFF_ROPE + 4096;
constexpr size_t OFF_RS2 = OFF_RS1 + al256(NT * 4);
constexpr size_t OFF_RSQ = OFF_RS2 + al256(NT * 4);
constexpr size_t OFF_RSKV = OFF_RSQ + al256(NT * 4);
constexpr size_t OFF_CTX = OFF_RSKV + al256(NT * 4);
constexpr size_t OFF_W = OFF_CTX + (size_t)NTC * D * 4;
constexpr size_t WO_WIN = 0;
constexpr size_t WO_UQ = WO_WIN + (size_t)INC * 1024 * 2;
constexpr size_t WO_UKV = WO_UQ + (size_t)768 * 384 * 2;
constexpr size_t WO_BRP = WO_UKV + (size_t)1024 * 256 * 2;
constexpr size_t WO_BRM = WO_BRP + (size_t)1024 * 256 * 2;
constexpr size_t WO_BRR = WO_BRM + (size_t)1024 * 512 * 2;
constexpr size_t WO_WO = WO_BRR + (size_t)1024 * 256 * 2;
constexpr size_t WO_W1 = WO_WO + (size_t)1024 * 1024 * 2;
constexpr size_t WO_W2 = WO_W1 + (size_t)4096 * 1024 * 2;
constexpr size_t WO_RW2 = WO_W2 + (size_t)1024 * 4096 * 2;
constexpr size_t WO_RA2 = WO_RW2 + (size_t)2 * 256 * 64 * 2;
constexpr size_t WO_RG2 = WO_RA2 + (size_t)2 * 256 * 64 * 2;
constexpr size_t W_LAYER = al256(WO_RG2 + (size_t)256 * 128 * 2);
constexpr size_t OFF_R1 = OFF_W + 2 * W_LAYER;
constexpr size_t SZ_Q = (size_t)NB * 8 * LK * 96 * 2;
constexpr size_t SZ_VT = (size_t)NB * 8 * 64 * LK * 2;
constexpr size_t SZ_R1 = 2 * SZ_Q + SZ_VT;
constexpr size_t OFF_R2 = OFF_R1 + al256(SZ_R1);
constexpr size_t SZ_TOK256 = (size_t)NT * 256 * 2;
constexpr size_t OFF_R3 = OFF_R2 + al256((size_t)NT * ZA * 2);
constexpr size_t OFF_R4 = OFF_R3 + 10 * SZ_TOK256;
constexpr size_t OFF_KR = OFF_R4 + SZ_TOK256;
constexpr size_t OFF_OMLA = OFF_KR + al256((size_t)NT * 32 * 2);
constexpr size_t WS_END = OFF_OMLA + (size_t)NT * 512 * 2;
static_assert(WS_END <= 536870912ull, "workspace map exceeds 4x the largest tensor");
constexpr size_t OFF_HB1 = OFF_R3;
constexpr size_t OFF_HBG = OFF_R1 + (size_t)NT * 1024 * 2;
constexpr size_t OFF_HB2 = OFF_R3 + 5 * SZ_TOK256;
enum { SA_R = 0, SA_V = 1, SA_KDF = 2, SA_KDB = 3, SA_G = 4, SA_KKN = 5, SA_OMWF = 6, SA_BF = 7, SA_OMWB = 8, SA_BB = 9 };

struct Params { const float* in[34]; float* out; char* ws; };

enum { I_X = 0, I_C, I_CTX, I_CCTX, I_N1G, I_N2G, I_WADA, I_BADA, I_WIN, I_POOLW, I_POOLS, I_QNORM, I_WUQ, I_KVNORM, I_WUKV,
       I_GQ, I_GK, I_MU, I_W0, I_W2R, I_A0, I_A2R, I_KA, I_KK, I_RK, I_G2R, I_LNW, I_LNB, I_BRP, I_BRM, I_BRR, I_WO, I_W1, I_W2 };

DI float bf2f(u16 h) { return __uint_as_float(((unsigned)h) << 16); }
DI float bflo(unsigned u) { return __uint_as_float(u << 16); }
DI float bfhi(unsigned u) { return __uint_as_float(u & 0xffff0000u); }
DI unsigned pack2(float a, float b) { float2_t v = {a, b}; bf16x2_t r = __builtin_convertvector(v, bf16x2_t); return __builtin_bit_cast(unsigned, r); }
DI u16 f2bf(float a) { return (u16)(pack2(a, 0.f) & 0xffffu); }
DI float sigmoidf_(float x) { return 1.f / (1.f + __expf(-x)); }
DI float siluf_(float x) { return x / (1.f + __expf(-x)); }
DI float rowsum16(float x) {
  x += __builtin_bit_cast(float, __builtin_amdgcn_update_dpp(0, __builtin_bit_cast(int, x), 0x128, 0xf, 0xf, false));
  x += __builtin_bit_cast(float, __builtin_amdgcn_update_dpp(0, __builtin_bit_cast(int, x), 0x124, 0xf, 0xf, false));
  x += __builtin_bit_cast(float, __builtin_amdgcn_update_dpp(0, __builtin_bit_cast(int, x), 0x122, 0xf, 0xf, false));
  x += __builtin_bit_cast(float, __builtin_amdgcn_update_dpp(0, __builtin_bit_cast(int, x), 0x121, 0xf, 0xf, false));
  return x;
}
DI float wavesum(float x) {
  x = rowsum16(x);
  const int xi = __builtin_bit_cast(int, x);
  return __builtin_bit_cast(float, __builtin_amdgcn_readlane(xi, 0)) + __builtin_bit_cast(float, __builtin_amdgcn_readlane(xi, 16)) +
         __builtin_bit_cast(float, __builtin_amdgcn_readlane(xi, 32)) + __builtin_bit_cast(float, __builtin_amdgcn_readlane(xi, 48));
}
DI void grid_barrier(unsigned* ctr, unsigned& epoch) {
  asm volatile("s_waitcnt vmcnt(0)" ::: "memory");
  __syncthreads();
  epoch++;
  if (threadIdx.x == 0) {
    __builtin_amdgcn_fence(__ATOMIC_RELEASE, "agent");
    asm volatile("s_waitcnt vmcnt(0)" ::: "memory");
    const unsigned target = epoch * gridDim.x;
    __hip_atomic_fetch_add(ctr, 1u, __ATOMIC_RELAXED, __HIP_MEMORY_SCOPE_AGENT);
    while (__hip_atomic_load(ctr, __ATOMIC_RELAXED, __HIP_MEMORY_SCOPE_AGENT) < target) __builtin_amdgcn_s_sleep(2);
    __builtin_amdgcn_fence(__ATOMIC_ACQUIRE, "agent");
    asm volatile("s_waitcnt vmcnt(0)" ::: "memory");
  }
  __syncthreads();
}


#define XB_TMO      128
#define XB_XCNT(j)  (256  + 64 * (j))
#define XB_XSUB(j)  (1280 + 64 * (j))
#define XB_XGEN(j)  (2304 + 64 * (j))
#define XB_TOP      3328
#define XB_TOPGEN   3392
#define XB_SPIN_CAP (1u << 22)
#define LAS __attribute__((address_space(3)))
DI unsigned xb_ld(unsigned* p)              { return __hip_atomic_load(p, __ATOMIC_RELAXED, __HIP_MEMORY_SCOPE_AGENT); }
DI unsigned xb_add(unsigned* p, unsigned v) { return __hip_atomic_fetch_add(p, v, __ATOMIC_RELAXED, __HIP_MEMORY_SCOPE_AGENT); }
DI unsigned xb_xcc_id() { return (unsigned)__builtin_amdgcn_s_getreg((3 << 11) | 20) & 0xFu; }
#define XB_SPIN(cond, bar) do { unsigned _sp = 0; while (cond) { __builtin_amdgcn_s_sleep(1); \
    if ((++_sp & 255u) == 0u) { if (xb_ld(&(bar)[XB_TMO])) break; if (_sp > XB_SPIN_CAP) { atomicAdd(&(bar)[XB_TMO], 1u); break; } } } } while (0)
__shared__ uint4 g_xb_words;
__shared__ unsigned long long g_base_sh[2];
DI void xcd_barrier_post(unsigned* bar) {
  const unsigned x = xb_xcc_id();
  if (threadIdx.x == 0) { g_xb_words = make_uint4(0u, 0u, x, 0u); (void)xb_add(&bar[XB_XCNT(x)], 1u); }
}
DI void xcd_barrier_complete(unsigned* bar, unsigned x, unsigned& nloc, unsigned& nx) {
  const unsigned G = gridDim.x;
  unsigned sum, cnt, mine, sp = 0u;
  for (;;) {
    sum = 0u; cnt = 0u; mine = 0u;
#pragma unroll
    for (unsigned j = 0; j < 16; ++j) { const unsigned c = xb_ld(&bar[XB_XCNT(j)]); sum += c; cnt += (c > 0u) ? 1u : 0u; mine = (j == x) ? c : mine; }
    if (sum == G) break;
    __builtin_amdgcn_s_sleep(1);
    if ((++sp & 255u) == 0u) { if (xb_ld(&bar[XB_TMO])) break; if (sp > XB_SPIN_CAP) { atomicAdd(&bar[XB_TMO], 1u); break; } }
  }
  nloc = mine > 0u ? mine : 1u; nx = cnt > 0u ? cnt : 1u;
}
DI void xcd_barrier() {
  asm volatile("s_waitcnt vmcnt(0)" ::: "memory");
  __syncthreads();
  if (threadIdx.x == 0) {
    unsigned* bar = (unsigned*)(g_base_sh[0] + OFF_BAR);
    __builtin_amdgcn_s_waitcnt(0);
    unsigned nloc = g_xb_words.x, nx = g_xb_words.y; const unsigned x = g_xb_words.z;
    if (nloc == 0u) { xcd_barrier_complete(bar, x, nloc, nx); g_xb_words.x = nloc; g_xb_words.y = nx; }
    const unsigned old = xb_add(&bar[XB_XSUB(x)], 1u);
    const unsigned gen = old / nloc;
    if (old + 1u == (gen + 1u) * nloc) {
      __builtin_amdgcn_fence(__ATOMIC_RELEASE, "agent");
      asm volatile("s_waitcnt vmcnt(0)" ::: "memory");
      const unsigned og = xb_add(&bar[XB_TOP], 1u);
      const unsigned tg = og / nx;
      if (og + 1u == (tg + 1u) * nx) xb_add(&bar[XB_TOPGEN], 1u);
      else XB_SPIN(xb_ld(&bar[XB_TOPGEN]) == tg, bar);
      __builtin_amdgcn_fence(__ATOMIC_ACQUIRE, "agent");
      xb_add(&bar[XB_XGEN(x)], 1u);
      asm volatile("s_waitcnt vmcnt(0)" ::: "memory");
    } else {
      XB_SPIN(xb_ld(&bar[XB_XGEN(x)]) == gen, bar);
      __builtin_amdgcn_fence(__ATOMIC_ACQUIRE, "agent");
      asm volatile("s_waitcnt vmcnt(0)" ::: "memory");
    }
  }
  __syncthreads();
}
DI int launder_v(int x) { asm volatile("" : "+v"(x)); return x; }
DI int launder_s(int x) { asm volatile("" : "+s"(x)); return x; }
#define LAUNDER_IDS const int tid__ = launder_v((int)threadIdx.x); const int blk__ = launder_s((int)blockIdx.x); (void)tid__; (void)blk__;
DI void do_transpose(const float* __restrict__ src, int K, int N, u16* __restrict__ dst, const float* __restrict__ ksc, int perm, int tile, float* tl) {
  LAUNDER_IDS
  const int ntn = (N + 63) >> 6;
  const int kt = tile / ntn, nt = tile - kt * ntn;
  const int k0 = kt * 64, n0 = nt * 64;
  const int tid = tid__;
  __syncthreads();
#pragma unroll 4
  for (int i = 0; i < 16; ++i) {
    const int kk = i * 4 + (tid >> 6), nn = tid & 63;
    float v = 0.f;
    if (n0 + nn < N) v = src[(size_t)(k0 + kk) * N + n0 + nn];
    if (ksc) v *= ksc[k0 + kk];
    tl[kk * 65 + nn] = v;
  }
  __syncthreads();
#pragma unroll 4
  for (int i = 0; i < 16; ++i) {
    const int nn = i * 4 + (tid >> 6), kk = tid & 63;
    int n = n0 + nn;
    if (n < N) {
      if (perm) { const int h = n / 96, d = n - h * 96; n = d < 64 ? h * 64 + d : 512 + h * 32 + (d - 64); }
      dst[(size_t)n * K + k0 + kk] = f2bf(tl[kk * 65 + nn]);
    }
  }
}

DI void phase_prep(const Params& p, char* smem) {
  LAUNDER_IDS
  float* tl = (float*)smem;
  const int tid = tid__;
  constexpr int T_WIN = 16 * 81, T_UQ = 6 * 12, T_UKV = 4 * 16, T_BRM = 8 * 16, T_BRR = 4 * 16, T_WO = 16 * 16, T_W1 = 16 * 64, T_W2 = 64 * 16,
                T_RW2 = 4, T_RA2 = 4, T_RG2 = 2 * 4;
  constexpr int T_LAYER = T_WIN + T_UQ + T_UKV + T_BRM + T_BRR + T_WO + T_W1 + T_W2 + 2 * T_RW2 + 2 * T_RA2 + T_RG2;
  for (int g = blk__; g < 2 * T_LAYER; g += gridDim.x) {
    const int l = g / T_LAYER; int t = g - l * T_LAYER;
    char* wl = p.ws + OFF_W + (size_t)l * W_LAYER;
#define JOB(SRC, KK, NN, DSTOFF, SC, PERM, CNT) if (t < (CNT)) { do_transpose((SRC), (KK), (NN), (u16*)(wl + (DSTOFF)), (SC), (PERM), t, tl); continue; } t -= (CNT);
    JOB(p.in[I_WIN] + (size_t)l * 1024 * INC, 1024, INC, WO_WIN, nullptr, 0, T_WIN)
    JOB(p.in[I_WUQ] + (size_t)l * 384 * 768, 384, 768, WO_UQ, p.in[I_QNORM] + l * 384, 1, T_UQ)
    JOB(p.in[I_WUKV] + (size_t)l * 256 * 1024, 256, 1024, WO_UKV, p.in[I_KVNORM] + l * 256, 0, T_UKV)
    JOB(p.in[I_BRM] + (size_t)l * 512 * 1024, 512, 1024, WO_BRM, nullptr, 0, T_BRM)
    JOB(p.in[I_BRR] + (size_t)l * 256 * 1024, 256, 1024, WO_BRR, nullptr, 0, T_BRR)
    JOB(p.in[I_WO] + (size_t)l * 1024 * 1024, 1024, 1024, WO_WO, nullptr, 0, T_WO)
    JOB(p.in[I_W1] + (size_t)l * 1024 * 4096, 1024, 4096, WO_W1, nullptr, 0, T_W1)
    JOB(p.in[I_W2] + (size_t)l * 4096 * 1024, 4096, 1024, WO_W2, nullptr, 0, T_W2)
    JOB(p.in[I_W2R] + (size_t)(l * 2 + 0) * 64 * 256, 64, 256, WO_RW2, nullptr, 0, T_RW2)
    JOB(p.in[I_W2R] + (size_t)(l * 2 + 1) * 64 * 256, 64, 256, WO_RW2 + 256 * 64 * 2, nullptr, 0, T_RW2)
    JOB(p.in[I_A2R] + (size_t)(l * 2 + 0) * 64 * 256, 64, 256, WO_RA2, nullptr, 0, T_RA2)
    JOB(p.in[I_A2R] + (size_t)(l * 2 + 1) * 64 * 256, 64, 256, WO_RA2 + 256 * 64 * 2, nullptr, 0, T_RA2)
    JOB(p.in[I_G2R] + (size_t)l * 128 * 256, 128, 256, WO_RG2, nullptr, 0, T_RG2)
#undef JOB
  }
  for (int e = blk__ * 256 + tid; e < 2 * 256 * 1024; e += gridDim.x * 256) {
    const int l = e >> 18, r = e & 262143, cin = r >> 10, n = r & 1023, g = cin >> 6, c = cin & 63;
    const float* pw = p.in[I_POOLW] + ((size_t)(l * 4 + g) * 64 + c) * 64;
    const float* ps = p.in[I_POOLS] + l * 256 + g * 64;
    const float* wb = p.in[I_BRP] + ((size_t)l * 256 + g * 64) * 1024 + n;
    float s = 0.f;
    for (int d = 0; d < 64; ++d) s += pw[d] * ps[d] * wb[(size_t)d * 1024];
    ((u16*)(p.ws + OFF_W + (size_t)l * W_LAYER + WO_BRP))[(size_t)n * 256 + cin] = f2bf(s);
  }
  if (blk__ == gridDim.x - 1) {
    for (int e = tid; e < 512; e += 256) {
      const int pos = e >> 3, f = e & 7;
      const float inv = powf(10000.f, -(float)f / 8.f);
      const float ang = (float)pos * inv;
      float* rt = (float*)(p.ws + OFF_ROPE);
      rt[e * 2] = cosf(ang); rt[e * 2 + 1] = sinf(ang);
    }
  }
  {
    float* sl = (float*)smem;
    float* red = sl + 9 * 1024;
    __syncthreads();
    for (int e = tid; e < 9 * 1024; e += 256) {
      const int b = e >> 10, k = e & 1023;
      const float v = b < 8 ? p.in[I_C][b * 1024 + k] : p.in[I_CCTX][k];
      sl[e] = siluf_(v);
    }
    __syncthreads();
    const int wave = tid >> 6, lane = tid & 63;
    for (int it = blk__; it < 192; it += gridDim.x) {
      const int l = it / 96, cg_ = it - l * 96;
      const int col = cg_ * 64 + lane;
      const float* wa = p.in[I_WADA] + (size_t)l * 1024 * 6144 + col;
      float acc[9];
#pragma unroll
      for (int b = 0; b < 9; ++b) acc[b] = 0.f;
#pragma unroll 8
      for (int k = wave * 256; k < wave * 256 + 256; ++k) {
        const float w = wa[(size_t)k * 6144];
#pragma unroll
        for (int b = 0; b < 9; ++b) acc[b] += sl[b * 1024 + k] * w;
      }
#pragma unroll
      for (int b = 0; b < 9; ++b) red[(wave * 9 + b) * 64 + lane] = acc[b];
      __syncthreads();
      for (int e = tid; e < 9 * 64; e += 256) {
        const int b = e >> 6, c = e & 63;
        const float s = red[(0 * 9 + b) * 64 + c] + red[(1 * 9 + b) * 64 + c] + red[(2 * 9 + b) * 64 + c] + red[(3 * 9 + b) * 64 + c];
        ((float*)(p.ws + OFF_MODS))[(size_t)(l * 9 + b) * 6144 + cg_ * 64 + c] = s + p.in[I_BADA][l * 6144 + cg_ * 64 + c];
      }
      __syncthreads();
    }
  }
}

DI const float* xrow(const float* xl, const float* xc, int r) { return r < NTL ? xl + (size_t)r * D : xc + (size_t)(r - NTL) * D; }

DI void phase_norm(const float* xl, const float* xc, const float* tab  , u16* hb, int M) {
  LAUNDER_IDS
  const int wave = tid__ >> 6, lane = tid__ & 63;
  for (int r = blk__ * 4 + wave; r < M; r += gridDim.x * 4) {
    const float* xp = xrow(xl, xc, r);
    const int b9 = r < NTL ? r >> 12 : 8;
    float4 v[4];
    float s = 0.f;
#pragma unroll
    for (int i = 0; i < 4; ++i) { v[i] = *(const float4*)(xp + i * 256 + lane * 4); s += v[i].x * v[i].x + v[i].y * v[i].y + v[i].z * v[i].z + v[i].w * v[i].w; }
    s = wavesum(s);
    const float rs = rsqrtf(s * (1.f / 1024.f) + 1e-6f);
    const float* t = tab + b9 * 2048;
#pragma unroll
    for (int i = 0; i < 4; ++i) {
      const int k = i * 256 + lane * 4;
      const float4 g = *(const float4*)(t + k), sh = *(const float4*)(t + 1024 + k);
      *(uint2*)(hb + (size_t)r * 1024 + k) = make_uint2(pack2(v[i].x * rs * g.x + sh.x, v[i].y * rs * g.y + sh.y), pack2(v[i].z * rs * g.z + sh.z, v[i].w * rs * g.w + sh.w));
    }
  }
}
DI void phase_tables(const Params& p) {
  LAUNDER_IDS
  const float* mods = (const float*)(p.ws + OFF_MODS);
  float* tab = (float*)(p.ws + OFF_TAB);
  for (int e = blk__ * 256 + tid__; e < 2 * 2 * 9 * 1024; e += gridDim.x * 256) {
    const int k = e & 1023, b9 = (e >> 10) % 9, ln = (e >> 10) / 9, l = ln >> 1, nrm = ln & 1;
    const float g = p.in[nrm ? I_N2G : I_N1G][l * 1024 + k];
    const float sh = mods[(size_t)(l * 9 + b9) * 6144 + (nrm * 3 + 0) * 1024 + k];
    const float sc = mods[(size_t)(l * 9 + b9) * 6144 + (nrm * 3 + 1) * 1024 + k];
    float* t = tab + ((size_t)(l * 2 + nrm) * 9 + b9) * 2048;
    t[k] = g * (1.f + sc); t[1024 + k] = sh;
  }
}

struct LoadBf16 {
  const u16* A; int lda;
  DI void init(int m0) {}
  DI uint4 load(int i, int m0, int k0) const {
    LAUNDER_IDS
    const int tid = tid__, kc = (tid & 7) * 8;
    return *(const uint4*)(A + (size_t)(m0 + (tid >> 3) + i * 32) * lda + k0 + kc);
  }
};
struct LoadNorm {
  const float* xl; const float* xc; const float* rs; const float* tab;
  float r0, r1, r2, r3;
  DI void init(int m0) {
    LAUNDER_IDS
    const int tid = tid__;
    r0 = rs[m0 + (tid >> 3)]; r1 = rs[m0 + (tid >> 3) + 32]; r2 = rs[m0 + (tid >> 3) + 64]; r3 = rs[m0 + (tid >> 3) + 96];
  }
  DI uint4 load(int i, int m0, int k0) const {
    LAUNDER_IDS
    const int tid = tid__, kc = (tid & 7) * 8;
    const int b9 = m0 < NTL ? m0 >> 12 : 8;
    const float* t = tab + b9 * 2048 + k0 + kc;
    const float4 g0 = *(const float4*)t, g1 = *(const float4*)(t + 4), s0 = *(const float4*)(t + 1024), s1 = *(const float4*)(t + 1028);
    const float* xp = xrow(xl, xc, m0 + (tid >> 3)) + k0 + kc + (size_t)i * 32 * D;
    const float4 x0 = *(const float4*)xp, x1 = *(const float4*)(xp + 4);
    const float rr = i == 0 ? r0 : i == 1 ? r1 : i == 2 ? r2 : r3;
    uint4 o;
    o.x = pack2(x0.x * rr * g0.x + s0.x, x0.y * rr * g0.y + s0.y);
    o.y = pack2(x0.z * rr * g0.z + s0.z, x0.w * rr * g0.w + s0.w);
    o.z = pack2(x1.x * rr * g1.x + s1.x, x1.y * rr * g1.y + s1.y);
    o.w = pack2(x1.z * rr * g1.z + s1.z, x1.w * rr * g1.w + s1.w);
    return o;
  }
};

DI bool tile_map(int it, int NTM, int NTN, int blk, int nblk, int& tm, int& tn) {
  const int xcd = blk & 7, local = blk >> 3, LB = nblk >> 3;
  const int R = NTM >> 3;
  const int s = it * LB + local;
  if (s >= R * NTN) return false;
  const int F = R >> 3, per_full = 8 * NTN;
  int mg, r, gm;
  if (s < F * per_full) { mg = s / per_full; r = s - mg * per_full; gm = 8; }
  else { mg = F; r = s - F * per_full; gm = R - F * 8; }
  const int ng = r / (gm * 8);
  const int r2 = r - ng * gm * 8;
  const int mi = r2 % gm, ni = r2 / gm;
  tm = xcd * R + mg * 8 + mi; tn = ng * 8 + ni;
  return true;
}
constexpr int LDT = 72;
template <int NI, class LA>
DI void gemm_mainloop(f32x4 (&acc)[4][NI], LA la, const u16* __restrict__ Bt, int ldb, int K, int m0, int n0, char* smem) {
  LAUNDER_IDS
  constexpr int NBI = NI;
  u16* As = (u16*)smem; u16* Bs = As + 2 * 128 * LDT;
  const int tid = tid__, lane = tid & 63, wave = tid >> 6, wr = wave >> 1, wc = wave & 1, lr = lane & 15, lq = lane >> 4;
  uint4 ra[4], rb[NBI];
  la.init(m0);
#pragma unroll
  for (int i = 0; i < 4; ++i) ra[i] = la.load(i, m0, 0);
#pragma unroll
  for (int i = 0; i < NBI; ++i) {
    const int c = tid + i * 256, row = c >> 3, kc = (c & 7) * 8;
    rb[i] = *(const uint4*)(Bt + (size_t)(n0 + row) * ldb + kc);
  }
#pragma unroll
  for (int i = 0; i < 4; ++i) {
    const int c = tid + i * 256, row = c >> 3, kc = (c & 7) * 8;
    *(uint4*)(As + row * LDT + kc) = ra[i];
    if (i < NBI) *(uint4*)(Bs + row * LDT + kc) = rb[i];
  }
  __syncthreads();
  const int nk = K >> 6;
  for (int kt = 0; kt < nk; ++kt) {
    const int cur = kt & 1;
    if (kt + 1 < nk) {
      const int k0 = (kt + 1) * 64;
#pragma unroll
      for (int i = 0; i < 4; ++i) ra[i] = la.load(i, m0, k0);
#pragma unroll
      for (int i = 0; i < NBI; ++i) {
        const int c = tid + i * 256, row = c >> 3, kc = (c & 7) * 8;
        rb[i] = *(const uint4*)(Bt + (size_t)(n0 + row) * ldb + k0 + kc);
      }
    }
    const u16* Ac = As + cur * 128 * LDT + (wr * 64 + lr) * LDT + lq * 8;
    const u16* Bc = Bs + cur * 128 * LDT + (wc * 16 * NI + lr) * LDT + lq * 8;
#pragma unroll
    for (int ks = 0; ks < 2; ++ks) {
      bf16x8 af[4], bfr[NI];
#pragma unroll
      for (int mi = 0; mi < 4; ++mi) af[mi] = *(const bf16x8*)(Ac + mi * 16 * LDT + ks * 32);
#pragma unroll
      for (int ni = 0; ni < NI; ++ni) bfr[ni] = *(const bf16x8*)(Bc + ni * 16 * LDT + ks * 32);
#pragma unroll
      for (int mi = 0; mi < 4; ++mi)
#pragma unroll
        for (int ni = 0; ni < NI; ++ni)
          acc[mi][ni] = __builtin_amdgcn_mfma_f32_16x16x32_bf16(bfr[ni], af[mi], acc[mi][ni], 0, 0, 0);
    }
    if (kt + 1 < nk) {
      const int nxt = cur ^ 1;
#pragma unroll
      for (int i = 0; i < 4; ++i) {
        const int c = tid + i * 256, row = c >> 3, kc = (c & 7) * 8;
        *(uint4*)(As + nxt * 128 * LDT + row * LDT + kc) = ra[i];
        if (i < NBI) *(uint4*)(Bs + nxt * 128 * LDT + row * LDT + kc) = rb[i];
      }
    }
    __syncthreads();
  }
}
template <int NI>
DI void zero_acc(f32x4 (&acc)[4][NI]) {
#pragma unroll
  for (int i = 0; i < 4; ++i)
#pragma unroll
    for (int j = 0; j < NI; ++j) acc[i][j] = f32x4{0.f, 0.f, 0.f, 0.f};
}
template <int MI, int NI>
DI void gemm256(f32x4 (&acc)[MI][NI], const u16* __restrict__ A, int lda, const u16* __restrict__ Bt, int ldb, int K, int m0, int n0, char* smem) {
  LAUNDER_IDS
  const int lane = tid__ & 63, wave = tid__ >> 6, wr = wave >> 1, wc = wave & 1, lr = lane & 15, lq = lane >> 4;
  constexpr int NAW = MI / 2;
  constexpr int NBW = NI / 2;
  constexpr int ABYTES = MI * 2 * 1024;
  constexpr int STAGE = ABYTES + NI * 2 * 1024;
  constexpr int LPS = NAW + NBW;
  static_assert(3 * STAGE <= 73728, "ring does not fit");
  const int srow = lane >> 2, scol = ((lane & 3) ^ ((lane >> 5) << 1)) * 8;
  const u16* Ag = A + (size_t)(m0 + wave * NAW * 16 + srow) * lda + scol;
  const u16* Bg = Bt + (size_t)(n0 + wave * NBW * 16 + srow) * ldb + scol;
  char* la = smem + (wave * NAW) * 1024 + lane * 16;
  char* lb = smem + ABYTES + (wave * NBW) * 1024 + lane * 16;
#define G256_ISSUE(S, K0) do { \
    _Pragma("unroll") for (int j_ = 0; j_ < NAW; ++j_) \
      __builtin_amdgcn_global_load_lds((const unsigned*)(Ag + (size_t)j_ * 16 * lda + (K0)), (__attribute__((address_space(3))) unsigned*)(la + (S) * STAGE + j_ * 1024), 16, 0, 0); \
    _Pragma("unroll") for (int j_ = 0; j_ < NBW; ++j_) \
      __builtin_amdgcn_global_load_lds((const unsigned*)(Bg + (size_t)j_ * 16 * ldb + (K0)), (__attribute__((address_space(3))) unsigned*)(lb + (S) * STAGE + j_ * 1024), 16, 0, 0); \
  } while (0)
  const int nk = K >> 5;
  G256_ISSUE(0, 0);
  if (nk > 1) G256_ISSUE(1, 32);
  const int foff = lr * 64 + ((lq ^ ((lr >> 3) << 1)) * 16);
  int st = 0;
  for (int kt = 0; kt < nk; ++kt) {
    if (kt + 1 < nk) asm volatile("s_waitcnt vmcnt(%0) lgkmcnt(0)" :: "n"(LPS) : "memory");
    else asm volatile("s_waitcnt vmcnt(0) lgkmcnt(0)" ::: "memory");
    __builtin_amdgcn_s_barrier();
    if (kt + 2 < nk) { const int s2 = st >= 1 ? st - 1 : 2; G256_ISSUE(s2, (kt + 2) * 32); }
    const char* sb = smem + st * STAGE + foff;
    bf16x8 af[MI], bfr[NI];
#pragma unroll
    for (int mi = 0; mi < MI; ++mi) af[mi] = *(const bf16x8*)(sb + (wr * MI + mi) * 1024);
#pragma unroll
    for (int ni = 0; ni < NI; ++ni) bfr[ni] = *(const bf16x8*)(sb + ABYTES + (wc * NI + ni) * 1024);
#pragma unroll
    for (int mi = 0; mi < MI; ++mi)
#pragma unroll
      for (int ni = 0; ni < NI; ++ni)
        acc[mi][ni] = __builtin_amdgcn_mfma_f32_16x16x32_bf16(bfr[ni], af[mi], acc[mi][ni], 0, 0, 0);
    st = st == 2 ? 0 : st + 1;
  }
  asm volatile("s_waitcnt lgkmcnt(0)" ::: "memory");
  __builtin_amdgcn_s_barrier();
#undef G256_ISSUE
}
template <int MI, int NI>
DI void zero_accm(f32x4 (&acc)[MI][NI]) {
#pragma unroll
  for (int i = 0; i < MI; ++i)
#pragma unroll
    for (int j = 0; j < NI; ++j) acc[i][j] = f32x4{0.f, 0.f, 0.f, 0.f};
}
#define EPI_BEGIN const int lr1_ = launder_v(lr), lq1_ = launder_v(lq), wr1_ = launder_v(wr), wc1_ = launder_v(wc); { const int lr = lr1_, lq = lq1_, wr = wr1_, wc = wc1_; (void)lr; (void)lq; (void)wr; (void)wc;
#define EPI_END }
#define WAVE_COORDS const int lane = tid__ & 63, wave = tid__ >> 6, wr = wave >> 1, wc = wave & 1, lr = lane & 15, lq = lane >> 4; (void)wr; (void)wc; (void)lr; (void)lq;

DI void phase_zgemm(const Params& p, int l, char* smem) {
  LAUNDER_IDS
  WAVE_COORDS
  const u16* Wt = (const u16*)(p.ws + OFF_W + (size_t)l * W_LAYER + WO_WIN);
  const u16* hb = (const u16*)(p.ws + OFF_HB1);
  u16* za = (u16*)(p.ws + OFF_R2); u16* zr = (u16*)(p.ws + OFF_R1);
  for (int it = 0;; ++it) {
    int tm, tn;
    if (!tile_map(it, NT / 256, 17, blk__, gridDim.x, tm, tn)) break;
    const int m0 = tm * 256, n0 = tn * 128;
    f32x4 acc[8][4]; zero_accm<8, 4>(acc);
    gemm256<8, 4>(acc, hb, 1024, Wt, 1024, 1024, m0, n0, smem);
    EPI_BEGIN
#pragma unroll
    for (int mi = 0; mi < 8; ++mi) {
      const int m = m0 + wr * 128 + mi * 16 + lr;
#pragma unroll
      for (int ni = 0; ni < 4; ++ni) {
        const int n = n0 + wc * 64 + ni * 16 + lq * 4;
        uint2 v; v.x = pack2(acc[mi][ni][0], acc[mi][ni][1]); v.y = pack2(acc[mi][ni][2], acc[mi][ni][3]);
        if (n < ZA) *(uint2*)(za + (size_t)m * ZA + n) = v;
        else if (n < ZA + ZR) *(uint2*)(zr + (size_t)m * ZR + (n - ZA)) = v;
      }
    }
    EPI_END
  }
}

DI void phase_tokA(const Params& p, int l) {
  LAUNDER_IDS
  const int wave = tid__ >> 6, lane = tid__ & 63;
  const u16* za = (const u16*)(p.ws + OFF_R2);
  float* rsq = (float*)(p.ws + OFF_RSQ); float* rskv = (float*)(p.ws + OFF_RSKV);
  u16* krb = (u16*)(p.ws + OFF_KR);
  u16* pooled = (u16*)(p.ws + OFF_R4);
  const float* rt = (const float*)(p.ws + OFF_ROPE);
  const float* gk = p.in[I_GK] + l * 96;
  for (int r = blk__ * 4 + wave; r < NT; r += gridDim.x * 4) {
    const u16* z = za + (size_t)r * ZA;
    const bool lat = r < NTL;
    const int b = lat ? r >> 12 : (r - NTL) >> 8;
    const int t = lat ? r & 4095 : (r - NTL) & 255;
    const int Ls = lat ? L : LC;
    const int pos = lat ? t : 4096 + t;
    float sq = 0.f, skv = 0.f;
#pragma unroll
    for (int i = 0; i < 6; ++i) { const float v = bf2f(z[256 + i * 64 + lane]); sq += v * v; }
#pragma unroll
    for (int i = 0; i < 4; ++i) { const float v = bf2f(z[640 + i * 64 + lane]); skv += v * v; }
    sq = wavesum(sq); skv = wavesum(skv);
    if (lane == 0) { rsq[r] = rsqrtf(sq * (1.f / 384.f) + 1e-6f); rskv[r] = rsqrtf(skv * (1.f / 256.f) + 1e-6f); }
    {
      const int d = lane & 31;
      float kr = bf2f(z[896 + d]);
      float ss = rowsum16(kr * kr);
      { const int si = __builtin_bit_cast(int, ss);
        ss = __builtin_bit_cast(float, __builtin_amdgcn_readlane(si, 0)) + __builtin_bit_cast(float, __builtin_amdgcn_readlane(si, 16)); }
      kr = kr * rsqrtf(ss * (1.f / 32.f) + 1e-6f) * gk[64 + d];
      const float other = __shfl_xor(kr, 16, 64);
      float outv = kr;
      if (lat) {
        const int i = d & 15;
        const int pp = i < 8 ? (t >> 6) : (t & 63);
        const float cs = rt[(pp * 8 + (i & 7)) * 2], sn = rt[(pp * 8 + (i & 7)) * 2 + 1];
        outv = d < 16 ? kr * cs - other * sn : other * sn + kr * cs;
      }
      if (lane < 32) krb[(size_t)r * 32 + d] = f2bf(outv);
    }
#pragma unroll
    for (int gi = 0; gi < 4; ++gi) {
      const int half = 1 << gi;
      const int lo = max(t - half, 0), hi = min(t + half, Ls);
      const int ch = gi * 64 + lane;
      float s = 0.f;
#pragma unroll
      for (int j = 0; j < 2 * half; ++j) {
        const int q = t - half + j;
        const int qc = min(max(q, 0), Ls - 1);
        const float v = bf2f(z[(ptrdiff_t)(qc - t) * ZA + ch]);
        s += (q == qc) ? v : 0.f;
      }
      const float mean = s / (float)(hi - lo);
      pooled[(size_t)r * 256 + ch] = f2bf(mean - bf2f(z[ch]));
    }
  }
}

constexpr int ZSL = 1160, TAL = 392;
DI void phase_tokB(const Params& p, int l, char* smem) {
  LAUNDER_IDS
  WAVE_COORDS
  const int tid = tid__;
  u16* Zs = (u16*)smem;
  u16* TA = Zs + 18 * ZSL;
  float* PV = (float*)(TA + 16 * TAL);
  const u16* zr = (const u16*)(p.ws + OFF_R1);
  const char* wl = p.ws + OFF_W + (size_t)l * W_LAYER;
  u16* sc = (u16*)(p.ws + OFF_R3);
  __syncthreads();
  for (int e = tid; e < 2 * ZR + 7 * 256; e += 256) {
    float v;
    if (e < 2 * ZR) v = p.in[I_MU][(size_t)l * 2 * ZR + e];
    else { const int f = e - 2 * ZR, a = f >> 8, c = f & 255;
      v = a == 0 ? p.in[I_KK][l * 256 + c] : a < 3 ? p.in[I_W0][(size_t)(l * 2 + a - 1) * 256 + c] : a < 5 ? p.in[I_A0][(size_t)(l * 2 + a - 3) * 256 + c] : p.in[I_KA][(size_t)(l * 2 + a - 5) * 256 + c]; }
    PV[e] = v;
  }
  const float* mu0 = PV; const float* mu1 = PV + ZR; const float* kkw = PV + 2 * ZR;
  const float* w0p = kkw + 256; const float* a0p = w0p + 512; const float* kap = a0p + 512;
  for (int tile = blk__; tile < NT / 16; tile += gridDim.x) {
    const int r0 = tile * 16;
    const bool lat = r0 < NTL;
    const int t0 = lat ? r0 & 4095 : (r0 - NTL) & 255;
    const int Ls = lat ? L : LC;
    __syncthreads();
    {
      uint4 v[11];
#pragma unroll
      for (int i = 0; i < 11; ++i) {
        const int c = tid + i * 256;
        const int ri = c / 144, ch = c - ri * 144;
        const int tt = t0 - 1 + ri;
        const int cc = min(c, 18 * 144 - 1);
        const int rc = cc / 144, chc = cc - rc * 144;
        const int ttc = min(max(t0 - 1 + rc, 0), Ls - 1);
        const uint4 ld = *(const uint4*)(zr + (size_t)(r0 - t0 + ttc) * ZR + chc * 8);
        const bool ok = (c < 18 * 144) && (tt >= 0) && (tt < Ls);
        v[i] = ok ? ld : make_uint4(0, 0, 0, 0);
      }
#pragma unroll
      for (int i = 0; i < 11; ++i) {
        const int c = tid + i * 256;
        const int ri = c / 144, ch = c - ri * 144;
        if (c < 18 * 144) {
          *(uint2*)(Zs + ri * ZSL + ch * 8) = make_uint2(v[i].x, v[i].y);
          *(uint2*)(Zs + ri * ZSL + ch * 8 + 4) = make_uint2(v[i].z, v[i].w);
        }
      }
    }
    __syncthreads();
#pragma unroll 4
    for (int e = tid; e < 16 * 384; e += 256) {
      const int i = e / 384, c = e - i * 384, zc = 768 + c;
      const float z = bf2f(Zs[(i + 1) * ZSL + zc]), zp = bf2f(Zs[i * ZSL + zc]), zn = bf2f(Zs[(i + 2) * ZSL + zc]);
      float v = z + mu0[zc] * (zp - z) + mu1[zc] * (zn - z);
      if (c < 128) v = 1.f - 2.f / (1.f + __expf(2.f * v)); else if (c >= 256) v = sigmoidf_(v);
      TA[i * TAL + c] = f2bf(v);
    }
    __syncthreads();
    const int row = r0 + lr;
    auto shifted4 = [&](int zc, float (&out)[4]) {
      const uint2 c0 = *(const uint2*)(Zs + (lr + 1) * ZSL + zc), cp = *(const uint2*)(Zs + lr * ZSL + zc), cn = *(const uint2*)(Zs + (lr + 2) * ZSL + zc);
      const float4 m0 = *(const float4*)(mu0 + zc), m1 = *(const float4*)(mu1 + zc);
      float z, zp, zn;
      z = bflo(c0.x); zp = bflo(cp.x); zn = bflo(cn.x); out[0] = z + m0.x * (zp - z) + m1.x * (zn - z);
      z = bfhi(c0.x); zp = bfhi(cp.x); zn = bfhi(cn.x); out[1] = z + m0.y * (zp - z) + m1.y * (zn - z);
      z = bflo(c0.y); zp = bflo(cp.y); zn = bflo(cn.y); out[2] = z + m0.z * (zp - z) + m1.z * (zn - z);
      z = bfhi(c0.y); zp = bfhi(cp.y); zn = bfhi(cn.y); out[3] = z + m0.w * (zp - z) + m1.w * (zn - z);
    };
    auto product128 = [&](f32x4 (&ac)[4], const u16* W, int off) {
      bf16x8 aop[4][4];
#pragma unroll
      for (int ks = 0; ks < 4; ++ks)
#pragma unroll
        for (int ni = 0; ni < 4; ++ni) aop[ks][ni] = *(const bf16x8*)(W + (size_t)(wave * 64 + ni * 16 + lr) * 128 + ks * 32 + lq * 8);
#pragma unroll
      for (int ni = 0; ni < 4; ++ni) ac[ni] = f32x4{0.f, 0.f, 0.f, 0.f};
#pragma unroll
      for (int ks = 0; ks < 4; ++ks) {
        const bf16x8 bop = *(const bf16x8*)(TA + lr * TAL + off + ks * 32 + lq * 8);
#pragma unroll
        for (int ni = 0; ni < 4; ++ni) ac[ni] = __builtin_amdgcn_mfma_f32_16x16x32_bf16(aop[ks][ni], bop, ac[ni], 0, 0, 0);
      }
      __builtin_amdgcn_sched_barrier(0);
    };
    auto product64x2 = [&](f32x4 (&ac0)[4], f32x4 (&ac1)[4], const u16* W0, const u16* W1, int off0, int off1) {
      bf16x8 a0[2][4], a1[2][4];
#pragma unroll
      for (int ks = 0; ks < 2; ++ks)
#pragma unroll
        for (int ni = 0; ni < 4; ++ni) {
          a0[ks][ni] = *(const bf16x8*)(W0 + (size_t)(wave * 64 + ni * 16 + lr) * 64 + ks * 32 + lq * 8);
          a1[ks][ni] = *(const bf16x8*)(W1 + (size_t)(wave * 64 + ni * 16 + lr) * 64 + ks * 32 + lq * 8);
        }
#pragma unroll
      for (int ni = 0; ni < 4; ++ni) { ac0[ni] = f32x4{0.f, 0.f, 0.f, 0.f}; ac1[ni] = f32x4{0.f, 0.f, 0.f, 0.f}; }
#pragma unroll
      for (int ks = 0; ks < 2; ++ks) {
        const bf16x8 b0 = *(const bf16x8*)(TA + lr * TAL + off0 + ks * 32 + lq * 8);
        const bf16x8 b1 = *(const bf16x8*)(TA + lr * TAL + off1 + ks * 32 + lq * 8);
#pragma unroll
        for (int ni = 0; ni < 4; ++ni) {
          ac0[ni] = __builtin_amdgcn_mfma_f32_16x16x32_bf16(a0[ks][ni], b0, ac0[ni], 0, 0, 0);
          ac1[ni] = __builtin_amdgcn_mfma_f32_16x16x32_bf16(a1[ks][ni], b1, ac1[ni], 0, 0, 0);
        }
      }
      __builtin_amdgcn_sched_barrier(0);
    };
    float ss = 0.f;
#pragma unroll
    for (int ni = 0; ni < 4; ++ni) {
      const int ch = wave * 64 + ni * 16 + lq * 4;
      float kx[4]; shifted4(256 + ch, kx);
      const float4 kw = *(const float4*)(kkw + ch);
      const float a0 = kx[0] * kw.x, a1 = kx[1] * kw.y, a2 = kx[2] * kw.z, a3 = kx[3] * kw.w;
      ss += a0 * a0 + a1 * a1 + a2 * a2 + a3 * a3;
    }
    ss += __shfl_xor(ss, 16, 64); ss += __shfl_xor(ss, 32, 64);
    const float kinv = rsqrtf(fmaxf(ss, 1e-24f));
    {
      f32x4 ag[4];
      product128(ag, (const u16*)(wl + WO_RG2), 256);
#pragma unroll
      for (int ni = 0; ni < 4; ++ni) {
        const int ch = wave * 64 + ni * 16 + lq * 4;
        const size_t o = (size_t)row * 256 + ch;
        float rx[4], kx[4], vx[4];
        shifted4(ch, rx); shifted4(256 + ch, kx); shifted4(512 + ch, vx);
        const float4 kw = *(const float4*)(kkw + ch);
        *(uint2*)(sc + SA_R * (size_t)NT * 256 + o) = make_uint2(pack2(rx[0], rx[1]), pack2(rx[2], rx[3]));
        *(uint2*)(sc + SA_V * (size_t)NT * 256 + o) = make_uint2(pack2(vx[0], vx[1]), pack2(vx[2], vx[3]));
        *(uint2*)(sc + SA_KKN * (size_t)NT * 256 + o) = make_uint2(pack2(-kx[0] * kw.x * kinv, -kx[1] * kw.y * kinv), pack2(-kx[2] * kw.z * kinv, -kx[3] * kw.w * kinv));
        *(uint2*)(sc + SA_G * (size_t)NT * 256 + o) = make_uint2(pack2(ag[ni][0], ag[ni][1]), pack2(ag[ni][2], ag[ni][3]));
        __builtin_amdgcn_sched_barrier(0);
      }
    }
#pragma unroll 1
    for (int d = 0; d < 2; ++d) {
      f32x4 aw[4], aa[4];
      product64x2(aw, aa, (const u16*)(wl + WO_RW2) + (size_t)d * 256 * 64, (const u16*)(wl + WO_RA2) + (size_t)d * 256 * 64, d * 64, 128 + d * 64);
      u16* oOMW = sc + (d ? SA_OMWB : SA_OMWF) * (size_t)NT * 256;
      u16* oKD = sc + (d ? SA_KDB : SA_KDF) * (size_t)NT * 256;
      u16* oB = sc + (d ? SA_BB : SA_BF) * (size_t)NT * 256;
#pragma unroll
      for (int ni = 0; ni < 4; ++ni) {
        const int ch = wave * 64 + ni * 16 + lq * 4;
        const size_t o = (size_t)row * 256 + ch;
        float kx[4]; shifted4(256 + ch, kx);
        const float4 kw = *(const float4*)(kkw + ch);
        const float kkn[4] = {kx[0] * kw.x * kinv, kx[1] * kw.y * kinv, kx[2] * kw.z * kinv, kx[3] * kw.w * kinv};
        const float4 w0 = *(const float4*)(w0p + d * 256 + ch);
        const float4 a0 = *(const float4*)(a0p + d * 256 + ch);
        const float4 ka = *(const float4*)(kap + d * 256 + ch);
        const float w0a[4] = {w0.x, w0.y, w0.z, w0.w}, a0a[4] = {a0.x, a0.y, a0.z, a0.w}, kaa[4] = {ka.x, ka.y, ka.z, ka.w};
        float omw[4], kd[4], bb[4];
#pragma unroll
        for (int j = 0; j < 4; ++j) {
          const float xw = -(w0a[j] + aw[ni][j]);
          const float sp = fmaxf(xw, 0.f) + __logf(1.f + __expf(-fabsf(xw)));
          const float wlog = -sp - 0.5f;
          const float e = __expf(wlog);
          omw[j] = 1.f - __expf(-e);
          const float a = sigmoidf_(a0a[j] + aa[ni][j]);
          kd[j] = kx[j] * (1.f + (a - 1.f) * kaa[j]);
          bb[j] = kkn[j] * a;
        }
        *(uint2*)(oOMW + o) = make_uint2(pack2(omw[0], omw[1]), pack2(omw[2], omw[3]));
        *(uint2*)(oKD + o) = make_uint2(pack2(kd[0], kd[1]), pack2(kd[2], kd[3]));
        *(uint2*)(oB + o) = make_uint2(pack2(bb[0], bb[1]), pack2(bb[2], bb[3]));
        __builtin_amdgcn_sched_barrier(0);
      }
    }
  }
}

DI size_t qk_index(int m, int h) {
  const bool lat = m < NTL;
  const int b = lat ? m >> 12 : (m - NTL) >> 8;
  const int pos = lat ? m & 4095 : 4096 + ((m - NTL) & 255);
  return ((size_t)(b * 8 + h) * LK + pos) * 96;
}
DI void phase_qkv(const Params& p, int l, char* smem) {
  LAUNDER_IDS
  WAVE_COORDS
  const char* wl = p.ws + OFF_W + (size_t)l * W_LAYER;
  const u16* za = (const u16*)(p.ws + OFF_R2);
  const float* rsq0 = (const float*)(p.ws + OFF_RSQ); const float* rskv0 = (const float*)(p.ws + OFF_RSKV);
  u16* Qb = (u16*)(p.ws + OFF_R1); u16* Kb = (u16*)(p.ws + OFF_R1 + SZ_Q); u16* Vt = (u16*)(p.ws + OFF_R1 + 2 * SZ_Q);
  const float* rt0 = (const float*)(p.ws + OFF_ROPE);
  const float* gq0 = p.in[I_GQ] + l * 96; const float* gk0 = p.in[I_GK] + l * 96;
  const float QS = 0.10206207261596577f * 1.4426950408889634f;
  constexpr int NTM = NT / 256;
  for (int it = 0;; ++it) {
    int tm, tn;
    if (!tile_map(it, NTM, 6, blk__, gridDim.x, tm, tn)) break;
    f32x4 acc[8][4]; zero_accm<8, 4>(acc);
    {
      const int m0 = tm * 256, n0 = tn * 128;
      gemm256<8, 4>(acc, za + 256, ZA, (const u16*)(wl + WO_UQ), 384, 384, m0, n0, smem);
      EPI_BEGIN
      const float* gq = gq0; const float* rt = rt0; const float* rsq = rsq0;
      asm volatile("" : "+v"(gq), "+v"(rt), "+v"(rsq));
      const int nw = n0 + wc * 64;
#pragma unroll
      for (int mi = 0; mi < 8; ++mi) {
        __builtin_amdgcn_sched_barrier(0);
        const int m = m0 + wr * 128 + mi * 16 + lr;
        const float rs = rsq[m];
        if (nw < 512) {
          const int h = nw >> 6;
          float ss = 0.f;
#pragma unroll
          for (int ni = 0; ni < 4; ++ni)
#pragma unroll
            for (int j = 0; j < 4; ++j) { const float v = acc[mi][ni][j] * rs; ss += v * v; }
          ss += __shfl_xor(ss, 16, 64); ss += __shfl_xor(ss, 32, 64);
          const float f = rs * rsqrtf(ss * (1.f / 64.f) + 1e-6f) * QS;
          u16* dst = Qb + qk_index(m, h);
#pragma unroll
          for (int ni = 0; ni < 4; ++ni) {
            const int d = ni * 16 + lq * 4;
            const float4 g = *(const float4*)(gq + d);
            *(uint2*)(dst + d) = make_uint2(pack2(acc[mi][ni][0] * f * g.x, acc[mi][ni][1] * f * g.y), pack2(acc[mi][ni][2] * f * g.z, acc[mi][ni][3] * f * g.w));
          }
        } else {
          const bool lat = m < NTL;
          const int tt = m & 4095;
#pragma unroll
          for (int hh = 0; hh < 2; ++hh) {
            __builtin_amdgcn_sched_barrier(0);
            const int h = ((nw - 512) >> 5) + hh;
            float ss = 0.f;
#pragma unroll
            for (int ni = 0; ni < 2; ++ni)
#pragma unroll
              for (int j = 0; j < 4; ++j) { const float v = acc[mi][hh * 2 + ni][j] * rs; ss += v * v; }
            ss += __shfl_xor(ss, 16, 64); ss += __shfl_xor(ss, 32, 64);
            const float f = rs * rsqrtf(ss * (1.f / 32.f) + 1e-6f) * QS;
            const int i0 = lq * 4;
            const float4 g1 = *(const float4*)(gq + 64 + i0), g2 = *(const float4*)(gq + 80 + i0);
            const float g1a[4] = {g1.x, g1.y, g1.z, g1.w}, g2a[4] = {g2.x, g2.y, g2.z, g2.w};
            float o1[4], o2[4];
#pragma unroll
            for (int j = 0; j < 4; ++j) {
              const float x1 = acc[mi][hh * 2][j] * f * g1a[j], x2 = acc[mi][hh * 2 + 1][j] * f * g2a[j];
              float cs = 1.f, sn = 0.f;
              if (lat) {
                const int i = i0 + j;
                const int pp = i < 8 ? (tt >> 6) : (tt & 63);
                cs = rt[(pp * 8 + (i & 7)) * 2]; sn = rt[(pp * 8 + (i & 7)) * 2 + 1];
              }
              o1[j] = x1 * cs - x2 * sn; o2[j] = x1 * sn + x2 * cs;
            }
            u16* dst = Qb + qk_index(m, h) + 64;
            *(uint2*)(dst + i0) = make_uint2(pack2(o1[0], o1[1]), pack2(o1[2], o1[3]));
            *(uint2*)(dst + 16 + i0) = make_uint2(pack2(o2[0], o2[1]), pack2(o2[2], o2[3]));
          }
        }
      }
      EPI_END
    }
  }
  __builtin_amdgcn_sched_barrier(0);
  for (int it = 0;; ++it) {
    int tm, tn;
    if (!tile_map(it, NTM, 8, blk__, gridDim.x, tm, tn)) break;
    f32x4 acc[8][4]; zero_accm<8, 4>(acc);
    {
      const int h = tn, m0 = tm * 256, n0 = h * 128;
      gemm256<8, 4>(acc, za + 640, ZA, (const u16*)(wl + WO_UKV), 256, 256, m0, n0, smem);
      EPI_BEGIN
      const float* gk = gk0; const float* rskv = rskv0;
      asm volatile("" : "+v"(gk), "+v"(rskv));
#pragma unroll
      for (int mi = 0; mi < 8; ++mi) {
        __builtin_amdgcn_sched_barrier(0);
        const int m = m0 + wr * 128 + mi * 16 + lr;
        const float rs = rskv[m];
        if (wc == 0) {
          float ss = 0.f;
#pragma unroll
          for (int ni = 0; ni < 4; ++ni)
#pragma unroll
            for (int j = 0; j < 4; ++j) { const float v = acc[mi][ni][j] * rs; ss += v * v; }
          ss += __shfl_xor(ss, 16, 64); ss += __shfl_xor(ss, 32, 64);
          const float f = rs * rsqrtf(ss * (1.f / 64.f) + 1e-6f);
          u16* dst = Kb + qk_index(m, h);
#pragma unroll
          for (int ni = 0; ni < 4; ++ni) {
            const int d = ni * 16 + lq * 4;
            const float4 g = *(const float4*)(gk + d);
            *(uint2*)(dst + d) = make_uint2(pack2(acc[mi][ni][0] * f * g.x, acc[mi][ni][1] * f * g.y), pack2(acc[mi][ni][2] * f * g.z, acc[mi][ni][3] * f * g.w));
          }
          *(uint4*)(dst + 64 + lq * 8) = *(const uint4*)((const u16*)(p.ws + OFF_KR) + (size_t)m * 32 + lq * 8);
        } else {
          const bool lat = m < NTL;
          const int b = lat ? m >> 12 : (m - NTL) >> 8;
          const int pos = lat ? m & 4095 : 4096 + ((m - NTL) & 255);
          u16* dst = Vt + (size_t)(b * 8 + h) * 64 * LK + pos + (size_t)(lq * 4) * LK;
#pragma unroll
          for (int ni = 0; ni < 4; ++ni) {
            asm volatile("" : "+v"(dst));
#pragma unroll
            for (int j = 0; j < 4; ++j) dst[j * LK] = f2bf(acc[mi][ni][j] * rs);
            dst += 16 * LK;
          }
        }
      }
      EPI_END
    }
  }
}

DI int scan_row(int b, int dir, int s) {
  if (s < LC) return NTL + b * LC + (dir ? LC - 1 - s : s);
  const int t = s - LC;
  return b * L + (dir ? L - 1 - t : t);
}
DI void phase_scan(const Params& p, char* smem) {
  LAUNDER_IDS
  const int blk = blk__;
  if (blk >= 256) return;
  const int tid = tid__, lane = tid & 63, wave = tid >> 6, kq = lane & 15, rg = lane >> 4;
  const int chain = (blk & 7) + 8 * (blk >> 5), quarter = (blk >> 3) & 3;
  const int b = chain >> 3, h = (chain >> 1) & 3, dir = chain & 1;
  const u16* sc = (const u16*)(p.ws + OFF_R3);
  const size_t AS = (size_t)NT * 256;
  const u16* aOMW = sc + (dir ? SA_OMWB : SA_OMWF) * AS;
  const u16* aKD = sc + (dir ? SA_KDB : SA_KDF) * AS;
  const u16* aB = sc + (dir ? SA_BB : SA_BF) * AS;
  const u16* aKKN = sc + SA_KKN * AS;
  const u16* aR = sc + SA_R * AS;
  const u16* aV = sc + SA_V * AS;
  u16* Y = (u16*)(p.ws + OFF_R2) + (dir ? AS : 0);
  constexpr int CH = 16, BSZ = 5 * CH * 64 + CH * 16;
  float* buf = (float*)smem;
  const int st_ld = tid >> 4, k4 = (tid & 15) * 4;
  const int vrow = quarter * 16 + wave * 4 + rg;
  uint2 g0, g1, g2, g3, g4; u16 gv;
#define SCAN_GLOAD(CHUNK) do { \
    const int row_ = scan_row(b, dir, (CHUNK) * CH + st_ld); \
    const size_t o_ = (size_t)row_ * 256 + h * 64 + k4; \
    g0 = *(const uint2*)(aOMW + o_); g1 = *(const uint2*)(aKD + o_); g2 = *(const uint2*)(aB + o_); g3 = *(const uint2*)(aKKN + o_); g4 = *(const uint2*)(aR + o_); \
    gv = aV[(size_t)row_ * 256 + h * 64 + quarter * 16 + (tid & 15)]; } while (0)
#define SCAN_LSTORE(BI) do { \
    float* bb_ = buf + (BI) * BSZ + st_ld * 64 + k4; \
    *(float4*)(bb_ + 0 * CH * 64) = make_float4(1.f - bflo(g0.x), 1.f - bfhi(g0.x), 1.f - bflo(g0.y), 1.f - bfhi(g0.y)); \
    *(float4*)(bb_ + 1 * CH * 64) = make_float4(bflo(g1.x), bfhi(g1.x), bflo(g1.y), bfhi(g1.y)); \
    *(float4*)(bb_ + 2 * CH * 64) = make_float4(bflo(g2.x), bfhi(g2.x), bflo(g2.y), bfhi(g2.y)); \
    *(float4*)(bb_ + 3 * CH * 64) = make_float4(bflo(g3.x), bfhi(g3.x), bflo(g3.y), bfhi(g3.y)); \
    *(float4*)(bb_ + 4 * CH * 64) = make_float4(bflo(g4.x), bfhi(g4.x), bflo(g4.y), bfhi(g4.y)); \
    buf[(BI) * BSZ + 5 * CH * 64 + st_ld * 16 + (tid & 15)] = bf2f(gv); } while (0)
  float2_t S01 = {0.f, 0.f}, S23 = {0.f, 0.f};
  __builtin_amdgcn_s_setprio(3);
  __syncthreads();
  SCAN_GLOAD(0); SCAN_LSTORE(0);
  __syncthreads();
  constexpr int NCH = LK / CH;
  for (int c = 0; c < NCH; ++c) {
    if (c + 1 < NCH) SCAN_GLOAD(c + 1);
    const float* bb = buf + (c & 1) * BSZ;
    const int rowbase = scan_row(b, dir, c * CH);
    const int rstep = dir ? -1 : 1;
    const float* bl = bb + kq * 4;
    const float* bv = bb + 5 * CH * 64 + wave * 4 + rg;
    float4 fw = *(const float4*)(bl + 0 * CH * 64), fk = *(const float4*)(bl + 1 * CH * 64), fb = *(const float4*)(bl + 2 * CH * 64),
           fa = *(const float4*)(bl + 3 * CH * 64), fr = *(const float4*)(bl + 4 * CH * 64);
    float vv = bv[0];
    float ysel = 0.f;
#pragma unroll
    for (int s = 0; s < CH; ++s) {
      const float2_t a01 = {fa.x, fa.y}, a23 = {fa.z, fa.w};
      const float2_t w01 = {fw.x, fw.y}, w23 = {fw.z, fw.w}, k01 = {fk.x, fk.y}, k23 = {fk.z, fk.w}, b01 = {fb.x, fb.y}, b23 = {fb.z, fb.w};
      const float2_t r01 = {fr.x, fr.y}, r23 = {fr.z, fr.w};
      const float2_t vv2 = {vv, vv};
      if (s + 1 < CH) {
        fw = *(const float4*)(bl + 0 * CH * 64 + (s + 1) * 64); fk = *(const float4*)(bl + 1 * CH * 64 + (s + 1) * 64); fb = *(const float4*)(bl + 2 * CH * 64 + (s + 1) * 64);
        fa = *(const float4*)(bl + 3 * CH * 64 + (s + 1) * 64); fr = *(const float4*)(bl + 4 * CH * 64 + (s + 1) * 64);
        vv = bv[(s + 1) * 16];
      }
      float2_t t2 = S01 * a01; t2 = S23 * a23 + t2;
      const float sa = rowsum16(t2.x + t2.y);
      const float2_t sa2 = {sa, sa};
      float2_t u01 = vv2 * k01; u01 = sa2 * b01 + u01; S01 = S01 * w01 + u01;
      float2_t u23 = vv2 * k23; u23 = sa2 * b23 + u23; S23 = S23 * w23 + u23;
      float2_t y2 = S01 * r01; y2 = S23 * r23 + y2;
      const float y = rowsum16(y2.x + y2.y);
      ysel = (kq == s) ? y : ysel;
    }
    Y[(size_t)(rowbase + rstep * kq) * 256 + h * 64 + vrow] = f2bf(ysel);
    if (c + 1 < NCH) SCAN_LSTORE((c + 1) & 1);
    __syncthreads();
  }
  __builtin_amdgcn_s_setprio(0);
#undef SCAN_GLOAD
#undef SCAN_LSTORE
}

constexpr int KSL = 104, VSL = 68;
template <int B0>
DI bf16x8 pack8(const f32x16& v) {
  uint4 pw;
  pw.x = pack2(v[B0 + 0], v[B0 + 1]); pw.y = pack2(v[B0 + 2], v[B0 + 3]); pw.z = pack2(v[B0 + 4], v[B0 + 5]); pw.w = pack2(v[B0 + 6], v[B0 + 7]);
  return __builtin_bit_cast(bf16x8, pw);
}
DI void pv_step(f32x16& o0, f32x16& o1, const u16* Vc, int r32, int kb, bf16x8 pf) {
  {
    const uint2 lo = *(const uint2*)(Vc + r32 * VSL + kb), hi2 = *(const uint2*)(Vc + r32 * VSL + kb + 8);
    const bf16x8 va = __builtin_bit_cast(bf16x8, make_uint4(lo.x, lo.y, hi2.x, hi2.y));
    o0 = __builtin_amdgcn_mfma_f32_32x32x16_bf16(va, pf, o0, 0, 0, 0);
  }
  {
    const uint2 lo = *(const uint2*)(Vc + (32 + r32) * VSL + kb), hi2 = *(const uint2*)(Vc + (32 + r32) * VSL + kb + 8);
    const bf16x8 va = __builtin_bit_cast(bf16x8, make_uint4(lo.x, lo.y, hi2.x, hi2.y));
    o1 = __builtin_amdgcn_mfma_f32_32x32x16_bf16(va, pf, o1, 0, 0, 0);
  }
}
DI void attn_item(const Params& p, int item, char* smem) {
  LAUNDER_IDS
  const int tid = tid__, lane = tid & 63, wave = tid >> 6, r32 = lane & 31, hi = lane >> 5;
  int bh, qpos0, key0, nkt, orow0;
  if (item < 2048) { bh = item >> 5; const int qb = item & 31; qpos0 = qb * 128; key0 = 0; nkt = LK / 64; orow0 = (bh >> 3) * L + qpos0; }
  else { const int it = item - 2048; bh = it >> 1; const int qb = it & 1; qpos0 = 4096 + qb * 128; key0 = 4096; nkt = LC / 64; orow0 = NTL + (bh >> 3) * LC + qb * 128; }
  const int h = bh & 7;
  const u16* Qp = (const u16*)(p.ws + OFF_R1) + ((size_t)bh * LK + qpos0 + wave * 32 + r32) * 96 + hi * 8;
  const u16* Kp = (const u16*)(p.ws + OFF_R1 + SZ_Q) + ((size_t)bh * LK + key0) * 96;
  const u16* Vp = (const u16*)(p.ws + OFF_R1 + 2 * SZ_Q) + (size_t)bh * 64 * LK + key0;
  u16* Ks = (u16*)smem;
  u16* Vs = Ks + 2 * 64 * KSL;
  bf16x8 qr[6];
#pragma unroll
  for (int d0 = 0; d0 < 6; ++d0) qr[d0] = *(const bf16x8*)(Qp + d0 * 16);
  uint4 sk0, sk1, sk2, sv0, sv1;
  const int kr0 = tid / 12, kc0 = tid - kr0 * 12, kr1 = (tid + 256) / 12, kc1 = (tid + 256) - kr1 * 12, kr2 = (tid + 512) / 12, kc2 = (tid + 512) - kr2 * 12;
  const int vd0 = tid >> 3, vc0 = tid & 7, vd1 = vd0 + 32;
#define gload(kt) do { \
    sk0 = *(const uint4*)(Kp + (size_t)((kt) * 64 + kr0) * 96 + kc0 * 8); sk1 = *(const uint4*)(Kp + (size_t)((kt) * 64 + kr1) * 96 + kc1 * 8); \
    sk2 = *(const uint4*)(Kp + (size_t)((kt) * 64 + kr2) * 96 + kc2 * 8); \
    sv0 = *(const uint4*)(Vp + (size_t)vd0 * LK + (kt) * 64 + vc0 * 8); sv1 = *(const uint4*)(Vp + (size_t)vd1 * LK + (kt) * 64 + vc0 * 8); } while (0)
#define lstore(bi) do { \
    *(uint4*)(Ks + (bi) * 64 * KSL + kr0 * KSL + kc0 * 8) = sk0; *(uint4*)(Ks + (bi) * 64 * KSL + kr1 * KSL + kc1 * 8) = sk1; *(uint4*)(Ks + (bi) * 64 * KSL + kr2 * KSL + kc2 * 8) = sk2; \
    { u16* dst = Vs + (bi) * 64 * VSL + vd0 * VSL + vc0 * 8; *(uint2*)dst = make_uint2(sv0.x, sv0.y); *(uint2*)(dst + 4) = make_uint2(sv0.z, sv0.w); } \
    { u16* dst = Vs + (bi) * 64 * VSL + vd1 * VSL + vc0 * 8; *(uint2*)dst = make_uint2(sv1.x, sv1.y); *(uint2*)(dst + 4) = make_uint2(sv1.z, sv1.w); } } while (0)
  f32x16 o0, o1;
#pragma unroll
  for (int i = 0; i < 16; ++i) { o0[i] = 0.f; o1[i] = 0.f; }
  float mrun = -1e30f, lrun = 0.f;
  __syncthreads();
  gload(0); lstore(0);
  __syncthreads();
  for (int kt = 0; kt < nkt; ++kt) {
    const int cur = kt & 1;
    if (kt + 1 < nkt) gload(kt + 1);
    const u16* Kc = Ks + cur * 64 * KSL;
    const u16* Vc = Vs + cur * 64 * VSL;
    f32x16 p0, p1;
#pragma unroll
    for (int i = 0; i < 16; ++i) { p0[i] = 0.f; p1[i] = 0.f; }
#pragma unroll
    for (int d0 = 0; d0 < 6; ++d0) {
      const bf16x8 a0 = *(const bf16x8*)(Kc + r32 * KSL + d0 * 16 + hi * 8);
      const bf16x8 a1 = *(const bf16x8*)(Kc + (32 + r32) * KSL + d0 * 16 + hi * 8);
      p0 = __builtin_amdgcn_mfma_f32_32x32x16_bf16(a0, qr[d0], p0, 0, 0, 0);
      p1 = __builtin_amdgcn_mfma_f32_32x32x16_bf16(a1, qr[d0], p1, 0, 0, 0);
    }
    float mx = p0[0];
#pragma unroll
    for (int i = 1; i < 16; ++i) mx = fmaxf(mx, p0[i]);
#pragma unroll
    for (int i = 0; i < 16; ++i) mx = fmaxf(mx, p1[i]);
    mx = fmaxf(mx, __shfl_xor(mx, 32, 64));
    if (!__all(mx - mrun <= 8.f)) {
      const float mn = fmaxf(mrun, mx);
      const float alpha = __builtin_amdgcn_exp2f(mrun - mn);
      mrun = mn; lrun *= alpha;
#pragma unroll
      for (int i = 0; i < 16; ++i) { o0[i] *= alpha; o1[i] *= alpha; }
    }
    float ps = 0.f;
#pragma unroll
    for (int i = 0; i < 16; ++i) { p0[i] = __builtin_amdgcn_exp2f(p0[i] - mrun); ps += p0[i]; }
#pragma unroll
    for (int i = 0; i < 16; ++i) { p1[i] = __builtin_amdgcn_exp2f(p1[i] - mrun); ps += p1[i]; }
    lrun += ps;
    pv_step(o0, o1, Vc, r32, 0 + hi * 4, pack8<0>(p0));
    pv_step(o0, o1, Vc, r32, 16 + hi * 4, pack8<8>(p0));
    pv_step(o0, o1, Vc, r32, 32 + hi * 4, pack8<0>(p1));
    pv_step(o0, o1, Vc, r32, 48 + hi * 4, pack8<8>(p1));
    if (kt + 1 < nkt) lstore(cur ^ 1);
    __syncthreads();
  }
  lrun += __shfl_xor(lrun, 32, 64);
  const float inv = 1.f / lrun;
  u16* om = (u16*)(p.ws + OFF_OMLA) + (size_t)(orow0 + wave * 32 + r32) * 512 + h * 64;
#pragma unroll
  for (int g = 0; g < 4; ++g) {
    const int d = 8 * g + 4 * hi;
    *(uint2*)(om + d) = make_uint2(pack2(o0[4 * g] * inv, o0[4 * g + 1] * inv), pack2(o0[4 * g + 2] * inv, o0[4 * g + 3] * inv));
    *(uint2*)(om + 32 + d) = make_uint2(pack2(o1[4 * g] * inv, o1[4 * g + 1] * inv), pack2(o1[4 * g + 2] * inv, o1[4 * g + 3] * inv));
  }
#undef gload
#undef lstore
}

DI void readout_row(const Params& p, int l, int r) {
  LAUNDER_IDS
  const int lane = tid__ & 63;
  const u16* sc = (const u16*)(p.ws + OFF_R3);
  const size_t AS = (size_t)NT * 256;
  const size_t o = (size_t)r * 256 + lane * 4;
  const u16* Yf = (const u16*)(p.ws + OFF_R2);
  const uint2 yf = *(const uint2*)(Yf + o), yb = *(const uint2*)(Yf + AS + o);
  const uint2 ur = *(const uint2*)(sc + SA_R * AS + o), uv = *(const uint2*)(sc + SA_V * AS + o);
  const uint2 kf = *(const uint2*)(sc + SA_KDF * AS + o), kb = *(const uint2*)(sc + SA_KDB * AS + o), ug = *(const uint2*)(sc + SA_G * AS + o);
  float y[4] = {bflo(yf.x) + bflo(yb.x), bfhi(yf.x) + bfhi(yb.x), bflo(yf.y) + bflo(yb.y), bfhi(yf.y) + bfhi(yb.y)};
  const float rr[4] = {bflo(ur.x), bfhi(ur.x), bflo(ur.y), bfhi(ur.y)};
  const float vv[4] = {bflo(uv.x), bfhi(uv.x), bflo(uv.y), bfhi(uv.y)};
  const float km[4] = {0.5f * (bflo(kf.x) + bflo(kb.x)), 0.5f * (bfhi(kf.x) + bfhi(kb.x)), 0.5f * (bflo(kf.y) + bflo(kb.y)), 0.5f * (bfhi(kf.y) + bfhi(kb.y))};
  const float gg[4] = {bflo(ug.x), bfhi(ug.x), bflo(ug.y), bfhi(ug.y)};
  const float4 rk4 = *(const float4*)(p.in[I_RK] + l * 256 + lane * 4);
  const float4 lw4 = *(const float4*)(p.in[I_LNW] + l * 256 + lane * 4);
  const float4 lb4 = *(const float4*)(p.in[I_LNB] + l * 256 + lane * 4);
  const float rk[4] = {rk4.x, rk4.y, rk4.z, rk4.w}, lw[4] = {lw4.x, lw4.y, lw4.z, lw4.w}, lb[4] = {lb4.x, lb4.y, lb4.z, lb4.w};
  float s = y[0] + y[1] + y[2] + y[3];
  s = rowsum16(s);
  const float mu = s * (1.f / 64.f);
  float q = 0.f, bn = 0.f;
#pragma unroll
  for (int j = 0; j < 4; ++j) { const float d = y[j] - mu; q += d * d; bn += rr[j] * km[j] * rk[j]; }
  q = rowsum16(q); bn = rowsum16(bn);
  const float rstd = rsqrtf(q * (1.f / 64.f) + 64e-5f);
  float ov[4];
#pragma unroll
  for (int j = 0; j < 4; ++j) ov[j] = ((y[j] - mu) * rstd * lw[j] + lb[j] + bn * vv[j]) * gg[j];
  u16* orw = (u16*)(p.ws + OFF_R3 + SA_KKN * SZ_TOK256 + (size_t)NT * 512 * 2);
  *(uint2*)(orw + o) = make_uint2(pack2(ov[0], ov[1]), pack2(ov[2], ov[3]));
}

DI void phase_attn(const Params& p, int l, char* smem) {
  LAUNDER_IDS
  __shared__ int qslot_sh;
  const int nattn = (l == 0) ? 2048 + 128 : 2048;
  unsigned* ctr = (unsigned*)(p.ws + OFF_BAR) + 16 + l * 16;
  for (;;) {
    __syncthreads();
    if (tid__ == 0) qslot_sh = (int)__hip_atomic_fetch_add(ctr, 1u, __ATOMIC_RELAXED, __HIP_MEMORY_SCOPE_AGENT);
    __syncthreads();
    const int it = qslot_sh;
    if (it >= nattn) break;
    attn_item(p, it, smem);
  }
}
DI void phase_readout(const Params& p, int l, int Mout) {
  LAUNDER_IDS
  const int wave = tid__ >> 6;
  for (int r = blk__ * 4 + wave; r < Mout; r += gridDim.x * 4) readout_row(p, l, r);
}

DI void phase_merge(const Params& p, int l, int Mout, char* smem) {
  LAUNDER_IDS
  WAVE_COORDS
  const char* wl = p.ws + OFF_W + (size_t)l * W_LAYER;
  const u16* hg = (const u16*)(p.ws + OFF_HBG);
  const u16* opool = (const u16*)(p.ws + OFF_R4);
  const u16* omla = (const u16*)(p.ws + OFF_OMLA);
  const u16* orw = (const u16*)(p.ws + OFF_R3 + SA_KKN * SZ_TOK256) + (size_t)NT * 512;
  u16* mo = (u16*)(p.ws + OFF_R1);
  const int ntm = Mout / 128;
  for (int it = 0;; ++it) {
    int tm, tn;
    if (!tile_map(it, ntm, 8, blk__, gridDim.x, tm, tn)) break;
    const int m0 = tm * 128, n0 = tn * 128;
    f32x4 msum[4][4]; zero_accm<4, 4>(msum);
#pragma unroll 1
    for (int br = 0; br < 3; ++br) {
      unsigned gpk[4][4][2];
      {
        f32x4 ag[4][4]; zero_accm<4, 4>(ag);
        gemm256<4, 4>(ag, hg, 1024, (const u16*)(wl + WO_WIN) + (size_t)(2080 + br * 1024) * 1024, 1024, 1024, m0, n0, smem);
#pragma unroll
        for (int mi = 0; mi < 4; ++mi)
#pragma unroll
          for (int ni = 0; ni < 4; ++ni) {
            gpk[mi][ni][0] = pack2(sigmoidf_(ag[mi][ni][0]), sigmoidf_(ag[mi][ni][1]));
            gpk[mi][ni][1] = pack2(sigmoidf_(ag[mi][ni][2]), sigmoidf_(ag[mi][ni][3]));
          }
      }
      __builtin_amdgcn_sched_barrier(0);
      f32x4 ab[4][4]; zero_accm<4, 4>(ab);
      {
        const int Kb = br == 1 ? 512 : 256;
        const u16* Ab = br == 0 ? opool : br == 1 ? omla : orw;
        const u16* Wb = (const u16*)(wl + (br == 0 ? WO_BRP : br == 1 ? WO_BRM : WO_BRR));
        gemm256<4, 4>(ab, Ab, Kb, Wb, Kb, Kb, m0, n0, smem);
      }
#pragma unroll
      for (int mi = 0; mi < 4; ++mi)
#pragma unroll
        for (int ni = 0; ni < 4; ++ni) {
          msum[mi][ni][0] += bflo(gpk[mi][ni][0]) * ab[mi][ni][0];
          msum[mi][ni][1] += bfhi(gpk[mi][ni][0]) * ab[mi][ni][1];
          msum[mi][ni][2] += bflo(gpk[mi][ni][1]) * ab[mi][ni][2];
          msum[mi][ni][3] += bfhi(gpk[mi][ni][1]) * ab[mi][ni][3];
        }
      __builtin_amdgcn_sched_barrier(0);
    }
    EPI_BEGIN
#pragma unroll
    for (int mi = 0; mi < 4; ++mi) {
      const int m = m0 + wr * 64 + mi * 16 + lr;
#pragma unroll
      for (int ni = 0; ni < 4; ++ni) {
        const int n = n0 + wc * 64 + ni * 16 + lq * 4;
        *(uint2*)(mo + (size_t)m * 1024 + n) = make_uint2(pack2(msum[mi][ni][0], msum[mi][ni][1]), pack2(msum[mi][ni][2], msum[mi][ni][3]));
      }
    }
    EPI_END
  }
}

DI void phase_resid(const Params& p, const u16* A, int K, const u16* Bt, const float* gate  ,
                    const float* xl_in, const float* xc_in, float* xl_out, float* xc_out, int Mout, char* smem) {
  LAUNDER_IDS
  WAVE_COORDS
  const int ntm = Mout / 256;
  for (int it = 0;; ++it) {
    int tm, tn;
    if (!tile_map(it, ntm, 8, blk__, gridDim.x, tm, tn)) break;
    const int m0 = tm * 256, n0 = tn * 128;
    f32x4 acc[8][4]; zero_accm<8, 4>(acc);
    gemm256<8, 4>(acc, A, K, Bt, K, K, m0, n0, smem);
    EPI_BEGIN
#pragma unroll
    for (int mi = 0; mi < 8; ++mi) {
      const int m = m0 + wr * 128 + mi * 16 + lr;
      const int b9 = m < NTL ? m >> 12 : 8;
      const float* xi = xrow(xl_in, xc_in, m);
      float* xo = m < NTL ? xl_out + (size_t)m * D : xc_out + (size_t)(m - NTL) * D;
#pragma unroll
      for (int ni = 0; ni < 4; ++ni) {
        const int n = n0 + wc * 64 + ni * 16 + lq * 4;
        const float4 g = *(const float4*)(gate + (size_t)b9 * 6144 + n);
        const float4 xv = *(const float4*)(xi + n);
        float4 ov;
        ov.x = xv.x + g.x * acc[mi][ni][0]; ov.y = xv.y + g.y * acc[mi][ni][1]; ov.z = xv.z + g.z * acc[mi][ni][2]; ov.w = xv.w + g.w * acc[mi][ni][3];
        *(float4*)(xo + n) = ov;
      }
      __builtin_amdgcn_sched_barrier(0);
    }
    EPI_END
  }
}
DI void phase_mlp1(const Params& p, int l, int Mout, char* smem) {
  LAUNDER_IDS
  WAVE_COORDS
  const char* wl = p.ws + OFF_W + (size_t)l * W_LAYER;
  const u16* hb = (const u16*)(p.ws + OFF_HB2);
  u16* U = (u16*)(p.ws + OFF_R1);
  const int ntm = Mout / 256;
  for (int it = 0;; ++it) {
    int tm, tn;
    if (!tile_map(it, ntm, 32, blk__, gridDim.x, tm, tn)) break;
    const int m0 = tm * 256, n0 = tn * 128;
    f32x4 acc[8][4]; zero_accm<8, 4>(acc);
    gemm256<8, 4>(acc, hb, 1024, (const u16*)(wl + WO_W1), 1024, 1024, m0, n0, smem);
    EPI_BEGIN
#pragma unroll
    for (int mi = 0; mi < 8; ++mi) {
      const int m = m0 + wr * 128 + mi * 16 + lr;
#pragma unroll
      for (int ni = 0; ni < 4; ++ni) {
        const int n = n0 + wc * 64 + ni * 16 + lq * 4;
        float v[4];
#pragma unroll
        for (int j = 0; j < 4; ++j) { const float a = fmaxf(acc[mi][ni][j], 0.f); v[j] = a * a; }
        *(uint2*)(U + (size_t)m * DFF + n) = make_uint2(pack2(v[0], v[1]), pack2(v[2], v[3]));
      }
      __builtin_amdgcn_sched_barrier(0);
    }
    EPI_END
  }
}

__global__ void __launch_bounds__(256, 2) fwd_megakernel(Params pk) {
  __shared__ __attribute__((aligned(16))) char smem[73728];
  cg::grid_group grid = cg::this_grid();
  if (threadIdx.x == 0) { g_base_sh[0] = (unsigned long long)pk.ws; g_base_sh[1] = (unsigned long long)pk.out; }
  xcd_barrier_post((unsigned*)(pk.ws + OFF_BAR));
  __syncthreads();
  phase_prep(pk, smem);
  if (pk.ws == nullptr) grid.sync();
  xcd_barrier();
  phase_tables(pk);
  xcd_barrier();
#define CTXBUF ((float*)(p.ws + OFF_CTX))
#define XLP (l == 0 ? p.in[I_X] : (const float*)p.out)
#define XCP (l == 0 ? p.in[I_CTX] : (const float*)CTXBUF)
#define MOUT (l == 0 ? NT : NTL)
#define WLP (p.ws + OFF_W + (size_t)l * W_LAYER)
#define TABP(nrm) ((const float*)(p.ws + OFF_TAB) + (size_t)(l * 2 + (nrm)) * 9 * 2048)
#define MODP(j) ((const float*)(p.ws + OFF_MODS) + (size_t)l * 9 * 6144 + (j) * 1024)
#ifndef PROBE_Q
#define PROBE_Q -1
#endif
#pragma nounroll
  for (int ph = 0; ph < 22; ++ph) {
    const int l = ph >= 11 ? 1 : 0, q = ph - l * 11;
    Params p = pk;
    {
      asm volatile("" ::: "memory");
      unsigned long long w_ = g_base_sh[0], o_ = g_base_sh[1];
      unsigned wl_ = (unsigned)w_, wh_ = (unsigned)(w_ >> 32), ol_ = (unsigned)o_, oh_ = (unsigned)(o_ >> 32);
      wl_ = __builtin_amdgcn_readfirstlane(wl_); wh_ = __builtin_amdgcn_readfirstlane(wh_); ol_ = __builtin_amdgcn_readfirstlane(ol_); oh_ = __builtin_amdgcn_readfirstlane(oh_);
      asm volatile("" : "+s"(wl_), "+s"(wh_), "+s"(ol_), "+s"(oh_));
      p.ws = (char*)(((unsigned long long)wh_ << 32) | wl_); p.out = (float*)(((unsigned long long)oh_ << 32) | ol_);
    }
#pragma nounroll
    for (int rep = 0; rep < (q == PROBE_Q ? 2 : 1); ++rep)
    switch (q) {
      case 0: phase_norm(XLP, XCP, TABP(0), (u16*)(p.ws + OFF_HB1), NT); break;
      case 1: phase_zgemm(p, l, smem); break;
      case 2: phase_tokA(p, l); phase_tokB(p, l, smem); break;
      case 3: phase_qkv(p, l, smem); break;
      case 4: phase_scan(p, smem); phase_attn(p, l, smem); break;
      case 5: phase_norm(XLP, XCP, TABP(0), (u16*)(p.ws + OFF_HBG), MOUT); phase_readout(p, l, MOUT); break;
      case 6: phase_merge(p, l, MOUT, smem); break;
      case 7: phase_resid(p, (const u16*)(p.ws + OFF_R1), 1024, (const u16*)(WLP + WO_WO), MODP(2), XLP, XCP, p.out, CTXBUF, MOUT, smem); break;
      case 8: phase_norm(p.out, CTXBUF, TABP(1), (u16*)(p.ws + OFF_HB2), MOUT); break;
      case 9: phase_mlp1(p, l, MOUT, smem); break;
      default: phase_resid(p, (const u16*)(p.ws + OFF_R1), 4096, (const u16*)(WLP + WO_W2), MODP(5), p.out, CTXBUF, p.out, CTXBUF, MOUT, smem); break;
    }
    if (ph != 21) xcd_barrier();
  }
}

extern "C" void kernel_launch(void* const* d_in, const int* in_sizes, int n_in, void* d_out, int out_size, void* d_ws, size_t ws_size, hipStream_t stream) {
  static int grid_blocks = 0;
  if (!grid_blocks) {
    int dev = 0, cus = 0, per_cu = 0;
    hipGetDevice(&dev);
    hipDeviceGetAttribute(&cus, hipDeviceAttributeMultiprocessorCount, dev);
    hipOccupancyMaxActiveBlocksPerMultiprocessor(&per_cu, fwd_megakernel, 256, 0);
    if (per_cu > 2) per_cu = 2;
    if (per_cu < 1) per_cu = 1;
    grid_blocks = cus * per_cu;
    if (ws_size < WS_END) fprintf(stderr, "kernel_launch: workspace too small: %zu < %zu\n", ws_size, (size_t)WS_END);
  }
  Params p{};
  for (int i = 0; i < 34; ++i) p.in[i] = (const float*)d_in[i];
  p.out = (float*)d_out;
  p.ws = (char*)d_ws;
  hipMemsetAsync(d_ws, 0, 16384, stream);
  void* args[] = {&p};
  hipError_t e = hipLaunchCooperativeKernel((void*)fwd_megakernel, dim3(grid_blocks), dim3(256), args, 0, stream);
  if (e != hipSuccess) fprintf(stderr, "cooperative launch failed: %s (grid %d)\n", hipGetErrorString(e), grid_blocks);
}
```

```cpp
#include <hip/hip_runtime.h>
#include <hip/hip_cooperative_groups.h>
#include <stdint.h>
#include <cstdio>
namespace cg = cooperative_groups;

typedef unsigned short u16;
typedef __attribute__((ext_vector_type(8))) short bf16x8;
typedef __attribute__((ext_vector_type(4))) float f32x4;
typedef __attribute__((ext_vector_type(16))) float f32x16;
typedef __bf16 bf16x2_t __attribute__((ext_vector_type(2)));
typedef float float2_t __attribute__((ext_vector_type(2)));

#define DI __device__ __forceinline__

constexpr int D = 1024, NB = 8, L = 4096, LC = 256, LK = 4352;
constexpr int NTL = NB * L;
constexpr int NTC = NB * LC;
constexpr int NT = NTL + NTC;
constexpr int INC = 5152;
constexpr int ZA = 928;
constexpr int ZR = 1152;
constexpr int DFF = 4096;

constexpr size_t al256(size_t x) { return (x + 255) / 256 * 256; }
constexpr size_t OFF_BAR = 0;
constexpr size_t OFF_MODS = 16384;
constexpr size_t OFF_TAB = OFF_MODS + al256(2 * 9 * 6144 * 4);
constexpr size_t OFF_ROPE = OFF_TAB + al256(2 * 2 * 9 * 2 * 1024 * 4);
constexpr size_t OFF_RS1 = OFF_ROPE + 4096;
constexpr size_t OFF_RS2 = OFF_RS1 + al256(NT * 4);
constexpr size_t OFF_RSQ = OFF_RS2 + al256(NT * 4);
constexpr size_t OFF_RSKV = OFF_RSQ + al256(NT * 4);
constexpr size_t OFF_CTX = OFF_RSKV + al256(NT * 4);
constexpr size_t OFF_W = OFF_CTX + (size_t)NTC * D * 4;
constexpr size_t WO_WIN = 0;
constexpr size_t WO_UQ = WO_WIN + (size_t)INC * 1024 * 2;
constexpr size_t WO_UKV = WO_UQ + (size_t)768 * 384 * 2;
constexpr size_t WO_BRP = WO_UKV + (size_t)1024 * 256 * 2;
constexpr size_t WO_BRM = WO_BRP + (size_t)1024 * 256 * 2;
constexpr size_t WO_BRR = WO_BRM + (size_t)1024 * 512 * 2;
constexpr size_t WO_WO = WO_BRR + (size_t)1024 * 256 * 2;
constexpr size_t WO_W1 = WO_WO + (size_t)1024 * 1024 * 2;
constexpr size_t WO_W2 = WO_W1 + (size_t)4096 * 1024 * 2;
constexpr size_t WO_RW2 = WO_W2 + (size_t)1024 * 4096 * 2;
constexpr size_t WO_RA2 = WO_RW2 + (size_t)2 * 256 * 64 * 2;
constexpr size_t WO_RG2 = WO_RA2 + (size_t)2 * 256 * 64 * 2;
constexpr size_t W_LAYER = al256(WO_RG2 + (size_t)256 * 128 * 2);
constexpr size_t OFF_R1 = OFF_W + 2 * W_LAYER;
constexpr size_t SZ_Q = (size_t)NB * 8 * LK * 96 * 2;
constexpr size_t SZ_VT = (size_t)NB * 8 * 64 * LK * 2;
constexpr size_t SZ_R1 = 2 * SZ_Q + SZ_VT;
constexpr size_t OFF_R2 = OFF_R1 + al256(SZ_R1);
constexpr size_t SZ_TOK256 = (size_t)NT * 256 * 2;
constexpr size_t OFF_R3 = OFF_R2 + al256((size_t)NT * ZA * 2);
constexpr size_t OFF_R4 = OFF_R3 + 10 * SZ_TOK256;
constexpr size_t OFF_KR = OFF_R4 + SZ_TOK256;
constexpr size_t OFF_OMLA = OFF_KR + al256((size_t)NT * 32 * 2);
constexpr size_t WS_END = OFF_OMLA + (size_t)NT * 512 * 2;
static_assert(WS_END <= 536870912ull, "workspace map exceeds 4x the largest tensor");
constexpr size_t OFF_HB1 = OFF_R3;
constexpr size_t OFF_HBG = OFF_R1 + (size_t)NT * 1024 * 2;
constexpr size_t OFF_HB2 = OFF_R3 + 5 * SZ_TOK256;
enum { SA_R = 0, SA_V = 1, SA_KDF = 2, SA_KDB = 3, SA_G = 4, SA_KKN = 5, SA_OMWF = 6, SA_BF = 7, SA_OMWB = 8, SA_BB = 9 };

struct Params { const float* in[34]; float* out; char* ws; };

enum { I_X = 0, I_C, I_CTX, I_CCTX, I_N1G, I_N2G, I_WADA, I_BADA, I_WIN, I_POOLW, I_POOLS, I_QNORM, I_WUQ, I_KVNORM, I_WUKV,
       I_GQ, I_GK, I_MU, I_W0, I_W2R, I_A0, I_A2R, I_KA, I_KK, I_RK, I_G2R, I_LNW, I_LNB, I_BRP, I_BRM, I_BRR, I_WO, I_W1, I_W2 };

DI float bf2f(u16 h) { return __uint_as_float(((unsigned)h) << 16); }
DI float bflo(unsigned u) { return __uint_as_float(u << 16); }
DI float bfhi(unsigned u) { return __uint_as_float(u & 0xffff0000u); }
DI unsigned pack2(float a, float b) { float2_t v = {a, b}; bf16x2_t r = __builtin_convertvector(v, bf16x2_t); return __builtin_bit_cast(unsigned, r); }
DI u16 f2bf(float a) { return (u16)(pack2(a, 0.f) & 0xffffu); }
DI float sigmoidf_(float x) { return 1.f / (1.f + __expf(-x)); }
DI float siluf_(float x) { return x / (1.f + __expf(-x)); }
DI float rowsum16(float x) {
  x += __builtin_bit_cast(float, __builtin_amdgcn_update_dpp(0, __builtin_bit_cast(int, x), 0x128, 0xf, 0xf, false));
  x += __builtin_bit_cast(float, __builtin_amdgcn_update_dpp(0, __builtin_bit_cast(int, x), 0x124, 0xf, 0xf, false));
  x += __builtin_bit_cast(float, __builtin_amdgcn_update_dpp(0, __builtin_bit_cast(int, x), 0x122, 0xf, 0xf, false));
  x += __builtin_bit_cast(float, __builtin_amdgcn_update_dpp(0, __builtin_bit_cast(int, x), 0x121, 0xf, 0xf, false));
  return x;
}
DI float wavesum(float x) {
  x = rowsum16(x);
  const int xi = __builtin_bit_cast(int, x);
  return __builtin_bit_cast(float, __builtin_amdgcn_readlane(xi, 0)) + __builtin_bit_cast(float, __builtin_amdgcn_readlane(xi, 16)) +
         __builtin_bit_cast(float, __builtin_amdgcn_readlane(xi, 32)) + __builtin_bit_cast(float, __builtin_amdgcn_readlane(xi, 48));
}
DI void grid_barrier(unsigned* ctr, unsigned& epoch) {
  asm volatile("s_waitcnt vmcnt(0)" ::: "memory");
  __syncthreads();
  epoch++;
  if (threadIdx.x == 0) {
    __builtin_amdgcn_fence(__ATOMIC_RELEASE, "agent");
    asm volatile("s_waitcnt vmcnt(0)" ::: "memory");
    const unsigned target = epoch * gridDim.x;
    __hip_atomic_fetch_add(ctr, 1u, __ATOMIC_RELAXED, __HIP_MEMORY_SCOPE_AGENT);
    while (__hip_atomic_load(ctr, __ATOMIC_RELAXED, __HIP_MEMORY_SCOPE_AGENT) < target) __builtin_amdgcn_s_sleep(2);
    __builtin_amdgcn_fence(__ATOMIC_ACQUIRE, "agent");
    asm volatile("s_waitcnt vmcnt(0)" ::: "memory");
  }
  __syncthreads();
}


#define XB_TMO      128
#define XB_XCNT(j)  (256  + 64 * (j))
#define XB_XSUB(j)  (1280 + 64 * (j))
#define XB_XGEN(j)  (2304 + 64 * (j))
#define XB_TOP      3328
#define XB_TOPGEN   3392
#define XB_SPIN_CAP (1u << 22)
#define LAS __attribute__((address_space(3)))
DI unsigned xb_ld(unsigned* p)              { return __hip_atomic_load(p, __ATOMIC_RELAXED, __HIP_MEMORY_SCOPE_AGENT); }
DI unsigned xb_add(unsigned* p, unsigned v) { return __hip_atomic_fetch_add(p, v, __ATOMIC_RELAXED, __HIP_MEMORY_SCOPE_AGENT); }
DI unsigned xb_xcc_id() { return (unsigned)__builtin_amdgcn_s_getreg((3 << 11) | 20) & 0xFu; }
#define XB_SPIN(cond, bar) do { unsigned _sp = 0; while (cond) { __builtin_amdgcn_s_sleep(1); \
    if ((++_sp & 255u) == 0u) { if (xb_ld(&(bar)[XB_TMO])) break; if (_sp > XB_SPIN_CAP) { atomicAdd(&(bar)[XB_TMO], 1u); break; } } } } while (0)
__shared__ uint4 g_xb_words;
__shared__ unsigned long long g_base_sh[2];
DI void xcd_barrier_post(unsigned* bar) {
  const unsigned x = xb_xcc_id();
  if (threadIdx.x == 0) { g_xb_words = make_uint4(0u, 0u, x, 0u); (void)xb_add(&bar[XB_XCNT(x)], 1u); }
}
DI void xcd_barrier_complete(unsigned* bar, unsigned x, unsigned& nloc, unsigned& nx) {
  const unsigned G = gridDim.x;
  unsigned sum, cnt, mine, sp = 0u;
  for (;;) {
    sum = 0u; cnt = 0u; mine = 0u;
#pragma unroll
    for (unsigned j = 0; j < 16; ++j) { const unsigned c = xb_ld(&bar[XB_XCNT(j)]); sum += c; cnt += (c > 0u) ? 1u : 0u; mine = (j == x) ? c : mine; }
    if (sum == G) break;
    __builtin_amdgcn_s_sleep(1);
    if ((++sp & 255u) == 0u) { if (xb_ld(&bar[XB_TMO])) break; if (sp > XB_SPIN_CAP) { atomicAdd(&bar[XB_TMO], 1u); break; } }
  }
  nloc = mine > 0u ? mine : 1u; nx = cnt > 0u ? cnt : 1u;
}
DI void xcd_barrier() {
  asm volatile("s_waitcnt vmcnt(0)" ::: "memory");
  __syncthreads();
  if (threadIdx.x == 0) {
    unsigned* bar = (unsigned*)(g_base_sh[0] + OFF_BAR);
    __builtin_amdgcn_s_waitcnt(0);
    unsigned nloc = g_xb_words.x, nx = g_xb_words.y; const unsigned x = g_xb_words.z;
    if (nloc == 0u) { xcd_barrier_complete(bar, x, nloc, nx); g_xb_words.x = nloc; g_xb_words.y = nx; }
    const unsigned old = xb_add(&bar[XB_XSUB(x)], 1u);
    const unsigned gen = old / nloc;
    if (old + 1u == (gen + 1u) * nloc) {
      __builtin_amdgcn_fence(__ATOMIC_RELEASE, "agent");
      asm volatile("s_waitcnt vmcnt(0)" ::: "memory");
      const unsigned og = xb_add(&bar[XB_TOP], 1u);
      const unsigned tg = og / nx;
      if (og + 1u == (tg + 1u) * nx) xb_add(&bar[XB_TOPGEN], 1u);
      else XB_SPIN(xb_ld(&bar[XB_TOPGEN]) == tg, bar);
      __builtin_amdgcn_fence(__ATOMIC_ACQUIRE, "agent");
      xb_add(&bar[XB_XGEN(x)], 1u);
      asm volatile("s_waitcnt vmcnt(0)" ::: "memory");
    } else {
      XB_SPIN(xb_ld(&bar[XB_XGEN(x)]) == gen, bar);
      __builtin_amdgcn_fence(__ATOMIC_ACQUIRE, "agent");
      asm volatile("s_waitcnt vmcnt(0)" ::: "memory");
    }
  }
  __syncthreads();
}
DI int launder_v(int x) { asm volatile("" : "+v"(x)); return x; }
DI int launder_s(int x) { asm volatile("" : "+s"(x)); return x; }
#define LAUNDER_IDS const int tid__ = launder_v((int)threadIdx.x); const int blk__ = launder_s((int)blockIdx.x); (void)tid__; (void)blk__;
DI void do_transpose(const float* __restrict__ src, int K, int N, u16* __restrict__ dst, const float* __restrict__ ksc, int perm, int tile, float* tl) {
  LAUNDER_IDS
  const int ntn = (N + 63) >> 6;
  const int kt = tile / ntn, nt = tile - kt * ntn;
  const int k0 = kt * 64, n0 = nt * 64;
  const int tid = tid__;
  __syncthreads();
#pragma unroll 4
  for (int i = 0; i < 16; ++i) {
    const int kk = i * 4 + (tid >> 6), nn = tid & 63;
    float v = 0.f;
    if (n0 + nn < N) v = src[(size_t)(k0 + kk) * N + n0 + nn];
    if (ksc) v *= ksc[k0 + kk];
    tl[kk * 65 + nn] = v;
  }
  __syncthreads();
#pragma unroll 4
  for (int i = 0; i < 16; ++i) {
    const int nn = i * 4 + (tid >> 6), kk = tid & 63;
    int n = n0 + nn;
    if (n < N) {
      if (perm) { const int h = n / 96, d = n - h * 96; n = d < 64 ? h * 64 + d : 512 + h * 32 + (d - 64); }
      dst[(size_t)n * K + k0 + kk] = f2bf(tl[kk * 65 + nn]);
    }
  }
}

DI void phase_prep(const Params& p, char* smem) {
  LAUNDER_IDS
  float* tl = (float*)smem;
  const int tid = tid__;
  constexpr int T_WIN = 16 * 81, T_UQ = 6 * 12, T_UKV = 4 * 16, T_BRM = 8 * 16, T_BRR = 4 * 16, T_WO = 16 * 16, T_W1 = 16 * 64, T_W2 = 64 * 16,
                T_RW2 = 4, T_RA2 = 4, T_RG2 = 2 * 4;
  constexpr int T_LAYER = T_WIN + T_UQ + T_UKV + T_BRM + T_BRR + T_WO + T_W1 + T_W2 + 2 * T_RW2 + 2 * T_RA2 + T_RG2;
  for (int g = blk__; g < 2 * T_LAYER; g += gridDim.x) {
    const int l = g / T_LAYER; int t = g - l * T_LAYER;
    char* wl = p.ws + OFF_W + (size_t)l * W_LAYER;
#define JOB(SRC, KK, NN, DSTOFF, SC, PERM, CNT) if (t < (CNT)) { do_transpose((SRC), (KK), (NN), (u16*)(wl + (DSTOFF)), (SC), (PERM), t, tl); continue; } t -= (CNT);
    JOB(p.in[I_WIN] + (size_t)l * 1024 * INC, 1024, INC, WO_WIN, nullptr, 0, T_WIN)
    JOB(p.in[I_WUQ] + (size_t)l * 384 * 768, 384, 768, WO_UQ, p.in[I_QNORM] + l * 384, 1, T_UQ)
    JOB(p.in[I_WUKV] + (size_t)l * 256 * 1024, 256, 1024, WO_UKV, p.in[I_KVNORM] + l * 256, 0, T_UKV)
    JOB(p.in[I_BRM] + (size_t)l * 512 * 1024, 512, 1024, WO_BRM, nullptr, 0, T_BRM)
    JOB(p.in[I_BRR] + (size_t)l * 256 * 1024, 256, 1024, WO_BRR, nullptr, 0, T_BRR)
    JOB(p.in[I_WO] + (size_t)l * 1024 * 1024, 1024, 1024, WO_WO, nullptr, 0, T_WO)
    JOB(p.in[I_W1] + (size_t)l * 1024 * 4096, 1024, 4096, WO_W1, nullptr, 0, T_W1)
    JOB(p.in[I_W2] + (size_t)l * 4096 * 1024, 4096, 1024, WO_W2, nullptr, 0, T_W2)
    JOB(p.in[I_W2R] + (size_t)(l * 2 + 0) * 64 * 256, 64, 256, WO_RW2, nullptr, 0, T_RW2)
    JOB(p.in[I_W2R] + (size_t)(l * 2 + 1) * 64 * 256, 64, 256, WO_RW2 + 256 * 64 * 2, nullptr, 0, T_RW2)
    JOB(p.in[I_A2R] + (size_t)(l * 2 + 0) * 64 * 256, 64, 256, WO_RA2, nullptr, 0, T_RA2)
    JOB(p.in[I_A2R] + (size_t)(l * 2 + 1) * 64 * 256, 64, 256, WO_RA2 + 256 * 64 * 2, nullptr, 0, T_RA2)
    JOB(p.in[I_G2R] + (size_t)l * 128 * 256, 128, 256, WO_RG2, nullptr, 0, T_RG2)
#undef JOB
  }
  for (int e = blk__ * 256 + tid; e < 2 * 256 * 1024; e += gridDim.x * 256) {
    const int l = e >> 18, r = e & 262143, cin = r >> 10, n = r & 1023, g = cin >> 6, c = cin & 63;
    const float* pw = p.in[I_POOLW] + ((size_t)(l * 4 + g) * 64 + c) * 64;
    const float* ps = p.in[I_POOLS] + l * 256 + g * 64;
    const float* wb = p.in[I_BRP] + ((size_t)l * 256 + g * 64) * 1024 + n;
    float s = 0.f;
    for (int d = 0; d < 64; ++d) s += pw[d] * ps[d] * wb[(size_t)d * 1024];
    ((u16*)(p.ws + OFF_W + (size_t)l * W_LAYER + WO_BRP))[(size_t)n * 256 + cin] = f2bf(s);
  }
  if (blk__ == gridDim.x - 1) {
    for (int e = tid; e < 512; e += 256) {
      const int pos = e >> 3, f = e & 7;
      const float inv = powf(10000.f, -(float)f / 8.f);
      const float ang = (float)pos * inv;
      float* rt = (float*)(p.ws + OFF_ROPE);
      rt[e * 2] = cosf(ang); rt[e * 2 + 1] = sinf(ang);
    }
  }
  {
    float* sl = (float*)smem;
    float* red = sl + 9 * 1024;
    __syncthreads();
    for (int e = tid; e < 9 * 1024; e += 256) {
      const int b = e >> 10, k = e & 1023;
      const float v = b < 8 ? p.in[I_C][b * 1024 + k] : p.in[I_CCTX][k];
      sl[e] = siluf_(v);
    }
    __syncthreads();
    const int wave = tid >> 6, lane = tid & 63;
    for (int it = blk__; it < 192; it += gridDim.x) {
      const int l = it / 96, cg_ = it - l * 96;
      const int col = cg_ * 64 + lane;
      const float* wa = p.in[I_WADA] + (size_t)l * 1024 * 6144 + col;
      float acc[9];
#pragma unroll
      for (int b = 0; b < 9; ++b) acc[b] = 0.f;
#pragma unroll 8
      for (int k = wave * 256; k < wave * 256 + 256; ++k) {
        const float w = wa[(size_t)k * 6144];
#pragma unroll
        for (int b = 0; b < 9; ++b) acc[b] += sl[b * 1024 + k] * w;
      }
#pragma unroll
      for (int b = 0; b < 9; ++b) red[(wave * 9 + b) * 64 + lane] = acc[b];
      __syncthreads();
      for (int e = tid; e < 9 * 64; e += 256) {
        const int b = e >> 6, c = e & 63;
        const float s = red[(0 * 9 + b) * 64 + c] + red[(1 * 9 + b) * 64 + c] + red[(2 * 9 + b) * 64 + c] + red[(3 * 9 + b) * 64 + c];
        ((float*)(p.ws + OFF_MODS))[(size_t)(l * 9 + b) * 6144 + cg_ * 64 + c] = s + p.in[I_BADA][l * 6144 + cg_ * 64 + c];
      }
      __syncthreads();
    }
  }
}

DI const float* xrow(const float* xl, const float* xc, int r) { return r < NTL ? xl + (size_t)r * D : xc + (size_t)(r - NTL) * D; }

DI void phase_norm(const float* xl, const float* xc, const float* tab  , u16* hb, int M) {
  LAUNDER_IDS
  const int wave = tid__ >> 6, lane = tid__ & 63;
  for (int r = blk__ * 4 + wave; r < M; r += gridDim.x * 4) {
    const float* xp = xrow(xl, xc, r);
    const int b9 = r < NTL ? r >> 12 : 8;
    float4 v[4];
    float s = 0.f;
#pragma unroll
    for (int i = 0; i < 4; ++i) { v[i] = *(const float4*)(xp + i * 256 + lane * 4); s += v[i].x * v[i].x + v[i].y * v[i].y + v[i].z * v[i].z + v[i].w * v[i].w; }
    s = wavesum(s);
    const float rs = rsqrtf(s * (1.f / 1024.f) + 1e-6f);
    const float* t = tab + b9 * 2048;
#pragma unroll
    for (int i = 0; i < 4; ++i) {
      const int k = i * 256 + lane * 4;
      const float4 g = *(const float4*)(t + k), sh = *(const float4*)(t + 1024 + k);
      *(uint2*)(hb + (size_t)r * 1024 + k) = make_uint2(pack2(v[i].x * rs * g.x + sh.x, v[i].y * rs * g.y + sh.y), pack2(v[i].z * rs * g.z + sh.z, v[i].w * rs * g.w + sh.w));
    }
  }
}
DI void phase_tables(const Params& p) {
  LAUNDER_IDS
  const float* mods = (const float*)(p.ws + OFF_MODS);
  float* tab = (float*)(p.ws + OFF_TAB);
  for (int e = blk__ * 256 + tid__; e < 2 * 2 * 9 * 1024; e += gridDim.x * 256) {
    const int k = e & 1023, b9 = (e >> 10) % 9, ln = (e >> 10) / 9, l = ln >> 1, nrm = ln & 1;
    const float g = p.in[nrm ? I_N2G : I_N1G][l * 1024 + k];
    const float sh = mods[(size_t)(l * 9 + b9) * 6144 + (nrm * 3 + 0) * 1024 + k];
    const float sc = mods[(size_t)(l * 9 + b9) * 6144 + (nrm * 3 + 1) * 1024 + k];
    float* t = tab + ((size_t)(l * 2 + nrm) * 9 + b9) * 2048;
    t[k] = g * (1.f + sc); t[1024 + k] = sh;
  }
}

struct LoadBf16 {
  const u16* A; int lda;
  DI void init(int m0) {}
  DI uint4 load(int i, int m0, int k0) const {
    LAUNDER_IDS
    const int tid = tid__, kc = (tid & 7) * 8;
    return *(const uint4*)(A + (size_t)(m0 + (tid >> 3) + i * 32) * lda + k0 + kc);
  }
};
struct LoadNorm {
  const float* xl; const float* xc; const float* rs; const float* tab;
  float r0, r1, r2, r3;
  DI void init(int m0) {
    LAUNDER_IDS
    const int tid = tid__;
    r0 = rs[m0 + (tid >> 3)]; r1 = rs[m0 + (tid >> 3) + 32]; r2 = rs[m0 + (tid >> 3) + 64]; r3 = rs[m0 + (tid >> 3) + 96];
  }
  DI uint4 load(int i, int m0, int k0) const {
    LAUNDER_IDS
    const int tid = tid__, kc = (tid & 7) * 8;
    const int b9 = m0 < NTL ? m0 >> 12 : 8;
    const float* t = tab + b9 * 2048 + k0 + kc;
    const float4 g0 = *(const float4*)t, g1 = *(const float4*)(t + 4), s0 = *(const float4*)(t + 1024), s1 = *(const float4*)(t + 1028);
    const float* xp = xrow(xl, xc, m0 + (tid >> 3)) + k0 + kc + (size_t)i * 32 * D;
    const float4 x0 = *(const float4*)xp, x1 = *(const float4*)(xp + 4);
    const float rr = i == 0 ? r0 : i == 1 ? r1 : i == 2 ? r2 : r3;
    uint4 o;
    o.x = pack2(x0.x * rr * g0.x + s0.x, x0.y * rr * g0.y + s0.y);
    o.y = pack2(x0.z * rr * g0.z + s0.z, x0.w * rr * g0.w + s0.w);
    o.z = pack2(x1.x * rr * g1.x + s1.x, x1.y * rr * g1.y + s1.y);
    o.w = pack2(x1.z * rr * g1.z + s1.z, x1.w * rr * g1.w + s1.w);
    return o;
  }
};

DI bool tile_map(int it, int NTM, int NTN, int blk, int nblk, int& tm, int& tn) {
  const int xcd = blk & 7, local = blk >> 3, LB = nblk >> 3;
  const int R = NTM >> 3;
  const int s = it * LB + local;
  if (s >= R * NTN) return false;
  const int F = R >> 3, per_full = 8 * NTN;
  int mg, r, gm;
  if (s < F * per_full) { mg = s / per_full; r = s - mg * per_full; gm = 8; }
  else { mg = F; r = s - F * per_full; gm = R - F * 8; }
  const int ng = r / (gm * 8);
  const int r2 = r - ng * gm * 8;
  const int mi = r2 % gm, ni = r2 / gm;
  tm = xcd * R + mg * 8 + mi; tn = ng * 8 + ni;
  return true;
}
constexpr int LDT = 72;
template <int NI, class LA>
DI void gemm_mainloop(f32x4 (&acc)[4][NI], LA la, const u16* __restrict__ Bt, int ldb, int K, int m0, int n0, char* smem) {
  LAUNDER_IDS
  constexpr int NBI = NI;
  u16* As = (u16*)smem; u16* Bs = As + 2 * 128 * LDT;
  const int tid = tid__, lane = tid & 63, wave = tid >> 6, wr = wave >> 1, wc = wave & 1, lr = lane & 15, lq = lane >> 4;
  uint4 ra[4], rb[NBI];
  la.init(m0);
#pragma unroll
  for (int i = 0; i < 4; ++i) ra[i] = la.load(i, m0, 0);
#pragma unroll
  for (int i = 0; i < NBI; ++i) {
    const int c = tid + i * 256, row = c >> 3, kc = (c & 7) * 8;
    rb[i] = *(const uint4*)(Bt + (size_t)(n0 + row) * ldb + kc);
  }
#pragma unroll
  for (int i = 0; i < 4; ++i) {
    const int c = tid + i * 256, row = c >> 3, kc = (c & 7) * 8;
    *(uint4*)(As + row * LDT + kc) = ra[i];
    if (i < NBI) *(uint4*)(Bs + row * LDT + kc) = rb[i];
  }
  __syncthreads();
  const int nk = K >> 6;
  for (int kt = 0; kt < nk; ++kt) {
    const int cur = kt & 1;
    if (kt + 1 < nk) {
      const int k0 = (kt + 1) * 64;
#pragma unroll
      for (int i = 0; i < 4; ++i) ra[i] = la.load(i, m0, k0);
#pragma unroll
      for (int i = 0; i < NBI; ++i) {
        const int c = tid + i * 256, row = c >> 3, kc = (c & 7) * 8;
        rb[i] = *(const uint4*)(Bt + (size_t)(n0 + row) * ldb + k0 + kc);
      }
    }
    const u16* Ac = As + cur * 128 * LDT + (wr * 64 + lr) * LDT + lq * 8;
    const u16* Bc = Bs + cur * 128 * LDT + (wc * 16 * NI + lr) * LDT + lq * 8;
#pragma unroll
    for (int ks = 0; ks < 2; ++ks) {
      bf16x8 af[4], bfr[NI];
#pragma unroll
      for (int mi = 0; mi < 4; ++mi) af[mi] = *(const bf16x8*)(Ac + mi * 16 * LDT + ks * 32);
#pragma unroll
      for (int ni = 0; ni < NI; ++ni) bfr[ni] = *(const bf16x8*)(Bc + ni * 16 * LDT + ks * 32);
#pragma unroll
      for (int mi = 0; mi < 4; ++mi)
#pragma unroll
        for (int ni = 0; ni < NI; ++ni)
          acc[mi][ni] = __builtin_amdgcn_mfma_f32_16x16x32_bf16(bfr[ni], af[mi], acc[mi][ni], 0, 0, 0);
    }
    if (kt + 1 < nk) {
      const int nxt = cur ^ 1;
#pragma unroll
      for (int i = 0; i < 4; ++i) {
        const int c = tid + i * 256, row = c >> 3, kc = (c & 7) * 8;
        *(uint4*)(As + nxt * 128 * LDT + row * LDT + kc) = ra[i];
        if (i < NBI) *(uint4*)(Bs + nxt * 128 * LDT + row * LDT + kc) = rb[i];
      }
    }
    __syncthreads();
  }
}
template <int NI>
DI void zero_acc(f32x4 (&acc)[4][NI]) {
#pragma unroll
  for (int i = 0; i < 4; ++i)
#pragma unroll
    for (int j = 0; j < NI; ++j) acc[i][j] = f32x4{0.f, 0.f, 0.f, 0.f};
}
template <int MI, int NI>
DI void gemm256(f32x4 (&acc)[MI][NI], const u16* __restrict__ A, int lda, const u16* __restrict__ Bt, int ldb, int K, int m0, int n0, char* smem) {
  LAUNDER_IDS
  const int lane = tid__ & 63, wave = tid__ >> 6, wr = wave >> 1, wc = wave & 1, lr = lane & 15, lq = lane >> 4;
  constexpr int NAW = MI / 2;
  constexpr int NBW = NI / 2;
  constexpr int ABYTES = MI * 2 * 1024;
  constexpr int STAGE = ABYTES + NI * 2 * 1024;
  constexpr int LPS = NAW + NBW;
  static_assert(3 * STAGE <= 73728, "ring does not fit");
  const int srow = lane >> 2, scol = ((lane & 3) ^ ((lane >> 5) << 1)) * 8;
  const u16* Ag = A + (size_t)(m0 + wave * NAW * 16 + srow) * lda + scol;
  const u16* Bg = Bt + (size_t)(n0 + wave * NBW * 16 + srow) * ldb + scol;
  char* la = smem + (wave * NAW) * 1024 + lane * 16;
  char* lb = smem + ABYTES + (wave * NBW) * 1024 + lane * 16;
#define G256_ISSUE(S, K0) do { \
    _Pragma("unroll") for (int j_ = 0; j_ < NAW; ++j_) \
      __builtin_amdgcn_global_load_lds((const unsigned*)(Ag + (size_t)j_ * 16 * lda + (K0)), (__attribute__((address_space(3))) unsigned*)(la + (S) * STAGE + j_ * 1024), 16, 0, 0); \
    _Pragma("unroll") for (int j_ = 0; j_ < NBW; ++j_) \
      __builtin_amdgcn_global_load_lds((const unsigned*)(Bg + (size_t)j_ * 16 * ldb + (K0)), (__attribute__((address_space(3))) unsigned*)(lb + (S) * STAGE + j_ * 1024), 16, 0, 0); \
  } while (0)
  const int nk = K >> 5;
  G256_ISSUE(0, 0);
  if (nk > 1) G256_ISSUE(1, 32);
  const int foff = lr * 64 + ((lq ^ ((lr >> 3) << 1)) * 16);
  int st = 0;
  for (int kt = 0; kt < nk; ++kt) {
    if (kt + 1 < nk) asm volatile("s_waitcnt vmcnt(%0) lgkmcnt(0)" :: "n"(LPS) : "memory");
    else asm volatile("s_waitcnt vmcnt(0) lgkmcnt(0)" ::: "memory");
    __builtin_amdgcn_s_barrier();
    if (kt + 2 < nk) { const int s2 = st >= 1 ? st - 1 : 2; G256_ISSUE(s2, (kt + 2) * 32); }
    const char* sb = smem + st * STAGE + foff;
    bf16x8 af[MI], bfr[NI];
#pragma unroll
    for (int mi = 0; mi < MI; ++mi) af[mi] = *(const bf16x8*)(sb + (wr * MI + mi) * 1024);
#pragma unroll
    for (int ni = 0; ni < NI; ++ni) bfr[ni] = *(const bf16x8*)(sb + ABYTES + (wc * NI + ni) * 1024);
#pragma unroll
    for (int mi = 0; mi < MI; ++mi)
#pragma unroll
      for (int ni = 0; ni < NI; ++ni)
        acc[mi][ni] = __builtin_amdgcn_mfma_f32_16x16x32_bf16(bfr[ni], af[mi], acc[mi][ni], 0, 0, 0);
    st = st == 2 ? 0 : st + 1;
  }
  asm volatile("s_waitcnt lgkmcnt(0)" ::: "memory");
  __builtin_amdgcn_s_barrier();
#undef G256_ISSUE
}
template <int MI, int NI>
DI void zero_accm(f32x4 (&acc)[MI][NI]) {
#pragma unroll
  for (int i = 0; i < MI; ++i)
#pragma unroll
    for (int j = 0; j < NI; ++j) acc[i][j] = f32x4{0.f, 0.f, 0.f, 0.f};
}
#define EPI_BEGIN const int lr1_ = launder_v(lr), lq1_ = launder_v(lq), wr1_ = launder_v(wr), wc1_ = launder_v(wc); { const int lr = lr1_, lq = lq1_, wr = wr1_, wc = wc1_; (void)lr; (void)lq; (void)wr; (void)wc;
#define EPI_END }
#define WAVE_COORDS const int lane = tid__ & 63, wave = tid__ >> 6, wr = wave >> 1, wc = wave & 1, lr = lane & 15, lq = lane >> 4; (void)wr; (void)wc; (void)lr; (void)lq;

DI void phase_zgemm(const Params& p, int l, char* smem) {
  LAUNDER_IDS
  WAVE_COORDS
  const u16* Wt = (const u16*)(p.ws + OFF_W + (size_t)l * W_LAYER + WO_WIN);
  const u16* hb = (const u16*)(p.ws + OFF_HB1);
  u16* za = (u16*)(p.ws + OFF_R2); u16* zr = (u16*)(p.ws + OFF_R1);
  for (int it = 0;; ++it) {
    int tm, tn;
    if (!tile_map(it, NT / 256, 17, blk__, gridDim.x, tm, tn)) break;
    const int m0 = tm * 256, n0 = tn * 128;
    f32x4 acc[8][4]; zero_accm<8, 4>(acc);
    gemm256<8, 4>(acc, hb, 1024, Wt, 1024, 1024, m0, n0, smem);
    EPI_BEGIN
#pragma unroll
    for (int mi = 0; mi < 8; ++mi) {
      const int m = m0 + wr * 128 + mi * 16 + lr;
#pragma unroll
      for (int ni = 0; ni < 4; ++ni) {
        const int n = n0 + wc * 64 + ni * 16 + lq * 4;
        uint2 v; v.x = pack2(acc[mi][ni][0], acc[mi][ni][1]); v.y = pack2(acc[mi][ni][2], acc[mi][ni][3]);
        if (n < ZA) *(uint2*)(za + (size_t)m * ZA + n) = v;
        else if (n < ZA + ZR) *(uint2*)(zr + (size_t)m * ZR + (n - ZA)) = v;
      }
    }
    EPI_END
  }
}

DI void phase_tokA(const Params& p, int l) {
  LAUNDER_IDS
  const int wave = tid__ >> 6, lane = tid__ & 63;
  const u16* za = (const u16*)(p.ws + OFF_R2);
  float* rsq = (float*)(p.ws + OFF_RSQ); float* rskv = (float*)(p.ws + OFF_RSKV);
  u16* krb = (u16*)(p.ws + OFF_KR);
  u16* pooled = (u16*)(p.ws + OFF_R4);
  const float* rt = (const float*)(p.ws + OFF_ROPE);
  const float* gk = p.in[I_GK] + l * 96;
  for (int r = blk__ * 4 + wave; r < NT; r += gridDim.x * 4) {
    const u16* z = za + (size_t)r * ZA;
    const bool lat = r < NTL;
    const int b = lat ? r >> 12 : (r - NTL) >> 8;
    const int t = lat ? r & 4095 : (r - NTL) & 255;
    const int Ls = lat ? L : LC;
    const int pos = lat ? t : 4096 + t;
    float sq = 0.f, skv = 0.f;
#pragma unroll
    for (int i = 0; i < 6; ++i) { const float v = bf2f(z[256 + i * 64 + lane]); sq += v * v; }
#pragma unroll
    for (int i = 0; i < 4; ++i) { const float v = bf2f(z[640 + i * 64 + lane]); skv += v * v; }
    sq = wavesum(sq); skv = wavesum(skv);
    if (lane == 0) { rsq[r] = rsqrtf(sq * (1.f / 384.f) + 1e-6f); rskv[r] = rsqrtf(skv * (1.f / 256.f) + 1e-6f); }
    {
      const int d = lane & 31;
      float kr = bf2f(z[896 + d]);
      float ss = rowsum16(kr * kr);
      { const int si = __builtin_bit_cast(int, ss);
        ss = __builtin_bit_cast(float, __builtin_amdgcn_readlane(si, 0)) + __builtin_bit_cast(float, __builtin_amdgcn_readlane(si, 16)); }
      kr = kr * rsqrtf(ss * (1.f / 32.f) + 1e-6f) * gk[64 + d];
      const float other = __shfl_xor(kr, 16, 64);
      float outv = kr;
      if (lat) {
        const int i = d & 15;
        const int pp = i < 8 ? (t >> 6) : (t & 63);
        const float cs = rt[(pp * 8 + (i & 7)) * 2], sn = rt[(pp * 8 + (i & 7)) * 2 + 1];
        outv = d < 16 ? kr * cs - other * sn : other * sn + kr * cs;
      }
      if (lane < 32) krb[(size_t)r * 32 + d] = f2bf(outv);
    }
#pragma unroll
    for (int gi = 0; gi < 4; ++gi) {
      const int half = 1 << gi;
      const int lo = max(t - half, 0), hi = min(t + half, Ls);
      const int ch = gi * 64 + lane;
      float s = 0.f;
#pragma unroll
      for (int j = 0; j < 2 * half; ++j) {
        const int q = t - half + j;
        const int qc = min(max(q, 0), Ls - 1);
        const float v = bf2f(z[(ptrdiff_t)(qc - t) * ZA + ch]);
        s += (q == qc) ? v : 0.f;
      }
      const float mean = s / (float)(hi - lo);
      pooled[(size_t)r * 256 + ch] = f2bf(mean - bf2f(z[ch]));
    }
  }
}

constexpr int ZSL = 1160, TAL = 392;
DI void phase_tokB(const Params& p, int l, char* smem) {
  LAUNDER_IDS
  WAVE_COORDS
  const int tid = tid__;
  u16* Zs = (u16*)smem;
  u16* TA = Zs + 18 * ZSL;
  float* PV = (float*)(TA + 16 * TAL);
  const u16* zr = (const u16*)(p.ws + OFF_R1);
  const char* wl = p.ws + OFF_W + (size_t)l * W_LAYER;
  u16* sc = (u16*)(p.ws + OFF_R3);
  __syncthreads();
  for (int e = tid; e < 2 * ZR + 7 * 256; e += 256) {
    float v;
    if (e < 2 * ZR) v = p.in[I_MU][(size_t)l * 2 * ZR + e];
    else { const int f = e - 2 * ZR, a = f >> 8, c = f & 255;
      v = a == 0 ? p.in[I_KK][l * 256 + c] : a < 3 ? p.in[I_W0][(size_t)(l * 2 + a - 1) * 256 + c] : a < 5 ? p.in[I_A0][(size_t)(l * 2 + a - 3) * 256 + c] : p.in[I_KA][(size_t)(l * 2 + a - 5) * 256 + c]; }
    PV[e] = v;
  }
  const float* mu0 = PV; const float* mu1 = PV + ZR; const float* kkw = PV + 2 * ZR;
  const float* w0p = kkw + 256; const float* a0p = w0p + 512; const float* kap = a0p + 512;
  for (int tile = blk__; tile < NT / 16; tile += gridDim.x) {
    const int r0 = tile * 16;
    const bool lat = r0 < NTL;
    const int t0 = lat ? r0 & 4095 : (r0 - NTL) & 255;
    const int Ls = lat ? L : LC;
    __syncthreads();
    {
      uint4 v[11];
#pragma unroll
      for (int i = 0; i < 11; ++i) {
        const int c = tid + i * 256;
        const int ri = c / 144, ch = c - ri * 144;
        const int tt = t0 - 1 + ri;
        const int cc = min(c, 18 * 144 - 1);
        const int rc = cc / 144, chc = cc - rc * 144;
        const int ttc = min(max(t0 - 1 + rc, 0), Ls - 1);
        const uint4 ld = *(const uint4*)(zr + (size_t)(r0 - t0 + ttc) * ZR + chc * 8);
        const bool ok = (c < 18 * 144) && (tt >= 0) && (tt < Ls);
        v[i] = ok ? ld : make_uint4(0, 0, 0, 0);
      }
#pragma unroll
      for (int i = 0; i < 11; ++i) {
        const int c = tid + i * 256;
        const int ri = c / 144, ch = c - ri * 144;
        if (c < 18 * 144) {
          *(uint2*)(Zs + ri * ZSL + ch * 8) = make_uint2(v[i].x, v[i].y);
          *(uint2*)(Zs + ri * ZSL + ch * 8 + 4) = make_uint2(v[i].z, v[i].w);
        }
      }
    }
    __syncthreads();
#pragma unroll 4
    for (int e = tid; e < 16 * 384; e += 256) {
      const int i = e / 384, c = e - i * 384, zc = 768 + c;
      const float z = bf2f(Zs[(i + 1) * ZSL + zc]), zp = bf2f(Zs[i * ZSL + zc]), zn = bf2f(Zs[(i + 2) * ZSL + zc]);
      float v = z + mu0[zc] * (zp - z) + mu1[zc] * (zn - z);
      if (c < 128) v = 1.f - 2.f / (1.f + __expf(2.f * v)); else if (c >= 256) v = sigmoidf_(v);
      TA[i * TAL + c] = f2bf(v);
    }
    __syncthreads();
    const int row = r0 + lr;
    auto shifted4 = [&](int zc, float (&out)[4]) {
      const uint2 c0 = *(const uint2*)(Zs + (lr + 1) * ZSL + zc), cp = *(const uint2*)(Zs + lr * ZSL + zc), cn = *(const uint2*)(Zs + (lr + 2) * ZSL + zc);
      const float4 m0 = *(const float4*)(mu0 + zc), m1 = *(const float4*)(mu1 + zc);
      float z, zp, zn;
      z = bflo(c0.x); zp = bflo(cp.x); zn = bflo(cn.x); out[0] = z + m0.x * (zp - z) + m1.x * (zn - z);
      z = bfhi(c0.x); zp = bfhi(cp.x); zn = bfhi(cn.x); out[1] = z + m0.y * (zp - z) + m1.y * (zn - z);
      z = bflo(c0.y); zp = bflo(cp.y); zn = bflo(cn.y); out[2] = z + m0.z * (zp - z) + m1.z * (zn - z);
      z = bfhi(c0.y); zp = bfhi(cp.y); zn = bfhi(cn.y); out[3] = z + m0.w * (zp - z) + m1.w * (zn - z);
    };
    auto product128 = [&](f32x4 (&ac)[4], const u16* W, int off) {
      bf16x8 aop[4][4];
#pragma unroll
      for (int ks = 0; ks < 4; ++ks)
#pragma unroll
        for (int ni = 0; ni < 4; ++ni) aop[ks][ni] = *(const bf16x8*)(W + (size_t)(wave * 64 + ni * 16 + lr) * 128 + ks * 32 + lq * 8);
#pragma unroll
      for (int ni = 0; ni < 4; ++ni) ac[ni] = f32x4{0.f, 0.f, 0.f, 0.f};
#pragma unroll
      for (int ks = 0; ks < 4; ++ks) {
        const bf16x8 bop = *(const bf16x8*)(TA + lr * TAL + off + ks * 32 + lq * 8);
#pragma unroll
        for (int ni = 0; ni < 4; ++ni) ac[ni] = __builtin_amdgcn_mfma_f32_16x16x32_bf16(aop[ks][ni], bop, ac[ni], 0, 0, 0);
      }
      __builtin_amdgcn_sched_barrier(0);
    };
    auto product64x2 = [&](f32x4 (&ac0)[4], f32x4 (&ac1)[4], const u16* W0, const u16* W1, int off0, int off1) {
      bf16x8 a0[2][4], a1[2][4];
#pragma unroll
      for (int ks = 0; ks < 2; ++ks)
#pragma unroll
        for (int ni = 0; ni < 4; ++ni) {
          a0[ks][ni] = *(const bf16x8*)(W0 + (size_t)(wave * 64 + ni * 16 + lr) * 64 + ks * 32 + lq * 8);
          a1[ks][ni] = *(const bf16x8*)(W1 + (size_t)(wave * 64 + ni * 16 + lr) * 64 + ks * 32 + lq * 8);
        }
#pragma unroll
      for (int ni = 0; ni < 4; ++ni) { ac0[ni] = f32x4{0.f, 0.f, 0.f, 0.f}; ac1[ni] = f32x4{0.f, 0.f, 0.f, 0.f}; }
#pragma unroll
      for (int ks = 0; ks < 2; ++ks) {
        const bf16x8 b0 = *(const bf16x8*)(TA + lr * TAL + off0 + ks * 32 + lq * 8);
        const bf16x8 b1 = *(const bf16x8*)(TA + lr * TAL + off1 + ks * 32 + lq * 8);
#pragma unroll
        for (int ni = 0; ni < 4; ++ni) {
          ac0[ni] = __builtin_amdgcn_mfma_f32_16x16x32_bf16(a0[ks][ni], b0, ac0[ni], 0, 0, 0);
          ac1[ni] = __builtin_amdgcn_mfma_f32_16x16x32_bf16(a1[ks][ni], b1, ac1[ni], 0, 0, 0);
        }
      }
      __builtin_amdgcn_sched_barrier(0);
    };
    float ss = 0.f;
#pragma unroll
    for (int ni = 0; ni < 4; ++ni) {
      const int ch = wave * 64 + ni * 16 + lq * 4;
      float kx[4]; shifted4(256 + ch, kx);
      const float4 kw = *(const float4*)(kkw + ch);
      const float a0 = kx[0] * kw.x, a1 = kx[1] * kw.y, a2 = kx[2] * kw.z, a3 = kx[3] * kw.w;
      ss += a0 * a0 + a1 * a1 + a2 * a2 + a3 * a3;
    }
    ss += __shfl_xor(ss, 16, 64); ss += __shfl_xor(ss, 32, 64);
    const float kinv = rsqrtf(fmaxf(ss, 1e-24f));
    {
      f32x4 ag[4];
      product128(ag, (const u16*)(wl + WO_RG2), 256);
#pragma unroll
      for (int ni = 0; ni < 4; ++ni) {
        const int ch = wave * 64 + ni * 16 + lq * 4;
        const size_t o = (size_t)row * 256 + ch;
        float rx[4], kx[4], vx[4];
        shifted4(ch, rx); shifted4(256 + ch, kx); shifted4(512 + ch, vx);
        const float4 kw = *(const float4*)(kkw + ch);
        *(uint2*)(sc + SA_R * (size_t)NT * 256 + o) = make_uint2(pack2(rx[0], rx[1]), pack2(rx[2], rx[3]));
        *(uint2*)(sc + SA_V * (size_t)NT * 256 + o) = make_uint2(pack2(vx[0], vx[1]), pack2(vx[2], vx[3]));
        *(uint2*)(sc + SA_KKN * (size_t)NT * 256 + o) = make_uint2(pack2(-kx[0] * kw.x * kinv, -kx[1] * kw.y * kinv), pack2(-kx[2] * kw.z * kinv, -kx[3] * kw.w * kinv));
        *(uint2*)(sc + SA_G * (size_t)NT * 256 + o) = make_uint2(pack2(ag[ni][0], ag[ni][1]), pack2(ag[ni][2], ag[ni][3]));
        __builtin_amdgcn_sched_barrier(0);
      }
    }
#pragma unroll 1
    for (int d = 0; d < 2; ++d) {
      f32x4 aw[4], aa[4];
      product64x2(aw, aa, (const u16*)(wl + WO_RW2) + (size_t)d * 256 * 64, (const u16*)(wl + WO_RA2) + (size_t)d * 256 * 64, d * 64, 128 + d * 64);
      u16* oOMW = sc + (d ? SA_OMWB : SA_OMWF) * (size_t)NT * 256;
      u16* oKD = sc + (d ? SA_KDB : SA_KDF) * (size_t)NT * 256;
      u16* oB = sc + (d ? SA_BB : SA_BF) * (size_t)NT * 256;
#pragma unroll
      for (int ni = 0; ni < 4; ++ni) {
        const int ch = wave * 64 + ni * 16 + lq * 4;
        const size_t o = (size_t)row * 256 + ch;
        float kx[4]; shifted4(256 + ch, kx);
        const float4 kw = *(const float4*)(kkw + ch);
        const float kkn[4] = {kx[0] * kw.x * kinv, kx[1] * kw.y * kinv, kx[2] * kw.z * kinv, kx[3] * kw.w * kinv};
        const float4 w0 = *(const float4*)(w0p + d * 256 + ch);
        const float4 a0 = *(const float4*)(a0p + d * 256 + ch);
        const float4 ka = *(const float4*)(kap + d * 256 + ch);
        const float w0a[4] = {w0.x, w0.y, w0.z, w0.w}, a0a[4] = {a0.x, a0.y, a0.z, a0.w}, kaa[4] = {ka.x, ka.y, ka.z, ka.w};
        float omw[4], kd[4], bb[4];
#pragma unroll
        for (int j = 0; j < 4; ++j) {
          const float xw = -(w0a[j] + aw[ni][j]);
          const float sp = fmaxf(xw, 0.f) + __logf(1.f + __expf(-fabsf(xw)));
          const float wlog = -sp - 0.5f;
          const float e = __expf(wlog);
          omw[j] = 1.f - __expf(-e);
          const float a = sigmoidf_(a0a[j] + aa[ni][j]);
          kd[j] = kx[j] * (1.f + (a - 1.f) * kaa[j]);
          bb[j] = kkn[j] * a;
        }
        *(uint2*)(oOMW + o) = make_uint2(pack2(omw[0], omw[1]), pack2(omw[2], omw[3]));
        *(uint2*)(oKD + o) = make_uint2(pack2(kd[0], kd[1]), pack2(kd[2], kd[3]));
        *(uint2*)(oB + o) = make_uint2(pack2(bb[0], bb[1]), pack2(bb[2], bb[3]));
        __builtin_amdgcn_sched_barrier(0);
      }
    }
  }
}

DI size_t qk_index(int m, int h) {
  const bool lat = m < NTL;
  const int b = lat ? m >> 12 : (m - NTL) >> 8;
  const int pos = lat ? m & 4095 : 4096 + ((m - NTL) & 255);
  return ((size_t)(b * 8 + h) * LK + pos) * 96;
}
DI void phase_qkv(const Params& p, int l, char* smem) {
  LAUNDER_IDS
  WAVE_COORDS
  const char* wl = p.ws + OFF_W + (size_t)l * W_LAYER;
  const u16* za = (const u16*)(p.ws + OFF_R2);
  const float* rsq0 = (const float*)(p.ws + OFF_RSQ); const float* rskv0 = (const float*)(p.ws + OFF_RSKV);
  u16* Qb = (u16*)(p.ws + OFF_R1); u16* Kb = (u16*)(p.ws + OFF_R1 + SZ_Q); u16* Vt = (u16*)(p.ws + OFF_R1 + 2 * SZ_Q);
  const float* rt0 = (const float*)(p.ws + OFF_ROPE);
  const float* gq0 = p.in[I_GQ] + l * 96; const float* gk0 = p.in[I_GK] + l * 96;
  const float QS = 0.10206207261596577f * 1.4426950408889634f;
  constexpr int NTM = NT / 256;
  for (int it = 0;; ++it) {
    int tm, tn;
    if (!tile_map(it, NTM, 6, blk__, gridDim.x, tm, tn)) break;
    f32x4 acc[8][4]; zero_accm<8, 4>(acc);
    {
      const int m0 = tm * 256, n0 = tn * 128;
      gemm256<8, 4>(acc, za + 256, ZA, (const u16*)(wl + WO_UQ), 384, 384, m0, n0, smem);
      EPI_BEGIN
      const float* gq = gq0; const float* rt = rt0; const float* rsq = rsq0;
      asm volatile("" : "+v"(gq), "+v"(rt), "+v"(rsq));
      const int nw = n0 + wc * 64;
#pragma unroll
      for (int mi = 0; mi < 8; ++mi) {
        __builtin_amdgcn_sched_barrier(0);
        const int m = m0 + wr * 128 + mi * 16 + lr;
        const float rs = rsq[m];
        if (nw < 512) {
          const int h = nw >> 6;
          float ss = 0.f;
#pragma unroll
          for (int ni = 0; ni < 4; ++ni)
#pragma unroll
            for (int j = 0; j < 4; ++j) { const float v = acc[mi][ni][j] * rs; ss += v * v; }
          ss += __shfl_xor(ss, 16, 64); ss += __shfl_xor(ss, 32, 64);
          const float f = rs * rsqrtf(ss * (1.f / 64.f) + 1e-6f) * QS;
          u16* dst = Qb + qk_index(m, h);
#pragma unroll
          for (int ni = 0; ni < 4; ++ni) {
            const int d = ni * 16 + lq * 4;
            const float4 g = *(const float4*)(gq + d);
            *(uint2*)(dst + d) = make_uint2(pack2(acc[mi][ni][0] * f * g.x, acc[mi][ni][1] * f * g.y), pack2(acc[mi][ni][2] * f * g.z, acc[mi][ni][3] * f * g.w));
          }
        } else {
          const bool lat = m < NTL;
          const int tt = m & 4095;
#pragma unroll
          for (int hh = 0; hh < 2; ++hh) {
            __builtin_amdgcn_sched_barrier(0);
            const int h = ((nw - 512) >> 5) + hh;
            float ss = 0.f;
#pragma unroll
            for (int ni = 0; ni < 2; ++ni)
#pragma unroll
              for (int j = 0; j < 4; ++j) { const float v = acc[mi][hh * 2 + ni][j] * rs; ss += v * v; }
            ss += __shfl_xor(ss, 16, 64); ss += __shfl_xor(ss, 32, 64);
            const float f = rs * rsqrtf(ss * (1.f / 32.f) + 1e-6f) * QS;
            const int i0 = lq * 4;
            const float4 g1 = *(const float4*)(gq + 64 + i0), g2 = *(const float4*)(gq + 80 + i0);
            const float g1a[4] = {g1.x, g1.y, g1.z, g1.w}, g2a[4] = {g2.x, g2.y, g2.z, g2.w};
            float o1[4], o2[4];
#pragma unroll
            for (int j = 0; j < 4; ++j) {
              const float x1 = acc[mi][hh * 2][j] * f * g1a[j], x2 = acc[mi][hh * 2 + 1][j] * f * g2a[j];
              float cs = 1.f, sn = 0.f;
              if (lat) {
                const int i = i0 + j;
                const int pp = i < 8 ? (tt >> 6) : (tt & 63);
                cs = rt[(pp * 8 + (i & 7)) * 2]; sn = rt[(pp * 8 + (i & 7)) * 2 + 1];
              }
              o1[j] = x1 * cs - x2 * sn; o2[j] = x1 * sn + x2 * cs;
            }
            u16* dst = Qb + qk_index(m, h) + 64;
            *(uint2*)(dst + i0) = make_uint2(pack2(o1[0], o1[1]), pack2(o1[2], o1[3]));
            *(uint2*)(dst + 16 + i0) = make_uint2(pack2(o2[0], o2[1]), pack2(o2[2], o2[3]));
          }
        }
      }
      EPI_END
    }
  }
  __builtin_amdgcn_sched_barrier(0);
  for (int it = 0;; ++it) {
    int tm, tn;
    if (!tile_map(it, NTM, 8, blk__, gridDim.x, tm, tn)) break;
    f32x4 acc[8][4]; zero_accm<8, 4>(acc);
    {
      const int h = tn, m0 = tm * 256, n0 = h * 128;
      gemm256<8, 4>(acc, za + 640, ZA, (const u16*)(wl + WO_UKV), 256, 256, m0, n0, smem);
      EPI_BEGIN
      const float* gk = gk0; const float* rskv = rskv0;
      asm volatile("" : "+v"(gk), "+v"(rskv));
#pragma unroll
      for (int mi = 0; mi < 8; ++mi) {
        __builtin_amdgcn_sched_barrier(0);
        const int m = m0 + wr * 128 + mi * 16 + lr;
        const float rs = rskv[m];
        if (wc == 0) {
          float ss = 0.f;
#pragma unroll
          for (int ni = 0; ni < 4; ++ni)
#pragma unroll
            for (int j = 0; j < 4; ++j) { const float v = acc[mi][ni][j] * rs; ss += v * v; }
          ss += __shfl_xor(ss, 16, 64); ss += __shfl_xor(ss, 32, 64);
          const float f = rs * rsqrtf(ss * (1.f / 64.f) + 1e-6f);
          u16* dst = Kb + qk_index(m, h);
#pragma unroll
          for (int ni = 0; ni < 4; ++ni) {
            const int d = ni * 16 + lq * 4;
            const float4 g = *(const float4*)(gk + d);
            *(uint2*)(dst + d) = make_uint2(pack2(acc[mi][ni][0] * f * g.x, acc[mi][ni][1] * f * g.y), pack2(acc[mi][ni][2] * f * g.z, acc[mi][ni][3] * f * g.w));
          }
          *(uint4*)(dst + 64 + lq * 8) = *(const uint4*)((const u16*)(p.ws + OFF_KR) + (size_t)m * 32 + lq * 8);
        } else {
          const bool lat = m < NTL;
          const int b = lat ? m >> 12 : (m - NTL) >> 8;
          const int pos = lat ? m & 4095 : 4096 + ((m - NTL) & 255);
          u16* dst = Vt + (size_t)(b * 8 + h) * 64 * LK + pos + (size_t)(lq * 4) * LK;
#pragma unroll
          for (int ni = 0; ni < 4; ++ni) {
            asm volatile("" : "+v"(dst));
#pragma unroll
            for (int j = 0; j < 4; ++j) dst[j * LK] = f2bf(acc[mi][ni][j] * rs);
            dst += 16 * LK;
          }
        }
      }
      EPI_END
    }
  }
}

DI int scan_row(int b, int dir, int s) {
  if (s < LC) return NTL + b * LC + (dir ? LC - 1 - s : s);
  const int t = s - LC;
  return b * L + (dir ? L - 1 - t : t);
}
DI void phase_scan(const Params& p, char* smem) {
  LAUNDER_IDS
  const int blk = blk__;
  if (blk >= 256) return;
  const int tid = tid__, lane = tid & 63, wave = tid >> 6, kq = lane & 15, rg = lane >> 4;
  const int chain = (blk & 7) + 8 * (blk >> 5), quarter = (blk >> 3) & 3;
  const int b = chain >> 3, h = (chain >> 1) & 3, dir = chain & 1;
  const u16* sc = (const u16*)(p.ws + OFF_R3);
  const size_t AS = (size_t)NT * 256;
  const u16* aOMW = sc + (dir ? SA_OMWB : SA_OMWF) * AS;
  const u16* aKD = sc + (dir ? SA_KDB : SA_KDF) * AS;
  const u16* aB = sc + (dir ? SA_BB : SA_BF) * AS;
  const u16* aKKN = sc + SA_KKN * AS;
  const u16* aR = sc + SA_R * AS;
  const u16* aV = sc + SA_V * AS;
  u16* Y = (u16*)(p.ws + OFF_R2) + (dir ? AS : 0);
  constexpr int CH = 16, BSZ = 5 * CH * 64 + CH * 16;
  float* buf = (float*)smem;
  const int st_ld = tid >> 4, k4 = (tid & 15) * 4;
  const int vrow = quarter * 16 + wave * 4 + rg;
  uint2 g0, g1, g2, g3, g4; u16 gv;
#define SCAN_GLOAD(CHUNK) do { \
    const int row_ = scan_row(b, dir, (CHUNK) * CH + st_ld); \
    const size_t o_ = (size_t)row_ * 256 + h * 64 + k4; \
    g0 = *(const uint2*)(aOMW + o_); g1 = *(const uint2*)(aKD + o_); g2 = *(const uint2*)(aB + o_); g3 = *(const uint2*)(aKKN + o_); g4 = *(const uint2*)(aR + o_); \
    gv = aV[(size_t)row_ * 256 + h * 64 + quarter * 16 + (tid & 15)]; } while (0)
#define SCAN_LSTORE(BI) do { \
    float* bb_ = buf + (BI) * BSZ + st_ld * 64 + k4; \
    *(float4*)(bb_ + 0 * CH * 64) = make_float4(1.f - bflo(g0.x), 1.f - bfhi(g0.x), 1.f - bflo(g0.y), 1.f - bfhi(g0.y)); \
    *(float4*)(bb_ + 1 * CH * 64) = make_float4(bflo(g1.x), bfhi(g1.x), bflo(g1.y), bfhi(g1.y)); \
    *(float4*)(bb_ + 2 * CH * 64) = make_float4(bflo(g2.x), bfhi(g2.x), bflo(g2.y), bfhi(g2.y)); \
    *(float4*)(bb_ + 3 * CH * 64) = make_float4(bflo(g3.x), bfhi(g3.x), bflo(g3.y), bfhi(g3.y)); \
    *(float4*)(bb_ + 4 * CH * 64) = make_float4(bflo(g4.x), bfhi(g4.x), bflo(g4.y), bfhi(g4.y)); \
    buf[(BI) * BSZ + 5 * CH * 64 + st_ld * 16 + (tid & 15)] = bf2f(gv); } while (0)
  float2_t S01 = {0.f, 0.f}, S23 = {0.f, 0.f};
  __builtin_amdgcn_s_setprio(3);
  __syncthreads();
  SCAN_GLOAD(0); SCAN_LSTORE(0);
  __syncthreads();
  constexpr int NCH = LK / CH;
  for (int c = 0; c < NCH; ++c) {
    if (c + 1 < NCH) SCAN_GLOAD(c + 1);
    const float* bb = buf + (c & 1) * BSZ;
    const int rowbase = scan_row(b, dir, c * CH);
    const int rstep = dir ? -1 : 1;
    const float* bl = bb + kq * 4;
    const float* bv = bb + 5 * CH * 64 + wave * 4 + rg;
    float4 fw = *(const float4*)(bl + 0 * CH * 64), fk = *(const float4*)(bl + 1 * CH * 64), fb = *(const float4*)(bl + 2 * CH * 64),
           fa = *(const float4*)(bl + 3 * CH * 64), fr = *(const float4*)(bl + 4 * CH * 64);
    float vv = bv[0];
    float ysel = 0.f, ypart = 0.f;
#pragma unroll
    for (int s = 0; s < CH; ++s) {
      const float2_t a01 = {fa.x, fa.y}, a23 = {fa.z, fa.w};
      const float2_t w01 = {fw.x, fw.y}, w23 = {fw.z, fw.w}, k01 = {fk.x, fk.y}, k23 = {fk.z, fk.w}, b01 = {fb.x, fb.y}, b23 = {fb.z, fb.w};
      const float2_t r01 = {fr.x, fr.y}, r23 = {fr.z, fr.w};
      const float2_t vv2 = {vv, vv};
      if (s + 1 < CH) {
        fw = *(const float4*)(bl + 0 * CH * 64 + (s + 1) * 64); fk = *(const float4*)(bl + 1 * CH * 64 + (s + 1) * 64); fb = *(const float4*)(bl + 2 * CH * 64 + (s + 1) * 64);
        fa = *(const float4*)(bl + 3 * CH * 64 + (s + 1) * 64); fr = *(const float4*)(bl + 4 * CH * 64 + (s + 1) * 64);
        vv = bv[(s + 1) * 16];
      }
      float2_t t2 = S01 * a01; t2 = S23 * a23 + t2;
      const float2_t q01 = S01 * w01 + vv2 * k01, q23 = S23 * w23 + vv2 * k23;
      float xs = t2.x + t2.y, ys = ypart;
      xs += __builtin_bit_cast(float, __builtin_amdgcn_update_dpp(0, __builtin_bit_cast(int, xs), 0x128, 0xf, 0xf, false));
      ys += __builtin_bit_cast(float, __builtin_amdgcn_update_dpp(0, __builtin_bit_cast(int, ys), 0x128, 0xf, 0xf, false));
      xs += __builtin_bit_cast(float, __builtin_amdgcn_update_dpp(0, __builtin_bit_cast(int, xs), 0x124, 0xf, 0xf, false));
      ys += __builtin_bit_cast(float, __builtin_amdgcn_update_dpp(0, __builtin_bit_cast(int, ys), 0x124, 0xf, 0xf, false));
      xs += __builtin_bit_cast(float, __builtin_amdgcn_update_dpp(0, __builtin_bit_cast(int, xs), 0x122, 0xf, 0xf, false));
      ys += __builtin_bit_cast(float, __builtin_amdgcn_update_dpp(0, __builtin_bit_cast(int, ys), 0x122, 0xf, 0xf, false));
      xs += __builtin_bit_cast(float, __builtin_amdgcn_update_dpp(0, __builtin_bit_cast(int, xs), 0x121, 0xf, 0xf, false));
      ys += __builtin_bit_cast(float, __builtin_amdgcn_update_dpp(0, __builtin_bit_cast(int, ys), 0x121, 0xf, 0xf, false));
      if (s > 0) ysel = (kq == s - 1) ? ys : ysel;
      const float2_t sa2 = {xs, xs};
      S01 = sa2 * b01 + q01; S23 = sa2 * b23 + q23;
      float2_t y2 = S01 * r01; y2 = S23 * r23 + y2;
      ypart = y2.x + y2.y;
    }
    { const float yl = rowsum16(ypart); ysel = (kq == CH - 1) ? yl : ysel; }
    Y[(size_t)(rowbase + rstep * kq) * 256 + h * 64 + vrow] = f2bf(ysel);
    if (c + 1 < NCH) SCAN_LSTORE((c + 1) & 1);
    __syncthreads();
  }
  __builtin_amdgcn_s_setprio(0);
#undef SCAN_GLOAD
#undef SCAN_LSTORE
}

constexpr int KSL = 104, VSL = 68;
template <int B0>
DI bf16x8 pack8(const f32x16& v) {
  uint4 pw;
  pw.x = pack2(v[B0 + 0], v[B0 + 1]); pw.y = pack2(v[B0 + 2], v[B0 + 3]); pw.z = pack2(v[B0 + 4], v[B0 + 5]); pw.w = pack2(v[B0 + 6], v[B0 + 7]);
  return __builtin_bit_cast(bf16x8, pw);
}
DI void pv_step(f32x16& o0, f32x16& o1, const u16* Vc, int r32, int kb, bf16x8 pf) {
  {
    const uint2 lo = *(const uint2*)(Vc + r32 * VSL + kb), hi2 = *(const uint2*)(Vc + r32 * VSL + kb + 8);
    const bf16x8 va = __builtin_bit_cast(bf16x8, make_uint4(lo.x, lo.y, hi2.x, hi2.y));
    o0 = __builtin_amdgcn_mfma_f32_32x32x16_bf16(va, pf, o0, 0, 0, 0);
  }
  {
    const uint2 lo = *(const uint2*)(Vc + (32 + r32) * VSL + kb), hi2 = *(const uint2*)(Vc + (32 + r32) * VSL + kb + 8);
    const bf16x8 va = __builtin_bit_cast(bf16x8, make_uint4(lo.x, lo.y, hi2.x, hi2.y));
    o1 = __builtin_amdgcn_mfma_f32_32x32x16_bf16(va, pf, o1, 0, 0, 0);
  }
}
DI void attn_item(const Params& p, int item, char* smem) {
  LAUNDER_IDS
  const int tid = tid__, lane = tid & 63, wave = tid >> 6, r32 = lane & 31, hi = lane >> 5;
  int bh, qpos0, key0, nkt, orow0;
  if (item < 2048) { bh = item >> 5; const int qb = item & 31; qpos0 = qb * 128; key0 = 0; nkt = LK / 64; orow0 = (bh >> 3) * L + qpos0; }
  else { const int it = item - 2048; bh = it >> 1; const int qb = it & 1; qpos0 = 4096 + qb * 128; key0 = 4096; nkt = LC / 64; orow0 = NTL + (bh >> 3) * LC + qb * 128; }
  const int h = bh & 7;
  const u16* Qp = (const u16*)(p.ws + OFF_R1) + ((size_t)bh * LK + qpos0 + wave * 32 + r32) * 96 + hi * 8;
  const u16* Kp = (const u16*)(p.ws + OFF_R1 + SZ_Q) + ((size_t)bh * LK + key0) * 96;
  const u16* Vp = (const u16*)(p.ws + OFF_R1 + 2 * SZ_Q) + (size_t)bh * 64 * LK + key0;
  u16* Ks = (u16*)smem;
  u16* Vs = Ks + 2 * 64 * KSL;
  bf16x8 qr[6];
#pragma unroll
  for (int d0 = 0; d0 < 6; ++d0) qr[d0] = *(const bf16x8*)(Qp + d0 * 16);
  uint4 ak0, ak1, ak2, av0, av1, bk0, bk1, bk2, bv0, bv1;
  const int kr0 = tid / 12, kc0 = tid - kr0 * 12, kr1 = (tid + 256) / 12, kc1 = (tid + 256) - kr1 * 12, kr2 = (tid + 512) / 12, kc2 = (tid + 512) - kr2 * 12;
  const int vd0 = tid >> 3, vc0 = tid & 7, vd1 = vd0 + 32;
#define gload(S, kt) do { \
    S##k0 = *(const uint4*)(Kp + (size_t)((kt) * 64 + kr0) * 96 + kc0 * 8); S##k1 = *(const uint4*)(Kp + (size_t)((kt) * 64 + kr1) * 96 + kc1 * 8); \
    S##k2 = *(const uint4*)(Kp + (size_t)((kt) * 64 + kr2) * 96 + kc2 * 8); \
    S##v0 = *(const uint4*)(Vp + (size_t)vd0 * LK + (kt) * 64 + vc0 * 8); S##v1 = *(const uint4*)(Vp + (size_t)vd1 * LK + (kt) * 64 + vc0 * 8); } while (0)
#define lstore(S, bi) do { \
    *(uint4*)(Ks + (bi) * 64 * KSL + kr0 * KSL + kc0 * 8) = S##k0; *(uint4*)(Ks + (bi) * 64 * KSL + kr1 * KSL + kc1 * 8) = S##k1; *(uint4*)(Ks + (bi) * 64 * KSL + kr2 * KSL + kc2 * 8) = S##k2; \
    { u16* dst = Vs + (bi) * 64 * VSL + vd0 * VSL + vc0 * 8; *(uint2*)dst = make_uint2(S##v0.x, S##v0.y); *(uint2*)(dst + 4) = make_uint2(S##v0.z, S##v0.w); } \
    { u16* dst = Vs + (bi) * 64 * VSL + vd1 * VSL + vc0 * 8; *(uint2*)dst = make_uint2(S##v1.x, S##v1.y); *(uint2*)(dst + 4) = make_uint2(S##v1.z, S##v1.w); } } while (0)
  f32x16 o0, o1;
#pragma unroll
  for (int i = 0; i < 16; ++i) { o0[i] = 0.f; o1[i] = 0.f; }
  float mrun = -1e30f, lrun = 0.f;
  auto tile_compute = [&](int cur) {
    const u16* Kc = Ks + cur * 64 * KSL;
    const u16* Vc = Vs + cur * 64 * VSL;
    f32x16 p0, p1;
#pragma unroll
    for (int i = 0; i < 16; ++i) { p0[i] = 0.f; p1[i] = 0.f; }
#pragma unroll
    for (int d0 = 0; d0 < 6; ++d0) {
      const bf16x8 a0 = *(const bf16x8*)(Kc + r32 * KSL + d0 * 16 + hi * 8);
      const bf16x8 a1 = *(const bf16x8*)(Kc + (32 + r32) * KSL + d0 * 16 + hi * 8);
      p0 = __builtin_amdgcn_mfma_f32_32x32x16_bf16(a0, qr[d0], p0, 0, 0, 0);
      p1 = __builtin_amdgcn_mfma_f32_32x32x16_bf16(a1, qr[d0], p1, 0, 0, 0);
    }
    float mx = p0[0];
#pragma unroll
    for (int i = 1; i < 16; ++i) mx = fmaxf(mx, p0[i]);
#pragma unroll
    for (int i = 0; i < 16; ++i) mx = fmaxf(mx, p1[i]);
    { auto rr = __builtin_amdgcn_permlane32_swap(__float_as_uint(mx), __float_as_uint(mx), false, false);
      mx = fmaxf(__uint_as_float(rr[0]), __uint_as_float(rr[1])); }
    if (!__all(mx - mrun <= 8.f)) {
      const float mn = fmaxf(mrun, mx);
      const float alpha = __builtin_amdgcn_exp2f(mrun - mn);
      mrun = mn; lrun *= alpha;
#pragma unroll
      for (int i = 0; i < 16; ++i) { o0[i] *= alpha; o1[i] *= alpha; }
    }
    float ps = 0.f;
#pragma unroll
    for (int i = 0; i < 16; ++i) { p0[i] = __builtin_amdgcn_exp2f(p0[i] - mrun); ps += p0[i]; }
#pragma unroll
    for (int i = 0; i < 16; ++i) { p1[i] = __builtin_amdgcn_exp2f(p1[i] - mrun); ps += p1[i]; }
    lrun += ps;
    pv_step(o0, o1, Vc, r32, 0 + hi * 4, pack8<0>(p0));
    pv_step(o0, o1, Vc, r32, 16 + hi * 4, pack8<8>(p0));
    pv_step(o0, o1, Vc, r32, 32 + hi * 4, pack8<0>(p1));
    pv_step(o0, o1, Vc, r32, 48 + hi * 4, pack8<8>(p1));
  };
  __syncthreads();
  gload(a, 0); lstore(a, 0);
  gload(a, 1);
  __syncthreads();
  for (int kt = 0; kt < nkt; kt += 2) {
    if (kt + 2 < nkt) gload(b, kt + 2);
    tile_compute(0);
    lstore(a, 1);
    __syncthreads();
    if (kt + 3 < nkt) gload(a, kt + 3);
    tile_compute(1);
    if (kt + 2 < nkt) lstore(b, 0);
    __syncthreads();
  }
  lrun += __shfl_xor(lrun, 32, 64);
  const float inv = 1.f / lrun;
  u16* om = (u16*)(p.ws + OFF_OMLA) + (size_t)(orow0 + wave * 32 + r32) * 512 + h * 64;
#pragma unroll
  for (int g = 0; g < 4; ++g) {
    const int d = 8 * g + 4 * hi;
    *(uint2*)(om + d) = make_uint2(pack2(o0[4 * g] * inv, o0[4 * g + 1] * inv), pack2(o0[4 * g + 2] * inv, o0[4 * g + 3] * inv));
    *(uint2*)(om + 32 + d) = make_uint2(pack2(o1[4 * g] * inv, o1[4 * g + 1] * inv), pack2(o1[4 * g + 2] * inv, o1[4 * g + 3] * inv));
  }
#undef gload
#undef lstore
}

DI void readout_row(const Params& p, int l, int r) {
  LAUNDER_IDS
  const int lane = tid__ & 63;
  const u16* sc = (const u16*)(p.ws + OFF_R3);
  const size_t AS = (size_t)NT * 256;
  const size_t o = (size_t)r * 256 + lane * 4;
  const u16* Yf = (const u16*)(p.ws + OFF_R2);
  const uint2 yf = *(const uint2*)(Yf + o), yb = *(const uint2*)(Yf + AS + o);
  const uint2 ur = *(const uint2*)(sc + SA_R * AS + o), uv = *(const uint2*)(sc + SA_V * AS + o);
  const uint2 kf = *(const uint2*)(sc + SA_KDF * AS + o), kb = *(const uint2*)(sc + SA_KDB * AS + o), ug = *(const uint2*)(sc + SA_G * AS + o);
  float y[4] = {bflo(yf.x) + bflo(yb.x), bfhi(yf.x) + bfhi(yb.x), bflo(yf.y) + bflo(yb.y), bfhi(yf.y) + bfhi(yb.y)};
  const float rr[4] = {bflo(ur.x), bfhi(ur.x), bflo(ur.y), bfhi(ur.y)};
  const float vv[4] = {bflo(uv.x), bfhi(uv.x), bflo(uv.y), bfhi(uv.y)};
  const float km[4] = {0.5f * (bflo(kf.x) + bflo(kb.x)), 0.5f * (bfhi(kf.x) + bfhi(kb.x)), 0.5f * (bflo(kf.y) + bflo(kb.y)), 0.5f * (bfhi(kf.y) + bfhi(kb.y))};
  const float gg[4] = {bflo(ug.x), bfhi(ug.x), bflo(ug.y), bfhi(ug.y)};
  const float4 rk4 = *(const float4*)(p.in[I_RK] + l * 256 + lane * 4);
  const float4 lw4 = *(const float4*)(p.in[I_LNW] + l * 256 + lane * 4);
  const float4 lb4 = *(const float4*)(p.in[I_LNB] + l * 256 + lane * 4);
  const float rk[4] = {rk4.x, rk4.y, rk4.z, rk4.w}, lw[4] = {lw4.x, lw4.y, lw4.z, lw4.w}, lb[4] = {lb4.x, lb4.y, lb4.z, lb4.w};
  float s = y[0] + y[1] + y[2] + y[3];
  s = rowsum16(s);
  const float mu = s * (1.f / 64.f);
  float q = 0.f, bn = 0.f;
#pragma unroll
  for (int j = 0; j < 4; ++j) { const float d = y[j] - mu; q += d * d; bn += rr[j] * km[j] * rk[j]; }
  q = rowsum16(q); bn = rowsum16(bn);
  const float rstd = rsqrtf(q * (1.f / 64.f) + 64e-5f);
  float ov[4];
#pragma unroll
  for (int j = 0; j < 4; ++j) ov[j] = ((y[j] - mu) * rstd * lw[j] + lb[j] + bn * vv[j]) * gg[j];
  u16* orw = (u16*)(p.ws + OFF_R3 + SA_KKN * SZ_TOK256 + (size_t)NT * 512 * 2);
  *(uint2*)(orw + o) = make_uint2(pack2(ov[0], ov[1]), pack2(ov[2], ov[3]));
}

DI void phase_attn(const Params& p, int l, char* smem) {
  LAUNDER_IDS
  __shared__ int qslot_sh;
  const int nattn = (l == 0) ? 2048 + 128 : 2048;
  unsigned* ctr = (unsigned*)(p.ws + OFF_BAR) + 16 + l * 16;
  for (;;) {
    __syncthreads();
    if (tid__ == 0) qslot_sh = (int)__hip_atomic_fetch_add(ctr, 1u, __ATOMIC_RELAXED, __HIP_MEMORY_SCOPE_AGENT);
    __syncthreads();
    const int it = qslot_sh;
    if (it >= nattn) break;
    attn_item(p, it, smem);
  }
}
DI void phase_readout(const Params& p, int l, int Mout) {
  LAUNDER_IDS
  const int wave = tid__ >> 6;
  for (int r = blk__ * 4 + wave; r < Mout; r += gridDim.x * 4) readout_row(p, l, r);
}

DI void phase_merge(const Params& p, int l, int Mout, char* smem) {
  LAUNDER_IDS
  WAVE_COORDS
  const char* wl = p.ws + OFF_W + (size_t)l * W_LAYER;
  const u16* hg = (const u16*)(p.ws + OFF_HBG);
  const u16* opool = (const u16*)(p.ws + OFF_R4);
  const u16* omla = (const u16*)(p.ws + OFF_OMLA);
  const u16* orw = (const u16*)(p.ws + OFF_R3 + SA_KKN * SZ_TOK256) + (size_t)NT * 512;
  u16* mo = (u16*)(p.ws + OFF_R1);
  const int ntm = Mout / 128;
  for (int it = 0;; ++it) {
    int tm, tn;
    if (!tile_map(it, ntm, 8, blk__, gridDim.x, tm, tn)) break;
    const int m0 = tm * 128, n0 = tn * 128;
    f32x4 msum[4][4]; zero_accm<4, 4>(msum);
#pragma unroll 1
    for (int br = 0; br < 3; ++br) {
      unsigned gpk[4][4][2];
      {
        f32x4 ag[4][4]; zero_accm<4, 4>(ag);
        gemm256<4, 4>(ag, hg, 1024, (const u16*)(wl + WO_WIN) + (size_t)(2080 + br * 1024) * 1024, 1024, 1024, m0, n0, smem);
#pragma unroll
        for (int mi = 0; mi < 4; ++mi)
#pragma unroll
          for (int ni = 0; ni < 4; ++ni) {
            gpk[mi][ni][0] = pack2(sigmoidf_(ag[mi][ni][0]), sigmoidf_(ag[mi][ni][1]));
            gpk[mi][ni][1] = pack2(sigmoidf_(ag[mi][ni][2]), sigmoidf_(ag[mi][ni][3]));
          }
      }
      __builtin_amdgcn_sched_barrier(0);
      f32x4 ab[4][4]; zero_accm<4, 4>(ab);
      {
        const int Kb = br == 1 ? 512 : 256;
        const u16* Ab = br == 0 ? opool : br == 1 ? omla : orw;
        const u16* Wb = (const u16*)(wl + (br == 0 ? WO_BRP : br == 1 ? WO_BRM : WO_BRR));
        gemm256<4, 4>(ab, Ab, Kb, Wb, Kb, Kb, m0, n0, smem);
      }
#pragma unroll
      for (int mi = 0; mi < 4; ++mi)
#pragma unroll
        for (int ni = 0; ni < 4; ++ni) {
          msum[mi][ni][0] += bflo(gpk[mi][ni][0]) * ab[mi][ni][0];
          msum[mi][ni][1] += bfhi(gpk[mi][ni][0]) * ab[mi][ni][1];
          msum[mi][ni][2] += bflo(gpk[mi][ni][1]) * ab[mi][ni][2];
          msum[mi][ni][3] += bfhi(gpk[mi][ni][1]) * ab[mi][ni][3];
        }
      __builtin_amdgcn_sched_barrier(0);
    }
    EPI_BEGIN
#pragma unroll
    for (int mi = 0; mi < 4; ++mi) {
      const int m = m0 + wr * 64 + mi * 16 + lr;
#pragma unroll
      for (int ni = 0; ni < 4; ++ni) {
        const int n = n0 + wc * 64 + ni * 16 + lq * 4;
        *(uint2*)(mo + (size_t)m * 1024 + n) = make_uint2(pack2(msum[mi][ni][0], msum[mi][ni][1]), pack2(msum[mi][ni][2], msum[mi][ni][3]));
      }
    }
    EPI_END
  }
}

DI void phase_resid(const Params& p, const u16* A, int K, const u16* Bt, const float* gate  ,
                    const float* xl_in, const float* xc_in, float* xl_out, float* xc_out, int Mout, char* smem) {
  LAUNDER_IDS
  WAVE_COORDS
  const int ntm = Mout / 256;
  for (int it = 0;; ++it) {
    int tm, tn;
    if (!tile_map(it, ntm, 8, blk__, gridDim.x, tm, tn)) break;
    const int m0 = tm * 256, n0 = tn * 128;
    f32x4 acc[8][4]; zero_accm<8, 4>(acc);
    gemm256<8, 4>(acc, A, K, Bt, K, K, m0, n0, smem);
    EPI_BEGIN
#pragma unroll
    for (int mi = 0; mi < 8; ++mi) {
      const int m = m0 + wr * 128 + mi * 16 + lr;
      const int b9 = m < NTL ? m >> 12 : 8;
      const float* xi = xrow(xl_in, xc_in, m);
      float* xo = m < NTL ? xl_out + (size_t)m * D : xc_out + (size_t)(m - NTL) * D;
#pragma unroll
      for (int ni = 0; ni < 4; ++ni) {
        const int n = n0 + wc * 64 + ni * 16 + lq * 4;
        const float4 g = *(const float4*)(gate + (size_t)b9 * 6144 + n);
        const float4 xv = *(const float4*)(xi + n);
        float4 ov;
        ov.x = xv.x + g.x * acc[mi][ni][0]; ov.y = xv.y + g.y * acc[mi][ni][1]; ov.z = xv.z + g.z * acc[mi][ni][2]; ov.w = xv.w + g.w * acc[mi][ni][3];
        *(float4*)(xo + n) = ov;
      }
      __builtin_amdgcn_sched_barrier(0);
    }
    EPI_END
  }
}
DI void phase_mlp1(const Params& p, int l, int Mout, char* smem) {
  LAUNDER_IDS
  WAVE_COORDS
  const char* wl = p.ws + OFF_W + (size_t)l * W_LAYER;
  const u16* hb = (const u16*)(p.ws + OFF_HB2);
  u16* U = (u16*)(p.ws + OFF_R1);
  const int ntm = Mout / 256;
  for (int it = 0;; ++it) {
    int tm, tn;
    if (!tile_map(it, ntm, 32, blk__, gridDim.x, tm, tn)) break;
    const int m0 = tm * 256, n0 = tn * 128;
    f32x4 acc[8][4]; zero_accm<8, 4>(acc);
    gemm256<8, 4>(acc, hb, 1024, (const u16*)(wl + WO_W1), 1024, 1024, m0, n0, smem);
    EPI_BEGIN
#pragma unroll
    for (int mi = 0; mi < 8; ++mi) {
      const int m = m0 + wr * 128 + mi * 16 + lr;
#pragma unroll
      for (int ni = 0; ni < 4; ++ni) {
        const int n = n0 + wc * 64 + ni * 16 + lq * 4;
        float v[4];
#pragma unroll
        for (int j = 0; j < 4; ++j) { const float a = fmaxf(acc[mi][ni][j], 0.f); v[j] = a * a; }
        *(uint2*)(U + (size_t)m * DFF + n) = make_uint2(pack2(v[0], v[1]), pack2(v[2], v[3]));
      }
      __builtin_amdgcn_sched_barrier(0);
    }
    EPI_END
  }
}

__global__ void __launch_bounds__(256, 2) fwd_megakernel(Params pk) {
  __shared__ __attribute__((aligned(16))) char smem[73728];
  cg::grid_group grid = cg::this_grid();
  if (threadIdx.x == 0) { g_base_sh[0] = (unsigned long long)pk.ws; g_base_sh[1] = (unsigned long long)pk.out; }
  xcd_barrier_post((unsigned*)(pk.ws + OFF_BAR));
  __syncthreads();
  phase_prep(pk, smem);
  if (pk.ws == nullptr) grid.sync();
  xcd_barrier();
  phase_tables(pk);
  xcd_barrier();
#define CTXBUF ((float*)(p.ws + OFF_CTX))
#define XLP (l == 0 ? p.in[I_X] : (const float*)p.out)
#define XCP (l == 0 ? p.in[I_CTX] : (const float*)CTXBUF)
#define MOUT (l == 0 ? NT : NTL)
#define WLP (p.ws + OFF_W + (size_t)l * W_LAYER)
#define TABP(nrm) ((const float*)(p.ws + OFF_TAB) + (size_t)(l * 2 + (nrm)) * 9 * 2048)
#define MODP(j) ((const float*)(p.ws + OFF_MODS) + (size_t)l * 9 * 6144 + (j) * 1024)
#ifndef PROBE_Q
#define PROBE_Q -1
#endif
#pragma nounroll
  for (int ph = 0; ph < 22; ++ph) {
    const int l = ph >= 11 ? 1 : 0, q = ph - l * 11;
    Params p = pk;
    {
      asm volatile("" ::: "memory");
      unsigned long long w_ = g_base_sh[0], o_ = g_base_sh[1];
      unsigned wl_ = (unsigned)w_, wh_ = (unsigned)(w_ >> 32), ol_ = (unsigned)o_, oh_ = (unsigned)(o_ >> 32);
      wl_ = __builtin_amdgcn_readfirstlane(wl_); wh_ = __builtin_amdgcn_readfirstlane(wh_); ol_ = __builtin_amdgcn_readfirstlane(ol_); oh_ = __builtin_amdgcn_readfirstlane(oh_);
      asm volatile("" : "+s"(wl_), "+s"(wh_), "+s"(ol_), "+s"(oh_));
      p.ws = (char*)(((unsigned long long)wh_ << 32) | wl_); p.out = (float*)(((unsigned long long)oh_ << 32) | ol_);
    }
#pragma nounroll
    for (int rep = 0; rep < (q == PROBE_Q ? 2 : 1); ++rep)
    switch (q) {
      case 0: phase_norm(XLP, XCP, TABP(0), (u16*)(p.ws + OFF_HB1), NT); break;
      case 1: phase_zgemm(p, l, smem); break;
      case 2: phase_tokA(p, l); phase_tokB(p, l, smem); break;
      case 3: phase_qkv(p, l, smem); break;
      case 4: phase_scan(p, smem); phase_attn(p, l, smem); break;
      case 5: phase_norm(XLP, XCP, TABP(0), (u16*)(p.ws + OFF_HBG), MOUT); phase_readout(p, l, MOUT); break;
      case 6: phase_merge(p, l, MOUT, smem); break;
      case 7: phase_resid(p, (const u16*)(p.ws + OFF_R1), 1024, (const u16*)(WLP + WO_WO), MODP(2), XLP, XCP, p.out, CTXBUF, MOUT, smem); break;
      case 8: phase_norm(p.out, CTXBUF, TABP(1), (u16*)(p.ws + OFF_HB2), MOUT); break;
      case 9: phase_mlp1(p, l, MOUT, smem); break;
      default: phase_resid(p, (const u16*)(p.ws + OFF_R1), 4096, (const u16*)(WLP + WO_W2), MODP(5), p.out, CTXBUF, p.out, CTXBUF, MOUT, smem); break;
    }
    if (ph != 21) xcd_barrier();
  }
}

extern "C" void kernel_launch(void* const* d_in, const int* in_sizes, int n_in, void* d_out, int out_size, void* d_ws, size_t ws_size, hipStream_t stream) {
  static int grid_blocks = 0;
  if (!grid_blocks) {
    int dev = 0, cus = 0, per_cu = 0;
    hipGetDevice(&dev);
    hipDeviceGetAttribute(&cus, hipDeviceAttributeMultiprocessorCount, dev);
    hipOccupancyMaxActiveBlocksPerMultiprocessor(&per_cu, fwd_megakernel, 256, 0);
    if (per_cu > 2) per_cu = 2;
    if (per_cu < 1) per_cu = 1;
    grid_blocks = cus * per_cu;
    if (ws_size < WS_END) fprintf(stderr, "kernel_launch: workspace too small: %zu < %zu\n", ws_size, (size_t)WS_END);
  }
  Params p{};
  for (int i = 0; i < 34; ++i) p.in[i] = (const float*)d_in[i];
  p.out = (float*)d_out;
  p.ws = (char*)d_ws;
  hipMemsetAsync(d_ws, 0, 16384, stream);
  void* args[] = {&p};
  hipError_t e = hipLaunchCooperativeKernel((void*)fwd_megakernel, dim3(grid_blocks), dim3(256), args, 0, stream);
  if (e != hipSuccess) fprintf(stderr, "cooperative launch failed: %s (grid %d)\n", hipGetErrorString(e), grid_blocks);
}
```

```cpp
#include <hip/hip_runtime.h>
#include <hip/hip_cooperative_groups.h>
#include <stdint.h>
#include <cstdio>
namespace cg = cooperative_groups;

typedef unsigned short u16;
typedef __attribute__((ext_vector_type(8))) short bf16x8;
typedef __attribute__((ext_vector_type(4))) float f32x4;
typedef __attribute__((ext_vector_type(16))) float f32x16;
typedef __bf16 bf16x2_t __attribute__((ext_vector_type(2)));
typedef float float2_t __attribute__((ext_vector_type(2)));

#define DI __device__ __forceinline__

constexpr int D = 1024, NB = 8, L = 4096, LC = 256, LK = 4352;
constexpr int NTL = NB * L;
constexpr int NTC = NB * LC;
constexpr int NT = NTL + NTC;
constexpr int INC = 5152;
constexpr int ZA = 928;
constexpr int ZR = 1152;
constexpr int DFF = 4096;

constexpr size_t al256(size_t x) { return (x + 255) / 256 * 256; }
constexpr size_t OFF_BAR = 0;
constexpr size_t OFF_MODS = 16384;
constexpr size_t OFF_TAB = OFF_MODS + al256(2 * 9 * 6144 * 4);
constexpr size_t OFF_ROPE = OFF_TAB + al256(2 * 2 * 9 * 2 * 1024 * 4);
constexpr size_t OFF_RS1 = OFF_ROPE + 4096;
constexpr size_t OFF_RS2 = OFF_RS1 + al256(NT * 4);
constexpr size_t OFF_RSQ = OFF_RS2 + al256(NT * 4);
constexpr size_t OFF_RSKV = OFF_RSQ + al256(NT * 4);
constexpr size_t OFF_CTX = OFF_RSKV + al256(NT * 4);
constexpr size_t OFF_W = OFF_CTX + (size_t)NTC * D * 4;
constexpr size_t WO_WIN = 0;
constexpr size_t WO_UQ = WO_WIN + (size_t)INC * 1024 * 2;
constexpr size_t WO_UKV = WO_UQ + (size_t)768 * 384 * 2;
constexpr size_t WO_BRP = WO_UKV + (size_t)1024 * 256 * 2;
constexpr size_t WO_BRM = WO_BRP + (size_t)1024 * 256 * 2;
constexpr size_t WO_BRR = WO_BRM + (size_t)1024 * 512 * 2;
constexpr size_t WO_WO = WO_BRR + (size_t)1024 * 256 * 2;
constexpr size_t WO_W1 = WO_WO + (size_t)1024 * 1024 * 2;
constexpr size_t WO_W2 = WO_W1 + (size_t)4096 * 1024 * 2;
constexpr size_t WO_RW2 = WO_W2 + (size_t)1024 * 4096 * 2;
constexpr size_t WO_RA2 = WO_RW2 + (size_t)2 * 256 * 64 * 2;
constexpr size_t WO_RG2 = WO_RA2 + (size_t)2 * 256 * 64 * 2;
constexpr size_t W_LAYER = al256(WO_RG2 + (size_t)256 * 128 * 2);
constexpr size_t OFF_R1 = OFF_W + 2 * W_LAYER;
constexpr size_t SZ_Q = (size_t)NB * 8 * LK * 96 * 2;
constexpr size_t SZ_VT = (size_t)NB * 8 * 64 * LK * 2;
constexpr size_t SZ_R1 = 2 * SZ_Q + SZ_VT;
constexpr size_t OFF_R2 = OFF_R1 + al256(SZ_R1);
constexpr size_t SZ_TOK256 = (size_t)NT * 256 * 2;
constexpr size_t OFF_R3 = OFF_R2 + al256((size_t)NT * ZA * 2);
constexpr size_t OFF_R4 = OFF_R3 + 10 * SZ_TOK256;
constexpr size_t OFF_KR = OFF_R4 + SZ_TOK256;
constexpr size_t OFF_OMLA = OFF_KR + al256((size_t)NT * 32 * 2);
constexpr size_t WS_END = OFF_OMLA + (size_t)NT * 512 * 2;
static_assert(WS_END <= 536870912ull, "workspace map exceeds 4x the largest tensor");
constexpr size_t OFF_HB1 = OFF_R3;
constexpr size_t OFF_HBG = OFF_R1 + (size_t)NT * 1024 * 2;
constexpr size_t OFF_HB2 = OFF_R3 + 5 * SZ_TOK256;
enum { SA_R = 0, SA_V = 1, SA_KDF = 2, SA_KDB = 3, SA_G = 4, SA_KKN = 5, SA_OMWF = 6, SA_BF = 7, SA_OMWB = 8, SA_BB = 9 };

struct Params { const float* in[34]; float* out; char* ws; };

enum { I_X = 0, I_C, I_CTX, I_CCTX, I_N1G, I_N2G, I_WADA, I_BADA, I_WIN, I_POOLW, I_POOLS, I_QNORM, I_WUQ, I_KVNORM, I_WUKV,
       I_GQ, I_GK, I_MU, I_W0, I_W2R, I_A0, I_A2R, I_KA, I_KK, I_RK, I_G2R, I_LNW, I_LNB, I_BRP, I_BRM, I_BRR, I_WO, I_W1, I_W2 };

DI float bf2f(u16 h) { return __uint_as_float(((unsigned)h) << 16); }
DI float bflo(unsigned u) { return __uint_as_float(u << 16); }
DI float bfhi(unsigned u) { return __uint_as_float(u & 0xffff0000u); }
DI unsigned pack2(float a, float b) { float2_t v = {a, b}; bf16x2_t r = __builtin_convertvector(v, bf16x2_t); return __builtin_bit_cast(unsigned, r); }
DI u16 f2bf(float a) { return (u16)(pack2(a, 0.f) & 0xffffu); }
DI float sigmoidf_(float x) { return 1.f / (1.f + __expf(-x)); }
DI float siluf_(float x) { return x / (1.f + __expf(-x)); }
DI float rowsum16(float x) {
  x += __builtin_bit_cast(float, __builtin_amdgcn_update_dpp(0, __builtin_bit_cast(int, x), 0x128, 0xf, 0xf, false));
  x += __builtin_bit_cast(float, __builtin_amdgcn_update_dpp(0, __builtin_bit_cast(int, x), 0x124, 0xf, 0xf, false));
  x += __builtin_bit_cast(float, __builtin_amdgcn_update_dpp(0, __builtin_bit_cast(int, x), 0x122, 0xf, 0xf, false));
  x += __builtin_bit_cast(float, __builtin_amdgcn_update_dpp(0, __builtin_bit_cast(int, x), 0x121, 0xf, 0xf, false));
  return x;
}
DI float wavesum(float x) {
  x = rowsum16(x);
  const int xi = __builtin_bit_cast(int, x);
  return __builtin_bit_cast(float, __builtin_amdgcn_readlane(xi, 0)) + __builtin_bit_cast(float, __builtin_amdgcn_readlane(xi, 16)) +
         __builtin_bit_cast(float, __builtin_amdgcn_readlane(xi, 32)) + __builtin_bit_cast(float, __builtin_amdgcn_readlane(xi, 48));
}
DI void grid_barrier(unsigned* ctr, unsigned& epoch) {
  asm volatile("s_waitcnt vmcnt(0)" ::: "memory");
  __syncthreads();
  epoch++;
  if (threadIdx.x == 0) {
    __builtin_amdgcn_fence(__ATOMIC_RELEASE, "agent");
    asm volatile("s_waitcnt vmcnt(0)" ::: "memory");
    const unsigned target = epoch * gridDim.x;
    __hip_atomic_fetch_add(ctr, 1u, __ATOMIC_RELAXED, __HIP_MEMORY_SCOPE_AGENT);
    while (__hip_atomic_load(ctr, __ATOMIC_RELAXED, __HIP_MEMORY_SCOPE_AGENT) < target) __builtin_amdgcn_s_sleep(2);
    __builtin_amdgcn_fence(__ATOMIC_ACQUIRE, "agent");
    asm volatile("s_waitcnt vmcnt(0)" ::: "memory");
  }
  __syncthreads();
}


#define XB_TMO      128
#define XB_XCNT(j)  (256  + 64 * (j))
#define XB_XSUB(j)  (1280 + 64 * (j))
#define XB_XGEN(j)  (2304 + 64 * (j))
#define XB_TOP      3328
#define XB_TOPGEN   3392
#define XB_SPIN_CAP (1u << 22)
#define LAS __attribute__((address_space(3)))
DI unsigned xb_ld(unsigned* p)              { return __hip_atomic_load(p, __ATOMIC_RELAXED, __HIP_MEMORY_SCOPE_AGENT); }
DI unsigned xb_add(unsigned* p, unsigned v) { return __hip_atomic_fetch_add(p, v, __ATOMIC_RELAXED, __HIP_MEMORY_SCOPE_AGENT); }
DI unsigned xb_xcc_id() { return (unsigned)__builtin_amdgcn_s_getreg((3 << 11) | 20) & 0xFu; }
#define XB_SPIN(cond, bar) do { unsigned _sp = 0; while (cond) { __builtin_amdgcn_s_sleep(1); \
    if ((++_sp & 255u) == 0u) { if (xb_ld(&(bar)[XB_TMO])) break; if (_sp > XB_SPIN_CAP) { atomicAdd(&(bar)[XB_TMO], 1u); break; } } } } while (0)
__shared__ uint4 g_xb_words;
__shared__ unsigned long long g_base_sh[2];
DI void xcd_barrier_post(unsigned* bar) {
  const unsigned x = xb_xcc_id();
  if (threadIdx.x == 0) { g_xb_words = make_uint4(0u, 0u, x, 0u); (void)xb_add(&bar[XB_XCNT(x)], 1u); }
}
DI void xcd_barrier_complete(unsigned* bar, unsigned x, unsigned& nloc, unsigned& nx) {
  const unsigned G = gridDim.x;
  unsigned sum, cnt, mine, sp = 0u;
  for (;;) {
    sum = 0u; cnt = 0u; mine = 0u;
#pragma unroll
    for (unsigned j = 0; j < 16; ++j) { const unsigned c = xb_ld(&bar[XB_XCNT(j)]); sum += c; cnt += (c > 0u) ? 1u : 0u; mine = (j == x) ? c : mine; }
    if (sum == G) break;
    __builtin_amdgcn_s_sleep(1);
    if ((++sp & 255u) == 0u) { if (xb_ld(&bar[XB_TMO])) break; if (sp > XB_SPIN_CAP) { atomicAdd(&bar[XB_TMO], 1u); break; } }
  }
  nloc = mine > 0u ? mine : 1u; nx = cnt > 0u ? cnt : 1u;
}
DI void xcd_barrier() {
  asm volatile("s_waitcnt vmcnt(0)" ::: "memory");
  __syncthreads();
  if (threadIdx.x == 0) {
    unsigned* bar = (unsigned*)(g_base_sh[0] + OFF_BAR);
    __builtin_amdgcn_s_waitcnt(0);
    unsigned nloc = g_xb_words.x, nx = g_xb_words.y; const unsigned x = g_xb_words.z;
    if (nloc == 0u) { xcd_barrier_complete(bar, x, nloc, nx); g_xb_words.x = nloc; g_xb_words.y = nx; }
    const unsigned old = xb_add(&bar[XB_XSUB(x)], 1u);
    const unsigned gen = old / nloc;
    if (old + 1u == (gen + 1u) * nloc) {
      __builtin_amdgcn_fence(__ATOMIC_RELEASE, "agent");
      asm volatile("s_waitcnt vmcnt(0)" ::: "memory");
      const unsigned og = xb_add(&bar[XB_TOP], 1u);
      const unsigned tg = og / nx;
      if (og + 1u == (tg + 1u) * nx) xb_add(&bar[XB_TOPGEN], 1u);
      else XB_SPIN(xb_ld(&bar[XB_TOPGEN]) == tg, bar);
      __builtin_amdgcn_fence(__ATOMIC_ACQUIRE, "agent");
      xb_add(&bar[XB_XGEN(x)], 1u);
      asm volatile("s_waitcnt vmcnt(0)" ::: "memory");
    } else {
      XB_SPIN(xb_ld(&bar[XB_XGEN(x)]) == gen, bar);
      __builtin_amdgcn_fence(__ATOMIC_ACQUIRE, "agent");
      asm volatile("s_waitcnt vmcnt(0)" ::: "memory");
    }
  }
  __syncthreads();
}
DI int launder_v(int x) { asm volatile("" : "+v"(x)); return x; }
DI int launder_s(int x) { asm volatile("" : "+s"(x)); return x; }
#define LAUNDER_IDS const int tid__ = launder_v((int)threadIdx.x); const int blk__ = launder_s((int)blockIdx.x); (void)tid__; (void)blk__;
DI void do_transpose(const float* __restrict__ src, int K, int N, u16* __restrict__ dst, const float* __restrict__ ksc, int perm, int tile, float* tl) {
  LAUNDER_IDS
  const int ntn = (N + 63) >> 6;
  const int kt = tile / ntn, nt = tile - kt * ntn;
  const int k0 = kt * 64, n0 = nt * 64;
  const int tid = tid__;
  __syncthreads();
#pragma unroll 4
  for (int i = 0; i < 16; ++i) {
    const int kk = i * 4 + (tid >> 6), nn = tid & 63;
    float v = 0.f;
    if (n0 + nn < N) v = src[(size_t)(k0 + kk) * N + n0 + nn];
    if (ksc) v *= ksc[k0 + kk];
    tl[kk * 65 + nn] = v;
  }
  __syncthreads();
#pragma unroll 4
  for (int i = 0; i < 16; ++i) {
    const int nn = i * 4 + (tid >> 6), kk = tid & 63;
    int n = n0 + nn;
    if (n < N) {
      if (perm) { const int h = n / 96, d = n - h * 96; n = d < 64 ? h * 64 + d : 512 + h * 32 + (d - 64); }
      dst[(size_t)n * K + k0 + kk] = f2bf(tl[kk * 65 + nn]);
    }
  }
}

DI void phase_prep(const Params& p, char* smem) {
  LAUNDER_IDS
  float* tl = (float*)smem;
  const int tid = tid__;
  constexpr int T_WIN = 16 * 81, T_UQ = 6 * 12, T_UKV = 4 * 16, T_BRM = 8 * 16, T_BRR = 4 * 16, T_WO = 16 * 16, T_W1 = 16 * 64, T_W2 = 64 * 16,
                T_RW2 = 4, T_RA2 = 4, T_RG2 = 2 * 4;
  constexpr int T_LAYER = T_WIN + T_UQ + T_UKV + T_BRM + T_BRR + T_WO + T_W1 + T_W2 + 2 * T_RW2 + 2 * T_RA2 + T_RG2;
  for (int g = blk__; g < 2 * T_LAYER; g += gridDim.x) {
    const int l = g / T_LAYER; int t = g - l * T_LAYER;
    char* wl = p.ws + OFF_W + (size_t)l * W_LAYER;
#define JOB(SRC, KK, NN, DSTOFF, SC, PERM, CNT) if (t < (CNT)) { do_transpose((SRC), (KK), (NN), (u16*)(wl + (DSTOFF)), (SC), (PERM), t, tl); continue; } t -= (CNT);
    JOB(p.in[I_WIN] + (size_t)l * 1024 * INC, 1024, INC, WO_WIN, nullptr, 0, T_WIN)
    JOB(p.in[I_WUQ] + (size_t)l * 384 * 768, 384, 768, WO_UQ, p.in[I_QNORM] + l * 384, 1, T_UQ)
    JOB(p.in[I_WUKV] + (size_t)l * 256 * 1024, 256, 1024, WO_UKV, p.in[I_KVNORM] + l * 256, 0, T_UKV)
    JOB(p.in[I_BRM] + (size_t)l * 512 * 1024, 512, 1024, WO_BRM, nullptr, 0, T_BRM)
    JOB(p.in[I_BRR] + (size_t)l * 256 * 1024, 256, 1024, WO_BRR, nullptr, 0, T_BRR)
    JOB(p.in[I_WO] + (size_t)l * 1024 * 1024, 1024, 1024, WO_WO, nullptr, 0, T_WO)
    JOB(p.in[I_W1] + (size_t)l * 1024 * 4096, 1024, 4096, WO_W1, nullptr, 0, T_W1)
    JOB(p.in[I_W2] + (size_t)l * 4096 * 1024, 4096, 1024, WO_W2, nullptr, 0, T_W2)
    JOB(p.in[I_W2R] + (size_t)(l * 2 + 0) * 64 * 256, 64, 256, WO_RW2, nullptr, 0, T_RW2)
    JOB(p.in[I_W2R] + (size_t)(l * 2 + 1) * 64 * 256, 64, 256, WO_RW2 + 256 * 64 * 2, nullptr, 0, T_RW2)
    JOB(p.in[I_A2R] + (size_t)(l * 2 + 0) * 64 * 256, 64, 256, WO_RA2, nullptr, 0, T_RA2)
    JOB(p.in[I_A2R] + (size_t)(l * 2 + 1) * 64 * 256, 64, 256, WO_RA2 + 256 * 64 * 2, nullptr, 0, T_RA2)
    JOB(p.in[I_G2R] + (size_t)l * 128 * 256, 128, 256, WO_RG2, nullptr, 0, T_RG2)
#undef JOB
  }
  for (int e = blk__ * 256 + tid; e < 2 * 256 * 1024; e += gridDim.x * 256) {
    const int l = e >> 18, r = e & 262143, cin = r >> 10, n = r & 1023, g = cin >> 6, c = cin & 63;
    const float* pw = p.in[I_POOLW] + ((size_t)(l * 4 + g) * 64 + c) * 64;
    const float* ps = p.in[I_POOLS] + l * 256 + g * 64;
    const float* wb = p.in[I_BRP] + ((size_t)l * 256 + g * 64) * 1024 + n;
    float s = 0.f;
    for (int d = 0; d < 64; ++d) s += pw[d] * ps[d] * wb[(size_t)d * 1024];
    ((u16*)(p.ws + OFF_W + (size_t)l * W_LAYER + WO_BRP))[(size_t)n * 256 + cin] = f2bf(s);
  }
  if (blk__ == gridDim.x - 1) {
    for (int e = tid; e < 512; e += 256) {
      const int pos = e >> 3, f = e & 7;
      const float inv = powf(10000.f, -(float)f / 8.f);
      const float ang = (float)pos * inv;
      float* rt = (float*)(p.ws + OFF_ROPE);
      rt[e * 2] = cosf(ang); rt[e * 2 + 1] = sinf(ang);
    }
  }
  {
    float* sl = (float*)smem;
    float* red = sl + 9 * 1024;
    __syncthreads();
    for (int e = tid; e < 9 * 1024; e += 256) {
      const int b = e >> 10, k = e & 1023;
      const float v = b < 8 ? p.in[I_C][b * 1024 + k] : p.in[I_CCTX][k];
      sl[e] = siluf_(v);
    }
    __syncthreads();
    const int wave = tid >> 6, lane = tid & 63;
    for (int it = blk__; it < 192; it += gridDim.x) {
      const int l = it / 96, cg_ = it - l * 96;
      const int col = cg_ * 64 + lane;
      const float* wa = p.in[I_WADA] + (size_t)l * 1024 * 6144 + col;
      float acc[9];
#pragma unroll
      for (int b = 0; b < 9; ++b) acc[b] = 0.f;
#pragma unroll 8
      for (int k = wave * 256; k < wave * 256 + 256; ++k) {
        const float w = wa[(size_t)k * 6144];
#pragma unroll
        for (int b = 0; b < 9; ++b) acc[b] += sl[b * 1024 + k] * w;
      }
#pragma unroll
      for (int b = 0; b < 9; ++b) red[(wave * 9 + b) * 64 + lane] = acc[b];
      __syncthreads();
      for (int e = tid; e < 9 * 64; e += 256) {
        const int b = e >> 6, c = e & 63;
        const float s = red[(0 * 9 + b) * 64 + c] + red[(1 * 9 + b) * 64 + c] + red[(2 * 9 + b) * 64 + c] + red[(3 * 9 + b) * 64 + c];
        ((float*)(p.ws + OFF_MODS))[(size_t)(l * 9 + b) * 6144 + cg_ * 64 + c] = s + p.in[I_BADA][l * 6144 + cg_ * 64 + c];
      }
      __syncthreads();
    }
  }
}

DI const float* xrow(const float* xl, const float* xc, int r) { return r < NTL ? xl + (size_t)r * D : xc + (size_t)(r - NTL) * D; }

DI void phase_norm(const float* xl, const float* xc, const float* tab  , u16* hb, int M) {
  LAUNDER_IDS
  const int wave = tid__ >> 6, lane = tid__ & 63;
  for (int r = blk__ * 4 + wave; r < M; r += gridDim.x * 4) {
    const float* xp = xrow(xl, xc, r);
    const int b9 = r < NTL ? r >> 12 : 8;
    float4 v[4];
    float s = 0.f;
#pragma unroll
    for (int i = 0; i < 4; ++i) { v[i] = *(const float4*)(xp + i * 256 + lane * 4); s += v[i].x * v[i].x + v[i].y * v[i].y + v[i].z * v[i].z + v[i].w * v[i].w; }
    s = wavesum(s);
    const float rs = rsqrtf(s * (1.f / 1024.f) + 1e-6f);
    const float* t = tab + b9 * 2048;
#pragma unroll
    for (int i = 0; i < 4; ++i) {
      const int k = i * 256 + lane * 4;
      const float4 g = *(const float4*)(t + k), sh = *(const float4*)(t + 1024 + k);
      *(uint2*)(hb + (size_t)r * 1024 + k) = make_uint2(pack2(v[i].x * rs * g.x + sh.x, v[i].y * rs * g.y + sh.y), pack2(v[i].z * rs * g.z + sh.z, v[i].w * rs * g.w + sh.w));
    }
  }
}
DI void phase_tables(const Params& p) {
  LAUNDER_IDS
  const float* mods = (const float*)(p.ws + OFF_MODS);
  float* tab = (float*)(p.ws + OFF_TAB);
  for (int e = blk__ * 256 + tid__; e < 2 * 2 * 9 * 1024; e += gridDim.x * 256) {
    const int k = e & 1023, b9 = (e >> 10) % 9, ln = (e >> 10) / 9, l = ln >> 1, nrm = ln & 1;
    const float g = p.in[nrm ? I_N2G : I_N1G][l * 1024 + k];
    const float sh = mods[(size_t)(l * 9 + b9) * 6144 + (nrm * 3 + 0) * 1024 + k];
    const float sc = mods[(size_t)(l * 9 + b9) * 6144 + (nrm * 3 + 1) * 1024 + k];
    float* t = tab + ((size_t)(l * 2 + nrm) * 9 + b9) * 2048;
    t[k] = g * (1.f + sc); t[1024 + k] = sh;
  }
}

struct LoadBf16 {
  const u16* A; int lda;
  DI void init(int m0) {}
  DI uint4 load(int i, int m0, int k0) const {
    LAUNDER_IDS
    const int tid = tid__, kc = (tid & 7) * 8;
    return *(const uint4*)(A + (size_t)(m0 + (tid >> 3) + i * 32) * lda + k0 + kc);
  }
};
struct LoadNorm {
  const float* xl; const float* xc; const float* rs; const float* tab;
  float r0, r1, r2, r3;
  DI void init(int m0) {
    LAUNDER_IDS
    const int tid = tid__;
    r0 = rs[m0 + (tid >> 3)]; r1 = rs[m0 + (tid >> 3) + 32]; r2 = rs[m0 + (tid >> 3) + 64]; r3 = rs[m0 + (tid >> 3) + 96];
  }
  DI uint4 load(int i, int m0, int k0) const {
    LAUNDER_IDS
    const int tid = tid__, kc = (tid & 7) * 8;
    const int b9 = m0 < NTL ? m0 >> 12 : 8;
    const float* t = tab + b9 * 2048 + k0 + kc;
    const float4 g0 = *(const float4*)t, g1 = *(const float4*)(t + 4), s0 = *(const float4*)(t + 1024), s1 = *(const float4*)(t + 1028);
    const float* xp = xrow(xl, xc, m0 + (tid >> 3)) + k0 + kc + (size_t)i * 32 * D;
    const float4 x0 = *(const float4*)xp, x1 = *(const float4*)(xp + 4);
    const float rr = i == 0 ? r0 : i == 1 ? r1 : i == 2 ? r2 : r3;
    uint4 o;
    o.x = pack2(x0.x * rr * g0.x + s0.x, x0.y * rr * g0.y + s0.y);
    o.y = pack2(x0.z * rr * g0.z + s0.z, x0.w * rr * g0.w + s0.w);
    o.z = pack2(x1.x * rr * g1.x + s1.x, x1.y * rr * g1.y + s1.y);
    o.w = pack2(x1.z * rr * g1.z + s1.z, x1.w * rr * g1.w + s1.w);
    return o;
  }
};

DI bool tile_map(int it, int NTM, int NTN, int blk, int nblk, int& tm, int& tn) {
  const int xcd = blk & 7, local = blk >> 3, LB = nblk >> 3;
  const int R = NTM >> 3;
  const int s = it * LB + local;
  if (s >= R * NTN) return false;
  const int F = R >> 3, per_full = 8 * NTN;
  int mg, r, gm;
  if (s < F * per_full) { mg = s / per_full; r = s - mg * per_full; gm = 8; }
  else { mg = F; r = s - F * per_full; gm = R - F * 8; }
  const int ng = r / (gm * 8);
  const int r2 = r - ng * gm * 8;
  const int mi = r2 % gm, ni = r2 / gm;
  tm = xcd * R + mg * 8 + mi; tn = ng * 8 + ni;
  return true;
}
constexpr int LDT = 72;
template <int NI, class LA>
DI void gemm_mainloop(f32x4 (&acc)[4][NI], LA la, const u16* __restrict__ Bt, int ldb, int K, int m0, int n0, char* smem) {
  LAUNDER_IDS
  constexpr int NBI = NI;
  u16* As = (u16*)smem; u16* Bs = As + 2 * 128 * LDT;
  const int tid = tid__, lane = tid & 63, wave = tid >> 6, wr = wave >> 1, wc = wave & 1, lr = lane & 15, lq = lane >> 4;
  uint4 ra[4], rb[NBI];
  la.init(m0);
#pragma unroll
  for (int i = 0; i < 4; ++i) ra[i] = la.load(i, m0, 0);
#pragma unroll
  for (int i = 0; i < NBI; ++i) {
    const int c = tid + i * 256, row = c >> 3, kc = (c & 7) * 8;
    rb[i] = *(const uint4*)(Bt + (size_t)(n0 + row) * ldb + kc);
  }
#pragma unroll
  for (int i = 0; i < 4; ++i) {
    const int c = tid + i * 256, row = c >> 3, kc = (c & 7) * 8;
    *(uint4*)(As + row * LDT + kc) = ra[i];
    if (i < NBI) *(uint4*)(Bs + row * LDT + kc) = rb[i];
  }
  __syncthreads();
  const int nk = K >> 6;
  for (int kt = 0; kt < nk; ++kt) {
    const int cur = kt & 1;
    if (kt + 1 < nk) {
      const int k0 = (kt + 1) * 64;
#pragma unroll
      for (int i = 0; i < 4; ++i) ra[i] = la.load(i, m0, k0);
#pragma unroll
      for (int i = 0; i < NBI; ++i) {
        const int c = tid + i * 256, row = c >> 3, kc = (c & 7) * 8;
        rb[i] = *(const uint4*)(Bt + (size_t)(n0 + row) * ldb + k0 + kc);
      }
    }
    const u16* Ac = As + cur * 128 * LDT + (wr * 64 + lr) * LDT + lq * 8;
    const u16* Bc = Bs + cur * 128 * LDT + (wc * 16 * NI + lr) * LDT + lq * 8;
#pragma unroll
    for (int ks = 0; ks < 2; ++ks) {
      bf16x8 af[4], bfr[NI];
#pragma unroll
      for (int mi = 0; mi < 4; ++mi) af[mi] = *(const bf16x8*)(Ac + mi * 16 * LDT + ks * 32);
#pragma unroll
      for (int ni = 0; ni < NI; ++ni) bfr[ni] = *(const bf16x8*)(Bc + ni * 16 * LDT + ks * 32);
#pragma unroll
      for (int mi = 0; mi < 4; ++mi)
#pragma unroll
        for (int ni = 0; ni < NI; ++ni)
          acc[mi][ni] = __builtin_amdgcn_mfma_f32_16x16x32_bf16(bfr[ni], af[mi], acc[mi][ni], 0, 0, 0);
    }
    if (kt + 1 < nk) {
      const int nxt = cur ^ 1;
#pragma unroll
      for (int i = 0; i < 4; ++i) {
        const int c = tid + i * 256, row = c >> 3, kc = (c & 7) * 8;
        *(uint4*)(As + nxt * 128 * LDT + row * LDT + kc) = ra[i];
        if (i < NBI) *(uint4*)(Bs + nxt * 128 * LDT + row * LDT + kc) = rb[i];
      }
    }
    __syncthreads();
  }
}
template <int NI>
DI void zero_acc(f32x4 (&acc)[4][NI]) {
#pragma unroll
  for (int i = 0; i < 4; ++i)
#pragma unroll
    for (int j = 0; j < NI; ++j) acc[i][j] = f32x4{0.f, 0.f, 0.f, 0.f};
}
template <int MI, int NI>
DI void gemm256(f32x4 (&acc)[MI][NI], const u16* __restrict__ A, int lda, const u16* __restrict__ Bt, int ldb, int K, int m0, int n0, char* smem) {
  LAUNDER_IDS
  const int lane = tid__ & 63, wave = tid__ >> 6, wr = wave >> 1, wc = wave & 1, lr = lane & 15, lq = lane >> 4;
  constexpr int NAW = MI / 2;
  constexpr int NBW = NI / 2;
  constexpr int ABYTES = MI * 2 * 1024;
  constexpr int STAGE = ABYTES + NI * 2 * 1024;
  constexpr int LPS = NAW + NBW;
  static_assert(3 * STAGE <= 73728, "ring does not fit");
  const int srow = lane >> 2, scol = ((lane & 3) ^ ((lane >> 5) << 1)) * 8;
  const u16* Ag = A + (size_t)(m0 + wave * NAW * 16 + srow) * lda + scol;
  const u16* Bg = Bt + (size_t)(n0 + wave * NBW * 16 + srow) * ldb + scol;
  char* la = smem + (wave * NAW) * 1024 + lane * 16;
  char* lb = smem + ABYTES + (wave * NBW) * 1024 + lane * 16;
#define G256_ISSUE(S, K0) do { \
    _Pragma("unroll") for (int j_ = 0; j_ < NAW; ++j_) \
      __builtin_amdgcn_global_load_lds((const unsigned*)(Ag + (size_t)j_ * 16 * lda + (K0)), (__attribute__((address_space(3))) unsigned*)(la + (S) * STAGE + j_ * 1024), 16, 0, 0); \
    _Pragma("unroll") for (int j_ = 0; j_ < NBW; ++j_) \
      __builtin_amdgcn_global_load_lds((const unsigned*)(Bg + (size_t)j_ * 16 * ldb + (K0)), (__attribute__((address_space(3))) unsigned*)(lb + (S) * STAGE + j_ * 1024), 16, 0, 0); \
  } while (0)
  const int nk = K >> 5;
  G256_ISSUE(0, 0);
  if (nk > 1) G256_ISSUE(1, 32);
  const int foff = lr * 64 + ((lq ^ ((lr >> 3) << 1)) * 16);
  int st = 0;
  for (int kt = 0; kt < nk; ++kt) {
    if (kt + 1 < nk) asm volatile("s_waitcnt vmcnt(%0) lgkmcnt(0)" :: "n"(LPS) : "memory");
    else asm volatile("s_waitcnt vmcnt(0) lgkmcnt(0)" ::: "memory");
    __builtin_amdgcn_s_barrier();
    if (kt + 2 < nk) { const int s2 = st >= 1 ? st - 1 : 2; G256_ISSUE(s2, (kt + 2) * 32); }
    const char* sb = smem + st * STAGE + foff;
    bf16x8 af[MI], bfr[NI];
#pragma unroll
    for (int mi = 0; mi < MI; ++mi) af[mi] = *(const bf16x8*)(sb + (wr * MI + mi) * 1024);
#pragma unroll
    for (int ni = 0; ni < NI; ++ni) bfr[ni] = *(const bf16x8*)(sb + ABYTES + (wc * NI + ni) * 1024);
#pragma unroll
    for (int mi = 0; mi < MI; ++mi)
#pragma unroll
      for (int ni = 0; ni < NI; ++ni)
        acc[mi][ni] = __builtin_amdgcn_mfma_f32_16x16x32_bf16(bfr[ni], af[mi], acc[mi][ni], 0, 0, 0);
    st = st == 2 ? 0 : st + 1;
  }
  asm volatile("s_waitcnt lgkmcnt(0)" ::: "memory");
  __builtin_amdgcn_s_barrier();
#undef G256_ISSUE
}
template <int MI, int NI>
DI void zero_accm(f32x4 (&acc)[MI][NI]) {
#pragma unroll
  for (int i = 0; i < MI; ++i)
#pragma unroll
    for (int j = 0; j < NI; ++j) acc[i][j] = f32x4{0.f, 0.f, 0.f, 0.f};
}
#define EPI_BEGIN const int lr1_ = launder_v(lr), lq1_ = launder_v(lq), wr1_ = launder_v(wr), wc1_ = launder_v(wc); { const int lr = lr1_, lq = lq1_, wr = wr1_, wc = wc1_; (void)lr; (void)lq; (void)wr; (void)wc;
#define EPI_END }
#define WAVE_COORDS const int lane = tid__ & 63, wave = tid__ >> 6, wr = wave >> 1, wc = wave & 1, lr = lane & 15, lq = lane >> 4; (void)wr; (void)wc; (void)lr; (void)lq;

DI void phase_zgemm(const Params& p, int l, char* smem) {
  LAUNDER_IDS
  WAVE_COORDS
  const u16* Wt = (const u16*)(p.ws + OFF_W + (size_t)l * W_LAYER + WO_WIN);
  const u16* hb = (const u16*)(p.ws + OFF_HB1);
  u16* za = (u16*)(p.ws + OFF_R2); u16* zr = (u16*)(p.ws + OFF_R1);
  for (int it = 0;; ++it) {
    int tm, tn;
    if (!tile_map(it, NT / 256, 17, blk__, gridDim.x, tm, tn)) break;
    const int m0 = tm * 256, n0 = tn * 128;
    f32x4 acc[8][4]; zero_accm<8, 4>(acc);
    gemm256<8, 4>(acc, hb, 1024, Wt, 1024, 1024, m0, n0, smem);
    EPI_BEGIN
#pragma unroll
    for (int mi = 0; mi < 8; ++mi) {
      const int m = m0 + wr * 128 + mi * 16 + lr;
#pragma unroll
      for (int ni = 0; ni < 4; ++ni) {
        const int n = n0 + wc * 64 + ni * 16 + lq * 4;
        uint2 v; v.x = pack2(acc[mi][ni][0], acc[mi][ni][1]); v.y = pack2(acc[mi][ni][2], acc[mi][ni][3]);
        if (n < ZA) *(uint2*)(za + (size_t)m * ZA + n) = v;
        else if (n < ZA + ZR) *(uint2*)(zr + (size_t)m * ZR + (n - ZA)) = v;
      }
    }
    EPI_END
  }
}

DI void phase_tokA(const Params& p, int l) {
  LAUNDER_IDS
  const int wave = tid__ >> 6, lane = tid__ & 63;
  const u16* za = (const u16*)(p.ws + OFF_R2);
  float* rsq = (float*)(p.ws + OFF_RSQ); float* rskv = (float*)(p.ws + OFF_RSKV);
  u16* krb = (u16*)(p.ws + OFF_KR);
  u16* pooled = (u16*)(p.ws + OFF_R4);
  const float* rt = (const float*)(p.ws + OFF_ROPE);
  const float* gk = p.in[I_GK] + l * 96;
  for (int r = blk__ * 4 + wave; r < NT; r += gridDim.x * 4) {
    const u16* z = za + (size_t)r * ZA;
    const bool lat = r < NTL;
    const int b = lat ? r >> 12 : (r - NTL) >> 8;
    const int t = lat ? r & 4095 : (r - NTL) & 255;
    const int Ls = lat ? L : LC;
    const int pos = lat ? t : 4096 + t;
    u16 zq[6], zk[4], pw[30], pc[4];
#pragma unroll
    for (int i = 0; i < 6; ++i) zq[i] = z[256 + i * 64 + lane];
#pragma unroll
    for (int i = 0; i < 4; ++i) zk[i] = z[640 + i * 64 + lane];
    const int d = lane & 31;
    const u16 kr_raw = z[896 + d];
    const float gkd = gk[64 + d];
    const int ri = d & 15;
    const int pp = ri < 8 ? (t >> 6) : (t & 63);
    const float cs = rt[(pp * 8 + (ri & 7)) * 2], sn = rt[(pp * 8 + (ri & 7)) * 2 + 1];
#pragma unroll
    for (int gi = 0; gi < 4; ++gi) {
      const int half = 1 << gi;
      pc[gi] = z[gi * 64 + lane];
#pragma unroll
      for (int j = 0; j < 2 * half; ++j) {
        const int qc = min(max(t - half + j, 0), Ls - 1);
        pw[2 * half - 2 + j] = z[(ptrdiff_t)(qc - t) * ZA + gi * 64 + lane];
      }
    }
    float sq = 0.f, skv = 0.f;
#pragma unroll
    for (int i = 0; i < 6; ++i) { const float v = bf2f(zq[i]); sq += v * v; }
#pragma unroll
    for (int i = 0; i < 4; ++i) { const float v = bf2f(zk[i]); skv += v * v; }
    sq = wavesum(sq); skv = wavesum(skv);
    const float rq = rsqrtf(sq * (1.f / 384.f) + 1e-6f), rkv = rsqrtf(skv * (1.f / 256.f) + 1e-6f);
    float kr = bf2f(kr_raw);
    float ss = rowsum16(kr * kr);
    { const int si = __builtin_bit_cast(int, ss);
      ss = __builtin_bit_cast(float, __builtin_amdgcn_readlane(si, 0)) + __builtin_bit_cast(float, __builtin_amdgcn_readlane(si, 16)); }
    kr = kr * rsqrtf(ss * (1.f / 32.f) + 1e-6f) * gkd;
    const float other = __shfl_xor(kr, 16, 64);
    const float rot = d < 16 ? kr * cs - other * sn : other * sn + kr * cs;
    const float outv = lat ? rot : kr;
    float pv[4];
#pragma unroll
    for (int gi = 0; gi < 4; ++gi) {
      const int half = 1 << gi;
      const int lo = max(t - half, 0), hi = min(t + half, Ls);
      float sm = 0.f;
#pragma unroll
      for (int j = 0; j < 2 * half; ++j) {
        const int q = t - half + j;
        sm += (q >= 0 && q < Ls) ? bf2f(pw[2 * half - 2 + j]) : 0.f;
      }
      pv[gi] = sm / (float)(hi - lo) - bf2f(pc[gi]);
    }
    if (lane == 0) { rsq[r] = rq; rskv[r] = rkv; }
    if (lane < 32) krb[(size_t)r * 32 + d] = f2bf(outv);
#pragma unroll
    for (int gi = 0; gi < 4; ++gi) pooled[(size_t)r * 256 + gi * 64 + lane] = f2bf(pv[gi]);
  }
}

constexpr int ZSL = 1160, TAL = 392;
DI void phase_tokB(const Params& p, int l, char* smem) {
  LAUNDER_IDS
  WAVE_COORDS
  const int tid = tid__;
  u16* Zs = (u16*)smem;
  u16* TA = Zs + 18 * ZSL;
  float* PV = (float*)(TA + 16 * TAL);
  const u16* zr = (const u16*)(p.ws + OFF_R1);
  const char* wl = p.ws + OFF_W + (size_t)l * W_LAYER;
  u16* sc = (u16*)(p.ws + OFF_R3);
  __syncthreads();
  for (int e = tid; e < 2 * ZR + 7 * 256; e += 256) {
    float v;
    if (e < 2 * ZR) v = p.in[I_MU][(size_t)l * 2 * ZR + e];
    else { const int f = e - 2 * ZR, a = f >> 8, c = f & 255;
      v = a == 0 ? p.in[I_KK][l * 256 + c] : a < 3 ? p.in[I_W0][(size_t)(l * 2 + a - 1) * 256 + c] : a < 5 ? p.in[I_A0][(size_t)(l * 2 + a - 3) * 256 + c] : p.in[I_KA][(size_t)(l * 2 + a - 5) * 256 + c]; }
    PV[e] = v;
  }
  const float* mu0 = PV; const float* mu1 = PV + ZR; const float* kkw = PV + 2 * ZR;
  const float* w0p = kkw + 256; const float* a0p = w0p + 512; const float* kap = a0p + 512;
  for (int tile = blk__; tile < NT / 16; tile += gridDim.x) {
    const int r0 = tile * 16;
    const bool lat = r0 < NTL;
    const int t0 = lat ? r0 & 4095 : (r0 - NTL) & 255;
    const int Ls = lat ? L : LC;
    __syncthreads();
    {
      uint4 v[11];
#pragma unroll
      for (int i = 0; i < 11; ++i) {
        const int c = tid + i * 256;
        const int ri = c / 144, ch = c - ri * 144;
        const int tt = t0 - 1 + ri;
        const int cc = min(c, 18 * 144 - 1);
        const int rc = cc / 144, chc = cc - rc * 144;
        const int ttc = min(max(t0 - 1 + rc, 0), Ls - 1);
        const uint4 ld = *(const uint4*)(zr + (size_t)(r0 - t0 + ttc) * ZR + chc * 8);
        const bool ok = (c < 18 * 144) && (tt >= 0) && (tt < Ls);
        v[i] = ok ? ld : make_uint4(0, 0, 0, 0);
      }
#pragma unroll
      for (int i = 0; i < 11; ++i) {
        const int c = tid + i * 256;
        const int ri = c / 144, ch = c - ri * 144;
        if (c < 18 * 144) {
          *(uint2*)(Zs + ri * ZSL + ch * 8) = make_uint2(v[i].x, v[i].y);
          *(uint2*)(Zs + ri * ZSL + ch * 8 + 4) = make_uint2(v[i].z, v[i].w);
        }
      }
    }
    __syncthreads();
#pragma unroll 4
    for (int e = tid; e < 16 * 384; e += 256) {
      const int i = e / 384, c = e - i * 384, zc = 768 + c;
      const float z = bf2f(Zs[(i + 1) * ZSL + zc]), zp = bf2f(Zs[i * ZSL + zc]), zn = bf2f(Zs[(i + 2) * ZSL + zc]);
      float v = z + mu0[zc] * (zp - z) + mu1[zc] * (zn - z);
      if (c < 128) v = 1.f - 2.f / (1.f + __expf(2.f * v)); else if (c >= 256) v = sigmoidf_(v);
      TA[i * TAL + c] = f2bf(v);
    }
    __syncthreads();
    const int row = r0 + lr;
    auto shifted4 = [&](int zc, float (&out)[4]) {
      const uint2 c0 = *(const uint2*)(Zs + (lr + 1) * ZSL + zc), cp = *(const uint2*)(Zs + lr * ZSL + zc), cn = *(const uint2*)(Zs + (lr + 2) * ZSL + zc);
      const float4 m0 = *(const float4*)(mu0 + zc), m1 = *(const float4*)(mu1 + zc);
      float z, zp, zn;
      z = bflo(c0.x); zp = bflo(cp.x); zn = bflo(cn.x); out[0] = z + m0.x * (zp - z) + m1.x * (zn - z);
      z = bfhi(c0.x); zp = bfhi(cp.x); zn = bfhi(cn.x); out[1] = z + m0.y * (zp - z) + m1.y * (zn - z);
      z = bflo(c0.y); zp = bflo(cp.y); zn = bflo(cn.y); out[2] = z + m0.z * (zp - z) + m1.z * (zn - z);
      z = bfhi(c0.y); zp = bfhi(cp.y); zn = bfhi(cn.y); out[3] = z + m0.w * (zp - z) + m1.w * (zn - z);
    };
    auto product128 = [&](f32x4 (&ac)[4], const u16* W, int off) {
      bf16x8 aop[4][4];
#pragma unroll
      for (int ks = 0; ks < 4; ++ks)
#pragma unroll
        for (int ni = 0; ni < 4; ++ni) aop[ks][ni] = *(const bf16x8*)(W + (size_t)(wave * 64 + ni * 16 + lr) * 128 + ks * 32 + lq * 8);
#pragma unroll
      for (int ni = 0; ni < 4; ++ni) ac[ni] = f32x4{0.f, 0.f, 0.f, 0.f};
#pragma unroll
      for (int ks = 0; ks < 4; ++ks) {
        const bf16x8 bop = *(const bf16x8*)(TA + lr * TAL + off + ks * 32 + lq * 8);
#pragma unroll
        for (int ni = 0; ni < 4; ++ni) ac[ni] = __builtin_amdgcn_mfma_f32_16x16x32_bf16(aop[ks][ni], bop, ac[ni], 0, 0, 0);
      }
      __builtin_amdgcn_sched_barrier(0);
    };
    auto product64x2 = [&](f32x4 (&ac0)[4], f32x4 (&ac1)[4], const u16* W0, const u16* W1, int off0, int off1) {
      bf16x8 a0[2][4], a1[2][4];
#pragma unroll
      for (int ks = 0; ks < 2; ++ks)
#pragma unroll
        for (int ni = 0; ni < 4; ++ni) {
          a0[ks][ni] = *(const bf16x8*)(W0 + (size_t)(wave * 64 + ni * 16 + lr) * 64 + ks * 32 + lq * 8);
          a1[ks][ni] = *(const bf16x8*)(W1 + (size_t)(wave * 64 + ni * 16 + lr) * 64 + ks * 32 + lq * 8);
        }
#pragma unroll
      for (int ni = 0; ni < 4; ++ni) { ac0[ni] = f32x4{0.f, 0.f, 0.f, 0.f}; ac1[ni] = f32x4{0.f, 0.f, 0.f, 0.f}; }
#pragma unroll
      for (int ks = 0; ks < 2; ++ks) {
        const bf16x8 b0 = *(const bf16x8*)(TA + lr * TAL + off0 + ks * 32 + lq * 8);
        const bf16x8 b1 = *(const bf16x8*)(TA + lr * TAL + off1 + ks * 32 + lq * 8);
#pragma unroll
        for (int ni = 0; ni < 4; ++ni) {
          ac0[ni] = __builtin_amdgcn_mfma_f32_16x16x32_bf16(a0[ks][ni], b0, ac0[ni], 0, 0, 0);
          ac1[ni] = __builtin_amdgcn_mfma_f32_16x16x32_bf16(a1[ks][ni], b1, ac1[ni], 0, 0, 0);
        }
      }
      __builtin_amdgcn_sched_barrier(0);
    };
    float ss = 0.f;
#pragma unroll
    for (int ni = 0; ni < 4; ++ni) {
      const int ch = wave * 64 + ni * 16 + lq * 4;
      float kx[4]; shifted4(256 + ch, kx);
      const float4 kw = *(const float4*)(kkw + ch);
      const float a0 = kx[0] * kw.x, a1 = kx[1] * kw.y, a2 = kx[2] * kw.z, a3 = kx[3] * kw.w;
      ss += a0 * a0 + a1 * a1 + a2 * a2 + a3 * a3;
    }
    ss += __shfl_xor(ss, 16, 64); ss += __shfl_xor(ss, 32, 64);
    const float kinv = rsqrtf(fmaxf(ss, 1e-24f));
    {
      f32x4 ag[4];
      product128(ag, (const u16*)(wl + WO_RG2), 256);
#pragma unroll
      for (int ni = 0; ni < 4; ++ni) {
        const int ch = wave * 64 + ni * 16 + lq * 4;
        const size_t o = (size_t)row * 256 + ch;
        float rx[4], kx[4], vx[4];
        shifted4(ch, rx); shifted4(256 + ch, kx); shifted4(512 + ch, vx);
        const float4 kw = *(const float4*)(kkw + ch);
        *(uint2*)(sc + SA_R * (size_t)NT * 256 + o) = make_uint2(pack2(rx[0], rx[1]), pack2(rx[2], rx[3]));
        *(uint2*)(sc + SA_V * (size_t)NT * 256 + o) = make_uint2(pack2(vx[0], vx[1]), pack2(vx[2], vx[3]));
        *(uint2*)(sc + SA_KKN * (size_t)NT * 256 + o) = make_uint2(pack2(-kx[0] * kw.x * kinv, -kx[1] * kw.y * kinv), pack2(-kx[2] * kw.z * kinv, -kx[3] * kw.w * kinv));
        *(uint2*)(sc + SA_G * (size_t)NT * 256 + o) = make_uint2(pack2(ag[ni][0], ag[ni][1]), pack2(ag[ni][2], ag[ni][3]));
        __builtin_amdgcn_sched_barrier(0);
      }
    }
#pragma unroll 1
    for (int d = 0; d < 2; ++d) {
      f32x4 aw[4], aa[4];
      product64x2(aw, aa, (const u16*)(wl + WO_RW2) + (size_t)d * 256 * 64, (const u16*)(wl + WO_RA2) + (size_t)d * 256 * 64, d * 64, 128 + d * 64);
      u16* oOMW = sc + (d ? SA_OMWB : SA_OMWF) * (size_t)NT * 256;
      u16* oKD = sc + (d ? SA_KDB : SA_KDF) * (size_t)NT * 256;
      u16* oB = sc + (d ? SA_BB : SA_BF) * (size_t)NT * 256;
#pragma unroll
      for (int ni = 0; ni < 4; ++ni) {
        const int ch = wave * 64 + ni * 16 + lq * 4;
        const size_t o = (size_t)row * 256 + ch;
        float kx[4]; shifted4(256 + ch, kx);
        const float4 kw = *(const float4*)(kkw + ch);
        const float kkn[4] = {kx[0] * kw.x * kinv, kx[1] * kw.y * kinv, kx[2] * kw.z * kinv, kx[3] * kw.w * kinv};
        const float4 w0 = *(const float4*)(w0p + d * 256 + ch);
        const float4 a0 = *(const float4*)(a0p + d * 256 + ch);
        const float4 ka = *(const float4*)(kap + d * 256 + ch);
        const float w0a[4] = {w0.x, w0.y, w0.z, w0.w}, a0a[4] = {a0.x, a0.y, a0.z, a0.w}, kaa[4] = {ka.x, ka.y, ka.z, ka.w};
        float omw[4], kd[4], bb[4];
#pragma unroll
        for (int j = 0; j < 4; ++j) {
          const float xw = -(w0a[j] + aw[ni][j]);
          const float sp = fmaxf(xw, 0.f) + __logf(1.f + __expf(-fabsf(xw)));
          const float wlog = -sp - 0.5f;
          const float e = __expf(wlog);
          omw[j] = 1.f - __expf(-e);
          const float a = sigmoidf_(a0a[j] + aa[ni][j]);
          kd[j] = kx[j] * (1.f + (a - 1.f) * kaa[j]);
          bb[j] = kkn[j] * a;
        }
        *(uint2*)(oOMW + o) = make_uint2(pack2(omw[0], omw[1]), pack2(omw[2], omw[3]));
        *(uint2*)(oKD + o) = make_uint2(pack2(kd[0], kd[1]), pack2(kd[2], kd[3]));
        *(uint2*)(oB + o) = make_uint2(pack2(bb[0], bb[1]), pack2(bb[2], bb[3]));
        __builtin_amdgcn_sched_barrier(0);
      }
    }
  }
}

DI size_t qk_index(int m, int h) {
  const bool lat = m < NTL;
  const int b = lat ? m >> 12 : (m - NTL) >> 8;
  const int pos = lat ? m & 4095 : 4096 + ((m - NTL) & 255);
  return ((size_t)(b * 8 + h) * LK + pos) * 96;
}
DI void phase_qkv(const Params& p, int l, char* smem) {
  LAUNDER_IDS
  WAVE_COORDS
  const char* wl = p.ws + OFF_W + (size_t)l * W_LAYER;
  const u16* za = (const u16*)(p.ws + OFF_R2);
  const float* rsq0 = (const float*)(p.ws + OFF_RSQ); const float* rskv0 = (const float*)(p.ws + OFF_RSKV);
  u16* Qb = (u16*)(p.ws + OFF_R1); u16* Kb = (u16*)(p.ws + OFF_R1 + SZ_Q); u16* Vt = (u16*)(p.ws + OFF_R1 + 2 * SZ_Q);
  const float* rt0 = (const float*)(p.ws + OFF_ROPE);
  const float* gq0 = p.in[I_GQ] + l * 96; const float* gk0 = p.in[I_GK] + l * 96;
  const float QS = 0.10206207261596577f * 1.4426950408889634f;
  constexpr int NTM = NT / 256;
  for (int it = 0;; ++it) {
    int tm, tn;
    if (!tile_map(it, NTM, 6, blk__, gridDim.x, tm, tn)) break;
    f32x4 acc[8][4]; zero_accm<8, 4>(acc);
    {
      const int m0 = tm * 256, n0 = tn * 128;
      gemm256<8, 4>(acc, za + 256, ZA, (const u16*)(wl + WO_UQ), 384, 384, m0, n0, smem);
      EPI_BEGIN
      const float* gq = gq0; const float* rt = rt0; const float* rsq = rsq0;
      asm volatile("" : "+v"(gq), "+v"(rt), "+v"(rsq));
      const int nw = n0 + wc * 64;
#pragma unroll
      for (int mi = 0; mi < 8; ++mi) {
        __builtin_amdgcn_sched_barrier(0);
        const int m = m0 + wr * 128 + mi * 16 + lr;
        const float rs = rsq[m];
        if (nw < 512) {
          const int h = nw >> 6;
          float ss = 0.f;
#pragma unroll
          for (int ni = 0; ni < 4; ++ni)
#pragma unroll
            for (int j = 0; j < 4; ++j) { const float v = acc[mi][ni][j] * rs; ss += v * v; }
          ss += __shfl_xor(ss, 16, 64); ss += __shfl_xor(ss, 32, 64);
          const float f = rs * rsqrtf(ss * (1.f / 64.f) + 1e-6f) * QS;
          u16* dst = Qb + qk_index(m, h);
#pragma unroll
          for (int ni = 0; ni < 4; ++ni) {
            const int d = ni * 16 + lq * 4;
            const float4 g = *(const float4*)(gq + d);
            *(uint2*)(dst + d) = make_uint2(pack2(acc[mi][ni][0] * f * g.x, acc[mi][ni][1] * f * g.y), pack2(acc[mi][ni][2] * f * g.z, acc[mi][ni][3] * f * g.w));
          }
        } else {
          const bool lat = m < NTL;
          const int tt = m & 4095;
#pragma unroll
          for (int hh = 0; hh < 2; ++hh) {
            __builtin_amdgcn_sched_barrier(0);
            const int h = ((nw - 512) >> 5) + hh;
            float ss = 0.f;
#pragma unroll
            for (int ni = 0; ni < 2; ++ni)
#pragma unroll
              for (int j = 0; j < 4; ++j) { const float v = acc[mi][hh * 2 + ni][j] * rs; ss += v * v; }
            ss += __shfl_xor(ss, 16, 64); ss += __shfl_xor(ss, 32, 64);
            const float f = rs * rsqrtf(ss * (1.f / 32.f) + 1e-6f) * QS;
            const int i0 = lq * 4;
            const float4 g1 = *(const float4*)(gq + 64 + i0), g2 = *(const float4*)(gq + 80 + i0);
            const float g1a[4] = {g1.x, g1.y, g1.z, g1.w}, g2a[4] = {g2.x, g2.y, g2.z, g2.w};
            float o1[4], o2[4];
#pragma unroll
            for (int j = 0; j < 4; ++j) {
              const float x1 = acc[mi][hh * 2][j] * f * g1a[j], x2 = acc[mi][hh * 2 + 1][j] * f * g2a[j];
              float cs = 1.f, sn = 0.f;
              if (lat) {
                const int i = i0 + j;
                const int pp = i < 8 ? (tt >> 6) : (tt & 63);
                cs = rt[(pp * 8 + (i & 7)) * 2]; sn = rt[(pp * 8 + (i & 7)) * 2 + 1];
              }
              o1[j] = x1 * cs - x2 * sn; o2[j] = x1 * sn + x2 * cs;
            }
            u16* dst = Qb + qk_index(m, h) + 64;
            *(uint2*)(dst + i0) = make_uint2(pack2(o1[0], o1[1]), pack2(o1[2], o1[3]));
            *(uint2*)(dst + 16 + i0) = make_uint2(pack2(o2[0], o2[1]), pack2(o2[2], o2[3]));
          }
        }
      }
      EPI_END
    }
  }
  __builtin_amdgcn_sched_barrier(0);
  for (int it = 0;; ++it) {
    int tm, tn;
    if (!tile_map(it, NTM, 8, blk__, gridDim.x, tm, tn)) break;
    f32x4 acc[8][4]; zero_accm<8, 4>(acc);
    {
      const int h = tn, m0 = tm * 256, n0 = h * 128;
      gemm256<8, 4>(acc, za + 640, ZA, (const u16*)(wl + WO_UKV), 256, 256, m0, n0, smem);
      EPI_BEGIN
      const float* gk = gk0; const float* rskv = rskv0;
      asm volatile("" : "+v"(gk), "+v"(rskv));
#pragma unroll
      for (int mi = 0; mi < 8; ++mi) {
        __builtin_amdgcn_sched_barrier(0);
        const int m = m0 + wr * 128 + mi * 16 + lr;
        const float rs = rskv[m];
        if (wc == 0) {
          float ss = 0.f;
#pragma unroll
          for (int ni = 0; ni < 4; ++ni)
#pragma unroll
            for (int j = 0; j < 4; ++j) { const float v = acc[mi][ni][j] * rs; ss += v * v; }
          ss += __shfl_xor(ss, 16, 64); ss += __shfl_xor(ss, 32, 64);
          const float f = rs * rsqrtf(ss * (1.f / 64.f) + 1e-6f);
          u16* dst = Kb + qk_index(m, h);
#pragma unroll
          for (int ni = 0; ni < 4; ++ni) {
            const int d = ni * 16 + lq * 4;
            const float4 g = *(const float4*)(gk + d);
            *(uint2*)(dst + d) = make_uint2(pack2(acc[mi][ni][0] * f * g.x, acc[mi][ni][1] * f * g.y), pack2(acc[mi][ni][2] * f * g.z, acc[mi][ni][3] * f * g.w));
          }
          *(uint4*)(dst + 64 + lq * 8) = *(const uint4*)((const u16*)(p.ws + OFF_KR) + (size_t)m * 32 + lq * 8);
        } else {
          const bool lat = m < NTL;
          const int b = lat ? m >> 12 : (m - NTL) >> 8;
          const int pos = lat ? m & 4095 : 4096 + ((m - NTL) & 255);
          u16* dst = Vt + (size_t)(b * 8 + h) * 64 * LK + pos + (size_t)(lq * 4) * LK;
#pragma unroll
          for (int ni = 0; ni < 4; ++ni) {
            asm volatile("" : "+v"(dst));
#pragma unroll
            for (int j = 0; j < 4; ++j) dst[j * LK] = f2bf(acc[mi][ni][j] * rs);
            dst += 16 * LK;
          }
        }
      }
      EPI_END
    }
  }
}

DI int scan_row(int b, int dir, int s) {
  if (s < LC) return NTL + b * LC + (dir ? LC - 1 - s : s);
  const int t = s - LC;
  return b * L + (dir ? L - 1 - t : t);
}
DI void phase_scan(const Params& p, char* smem) {
  LAUNDER_IDS
  const int blk = blk__;
  if (blk >= 256) return;
  const int tid = tid__, lane = tid & 63, wave = tid >> 6, kq = lane & 15, rg = lane >> 4;
  const int chain = (blk & 7) + 8 * (blk >> 5), quarter = (blk >> 3) & 3;
  const int b = chain >> 3, h = (chain >> 1) & 3, dir = chain & 1;
  const u16* sc = (const u16*)(p.ws + OFF_R3);
  const size_t AS = (size_t)NT * 256;
  const u16* aOMW = sc + (dir ? SA_OMWB : SA_OMWF) * AS;
  const u16* aKD = sc + (dir ? SA_KDB : SA_KDF) * AS;
  const u16* aB = sc + (dir ? SA_BB : SA_BF) * AS;
  const u16* aKKN = sc + SA_KKN * AS;
  const u16* aR = sc + SA_R * AS;
  const u16* aV = sc + SA_V * AS;
  u16* Y = (u16*)(p.ws + OFF_R2) + (dir ? AS : 0);
  constexpr int CH = 16, BSZ = 5 * CH * 64 + CH * 16;
  float* buf = (float*)smem;
  const int st_ld = tid >> 4, k4 = (tid & 15) * 4;
  const int vrow = quarter * 16 + wave * 4 + rg;
  uint2 g0, g1, g2, g3, g4; u16 gv;
#define SCAN_GLOAD(CHUNK) do { \
    const int row_ = scan_row(b, dir, (CHUNK) * CH + st_ld); \
    const size_t o_ = (size_t)row_ * 256 + h * 64 + k4; \
    g0 = *(const uint2*)(aOMW + o_); g1 = *(const uint2*)(aKD + o_); g2 = *(const uint2*)(aB + o_); g3 = *(const uint2*)(aKKN + o_); g4 = *(const uint2*)(aR + o_); \
    gv = aV[(size_t)row_ * 256 + h * 64 + quarter * 16 + (tid & 15)]; } while (0)
#define SCAN_LSTORE(BI) do { \
    float* bb_ = buf + (BI) * BSZ + st_ld * 64 + k4; \
    *(float4*)(bb_ + 0 * CH * 64) = make_float4(1.f - bflo(g0.x), 1.f - bfhi(g0.x), 1.f - bflo(g0.y), 1.f - bfhi(g0.y)); \
    *(float4*)(bb_ + 1 * CH * 64) = make_float4(bflo(g1.x), bfhi(g1.x), bflo(g1.y), bfhi(g1.y)); \
    *(float4*)(bb_ + 2 * CH * 64) = make_float4(bflo(g2.x), bfhi(g2.x), bflo(g2.y), bfhi(g2.y)); \
    *(float4*)(bb_ + 3 * CH * 64) = make_float4(bflo(g3.x), bfhi(g3.x), bflo(g3.y), bfhi(g3.y)); \
    *(float4*)(bb_ + 4 * CH * 64) = make_float4(bflo(g4.x), bfhi(g4.x), bflo(g4.y), bfhi(g4.y)); \
    buf[(BI) * BSZ + 5 * CH * 64 + st_ld * 16 + (tid & 15)] = bf2f(gv); } while (0)
  float2_t S01 = {0.f, 0.f}, S23 = {0.f, 0.f};
  __builtin_amdgcn_s_setprio(3);
  __syncthreads();
  SCAN_GLOAD(0); SCAN_LSTORE(0);
  __syncthreads();
  constexpr int NCH = LK / CH;
  for (int c = 0; c < NCH; ++c) {
    if (c + 1 < NCH) SCAN_GLOAD(c + 1);
    const float* bb = buf + (c & 1) * BSZ;
    const int rowbase = scan_row(b, dir, c * CH);
    const int rstep = dir ? -1 : 1;
    const float* bl = bb + kq * 4;
    const float* bv = bb + 5 * CH * 64 + wave * 4 + rg;
    float4 fwv[3], fkv[3], fbv[3], fav[3], frv[3]; float vvv[3];
#pragma unroll
    for (int q = 0; q < 2; ++q) {
      fwv[q] = *(const float4*)(bl + 0 * CH * 64 + q * 64); fkv[q] = *(const float4*)(bl + 1 * CH * 64 + q * 64); fbv[q] = *(const float4*)(bl + 2 * CH * 64 + q * 64);
      fav[q] = *(const float4*)(bl + 3 * CH * 64 + q * 64); frv[q] = *(const float4*)(bl + 4 * CH * 64 + q * 64); vvv[q] = bv[q * 16];
    }
    float ysel = 0.f, ypart = 0.f;
#pragma unroll
    for (int s = 0; s < CH; ++s) {
      const float4 fw = fwv[s % 3], fk = fkv[s % 3], fb = fbv[s % 3], fa = fav[s % 3], fr = frv[s % 3];
      const float vv = vvv[s % 3];
      const float2_t a01 = {fa.x, fa.y}, a23 = {fa.z, fa.w};
      const float2_t w01 = {fw.x, fw.y}, w23 = {fw.z, fw.w}, k01 = {fk.x, fk.y}, k23 = {fk.z, fk.w}, b01 = {fb.x, fb.y}, b23 = {fb.z, fb.w};
      const float2_t r01 = {fr.x, fr.y}, r23 = {fr.z, fr.w};
      const float2_t vv2 = {vv, vv};
      if (s + 2 < CH) {
        constexpr int dummy = 0; (void)dummy;
        const int q = (s + 2) % 3;
        fwv[q] = *(const float4*)(bl + 0 * CH * 64 + (s + 2) * 64); fkv[q] = *(const float4*)(bl + 1 * CH * 64 + (s + 2) * 64); fbv[q] = *(const float4*)(bl + 2 * CH * 64 + (s + 2) * 64);
        fav[q] = *(const float4*)(bl + 3 * CH * 64 + (s + 2) * 64); frv[q] = *(const float4*)(bl + 4 * CH * 64 + (s + 2) * 64); vvv[q] = bv[(s + 2) * 16];
      }
      float2_t t2 = S01 * a01; t2 = S23 * a23 + t2;
      const float2_t q01 = S01 * w01 + vv2 * k01, q23 = S23 * w23 + vv2 * k23;
      float xs = t2.x + t2.y, ys = ypart;
      xs += __builtin_bit_cast(float, __builtin_amdgcn_update_dpp(0, __builtin_bit_cast(int, xs), 0x128, 0xf, 0xf, false));
      ys += __builtin_bit_cast(float, __builtin_amdgcn_update_dpp(0, __builtin_bit_cast(int, ys), 0x128, 0xf, 0xf, false));
      xs += __builtin_bit_cast(float, __builtin_amdgcn_update_dpp(0, __builtin_bit_cast(int, xs), 0x124, 0xf, 0xf, false));
      ys += __builtin_bit_cast(float, __builtin_amdgcn_update_dpp(0, __builtin_bit_cast(int, ys), 0x124, 0xf, 0xf, false));
      xs += __builtin_bit_cast(float, __builtin_amdgcn_update_dpp(0, __builtin_bit_cast(int, xs), 0x122, 0xf, 0xf, false));
      ys += __builtin_bit_cast(float, __builtin_amdgcn_update_dpp(0, __builtin_bit_cast(int, ys), 0x122, 0xf, 0xf, false));
      xs += __builtin_bit_cast(float, __builtin_amdgcn_update_dpp(0, __builtin_bit_cast(int, xs), 0x121, 0xf, 0xf, false));
      ys += __builtin_bit_cast(float, __builtin_amdgcn_update_dpp(0, __builtin_bit_cast(int, ys), 0x121, 0xf, 0xf, false));
      if (s > 0) ysel = (kq == s - 1) ? ys : ysel;
      const float2_t sa2 = {xs, xs};
      S01 = sa2 * b01 + q01; S23 = sa2 * b23 + q23;
      float2_t y2 = S01 * r01; y2 = S23 * r23 + y2;
      ypart = y2.x + y2.y;
    }
    { const float yl = rowsum16(ypart); ysel = (kq == CH - 1) ? yl : ysel; }
    Y[(size_t)(rowbase + rstep * kq) * 256 + h * 64 + vrow] = f2bf(ysel);
    if (c + 1 < NCH) SCAN_LSTORE((c + 1) & 1);
    __syncthreads();
  }
  __builtin_amdgcn_s_setprio(0);
#undef SCAN_GLOAD
#undef SCAN_LSTORE
}

constexpr int KSL = 104, VSL = 68;
template <int B0>
DI bf16x8 pack8(const f32x16& v) {
  uint4 pw;
  pw.x = pack2(v[B0 + 0], v[B0 + 1]); pw.y = pack2(v[B0 + 2], v[B0 + 3]); pw.z = pack2(v[B0 + 4], v[B0 + 5]); pw.w = pack2(v[B0 + 6], v[B0 + 7]);
  return __builtin_bit_cast(bf16x8, pw);
}
DI void pv_step(f32x16& o0, f32x16& o1, const u16* Vc, int r32, int kb, bf16x8 pf) {
  {
    const uint2 lo = *(const uint2*)(Vc + r32 * VSL + kb), hi2 = *(const uint2*)(Vc + r32 * VSL + kb + 8);
    const bf16x8 va = __builtin_bit_cast(bf16x8, make_uint4(lo.x, lo.y, hi2.x, hi2.y));
    o0 = __builtin_amdgcn_mfma_f32_32x32x16_bf16(va, pf, o0, 0, 0, 0);
  }
  {
    const uint2 lo = *(const uint2*)(Vc + (32 + r32) * VSL + kb), hi2 = *(const uint2*)(Vc + (32 + r32) * VSL + kb + 8);
    const bf16x8 va = __builtin_bit_cast(bf16x8, make_uint4(lo.x, lo.y, hi2.x, hi2.y));
    o1 = __builtin_amdgcn_mfma_f32_32x32x16_bf16(va, pf, o1, 0, 0, 0);
  }
}
DI void attn_item(const Params& p, int item, char* smem) {
  LAUNDER_IDS
  const int tid = tid__, lane = tid & 63, wave = tid >> 6, r32 = lane & 31, hi = lane >> 5;
  int bh, qpos0, key0, nkt, orow0;
  if (item < 2048) { bh = item >> 5; const int qb = item & 31; qpos0 = qb * 128; key0 = 0; nkt = LK / 64; orow0 = (bh >> 3) * L + qpos0; }
  else { const int it = item - 2048; bh = it >> 1; const int qb = it & 1; qpos0 = 4096 + qb * 128; key0 = 4096; nkt = LC / 64; orow0 = NTL + (bh >> 3) * LC + qb * 128; }
  const int h = bh & 7;
  const u16* Qp = (const u16*)(p.ws + OFF_R1) + ((size_t)bh * LK + qpos0 + wave * 32 + r32) * 96 + hi * 8;
  const u16* Kp = (const u16*)(p.ws + OFF_R1 + SZ_Q) + ((size_t)bh * LK + key0) * 96;
  const u16* Vp = (const u16*)(p.ws + OFF_R1 + 2 * SZ_Q) + (size_t)bh * 64 * LK + key0;
  u16* Ks = (u16*)smem;
  u16* Vs = Ks + 2 * 64 * KSL;
  bf16x8 qr[6];
#pragma unroll
  for (int d0 = 0; d0 < 6; ++d0) qr[d0] = *(const bf16x8*)(Qp + d0 * 16);
  uint4 ak0, ak1, ak2, av0, av1, bk0, bk1, bk2, bv0, bv1;
  const int kr0 = tid / 12, kc0 = tid - kr0 * 12, kr1 = (tid + 256) / 12, kc1 = (tid + 256) - kr1 * 12, kr2 = (tid + 512) / 12, kc2 = (tid + 512) - kr2 * 12;
  const int vd0 = tid >> 3, vc0 = tid & 7, vd1 = vd0 + 32;
#define gload(S, kt) do { \
    S##k0 = *(const uint4*)(Kp + (size_t)((kt) * 64 + kr0) * 96 + kc0 * 8); S##k1 = *(const uint4*)(Kp + (size_t)((kt) * 64 + kr1) * 96 + kc1 * 8); \
    S##k2 = *(const uint4*)(Kp + (size_t)((kt) * 64 + kr2) * 96 + kc2 * 8); \
    S##v0 = *(const uint4*)(Vp + (size_t)vd0 * LK + (kt) * 64 + vc0 * 8); S##v1 = *(const uint4*)(Vp + (size_t)vd1 * LK + (kt) * 64 + vc0 * 8); } while (0)
#define lstore(S, bi) do { \
    *(uint4*)(Ks + (bi) * 64 * KSL + kr0 * KSL + kc0 * 8) = S##k0; *(uint4*)(Ks + (bi) * 64 * KSL + kr1 * KSL + kc1 * 8) = S##k1; *(uint4*)(Ks + (bi) * 64 * KSL + kr2 * KSL + kc2 * 8) = S##k2; \
    { u16* dst = Vs + (bi) * 64 * VSL + vd0 * VSL + vc0 * 8; *(uint2*)dst = make_uint2(S##v0.x, S##v0.y); *(uint2*)(dst + 4) = make_uint2(S##v0.z, S##v0.w); } \
    { u16* dst = Vs + (bi) * 64 * VSL + vd1 * VSL + vc0 * 8; *(uint2*)dst = make_uint2(S##v1.x, S##v1.y); *(uint2*)(dst + 4) = make_uint2(S##v1.z, S##v1.w); } } while (0)
  f32x16 o0, o1;
#pragma unroll
  for (int i = 0; i < 16; ++i) { o0[i] = 0.f; o1[i] = 0.f; }
  float mrun = -1e30f, lrun = 0.f;
  auto tile_compute = [&](int cur) {
    const u16* Kc = Ks + cur * 64 * KSL;
    const u16* Vc = Vs + cur * 64 * VSL;
    f32x16 p0, p1;
#pragma unroll
    for (int i = 0; i < 16; ++i) { p0[i] = 0.f; p1[i] = 0.f; }
#pragma unroll
    for (int d0 = 0; d0 < 6; ++d0) {
      const bf16x8 a0 = *(const bf16x8*)(Kc + r32 * KSL + d0 * 16 + hi * 8);
      const bf16x8 a1 = *(const bf16x8*)(Kc + (32 + r32) * KSL + d0 * 16 + hi * 8);
      p0 = __builtin_amdgcn_mfma_f32_32x32x16_bf16(a0, qr[d0], p0, 0, 0, 0);
      p1 = __builtin_amdgcn_mfma_f32_32x32x16_bf16(a1, qr[d0], p1, 0, 0, 0);
    }
    float mx = p0[0];
#pragma unroll
    for (int i = 1; i < 16; ++i) mx = fmaxf(mx, p0[i]);
#pragma unroll
    for (int i = 0; i < 16; ++i) mx = fmaxf(mx, p1[i]);
    { auto rr = __builtin_amdgcn_permlane32_swap(__float_as_uint(mx), __float_as_uint(mx), false, false);
      mx = fmaxf(__uint_as_float(rr[0]), __uint_as_float(rr[1])); }
    if (!__all(mx - mrun <= 8.f)) {
      const float mn = fmaxf(mrun, mx);
      const float alpha = __builtin_amdgcn_exp2f(mrun - mn);
      mrun = mn; lrun *= alpha;
#pragma unroll
      for (int i = 0; i < 16; ++i) { o0[i] *= alpha; o1[i] *= alpha; }
    }
    float ps = 0.f;
#pragma unroll
    for (int i = 0; i < 16; ++i) { p0[i] = __builtin_amdgcn_exp2f(p0[i] - mrun); ps += p0[i]; }
#pragma unroll
    for (int i = 0; i < 16; ++i) { p1[i] = __builtin_amdgcn_exp2f(p1[i] - mrun); ps += p1[i]; }
    lrun += ps;
    pv_step(o0, o1, Vc, r32, 0 + hi * 4, pack8<0>(p0));
    pv_step(o0, o1, Vc, r32, 16 + hi * 4, pack8<8>(p0));
    pv_step(o0, o1, Vc, r32, 32 + hi * 4, pack8<0>(p1));
    pv_step(o0, o1, Vc, r32, 48 + hi * 4, pack8<8>(p1));
  };
  __syncthreads();
  gload(a, 0); lstore(a, 0);
  gload(a, 1);
  __syncthreads();
  for (int kt = 0; kt < nkt; kt += 2) {
    if (kt + 2 < nkt) gload(b, kt + 2);
    tile_compute(0);
    lstore(a, 1);
    __syncthreads();
    if (kt + 3 < nkt) gload(a, kt + 3);
    tile_compute(1);
    if (kt + 2 < nkt) lstore(b, 0);
    __syncthreads();
  }
  lrun += __shfl_xor(lrun, 32, 64);
  const float inv = 1.f / lrun;
  u16* om = (u16*)(p.ws + OFF_OMLA) + (size_t)(orow0 + wave * 32 + r32) * 512 + h * 64;
#pragma unroll
  for (int g = 0; g < 4; ++g) {
    const int d = 8 * g + 4 * hi;
    *(uint2*)(om + d) = make_uint2(pack2(o0[4 * g] * inv, o0[4 * g + 1] * inv), pack2(o0[4 * g + 2] * inv, o0[4 * g + 3] * inv));
    *(uint2*)(om + 32 + d) = make_uint2(pack2(o1[4 * g] * inv, o1[4 * g + 1] * inv), pack2(o1[4 * g + 2] * inv, o1[4 * g + 3] * inv));
  }
#undef gload
#undef lstore
}

DI void readout_row(const Params& p, int l, int r) {
  LAUNDER_IDS
  const int lane = tid__ & 63;
  const u16* sc = (const u16*)(p.ws + OFF_R3);
  const size_t AS = (size_t)NT * 256;
  const size_t o = (size_t)r * 256 + lane * 4;
  const u16* Yf = (const u16*)(p.ws + OFF_R2);
  const uint2 yf = *(const uint2*)(Yf + o), yb = *(const uint2*)(Yf + AS + o);
  const uint2 ur = *(const uint2*)(sc + SA_R * AS + o), uv = *(const uint2*)(sc + SA_V * AS + o);
  const uint2 kf = *(const uint2*)(sc + SA_KDF * AS + o), kb = *(const uint2*)(sc + SA_KDB * AS + o), ug = *(const uint2*)(sc + SA_G * AS + o);
  float y[4] = {bflo(yf.x) + bflo(yb.x), bfhi(yf.x) + bfhi(yb.x), bflo(yf.y) + bflo(yb.y), bfhi(yf.y) + bfhi(yb.y)};
  const float rr[4] = {bflo(ur.x), bfhi(ur.x), bflo(ur.y), bfhi(ur.y)};
  const float vv[4] = {bflo(uv.x), bfhi(uv.x), bflo(uv.y), bfhi(uv.y)};
  const float km[4] = {0.5f * (bflo(kf.x) + bflo(kb.x)), 0.5f * (bfhi(kf.x) + bfhi(kb.x)), 0.5f * (bflo(kf.y) + bflo(kb.y)), 0.5f * (bfhi(kf.y) + bfhi(kb.y))};
  const float gg[4] = {bflo(ug.x), bfhi(ug.x), bflo(ug.y), bfhi(ug.y)};
  const float4 rk4 = *(const float4*)(p.in[I_RK] + l * 256 + lane * 4);
  const float4 lw4 = *(const float4*)(p.in[I_LNW] + l * 256 + lane * 4);
  const float4 lb4 = *(const float4*)(p.in[I_LNB] + l * 256 + lane * 4);
  const float rk[4] = {rk4.x, rk4.y, rk4.z, rk4.w}, lw[4] = {lw4.x, lw4.y, lw4.z, lw4.w}, lb[4] = {lb4.x, lb4.y, lb4.z, lb4.w};
  float s = y[0] + y[1] + y[2] + y[3];
  s = rowsum16(s);
  const float mu = s * (1.f / 64.f);
  float q = 0.f, bn = 0.f;
#pragma unroll
  for (int j = 0; j < 4; ++j) { const float d = y[j] - mu; q += d * d; bn += rr[j] * km[j] * rk[j]; }
  q = rowsum16(q); bn = rowsum16(bn);
  const float rstd = rsqrtf(q * (1.f / 64.f) + 64e-5f);
  float ov[4];
#pragma unroll
  for (int j = 0; j < 4; ++j) ov[j] = ((y[j] - mu) * rstd * lw[j] + lb[j] + bn * vv[j]) * gg[j];
  u16* orw = (u16*)(p.ws + OFF_R3 + SA_KKN * SZ_TOK256 + (size_t)NT * 512 * 2);
  *(uint2*)(orw + o) = make_uint2(pack2(ov[0], ov[1]), pack2(ov[2], ov[3]));
}

DI void phase_attn(const Params& p, int l, char* smem) {
  LAUNDER_IDS
  __shared__ int qslot_sh;
  const int nattn = (l == 0) ? 2048 + 128 : 2048;
  unsigned* ctr = (unsigned*)(p.ws + OFF_BAR) + 16 + l * 16;
  for (;;) {
    __syncthreads();
    if (tid__ == 0) qslot_sh = (int)__hip_atomic_fetch_add(ctr, 1u, __ATOMIC_RELAXED, __HIP_MEMORY_SCOPE_AGENT);
    __syncthreads();
    const int it = qslot_sh;
    if (it >= nattn) break;
    attn_item(p, it, smem);
  }
}
DI void phase_readout(const Params& p, int l, int Mout) {
  LAUNDER_IDS
  const int wave = tid__ >> 6;
  for (int r = blk__ * 4 + wave; r < Mout; r += gridDim.x * 4) readout_row(p, l, r);
}

DI void phase_merge(const Params& p, int l, int Mout, char* smem) {
  LAUNDER_IDS
  WAVE_COORDS
  const char* wl = p.ws + OFF_W + (size_t)l * W_LAYER;
  const u16* hg = (const u16*)(p.ws + OFF_HBG);
  const u16* opool = (const u16*)(p.ws + OFF_R4);
  const u16* omla = (const u16*)(p.ws + OFF_OMLA);
  const u16* orw = (const u16*)(p.ws + OFF_R3 + SA_KKN * SZ_TOK256) + (size_t)NT * 512;
  u16* mo = (u16*)(p.ws + OFF_R1);
  const int ntm = Mout / 128;
  for (int it = 0;; ++it) {
    int tm, tn;
    if (!tile_map(it, ntm, 8, blk__, gridDim.x, tm, tn)) break;
    const int m0 = tm * 128, n0 = tn * 128;
    f32x4 msum[4][4]; zero_accm<4, 4>(msum);
#pragma unroll 1
    for (int br = 0; br < 3; ++br) {
      unsigned gpk[4][4][2];
      {
        f32x4 ag[4][4]; zero_accm<4, 4>(ag);
        gemm256<4, 4>(ag, hg, 1024, (const u16*)(wl + WO_WIN) + (size_t)(2080 + br * 1024) * 1024, 1024, 1024, m0, n0, smem);
#pragma unroll
        for (int mi = 0; mi < 4; ++mi)
#pragma unroll
          for (int ni = 0; ni < 4; ++ni) {
            gpk[mi][ni][0] = pack2(sigmoidf_(ag[mi][ni][0]), sigmoidf_(ag[mi][ni][1]));
            gpk[mi][ni][1] = pack2(sigmoidf_(ag[mi][ni][2]), sigmoidf_(ag[mi][ni][3]));
          }
      }
      __builtin_amdgcn_sched_barrier(0);
      f32x4 ab[4][4]; zero_accm<4, 4>(ab);
      {
        const int Kb = br == 1 ? 512 : 256;
        const u16* Ab = br == 0 ? opool : br == 1 ? omla : orw;
        const u16* Wb = (const u16*)(wl + (br == 0 ? WO_BRP : br == 1 ? WO_BRM : WO_BRR));
        gemm256<4, 4>(ab, Ab, Kb, Wb, Kb, Kb, m0, n0, smem);
      }
#pragma unroll
      for (int mi = 0; mi < 4; ++mi)
#pragma unroll
        for (int ni = 0; ni < 4; ++ni) {
          msum[mi][ni][0] += bflo(gpk[mi][ni][0]) * ab[mi][ni][0];
          msum[mi][ni][1] += bfhi(gpk[mi][ni][0]) * ab[mi][ni][1];
          msum[mi][ni][2] += bflo(gpk[mi][ni][1]) * ab[mi][ni][2];
          msum[mi][ni][3] += bfhi(gpk[mi][ni][1]) * ab[mi][ni][3];
        }
      __builtin_amdgcn_sched_barrier(0);
    }
    EPI_BEGIN
#pragma unroll
    for (int mi = 0; mi < 4; ++mi) {
      const int m = m0 + wr * 64 + mi * 16 + lr;
#pragma unroll
      for (int ni = 0; ni < 4; ++ni) {
        const int n = n0 + wc * 64 + ni * 16 + lq * 4;
        *(uint2*)(mo + (size_t)m * 1024 + n) = make_uint2(pack2(msum[mi][ni][0], msum[mi][ni][1]), pack2(msum[mi][ni][2], msum[mi][ni][3]));
      }
    }
    EPI_END
  }
}

DI void phase_resid(const Params& p, const u16* A, int K, const u16* Bt, const float* gate  ,
                    const float* xl_in, const float* xc_in, float* xl_out, float* xc_out, int Mout, char* smem) {
  LAUNDER_IDS
  WAVE_COORDS
  const int ntm = Mout / 256;
  for (int it = 0;; ++it) {
    int tm, tn;
    if (!tile_map(it, ntm, 8, blk__, gridDim.x, tm, tn)) break;
    const int m0 = tm * 256, n0 = tn * 128;
    f32x4 acc[8][4]; zero_accm<8, 4>(acc);
    gemm256<8, 4>(acc, A, K, Bt, K, K, m0, n0, smem);
    EPI_BEGIN
#pragma unroll
    for (int mi = 0; mi < 8; ++mi) {
      const int m = m0 + wr * 128 + mi * 16 + lr;
      const int b9 = m < NTL ? m >> 12 : 8;
      const float* xi = xrow(xl_in, xc_in, m);
      float* xo = m < NTL ? xl_out + (size_t)m * D : xc_out + (size_t)(m - NTL) * D;
#pragma unroll
      for (int ni = 0; ni < 4; ++ni) {
        const int n = n0 + wc * 64 + ni * 16 + lq * 4;
        const float4 g = *(const float4*)(gate + (size_t)b9 * 6144 + n);
        const float4 xv = *(const float4*)(xi + n);
        float4 ov;
        ov.x = xv.x + g.x * acc[mi][ni][0]; ov.y = xv.y + g.y * acc[mi][ni][1]; ov.z = xv.z + g.z * acc[mi][ni][2]; ov.w = xv.w + g.w * acc[mi][ni][3];
        *(float4*)(xo + n) = ov;
      }
      __builtin_amdgcn_sched_barrier(0);
    }
    EPI_END
  }
}
DI void phase_mlp1(const Params& p, int l, int Mout, char* smem) {
  LAUNDER_IDS
  WAVE_COORDS
  const char* wl = p.ws + OFF_W + (size_t)l * W_LAYER;
  const u16* hb = (const u16*)(p.ws + OFF_HB2);
  u16* U = (u16*)(p.ws + OFF_R1);
  const int ntm = Mout / 256;
  for (int it = 0;; ++it) {
    int tm, tn;
    if (!tile_map(it, ntm, 32, blk__, gridDim.x, tm, tn)) break;
    const int m0 = tm * 256, n0 = tn * 128;
    f32x4 acc[8][4]; zero_accm<8, 4>(acc);
    gemm256<8, 4>(acc, hb, 1024, (const u16*)(wl + WO_W1), 1024, 1024, m0, n0, smem);
    EPI_BEGIN
#pragma unroll
    for (int mi = 0; mi < 8; ++mi) {
      const int m = m0 + wr * 128 + mi * 16 + lr;
#pragma unroll
      for (int ni = 0; ni < 4; ++ni) {
        const int n = n0 + wc * 64 + ni * 16 + lq * 4;
        float v[4];
#pragma unroll
        for (int j = 0; j < 4; ++j) { const float a = fmaxf(acc[mi][ni][j], 0.f); v[j] = a * a; }
        *(uint2*)(U + (size_t)m * DFF + n) = make_uint2(pack2(v[0], v[1]), pack2(v[2], v[3]));
      }
      __builtin_amdgcn_sched_barrier(0);
    }
    EPI_END
  }
}

__global__ void __launch_bounds__(256, 2) fwd_megakernel(Params pk) {
  __shared__ __attribute__((aligned(16))) char smem[73728];
  cg::grid_group grid = cg::this_grid();
  if (threadIdx.x == 0) { g_base_sh[0] = (unsigned long long)pk.ws; g_base_sh[1] = (unsigned long long)pk.out; }
  xcd_barrier_post((unsigned*)(pk.ws + OFF_BAR));
  __syncthreads();
  phase_prep(pk, smem);
  if (pk.ws == nullptr) grid.sync();
  xcd_barrier();
  phase_tables(pk);
  xcd_barrier();
#define CTXBUF ((float*)(p.ws + OFF_CTX))
#define XLP (l == 0 ? p.in[I_X] : (const float*)p.out)
#define XCP (l == 0 ? p.in[I_CTX] : (const float*)CTXBUF)
#define MOUT (l == 0 ? NT : NTL)
#define WLP (p.ws + OFF_W + (size_t)l * W_LAYER)
#define TABP(nrm) ((const float*)(p.ws + OFF_TAB) + (size_t)(l * 2 + (nrm)) * 9 * 2048)
#define MODP(j) ((const float*)(p.ws + OFF_MODS) + (size_t)l * 9 * 6144 + (j) * 1024)
#ifndef PROBE_Q
#define PROBE_Q -1
#endif
#pragma nounroll
  for (int ph = 0; ph < 22; ++ph) {
    const int l = ph >= 11 ? 1 : 0, q = ph - l * 11;
    Params p = pk;
    {
      asm volatile("" ::: "memory");
      unsigned long long w_ = g_base_sh[0], o_ = g_base_sh[1];
      unsigned wl_ = (unsigned)w_, wh_ = (unsigned)(w_ >> 32), ol_ = (unsigned)o_, oh_ = (unsigned)(o_ >> 32);
      wl_ = __builtin_amdgcn_readfirstlane(wl_); wh_ = __builtin_amdgcn_readfirstlane(wh_); ol_ = __builtin_amdgcn_readfirstlane(ol_); oh_ = __builtin_amdgcn_readfirstlane(oh_);
      asm volatile("" : "+s"(wl_), "+s"(wh_), "+s"(ol_), "+s"(oh_));
      p.ws = (char*)(((unsigned long long)wh_ << 32) | wl_); p.out = (float*)(((unsigned long long)oh_ << 32) | ol_);
    }
#pragma nounroll
    for (int rep = 0; rep < (q == PROBE_Q ? 2 : 1); ++rep)
    switch (q) {
      case 0: phase_norm(XLP, XCP, TABP(0), (u16*)(p.ws + OFF_HB1), NT); break;
      case 1: phase_zgemm(p, l, smem); break;
      case 2: phase_tokA(p, l); phase_tokB(p, l, smem); break;
      case 3: phase_qkv(p, l, smem); break;
      case 4: phase_scan(p, smem); phase_attn(p, l, smem); break;
      case 5: phase_norm(XLP, XCP, TABP(0), (u16*)(p.ws + OFF_HBG), MOUT); phase_readout(p, l, MOUT); break;
      case 6: phase_merge(p, l, MOUT, smem); break;
      case 7: phase_resid(p, (const u16*)(p.ws + OFF_R1), 1024, (const u16*)(WLP + WO_WO), MODP(2), XLP, XCP, p.out, CTXBUF, MOUT, smem); break;
      case 8: phase_norm(p.out, CTXBUF, TABP(1), (u16*)(p.ws + OFF_HB2), MOUT); break;
      case 9: phase_mlp1(p, l, MOUT, smem); break;
      default: phase_resid(p, (const u16*)(p.ws + OFF_R1), 4096, (const u16*)(WLP + WO_W2), MODP(5), p.out, CTXBUF, p.out, CTXBUF, MOUT, smem); break;
    }
    if (ph != 21) xcd_barrier();
  }
}

extern "C" void kernel_launch(void* const* d_in, const int* in_sizes, int n_in, void* d_out, int out_size, void* d_ws, size_t ws_size, hipStream_t stream) {
  static int grid_blocks = 0;
  if (!grid_blocks) {
    int dev = 0, cus = 0, per_cu = 0;
    hipGetDevice(&dev);
    hipDeviceGetAttribute(&cus, hipDeviceAttributeMultiprocessorCount, dev);
    hipOccupancyMaxActiveBlocksPerMultiprocessor(&per_cu, fwd_megakernel, 256, 0);
    if (per_cu > 2) per_cu = 2;
    if (per_cu < 1) per_cu = 1;
    grid_blocks = cus * per_cu;
    if (ws_size < WS_END) fprintf(stderr, "kernel_launch: workspace too small: %zu < %zu\n", ws_size, (size_t)WS_END);
  }
  Params p{};
  for (int i = 0; i < 34; ++i) p.in[i] = (const float*)d_in[i];
  p.out = (float*)d_out;
  p.ws = (char*)d_ws;
  hipMemsetAsync(d_ws, 0, 16384, stream);
  void* args[] = {&p};
  hipError_t e = hipLaunchCooperativeKernel((void*)fwd_megakernel, dim3(grid_blocks), dim3(256), args, 0, stream);
  if (e != hipSuccess) fprintf(stderr, "cooperative launch failed: %s (grid %d)\n", hipGetErrorString(e), grid_blocks);
}
```

```cpp
#include <hip/hip_runtime.h>
#include <hip/hip_cooperative_groups.h>
#include <stdint.h>
#include <cstdio>
namespace cg = cooperative_groups;

typedef unsigned short u16;
typedef __attribute__((ext_vector_type(8))) short bf16x8;
typedef __attribute__((ext_vector_type(4))) float f32x4;
typedef __attribute__((ext_vector_type(16))) float f32x16;
typedef __bf16 bf16x2_t __attribute__((ext_vector_type(2)));
typedef float float2_t __attribute__((ext_vector_type(2)));

#define DI __device__ __forceinline__

constexpr int D = 1024, NB = 8, L = 4096, LC = 256, LK = 4352;
constexpr int NTL = NB * L;
constexpr int NTC = NB * LC;
constexpr int NT = NTL + NTC;
constexpr int INC = 5152;
constexpr int ZA = 928;
constexpr int ZR = 1152;
constexpr int DFF = 4096;

constexpr size_t al256(size_t x) { return (x + 255) / 256 * 256; }
constexpr size_t OFF_BAR = 0;
constexpr size_t OFF_MODS = 16384;
constexpr size_t OFF_TAB = OFF_MODS + al256(2 * 9 * 6144 * 4);
constexpr size_t OFF_ROPE = OFF_TAB + al256(2 * 2 * 9 * 2 * 1024 * 4);
constexpr size_t OFF_RS1 = OFF_ROPE + 4096;
constexpr size_t OFF_RS2 = OFF_RS1 + al256(NT * 4);
constexpr size_t OFF_RSQ = OFF_RS2 + al256(NT * 4);
constexpr size_t OFF_RSKV = OFF_RSQ + al256(NT * 4);
constexpr size_t OFF_CTX = OFF_RSKV + al256(NT * 4);
constexpr size_t OFF_W = OFF_CTX + (size_t)NTC * D * 4;
constexpr size_t WO_WIN = 0;
constexpr size_t WO_UQ = WO_WIN + (size_t)INC * 1024 * 2;
constexpr size_t WO_UKV = WO_UQ + (size_t)768 * 384 * 2;
constexpr size_t WO_BRP = WO_UKV + (size_t)1024 * 256 * 2;
constexpr size_t WO_BRM = WO_BRP + (size_t)1024 * 256 * 2;
constexpr size_t WO_BRR = WO_BRM + (size_t)1024 * 512 * 2;
constexpr size_t WO_WO = WO_BRR + (size_t)1024 * 256 * 2;
constexpr size_t WO_W1 = WO_WO + (size_t)1024 * 1024 * 2;
constexpr size_t WO_W2 = WO_W1 + (size_t)4096 * 1024 * 2;
constexpr size_t WO_RW2 = WO_W2 + (size_t)1024 * 4096 * 2;
constexpr size_t WO_RA2 = WO_RW2 + (size_t)2 * 256 * 64 * 2;
constexpr size_t WO_RG2 = WO_RA2 + (size_t)2 * 256 * 64 * 2;
constexpr size_t W_LAYER = al256(WO_RG2 + (size_t)256 * 128 * 2);
constexpr size_t OFF_R1 = OFF_W + 2 * W_LAYER;
constexpr size_t SZ_Q = (size_t)NB * 8 * LK * 96 * 2;
constexpr size_t SZ_VT = (size_t)NB * 8 * 64 * LK * 2;
constexpr size_t SZ_R1 = 2 * SZ_Q + SZ_VT;
constexpr size_t OFF_R2 = OFF_R1 + al256(SZ_R1);
constexpr size_t SZ_TOK256 = (size_t)NT * 256 * 2;
constexpr size_t OFF_R3 = OFF_R2 + al256((size_t)NT * ZA * 2);
constexpr size_t OFF_R4 = OFF_R3 + 10 * SZ_TOK256;
constexpr size_t OFF_KR = OFF_R4 + SZ_TOK256;
constexpr size_t OFF_OMLA = OFF_KR + al256((size_t)NT * 32 * 2);
constexpr size_t WS_END = OFF_OMLA + (size_t)NT * 512 * 2;
static_assert(WS_END <= 536870912ull, "workspace map exceeds 4x the largest tensor");
constexpr size_t OFF_HB1 = OFF_R3;
constexpr size_t OFF_HBG = OFF_R1 + (size_t)NT * 1024 * 2;
constexpr size_t OFF_HB2 = OFF_R3 + 5 * SZ_TOK256;
enum { SA_R = 0, SA_V = 1, SA_KDF = 2, SA_KDB = 3, SA_G = 4, SA_KKN = 5, SA_OMWF = 6, SA_BF = 7, SA_OMWB = 8, SA_BB = 9 };

struct Params { const float* in[34]; float* out; char* ws; };

enum { I_X = 0, I_C, I_CTX, I_CCTX, I_N1G, I_N2G, I_WADA, I_BADA, I_WIN, I_POOLW, I_POOLS, I_QNORM, I_WUQ, I_KVNORM, I_WUKV,
       I_GQ, I_GK, I_MU, I_W0, I_W2R, I_A0, I_A2R, I_KA, I_KK, I_RK, I_G2R, I_LNW, I_LNB, I_BRP, I_BRM, I_BRR, I_WO, I_W1, I_W2 };

DI float bf2f(u16 h) { return __uint_as_float(((unsigned)h) << 16); }
DI float bflo(unsigned u) { return __uint_as_float(u << 16); }
DI float bfhi(unsigned u) { return __uint_as_float(u & 0xffff0000u); }
DI unsigned pack2(float a, float b) { float2_t v = {a, b}; bf16x2_t r = __builtin_convertvector(v, bf16x2_t); return __builtin_bit_cast(unsigned, r); }
DI u16 f2bf(float a) { return (u16)(pack2(a, 0.f) & 0xffffu); }
DI float sigmoidf_(float x) { return 1.f / (1.f + __expf(-x)); }
DI float siluf_(float x) { return x / (1.f + __expf(-x)); }
DI float rowsum16(float x) {
  x += __builtin_bit_cast(float, __builtin_amdgcn_update_dpp(0, __builtin_bit_cast(int, x), 0x128, 0xf, 0xf, false));
  x += __builtin_bit_cast(float, __builtin_amdgcn_update_dpp(0, __builtin_bit_cast(int, x), 0x124, 0xf, 0xf, false));
  x += __builtin_bit_cast(float, __builtin_amdgcn_update_dpp(0, __builtin_bit_cast(int, x), 0x122, 0xf, 0xf, false));
  x += __builtin_bit_cast(float, __builtin_amdgcn_update_dpp(0, __builtin_bit_cast(int, x), 0x121, 0xf, 0xf, false));
  return x;
}
DI float wavesum(float x) {
  x = rowsum16(x);
  const int xi = __builtin_bit_cast(int, x);
  return __builtin_bit_cast(float, __builtin_amdgcn_readlane(xi, 0)) + __builtin_bit_cast(float, __builtin_amdgcn_readlane(xi, 16)) +
         __builtin_bit_cast(float, __builtin_amdgcn_readlane(xi, 32)) + __builtin_bit_cast(float, __builtin_amdgcn_readlane(xi, 48));
}
DI void grid_barrier(unsigned* ctr, unsigned& epoch) {
  asm volatile("s_waitcnt vmcnt(0)" ::: "memory");
  __syncthreads();
  epoch++;
  if (threadIdx.x == 0) {
    __builtin_amdgcn_fence(__ATOMIC_RELEASE, "agent");
    asm volatile("s_waitcnt vmcnt(0)" ::: "memory");
    const unsigned target = epoch * gridDim.x;
    __hip_atomic_fetch_add(ctr, 1u, __ATOMIC_RELAXED, __HIP_MEMORY_SCOPE_AGENT);
    while (__hip_atomic_load(ctr, __ATOMIC_RELAXED, __HIP_MEMORY_SCOPE_AGENT) < target) __builtin_amdgcn_s_sleep(2);
    __builtin_amdgcn_fence(__ATOMIC_ACQUIRE, "agent");
    asm volatile("s_waitcnt vmcnt(0)" ::: "memory");
  }
  __syncthreads();
}


#define XB_TMO      128
#define XB_XCNT(j)  (256  + 64 * (j))
#define XB_XSUB(j)  (1280 + 64 * (j))
#define XB_XGEN(j)  (2304 + 64 * (j))
#define XB_TOP      3328
#define XB_TOPGEN   3392
#define XB_SPIN_CAP (1u << 22)
#define LAS __attribute__((address_space(3)))
DI unsigned xb_ld(unsigned* p)              { return __hip_atomic_load(p, __ATOMIC_RELAXED, __HIP_MEMORY_SCOPE_AGENT); }
DI unsigned xb_add(unsigned* p, unsigned v) { return __hip_atomic_fetch_add(p, v, __ATOMIC_RELAXED, __HIP_MEMORY_SCOPE_AGENT); }
DI unsigned xb_xcc_id() { return (unsigned)__builtin_amdgcn_s_getreg((3 << 11) | 20) & 0xFu; }
#define XB_SPIN(cond, bar) do { unsigned _sp = 0; while (cond) { __builtin_amdgcn_s_sleep(1); \
    if ((++_sp & 255u) == 0u) { if (xb_ld(&(bar)[XB_TMO])) break; if (_sp > XB_SPIN_CAP) { atomicAdd(&(bar)[XB_TMO], 1u); break; } } } } while (0)
__shared__ uint4 g_xb_words;
__shared__ unsigned long long g_base_sh[2];
DI void xcd_barrier_post(unsigned* bar) {
  const unsigned x = xb_xcc_id();
  if (threadIdx.x == 0) { g_xb_words = make_uint4(0u, 0u, x, 0u); (void)xb_add(&bar[XB_XCNT(x)], 1u); }
}
DI void xcd_barrier_complete(unsigned* bar, unsigned x, unsigned& nloc, unsigned& nx) {
  const unsigned G = gridDim.x;
  unsigned sum, cnt, mine, sp = 0u;
  for (;;) {
    sum = 0u; cnt = 0u; mine = 0u;
#pragma unroll
    for (unsigned j = 0; j < 16; ++j) { const unsigned c = xb_ld(&bar[XB_XCNT(j)]); sum += c; cnt += (c > 0u) ? 1u : 0u; mine = (j == x) ? c : mine; }
    if (sum == G) break;
    __builtin_amdgcn_s_sleep(1);
    if ((++sp & 255u) == 0u) { if (xb_ld(&bar[XB_TMO])) break; if (sp > XB_SPIN_CAP) { atomicAdd(&bar[XB_TMO], 1u); break; } }
  }
  nloc = mine > 0u ? mine : 1u; nx = cnt > 0u ? cnt : 1u;
}
DI void xcd_barrier() {
  asm volatile("s_waitcnt vmcnt(0)" ::: "memory");
  __syncthreads();
  if (threadIdx.x == 0) {
    unsigned* bar = (unsigned*)(g_base_sh[0] + OFF_BAR);
    __builtin_amdgcn_s_waitcnt(0);
    unsigned nloc = g_xb_words.x, nx = g_xb_words.y; const unsigned x = g_xb_words.z;
    if (nloc == 0u) { xcd_barrier_complete(bar, x, nloc, nx); g_xb_words.x = nloc; g_xb_words.y = nx; }
    const unsigned old = xb_add(&bar[XB_XSUB(x)], 1u);
    const unsigned gen = old / nloc;
    if (old + 1u == (gen + 1u) * nloc) {
      __builtin_amdgcn_fence(__ATOMIC_RELEASE, "agent");
      asm volatile("s_waitcnt vmcnt(0)" ::: "memory");
      const unsigned og = xb_add(&bar[XB_TOP], 1u);
      const unsigned tg = og / nx;
      if (og + 1u == (tg + 1u) * nx) xb_add(&bar[XB_TOPGEN], 1u);
      else XB_SPIN(xb_ld(&bar[XB_TOPGEN]) == tg, bar);
      __builtin_amdgcn_fence(__ATOMIC_ACQUIRE, "agent");
      xb_add(&bar[XB_XGEN(x)], 1u);
      asm volatile("s_waitcnt vmcnt(0)" ::: "memory");
    } else {
      XB_SPIN(xb_ld(&bar[XB_XGEN(x)]) == gen, bar);
      __builtin_amdgcn_fence(__ATOMIC_ACQUIRE, "agent");
      asm volatile("s_waitcnt vmcnt(0)" ::: "memory");
    }
  }
  __syncthreads();
}
DI int launder_v(int x) { asm volatile("" : "+v"(x)); return x; }
DI int launder_s(int x) { asm volatile("" : "+s"(x)); return x; }
#define LAUNDER_IDS const int tid__ = launder_v((int)threadIdx.x); const int blk__ = launder_s((int)blockIdx.x); (void)tid__; (void)blk__;
DI void do_transpose(const float* __restrict__ src, int K, int N, u16* __restrict__ dst, const float* __restrict__ ksc, int perm, int tile, float* tl) {
  LAUNDER_IDS
  const int ntn = (N + 63) >> 6;
  const int kt = tile / ntn, nt = tile - kt * ntn;
  const int k0 = kt * 64, n0 = nt * 64;
  const int tid = tid__;
  __syncthreads();
#pragma unroll 4
  for (int i = 0; i < 16; ++i) {
    const int kk = i * 4 + (tid >> 6), nn = tid & 63;
    float v = 0.f;
    if (n0 + nn < N) v = src[(size_t)(k0 + kk) * N + n0 + nn];
    if (ksc) v *= ksc[k0 + kk];
    tl[kk * 65 + nn] = v;
  }
  __syncthreads();
#pragma unroll 4
  for (int i = 0; i < 16; ++i) {
    const int nn = i * 4 + (tid >> 6), kk = tid & 63;
    int n = n0 + nn;
    if (n < N) {
      if (perm) { const int h = n / 96, d = n - h * 96; n = d < 64 ? h * 64 + d : 512 + h * 32 + (d - 64); }
      dst[(size_t)n * K + k0 + kk] = f2bf(tl[kk * 65 + nn]);
    }
  }
}

DI void phase_prep(const Params& p, char* smem) {
  LAUNDER_IDS
  float* tl = (float*)smem;
  const int tid = tid__;
  constexpr int T_WIN = 16 * 81, T_UQ = 6 * 12, T_UKV = 4 * 16, T_BRM = 8 * 16, T_BRR = 4 * 16, T_WO = 16 * 16, T_W1 = 16 * 64, T_W2 = 64 * 16,
                T_RW2 = 4, T_RA2 = 4, T_RG2 = 2 * 4;
  constexpr int T_LAYER = T_WIN + T_UQ + T_UKV + T_BRM + T_BRR + T_WO + T_W1 + T_W2 + 2 * T_RW2 + 2 * T_RA2 + T_RG2;
  for (int g = blk__; g < 2 * T_LAYER; g += gridDim.x) {
    const int l = g / T_LAYER; int t = g - l * T_LAYER;
    char* wl = p.ws + OFF_W + (size_t)l * W_LAYER;
#define JOB(SRC, KK, NN, DSTOFF, SC, PERM, CNT) if (t < (CNT)) { do_transpose((SRC), (KK), (NN), (u16*)(wl + (DSTOFF)), (SC), (PERM), t, tl); continue; } t -= (CNT);
    JOB(p.in[I_WIN] + (size_t)l * 1024 * INC, 1024, INC, WO_WIN, nullptr, 0, T_WIN)
    JOB(p.in[I_WUQ] + (size_t)l * 384 * 768, 384, 768, WO_UQ, p.in[I_QNORM] + l * 384, 1, T_UQ)
    JOB(p.in[I_WUKV] + (size_t)l * 256 * 1024, 256, 1024, WO_UKV, p.in[I_KVNORM] + l * 256, 0, T_UKV)
    JOB(p.in[I_BRM] + (size_t)l * 512 * 1024, 512, 1024, WO_BRM, nullptr, 0, T_BRM)
    JOB(p.in[I_BRR] + (size_t)l * 256 * 1024, 256, 1024, WO_BRR, nullptr, 0, T_BRR)
    JOB(p.in[I_WO] + (size_t)l * 1024 * 1024, 1024, 1024, WO_WO, nullptr, 0, T_WO)
    JOB(p.in[I_W1] + (size_t)l * 1024 * 4096, 1024, 4096, WO_W1, nullptr, 0, T_W1)
    JOB(p.in[I_W2] + (size_t)l * 4096 * 1024, 4096, 1024, WO_W2, nullptr, 0, T_W2)
    JOB(p.in[I_W2R] + (size_t)(l * 2 + 0) * 64 * 256, 64, 256, WO_RW2, nullptr, 0, T_RW2)
    JOB(p.in[I_W2R] + (size_t)(l * 2 + 1) * 64 * 256, 64, 256, WO_RW2 + 256 * 64 * 2, nullptr, 0, T_RW2)
    JOB(p.in[I_A2R] + (size_t)(l * 2 + 0) * 64 * 256, 64, 256, WO_RA2, nullptr, 0, T_RA2)
    JOB(p.in[I_A2R] + (size_t)(l * 2 + 1) * 64 * 256, 64, 256, WO_RA2 + 256 * 64 * 2, nullptr, 0, T_RA2)
    JOB(p.in[I_G2R] + (size_t)l * 128 * 256, 128, 256, WO_RG2, nullptr, 0, T_RG2)
#undef JOB
  }
  for (int e = blk__ * 256 + tid; e < 2 * 256 * 1024; e += gridDim.x * 256) {
    const int l = e >> 18, r = e & 262143, cin = r >> 10, n = r & 1023, g = cin >> 6, c = cin & 63;
    const float* pw = p.in[I_POOLW] + ((size_t)(l * 4 + g) * 64 + c) * 64;
    const float* ps = p.in[I_POOLS] + l * 256 + g * 64;
    const float* wb = p.in[I_BRP] + ((size_t)l * 256 + g * 64) * 1024 + n;
    float s = 0.f;
    for (int d = 0; d < 64; ++d) s += pw[d] * ps[d] * wb[(size_t)d * 1024];
    ((u16*)(p.ws + OFF_W + (size_t)l * W_LAYER + WO_BRP))[(size_t)n * 256 + cin] = f2bf(s);
  }
  if (blk__ == gridDim.x - 1) {
    for (int e = tid; e < 512; e += 256) {
      const int pos = e >> 3, f = e & 7;
      const float inv = powf(10000.f, -(float)f / 8.f);
      const float ang = (float)pos * inv;
      float* rt = (float*)(p.ws + OFF_ROPE);
      rt[e * 2] = cosf(ang); rt[e * 2 + 1] = sinf(ang);
    }
  }
  {
    float* sl = (float*)smem;
    float* red = sl + 9 * 1024;
    __syncthreads();
    for (int e = tid; e < 9 * 1024; e += 256) {
      const int b = e >> 10, k = e & 1023;
      const float v = b < 8 ? p.in[I_C][b * 1024 + k] : p.in[I_CCTX][k];
      sl[e] = siluf_(v);
    }
    __syncthreads();
    const int wave = tid >> 6, lane = tid & 63;
    for (int it = blk__; it < 192; it += gridDim.x) {
      const int l = it / 96, cg_ = it - l * 96;
      const int col = cg_ * 64 + lane;
      const float* wa = p.in[I_WADA] + (size_t)l * 1024 * 6144 + col;
      float acc[9];
#pragma unroll
      for (int b = 0; b < 9; ++b) acc[b] = 0.f;
#pragma unroll 8
      for (int k = wave * 256; k < wave * 256 + 256; ++k) {
        const float w = wa[(size_t)k * 6144];
#pragma unroll
        for (int b = 0; b < 9; ++b) acc[b] += sl[b * 1024 + k] * w;
      }
#pragma unroll
      for (int b = 0; b < 9; ++b) red[(wave * 9 + b) * 64 + lane] = acc[b];
      __syncthreads();
      for (int e = tid; e < 9 * 64; e += 256) {
        const int b = e >> 6, c = e & 63;
        const float s = red[(0 * 9 + b) * 64 + c] + red[(1 * 9 + b) * 64 + c] + red[(2 * 9 + b) * 64 + c] + red[(3 * 9 + b) * 64 + c];
        ((float*)(p.ws + OFF_MODS))[(size_t)(l * 9 + b) * 6144 + cg_ * 64 + c] = s + p.in[I_BADA][l * 6144 + cg_ * 64 + c];
      }
      __syncthreads();
    }
  }
}

DI const float* xrow(const float* xl, const float* xc, int r) { return r < NTL ? xl + (size_t)r * D : xc + (size_t)(r - NTL) * D; }

DI void phase_norm(const float* xl, const float* xc, const float* tab  , u16* hb, int M) {
  LAUNDER_IDS
  const int wave = tid__ >> 6, lane = tid__ & 63;
  for (int r = blk__ * 4 + wave; r < M; r += gridDim.x * 4) {
    const float* xp = xrow(xl, xc, r);
    const int b9 = r < NTL ? r >> 12 : 8;
    float4 v[4];
    float s = 0.f;
#pragma unroll
    for (int i = 0; i < 4; ++i) { v[i] = *(const float4*)(xp + i * 256 + lane * 4); s += v[i].x * v[i].x + v[i].y * v[i].y + v[i].z * v[i].z + v[i].w * v[i].w; }
    s = wavesum(s);
    const float rs = rsqrtf(s * (1.f / 1024.f) + 1e-6f);
    const float* t = tab + b9 * 2048;
#pragma unroll
    for (int i = 0; i < 4; ++i) {
      const int k = i * 256 + lane * 4;
      const float4 g = *(const float4*)(t + k), sh = *(const float4*)(t + 1024 + k);
      *(uint2*)(hb + (size_t)r * 1024 + k) = make_uint2(pack2(v[i].x * rs * g.x + sh.x, v[i].y * rs * g.y + sh.y), pack2(v[i].z * rs * g.z + sh.z, v[i].w * rs * g.w + sh.w));
    }
  }
}
DI void phase_tables(const Params& p) {
  LAUNDER_IDS
  const float* mods = (const float*)(p.ws + OFF_MODS);
  float* tab = (float*)(p.ws + OFF_TAB);
  for (int e = blk__ * 256 + tid__; e < 2 * 2 * 9 * 1024; e += gridDim.x * 256) {
    const int k = e & 1023, b9 = (e >> 10) % 9, ln = (e >> 10) / 9, l = ln >> 1, nrm = ln & 1;
    const float g = p.in[nrm ? I_N2G : I_N1G][l * 1024 + k];
    const float sh = mods[(size_t)(l * 9 + b9) * 6144 + (nrm * 3 + 0) * 1024 + k];
    const float sc = mods[(size_t)(l * 9 + b9) * 6144 + (nrm * 3 + 1) * 1024 + k];
    float* t = tab + ((size_t)(l * 2 + nrm) * 9 + b9) * 2048;
    t[k] = g * (1.f + sc); t[1024 + k] = sh;
  }
}

struct LoadBf16 {
  const u16* A; int lda;
  DI void init(int m0) {}
  DI uint4 load(int i, int m0, int k0) const {
    LAUNDER_IDS
    const int tid = tid__, kc = (tid & 7) * 8;
    return *(const uint4*)(A + (size_t)(m0 + (tid >> 3) + i * 32) * lda + k0 + kc);
  }
};
struct LoadNorm {
  const float* xl; const float* xc; const float* rs; const float* tab;
  float r0, r1, r2, r3;
  DI void init(int m0) {
    LAUNDER_IDS
    const int tid = tid__;
    r0 = rs[m0 + (tid >> 3)]; r1 = rs[m0 + (tid >> 3) + 32]; r2 = rs[m0 + (tid >> 3) + 64]; r3 = rs[m0 + (tid >> 3) + 96];
  }
  DI uint4 load(int i, int m0, int k0) const {
    LAUNDER_IDS
    const int tid = tid__, kc = (tid & 7) * 8;
    const int b9 = m0 < NTL ? m0 >> 12 : 8;
    const float* t = tab + b9 * 2048 + k0 + kc;
    const float4 g0 = *(const float4*)t, g1 = *(const float4*)(t + 4), s0 = *(const float4*)(t + 1024), s1 = *(const float4*)(t + 1028);
    const float* xp = xrow(xl, xc, m0 + (tid >> 3)) + k0 + kc + (size_t)i * 32 * D;
    const float4 x0 = *(const float4*)xp, x1 = *(const float4*)(xp + 4);
    const float rr = i == 0 ? r0 : i == 1 ? r1 : i == 2 ? r2 : r3;
    uint4 o;
    o.x = pack2(x0.x * rr * g0.x + s0.x, x0.y * rr * g0.y + s0.y);
    o.y = pack2(x0.z * rr * g0.z + s0.z, x0.w * rr * g0.w + s0.w);
    o.z = pack2(x1.x * rr * g1.x + s1.x, x1.y * rr * g1.y + s1.y);
    o.w = pack2(x1.z * rr * g1.z + s1.z, x1.w * rr * g1.w + s1.w);
    return o;
  }
};

DI bool tile_map(int it, int NTM, int NTN, int blk, int nblk, int& tm, int& tn) {
  const int xcd = blk & 7, local = blk >> 3, LB = nblk >> 3;
  const int R = NTM >> 3;
  const int s = it * LB + local;
  if (s >= R * NTN) return false;
  const int F = R >> 3, per_full = 8 * NTN;
  int mg, r, gm;
  if (s < F * per_full) { mg = s / per_full; r = s - mg * per_full; gm = 8; }
  else { mg = F; r = s - F * per_full; gm = R - F * 8; }
  const int ng = r / (gm * 8);
  const int r2 = r - ng * gm * 8;
  const int mi = r2 % gm, ni = r2 / gm;
  tm = xcd * R + mg * 8 + mi; tn = ng * 8 + ni;
  return true;
}
constexpr int LDT = 72;
template <int NI, class LA>
DI void gemm_mainloop(f32x4 (&acc)[4][NI], LA la, const u16* __restrict__ Bt, int ldb, int K, int m0, int n0, char* smem) {
  LAUNDER_IDS
  constexpr int NBI = NI;
  u16* As = (u16*)smem; u16* Bs = As + 2 * 128 * LDT;
  const int tid = tid__, lane = tid & 63, wave = tid >> 6, wr = wave >> 1, wc = wave & 1, lr = lane & 15, lq = lane >> 4;
  uint4 ra[4], rb[NBI];
  la.init(m0);
#pragma unroll
  for (int i = 0; i < 4; ++i) ra[i] = la.load(i, m0, 0);
#pragma unroll
  for (int i = 0; i < NBI; ++i) {
    const int c = tid + i * 256, row = c >> 3, kc = (c & 7) * 8;
    rb[i] = *(const uint4*)(Bt + (size_t)(n0 + row) * ldb + kc);
  }
#pragma unroll
  for (int i = 0; i < 4; ++i) {
    const int c = tid + i * 256, row = c >> 3, kc = (c & 7) * 8;
    *(uint4*)(As + row * LDT + kc) = ra[i];
    if (i < NBI) *(uint4*)(Bs + row * LDT + kc) = rb[i];
  }
  __syncthreads();
  const int nk = K >> 6;
  for (int kt = 0; kt < nk; ++kt) {
    const int cur = kt & 1;
    if (kt + 1 < nk) {
      const int k0 = (kt + 1) * 64;
#pragma unroll
      for (int i = 0; i < 4; ++i) ra[i] = la.load(i, m0, k0);
#pragma unroll
      for (int i = 0; i < NBI; ++i) {
        const int c = tid + i * 256, row = c >> 3, kc = (c & 7) * 8;
        rb[i] = *(const uint4*)(Bt + (size_t)(n0 + row) * ldb + k0 + kc);
      }
    }
    const u16* Ac = As + cur * 128 * LDT + (wr * 64 + lr) * LDT + lq * 8;
    const u16* Bc = Bs + cur * 128 * LDT + (wc * 16 * NI + lr) * LDT + lq * 8;
#pragma unroll
    for (int ks = 0; ks < 2; ++ks) {
      bf16x8 af[4], bfr[NI];
#pragma unroll
      for (int mi = 0; mi < 4; ++mi) af[mi] = *(const bf16x8*)(Ac + mi * 16 * LDT + ks * 32);
#pragma unroll
      for (int ni = 0; ni < NI; ++ni) bfr[ni] = *(const bf16x8*)(Bc + ni * 16 * LDT + ks * 32);
#pragma unroll
      for (int mi = 0; mi < 4; ++mi)
#pragma unroll
        for (int ni = 0; ni < NI; ++ni)
          acc[mi][ni] = __builtin_amdgcn_mfma_f32_16x16x32_bf16(bfr[ni], af[mi], acc[mi][ni], 0, 0, 0);
    }
    if (kt + 1 < nk) {
      const int nxt = cur ^ 1;
#pragma unroll
      for (int i = 0; i < 4; ++i) {
        const int c = tid + i * 256, row = c >> 3, kc = (c & 7) * 8;
        *(uint4*)(As + nxt * 128 * LDT + row * LDT + kc) = ra[i];
        if (i < NBI) *(uint4*)(Bs + nxt * 128 * LDT + row * LDT + kc) = rb[i];
      }
    }
    __syncthreads();
  }
}
template <int NI>
DI void zero_acc(f32x4 (&acc)[4][NI]) {
#pragma unroll
  for (int i = 0; i < 4; ++i)
#pragma unroll
    for (int j = 0; j < NI; ++j) acc[i][j] = f32x4{0.f, 0.f, 0.f, 0.f};
}
template <int MI, int NI>
DI void gemm256(f32x4 (&acc)[MI][NI], const u16* __restrict__ A, int lda, const u16* __restrict__ Bt, int ldb, int K, int m0, int n0, char* smem) {
  LAUNDER_IDS
  const int lane = tid__ & 63, wave = tid__ >> 6, wr = wave >> 1, wc = wave & 1, lr = lane & 15, lq = lane >> 4;
  constexpr int NAW = MI / 2;
  constexpr int NBW = NI / 2;
  constexpr int ABYTES = MI * 2 * 1024;
  constexpr int STAGE = ABYTES + NI * 2 * 1024;
  constexpr int LPS = NAW + NBW;
  static_assert(3 * STAGE <= 73728, "ring does not fit");
  const int srow = lane >> 2, scol = ((lane & 3) ^ ((lane >> 5) << 1)) * 8;
  const u16* Ag = A + (size_t)(m0 + wave * NAW * 16 + srow) * lda + scol;
  const u16* Bg = Bt + (size_t)(n0 + wave * NBW * 16 + srow) * ldb + scol;
  char* la = smem + (wave * NAW) * 1024 + lane * 16;
  char* lb = smem + ABYTES + (wave * NBW) * 1024 + lane * 16;
#define G256_ISSUE(S, K0) do { \
    _Pragma("unroll") for (int j_ = 0; j_ < NAW; ++j_) \
      __builtin_amdgcn_global_load_lds((const unsigned*)(Ag + (size_t)j_ * 16 * lda + (K0)), (__attribute__((address_space(3))) unsigned*)(la + (S) * STAGE + j_ * 1024), 16, 0, 0); \
    _Pragma("unroll") for (int j_ = 0; j_ < NBW; ++j_) \
      __builtin_amdgcn_global_load_lds((const unsigned*)(Bg + (size_t)j_ * 16 * ldb + (K0)), (__attribute__((address_space(3))) unsigned*)(lb + (S) * STAGE + j_ * 1024), 16, 0, 0); \
  } while (0)
  const int nk = K >> 5;
  G256_ISSUE(0, 0);
  if (nk > 1) G256_ISSUE(1, 32);
  const int foff = lr * 64 + ((lq ^ ((lr >> 3) << 1)) * 16);
  int st = 0;
  for (int kt = 0; kt < nk; ++kt) {
    if (kt + 1 < nk) asm volatile("s_waitcnt vmcnt(%0) lgkmcnt(0)" :: "n"(LPS) : "memory");
    else asm volatile("s_waitcnt vmcnt(0) lgkmcnt(0)" ::: "memory");
    __builtin_amdgcn_s_barrier();
    if (kt + 2 < nk) { const int s2 = st >= 1 ? st - 1 : 2; G256_ISSUE(s2, (kt + 2) * 32); }
    const char* sb = smem + st * STAGE + foff;
    bf16x8 af[MI], bfr[NI];
#pragma unroll
    for (int mi = 0; mi < MI; ++mi) af[mi] = *(const bf16x8*)(sb + (wr * MI + mi) * 1024);
#pragma unroll
    for (int ni = 0; ni < NI; ++ni) bfr[ni] = *(const bf16x8*)(sb + ABYTES + (wc * NI + ni) * 1024);
#pragma unroll
    for (int mi = 0; mi < MI; ++mi)
#pragma unroll
      for (int ni = 0; ni < NI; ++ni)
        acc[mi][ni] = __builtin_amdgcn_mfma_f32_16x16x32_bf16(bfr[ni], af[mi], acc[mi][ni], 0, 0, 0);
    st = st == 2 ? 0 : st + 1;
  }
  asm volatile("s_waitcnt lgkmcnt(0)" ::: "memory");
  __builtin_amdgcn_s_barrier();
#undef G256_ISSUE
}
template <int MI, int NI>
DI void zero_accm(f32x4 (&acc)[MI][NI]) {
#pragma unroll
  for (int i = 0; i < MI; ++i)
#pragma unroll
    for (int j = 0; j < NI; ++j) acc[i][j] = f32x4{0.f, 0.f, 0.f, 0.f};
}
#define EPI_BEGIN const int lr1_ = launder_v(lr), lq1_ = launder_v(lq), wr1_ = launder_v(wr), wc1_ = launder_v(wc); { const int lr = lr1_, lq = lq1_, wr = wr1_, wc = wc1_; (void)lr; (void)lq; (void)wr; (void)wc;
#define EPI_END }
#define WAVE_COORDS const int lane = tid__ & 63, wave = tid__ >> 6, wr = wave >> 1, wc = wave & 1, lr = lane & 15, lq = lane >> 4; (void)wr; (void)wc; (void)lr; (void)lq;

DI void phase_zgemm(const Params& p, int l, char* smem) {
  LAUNDER_IDS
  WAVE_COORDS
  const u16* Wt = (const u16*)(p.ws + OFF_W + (size_t)l * W_LAYER + WO_WIN);
  const u16* hb = (const u16*)(p.ws + OFF_HB1);
  u16* za = (u16*)(p.ws + OFF_R2); u16* zr = (u16*)(p.ws + OFF_R1);
  for (int it = 0;; ++it) {
    int tm, tn;
    if (!tile_map(it, NT / 256, 17, blk__, gridDim.x, tm, tn)) break;
    const int m0 = tm * 256, n0 = tn * 128;
    f32x4 acc[8][4]; zero_accm<8, 4>(acc);
    gemm256<8, 4>(acc, hb, 1024, Wt, 1024, 1024, m0, n0, smem);
    EPI_BEGIN
#pragma unroll
    for (int mi = 0; mi < 8; ++mi) {
      const int m = m0 + wr * 128 + mi * 16 + lr;
#pragma unroll
      for (int ni = 0; ni < 4; ++ni) {
        const int n = n0 + wc * 64 + ni * 16 + lq * 4;
        uint2 v; v.x = pack2(acc[mi][ni][0], acc[mi][ni][1]); v.y = pack2(acc[mi][ni][2], acc[mi][ni][3]);
        if (n < ZA) *(uint2*)(za + (size_t)m * ZA + n) = v;
        else if (n < ZA + ZR) *(uint2*)(zr + (size_t)m * ZR + (n - ZA)) = v;
      }
    }
    EPI_END
  }
}

DI void phase_tokA(const Params& p, int l) {
  LAUNDER_IDS
  const int wave = tid__ >> 6, lane = tid__ & 63;
  const u16* za = (const u16*)(p.ws + OFF_R2);
  float* rsq = (float*)(p.ws + OFF_RSQ); float* rskv = (float*)(p.ws + OFF_RSKV);
  u16* krb = (u16*)(p.ws + OFF_KR);
  u16* pooled = (u16*)(p.ws + OFF_R4);
  const float* rt = (const float*)(p.ws + OFF_ROPE);
  const float* gk = p.in[I_GK] + l * 96;
  for (int r = blk__ * 4 + wave; r < NT; r += gridDim.x * 4) {
    const u16* z = za + (size_t)r * ZA;
    const bool lat = r < NTL;
    const int b = lat ? r >> 12 : (r - NTL) >> 8;
    const int t = lat ? r & 4095 : (r - NTL) & 255;
    const int Ls = lat ? L : LC;
    const int pos = lat ? t : 4096 + t;
    u16 zq[6], zk[4], pw[30], pc[4];
#pragma unroll
    for (int i = 0; i < 6; ++i) zq[i] = z[256 + i * 64 + lane];
#pragma unroll
    for (int i = 0; i < 4; ++i) zk[i] = z[640 + i * 64 + lane];
    const int d = lane & 31;
    const u16 kr_raw = z[896 + d];
    const float gkd = gk[64 + d];
    const int ri = d & 15;
    const int pp = ri < 8 ? (t >> 6) : (t & 63);
    const float cs = rt[(pp * 8 + (ri & 7)) * 2], sn = rt[(pp * 8 + (ri & 7)) * 2 + 1];
#pragma unroll
    for (int gi = 0; gi < 4; ++gi) {
      const int half = 1 << gi;
      pc[gi] = z[gi * 64 + lane];
#pragma unroll
      for (int j = 0; j < 2 * half; ++j) {
        const int qc = min(max(t - half + j, 0), Ls - 1);
        pw[2 * half - 2 + j] = z[(ptrdiff_t)(qc - t) * ZA + gi * 64 + lane];
      }
    }
    float sq = 0.f, skv = 0.f;
#pragma unroll
    for (int i = 0; i < 6; ++i) { const float v = bf2f(zq[i]); sq += v * v; }
#pragma unroll
    for (int i = 0; i < 4; ++i) { const float v = bf2f(zk[i]); skv += v * v; }
    sq = wavesum(sq); skv = wavesum(skv);
    const float rq = rsqrtf(sq * (1.f / 384.f) + 1e-6f), rkv = rsqrtf(skv * (1.f / 256.f) + 1e-6f);
    float kr = bf2f(kr_raw);
    float ss = rowsum16(kr * kr);
    { const int si = __builtin_bit_cast(int, ss);
      ss = __builtin_bit_cast(float, __builtin_amdgcn_readlane(si, 0)) + __builtin_bit_cast(float, __builtin_amdgcn_readlane(si, 16)); }
    kr = kr * rsqrtf(ss * (1.f / 32.f) + 1e-6f) * gkd;
    const float other = __shfl_xor(kr, 16, 64);
    const float rot = d < 16 ? kr * cs - other * sn : other * sn + kr * cs;
    const float outv = lat ? rot : kr;
    float pv[4];
#pragma unroll
    for (int gi = 0; gi < 4; ++gi) {
      const int half = 1 << gi;
      const int lo = max(t - half, 0), hi = min(t + half, Ls);
      float sm = 0.f;
#pragma unroll
      for (int j = 0; j < 2 * half; ++j) {
        const int q = t - half + j;
        sm += (q >= 0 && q < Ls) ? bf2f(pw[2 * half - 2 + j]) : 0.f;
      }
      pv[gi] = sm / (float)(hi - lo) - bf2f(pc[gi]);
    }
    if (lane == 0) { rsq[r] = rq; rskv[r] = rkv; }
    if (lane < 32) krb[(size_t)r * 32 + d] = f2bf(outv);
#pragma unroll
    for (int gi = 0; gi < 4; ++gi) pooled[(size_t)r * 256 + gi * 64 + lane] = f2bf(pv[gi]);
  }
}

constexpr int ZSL = 1160, TAL = 392;
DI void phase_tokB(const Params& p, int l, char* smem) {
  LAUNDER_IDS
  WAVE_COORDS
  const int tid = tid__;
  u16* Zs = (u16*)smem;
  u16* TA = Zs + 18 * ZSL;
  float* PV = (float*)(TA + 16 * TAL);
  const u16* zr = (const u16*)(p.ws + OFF_R1);
  const char* wl = p.ws + OFF_W + (size_t)l * W_LAYER;
  u16* sc = (u16*)(p.ws + OFF_R3);
  __syncthreads();
  for (int e = tid; e < 2 * ZR + 7 * 256; e += 256) {
    float v;
    if (e < 2 * ZR) v = p.in[I_MU][(size_t)l * 2 * ZR + e];
    else { const int f = e - 2 * ZR, a = f >> 8, c = f & 255;
      v = a == 0 ? p.in[I_KK][l * 256 + c] : a < 3 ? p.in[I_W0][(size_t)(l * 2 + a - 1) * 256 + c] : a < 5 ? p.in[I_A0][(size_t)(l * 2 + a - 3) * 256 + c] : p.in[I_KA][(size_t)(l * 2 + a - 5) * 256 + c]; }
    PV[e] = v;
  }
  const float* mu0 = PV; const float* mu1 = PV + ZR; const float* kkw = PV + 2 * ZR;
  const float* w0p = kkw + 256; const float* a0p = w0p + 512; const float* kap = a0p + 512;
  for (int tile = blk__; tile < NT / 16; tile += gridDim.x) {
    const int r0 = tile * 16;
    const bool lat = r0 < NTL;
    const int t0 = lat ? r0 & 4095 : (r0 - NTL) & 255;
    const int Ls = lat ? L : LC;
    __syncthreads();
    {
      uint4 v[11];
#pragma unroll
      for (int i = 0; i < 11; ++i) {
        const int c = tid + i * 256;
        const int ri = c / 144, ch = c - ri * 144;
        const int tt = t0 - 1 + ri;
        const int cc = min(c, 18 * 144 - 1);
        const int rc = cc / 144, chc = cc - rc * 144;
        const int ttc = min(max(t0 - 1 + rc, 0), Ls - 1);
        const uint4 ld = *(const uint4*)(zr + (size_t)(r0 - t0 + ttc) * ZR + chc * 8);
        const bool ok = (c < 18 * 144) && (tt >= 0) && (tt < Ls);
        v[i] = ok ? ld : make_uint4(0, 0, 0, 0);
      }
#pragma unroll
      for (int i = 0; i < 11; ++i) {
        const int c = tid + i * 256;
        const int ri = c / 144, ch = c - ri * 144;
        if (c < 18 * 144) {
          *(uint2*)(Zs + ri * ZSL + ch * 8) = make_uint2(v[i].x, v[i].y);
          *(uint2*)(Zs + ri * ZSL + ch * 8 + 4) = make_uint2(v[i].z, v[i].w);
        }
      }
    }
    __syncthreads();
#pragma unroll 4
    for (int e = tid; e < 16 * 384; e += 256) {
      const int i = e / 384, c = e - i * 384, zc = 768 + c;
      const float z = bf2f(Zs[(i + 1) * ZSL + zc]), zp = bf2f(Zs[i * ZSL + zc]), zn = bf2f(Zs[(i + 2) * ZSL + zc]);
      float v = z + mu0[zc] * (zp - z) + mu1[zc] * (zn - z);
      if (c < 128) v = 1.f - 2.f / (1.f + __expf(2.f * v)); else if (c >= 256) v = sigmoidf_(v);
      TA[i * TAL + c] = f2bf(v);
    }
    __syncthreads();
    const int row = r0 + lr;
    auto shifted4 = [&](int zc, float (&out)[4]) {
      const uint2 c0 = *(const uint2*)(Zs + (lr + 1) * ZSL + zc), cp = *(const uint2*)(Zs + lr * ZSL + zc), cn = *(const uint2*)(Zs + (lr + 2) * ZSL + zc);
      const float4 m0 = *(const float4*)(mu0 + zc), m1 = *(const float4*)(mu1 + zc);
      float z, zp, zn;
      z = bflo(c0.x); zp = bflo(cp.x); zn = bflo(cn.x); out[0] = z + m0.x * (zp - z) + m1.x * (zn - z);
      z = bfhi(c0.x); zp = bfhi(cp.x); zn = bfhi(cn.x); out[1] = z + m0.y * (zp - z) + m1.y * (zn - z);
      z = bflo(c0.y); zp = bflo(cp.y); zn = bflo(cn.y); out[2] = z + m0.z * (zp - z) + m1.z * (zn - z);
      z = bfhi(c0.y); zp = bfhi(cp.y); zn = bfhi(cn.y); out[3] = z + m0.w * (zp - z) + m1.w * (zn - z);
    };
    auto product128 = [&](f32x4 (&ac)[4], const u16* W, int off) {
      bf16x8 aop[4][4];
#pragma unroll
      for (int ks = 0; ks < 4; ++ks)
#pragma unroll
        for (int ni = 0; ni < 4; ++ni) aop[ks][ni] = *(const bf16x8*)(W + (size_t)(wave * 64 + ni * 16 + lr) * 128 + ks * 32 + lq * 8);
#pragma unroll
      for (int ni = 0; ni < 4; ++ni) ac[ni] = f32x4{0.f, 0.f, 0.f, 0.f};
#pragma unroll
      for (int ks = 0; ks < 4; ++ks) {
        const bf16x8 bop = *(const bf16x8*)(TA + lr * TAL + off + ks * 32 + lq * 8);
#pragma unroll
        for (int ni = 0; ni < 4; ++ni) ac[ni] = __builtin_amdgcn_mfma_f32_16x16x32_bf16(aop[ks][ni], bop, ac[ni], 0, 0, 0);
      }
      __builtin_amdgcn_sched_barrier(0);
    };
    auto product64x2 = [&](f32x4 (&ac0)[4], f32x4 (&ac1)[4], const u16* W0, const u16* W1, int off0, int off1) {
      bf16x8 a0[2][4], a1[2][4];
#pragma unroll
      for (int ks = 0; ks < 2; ++ks)
#pragma unroll
        for (int ni = 0; ni < 4; ++ni) {
          a0[ks][ni] = *(const bf16x8*)(W0 + (size_t)(wave * 64 + ni * 16 + lr) * 64 + ks * 32 + lq * 8);
          a1[ks][ni] = *(const bf16x8*)(W1 + (size_t)(wave * 64 + ni * 16 + lr) * 64 + ks * 32 + lq * 8);
        }
#pragma unroll
      for (int ni = 0; ni < 4; ++ni) { ac0[ni] = f32x4{0.f, 0.f, 0.f, 0.f}; ac1[ni] = f32x4{0.f, 0.f, 0.f, 0.f}; }
#pragma unroll
      for (int ks = 0; ks < 2; ++ks) {
        const bf16x8 b0 = *(const bf16x8*)(TA + lr * TAL + off0 + ks * 32 + lq * 8);
        const bf16x8 b1 = *(const bf16x8*)(TA + lr * TAL + off1 + ks * 32 + lq * 8);
#pragma unroll
        for (int ni = 0; ni < 4; ++ni) {
          ac0[ni] = __builtin_amdgcn_mfma_f32_16x16x32_bf16(a0[ks][ni], b0, ac0[ni], 0, 0, 0);
          ac1[ni] = __builtin_amdgcn_mfma_f32_16x16x32_bf16(a1[ks][ni], b1, ac1[ni], 0, 0, 0);
        }
      }
      __builtin_amdgcn_sched_barrier(0);
    };
    float ss = 0.f;
#pragma unroll
    for (int ni = 0; ni < 4; ++ni) {
      const int ch = wave * 64 + ni * 16 + lq * 4;
      float kx[4]; shifted4(256 + ch, kx);
      const float4 kw = *(const float4*)(kkw + ch);
      const float a0 = kx[0] * kw.x, a1 = kx[1] * kw.y, a2 = kx[2] * kw.z, a3 = kx[3] * kw.w;
      ss += a0 * a0 + a1 * a1 + a2 * a2 + a3 * a3;
    }
    ss += __shfl_xor(ss, 16, 64); ss += __shfl_xor(ss, 32, 64);
    const float kinv = rsqrtf(fmaxf(ss, 1e-24f));
    {
      f32x4 ag[4];
      product128(ag, (const u16*)(wl + WO_RG2), 256);
#pragma unroll
      for (int ni = 0; ni < 4; ++ni) {
        const int ch = wave * 64 + ni * 16 + lq * 4;
        const size_t o = (size_t)row * 256 + ch;
        float rx[4], kx[4], vx[4];
        shifted4(ch, rx); shifted4(256 + ch, kx); shifted4(512 + ch, vx);
        const float4 kw = *(const float4*)(kkw + ch);
        *(uint2*)(sc + SA_R * (size_t)NT * 256 + o) = make_uint2(pack2(rx[0], rx[1]), pack2(rx[2], rx[3]));
        *(uint2*)(sc + SA_V * (size_t)NT * 256 + o) = make_uint2(pack2(vx[0], vx[1]), pack2(vx[2], vx[3]));
        *(uint2*)(sc + SA_KKN * (size_t)NT * 256 + o) = make_uint2(pack2(-kx[0] * kw.x * kinv, -kx[1] * kw.y * kinv), pack2(-kx[2] * kw.z * kinv, -kx[3] * kw.w * kinv));
        *(uint2*)(sc + SA_G * (size_t)NT * 256 + o) = make_uint2(pack2(ag[ni][0], ag[ni][1]), pack2(ag[ni][2], ag[ni][3]));
        __builtin_amdgcn_sched_barrier(0);
      }
    }
#pragma unroll 1
    for (int d = 0; d < 2; ++d) {
      f32x4 aw[4], aa[4];
      product64x2(aw, aa, (const u16*)(wl + WO_RW2) + (size_t)d * 256 * 64, (const u16*)(wl + WO_RA2) + (size_t)d * 256 * 64, d * 64, 128 + d * 64);
      u16* oOMW = sc + (d ? SA_OMWB : SA_OMWF) * (size_t)NT * 256;
      u16* oKD = sc + (d ? SA_KDB : SA_KDF) * (size_t)NT * 256;
      u16* oB = sc + (d ? SA_BB : SA_BF) * (size_t)NT * 256;
#pragma unroll
      for (int ni = 0; ni < 4; ++ni) {
        const int ch = wave * 64 + ni * 16 + lq * 4;
        const size_t o = (size_t)row * 256 + ch;
        float kx[4]; shifted4(256 + ch, kx);
        const float4 kw = *(const float4*)(kkw + ch);
        const float kkn[4] = {kx[0] * kw.x * kinv, kx[1] * kw.y * kinv, kx[2] * kw.z * kinv, kx[3] * kw.w * kinv};
        const float4 w0 = *(const float4*)(w0p + d * 256 + ch);
        const float4 a0 = *(const float4*)(a0p + d * 256 + ch);
        const float4 ka = *(const float4*)(kap + d * 256 + ch);
        const float w0a[4] = {w0.x, w0.y, w0.z, w0.w}, a0a[4] = {a0.x, a0.y, a0.z, a0.w}, kaa[4] = {ka.x, ka.y, ka.z, ka.w};
        float omw[4], kd[4], bb[4];
#pragma unroll
        for (int j = 0; j < 4; ++j) {
          const float xw = -(w0a[j] + aw[ni][j]);
          const float sp = fmaxf(xw, 0.f) + __logf(1.f + __expf(-fabsf(xw)));
          const float wlog = -sp - 0.5f;
          const float e = __expf(wlog);
          omw[j] = 1.f - __expf(-e);
          const float a = sigmoidf_(a0a[j] + aa[ni][j]);
          kd[j] = kx[j] * (1.f + (a - 1.f) * kaa[j]);
          bb[j] = kkn[j] * a;
        }
        *(uint2*)(oOMW + o) = make_uint2(pack2(omw[0], omw[1]), pack2(omw[2], omw[3]));
        *(uint2*)(oKD + o) = make_uint2(pack2(kd[0], kd[1]), pack2(kd[2], kd[3]));
        *(uint2*)(oB + o) = make_uint2(pack2(bb[0], bb[1]), pack2(bb[2], bb[3]));
        __builtin_amdgcn_sched_barrier(0);
      }
    }
  }
}

DI size_t qk_index(int m, int h) {
  const bool lat = m < NTL;
  const int b = lat ? m >> 12 : (m - NTL) >> 8;
  const int pos = lat ? m & 4095 : 4096 + ((m - NTL) & 255);
  return ((size_t)(b * 8 + h) * LK + pos) * 96;
}
DI void phase_qkv(const Params& p, int l, char* smem) {
  LAUNDER_IDS
  WAVE_COORDS
  const char* wl = p.ws + OFF_W + (size_t)l * W_LAYER;
  const u16* za = (const u16*)(p.ws + OFF_R2);
  const float* rsq0 = (const float*)(p.ws + OFF_RSQ); const float* rskv0 = (const float*)(p.ws + OFF_RSKV);
  u16* Qb = (u16*)(p.ws + OFF_R1); u16* Kb = (u16*)(p.ws + OFF_R1 + SZ_Q); u16* Vt = (u16*)(p.ws + OFF_R1 + 2 * SZ_Q);
  const float* rt0 = (const float*)(p.ws + OFF_ROPE);
  const float* gq0 = p.in[I_GQ] + l * 96; const float* gk0 = p.in[I_GK] + l * 96;
  const float QS = 0.10206207261596577f * 1.4426950408889634f;
  constexpr int NTM = NT / 256;
  for (int it = 0;; ++it) {
    int tm, tn;
    if (!tile_map(it, NTM, 6, blk__, gridDim.x, tm, tn)) break;
    f32x4 acc[8][4]; zero_accm<8, 4>(acc);
    {
      const int m0 = tm * 256, n0 = tn * 128;
      gemm256<8, 4>(acc, za + 256, ZA, (const u16*)(wl + WO_UQ), 384, 384, m0, n0, smem);
      EPI_BEGIN
      const float* gq = gq0; const float* rt = rt0; const float* rsq = rsq0;
      asm volatile("" : "+v"(gq), "+v"(rt), "+v"(rsq));
      const int nw = n0 + wc * 64;
#pragma unroll
      for (int mi = 0; mi < 8; ++mi) {
        __builtin_amdgcn_sched_barrier(0);
        const int m = m0 + wr * 128 + mi * 16 + lr;
        const float rs = rsq[m];
        if (nw < 512) {
          const int h = nw >> 6;
          float ss = 0.f;
#pragma unroll
          for (int ni = 0; ni < 4; ++ni)
#pragma unroll
            for (int j = 0; j < 4; ++j) { const float v = acc[mi][ni][j] * rs; ss += v * v; }
          ss += __shfl_xor(ss, 16, 64); ss += __shfl_xor(ss, 32, 64);
          const float f = rs * rsqrtf(ss * (1.f / 64.f) + 1e-6f) * QS;
          u16* dst = Qb + qk_index(m, h);
#pragma unroll
          for (int ni = 0; ni < 4; ++ni) {
            const int d = ni * 16 + lq * 4;
            const float4 g = *(const float4*)(gq + d);
            *(uint2*)(dst + d) = make_uint2(pack2(acc[mi][ni][0] * f * g.x, acc[mi][ni][1] * f * g.y), pack2(acc[mi][ni][2] * f * g.z, acc[mi][ni][3] * f * g.w));
          }
        } else {
          const bool lat = m < NTL;
          const int tt = m & 4095;
#pragma unroll
          for (int hh = 0; hh < 2; ++hh) {
            __builtin_amdgcn_sched_barrier(0);
            const int h = ((nw - 512) >> 5) + hh;
            float ss = 0.f;
#pragma unroll
            for (int ni = 0; ni < 2; ++ni)
#pragma unroll
              for (int j = 0; j < 4; ++j) { const float v = acc[mi][hh * 2 + ni][j] * rs; ss += v * v; }
            ss += __shfl_xor(ss, 16, 64); ss += __shfl_xor(ss, 32, 64);
            const float f = rs * rsqrtf(ss * (1.f / 32.f) + 1e-6f) * QS;
            const int i0 = lq * 4;
            const float4 g1 = *(const float4*)(gq + 64 + i0), g2 = *(const float4*)(gq + 80 + i0);
            const float g1a[4] = {g1.x, g1.y, g1.z, g1.w}, g2a[4] = {g2.x, g2.y, g2.z, g2.w};
            float o1[4], o2[4];
#pragma unroll
            for (int j = 0; j < 4; ++j) {
              const float x1 = acc[mi][hh * 2][j] * f * g1a[j], x2 = acc[mi][hh * 2 + 1][j] * f * g2a[j];
              float cs = 1.f, sn = 0.f;
              if (lat) {
                const int i = i0 + j;
                const int pp = i < 8 ? (tt >> 6) : (tt & 63);
                cs = rt[(pp * 8 + (i & 7)) * 2]; sn = rt[(pp * 8 + (i & 7)) * 2 + 1];
              }
              o1[j] = x1 * cs - x2 * sn; o2[j] = x1 * sn + x2 * cs;
            }
            u16* dst = Qb + qk_index(m, h) + 64;
            *(uint2*)(dst + i0) = make_uint2(pack2(o1[0], o1[1]), pack2(o1[2], o1[3]));
            *(uint2*)(dst + 16 + i0) = make_uint2(pack2(o2[0], o2[1]), pack2(o2[2], o2[3]));
          }
        }
      }
      EPI_END
    }
  }
  __builtin_amdgcn_sched_barrier(0);
  for (int it = 0;; ++it) {
    int tm, tn;
    if (!tile_map(it, NTM, 8, blk__, gridDim.x, tm, tn)) break;
    f32x4 acc[8][4]; zero_accm<8, 4>(acc);
    {
      const int h = tn, m0 = tm * 256, n0 = h * 128;
      gemm256<8, 4>(acc, za + 640, ZA, (const u16*)(wl + WO_UKV), 256, 256, m0, n0, smem);
      EPI_BEGIN
      const float* gk = gk0; const float* rskv = rskv0;
      asm volatile("" : "+v"(gk), "+v"(rskv));
#pragma unroll
      for (int mi = 0; mi < 8; ++mi) {
        __builtin_amdgcn_sched_barrier(0);
        const int m = m0 + wr * 128 + mi * 16 + lr;
        const float rs = rskv[m];
        if (wc == 0) {
          float ss = 0.f;
#pragma unroll
          for (int ni = 0; ni < 4; ++ni)
#pragma unroll
            for (int j = 0; j < 4; ++j) { const float v = acc[mi][ni][j] * rs; ss += v * v; }
          ss += __shfl_xor(ss, 16, 64); ss += __shfl_xor(ss, 32, 64);
          const float f = rs * rsqrtf(ss * (1.f / 64.f) + 1e-6f);
          u16* dst = Kb + qk_index(m, h);
#pragma unroll
          for (int ni = 0; ni < 4; ++ni) {
            const int d = ni * 16 + lq * 4;
            const float4 g = *(const float4*)(gk + d);
            *(uint2*)(dst + d) = make_uint2(pack2(acc[mi][ni][0] * f * g.x, acc[mi][ni][1] * f * g.y), pack2(acc[mi][ni][2] * f * g.z, acc[mi][ni][3] * f * g.w));
          }
          *(uint4*)(dst + 64 + lq * 8) = *(const uint4*)((const u16*)(p.ws + OFF_KR) + (size_t)m * 32 + lq * 8);
        } else {
          const bool lat = m < NTL;
          const int b = lat ? m >> 12 : (m - NTL) >> 8;
          const int pos = lat ? m & 4095 : 4096 + ((m - NTL) & 255);
          u16* dst = Vt + (size_t)(b * 8 + h) * 64 * LK + pos + (size_t)(lq * 4) * LK;
#pragma unroll
          for (int ni = 0; ni < 4; ++ni) {
            asm volatile("" : "+v"(dst));
#pragma unroll
            for (int j = 0; j < 4; ++j) dst[j * LK] = f2bf(acc[mi][ni][j] * rs);
            dst += 16 * LK;
          }
        }
      }
      EPI_END
    }
  }
}

DI int scan_row(int b, int dir, int s) {
  if (s < LC) return NTL + b * LC + (dir ? LC - 1 - s : s);
  const int t = s - LC;
  return b * L + (dir ? L - 1 - t : t);
}
DI void phase_scan(const Params& p, char* smem) {
  LAUNDER_IDS
  const int blk = blk__;
  if (blk >= 256) return;
  const int tid = tid__, lane = tid & 63, wave = tid >> 6, kq = lane & 15, rg = lane >> 4;
  const int chain = (blk & 7) + 8 * (blk >> 5), quarter = (blk >> 3) & 3;
  const int b = chain >> 3, h = (chain >> 1) & 3, dir = chain & 1;
  const u16* sc = (const u16*)(p.ws + OFF_R3);
  const size_t AS = (size_t)NT * 256;
  const u16* aOMW = sc + (dir ? SA_OMWB : SA_OMWF) * AS;
  const u16* aKD = sc + (dir ? SA_KDB : SA_KDF) * AS;
  const u16* aB = sc + (dir ? SA_BB : SA_BF) * AS;
  const u16* aKKN = sc + SA_KKN * AS;
  const u16* aR = sc + SA_R * AS;
  const u16* aV = sc + SA_V * AS;
  u16* Y = (u16*)(p.ws + OFF_R2) + (dir ? AS : 0);
  constexpr int CH = 16, BSZ = 5 * CH * 64 + CH * 16;
  float* buf = (float*)smem;
  const int st_ld = tid >> 4, k4 = (tid & 15) * 4;
  const int vrow = quarter * 16 + wave * 4 + rg;
  uint2 g0, g1, g2, g3, g4; u16 gv;
#define SCAN_GLOAD(CHUNK) do { \
    const int row_ = scan_row(b, dir, (CHUNK) * CH + st_ld); \
    const size_t o_ = (size_t)row_ * 256 + h * 64 + k4; \
    g0 = *(const uint2*)(aOMW + o_); g1 = *(const uint2*)(aKD + o_); g2 = *(const uint2*)(aB + o_); g3 = *(const uint2*)(aKKN + o_); g4 = *(const uint2*)(aR + o_); \
    gv = aV[(size_t)row_ * 256 + h * 64 + quarter * 16 + (tid & 15)]; } while (0)
#define SCAN_LSTORE(BI) do { \
    float* bb_ = buf + (BI) * BSZ + st_ld * 64 + k4; \
    *(float4*)(bb_ + 0 * CH * 64) = make_float4(1.f - bflo(g0.x), 1.f - bfhi(g0.x), 1.f - bflo(g0.y), 1.f - bfhi(g0.y)); \
    *(float4*)(bb_ + 1 * CH * 64) = make_float4(bflo(g1.x), bfhi(g1.x), bflo(g1.y), bfhi(g1.y)); \
    *(float4*)(bb_ + 2 * CH * 64) = make_float4(bflo(g2.x), bfhi(g2.x), bflo(g2.y), bfhi(g2.y)); \
    *(float4*)(bb_ + 3 * CH * 64) = make_float4(bflo(g3.x), bfhi(g3.x), bflo(g3.y), bfhi(g3.y)); \
    *(float4*)(bb_ + 4 * CH * 64) = make_float4(bflo(g4.x), bfhi(g4.x), bflo(g4.y), bfhi(g4.y)); \
    buf[(BI) * BSZ + 5 * CH * 64 + st_ld * 16 + (tid & 15)] = bf2f(gv); } while (0)
  float2_t S01 = {0.f, 0.f}, S23 = {0.f, 0.f};
  __builtin_amdgcn_s_setprio(3);
  __syncthreads();
  SCAN_GLOAD(0); SCAN_LSTORE(0);
  __syncthreads();
  constexpr int NCH = LK / CH;
  for (int c = 0; c < NCH; ++c) {
    if (c + 1 < NCH) SCAN_GLOAD(c + 1);
    const float* bb = buf + (c & 1) * BSZ;
    const int rowbase = scan_row(b, dir, c * CH);
    const int rstep = dir ? -1 : 1;
    const float* bl = bb + kq * 4;
    const float* bv = bb + 5 * CH * 64 + wave * 4 + rg;
    float4 fwv[3], fkv[3], fbv[3], fav[3], frv[3]; float vvv[3];
#pragma unroll
    for (int q = 0; q < 2; ++q) {
      fwv[q] = *(const float4*)(bl + 0 * CH * 64 + q * 64); fkv[q] = *(const float4*)(bl + 1 * CH * 64 + q * 64); fbv[q] = *(const float4*)(bl + 2 * CH * 64 + q * 64);
      fav[q] = *(const float4*)(bl + 3 * CH * 64 + q * 64); frv[q] = *(const float4*)(bl + 4 * CH * 64 + q * 64); vvv[q] = bv[q * 16];
    }
    float ysel = 0.f, ypart = 0.f;
#pragma unroll
    for (int s = 0; s < CH; ++s) {
      const float4 fw = fwv[s % 3], fk = fkv[s % 3], fb = fbv[s % 3], fa = fav[s % 3], fr = frv[s % 3];
      const float vv = vvv[s % 3];
      const float2_t a01 = {fa.x, fa.y}, a23 = {fa.z, fa.w};
      const float2_t w01 = {fw.x, fw.y}, w23 = {fw.z, fw.w}, k01 = {fk.x, fk.y}, k23 = {fk.z, fk.w}, b01 = {fb.x, fb.y}, b23 = {fb.z, fb.w};
      const float2_t r01 = {fr.x, fr.y}, r23 = {fr.z, fr.w};
      const float2_t vv2 = {vv, vv};
      if (s + 2 < CH) {
        constexpr int dummy = 0; (void)dummy;
        const int q = (s + 2) % 3;
        fwv[q] = *(const float4*)(bl + 0 * CH * 64 + (s + 2) * 64); fkv[q] = *(const float4*)(bl + 1 * CH * 64 + (s + 2) * 64); fbv[q] = *(const float4*)(bl + 2 * CH * 64 + (s + 2) * 64);
        fav[q] = *(const float4*)(bl + 3 * CH * 64 + (s + 2) * 64); frv[q] = *(const float4*)(bl + 4 * CH * 64 + (s + 2) * 64); vvv[q] = bv[(s + 2) * 16];
      }
      float2_t t2 = S01 * a01; t2 = S23 * a23 + t2;
      const float2_t q01 = S01 * w01 + vv2 * k01, q23 = S23 * w23 + vv2 * k23;
      float xs = t2.x + t2.y, ys = ypart;
      xs += __builtin_bit_cast(float, __builtin_amdgcn_update_dpp(0, __builtin_bit_cast(int, xs), 0x128, 0xf, 0xf, false));
      ys += __builtin_bit_cast(float, __builtin_amdgcn_update_dpp(0, __builtin_bit_cast(int, ys), 0x128, 0xf, 0xf, false));
      xs += __builtin_bit_cast(float, __builtin_amdgcn_update_dpp(0, __builtin_bit_cast(int, xs), 0x124, 0xf, 0xf, false));
      ys += __builtin_bit_cast(float, __builtin_amdgcn_update_dpp(0, __builtin_bit_cast(int, ys), 0x124, 0xf, 0xf, false));
      xs += __builtin_bit_cast(float, __builtin_amdgcn_update_dpp(0, __builtin_bit_cast(int, xs), 0x122, 0xf, 0xf, false));
      ys += __builtin_bit_cast(float, __builtin_amdgcn_update_dpp(0, __builtin_bit_cast(int, ys), 0x122, 0xf, 0xf, false));
      xs += __builtin_bit_cast(float, __builtin_amdgcn_update_dpp(0, __builtin_bit_cast(int, xs), 0x121, 0xf, 0xf, false));
      ys += __builtin_bit_cast(float, __builtin_amdgcn_update_dpp(0, __builtin_bit_cast(int, ys), 0x121, 0xf, 0xf, false));
      if (s > 0) ysel = (kq == s - 1) ? ys : ysel;
      const float2_t sa2 = {xs, xs};
      S01 = sa2 * b01 + q01; S23 = sa2 * b23 + q23;
      float2_t y2 = S01 * r01; y2 = S23 * r23 + y2;
      ypart = y2.x + y2.y;
    }
    { const float yl = rowsum16(ypart); ysel = (kq == CH - 1) ? yl : ysel; }
    Y[(size_t)(rowbase + rstep * kq) * 256 + h * 64 + vrow] = f2bf(ysel);
    if (c + 1 < NCH) SCAN_LSTORE((c + 1) & 1);
    __syncthreads();
  }
  __builtin_amdgcn_s_setprio(0);
#undef SCAN_GLOAD
#undef SCAN_LSTORE
}

constexpr int KSL = 104, VSL = 68;
template <int B0>
DI bf16x8 pack8(const f32x16& v) {
  uint4 pw;
  pw.x = pack2(v[B0 + 0], v[B0 + 1]); pw.y = pack2(v[B0 + 2], v[B0 + 3]); pw.z = pack2(v[B0 + 4], v[B0 + 5]); pw.w = pack2(v[B0 + 6], v[B0 + 7]);
  return __builtin_bit_cast(bf16x8, pw);
}
DI void pv_step(f32x16& o0, f32x16& o1, const u16* Vc, int r32, int kb, bf16x8 pf) {
  {
    const uint2 lo = *(const uint2*)(Vc + r32 * VSL + kb), hi2 = *(const uint2*)(Vc + r32 * VSL + kb + 8);
    const bf16x8 va = __builtin_bit_cast(bf16x8, make_uint4(lo.x, lo.y, hi2.x, hi2.y));
    o0 = __builtin_amdgcn_mfma_f32_32x32x16_bf16(va, pf, o0, 0, 0, 0);
  }
  {
    const uint2 lo = *(const uint2*)(Vc + (32 + r32) * VSL + kb), hi2 = *(const uint2*)(Vc + (32 + r32) * VSL + kb + 8);
    const bf16x8 va = __builtin_bit_cast(bf16x8, make_uint4(lo.x, lo.y, hi2.x, hi2.y));
    o1 = __builtin_amdgcn_mfma_f32_32x32x16_bf16(va, pf, o1, 0, 0, 0);
  }
}
DI void attn_item(const Params& p, int item, char* smem) {
  LAUNDER_IDS
  const int tid = tid__, lane = tid & 63, wave = tid >> 6, r32 = lane & 31, hi = lane >> 5;
  int bh, qpos0, key0, nkt, orow0;
  if (item < 2048) { bh = item >> 5; const int qb = item & 31; qpos0 = qb * 128; key0 = 0; nkt = LK / 64; orow0 = (bh >> 3) * L + qpos0; }
  else { const int it = item - 2048; bh = it >> 1; const int qb = it & 1; qpos0 = 4096 + qb * 128; key0 = 4096; nkt = LC / 64; orow0 = NTL + (bh >> 3) * LC + qb * 128; }
  const int h = bh & 7;
  const u16* Qp = (const u16*)(p.ws + OFF_R1) + ((size_t)bh * LK + qpos0 + wave * 32 + r32) * 96 + hi * 8;
  const u16* Kp = (const u16*)(p.ws + OFF_R1 + SZ_Q) + ((size_t)bh * LK + key0) * 96;
  const u16* Vp = (const u16*)(p.ws + OFF_R1 + 2 * SZ_Q) + (size_t)bh * 64 * LK + key0;
  u16* Ks = (u16*)smem;
  u16* Vs = Ks + 2 * 64 * KSL;
  bf16x8 qr[6];
#pragma unroll
  for (int d0 = 0; d0 < 6; ++d0) qr[d0] = *(const bf16x8*)(Qp + d0 * 16);
  uint4 ak0, ak1, ak2, av0, av1, bk0, bk1, bk2, bv0, bv1;
  const int kr0 = tid / 12, kc0 = tid - kr0 * 12, kr1 = (tid + 256) / 12, kc1 = (tid + 256) - kr1 * 12, kr2 = (tid + 512) / 12, kc2 = (tid + 512) - kr2 * 12;
  const int vd0 = tid >> 3, vc0 = tid & 7, vd1 = vd0 + 32;
#define gload(S, kt) do { \
    S##k0 = *(const uint4*)(Kp + (size_t)((kt) * 64 + kr0) * 96 + kc0 * 8); S##k1 = *(const uint4*)(Kp + (size_t)((kt) * 64 + kr1) * 96 + kc1 * 8); \
    S##k2 = *(const uint4*)(Kp + (size_t)((kt) * 64 + kr2) * 96 + kc2 * 8); \
    S##v0 = *(const uint4*)(Vp + (size_t)vd0 * LK + (kt) * 64 + vc0 * 8); S##v1 = *(const uint4*)(Vp + (size_t)vd1 * LK + (kt) * 64 + vc0 * 8); } while (0)
#define lstore(S, bi) do { \
    *(uint4*)(Ks + (bi) * 64 * KSL + kr0 * KSL + kc0 * 8) = S##k0; *(uint4*)(Ks + (bi) * 64 * KSL + kr1 * KSL + kc1 * 8) = S##k1; *(uint4*)(Ks + (bi) * 64 * KSL + kr2 * KSL + kc2 * 8) = S##k2; \
    { u16* dst = Vs + (bi) * 64 * VSL + vd0 * VSL + vc0 * 8; *(uint2*)dst = make_uint2(S##v0.x, S##v0.y); *(uint2*)(dst + 4) = make_uint2(S##v0.z, S##v0.w); } \
    { u16* dst = Vs + (bi) * 64 * VSL + vd1 * VSL + vc0 * 8; *(uint2*)dst = make_uint2(S##v1.x, S##v1.y); *(uint2*)(dst + 4) = make_uint2(S##v1.z, S##v1.w); } } while (0)
  f32x16 o0, o1;
#pragma unroll
  for (int i = 0; i < 16; ++i) { o0[i] = 0.f; o1[i] = 0.f; }
  float mrun = -1e30f, lrun = 0.f;
  auto tile_compute = [&](int cur) {
    const u16* Kc = Ks + cur * 64 * KSL;
    const u16* Vc = Vs + cur * 64 * VSL;
    f32x16 p0, p1;
#pragma unroll
    for (int i = 0; i < 16; ++i) { p0[i] = 0.f; p1[i] = 0.f; }
#pragma unroll
    for (int d0 = 0; d0 < 6; ++d0) {
      const bf16x8 a0 = *(const bf16x8*)(Kc + r32 * KSL + d0 * 16 + hi * 8);
      const bf16x8 a1 = *(const bf16x8*)(Kc + (32 + r32) * KSL + d0 * 16 + hi * 8);
      p0 = __builtin_amdgcn_mfma_f32_32x32x16_bf16(a0, qr[d0], p0, 0, 0, 0);
      p1 = __builtin_amdgcn_mfma_f32_32x32x16_bf16(a1, qr[d0], p1, 0, 0, 0);
    }
    float mx = p0[0];
#pragma unroll
    for (int i = 1; i < 16; ++i) mx = fmaxf(mx, p0[i]);
#pragma unroll
    for (int i = 0; i < 16; ++i) mx = fmaxf(mx, p1[i]);
    { auto rr = __builtin_amdgcn_permlane32_swap(__float_as_uint(mx), __float_as_uint(mx), false, false);
      mx = fmaxf(__uint_as_float(rr[0]), __uint_as_float(rr[1])); }
    if (!__all(mx - mrun <= 8.f)) {
      const float mn = fmaxf(mrun, mx);
      const float alpha = __builtin_amdgcn_exp2f(mrun - mn);
      mrun = mn; lrun *= alpha;
#pragma unroll
      for (int i = 0; i < 16; ++i) { o0[i] *= alpha; o1[i] *= alpha; }
    }
    float ps = 0.f;
#pragma unroll
    for (int i = 0; i < 16; ++i) { p0[i] = __builtin_amdgcn_exp2f(p0[i] - mrun); ps += p0[i]; }
#pragma unroll
    for (int i = 0; i < 16; ++i) { p1[i] = __builtin_amdgcn_exp2f(p1[i] - mrun); ps += p1[i]; }
    lrun += ps;
    pv_step(o0, o1, Vc, r32, 0 + hi * 4, pack8<0>(p0));
    pv_step(o0, o1, Vc, r32, 16 + hi * 4, pack8<8>(p0));
    pv_step(o0, o1, Vc, r32, 32 + hi * 4, pack8<0>(p1));
    pv_step(o0, o1, Vc, r32, 48 + hi * 4, pack8<8>(p1));
  };
  __syncthreads();
  gload(a, 0); lstore(a, 0);
  gload(a, 1);
  __syncthreads();
  for (int kt = 0; kt < nkt; kt += 2) {
    if (kt + 2 < nkt) gload(b, kt + 2);
    tile_compute(0);
    lstore(a, 1);
    __syncthreads();
    if (kt + 3 < nkt) gload(a, kt + 3);
    tile_compute(1);
    if (kt + 2 < nkt) lstore(b, 0);
    __syncthreads();
  }
  lrun += __shfl_xor(lrun, 32, 64);
  const float inv = 1.f / lrun;
  u16* om = (u16*)(p.ws + OFF_OMLA) + (size_t)(orow0 + wave * 32 + r32) * 512 + h * 64;
#pragma unroll
  for (int g = 0; g < 4; ++g) {
    const int d = 8 * g + 4 * hi;
    *(uint2*)(om + d) = make_uint2(pack2(o0[4 * g] * inv, o0[4 * g + 1] * inv), pack2(o0[4 * g + 2] * inv, o0[4 * g + 3] * inv));
    *(uint2*)(om + 32 + d) = make_uint2(pack2(o1[4 * g] * inv, o1[4 * g + 1] * inv), pack2(o1[4 * g + 2] * inv, o1[4 * g + 3] * inv));
  }
#undef gload
#undef lstore
}

DI void readout_row(const Params& p, int l, int r) {
  LAUNDER_IDS
  const int lane = tid__ & 63;
  const u16* sc = (const u16*)(p.ws + OFF_R3);
  const size_t AS = (size_t)NT * 256;
  const size_t o = (size_t)r * 256 + lane * 4;
  const u16* Yf = (const u16*)(p.ws + OFF_R2);
  const uint2 yf = *(const uint2*)(Yf + o), yb = *(const uint2*)(Yf + AS + o);
  const uint2 ur = *(const uint2*)(sc + SA_R * AS + o), uv = *(const uint2*)(sc + SA_V * AS + o);
  const uint2 kf = *(const uint2*)(sc + SA_KDF * AS + o), kb = *(const uint2*)(sc + SA_KDB * AS + o), ug = *(const uint2*)(sc + SA_G * AS + o);
  float y[4] = {bflo(yf.x) + bflo(yb.x), bfhi(yf.x) + bfhi(yb.x), bflo(yf.y) + bflo(yb.y), bfhi(yf.y) + bfhi(yb.y)};
  const float rr[4] = {bflo(ur.x), bfhi(ur.x), bflo(ur.y), bfhi(ur.y)};
  const float vv[4] = {bflo(uv.x), bfhi(uv.x), bflo(uv.y), bfhi(uv.y)};
  const float km[4] = {0.5f * (bflo(kf.x) + bflo(kb.x)), 0.5f * (bfhi(kf.x) + bfhi(kb.x)), 0.5f * (bflo(kf.y) + bflo(kb.y)), 0.5f * (bfhi(kf.y) + bfhi(kb.y))};
  const float gg[4] = {bflo(ug.x), bfhi(ug.x), bflo(ug.y), bfhi(ug.y)};
  const float4 rk4 = *(const float4*)(p.in[I_RK] + l * 256 + lane * 4);
  const float4 lw4 = *(const float4*)(p.in[I_LNW] + l * 256 + lane * 4);
  const float4 lb4 = *(const float4*)(p.in[I_LNB] + l * 256 + lane * 4);
  const float rk[4] = {rk4.x, rk4.y, rk4.z, rk4.w}, lw[4] = {lw4.x, lw4.y, lw4.z, lw4.w}, lb[4] = {lb4.x, lb4.y, lb4.z, lb4.w};
  float s = y[0] + y[1] + y[2] + y[3];
  s = rowsum16(s);
  const float mu = s * (1.f / 64.f);
  float q = 0.f, bn = 0.f;
#pragma unroll
  for (int j = 0; j < 4; ++j) { const float d = y[j] - mu; q += d * d; bn += rr[j] * km[j] * rk[j]; }
  q = rowsum16(q); bn = rowsum16(bn);
  const float rstd = rsqrtf(q * (1.f / 64.f) + 64e-5f);
  float ov[4];
#pragma unroll
  for (int j = 0; j < 4; ++j) ov[j] = ((y[j] - mu) * rstd * lw[j] + lb[j] + bn * vv[j]) * gg[j];
  u16* orw = (u16*)(p.ws + OFF_R3 + SA_KKN * SZ_TOK256 + (size_t)NT * 512 * 2);
  *(uint2*)(orw + o) = make_uint2(pack2(ov[0], ov[1]), pack2(ov[2], ov[3]));
}

DI void phase_attn(const Params& p, int l, char* smem) {
  LAUNDER_IDS
  __shared__ int qslot_sh;
  const int nattn = (l == 0) ? 2048 + 128 : 2048;
  unsigned* ctr = (unsigned*)(p.ws + OFF_BAR) + 16 + l * 16;
  for (;;) {
    __syncthreads();
    if (tid__ == 0) qslot_sh = (int)__hip_atomic_fetch_add(ctr, 1u, __ATOMIC_RELAXED, __HIP_MEMORY_SCOPE_AGENT);
    __syncthreads();
    const int it = qslot_sh;
    if (it >= nattn) break;
    attn_item(p, it, smem);
  }
}
DI void phase_readout(const Params& p, int l, int Mout) {
  LAUNDER_IDS
  const int wave = tid__ >> 6;
  for (int r = blk__ * 4 + wave; r < Mout; r += gridDim.x * 4) readout_row(p, l, r);
}

DI void phase_merge(const Params& p, int l, int Mout, char* smem) {
  LAUNDER_IDS
  WAVE_COORDS
  const char* wl = p.ws + OFF_W + (size_t)l * W_LAYER;
  const u16* hg = (const u16*)(p.ws + OFF_HBG);
  const u16* opool = (const u16*)(p.ws + OFF_R4);
  const u16* omla = (const u16*)(p.ws + OFF_OMLA);
  const u16* orw = (const u16*)(p.ws + OFF_R3 + SA_KKN * SZ_TOK256) + (size_t)NT * 512;
  u16* mo = (u16*)(p.ws + OFF_R1);
  const int ntm = Mout / 128;
  for (int it = 0;; ++it) {
    int tm, tn;
    if (!tile_map(it, ntm, 8, blk__, gridDim.x, tm, tn)) break;
    const int m0 = tm * 128, n0 = tn * 128;
    f32x4 msum[4][4]; zero_accm<4, 4>(msum);
#pragma unroll 1
    for (int br = 0; br < 3; ++br) {
      unsigned gpk[4][4][2];
      {
        f32x4 ag[4][4]; zero_accm<4, 4>(ag);
        gemm256<4, 4>(ag, hg, 1024, (const u16*)(wl + WO_WIN) + (size_t)(2080 + br * 1024) * 1024, 1024, 1024, m0, n0, smem);
#pragma unroll
        for (int mi = 0; mi < 4; ++mi)
#pragma unroll
          for (int ni = 0; ni < 4; ++ni) {
            gpk[mi][ni][0] = pack2(sigmoidf_(ag[mi][ni][0]), sigmoidf_(ag[mi][ni][1]));
            gpk[mi][ni][1] = pack2(sigmoidf_(ag[mi][ni][2]), sigmoidf_(ag[mi][ni][3]));
          }
      }
      __builtin_amdgcn_sched_barrier(0);
      f32x4 ab[4][4]; zero_accm<4, 4>(ab);
      {
        const int Kb = br == 1 ? 512 : 256;
        const u16* Ab = br == 0 ? opool : br == 1 ? omla : orw;
        const u16* Wb = (const u16*)(wl + (br == 0 ? WO_BRP : br == 1 ? WO_BRM : WO_BRR));
        gemm256<4, 4>(ab, Ab, Kb, Wb, Kb, Kb, m0, n0, smem);
      }
#pragma unroll
      for (int mi = 0; mi < 4; ++mi)
#pragma unroll
        for (int ni = 0; ni < 4; ++ni) {
          msum[mi][ni][0] += bflo(gpk[mi][ni][0]) * ab[mi][ni][0];
          msum[mi][ni][1] += bfhi(gpk[mi][ni][0]) * ab[mi][ni][1];
          msum[mi][ni][2] += bflo(gpk[mi][ni][1]) * ab[mi][ni][2];
          msum[mi][ni][3] += bfhi(gpk[mi][ni][1]) * ab[mi][ni][3];
        }
      __builtin_amdgcn_sched_barrier(0);
    }
    EPI_BEGIN
#pragma unroll
    for (int mi = 0; mi < 4; ++mi) {
      const int m = m0 + wr * 64 + mi * 16 + lr;
#pragma unroll
      for (int ni = 0; ni < 4; ++ni) {
        const int n = n0 + wc * 64 + ni * 16 + lq * 4;
        *(uint2*)(mo + (size_t)m * 1024 + n) = make_uint2(pack2(msum[mi][ni][0], msum[mi][ni][1]), pack2(msum[mi][ni][2], msum[mi][ni][3]));
      }
    }
    EPI_END
  }
}

template <int MI, int NI>
DI void resid_tile(const u16* A, int K, const u16* Bt, const float* gate, const float* xl_in, const float* xc_in, float* xl_out, float* xc_out,
                   int m0, int n0, char* smem) {
  LAUNDER_IDS
  WAVE_COORDS
  f32x4 acc[MI][NI]; zero_accm<MI, NI>(acc);
  gemm256<MI, NI>(acc, A, K, Bt, K, K, m0, n0, smem);
  EPI_BEGIN
#pragma unroll
  for (int mi = 0; mi < MI; ++mi) {
    const int m = m0 + wr * 16 * MI + mi * 16 + lr;
    const int b9 = m < NTL ? m >> 12 : 8;
    const float* xi = xrow(xl_in, xc_in, m);
    float* xo = m < NTL ? xl_out + (size_t)m * D : xc_out + (size_t)(m - NTL) * D;
#pragma unroll
    for (int ni = 0; ni < NI; ++ni) {
      const int n = n0 + wc * 16 * NI + ni * 16 + lq * 4;
      const float4 g = *(const float4*)(gate + (size_t)b9 * 6144 + n);
      const float4 xv = *(const float4*)(xi + n);
      float4 ov;
      ov.x = xv.x + g.x * acc[mi][ni][0]; ov.y = xv.y + g.y * acc[mi][ni][1]; ov.z = xv.z + g.z * acc[mi][ni][2]; ov.w = xv.w + g.w * acc[mi][ni][3];
      *(float4*)(xo + n) = ov;
    }
    __builtin_amdgcn_sched_barrier(0);
  }
  EPI_END
}
DI void phase_resid(const Params& p, const u16* A, int K, const u16* Bt, const float* gate  ,
                    const float* xl_in, const float* xc_in, float* xl_out, float* xc_out, int Mout, char* smem) {
  LAUNDER_IDS
  for (int it = 0;; ++it) {
    int tm, tn;
    if (!tile_map(it, NTL / 256, 8, blk__, gridDim.x, tm, tn)) break;
    resid_tile<8, 4>(A, K, Bt, gate, xl_in, xc_in, xl_out, xc_out, tm * 256, tn * 128, smem);
  }
  if (Mout > NTL) {
    for (int t = blk__; t < (NTC / 64) * 16; t += gridDim.x) {
      const int tm = t >> 4, tn = t & 15;
      resid_tile<2, 2>(A, K, Bt, gate, xl_in, xc_in, xl_out, xc_out, NTL + tm * 64, tn * 64, smem);
    }
  }
}
DI void phase_mlp1(const Params& p, int l, int Mout, char* smem) {
  LAUNDER_IDS
  WAVE_COORDS
  const char* wl = p.ws + OFF_W + (size_t)l * W_LAYER;
  const u16* hb = (const u16*)(p.ws + OFF_HB2);
  u16* U = (u16*)(p.ws + OFF_R1);
  const int ntm = Mout / 256;
  for (int it = 0;; ++it) {
    int tm, tn;
    if (!tile_map(it, ntm, 32, blk__, gridDim.x, tm, tn)) break;
    const int m0 = tm * 256, n0 = tn * 128;
    f32x4 acc[8][4]; zero_accm<8, 4>(acc);
    gemm256<8, 4>(acc, hb, 1024, (const u16*)(wl + WO_W1), 1024, 1024, m0, n0, smem);
    EPI_BEGIN
#pragma unroll
    for (int mi = 0; mi < 8; ++mi) {
      const int m = m0 + wr * 128 + mi * 16 + lr;
#pragma unroll
      for (int ni = 0; ni < 4; ++ni) {
        const int n = n0 + wc * 64 + ni * 16 + lq * 4;
        float v[4];
#pragma unroll
        for (int j = 0; j < 4; ++j) { const float a = fmaxf(acc[mi][ni][j], 0.f); v[j] = a * a; }
        *(uint2*)(U + (size_t)m * DFF + n) = make_uint2(pack2(v[0], v[1]), pack2(v[2], v[3]));
      }
      __builtin_amdgcn_sched_barrier(0);
    }
    EPI_END
  }
}

__global__ void __launch_bounds__(256, 2) fwd_megakernel(Params pk) {
  __shared__ __attribute__((aligned(16))) char smem[73728];
  cg::grid_group grid = cg::this_grid();
  if (threadIdx.x == 0) { g_base_sh[0] = (unsigned long long)pk.ws; g_base_sh[1] = (unsigned long long)pk.out; }
  xcd_barrier_post((unsigned*)(pk.ws + OFF_BAR));
  __syncthreads();
  phase_prep(pk, smem);
  if (pk.ws == nullptr) grid.sync();
  xcd_barrier();
  phase_tables(pk);
  xcd_barrier();
#define CTXBUF ((float*)(p.ws + OFF_CTX))
#define XLP (l == 0 ? p.in[I_X] : (const float*)p.out)
#define XCP (l == 0 ? p.in[I_CTX] : (const float*)CTXBUF)
#define MOUT (l == 0 ? NT : NTL)
#define WLP (p.ws + OFF_W + (size_t)l * W_LAYER)
#define TABP(nrm) ((const float*)(p.ws + OFF_TAB) + (size_t)(l * 2 + (nrm)) * 9 * 2048)
#define MODP(j) ((const float*)(p.ws + OFF_MODS) + (size_t)l * 9 * 6144 + (j) * 1024)
#ifndef PROBE_Q
#define PROBE_Q -1
#endif
#pragma nounroll
  for (int ph = 0; ph < 22; ++ph) {
    const int l = ph >= 11 ? 1 : 0, q = ph - l * 11;
    Params p = pk;
    {
      asm volatile("" ::: "memory");
      unsigned long long w_ = g_base_sh[0], o_ = g_base_sh[1];
      unsigned wl_ = (unsigned)w_, wh_ = (unsigned)(w_ >> 32), ol_ = (unsigned)o_, oh_ = (unsigned)(o_ >> 32);
      wl_ = __builtin_amdgcn_readfirstlane(wl_); wh_ = __builtin_amdgcn_readfirstlane(wh_); ol_ = __builtin_amdgcn_readfirstlane(ol_); oh_ = __builtin_amdgcn_readfirstlane(oh_);
      asm volatile("" : "+s"(wl_), "+s"(wh_), "+s"(ol_), "+s"(oh_));
      p.ws = (char*)(((unsigned long long)wh_ << 32) | wl_); p.out = (float*)(((unsigned long long)oh_ << 32) | ol_);
    }
#pragma nounroll
    for (int rep = 0; rep < (q == PROBE_Q ? 2 : 1); ++rep)
    switch (q) {
      case 0: phase_norm(XLP, XCP, TABP(0), (u16*)(p.ws + OFF_HB1), NT); break;
      case 1: phase_zgemm(p, l, smem); break;
      case 2: phase_tokA(p, l); phase_tokB(p, l, smem); break;
      case 3: phase_qkv(p, l, smem); break;
      case 4: phase_scan(p, smem); phase_attn(p, l, smem); break;
      case 5: phase_norm(XLP, XCP, TABP(0), (u16*)(p.ws + OFF_HBG), MOUT); phase_readout(p, l, MOUT); break;
      case 6: phase_merge(p, l, MOUT, smem); break;
      case 7: phase_resid(p, (const u16*)(p.ws + OFF_R1), 1024, (const u16*)(WLP + WO_WO), MODP(2), XLP, XCP, p.out, CTXBUF, MOUT, smem); break;
      case 8: phase_norm(p.out, CTXBUF, TABP(1), (u16*)(p.ws + OFF_HB2), MOUT); break;
      case 9: phase_mlp1(p, l, MOUT, smem); break;
      default: phase_resid(p, (const u16*)(p.ws + OFF_R1), 4096, (const u16*)(WLP + WO_W2), MODP(5), p.out, CTXBUF, p.out, CTXBUF, MOUT, smem); break;
    }
    if (ph != 21) xcd_barrier();
  }
}

extern "C" void kernel_launch(void* const* d_in, const int* in_sizes, int n_in, void* d_out, int out_size, void* d_ws, size_t ws_size, hipStream_t stream) {
  static int grid_blocks = 0;
  if (!grid_blocks) {
    int dev = 0, cus = 0, per_cu = 0;
    hipGetDevice(&dev);
    hipDeviceGetAttribute(&cus, hipDeviceAttributeMultiprocessorCount, dev);
    hipOccupancyMaxActiveBlocksPerMultiprocessor(&per_cu, fwd_megakernel, 256, 0);
    if (per_cu > 2) per_cu = 2;
    if (per_cu < 1) per_cu = 1;
    grid_blocks = cus * per_cu;
    if (ws_size < WS_END) fprintf(stderr, "kernel_launch: workspace too small: %zu < %zu\n", ws_size, (size_t)WS_END);
  }
  Params p{};
  for (int i = 0; i < 34; ++i) p.in[i] = (const float*)d_in[i];
  p.out = (float*)d_out;
  p.ws = (char*)d_ws;
  hipMemsetAsync(d_ws, 0, 16384, stream);
  void* args[] = {&p};
  hipError_t e = hipLaunchCooperativeKernel((void*)fwd_megakernel, dim3(grid_blocks), dim3(256), args, 0, stream);
  if (e != hipSuccess) fprintf(stderr, "cooperative launch failed: %s (grid %d)\n", hipGetErrorString(e), grid_blocks);
}
```

```cpp
#include <hip/hip_runtime.h>
#include <hip/hip_cooperative_groups.h>
#include <stdint.h>
#include <cstdio>
namespace cg = cooperative_groups;

typedef unsigned short u16;
typedef __attribute__((ext_vector_type(8))) short bf16x8;
typedef __attribute__((ext_vector_type(4))) float f32x4;
typedef __attribute__((ext_vector_type(16))) float f32x16;
typedef __bf16 bf16x2_t __attribute__((ext_vector_type(2)));
typedef float float2_t __attribute__((ext_vector_type(2)));

#define DI __device__ __forceinline__

constexpr int D = 1024, NB = 8, L = 4096, LC = 256, LK = 4352;
constexpr int NTL = NB * L;
constexpr int NTC = NB * LC;
constexpr int NT = NTL + NTC;
constexpr int INC = 5152;
constexpr int ZA = 928;
constexpr int ZR = 1152;
constexpr int DFF = 4096;

constexpr size_t al256(size_t x) { return (x + 255) / 256 * 256; }
constexpr size_t OFF_BAR = 0;
constexpr size_t OFF_MODS = 16384;
constexpr size_t OFF_TAB = OFF_MODS + al256(2 * 9 * 6144 * 4);
constexpr size_t OFF_ROPE = OFF_TAB + al256(2 * 2 * 9 * 2 * 1024 * 4);
constexpr size_t OFF_RS1 = OFF_ROPE + 4096;
constexpr size_t OFF_RS2 = OFF_RS1 + al256(NT * 4);
constexpr size_t OFF_RSQ = OFF_RS2 + al256(NT * 4);
constexpr size_t OFF_RSKV = OFF_RSQ + al256(NT * 4);
constexpr size_t OFF_CTX = OFF_RSKV + al256(NT * 4);
constexpr size_t OFF_W = OFF_CTX + (size_t)NTC * D * 4;
constexpr size_t WO_WIN = 0;
constexpr size_t WO_UQ = WO_WIN + (size_t)INC * 1024 * 2;
constexpr size_t WO_UKV = WO_UQ + (size_t)768 * 384 * 2;
constexpr size_t WO_BRP = WO_UKV + (size_t)1024 * 256 * 2;
constexpr size_t WO_BRM = WO_BRP + (size_t)1024 * 256 * 2;
constexpr size_t WO_BRR = WO_BRM + (size_t)1024 * 512 * 2;
constexpr size_t WO_WO = WO_BRR + (size_t)1024 * 256 * 2;
constexpr size_t WO_W1 = WO_WO + (size_t)1024 * 1024 * 2;
constexpr size_t WO_W2 = WO_W1 + (size_t)4096 * 1024 * 2;
constexpr size_t WO_RW2 = WO_W2 + (size_t)1024 * 4096 * 2;
constexpr size_t WO_RA2 = WO_RW2 + (size_t)2 * 256 * 64 * 2;
constexpr size_t WO_RG2 = WO_RA2 + (size_t)2 * 256 * 64 * 2;
constexpr size_t W_LAYER = al256(WO_RG2 + (size_t)256 * 128 * 2);
constexpr size_t OFF_R1 = OFF_W + 2 * W_LAYER;
constexpr size_t SZ_Q = (size_t)NB * 8 * LK * 96 * 2;
constexpr size_t SZ_VT = (size_t)NB * 8 * 64 * LK * 2;
constexpr size_t SZ_R1 = 2 * SZ_Q + SZ_VT;
constexpr size_t OFF_R2 = OFF_R1 + al256(SZ_R1);
constexpr size_t SZ_TOK256 = (size_t)NT * 256 * 2;
constexpr size_t OFF_R3 = OFF_R2 + al256((size_t)NT * ZA * 2);
constexpr size_t OFF_R4 = OFF_R3 + 10 * SZ_TOK256;
constexpr size_t OFF_KR = OFF_R4 + SZ_TOK256;
constexpr size_t OFF_OMLA = OFF_KR + al256((size_t)NT * 32 * 2);
constexpr size_t WS_END = OFF_OMLA + (size_t)NT * 512 * 2;
static_assert(WS_END <= 536870912ull, "workspace map exceeds 4x the largest tensor");
constexpr size_t OFF_HB1 = OFF_R3;
constexpr size_t OFF_HBG = OFF_R1 + (size_t)NT * 1024 * 2;
constexpr size_t OFF_HB2 = OFF_R3 + 5 * SZ_TOK256;
enum { SA_R = 0, SA_V = 1, SA_KDF = 2, SA_KDB = 3, SA_G = 4, SA_KKN = 5, SA_OMWF = 6, SA_BF = 7, SA_OMWB = 8, SA_BB = 9 };

struct Params { const float* in[34]; float* out; char* ws; };

enum { I_X = 0, I_C, I_CTX, I_CCTX, I_N1G, I_N2G, I_WADA, I_BADA, I_WIN, I_POOLW, I_POOLS, I_QNORM, I_WUQ, I_KVNORM, I_WUKV,
       I_GQ, I_GK, I_MU, I_W0, I_W2R, I_A0, I_A2R, I_KA, I_KK, I_RK, I_G2R, I_LNW, I_LNB, I_BRP, I_BRM, I_BRR, I_WO, I_W1, I_W2 };

DI float bf2f(u16 h) { return __uint_as_float(((unsigned)h) << 16); }
DI float bflo(unsigned u) { return __uint_as_float(u << 16); }
DI float bfhi(unsigned u) { return __uint_as_float(u & 0xffff0000u); }
DI unsigned pack2(float a, float b) { float2_t v = {a, b}; bf16x2_t r = __builtin_convertvector(v, bf16x2_t); return __builtin_bit_cast(unsigned, r); }
DI u16 f2bf(float a) { return (u16)(pack2(a, 0.f) & 0xffffu); }
DI float sigmoidf_(float x) { return 1.f / (1.f + __expf(-x)); }
DI float siluf_(float x) { return x / (1.f + __expf(-x)); }
DI float rowsum16(float x) {
  x += __builtin_bit_cast(float, __builtin_amdgcn_update_dpp(0, __builtin_bit_cast(int, x), 0x128, 0xf, 0xf, false));
  x += __builtin_bit_cast(float, __builtin_amdgcn_update_dpp(0, __builtin_bit_cast(int, x), 0x124, 0xf, 0xf, false));
  x += __builtin_bit_cast(float, __builtin_amdgcn_update_dpp(0, __builtin_bit_cast(int, x), 0x122, 0xf, 0xf, false));
  x += __builtin_bit_cast(float, __builtin_amdgcn_update_dpp(0, __builtin_bit_cast(int, x), 0x121, 0xf, 0xf, false));
  return x;
}
DI float wavesum(float x) {
  x = rowsum16(x);
  const int xi = __builtin_bit_cast(int, x);
  return __builtin_bit_cast(float, __builtin_amdgcn_readlane(xi, 0)) + __builtin_bit_cast(float, __builtin_amdgcn_readlane(xi, 16)) +
         __builtin_bit_cast(float, __builtin_amdgcn_readlane(xi, 32)) + __builtin_bit_cast(float, __builtin_amdgcn_readlane(xi, 48));
}
DI void grid_barrier(unsigned* ctr, unsigned& epoch) {
  asm volatile("s_waitcnt vmcnt(0)" ::: "memory");
  __syncthreads();
  epoch++;
  if (threadIdx.x == 0) {
    __builtin_amdgcn_fence(__ATOMIC_RELEASE, "agent");
    asm volatile("s_waitcnt vmcnt(0)" ::: "memory");
    const unsigned target = epoch * gridDim.x;
    __hip_atomic_fetch_add(ctr, 1u, __ATOMIC_RELAXED, __HIP_MEMORY_SCOPE_AGENT);
    while (__hip_atomic_load(ctr, __ATOMIC_RELAXED, __HIP_MEMORY_SCOPE_AGENT) < target) __builtin_amdgcn_s_sleep(2);
    __builtin_amdgcn_fence(__ATOMIC_ACQUIRE, "agent");
    asm volatile("s_waitcnt vmcnt(0)" ::: "memory");
  }
  __syncthreads();
}


#define XB_TMO      128
#define XB_XCNT(j)  (256  + 64 * (j))
#define XB_XSUB(j)  (1280 + 64 * (j))
#define XB_XGEN(j)  (2304 + 64 * (j))
#define XB_TOP      3328
#define XB_TOPGEN   3392
#define XB_SPIN_CAP (1u << 22)
#define LAS __attribute__((address_space(3)))
DI unsigned xb_ld(unsigned* p)              { return __hip_atomic_load(p, __ATOMIC_RELAXED, __HIP_MEMORY_SCOPE_AGENT); }
DI unsigned xb_add(unsigned* p, unsigned v) { return __hip_atomic_fetch_add(p, v, __ATOMIC_RELAXED, __HIP_MEMORY_SCOPE_AGENT); }
DI unsigned xb_xcc_id() { return (unsigned)__builtin_amdgcn_s_getreg((3 << 11) | 20) & 0xFu; }
#define XB_SPIN(cond, bar) do { unsigned _sp = 0; while (cond) { __builtin_amdgcn_s_sleep(1); \
    if ((++_sp & 255u) == 0u) { if (xb_ld(&(bar)[XB_TMO])) break; if (_sp > XB_SPIN_CAP) { atomicAdd(&(bar)[XB_TMO], 1u); break; } } } } while (0)
__shared__ uint4 g_xb_words;
__shared__ unsigned long long g_base_sh[2];
DI void xcd_barrier_post(unsigned* bar) {
  const unsigned x = xb_xcc_id();
  if (threadIdx.x == 0) { g_xb_words = make_uint4(0u, 0u, x, 0u); (void)xb_add(&bar[XB_XCNT(x)], 1u); }
}
DI void xcd_barrier_complete(unsigned* bar, unsigned x, unsigned& nloc, unsigned& nx) {
  const unsigned G = gridDim.x;
  unsigned sum, cnt, mine, sp = 0u;
  for (;;) {
    sum = 0u; cnt = 0u; mine = 0u;
#pragma unroll
    for (unsigned j = 0; j < 16; ++j) { const unsigned c = xb_ld(&bar[XB_XCNT(j)]); sum += c; cnt += (c > 0u) ? 1u : 0u; mine = (j == x) ? c : mine; }
    if (sum == G) break;
    __builtin_amdgcn_s_sleep(1);
    if ((++sp & 255u) == 0u) { if (xb_ld(&bar[XB_TMO])) break; if (sp > XB_SPIN_CAP) { atomicAdd(&bar[XB_TMO], 1u); break; } }
  }
  nloc = mine > 0u ? mine : 1u; nx = cnt > 0u ? cnt : 1u;
}
DI void xcd_barrier() {
  asm volatile("s_waitcnt vmcnt(0)" ::: "memory");
  __syncthreads();
  if (threadIdx.x == 0) {
    unsigned* bar = (unsigned*)(g_base_sh[0] + OFF_BAR);
    __builtin_amdgcn_s_waitcnt(0);
    unsigned nloc = g_xb_words.x, nx = g_xb_words.y; const unsigned x = g_xb_words.z;
    if (nloc == 0u) { xcd_barrier_complete(bar, x, nloc, nx); g_xb_words.x = nloc; g_xb_words.y = nx; }
    const unsigned old = xb_add(&bar[XB_XSUB(x)], 1u);
    const unsigned gen = old / nloc;
    if (old + 1u == (gen + 1u) * nloc) {
      __builtin_amdgcn_fence(__ATOMIC_RELEASE, "agent");
      asm volatile("s_waitcnt vmcnt(0)" ::: "memory");
      const unsigned og = xb_add(&bar[XB_TOP], 1u);
      const unsigned tg = og / nx;
      if (og + 1u == (tg + 1u) * nx) xb_add(&bar[XB_TOPGEN], 1u);
      else XB_SPIN(xb_ld(&bar[XB_TOPGEN]) == tg, bar);
      __builtin_amdgcn_fence(__ATOMIC_ACQUIRE, "agent");
      xb_add(&bar[XB_XGEN(x)], 1u);
      asm volatile("s_waitcnt vmcnt(0)" ::: "memory");
    } else {
      XB_SPIN(xb_ld(&bar[XB_XGEN(x)]) == gen, bar);
      __builtin_amdgcn_fence(__ATOMIC_ACQUIRE, "agent");
      asm volatile("s_waitcnt vmcnt(0)" ::: "memory");
    }
  }
  __syncthreads();
}
DI int launder_v(int x) { asm volatile("" : "+v"(x)); return x; }
DI int launder_s(int x) { asm volatile("" : "+s"(x)); return x; }
#define LAUNDER_IDS const int tid__ = launder_v((int)threadIdx.x); const int blk__ = launder_s((int)blockIdx.x); (void)tid__; (void)blk__;
DI void do_transpose(const float* __restrict__ src, int K, int N, u16* __restrict__ dst, const float* __restrict__ ksc, int perm, int tile, float* tl) {
  LAUNDER_IDS
  const int ntn = (N + 63) >> 6;
  const int kt = tile / ntn, nt = tile - kt * ntn;
  const int k0 = kt * 64, n0 = nt * 64;
  const int tid = tid__;
  __syncthreads();
#pragma unroll 4
  for (int i = 0; i < 16; ++i) {
    const int kk = i * 4 + (tid >> 6), nn = tid & 63;
    float v = 0.f;
    if (n0 + nn < N) v = src[(size_t)(k0 + kk) * N + n0 + nn];
    if (ksc) v *= ksc[k0 + kk];
    tl[kk * 65 + nn] = v;
  }
  __syncthreads();
#pragma unroll 4
  for (int i = 0; i < 16; ++i) {
    const int nn = i * 4 + (tid >> 6), kk = tid & 63;
    int n = n0 + nn;
    if (n < N) {
      if (perm) { const int h = n / 96, d = n - h * 96; n = d < 64 ? h * 64 + d : 512 + h * 32 + (d - 64); }
      dst[(size_t)n * K + k0 + kk] = f2bf(tl[kk * 65 + nn]);
    }
  }
}

DI void phase_prep(const Params& p, char* smem) {
  LAUNDER_IDS
  float* tl = (float*)smem;
  const int tid = tid__;
  constexpr int T_WIN = 16 * 81, T_UQ = 6 * 12, T_UKV = 4 * 16, T_BRM = 8 * 16, T_BRR = 4 * 16, T_WO = 16 * 16, T_W1 = 16 * 64, T_W2 = 64 * 16,
                T_RW2 = 4, T_RA2 = 4, T_RG2 = 2 * 4;
  constexpr int T_LAYER = T_WIN + T_UQ + T_UKV + T_BRM + T_BRR + T_WO + T_W1 + T_W2 + 2 * T_RW2 + 2 * T_RA2 + T_RG2;
  for (int g = blk__; g < 2 * T_LAYER; g += gridDim.x) {
    const int l = g / T_LAYER; int t = g - l * T_LAYER;
    char* wl = p.ws + OFF_W + (size_t)l * W_LAYER;
#define JOB(SRC, KK, NN, DSTOFF, SC, PERM, CNT) if (t < (CNT)) { do_transpose((SRC), (KK), (NN), (u16*)(wl + (DSTOFF)), (SC), (PERM), t, tl); continue; } t -= (CNT);
    JOB(p.in[I_WIN] + (size_t)l * 1024 * INC, 1024, INC, WO_WIN, nullptr, 0, T_WIN)
    JOB(p.in[I_WUQ] + (size_t)l * 384 * 768, 384, 768, WO_UQ, p.in[I_QNORM] + l * 384, 1, T_UQ)
    JOB(p.in[I_WUKV] + (size_t)l * 256 * 1024, 256, 1024, WO_UKV, p.in[I_KVNORM] + l * 256, 0, T_UKV)
    JOB(p.in[I_BRM] + (size_t)l * 512 * 1024, 512, 1024, WO_BRM, nullptr, 0, T_BRM)
    JOB(p.in[I_BRR] + (size_t)l * 256 * 1024, 256, 1024, WO_BRR, nullptr, 0, T_BRR)
    JOB(p.in[I_WO] + (size_t)l * 1024 * 1024, 1024, 1024, WO_WO, nullptr, 0, T_WO)
    JOB(p.in[I_W1] + (size_t)l * 1024 * 4096, 1024, 4096, WO_W1, nullptr, 0, T_W1)
    JOB(p.in[I_W2] + (size_t)l * 4096 * 1024, 4096, 1024, WO_W2, nullptr, 0, T_W2)
    JOB(p.in[I_W2R] + (size_t)(l * 2 + 0) * 64 * 256, 64, 256, WO_RW2, nullptr, 0, T_RW2)
    JOB(p.in[I_W2R] + (size_t)(l * 2 + 1) * 64 * 256, 64, 256, WO_RW2 + 256 * 64 * 2, nullptr, 0, T_RW2)
    JOB(p.in[I_A2R] + (size_t)(l * 2 + 0) * 64 * 256, 64, 256, WO_RA2, nullptr, 0, T_RA2)
    JOB(p.in[I_A2R] + (size_t)(l * 2 + 1) * 64 * 256, 64, 256, WO_RA2 + 256 * 64 * 2, nullptr, 0, T_RA2)
    JOB(p.in[I_G2R] + (size_t)l * 128 * 256, 128, 256, WO_RG2, nullptr, 0, T_RG2)
#undef JOB
  }
  for (int e = blk__ * 256 + tid; e < 2 * 256 * 1024; e += gridDim.x * 256) {
    const int l = e >> 18, r = e & 262143, cin = r >> 10, n = r & 1023, g = cin >> 6, c = cin & 63;
    const float* pw = p.in[I_POOLW] + ((size_t)(l * 4 + g) * 64 + c) * 64;
    const float* ps = p.in[I_POOLS] + l * 256 + g * 64;
    const float* wb = p.in[I_BRP] + ((size_t)l * 256 + g * 64) * 1024 + n;
    float s = 0.f;
    for (int d = 0; d < 64; ++d) s += pw[d] * ps[d] * wb[(size_t)d * 1024];
    ((u16*)(p.ws + OFF_W + (size_t)l * W_LAYER + WO_BRP))[(size_t)n * 256 + cin] = f2bf(s);
  }
  if (blk__ == gridDim.x - 1) {
    for (int e = tid; e < 512; e += 256) {
      const int pos = e >> 3, f = e & 7;
      const float inv = powf(10000.f, -(float)f / 8.f);
      const float ang = (float)pos * inv;
      float* rt = (float*)(p.ws + OFF_ROPE);
      rt[e * 2] = cosf(ang); rt[e * 2 + 1] = sinf(ang);
    }
  }
  {
    float* sl = (float*)smem;
    float* red = sl + 9 * 1024;
    __syncthreads();
    for (int e = tid; e < 9 * 1024; e += 256) {
      const int b = e >> 10, k = e & 1023;
      const float v = b < 8 ? p.in[I_C][b * 1024 + k] : p.in[I_CCTX][k];
      sl[e] = siluf_(v);
    }
    __syncthreads();
    const int wave = tid >> 6, lane = tid & 63;
    for (int it = blk__; it < 192; it += gridDim.x) {
      const int l = it / 96, cg_ = it - l * 96;
      const int col = cg_ * 64 + lane;
      const float* wa = p.in[I_WADA] + (size_t)l * 1024 * 6144 + col;
      float acc[9];
#pragma unroll
      for (int b = 0; b < 9; ++b) acc[b] = 0.f;
#pragma unroll 8
      for (int k = wave * 256; k < wave * 256 + 256; ++k) {
        const float w = wa[(size_t)k * 6144];
#pragma unroll
        for (int b = 0; b < 9; ++b) acc[b] += sl[b * 1024 + k] * w;
      }
#pragma unroll
      for (int b = 0; b < 9; ++b) red[(wave * 9 + b) * 64 + lane] = acc[b];
      __syncthreads();
      for (int e = tid; e < 9 * 64; e += 256) {
        const int b = e >> 6, c = e & 63;
        const float s = red[(0 * 9 + b) * 64 + c] + red[(1 * 9 + b) * 64 + c] + red[(2 * 9 + b) * 64 + c] + red[(3 * 9 + b) * 64 + c];
        ((float*)(p.ws + OFF_MODS))[(size_t)(l * 9 + b) * 6144 + cg_ * 64 + c] = s + p.in[I_BADA][l * 6144 + cg_ * 64 + c];
      }
      __syncthreads();
    }
  }
}

DI const float* xrow(const float* xl, const float* xc, int r) { return r < NTL ? xl + (size_t)r * D : xc + (size_t)(r - NTL) * D; }

DI void phase_norm(const float* xl, const float* xc, const float* tab  , u16* hb, int M) {
  LAUNDER_IDS
  const int wave = tid__ >> 6, lane = tid__ & 63;
  const int nw = gridDim.x * 4, rpw = (M + nw - 1) / nw;
  const int rbeg = (blk__ * 4 + wave) * rpw, rend = min(rbeg + rpw, M);
  int cur_b9 = -1;
  float4 g[4], sh[4];
#pragma unroll
  for (int i = 0; i < 4; ++i) { g[i] = make_float4(0.f, 0.f, 0.f, 0.f); sh[i] = g[i]; }
  float4 vn[4];
  if (rbeg < rend) {
    const float* xp0 = xrow(xl, xc, rbeg);
#pragma unroll
    for (int i = 0; i < 4; ++i) vn[i] = *(const float4*)(xp0 + i * 256 + lane * 4);
  }
  for (int r = rbeg; r < rend; ++r) {
    const int b9 = r < NTL ? r >> 12 : 8;
    float4 v[4];
#pragma unroll
    for (int i = 0; i < 4; ++i) v[i] = vn[i];
    {
      const float* xpn = xrow(xl, xc, min(r + 1, rend - 1));
#pragma unroll
      for (int i = 0; i < 4; ++i) vn[i] = *(const float4*)(xpn + i * 256 + lane * 4);
    }
    if (b9 != cur_b9) {
      cur_b9 = b9;
      const float* t = tab + b9 * 2048;
#pragma unroll
      for (int i = 0; i < 4; ++i) { g[i] = *(const float4*)(t + i * 256 + lane * 4); sh[i] = *(const float4*)(t + 1024 + i * 256 + lane * 4); }
    }
    float s = 0.f;
#pragma unroll
    for (int i = 0; i < 4; ++i) s += v[i].x * v[i].x + v[i].y * v[i].y + v[i].z * v[i].z + v[i].w * v[i].w;
    s = wavesum(s);
    const float rs = rsqrtf(s * (1.f / 1024.f) + 1e-6f);
#pragma unroll
    for (int i = 0; i < 4; ++i) {
      const int k = i * 256 + lane * 4;
      *(uint2*)(hb + (size_t)r * 1024 + k) = make_uint2(pack2(v[i].x * rs * g[i].x + sh[i].x, v[i].y * rs * g[i].y + sh[i].y), pack2(v[i].z * rs * g[i].z + sh[i].z, v[i].w * rs * g[i].w + sh[i].w));
    }
  }
}
DI void phase_tables(const Params& p) {
  LAUNDER_IDS
  const float* mods = (const float*)(p.ws + OFF_MODS);
  float* tab = (float*)(p.ws + OFF_TAB);
  for (int e = blk__ * 256 + tid__; e < 2 * 2 * 9 * 1024; e += gridDim.x * 256) {
    const int k = e & 1023, b9 = (e >> 10) % 9, ln = (e >> 10) / 9, l = ln >> 1, nrm = ln & 1;
    const float g = p.in[nrm ? I_N2G : I_N1G][l * 1024 + k];
    const float sh = mods[(size_t)(l * 9 + b9) * 6144 + (nrm * 3 + 0) * 1024 + k];
    const float sc = mods[(size_t)(l * 9 + b9) * 6144 + (nrm * 3 + 1) * 1024 + k];
    float* t = tab + ((size_t)(l * 2 + nrm) * 9 + b9) * 2048;
    t[k] = g * (1.f + sc); t[1024 + k] = sh;
  }
}

struct LoadBf16 {
  const u16* A; int lda;
  DI void init(int m0) {}
  DI uint4 load(int i, int m0, int k0) const {
    LAUNDER_IDS
    const int tid = tid__, kc = (tid & 7) * 8;
    return *(const uint4*)(A + (size_t)(m0 + (tid >> 3) + i * 32) * lda + k0 + kc);
  }
};
struct LoadNorm {
  const float* xl; const float* xc; const float* rs; const float* tab;
  float r0, r1, r2, r3;
  DI void init(int m0) {
    LAUNDER_IDS
    const int tid = tid__;
    r0 = rs[m0 + (tid >> 3)]; r1 = rs[m0 + (tid >> 3) + 32]; r2 = rs[m0 + (tid >> 3) + 64]; r3 = rs[m0 + (tid >> 3) + 96];
  }
  DI uint4 load(int i, int m0, int k0) const {
    LAUNDER_IDS
    const int tid = tid__, kc = (tid & 7) * 8;
    const int b9 = m0 < NTL ? m0 >> 12 : 8;
    const float* t = tab + b9 * 2048 + k0 + kc;
    const float4 g0 = *(const float4*)t, g1 = *(const float4*)(t + 4), s0 = *(const float4*)(t + 1024), s1 = *(const float4*)(t + 1028);
    const float* xp = xrow(xl, xc, m0 + (tid >> 3)) + k0 + kc + (size_t)i * 32 * D;
    const float4 x0 = *(const float4*)xp, x1 = *(const float4*)(xp + 4);
    const float rr = i == 0 ? r0 : i == 1 ? r1 : i == 2 ? r2 : r3;
    uint4 o;
    o.x = pack2(x0.x * rr * g0.x + s0.x, x0.y * rr * g0.y + s0.y);
    o.y = pack2(x0.z * rr * g0.z + s0.z, x0.w * rr * g0.w + s0.w);
    o.z = pack2(x1.x * rr * g1.x + s1.x, x1.y * rr * g1.y + s1.y);
    o.w = pack2(x1.z * rr * g1.z + s1.z, x1.w * rr * g1.w + s1.w);
    return o;
  }
};

DI bool tile_map(int it, int NTM, int NTN, int blk, int nblk, int& tm, int& tn) {
  const int xcd = blk & 7, local = blk >> 3, LB = nblk >> 3;
  const int R = NTM >> 3;
  const int s = it * LB + local;
  if (s >= R * NTN) return false;
  const int F = R >> 3, per_full = 8 * NTN;
  int mg, r, gm;
  if (s < F * per_full) { mg = s / per_full; r = s - mg * per_full; gm = 8; }
  else { mg = F; r = s - F * per_full; gm = R - F * 8; }
  const int ng = r / (gm * 8);
  const int r2 = r - ng * gm * 8;
  const int mi = r2 % gm, ni = r2 / gm;
  tm = xcd * R + mg * 8 + mi; tn = ng * 8 + ni;
  return true;
}
constexpr int LDT = 72;
template <int NI, class LA>
DI void gemm_mainloop(f32x4 (&acc)[4][NI], LA la, const u16* __restrict__ Bt, int ldb, int K, int m0, int n0, char* smem) {
  LAUNDER_IDS
  constexpr int NBI = NI;
  u16* As = (u16*)smem; u16* Bs = As + 2 * 128 * LDT;
  const int tid = tid__, lane = tid & 63, wave = tid >> 6, wr = wave >> 1, wc = wave & 1, lr = lane & 15, lq = lane >> 4;
  uint4 ra[4], rb[NBI];
  la.init(m0);
#pragma unroll
  for (int i = 0; i < 4; ++i) ra[i] = la.load(i, m0, 0);
#pragma unroll
  for (int i = 0; i < NBI; ++i) {
    const int c = tid + i * 256, row = c >> 3, kc = (c & 7) * 8;
    rb[i] = *(const uint4*)(Bt + (size_t)(n0 + row) * ldb + kc);
  }
#pragma unroll
  for (int i = 0; i < 4; ++i) {
    const int c = tid + i * 256, row = c >> 3, kc = (c & 7) * 8;
    *(uint4*)(As + row * LDT + kc) = ra[i];
    if (i < NBI) *(uint4*)(Bs + row * LDT + kc) = rb[i];
  }
  __syncthreads();
  const int nk = K >> 6;
  for (int kt = 0; kt < nk; ++kt) {
    const int cur = kt & 1;
    if (kt + 1 < nk) {
      const int k0 = (kt + 1) * 64;
#pragma unroll
      for (int i = 0; i < 4; ++i) ra[i] = la.load(i, m0, k0);
#pragma unroll
      for (int i = 0; i < NBI; ++i) {
        const int c = tid + i * 256, row = c >> 3, kc = (c & 7) * 8;
        rb[i] = *(const uint4*)(Bt + (size_t)(n0 + row) * ldb + k0 + kc);
      }
    }
    const u16* Ac = As + cur * 128 * LDT + (wr * 64 + lr) * LDT + lq * 8;
    const u16* Bc = Bs + cur * 128 * LDT + (wc * 16 * NI + lr) * LDT + lq * 8;
#pragma unroll
    for (int ks = 0; ks < 2; ++ks) {
      bf16x8 af[4], bfr[NI];
#pragma unroll
      for (int mi = 0; mi < 4; ++mi) af[mi] = *(const bf16x8*)(Ac + mi * 16 * LDT + ks * 32);
#pragma unroll
      for (int ni = 0; ni < NI; ++ni) bfr[ni] = *(const bf16x8*)(Bc + ni * 16 * LDT + ks * 32);
#pragma unroll
      for (int mi = 0; mi < 4; ++mi)
#pragma unroll
        for (int ni = 0; ni < NI; ++ni)
          acc[mi][ni] = __builtin_amdgcn_mfma_f32_16x16x32_bf16(bfr[ni], af[mi], acc[mi][ni], 0, 0, 0);
    }
    if (kt + 1 < nk) {
      const int nxt = cur ^ 1;
#pragma unroll
      for (int i = 0; i < 4; ++i) {
        const int c = tid + i * 256, row = c >> 3, kc = (c & 7) * 8;
        *(uint4*)(As + nxt * 128 * LDT + row * LDT + kc) = ra[i];
        if (i < NBI) *(uint4*)(Bs + nxt * 128 * LDT + row * LDT + kc) = rb[i];
      }
    }
    __syncthreads();
  }
}
template <int NI>
DI void zero_acc(f32x4 (&acc)[4][NI]) {
#pragma unroll
  for (int i = 0; i < 4; ++i)
#pragma unroll
    for (int j = 0; j < NI; ++j) acc[i][j] = f32x4{0.f, 0.f, 0.f, 0.f};
}
template <int MI, int NI>
DI void gemm256(f32x4 (&acc)[MI][NI], const u16* __restrict__ A, int lda, const u16* __restrict__ Bt, int ldb, int K, int m0, int n0, char* smem) {
  LAUNDER_IDS
  const int lane = tid__ & 63, wave = tid__ >> 6, wr = wave >> 1, wc = wave & 1, lr = lane & 15, lq = lane >> 4;
  constexpr int NAW = MI / 2;
  constexpr int NBW = NI / 2;
  constexpr int ABYTES = MI * 2 * 1024;
  constexpr int STAGE = ABYTES + NI * 2 * 1024;
  constexpr int LPS = NAW + NBW;
  static_assert(3 * STAGE <= 73728, "ring does not fit");
  const int srow = lane >> 2, scol = ((lane & 3) ^ ((lane >> 5) << 1)) * 8;
  const u16* Ag = A + (size_t)(m0 + wave * NAW * 16 + srow) * lda + scol;
  const u16* Bg = Bt + (size_t)(n0 + wave * NBW * 16 + srow) * ldb + scol;
  char* la = smem + (wave * NAW) * 1024 + lane * 16;
  char* lb = smem + ABYTES + (wave * NBW) * 1024 + lane * 16;
#define G256_ISSUE(S, K0) do { \
    _Pragma("unroll") for (int j_ = 0; j_ < NAW; ++j_) \
      __builtin_amdgcn_global_load_lds((const unsigned*)(Ag + (size_t)j_ * 16 * lda + (K0)), (__attribute__((address_space(3))) unsigned*)(la + (S) * STAGE + j_ * 1024), 16, 0, 0); \
    _Pragma("unroll") for (int j_ = 0; j_ < NBW; ++j_) \
      __builtin_amdgcn_global_load_lds((const unsigned*)(Bg + (size_t)j_ * 16 * ldb + (K0)), (__attribute__((address_space(3))) unsigned*)(lb + (S) * STAGE + j_ * 1024), 16, 0, 0); \
  } while (0)
  const int nk = K >> 5;
  G256_ISSUE(0, 0);
  if (nk > 1) G256_ISSUE(1, 32);
  const int foff = lr * 64 + ((lq ^ ((lr >> 3) << 1)) * 16);
  int st = 0;
  for (int kt = 0; kt < nk; ++kt) {
    if (kt + 1 < nk) asm volatile("s_waitcnt vmcnt(%0) lgkmcnt(0)" :: "n"(LPS) : "memory");
    else asm volatile("s_waitcnt vmcnt(0) lgkmcnt(0)" ::: "memory");
    __builtin_amdgcn_s_barrier();
    if (kt + 2 < nk) { const int s2 = st >= 1 ? st - 1 : 2; G256_ISSUE(s2, (kt + 2) * 32); }
    const char* sb = smem + st * STAGE + foff;
    bf16x8 af[MI], bfr[NI];
#pragma unroll
    for (int mi = 0; mi < MI; ++mi) af[mi] = *(const bf16x8*)(sb + (wr * MI + mi) * 1024);
#pragma unroll
    for (int ni = 0; ni < NI; ++ni) bfr[ni] = *(const bf16x8*)(sb + ABYTES + (wc * NI + ni) * 1024);
#pragma unroll
    for (int mi = 0; mi < MI; ++mi)
#pragma unroll
      for (int ni = 0; ni < NI; ++ni)
        acc[mi][ni] = __builtin_amdgcn_mfma_f32_16x16x32_bf16(bfr[ni], af[mi], acc[mi][ni], 0, 0, 0);
    st = st == 2 ? 0 : st + 1;
  }
  asm volatile("s_waitcnt lgkmcnt(0)" ::: "memory");
  __builtin_amdgcn_s_barrier();
#undef G256_ISSUE
}
template <int MI, int NI>
DI void zero_accm(f32x4 (&acc)[MI][NI]) {
#pragma unroll
  for (int i = 0; i < MI; ++i)
#pragma unroll
    for (int j = 0; j < NI; ++j) acc[i][j] = f32x4{0.f, 0.f, 0.f, 0.f};
}
#define EPI_BEGIN const int lr1_ = launder_v(lr), lq1_ = launder_v(lq), wr1_ = launder_v(wr), wc1_ = launder_v(wc); { const int lr = lr1_, lq = lq1_, wr = wr1_, wc = wc1_; (void)lr; (void)lq; (void)wr; (void)wc;
#define EPI_END }
#define WAVE_COORDS const int lane = tid__ & 63, wave = tid__ >> 6, wr = wave >> 1, wc = wave & 1, lr = lane & 15, lq = lane >> 4; (void)wr; (void)wc; (void)lr; (void)lq;

DI void phase_zgemm(const Params& p, int l, char* smem) {
  LAUNDER_IDS
  WAVE_COORDS
  const u16* Wt = (const u16*)(p.ws + OFF_W + (size_t)l * W_LAYER + WO_WIN);
  const u16* hb = (const u16*)(p.ws + OFF_HB1);
  u16* za = (u16*)(p.ws + OFF_R2); u16* zr = (u16*)(p.ws + OFF_R1);
  for (int it = 0;; ++it) {
    int tm, tn;
    if (!tile_map(it, NT / 256, 17, blk__, gridDim.x, tm, tn)) break;
    const int m0 = tm * 256, n0 = tn * 128;
    f32x4 acc[8][4]; zero_accm<8, 4>(acc);
    gemm256<8, 4>(acc, hb, 1024, Wt, 1024, 1024, m0, n0, smem);
    EPI_BEGIN
#pragma unroll
    for (int mi = 0; mi < 8; ++mi) {
      const int m = m0 + wr * 128 + mi * 16 + lr;
#pragma unroll
      for (int ni = 0; ni < 4; ++ni) {
        const int n = n0 + wc * 64 + ni * 16 + lq * 4;
        uint2 v; v.x = pack2(acc[mi][ni][0], acc[mi][ni][1]); v.y = pack2(acc[mi][ni][2], acc[mi][ni][3]);
        if (n < ZA) *(uint2*)(za + (size_t)m * ZA + n) = v;
        else if (n < ZA + ZR) *(uint2*)(zr + (size_t)m * ZR + (n - ZA)) = v;
      }
    }
    EPI_END
  }
}

DI void phase_tokA(const Params& p, int l) {
  LAUNDER_IDS
  const int wave = tid__ >> 6, lane = tid__ & 63;
  const u16* za = (const u16*)(p.ws + OFF_R2);
  float* rsq = (float*)(p.ws + OFF_RSQ); float* rskv = (float*)(p.ws + OFF_RSKV);
  u16* krb = (u16*)(p.ws + OFF_KR);
  u16* pooled = (u16*)(p.ws + OFF_R4);
  const float* rt = (const float*)(p.ws + OFF_ROPE);
  const float* gk = p.in[I_GK] + l * 96;
  for (int r = blk__ * 4 + wave; r < NT; r += gridDim.x * 4) {
    const u16* z = za + (size_t)r * ZA;
    const bool lat = r < NTL;
    const int b = lat ? r >> 12 : (r - NTL) >> 8;
    const int t = lat ? r & 4095 : (r - NTL) & 255;
    const int Ls = lat ? L : LC;
    const int pos = lat ? t : 4096 + t;
    u16 zq[6], zk[4], pw[30], pc[4];
#pragma unroll
    for (int i = 0; i < 6; ++i) zq[i] = z[256 + i * 64 + lane];
#pragma unroll
    for (int i = 0; i < 4; ++i) zk[i] = z[640 + i * 64 + lane];
    const int d = lane & 31;
    const u16 kr_raw = z[896 + d];
    const float gkd = gk[64 + d];
    const int ri = d & 15;
    const int pp = ri < 8 ? (t >> 6) : (t & 63);
    const float cs = rt[(pp * 8 + (ri & 7)) * 2], sn = rt[(pp * 8 + (ri & 7)) * 2 + 1];
#pragma unroll
    for (int gi = 0; gi < 4; ++gi) {
      const int half = 1 << gi;
      pc[gi] = z[gi * 64 + lane];
#pragma unroll
      for (int j = 0; j < 2 * half; ++j) {
        const int qc = min(max(t - half + j, 0), Ls - 1);
        pw[2 * half - 2 + j] = z[(ptrdiff_t)(qc - t) * ZA + gi * 64 + lane];
      }
    }
    float sq = 0.f, skv = 0.f;
#pragma unroll
    for (int i = 0; i < 6; ++i) { const float v = bf2f(zq[i]); sq += v * v; }
#pragma unroll
    for (int i = 0; i < 4; ++i) { const float v = bf2f(zk[i]); skv += v * v; }
    sq = wavesum(sq); skv = wavesum(skv);
    const float rq = rsqrtf(sq * (1.f / 384.f) + 1e-6f), rkv = rsqrtf(skv * (1.f / 256.f) + 1e-6f);
    float kr = bf2f(kr_raw);
    float ss = rowsum16(kr * kr);
    { const int si = __builtin_bit_cast(int, ss);
      ss = __builtin_bit_cast(float, __builtin_amdgcn_readlane(si, 0)) + __builtin_bit_cast(float, __builtin_amdgcn_readlane(si, 16)); }
    kr = kr * rsqrtf(ss * (1.f / 32.f) + 1e-6f) * gkd;
    const float other = __shfl_xor(kr, 16, 64);
    const float rot = d < 16 ? kr * cs - other * sn : other * sn + kr * cs;
    const float outv = lat ? rot : kr;
    float pv[4];
#pragma unroll
    for (int gi = 0; gi < 4; ++gi) {
      const int half = 1 << gi;
      const int lo = max(t - half, 0), hi = min(t + half, Ls);
      float sm = 0.f;
#pragma unroll
      for (int j = 0; j < 2 * half; ++j) {
        const int q = t - half + j;
        sm += (q >= 0 && q < Ls) ? bf2f(pw[2 * half - 2 + j]) : 0.f;
      }
      pv[gi] = sm / (float)(hi - lo) - bf2f(pc[gi]);
    }
    if (lane == 0) { rsq[r] = rq; rskv[r] = rkv; }
    if (lane < 32) krb[(size_t)r * 32 + d] = f2bf(outv);
#pragma unroll
    for (int gi = 0; gi < 4; ++gi) pooled[(size_t)r * 256 + gi * 64 + lane] = f2bf(pv[gi]);
  }
}

constexpr int ZSL = 1160, TAL = 392;
DI void phase_tokB(const Params& p, int l, char* smem) {
  LAUNDER_IDS
  WAVE_COORDS
  const int tid = tid__;
  u16* Zs = (u16*)smem;
  u16* TA = Zs + 18 * ZSL;
  float* PV = (float*)(TA + 16 * TAL);
  const u16* zr = (const u16*)(p.ws + OFF_R1);
  const char* wl = p.ws + OFF_W + (size_t)l * W_LAYER;
  u16* sc = (u16*)(p.ws + OFF_R3);
  __syncthreads();
  for (int e = tid; e < 2 * ZR + 7 * 256; e += 256) {
    float v;
    if (e < 2 * ZR) v = p.in[I_MU][(size_t)l * 2 * ZR + e];
    else { const int f = e - 2 * ZR, a = f >> 8, c = f & 255;
      v = a == 0 ? p.in[I_KK][l * 256 + c] : a < 3 ? p.in[I_W0][(size_t)(l * 2 + a - 1) * 256 + c] : a < 5 ? p.in[I_A0][(size_t)(l * 2 + a - 3) * 256 + c] : p.in[I_KA][(size_t)(l * 2 + a - 5) * 256 + c]; }
    PV[e] = v;
  }
  const float* mu0 = PV; const float* mu1 = PV + ZR; const float* kkw = PV + 2 * ZR;
  const float* w0p = kkw + 256; const float* a0p = w0p + 512; const float* kap = a0p + 512;
  for (int tile = blk__; tile < NT / 16; tile += gridDim.x) {
    const int r0 = tile * 16;
    const bool lat = r0 < NTL;
    const int t0 = lat ? r0 & 4095 : (r0 - NTL) & 255;
    const int Ls = lat ? L : LC;
    __syncthreads();
    {
      uint4 v[11];
#pragma unroll
      for (int i = 0; i < 11; ++i) {
        const int c = tid + i * 256;
        const int ri = c / 144, ch = c - ri * 144;
        const int tt = t0 - 1 + ri;
        const int cc = min(c, 18 * 144 - 1);
        const int rc = cc / 144, chc = cc - rc * 144;
        const int ttc = min(max(t0 - 1 + rc, 0), Ls - 1);
        const uint4 ld = *(const uint4*)(zr + (size_t)(r0 - t0 + ttc) * ZR + chc * 8);
        const bool ok = (c < 18 * 144) && (tt >= 0) && (tt < Ls);
        v[i] = ok ? ld : make_uint4(0, 0, 0, 0);
      }
#pragma unroll
      for (int i = 0; i < 11; ++i) {
        const int c = tid + i * 256;
        const int ri = c / 144, ch = c - ri * 144;
        if (c < 18 * 144) {
          *(uint2*)(Zs + ri * ZSL + ch * 8) = make_uint2(v[i].x, v[i].y);
          *(uint2*)(Zs + ri * ZSL + ch * 8 + 4) = make_uint2(v[i].z, v[i].w);
        }
      }
    }
    __syncthreads();
#pragma unroll 4
    for (int e = tid; e < 16 * 384; e += 256) {
      const int i = e / 384, c = e - i * 384, zc = 768 + c;
      const float z = bf2f(Zs[(i + 1) * ZSL + zc]), zp = bf2f(Zs[i * ZSL + zc]), zn = bf2f(Zs[(i + 2) * ZSL + zc]);
      float v = z + mu0[zc] * (zp - z) + mu1[zc] * (zn - z);
      if (c < 128) v = 1.f - 2.f / (1.f + __expf(2.f * v)); else if (c >= 256) v = sigmoidf_(v);
      TA[i * TAL + c] = f2bf(v);
    }
    __syncthreads();
    const int row = r0 + lr;
    auto shifted4 = [&](int zc, float (&out)[4]) {
      const uint2 c0 = *(const uint2*)(Zs + (lr + 1) * ZSL + zc), cp = *(const uint2*)(Zs + lr * ZSL + zc), cn = *(const uint2*)(Zs + (lr + 2) * ZSL + zc);
      const float4 m0 = *(const float4*)(mu0 + zc), m1 = *(const float4*)(mu1 + zc);
      float z, zp, zn;
      z = bflo(c0.x); zp = bflo(cp.x); zn = bflo(cn.x); out[0] = z + m0.x * (zp - z) + m1.x * (zn - z);
      z = bfhi(c0.x); zp = bfhi(cp.x); zn = bfhi(cn.x); out[1] = z + m0.y * (zp - z) + m1.y * (zn - z);
      z = bflo(c0.y); zp = bflo(cp.y); zn = bflo(cn.y); out[2] = z + m0.z * (zp - z) + m1.z * (zn - z);
      z = bfhi(c0.y); zp = bfhi(cp.y); zn = bfhi(cn.y); out[3] = z + m0.w * (zp - z) + m1.w * (zn - z);
    };
    auto product128 = [&](f32x4 (&ac)[4], const u16* W, int off) {
      bf16x8 aop[4][4];
#pragma unroll
      for (int ks = 0; ks < 4; ++ks)
#pragma unroll
        for (int ni = 0; ni < 4; ++ni) aop[ks][ni] = *(const bf16x8*)(W + (size_t)(wave * 64 + ni * 16 + lr) * 128 + ks * 32 + lq * 8);
#pragma unroll
      for (int ni = 0; ni < 4; ++ni) ac[ni] = f32x4{0.f, 0.f, 0.f, 0.f};
#pragma unroll
      for (int ks = 0; ks < 4; ++ks) {
        const bf16x8 bop = *(const bf16x8*)(TA + lr * TAL + off + ks * 32 + lq * 8);
#pragma unroll
        for (int ni = 0; ni < 4; ++ni) ac[ni] = __builtin_amdgcn_mfma_f32_16x16x32_bf16(aop[ks][ni], bop, ac[ni], 0, 0, 0);
      }
      __builtin_amdgcn_sched_barrier(0);
    };
    auto product64x2 = [&](f32x4 (&ac0)[4], f32x4 (&ac1)[4], const u16* W0, const u16* W1, int off0, int off1) {
      bf16x8 a0[2][4], a1[2][4];
#pragma unroll
      for (int ks = 0; ks < 2; ++ks)
#pragma unroll
        for (int ni = 0; ni < 4; ++ni) {
          a0[ks][ni] = *(const bf16x8*)(W0 + (size_t)(wave * 64 + ni * 16 + lr) * 64 + ks * 32 + lq * 8);
          a1[ks][ni] = *(const bf16x8*)(W1 + (size_t)(wave * 64 + ni * 16 + lr) * 64 + ks * 32 + lq * 8);
        }
#pragma unroll
      for (int ni = 0; ni < 4; ++ni) { ac0[ni] = f32x4{0.f, 0.f, 0.f, 0.f}; ac1[ni] = f32x4{0.f, 0.f, 0.f, 0.f}; }
#pragma unroll
      for (int ks = 0; ks < 2; ++ks) {
        const bf16x8 b0 = *(const bf16x8*)(TA + lr * TAL + off0 + ks * 32 + lq * 8);
        const bf16x8 b1 = *(const bf16x8*)(TA + lr * TAL + off1 + ks * 32 + lq * 8);
#pragma unroll
        for (int ni = 0; ni < 4; ++ni) {
          ac0[ni] = __builtin_amdgcn_mfma_f32_16x16x32_bf16(a0[ks][ni], b0, ac0[ni], 0, 0, 0);
          ac1[ni] = __builtin_amdgcn_mfma_f32_16x16x32_bf16(a1[ks][ni], b1, ac1[ni], 0, 0, 0);
        }
      }
      __builtin_amdgcn_sched_barrier(0);
    };
    float ss = 0.f;
#pragma unroll
    for (int ni = 0; ni < 4; ++ni) {
      const int ch = wave * 64 + ni * 16 + lq * 4;
      float kx[4]; shifted4(256 + ch, kx);
      const float4 kw = *(const float4*)(kkw + ch);
      const float a0 = kx[0] * kw.x, a1 = kx[1] * kw.y, a2 = kx[2] * kw.z, a3 = kx[3] * kw.w;
      ss += a0 * a0 + a1 * a1 + a2 * a2 + a3 * a3;
    }
    ss += __shfl_xor(ss, 16, 64); ss += __shfl_xor(ss, 32, 64);
    const float kinv = rsqrtf(fmaxf(ss, 1e-24f));
    {
      f32x4 ag[4];
      product128(ag, (const u16*)(wl + WO_RG2), 256);
#pragma unroll
      for (int ni = 0; ni < 4; ++ni) {
        const int ch = wave * 64 + ni * 16 + lq * 4;
        const size_t o = (size_t)row * 256 + ch;
        float rx[4], kx[4], vx[4];
        shifted4(ch, rx); shifted4(256 + ch, kx); shifted4(512 + ch, vx);
        const float4 kw = *(const float4*)(kkw + ch);
        *(uint2*)(sc + SA_R * (size_t)NT * 256 + o) = make_uint2(pack2(rx[0], rx[1]), pack2(rx[2], rx[3]));
        *(uint2*)(sc + SA_V * (size_t)NT * 256 + o) = make_uint2(pack2(vx[0], vx[1]), pack2(vx[2], vx[3]));
        *(uint2*)(sc + SA_KKN * (size_t)NT * 256 + o) = make_uint2(pack2(-kx[0] * kw.x * kinv, -kx[1] * kw.y * kinv), pack2(-kx[2] * kw.z * kinv, -kx[3] * kw.w * kinv));
        *(uint2*)(sc + SA_G * (size_t)NT * 256 + o) = make_uint2(pack2(ag[ni][0], ag[ni][1]), pack2(ag[ni][2], ag[ni][3]));
        __builtin_amdgcn_sched_barrier(0);
      }
    }
#pragma unroll 1
    for (int d = 0; d < 2; ++d) {
      f32x4 aw[4], aa[4];
      product64x2(aw, aa, (const u16*)(wl + WO_RW2) + (size_t)d * 256 * 64, (const u16*)(wl + WO_RA2) + (size_t)d * 256 * 64, d * 64, 128 + d * 64);
      u16* oOMW = sc + (d ? SA_OMWB : SA_OMWF) * (size_t)NT * 256;
      u16* oKD = sc + (d ? SA_KDB : SA_KDF) * (size_t)NT * 256;
      u16* oB = sc + (d ? SA_BB : SA_BF) * (size_t)NT * 256;
#pragma unroll
      for (int ni = 0; ni < 4; ++ni) {
        const int ch = wave * 64 + ni * 16 + lq * 4;
        const size_t o = (size_t)row * 256 + ch;
        float kx[4]; shifted4(256 + ch, kx);
        const float4 kw = *(const float4*)(kkw + ch);
        const float kkn[4] = {kx[0] * kw.x * kinv, kx[1] * kw.y * kinv, kx[2] * kw.z * kinv, kx[3] * kw.w * kinv};
        const float4 w0 = *(const float4*)(w0p + d * 256 + ch);
        const float4 a0 = *(const float4*)(a0p + d * 256 + ch);
        const float4 ka = *(const float4*)(kap + d * 256 + ch);
        const float w0a[4] = {w0.x, w0.y, w0.z, w0.w}, a0a[4] = {a0.x, a0.y, a0.z, a0.w}, kaa[4] = {ka.x, ka.y, ka.z, ka.w};
        float omw[4], kd[4], bb[4];
#pragma unroll
        for (int j = 0; j < 4; ++j) {
          const float xw = -(w0a[j] + aw[ni][j]);
          const float sp = fmaxf(xw, 0.f) + __logf(1.f + __expf(-fabsf(xw)));
          const float wlog = -sp - 0.5f;
          const float e = __expf(wlog);
          omw[j] = 1.f - __expf(-e);
          const float a = sigmoidf_(a0a[j] + aa[ni][j]);
          kd[j] = kx[j] * (1.f + (a - 1.f) * kaa[j]);
          bb[j] = kkn[j] * a;
        }
        *(uint2*)(oOMW + o) = make_uint2(pack2(omw[0], omw[1]), pack2(omw[2], omw[3]));
        *(uint2*)(oKD + o) = make_uint2(pack2(kd[0], kd[1]), pack2(kd[2], kd[3]));
        *(uint2*)(oB + o) = make_uint2(pack2(bb[0], bb[1]), pack2(bb[2], bb[3]));
        __builtin_amdgcn_sched_barrier(0);
      }
    }
  }
}

DI size_t qk_index(int m, int h) {
  const bool lat = m < NTL;
  const int b = lat ? m >> 12 : (m - NTL) >> 8;
  const int pos = lat ? m & 4095 : 4096 + ((m - NTL) & 255);
  return ((size_t)(b * 8 + h) * LK + pos) * 96;
}
DI void phase_qkv(const Params& p, int l, char* smem) {
  LAUNDER_IDS
  WAVE_COORDS
  const char* wl = p.ws + OFF_W + (size_t)l * W_LAYER;
  const u16* za = (const u16*)(p.ws + OFF_R2);
  const float* rsq0 = (const float*)(p.ws + OFF_RSQ); const float* rskv0 = (const float*)(p.ws + OFF_RSKV);
  u16* Qb = (u16*)(p.ws + OFF_R1); u16* Kb = (u16*)(p.ws + OFF_R1 + SZ_Q); u16* Vt = (u16*)(p.ws + OFF_R1 + 2 * SZ_Q);
  const float* rt0 = (const float*)(p.ws + OFF_ROPE);
  const float* gq0 = p.in[I_GQ] + l * 96; const float* gk0 = p.in[I_GK] + l * 96;
  const float QS = 0.10206207261596577f * 1.4426950408889634f;
  constexpr int NTM = NT / 256;
  for (int it = 0;; ++it) {
    int tm, tn;
    if (!tile_map(it, NTM, 6, blk__, gridDim.x, tm, tn)) break;
    f32x4 acc[8][4]; zero_accm<8, 4>(acc);
    {
      const int m0 = tm * 256, n0 = tn * 128;
      gemm256<8, 4>(acc, za + 256, ZA, (const u16*)(wl + WO_UQ), 384, 384, m0, n0, smem);
      EPI_BEGIN
      const float* gq = gq0; const float* rt = rt0; const float* rsq = rsq0;
      asm volatile("" : "+v"(gq), "+v"(rt), "+v"(rsq));
      const int nw = n0 + wc * 64;
#pragma unroll
      for (int mi = 0; mi < 8; ++mi) {
        __builtin_amdgcn_sched_barrier(0);
        const int m = m0 + wr * 128 + mi * 16 + lr;
        const float rs = rsq[m];
        if (nw < 512) {
          const int h = nw >> 6;
          float ss = 0.f;
#pragma unroll
          for (int ni = 0; ni < 4; ++ni)
#pragma unroll
            for (int j = 0; j < 4; ++j) { const float v = acc[mi][ni][j] * rs; ss += v * v; }
          ss += __shfl_xor(ss, 16, 64); ss += __shfl_xor(ss, 32, 64);
          const float f = rs * rsqrtf(ss * (1.f / 64.f) + 1e-6f) * QS;
          u16* dst = Qb + qk_index(m, h);
#pragma unroll
          for (int ni = 0; ni < 4; ++ni) {
            const int d = ni * 16 + lq * 4;
            const float4 g = *(const float4*)(gq + d);
            *(uint2*)(dst + d) = make_uint2(pack2(acc[mi][ni][0] * f * g.x, acc[mi][ni][1] * f * g.y), pack2(acc[mi][ni][2] * f * g.z, acc[mi][ni][3] * f * g.w));
          }
        } else {
          const bool lat = m < NTL;
          const int tt = m & 4095;
#pragma unroll
          for (int hh = 0; hh < 2; ++hh) {
            __builtin_amdgcn_sched_barrier(0);
            const int h = ((nw - 512) >> 5) + hh;
            float ss = 0.f;
#pragma unroll
            for (int ni = 0; ni < 2; ++ni)
#pragma unroll
              for (int j = 0; j < 4; ++j) { const float v = acc[mi][hh * 2 + ni][j] * rs; ss += v * v; }
            ss += __shfl_xor(ss, 16, 64); ss += __shfl_xor(ss, 32, 64);
            const float f = rs * rsqrtf(ss * (1.f / 32.f) + 1e-6f) * QS;
            const int i0 = lq * 4;
            const float4 g1 = *(const float4*)(gq + 64 + i0), g2 = *(const float4*)(gq + 80 + i0);
            const float g1a[4] = {g1.x, g1.y, g1.z, g1.w}, g2a[4] = {g2.x, g2.y, g2.z, g2.w};
            float o1[4], o2[4];
#pragma unroll
            for (int j = 0; j < 4; ++j) {
              const float x1 = acc[mi][hh * 2][j] * f * g1a[j], x2 = acc[mi][hh * 2 + 1][j] * f * g2a[j];
              float cs = 1.f, sn = 0.f;
              if (lat) {
                const int i = i0 + j;
                const int pp = i < 8 ? (tt >> 6) : (tt & 63);
                cs = rt[(pp * 8 + (i & 7)) * 2]; sn = rt[(pp * 8 + (i & 7)) * 2 + 1];
              }
              o1[j] = x1 * cs - x2 * sn; o2[j] = x1 * sn + x2 * cs;
            }
            u16* dst = Qb + qk_index(m, h) + 64;
            *(uint2*)(dst + i0) = make_uint2(pack2(o1[0], o1[1]), pack2(o1[2], o1[3]));
            *(uint2*)(dst + 16 + i0) = make_uint2(pack2(o2[0], o2[1]), pack2(o2[2], o2[3]));
          }
        }
      }
      EPI_END
    }
  }
  __builtin_amdgcn_sched_barrier(0);
  for (int it = 0;; ++it) {
    int tm, tn;
    if (!tile_map(it, NTM, 8, blk__, gridDim.x, tm, tn)) break;
    f32x4 acc[8][4]; zero_accm<8, 4>(acc);
    {
      const int h = tn, m0 = tm * 256, n0 = h * 128;
      gemm256<8, 4>(acc, za + 640, ZA, (const u16*)(wl + WO_UKV), 256, 256, m0, n0, smem);
      EPI_BEGIN
      const float* gk = gk0; const float* rskv = rskv0;
      asm volatile("" : "+v"(gk), "+v"(rskv));
#pragma unroll
      for (int mi = 0; mi < 8; ++mi) {
        __builtin_amdgcn_sched_barrier(0);
        const int m = m0 + wr * 128 + mi * 16 + lr;
        const float rs = rskv[m];
        if (wc == 0) {
          float ss = 0.f;
#pragma unroll
          for (int ni = 0; ni < 4; ++ni)
#pragma unroll
            for (int j = 0; j < 4; ++j) { const float v = acc[mi][ni][j] * rs; ss += v * v; }
          ss += __shfl_xor(ss, 16, 64); ss += __shfl_xor(ss, 32, 64);
          const float f = rs * rsqrtf(ss * (1.f / 64.f) + 1e-6f);
          u16* dst = Kb + qk_index(m, h);
#pragma unroll
          for (int ni = 0; ni < 4; ++ni) {
            const int d = ni * 16 + lq * 4;
            const float4 g = *(const float4*)(gk + d);
            *(uint2*)(dst + d) = make_uint2(pack2(acc[mi][ni][0] * f * g.x, acc[mi][ni][1] * f * g.y), pack2(acc[mi][ni][2] * f * g.z, acc[mi][ni][3] * f * g.w));
          }
          *(uint4*)(dst + 64 + lq * 8) = *(const uint4*)((const u16*)(p.ws + OFF_KR) + (size_t)m * 32 + lq * 8);
        } else {
          const bool lat = m < NTL;
          const int b = lat ? m >> 12 : (m - NTL) >> 8;
          const int pos = lat ? m & 4095 : 4096 + ((m - NTL) & 255);
          u16* dst = Vt + (size_t)(b * 8 + h) * 64 * LK + pos + (size_t)(lq * 4) * LK;
#pragma unroll
          for (int ni = 0; ni < 4; ++ni) {
            asm volatile("" : "+v"(dst));
#pragma unroll
            for (int j = 0; j < 4; ++j) dst[j * LK] = f2bf(acc[mi][ni][j] * rs);
            dst += 16 * LK;
          }
        }
      }
      EPI_END
    }
  }
}

DI int scan_row(int b, int dir, int s) {
  if (s < LC) return NTL + b * LC + (dir ? LC - 1 - s : s);
  const int t = s - LC;
  return b * L + (dir ? L - 1 - t : t);
}
DI void phase_scan(const Params& p, char* smem) {
  LAUNDER_IDS
  const int blk = blk__;
  if (blk >= 256) return;
  const int tid = tid__, lane = tid & 63, wave = tid >> 6, kq = lane & 15, rg = lane >> 4;
  const int chain = (blk & 7) + 8 * (blk >> 5), quarter = (blk >> 3) & 3;
  const int b = chain >> 3, h = (chain >> 1) & 3, dir = chain & 1;
  const u16* sc = (const u16*)(p.ws + OFF_R3);
  const size_t AS = (size_t)NT * 256;
  const u16* aOMW = sc + (dir ? SA_OMWB : SA_OMWF) * AS;
  const u16* aKD = sc + (dir ? SA_KDB : SA_KDF) * AS;
  const u16* aB = sc + (dir ? SA_BB : SA_BF) * AS;
  const u16* aKKN = sc + SA_KKN * AS;
  const u16* aR = sc + SA_R * AS;
  const u16* aV = sc + SA_V * AS;
  u16* Y = (u16*)(p.ws + OFF_R2) + (dir ? AS : 0);
  constexpr int CH = 16, BSZ = 5 * CH * 64 + CH * 16;
  float* buf = (float*)smem;
  const int st_ld = tid >> 4, k4 = (tid & 15) * 4;
  const int vrow = quarter * 16 + wave * 4 + rg;
  uint2 g0, g1, g2, g3, g4; u16 gv;
#define SCAN_GLOAD(CHUNK) do { \
    const int row_ = scan_row(b, dir, (CHUNK) * CH + st_ld); \
    const size_t o_ = (size_t)row_ * 256 + h * 64 + k4; \
    g0 = *(const uint2*)(aOMW + o_); g1 = *(const uint2*)(aKD + o_); g2 = *(const uint2*)(aB + o_); g3 = *(const uint2*)(aKKN + o_); g4 = *(const uint2*)(aR + o_); \
    gv = aV[(size_t)row_ * 256 + h * 64 + quarter * 16 + (tid & 15)]; } while (0)
#define SCAN_LSTORE(BI) do { \
    float* bb_ = buf + (BI) * BSZ + st_ld * 64 + k4; \
    *(float4*)(bb_ + 0 * CH * 64) = make_float4(1.f - bflo(g0.x), 1.f - bfhi(g0.x), 1.f - bflo(g0.y), 1.f - bfhi(g0.y)); \
    *(float4*)(bb_ + 1 * CH * 64) = make_float4(bflo(g1.x), bfhi(g1.x), bflo(g1.y), bfhi(g1.y)); \
    *(float4*)(bb_ + 2 * CH * 64) = make_float4(bflo(g2.x), bfhi(g2.x), bflo(g2.y), bfhi(g2.y)); \
    *(float4*)(bb_ + 3 * CH * 64) = make_float4(bflo(g3.x), bfhi(g3.x), bflo(g3.y), bfhi(g3.y)); \
    *(float4*)(bb_ + 4 * CH * 64) = make_float4(bflo(g4.x), bfhi(g4.x), bflo(g4.y), bfhi(g4.y)); \
    buf[(BI) * BSZ + 5 * CH * 64 + st_ld * 16 + (tid & 15)] = bf2f(gv); } while (0)
  float2_t S01 = {0.f, 0.f}, S23 = {0.f, 0.f};
  __builtin_amdgcn_s_setprio(3);
  __syncthreads();
  SCAN_GLOAD(0); SCAN_LSTORE(0);
  __syncthreads();
  constexpr int NCH = LK / CH;
  for (int c = 0; c < NCH; ++c) {
    if (c + 1 < NCH) SCAN_GLOAD(c + 1);
    const float* bb = buf + (c & 1) * BSZ;
    const int rowbase = scan_row(b, dir, c * CH);
    const int rstep = dir ? -1 : 1;
    const float* bl = bb + kq * 4;
    const float* bv = bb + 5 * CH * 64 + wave * 4 + rg;
    float4 fwv[3], fkv[3], fbv[3], fav[3], frv[3]; float vvv[3];
#pragma unroll
    for (int q = 0; q < 2; ++q) {
      fwv[q] = *(const float4*)(bl + 0 * CH * 64 + q * 64); fkv[q] = *(const float4*)(bl + 1 * CH * 64 + q * 64); fbv[q] = *(const float4*)(bl + 2 * CH * 64 + q * 64);
      fav[q] = *(const float4*)(bl + 3 * CH * 64 + q * 64); frv[q] = *(const float4*)(bl + 4 * CH * 64 + q * 64); vvv[q] = bv[q * 16];
    }
    float ysel = 0.f, ypart = 0.f;
#pragma unroll
    for (int s = 0; s < CH; ++s) {
      const float4 fw = fwv[s % 3], fk = fkv[s % 3], fb = fbv[s % 3], fa = fav[s % 3], fr = frv[s % 3];
      const float vv = vvv[s % 3];
      const float2_t a01 = {fa.x, fa.y}, a23 = {fa.z, fa.w};
      const float2_t w01 = {fw.x, fw.y}, w23 = {fw.z, fw.w}, k01 = {fk.x, fk.y}, k23 = {fk.z, fk.w}, b01 = {fb.x, fb.y}, b23 = {fb.z, fb.w};
      const float2_t r01 = {fr.x, fr.y}, r23 = {fr.z, fr.w};
      const float2_t vv2 = {vv, vv};
      if (s + 2 < CH) {
        constexpr int dummy = 0; (void)dummy;
        const int q = (s + 2) % 3;
        fwv[q] = *(const float4*)(bl + 0 * CH * 64 + (s + 2) * 64); fkv[q] = *(const float4*)(bl + 1 * CH * 64 + (s + 2) * 64); fbv[q] = *(const float4*)(bl + 2 * CH * 64 + (s + 2) * 64);
        fav[q] = *(const float4*)(bl + 3 * CH * 64 + (s + 2) * 64); frv[q] = *(const float4*)(bl + 4 * CH * 64 + (s + 2) * 64); vvv[q] = bv[(s + 2) * 16];
      }
      float2_t t2 = S01 * a01; t2 = S23 * a23 + t2;
      const float2_t q01 = S01 * w01 + vv2 * k01, q23 = S23 * w23 + vv2 * k23;
      float xs = t2.x + t2.y, ys = ypart;
      xs += __builtin_bit_cast(float, __builtin_amdgcn_update_dpp(0, __builtin_bit_cast(int, xs), 0x128, 0xf, 0xf, false));
      ys += __builtin_bit_cast(float, __builtin_amdgcn_update_dpp(0, __builtin_bit_cast(int, ys), 0x128, 0xf, 0xf, false));
      xs += __builtin_bit_cast(float, __builtin_amdgcn_update_dpp(0, __builtin_bit_cast(int, xs), 0x124, 0xf, 0xf, false));
      ys += __builtin_bit_cast(float, __builtin_amdgcn_update_dpp(0, __builtin_bit_cast(int, ys), 0x124, 0xf, 0xf, false));
      xs += __builtin_bit_cast(float, __builtin_amdgcn_update_dpp(0, __builtin_bit_cast(int, xs), 0x122, 0xf, 0xf, false));
      ys += __builtin_bit_cast(float, __builtin_amdgcn_update_dpp(0, __builtin_bit_cast(int, ys), 0x122, 0xf, 0xf, false));
      xs += __builtin_bit_cast(float, __builtin_amdgcn_update_dpp(0, __builtin_bit_cast(int, xs), 0x121, 0xf, 0xf, false));
      ys += __builtin_bit_cast(float, __builtin_amdgcn_update_dpp(0, __builtin_bit_cast(int, ys), 0x121, 0xf, 0xf, false));
      if (s > 0) ysel = (kq == s - 1) ? ys : ysel;
      const float2_t sa2 = {xs, xs};
      S01 = sa2 * b01 + q01; S23 = sa2 * b23 + q23;
      float2_t y2 = S01 * r01; y2 = S23 * r23 + y2;
      ypart = y2.x + y2.y;
    }
    { const float yl = rowsum16(ypart); ysel = (kq == CH - 1) ? yl : ysel; }
    Y[(size_t)(rowbase + rstep * kq) * 256 + h * 64 + vrow] = f2bf(ysel);
    if (c + 1 < NCH) SCAN_LSTORE((c + 1) & 1);
    __syncthreads();
  }
  __builtin_amdgcn_s_setprio(0);
#undef SCAN_GLOAD
#undef SCAN_LSTORE
}

constexpr int KSL = 104, VSL = 68;
template <int B0>
DI bf16x8 pack8(const f32x16& v) {
  uint4 pw;
  pw.x = pack2(v[B0 + 0], v[B0 + 1]); pw.y = pack2(v[B0 + 2], v[B0 + 3]); pw.z = pack2(v[B0 + 4], v[B0 + 5]); pw.w = pack2(v[B0 + 6], v[B0 + 7]);
  return __builtin_bit_cast(bf16x8, pw);
}
DI void pv_step(f32x16& o0, f32x16& o1, const u16* Vc, int r32, int kb, bf16x8 pf) {
  {
    const uint2 lo = *(const uint2*)(Vc + r32 * VSL + kb), hi2 = *(const uint2*)(Vc + r32 * VSL + kb + 8);
    const bf16x8 va = __builtin_bit_cast(bf16x8, make_uint4(lo.x, lo.y, hi2.x, hi2.y));
    o0 = __builtin_amdgcn_mfma_f32_32x32x16_bf16(va, pf, o0, 0, 0, 0);
  }
  {
    const uint2 lo = *(const uint2*)(Vc + (32 + r32) * VSL + kb), hi2 = *(const uint2*)(Vc + (32 + r32) * VSL + kb + 8);
    const bf16x8 va = __builtin_bit_cast(bf16x8, make_uint4(lo.x, lo.y, hi2.x, hi2.y));
    o1 = __builtin_amdgcn_mfma_f32_32x32x16_bf16(va, pf, o1, 0, 0, 0);
  }
}
DI void attn_item(const Params& p, int item, char* smem) {
  LAUNDER_IDS
  const int tid = tid__, lane = tid & 63, wave = tid >> 6, r32 = lane & 31, hi = lane >> 5;
  int bh, qpos0, key0, nkt, orow0;
  if (item < 2048) { bh = item >> 5; const int qb = item & 31; qpos0 = qb * 128; key0 = 0; nkt = LK / 64; orow0 = (bh >> 3) * L + qpos0; }
  else { const int it = item - 2048; bh = it >> 1; const int qb = it & 1; qpos0 = 4096 + qb * 128; key0 = 4096; nkt = LC / 64; orow0 = NTL + (bh >> 3) * LC + qb * 128; }
  const int h = bh & 7;
  const u16* Qp = (const u16*)(p.ws + OFF_R1) + ((size_t)bh * LK + qpos0 + wave * 32 + r32) * 96 + hi * 8;
  const u16* Kp = (const u16*)(p.ws + OFF_R1 + SZ_Q) + ((size_t)bh * LK + key0) * 96;
  const u16* Vp = (const u16*)(p.ws + OFF_R1 + 2 * SZ_Q) + (size_t)bh * 64 * LK + key0;
  u16* Ks = (u16*)smem;
  u16* Vs = Ks + 2 * 64 * KSL;
  bf16x8 qr[6];
#pragma unroll
  for (int d0 = 0; d0 < 6; ++d0) qr[d0] = *(const bf16x8*)(Qp + d0 * 16);
  uint4 ak0, ak1, ak2, av0, av1, bk0, bk1, bk2, bv0, bv1;
  const int kr0 = tid / 12, kc0 = tid - kr0 * 12, kr1 = (tid + 256) / 12, kc1 = (tid + 256) - kr1 * 12, kr2 = (tid + 512) / 12, kc2 = (tid + 512) - kr2 * 12;
  const int vd0 = tid >> 3, vc0 = tid & 7, vd1 = vd0 + 32;
#define gload(S, kt) do { \
    S##k0 = *(const uint4*)(Kp + (size_t)((kt) * 64 + kr0) * 96 + kc0 * 8); S##k1 = *(const uint4*)(Kp + (size_t)((kt) * 64 + kr1) * 96 + kc1 * 8); \
    S##k2 = *(const uint4*)(Kp + (size_t)((kt) * 64 + kr2) * 96 + kc2 * 8); \
    S##v0 = *(const uint4*)(Vp + (size_t)vd0 * LK + (kt) * 64 + vc0 * 8); S##v1 = *(const uint4*)(Vp + (size_t)vd1 * LK + (kt) * 64 + vc0 * 8); } while (0)
#define lstore(S, bi) do { \
    *(uint4*)(Ks + (bi) * 64 * KSL + kr0 * KSL + kc0 * 8) = S##k0; *(uint4*)(Ks + (bi) * 64 * KSL + kr1 * KSL + kc1 * 8) = S##k1; *(uint4*)(Ks + (bi) * 64 * KSL + kr2 * KSL + kc2 * 8) = S##k2; \
    { u16* dst = Vs + (bi) * 64 * VSL + vd0 * VSL + vc0 * 8; *(uint2*)dst = make_uint2(S##v0.x, S##v0.y); *(uint2*)(dst + 4) = make_uint2(S##v0.z, S##v0.w); } \
    { u16* dst = Vs + (bi) * 64 * VSL + vd1 * VSL + vc0 * 8; *(uint2*)dst = make_uint2(S##v1.x, S##v1.y); *(uint2*)(dst + 4) = make_uint2(S##v1.z, S##v1.w); } } while (0)
  f32x16 o0, o1;
#pragma unroll
  for (int i = 0; i < 16; ++i) { o0[i] = 0.f; o1[i] = 0.f; }
  float mrun = -1e30f, lrun = 0.f;
  auto tile_compute = [&](int cur) {
    const u16* Kc = Ks + cur * 64 * KSL;
    const u16* Vc = Vs + cur * 64 * VSL;
    f32x16 p0, p1;
#pragma unroll
    for (int i = 0; i < 16; ++i) { p0[i] = 0.f; p1[i] = 0.f; }
#pragma unroll
    for (int d0 = 0; d0 < 6; ++d0) {
      const bf16x8 a0 = *(const bf16x8*)(Kc + r32 * KSL + d0 * 16 + hi * 8);
      const bf16x8 a1 = *(const bf16x8*)(Kc + (32 + r32) * KSL + d0 * 16 + hi * 8);
      p0 = __builtin_amdgcn_mfma_f32_32x32x16_bf16(a0, qr[d0], p0, 0, 0, 0);
      p1 = __builtin_amdgcn_mfma_f32_32x32x16_bf16(a1, qr[d0], p1, 0, 0, 0);
    }
    float mx = p0[0];
#pragma unroll
    for (int i = 1; i < 16; ++i) mx = fmaxf(mx, p0[i]);
#pragma unroll
    for (int i = 0; i < 16; ++i) mx = fmaxf(mx, p1[i]);
    { auto rr = __builtin_amdgcn_permlane32_swap(__float_as_uint(mx), __float_as_uint(mx), false, false);
      mx = fmaxf(__uint_as_float(rr[0]), __uint_as_float(rr[1])); }
    if (!__all(mx - mrun <= 8.f)) {
      const float mn = fmaxf(mrun, mx);
      const float alpha = __builtin_amdgcn_exp2f(mrun - mn);
      mrun = mn; lrun *= alpha;
#pragma unroll
      for (int i = 0; i < 16; ++i) { o0[i] *= alpha; o1[i] *= alpha; }
    }
    float ps = 0.f;
#pragma unroll
    for (int i = 0; i < 16; ++i) { p0[i] = __builtin_amdgcn_exp2f(p0[i] - mrun); ps += p0[i]; }
#pragma unroll
    for (int i = 0; i < 16; ++i) { p1[i] = __builtin_amdgcn_exp2f(p1[i] - mrun); ps += p1[i]; }
    lrun += ps;
    pv_step(o0, o1, Vc, r32, 0 + hi * 4, pack8<0>(p0));
    pv_step(o0, o1, Vc, r32, 16 + hi * 4, pack8<8>(p0));
    pv_step(o0, o1, Vc, r32, 32 + hi * 4, pack8<0>(p1));
    pv_step(o0, o1, Vc, r32, 48 + hi * 4, pack8<8>(p1));
  };
  __syncthreads();
  gload(a, 0); lstore(a, 0);
  gload(a, 1);
  __syncthreads();
  for (int kt = 0; kt < nkt; kt += 2) {
    if (kt + 2 < nkt) gload(b, kt + 2);
    tile_compute(0);
    lstore(a, 1);
    __syncthreads();
    if (kt + 3 < nkt) gload(a, kt + 3);
    tile_compute(1);
    if (kt + 2 < nkt) lstore(b, 0);
    __syncthreads();
  }
  lrun += __shfl_xor(lrun, 32, 64);
  const float inv = 1.f / lrun;
  u16* om = (u16*)(p.ws + OFF_OMLA) + (size_t)(orow0 + wave * 32 + r32) * 512 + h * 64;
#pragma unroll
  for (int g = 0; g < 4; ++g) {
    const int d = 8 * g + 4 * hi;
    *(uint2*)(om + d) = make_uint2(pack2(o0[4 * g] * inv, o0[4 * g + 1] * inv), pack2(o0[4 * g + 2] * inv, o0[4 * g + 3] * inv));
    *(uint2*)(om + 32 + d) = make_uint2(pack2(o1[4 * g] * inv, o1[4 * g + 1] * inv), pack2(o1[4 * g + 2] * inv, o1[4 * g + 3] * inv));
  }
#undef gload
#undef lstore
}

DI void readout_row(const Params& p, int l, int r) {
  LAUNDER_IDS
  const int lane = tid__ & 63;
  const u16* sc = (const u16*)(p.ws + OFF_R3);
  const size_t AS = (size_t)NT * 256;
  const size_t o = (size_t)r * 256 + lane * 4;
  const u16* Yf = (const u16*)(p.ws + OFF_R2);
  const uint2 yf = *(const uint2*)(Yf + o), yb = *(const uint2*)(Yf + AS + o);
  const uint2 ur = *(const uint2*)(sc + SA_R * AS + o), uv = *(const uint2*)(sc + SA_V * AS + o);
  const uint2 kf = *(const uint2*)(sc + SA_KDF * AS + o), kb = *(const uint2*)(sc + SA_KDB * AS + o), ug = *(const uint2*)(sc + SA_G * AS + o);
  float y[4] = {bflo(yf.x) + bflo(yb.x), bfhi(yf.x) + bfhi(yb.x), bflo(yf.y) + bflo(yb.y), bfhi(yf.y) + bfhi(yb.y)};
  const float rr[4] = {bflo(ur.x), bfhi(ur.x), bflo(ur.y), bfhi(ur.y)};
  const float vv[4] = {bflo(uv.x), bfhi(uv.x), bflo(uv.y), bfhi(uv.y)};
  const float km[4] = {0.5f * (bflo(kf.x) + bflo(kb.x)), 0.5f * (bfhi(kf.x) + bfhi(kb.x)), 0.5f * (bflo(kf.y) + bflo(kb.y)), 0.5f * (bfhi(kf.y) + bfhi(kb.y))};
  const float gg[4] = {bflo(ug.x), bfhi(ug.x), bflo(ug.y), bfhi(ug.y)};
  const float4 rk4 = *(const float4*)(p.in[I_RK] + l * 256 + lane * 4);
  const float4 lw4 = *(const float4*)(p.in[I_LNW] + l * 256 + lane * 4);
  const float4 lb4 = *(const float4*)(p.in[I_LNB] + l * 256 + lane * 4);
  const float rk[4] = {rk4.x, rk4.y, rk4.z, rk4.w}, lw[4] = {lw4.x, lw4.y, lw4.z, lw4.w}, lb[4] = {lb4.x, lb4.y, lb4.z, lb4.w};
  float s = y[0] + y[1] + y[2] + y[3];
  s = rowsum16(s);
  const float mu = s * (1.f / 64.f);
  float q = 0.f, bn = 0.f;
#pragma unroll
  for (int j = 0; j < 4; ++j) { const float d = y[j] - mu; q += d * d; bn += rr[j] * km[j] * rk[j]; }
  q = rowsum16(q); bn = rowsum16(bn);
  const float rstd = rsqrtf(q * (1.f / 64.f) + 64e-5f);
  float ov[4];
#pragma unroll
  for (int j = 0; j < 4; ++j) ov[j] = ((y[j] - mu) * rstd * lw[j] + lb[j] + bn * vv[j]) * gg[j];
  u16* orw = (u16*)(p.ws + OFF_R3 + SA_KKN * SZ_TOK256 + (size_t)NT * 512 * 2);
  *(uint2*)(orw + o) = make_uint2(pack2(ov[0], ov[1]), pack2(ov[2], ov[3]));
}

DI void phase_attn(const Params& p, int l, char* smem) {
  LAUNDER_IDS
  __shared__ int qslot_sh;
  const int nattn = (l == 0) ? 2048 + 128 : 2048;
  unsigned* ctr = (unsigned*)(p.ws + OFF_BAR) + 16 + l * 16;
  for (;;) {
    __syncthreads();
    if (tid__ == 0) qslot_sh = (int)__hip_atomic_fetch_add(ctr, 1u, __ATOMIC_RELAXED, __HIP_MEMORY_SCOPE_AGENT);
    __syncthreads();
    const int it = qslot_sh;
    if (it >= nattn) break;
    attn_item(p, it, smem);
  }
}
DI void phase_readout(const Params& p, int l, int Mout) {
  LAUNDER_IDS
  const int wave = tid__ >> 6;
  for (int r = blk__ * 4 + wave; r < Mout; r += gridDim.x * 4) readout_row(p, l, r);
}

DI void phase_merge(const Params& p, int l, int Mout, char* smem) {
  LAUNDER_IDS
  WAVE_COORDS
  const char* wl = p.ws + OFF_W + (size_t)l * W_LAYER;
  const u16* hg = (const u16*)(p.ws + OFF_HBG);
  const u16* opool = (const u16*)(p.ws + OFF_R4);
  const u16* omla = (const u16*)(p.ws + OFF_OMLA);
  const u16* orw = (const u16*)(p.ws + OFF_R3 + SA_KKN * SZ_TOK256) + (size_t)NT * 512;
  u16* mo = (u16*)(p.ws + OFF_R1);
  const int ntm = Mout / 128;
  for (int it = 0;; ++it) {
    int tm, tn;
    if (!tile_map(it, ntm, 8, blk__, gridDim.x, tm, tn)) break;
    const int m0 = tm * 128, n0 = tn * 128;
    f32x4 msum[4][4]; zero_accm<4, 4>(msum);
#pragma unroll 1
    for (int br = 0; br < 3; ++br) {
      unsigned gpk[4][4][2];
      {
        f32x4 ag[4][4]; zero_accm<4, 4>(ag);
        gemm256<4, 4>(ag, hg, 1024, (const u16*)(wl + WO_WIN) + (size_t)(2080 + br * 1024) * 1024, 1024, 1024, m0, n0, smem);
#pragma unroll
        for (int mi = 0; mi < 4; ++mi)
#pragma unroll
          for (int ni = 0; ni < 4; ++ni) {
            gpk[mi][ni][0] = pack2(sigmoidf_(ag[mi][ni][0]), sigmoidf_(ag[mi][ni][1]));
            gpk[mi][ni][1] = pack2(sigmoidf_(ag[mi][ni][2]), sigmoidf_(ag[mi][ni][3]));
          }
      }
      __builtin_amdgcn_sched_barrier(0);
      f32x4 ab[4][4]; zero_accm<4, 4>(ab);
      {
        const int Kb = br == 1 ? 512 : 256;
        const u16* Ab = br == 0 ? opool : br == 1 ? omla : orw;
        const u16* Wb = (const u16*)(wl + (br == 0 ? WO_BRP : br == 1 ? WO_BRM : WO_BRR));
        gemm256<4, 4>(ab, Ab, Kb, Wb, Kb, Kb, m0, n0, smem);
      }
#pragma unroll
      for (int mi = 0; mi < 4; ++mi)
#pragma unroll
        for (int ni = 0; ni < 4; ++ni) {
          msum[mi][ni][0] += bflo(gpk[mi][ni][0]) * ab[mi][ni][0];
          msum[mi][ni][1] += bfhi(gpk[mi][ni][0]) * ab[mi][ni][1];
          msum[mi][ni][2] += bflo(gpk[mi][ni][1]) * ab[mi][ni][2];
          msum[mi][ni][3] += bfhi(gpk[mi][ni][1]) * ab[mi][ni][3];
        }
      __builtin_amdgcn_sched_barrier(0);
    }
    EPI_BEGIN
#pragma unroll
    for (int mi = 0; mi < 4; ++mi) {
      const int m = m0 + wr * 64 + mi * 16 + lr;
#pragma unroll
      for (int ni = 0; ni < 4; ++ni) {
        const int n = n0 + wc * 64 + ni * 16 + lq * 4;
        *(uint2*)(mo + (size_t)m * 1024 + n) = make_uint2(pack2(msum[mi][ni][0], msum[mi][ni][1]), pack2(msum[mi][ni][2], msum[mi][ni][3]));
      }
    }
    EPI_END
  }
}

template <int MI, int NI>
DI void resid_tile(const u16* A, int K, const u16* Bt, const float* gate, const float* xl_in, const float* xc_in, float* xl_out, float* xc_out,
                   int m0, int n0, char* smem) {
  LAUNDER_IDS
  WAVE_COORDS
  f32x4 acc[MI][NI]; zero_accm<MI, NI>(acc);
  gemm256<MI, NI>(acc, A, K, Bt, K, K, m0, n0, smem);
  EPI_BEGIN
#pragma unroll
  for (int mi = 0; mi < MI; ++mi) {
    const int m = m0 + wr * 16 * MI + mi * 16 + lr;
    const int b9 = m < NTL ? m >> 12 : 8;
    const float* xi = xrow(xl_in, xc_in, m);
    float* xo = m < NTL ? xl_out + (size_t)m * D : xc_out + (size_t)(m - NTL) * D;
#pragma unroll
    for (int ni = 0; ni < NI; ++ni) {
      const int n = n0 + wc * 16 * NI + ni * 16 + lq * 4;
      const float4 g = *(const float4*)(gate + (size_t)b9 * 6144 + n);
      const float4 xv = *(const float4*)(xi + n);
      float4 ov;
      ov.x = xv.x + g.x * acc[mi][ni][0]; ov.y = xv.y + g.y * acc[mi][ni][1]; ov.z = xv.z + g.z * acc[mi][ni][2]; ov.w = xv.w + g.w * acc[mi][ni][3];
      *(float4*)(xo + n) = ov;
    }
    __builtin_amdgcn_sched_barrier(0);
  }
  EPI_END
}
DI void phase_resid(const Params& p, const u16* A, int K, const u16* Bt, const float* gate  ,
                    const float* xl_in, const float* xc_in, float* xl_out, float* xc_out, int Mout, char* smem) {
  LAUNDER_IDS
  for (int it = 0;; ++it) {
    int tm, tn;
    if (!tile_map(it, NTL / 256, 8, blk__, gridDim.x, tm, tn)) break;
    resid_tile<8, 4>(A, K, Bt, gate, xl_in, xc_in, xl_out, xc_out, tm * 256, tn * 128, smem);
  }
  if (Mout > NTL) {
    for (int t = blk__; t < (NTC / 64) * 16; t += gridDim.x) {
      const int tm = t >> 4, tn = t & 15;
      resid_tile<2, 2>(A, K, Bt, gate, xl_in, xc_in, xl_out, xc_out, NTL + tm * 64, tn * 64, smem);
    }
  }
}
DI void phase_mlp1(const Params& p, int l, int Mout, char* smem) {
  LAUNDER_IDS
  WAVE_COORDS
  const char* wl = p.ws + OFF_W + (size_t)l * W_LAYER;
  const u16* hb = (const u16*)(p.ws + OFF_HB2);
  u16* U = (u16*)(p.ws + OFF_R1);
  const int ntm = Mout / 256;
  for (int it = 0;; ++it) {
    int tm, tn;
    if (!tile_map(it, ntm, 32, blk__, gridDim.x, tm, tn)) break;
    const int m0 = tm * 256, n0 = tn * 128;
    f32x4 acc[8][4]; zero_accm<8, 4>(acc);
    gemm256<8, 4>(acc, hb, 1024, (const u16*)(wl + WO_W1), 1024, 1024, m0, n0, smem);
    EPI_BEGIN
#pragma unroll
    for (int mi = 0; mi < 8; ++mi) {
      const int m = m0 + wr * 128 + mi * 16 + lr;
#pragma unroll
      for (int ni = 0; ni < 4; ++ni) {
        const int n = n0 + wc * 64 + ni * 16 + lq * 4;
        float v[4];
#pragma unroll
        for (int j = 0; j < 4; ++j) { const float a = fmaxf(acc[mi][ni][j], 0.f); v[j] = a * a; }
        *(uint2*)(U + (size_t)m * DFF + n) = make_uint2(pack2(v[0], v[1]), pack2(v[2], v[3]));
      }
      __builtin_amdgcn_sched_barrier(0);
    }
    EPI_END
  }
}

__global__ void __launch_bounds__(256, 2) fwd_megakernel(Params pk) {
  __shared__ __attribute__((aligned(16))) char smem[73728];
  cg::grid_group grid = cg::this_grid();
  if (threadIdx.x == 0) { g_base_sh[0] = (unsigned long long)pk.ws; g_base_sh[1] = (unsigned long long)pk.out; }
  xcd_barrier_post((unsigned*)(pk.ws + OFF_BAR));
  __syncthreads();
  phase_prep(pk, smem);
  if (pk.ws == nullptr) grid.sync();
  xcd_barrier();
  phase_tables(pk);
  xcd_barrier();
#define CTXBUF ((float*)(p.ws + OFF_CTX))
#define XLP (l == 0 ? p.in[I_X] : (const float*)p.out)
#define XCP (l == 0 ? p.in[I_CTX] : (const float*)CTXBUF)
#define MOUT (l == 0 ? NT : NTL)
#define WLP (p.ws + OFF_W + (size_t)l * W_LAYER)
#define TABP(nrm) ((const float*)(p.ws + OFF_TAB) + (size_t)(l * 2 + (nrm)) * 9 * 2048)
#define MODP(j) ((const float*)(p.ws + OFF_MODS) + (size_t)l * 9 * 6144 + (j) * 1024)
#ifndef PROBE_Q
#define PROBE_Q -1
#endif
#pragma nounroll
  for (int ph = 0; ph < 22; ++ph) {
    const int l = ph >= 11 ? 1 : 0, q = ph - l * 11;
    Params p = pk;
    {
      asm volatile("" ::: "memory");
      unsigned long long w_ = g_base_sh[0], o_ = g_base_sh[1];
      unsigned wl_ = (unsigned)w_, wh_ = (unsigned)(w_ >> 32), ol_ = (unsigned)o_, oh_ = (unsigned)(o_ >> 32);
      wl_ = __builtin_amdgcn_readfirstlane(wl_); wh_ = __builtin_amdgcn_readfirstlane(wh_); ol_ = __builtin_amdgcn_readfirstlane(ol_); oh_ = __builtin_amdgcn_readfirstlane(oh_);
      asm volatile("" : "+s"(wl_), "+s"(wh_), "+s"(ol_), "+s"(oh_));
      p.ws = (char*)(((unsigned long long)wh_ << 32) | wl_); p.out = (float*)(((unsigned long long)oh_ << 32) | ol_);
    }
#pragma nounroll
    for (int rep = 0; rep < (q == PROBE_Q ? 2 : 1); ++rep)
    switch (q) {
      case 0: phase_norm(XLP, XCP, TABP(0), (u16*)(p.ws + OFF_HB1), NT); break;
      case 1: phase_zgemm(p, l, smem); break;
      case 2: phase_tokA(p, l); phase_tokB(p, l, smem); break;
      case 3: phase_qkv(p, l, smem); break;
      case 4: phase_scan(p, smem); phase_attn(p, l, smem); break;
      case 5: phase_norm(XLP, XCP, TABP(0), (u16*)(p.ws + OFF_HBG), MOUT); phase_readout(p, l, MOUT); break;
      case 6: phase_merge(p, l, MOUT, smem); break;
      case 7: phase_resid(p, (const u16*)(p.ws + OFF_R1), 1024, (const u16*)(WLP + WO_WO), MODP(2), XLP, XCP, p.out, CTXBUF, MOUT, smem); break;
      case 8: phase_norm(p.out, CTXBUF, TABP(1), (u16*)(p.ws + OFF_HB2), MOUT); break;
      case 9: phase_mlp1(p, l, MOUT, smem); break;
      default: phase_resid(p, (const u16*)(p.ws + OFF_R1), 4096, (const u16*)(WLP + WO_W2), MODP(5), p.out, CTXBUF, p.out, CTXBUF, MOUT, smem); break;
    }
    if (ph != 21) xcd_barrier();
  }
}

extern "C" void kernel_launch(void* const* d_in, const int* in_sizes, int n_in, void* d_out, int out_size, void* d_ws, size_t ws_size, hipStream_t stream) {
  static int grid_blocks = 0;
  if (!grid_blocks) {
    int dev = 0, cus = 0, per_cu = 0;
    hipGetDevice(&dev);
    hipDeviceGetAttribute(&cus, hipDeviceAttributeMultiprocessorCount, dev);
    hipOccupancyMaxActiveBlocksPerMultiprocessor(&per_cu, fwd_megakernel, 256, 0);
    if (per_cu > 2) per_cu = 2;
    if (per_cu < 1) per_cu = 1;
    grid_blocks = cus * per_cu;
    if (ws_size < WS_END) fprintf(stderr, "kernel_launch: workspace too small: %zu < %zu\n", ws_size, (size_t)WS_END);
  }
  Params p{};
  for (int i = 0; i < 34; ++i) p.in[i] = (const float*)d_in[i];
  p.out = (float*)d_out;
  p.ws = (char*)d_ws;
  hipMemsetAsync(d_ws, 0, 16384, stream);
  void* args[] = {&p};
  hipError_t e = hipLaunchCooperativeKernel((void*)fwd_megakernel, dim3(grid_blocks), dim3(256), args, 0, stream);
  if (e != hipSuccess) fprintf(stderr, "cooperative launch failed: %s (grid %d)\n", hipGetErrorString(e), grid_blocks);
}
```

```cpp
#include <hip/hip_runtime.h>
#include <hip/hip_cooperative_groups.h>
#include <stdint.h>
#include <cstdio>
namespace cg = cooperative_groups;

typedef unsigned short u16;
typedef __attribute__((ext_vector_type(8))) short bf16x8;
typedef __attribute__((ext_vector_type(4))) float f32x4;
typedef __attribute__((ext_vector_type(16))) float f32x16;
typedef __bf16 bf16x2_t __attribute__((ext_vector_type(2)));
typedef float float2_t __attribute__((ext_vector_type(2)));

#define DI __device__ __forceinline__

constexpr int D = 1024, NB = 8, L = 4096, LC = 256, LK = 4352;
constexpr int NTL = NB * L;
constexpr int NTC = NB * LC;
constexpr int NT = NTL + NTC;
constexpr int INC = 5152;
constexpr int ZA = 928;
constexpr int ZR = 1152;
constexpr int DFF = 4096;

constexpr size_t al256(size_t x) { return (x + 255) / 256 * 256; }
constexpr size_t OFF_BAR = 0;
constexpr size_t OFF_MODS = 16384;
constexpr size_t OFF_TAB = OFF_MODS + al256(2 * 9 * 6144 * 4);
constexpr size_t OFF_ROPE = OFF_TAB + al256(2 * 2 * 9 * 2 * 1024 * 4);
constexpr size_t OFF_RS1 = OFF_ROPE + 4096;
constexpr size_t OFF_RS2 = OFF_RS1 + al256(NT * 4);
constexpr size_t OFF_RSQ = OFF_RS2 + al256(NT * 4);
constexpr size_t OFF_RSKV = OFF_RSQ + al256(NT * 4);
constexpr size_t OFF_CTX = OFF_RSKV + al256(NT * 4);
constexpr size_t OFF_W = OFF_CTX + (size_t)NTC * D * 4;
constexpr size_t WO_WIN = 0;
constexpr size_t WO_UQ = WO_WIN + (size_t)INC * 1024 * 2;
constexpr size_t WO_UKV = WO_UQ + (size_t)768 * 384 * 2;
constexpr size_t WO_BRP = WO_UKV + (size_t)1024 * 256 * 2;
constexpr size_t WO_BRM = WO_BRP + (size_t)1024 * 256 * 2;
constexpr size_t WO_BRR = WO_BRM + (size_t)1024 * 512 * 2;
constexpr size_t WO_WO = WO_BRR + (size_t)1024 * 256 * 2;
constexpr size_t WO_W1 = WO_WO + (size_t)1024 * 1024 * 2;
constexpr size_t WO_W2 = WO_W1 + (size_t)4096 * 1024 * 2;
constexpr size_t WO_RW2 = WO_W2 + (size_t)1024 * 4096 * 2;
constexpr size_t WO_RA2 = WO_RW2 + (size_t)2 * 256 * 64 * 2;
constexpr size_t WO_RG2 = WO_RA2 + (size_t)2 * 256 * 64 * 2;
constexpr size_t W_LAYER = al256(WO_RG2 + (size_t)256 * 128 * 2);
constexpr size_t OFF_R1 = OFF_W + 2 * W_LAYER;
constexpr size_t SZ_Q = (size_t)NB * 8 * LK * 96 * 2;
constexpr size_t SZ_VT = (size_t)NB * 8 * 64 * LK * 2;
constexpr size_t SZ_R1 = 2 * SZ_Q + SZ_VT;
constexpr size_t OFF_R2 = OFF_R1 + al256(SZ_R1);
constexpr size_t SZ_TOK256 = (size_t)NT * 256 * 2;
constexpr size_t OFF_R3 = OFF_R2 + al256((size_t)NT * ZA * 2);
constexpr size_t OFF_R4 = OFF_R3 + 10 * SZ_TOK256;
constexpr size_t OFF_KR = OFF_R4 + SZ_TOK256;
constexpr size_t OFF_OMLA = OFF_KR + al256((size_t)NT * 32 * 2);
constexpr size_t WS_END = OFF_OMLA + (size_t)NT * 512 * 2;
static_assert(WS_END <= 536870912ull, "workspace map exceeds 4x the largest tensor");
constexpr size_t OFF_HB1 = OFF_R3;
constexpr size_t OFF_HBG = OFF_R1 + (size_t)NT * 1024 * 2;
constexpr size_t OFF_HB2 = OFF_R3 + 5 * SZ_TOK256;
enum { SA_R = 0, SA_V = 1, SA_KDF = 2, SA_KDB = 3, SA_G = 4, SA_KKN = 5, SA_OMWF = 6, SA_BF = 7, SA_OMWB = 8, SA_BB = 9 };

struct Params { const float* in[34]; float* out; char* ws; };

enum { I_X = 0, I_C, I_CTX, I_CCTX, I_N1G, I_N2G, I_WADA, I_BADA, I_WIN, I_POOLW, I_POOLS, I_QNORM, I_WUQ, I_KVNORM, I_WUKV,
       I_GQ, I_GK, I_MU, I_W0, I_W2R, I_A0, I_A2R, I_KA, I_KK, I_RK, I_G2R, I_LNW, I_LNB, I_BRP, I_BRM, I_BRR, I_WO, I_W1, I_W2 };

DI float bf2f(u16 h) { return __uint_as_float(((unsigned)h) << 16); }
DI float bflo(unsigned u) { return __uint_as_float(u << 16); }
DI float bfhi(unsigned u) { return __uint_as_float(u & 0xffff0000u); }
DI unsigned pack2(float a, float b) { float2_t v = {a, b}; bf16x2_t r = __builtin_convertvector(v, bf16x2_t); return __builtin_bit_cast(unsigned, r); }
DI u16 f2bf(float a) { return (u16)(pack2(a, 0.f) & 0xffffu); }
DI float sigmoidf_(float x) { return 1.f / (1.f + __expf(-x)); }
DI float siluf_(float x) { return x / (1.f + __expf(-x)); }
DI float rowsum16(float x) {
  x += __builtin_bit_cast(float, __builtin_amdgcn_update_dpp(0, __builtin_bit_cast(int, x), 0x128, 0xf, 0xf, false));
  x += __builtin_bit_cast(float, __builtin_amdgcn_update_dpp(0, __builtin_bit_cast(int, x), 0x124, 0xf, 0xf, false));
  x += __builtin_bit_cast(float, __builtin_amdgcn_update_dpp(0, __builtin_bit_cast(int, x), 0x122, 0xf, 0xf, false));
  x += __builtin_bit_cast(float, __builtin_amdgcn_update_dpp(0, __builtin_bit_cast(int, x), 0x121, 0xf, 0xf, false));
  return x;
}
DI float wavesum(float x) {
  x = rowsum16(x);
  const int xi = __builtin_bit_cast(int, x);
  return __builtin_bit_cast(float, __builtin_amdgcn_readlane(xi, 0)) + __builtin_bit_cast(float, __builtin_amdgcn_readlane(xi, 16)) +
         __builtin_bit_cast(float, __builtin_amdgcn_readlane(xi, 32)) + __builtin_bit_cast(float, __builtin_amdgcn_readlane(xi, 48));
}
DI void grid_barrier(unsigned* ctr, unsigned& epoch) {
  asm volatile("s_waitcnt vmcnt(0)" ::: "memory");
  __syncthreads();
  epoch++;
  if (threadIdx.x == 0) {
    __builtin_amdgcn_fence(__ATOMIC_RELEASE, "agent");
    asm volatile("s_waitcnt vmcnt(0)" ::: "memory");
    const unsigned target = epoch * gridDim.x;
    __hip_atomic_fetch_add(ctr, 1u, __ATOMIC_RELAXED, __HIP_MEMORY_SCOPE_AGENT);
    while (__hip_atomic_load(ctr, __ATOMIC_RELAXED, __HIP_MEMORY_SCOPE_AGENT) < target) __builtin_amdgcn_s_sleep(2);
    __builtin_amdgcn_fence(__ATOMIC_ACQUIRE, "agent");
    asm volatile("s_waitcnt vmcnt(0)" ::: "memory");
  }
  __syncthreads();
}


#define XB_TMO      128
#define XB_XCNT(j)  (256  + 64 * (j))
#define XB_XSUB(j)  (1280 + 64 * (j))
#define XB_XGEN(j)  (2304 + 64 * (j))
#define XB_TOP      3328
#define XB_TOPGEN   3392
#define XB_SPIN_CAP (1u << 22)
#define LAS __attribute__((address_space(3)))
DI unsigned xb_ld(unsigned* p)              { return __hip_atomic_load(p, __ATOMIC_RELAXED, __HIP_MEMORY_SCOPE_AGENT); }
DI unsigned xb_add(unsigned* p, unsigned v) { return __hip_atomic_fetch_add(p, v, __ATOMIC_RELAXED, __HIP_MEMORY_SCOPE_AGENT); }
DI unsigned xb_xcc_id() { return (unsigned)__builtin_amdgcn_s_getreg((3 << 11) | 20) & 0xFu; }
#define XB_SPIN(cond, bar) do { unsigned _sp = 0; while (cond) { __builtin_amdgcn_s_sleep(1); \
    if ((++_sp & 255u) == 0u) { if (xb_ld(&(bar)[XB_TMO])) break; if (_sp > XB_SPIN_CAP) { atomicAdd(&(bar)[XB_TMO], 1u); break; } } } } while (0)
__shared__ uint4 g_xb_words;
__shared__ unsigned long long g_base_sh[2];
DI void xcd_barrier_post(unsigned* bar) {
  const unsigned x = xb_xcc_id();
  if (threadIdx.x == 0) { g_xb_words = make_uint4(0u, 0u, x, 0u); (void)xb_add(&bar[XB_XCNT(x)], 1u); }
}
DI void xcd_barrier_complete(unsigned* bar, unsigned x, unsigned& nloc, unsigned& nx) {
  const unsigned G = gridDim.x;
  unsigned sum, cnt, mine, sp = 0u;
  for (;;) {
    sum = 0u; cnt = 0u; mine = 0u;
#pragma unroll
    for (unsigned j = 0; j < 16; ++j) { const unsigned c = xb_ld(&bar[XB_XCNT(j)]); sum += c; cnt += (c > 0u) ? 1u : 0u; mine = (j == x) ? c : mine; }
    if (sum == G) break;
    __builtin_amdgcn_s_sleep(1);
    if ((++sp & 255u) == 0u) { if (xb_ld(&bar[XB_TMO])) break; if (sp > XB_SPIN_CAP) { atomicAdd(&bar[XB_TMO], 1u); break; } }
  }
  nloc = mine > 0u ? mine : 1u; nx = cnt > 0u ? cnt : 1u;
}
DI void xcd_barrier() {
  asm volatile("s_waitcnt vmcnt(0)" ::: "memory");
  __syncthreads();
  if (threadIdx.x == 0) {
    unsigned* bar = (unsigned*)(g_base_sh[0] + OFF_BAR);
    __builtin_amdgcn_s_waitcnt(0);
    unsigned nloc = g_xb_words.x, nx = g_xb_words.y; const unsigned x = g_xb_words.z;
    if (nloc == 0u) { xcd_barrier_complete(bar, x, nloc, nx); g_xb_words.x = nloc; g_xb_words.y = nx; }
    const unsigned old = xb_add(&bar[XB_XSUB(x)], 1u);
    const unsigned gen = old / nloc;
    if (old + 1u == (gen + 1u) * nloc) {
      __builtin_amdgcn_fence(__ATOMIC_RELEASE, "agent");
      asm volatile("s_waitcnt vmcnt(0)" ::: "memory");
      const unsigned og = xb_add(&bar[XB_TOP], 1u);
      const unsigned tg = og / nx;
      if (og + 1u == (tg + 1u) * nx) xb_add(&bar[XB_TOPGEN], 1u);
      else XB_SPIN(xb_ld(&bar[XB_TOPGEN]) == tg, bar);
      __builtin_amdgcn_fence(__ATOMIC_ACQUIRE, "agent");
      xb_add(&bar[XB_XGEN(x)], 1u);
      asm volatile("s_waitcnt vmcnt(0)" ::: "memory");
    } else {
      XB_SPIN(xb_ld(&bar[XB_XGEN(x)]) == gen, bar);
      __builtin_amdgcn_fence(__ATOMIC_ACQUIRE, "agent");
      asm volatile("s_waitcnt vmcnt(0)" ::: "memory");
    }
  }
  __syncthreads();
}
DI int launder_v(int x) { asm volatile("" : "+v"(x)); return x; }
DI int launder_s(int x) { asm volatile("" : "+s"(x)); return x; }
#define LAUNDER_IDS const int tid__ = launder_v((int)threadIdx.x); const int blk__ = launder_s((int)blockIdx.x); (void)tid__; (void)blk__;
DI void do_transpose(const float* __restrict__ src, int K, int N, u16* __restrict__ dst, const float* __restrict__ ksc, int perm, int tile, float* tl) {
  LAUNDER_IDS
  const int ntn = (N + 63) >> 6;
  const int kt = tile / ntn, nt = tile - kt * ntn;
  const int k0 = kt * 64, n0 = nt * 64;
  const int tid = tid__;
  __syncthreads();
#pragma unroll 4
  for (int i = 0; i < 16; ++i) {
    const int kk = i * 4 + (tid >> 6), nn = tid & 63;
    float v = 0.f;
    if (n0 + nn < N) v = src[(size_t)(k0 + kk) * N + n0 + nn];
    if (ksc) v *= ksc[k0 + kk];
    tl[kk * 65 + nn] = v;
  }
  __syncthreads();
#pragma unroll 4
  for (int i = 0; i < 16; ++i) {
    const int nn = i * 4 + (tid >> 6), kk = tid & 63;
    int n = n0 + nn;
    if (n < N) {
      if (perm) { const int h = n / 96, d = n - h * 96; n = d < 64 ? h * 64 + d : 512 + h * 32 + (d - 64); }
      dst[(size_t)n * K + k0 + kk] = f2bf(tl[kk * 65 + nn]);
    }
  }
}

DI void phase_prep(const Params& p, char* smem) {
  LAUNDER_IDS
  float* tl = (float*)smem;
  const int tid = tid__;
  constexpr int T_WIN = 16 * 81, T_UQ = 6 * 12, T_UKV = 4 * 16, T_BRM = 8 * 16, T_BRR = 4 * 16, T_WO = 16 * 16, T_W1 = 16 * 64, T_W2 = 64 * 16,
                T_RW2 = 4, T_RA2 = 4, T_RG2 = 2 * 4;
  constexpr int T_LAYER = T_WIN + T_UQ + T_UKV + T_BRM + T_BRR + T_WO + T_W1 + T_W2 + 2 * T_RW2 + 2 * T_RA2 + T_RG2;
  for (int g = blk__; g < 2 * T_LAYER; g += gridDim.x) {
    const int l = g / T_LAYER; int t = g - l * T_LAYER;
    char* wl = p.ws + OFF_W + (size_t)l * W_LAYER;
#define JOB(SRC, KK, NN, DSTOFF, SC, PERM, CNT) if (t < (CNT)) { do_transpose((SRC), (KK), (NN), (u16*)(wl + (DSTOFF)), (SC), (PERM), t, tl); continue; } t -= (CNT);
    JOB(p.in[I_WIN] + (size_t)l * 1024 * INC, 1024, INC, WO_WIN, nullptr, 0, T_WIN)
    JOB(p.in[I_WUQ] + (size_t)l * 384 * 768, 384, 768, WO_UQ, p.in[I_QNORM] + l * 384, 1, T_UQ)
    JOB(p.in[I_WUKV] + (size_t)l * 256 * 1024, 256, 1024, WO_UKV, p.in[I_KVNORM] + l * 256, 0, T_UKV)
    JOB(p.in[I_BRM] + (size_t)l * 512 * 1024, 512, 1024, WO_BRM, nullptr, 0, T_BRM)
    JOB(p.in[I_BRR] + (size_t)l * 256 * 1024, 256, 1024, WO_BRR, nullptr, 0, T_BRR)
    JOB(p.in[I_WO] + (size_t)l * 1024 * 1024, 1024, 1024, WO_WO, nullptr, 0, T_WO)
    JOB(p.in[I_W1] + (size_t)l * 1024 * 4096, 1024, 4096, WO_W1, nullptr, 0, T_W1)
    JOB(p.in[I_W2] + (size_t)l * 4096 * 1024, 4096, 1024, WO_W2, nullptr, 0, T_W2)
    JOB(p.in[I_W2R] + (size_t)(l * 2 + 0) * 64 * 256, 64, 256, WO_RW2, nullptr, 0, T_RW2)
    JOB(p.in[I_W2R] + (size_t)(l * 2 + 1) * 64 * 256, 64, 256, WO_RW2 + 256 * 64 * 2, nullptr, 0, T_RW2)
    JOB(p.in[I_A2R] + (size_t)(l * 2 + 0) * 64 * 256, 64, 256, WO_RA2, nullptr, 0, T_RA2)
    JOB(p.in[I_A2R] + (size_t)(l * 2 + 1) * 64 * 256, 64, 256, WO_RA2 + 256 * 64 * 2, nullptr, 0, T_RA2)
    JOB(p.in[I_G2R] + (size_t)l * 128 * 256, 128, 256, WO_RG2, nullptr, 0, T_RG2)
#undef JOB
  }
  for (int e = blk__ * 256 + tid; e < 2 * 256 * 1024; e += gridDim.x * 256) {
    const int l = e >> 18, r = e & 262143, cin = r >> 10, n = r & 1023, g = cin >> 6, c = cin & 63;
    const float* pw = p.in[I_POOLW] + ((size_t)(l * 4 + g) * 64 + c) * 64;
    const float* ps = p.in[I_POOLS] + l * 256 + g * 64;
    const float* wb = p.in[I_BRP] + ((size_t)l * 256 + g * 64) * 1024 + n;
    float s = 0.f;
    for (int d = 0; d < 64; ++d) s += pw[d] * ps[d] * wb[(size_t)d * 1024];
    ((u16*)(p.ws + OFF_W + (size_t)l * W_LAYER + WO_BRP))[(size_t)n * 256 + cin] = f2bf(s);
  }
  if (blk__ == gridDim.x - 1) {
    for (int e = tid; e < 512; e += 256) {
      const int pos = e >> 3, f = e & 7;
      const float inv = powf(10000.f, -(float)f / 8.f);
      const float ang = (float)pos * inv;
      float* rt = (float*)(p.ws + OFF_ROPE);
      rt[e * 2] = cosf(ang); rt[e * 2 + 1] = sinf(ang);
    }
  }
  {
    float* sl = (float*)smem;
    float* red = sl + 9 * 1024;
    __syncthreads();
    for (int e = tid; e < 9 * 1024; e += 256) {
      const int b = e >> 10, k = e & 1023;
      const float v = b < 8 ? p.in[I_C][b * 1024 + k] : p.in[I_CCTX][k];
      sl[e] = siluf_(v);
    }
    __syncthreads();
    const int wave = tid >> 6, lane = tid & 63;
    for (int it = blk__; it < 192; it += gridDim.x) {
      const int l = it / 96, cg_ = it - l * 96;
      const int col = cg_ * 64 + lane;
      const float* wa = p.in[I_WADA] + (size_t)l * 1024 * 6144 + col;
      float acc[9];
#pragma unroll
      for (int b = 0; b < 9; ++b) acc[b] = 0.f;
#pragma unroll 8
      for (int k = wave * 256; k < wave * 256 + 256; ++k) {
        const float w = wa[(size_t)k * 6144];
#pragma unroll
        for (int b = 0; b < 9; ++b) acc[b] += sl[b * 1024 + k] * w;
      }
#pragma unroll
      for (int b = 0; b < 9; ++b) red[(wave * 9 + b) * 64 + lane] = acc[b];
      __syncthreads();
      for (int e = tid; e < 9 * 64; e += 256) {
        const int b = e >> 6, c = e & 63;
        const float s = red[(0 * 9 + b) * 64 + c] + red[(1 * 9 + b) * 64 + c] + red[(2 * 9 + b) * 64 + c] + red[(3 * 9 + b) * 64 + c];
        ((float*)(p.ws + OFF_MODS))[(size_t)(l * 9 + b) * 6144 + cg_ * 64 + c] = s + p.in[I_BADA][l * 6144 + cg_ * 64 + c];
      }
      __syncthreads();
    }
  }
}

DI const float* xrow(const float* xl, const float* xc, int r) { return r < NTL ? xl + (size_t)r * D : xc + (size_t)(r - NTL) * D; }

DI void phase_norm(const float* xl, const float* xc, const float* tab  , u16* hb, int M) {
  LAUNDER_IDS
  const int wave = tid__ >> 6, lane = tid__ & 63;
  const int nw = gridDim.x * 4, rpw = (M + nw - 1) / nw;
  const int rbeg = (blk__ * 4 + wave) * rpw, rend = min(rbeg + rpw, M);
  int cur_b9 = -1;
  float4 g[4], sh[4];
#pragma unroll
  for (int i = 0; i < 4; ++i) { g[i] = make_float4(0.f, 0.f, 0.f, 0.f); sh[i] = g[i]; }
  float4 vn[4];
  if (rbeg < rend) {
    const float* xp0 = xrow(xl, xc, rbeg);
#pragma unroll
    for (int i = 0; i < 4; ++i) vn[i] = *(const float4*)(xp0 + i * 256 + lane * 4);
  }
  for (int r = rbeg; r < rend; ++r) {
    const int b9 = r < NTL ? r >> 12 : 8;
    float4 v[4];
#pragma unroll
    for (int i = 0; i < 4; ++i) v[i] = vn[i];
    {
      const float* xpn = xrow(xl, xc, min(r + 1, rend - 1));
#pragma unroll
      for (int i = 0; i < 4; ++i) vn[i] = *(const float4*)(xpn + i * 256 + lane * 4);
    }
    if (b9 != cur_b9) {
      cur_b9 = b9;
      const float* t = tab + b9 * 2048;
#pragma unroll
      for (int i = 0; i < 4; ++i) { g[i] = *(const float4*)(t + i * 256 + lane * 4); sh[i] = *(const float4*)(t + 1024 + i * 256 + lane * 4); }
    }
    float s = 0.f;
#pragma unroll
    for (int i = 0; i < 4; ++i) s += v[i].x * v[i].x + v[i].y * v[i].y + v[i].z * v[i].z + v[i].w * v[i].w;
    s = wavesum(s);
    const float rs = rsqrtf(s * (1.f / 1024.f) + 1e-6f);
#pragma unroll
    for (int i = 0; i < 4; ++i) {
      const int k = i * 256 + lane * 4;
      *(uint2*)(hb + (size_t)r * 1024 + k) = make_uint2(pack2(v[i].x * rs * g[i].x + sh[i].x, v[i].y * rs * g[i].y + sh[i].y), pack2(v[i].z * rs * g[i].z + sh[i].z, v[i].w * rs * g[i].w + sh[i].w));
    }
  }
}
DI void phase_tables(const Params& p) {
  LAUNDER_IDS
  const float* mods = (const float*)(p.ws + OFF_MODS);
  float* tab = (float*)(p.ws + OFF_TAB);
  for (int e = blk__ * 256 + tid__; e < 2 * 2 * 9 * 1024; e += gridDim.x * 256) {
    const int k = e & 1023, b9 = (e >> 10) % 9, ln = (e >> 10) / 9, l = ln >> 1, nrm = ln & 1;
    const float g = p.in[nrm ? I_N2G : I_N1G][l * 1024 + k];
    const float sh = mods[(size_t)(l * 9 + b9) * 6144 + (nrm * 3 + 0) * 1024 + k];
    const float sc = mods[(size_t)(l * 9 + b9) * 6144 + (nrm * 3 + 1) * 1024 + k];
    float* t = tab + ((size_t)(l * 2 + nrm) * 9 + b9) * 2048;
    t[k] = g * (1.f + sc); t[1024 + k] = sh;
  }
}

struct LoadBf16 {
  const u16* A; int lda;
  DI void init(int m0) {}
  DI uint4 load(int i, int m0, int k0) const {
    LAUNDER_IDS
    const int tid = tid__, kc = (tid & 7) * 8;
    return *(const uint4*)(A + (size_t)(m0 + (tid >> 3) + i * 32) * lda + k0 + kc);
  }
};
struct LoadNorm {
  const float* xl; const float* xc; const float* rs; const float* tab;
  float r0, r1, r2, r3;
  DI void init(int m0) {
    LAUNDER_IDS
    const int tid = tid__;
    r0 = rs[m0 + (tid >> 3)]; r1 = rs[m0 + (tid >> 3) + 32]; r2 = rs[m0 + (tid >> 3) + 64]; r3 = rs[m0 + (tid >> 3) + 96];
  }
  DI uint4 load(int i, int m0, int k0) const {
    LAUNDER_IDS
    const int tid = tid__, kc = (tid & 7) * 8;
    const int b9 = m0 < NTL ? m0 >> 12 : 8;
    const float* t = tab + b9 * 2048 + k0 + kc;
    const float4 g0 = *(const float4*)t, g1 = *(const float4*)(t + 4), s0 = *(const float4*)(t + 1024), s1 = *(const float4*)(t + 1028);
    const float* xp = xrow(xl, xc, m0 + (tid >> 3)) + k0 + kc + (size_t)i * 32 * D;
    const float4 x0 = *(const float4*)xp, x1 = *(const float4*)(xp + 4);
    const float rr = i == 0 ? r0 : i == 1 ? r1 : i == 2 ? r2 : r3;
    uint4 o;
    o.x = pack2(x0.x * rr * g0.x + s0.x, x0.y * rr * g0.y + s0.y);
    o.y = pack2(x0.z * rr * g0.z + s0.z, x0.w * rr * g0.w + s0.w);
    o.z = pack2(x1.x * rr * g1.x + s1.x, x1.y * rr * g1.y + s1.y);
    o.w = pack2(x1.z * rr * g1.z + s1.z, x1.w * rr * g1.w + s1.w);
    return o;
  }
};

DI bool tile_map(int it, int NTM, int NTN, int blk, int nblk, int& tm, int& tn) {
  const int xcd = blk & 7, local = blk >> 3, LB = nblk >> 3;
  const int R = NTM >> 3;
  const int s = it * LB + local;
  if (s >= R * NTN) return false;
  const int F = R >> 3, per_full = 8 * NTN;
  int mg, r, gm;
  if (s < F * per_full) { mg = s / per_full; r = s - mg * per_full; gm = 8; }
  else { mg = F; r = s - F * per_full; gm = R - F * 8; }
  const int ng = r / (gm * 8);
  const int r2 = r - ng * gm * 8;
  const int mi = r2 % gm, ni = r2 / gm;
  tm = xcd * R + mg * 8 + mi; tn = ng * 8 + ni;
  return true;
}
constexpr int LDT = 72;
template <int NI, class LA>
DI void gemm_mainloop(f32x4 (&acc)[4][NI], LA la, const u16* __restrict__ Bt, int ldb, int K, int m0, int n0, char* smem) {
  LAUNDER_IDS
  constexpr int NBI = NI;
  u16* As = (u16*)smem; u16* Bs = As + 2 * 128 * LDT;
  const int tid = tid__, lane = tid & 63, wave = tid >> 6, wr = wave >> 1, wc = wave & 1, lr = lane & 15, lq = lane >> 4;
  uint4 ra[4], rb[NBI];
  la.init(m0);
#pragma unroll
  for (int i = 0; i < 4; ++i) ra[i] = la.load(i, m0, 0);
#pragma unroll
  for (int i = 0; i < NBI; ++i) {
    const int c = tid + i * 256, row = c >> 3, kc = (c & 7) * 8;
    rb[i] = *(const uint4*)(Bt + (size_t)(n0 + row) * ldb + kc);
  }
#pragma unroll
  for (int i = 0; i < 4; ++i) {
    const int c = tid + i * 256, row = c >> 3, kc = (c & 7) * 8;
    *(uint4*)(As + row * LDT + kc) = ra[i];
    if (i < NBI) *(uint4*)(Bs + row * LDT + kc) = rb[i];
  }
  __syncthreads();
  const int nk = K >> 6;
  for (int kt = 0; kt < nk; ++kt) {
    const int cur = kt & 1;
    if (kt + 1 < nk) {
      const int k0 = (kt + 1) * 64;
#pragma unroll
      for (int i = 0; i < 4; ++i) ra[i] = la.load(i, m0, k0);
#pragma unroll
      for (int i = 0; i < NBI; ++i) {
        const int c = tid + i * 256, row = c >> 3, kc = (c & 7) * 8;
        rb[i] = *(const uint4*)(Bt + (size_t)(n0 + row) * ldb + k0 + kc);
      }
    }
    const u16* Ac = As + cur * 128 * LDT + (wr * 64 + lr) * LDT + lq * 8;
    const u16* Bc = Bs + cur * 128 * LDT + (wc * 16 * NI + lr) * LDT + lq * 8;
#pragma unroll
    for (int ks = 0; ks < 2; ++ks) {
      bf16x8 af[4], bfr[NI];
#pragma unroll
      for (int mi = 0; mi < 4; ++mi) af[mi] = *(const bf16x8*)(Ac + mi * 16 * LDT + ks * 32);
#pragma unroll
      for (int ni = 0; ni < NI; ++ni) bfr[ni] = *(const bf16x8*)(Bc + ni * 16 * LDT + ks * 32);
#pragma unroll
      for (int mi = 0; mi < 4; ++mi)
#pragma unroll
        for (int ni = 0; ni < NI; ++ni)
          acc[mi][ni] = __builtin_amdgcn_mfma_f32_16x16x32_bf16(bfr[ni], af[mi], acc[mi][ni], 0, 0, 0);
    }
    if (kt + 1 < nk) {
      const int nxt = cur ^ 1;
#pragma unroll
      for (int i = 0; i < 4; ++i) {
        const int c = tid + i * 256, row = c >> 3, kc = (c & 7) * 8;
        *(uint4*)(As + nxt * 128 * LDT + row * LDT + kc) = ra[i];
        if (i < NBI) *(uint4*)(Bs + nxt * 128 * LDT + row * LDT + kc) = rb[i];
      }
    }
    __syncthreads();
  }
}
template <int NI>
DI void zero_acc(f32x4 (&acc)[4][NI]) {
#pragma unroll
  for (int i = 0; i < 4; ++i)
#pragma unroll
    for (int j = 0; j < NI; ++j) acc[i][j] = f32x4{0.f, 0.f, 0.f, 0.f};
}
template <int MI, int NI>
DI void gemm256(f32x4 (&acc)[MI][NI], const u16* __restrict__ A, int lda, const u16* __restrict__ Bt, int ldb, int K, int m0, int n0, char* smem) {
  LAUNDER_IDS
  const int lane = tid__ & 63, wave = tid__ >> 6, wr = wave >> 1, wc = wave & 1, lr = lane & 15, lq = lane >> 4;
  constexpr int NAW = MI / 2;
  constexpr int NBW = NI / 2;
  constexpr int ABYTES = MI * 2 * 1024;
  constexpr int STAGE = ABYTES + NI * 2 * 1024;
  constexpr int LPS = NAW + NBW;
  static_assert(3 * STAGE <= 73728, "ring does not fit");
  const int srow = lane >> 2, scol = ((lane & 3) ^ ((lane >> 5) << 1)) * 8;
  const u16* Ag = A + (size_t)(m0 + wave * NAW * 16 + srow) * lda + scol;
  const u16* Bg = Bt + (size_t)(n0 + wave * NBW * 16 + srow) * ldb + scol;
  char* la = smem + (wave * NAW) * 1024 + lane * 16;
  char* lb = smem + ABYTES + (wave * NBW) * 1024 + lane * 16;
#define G256_ISSUE(S, K0) do { \
    _Pragma("unroll") for (int j_ = 0; j_ < NAW; ++j_) \
      __builtin_amdgcn_global_load_lds((const unsigned*)(Ag + (size_t)j_ * 16 * lda + (K0)), (__attribute__((address_space(3))) unsigned*)(la + (S) * STAGE + j_ * 1024), 16, 0, 0); \
    _Pragma("unroll") for (int j_ = 0; j_ < NBW; ++j_) \
      __builtin_amdgcn_global_load_lds((const unsigned*)(Bg + (size_t)j_ * 16 * ldb + (K0)), (__attribute__((address_space(3))) unsigned*)(lb + (S) * STAGE + j_ * 1024), 16, 0, 0); \
  } while (0)
  const int nk = K >> 5;
  G256_ISSUE(0, 0);
  if (nk > 1) G256_ISSUE(1, 32);
  const int foff = lr * 64 + ((lq ^ ((lr >> 3) << 1)) * 16);
  int st = 0;
  for (int kt = 0; kt < nk; ++kt) {
    if (kt + 1 < nk) asm volatile("s_waitcnt vmcnt(%0) lgkmcnt(0)" :: "n"(LPS) : "memory");
    else asm volatile("s_waitcnt vmcnt(0) lgkmcnt(0)" ::: "memory");
    __builtin_amdgcn_s_barrier();
    if (kt + 2 < nk) { const int s2 = st >= 1 ? st - 1 : 2; G256_ISSUE(s2, (kt + 2) * 32); }
    const char* sb = smem + st * STAGE + foff;
    bf16x8 af[MI], bfr[NI];
#pragma unroll
    for (int mi = 0; mi < MI; ++mi) af[mi] = *(const bf16x8*)(sb + (wr * MI + mi) * 1024);
#pragma unroll
    for (int ni = 0; ni < NI; ++ni) bfr[ni] = *(const bf16x8*)(sb + ABYTES + (wc * NI + ni) * 1024);
#pragma unroll
    for (int mi = 0; mi < MI; ++mi)
#pragma unroll
      for (int ni = 0; ni < NI; ++ni)
        acc[mi][ni] = __builtin_amdgcn_mfma_f32_16x16x32_bf16(bfr[ni], af[mi], acc[mi][ni], 0, 0, 0);
    st = st == 2 ? 0 : st + 1;
  }
  asm volatile("s_waitcnt lgkmcnt(0)" ::: "memory");
  __builtin_amdgcn_s_barrier();
#undef G256_ISSUE
}
template <int MI, int NI>
DI void zero_accm(f32x4 (&acc)[MI][NI]) {
#pragma unroll
  for (int i = 0; i < MI; ++i)
#pragma unroll
    for (int j = 0; j < NI; ++j) acc[i][j] = f32x4{0.f, 0.f, 0.f, 0.f};
}
#define EPI_BEGIN const int lr1_ = launder_v(lr), lq1_ = launder_v(lq), wr1_ = launder_v(wr), wc1_ = launder_v(wc); { const int lr = lr1_, lq = lq1_, wr = wr1_, wc = wc1_; (void)lr; (void)lq; (void)wr; (void)wc;
#define EPI_END }
DI uint4 widen16(uint2 a, uint2 b) {
  const auto r0 = __builtin_amdgcn_permlane16_swap(a.x, b.x, false, false);
  const auto r1 = __builtin_amdgcn_permlane16_swap(a.y, b.y, false, false);
  return make_uint4(r0[0], r1[0], r0[1], r1[1]);
}
#define WAVE_COORDS const int lane = tid__ & 63, wave = tid__ >> 6, wr = wave >> 1, wc = wave & 1, lr = lane & 15, lq = lane >> 4; (void)wr; (void)wc; (void)lr; (void)lq;

DI void phase_zgemm(const Params& p, int l, char* smem) {
  LAUNDER_IDS
  WAVE_COORDS
  const u16* Wt = (const u16*)(p.ws + OFF_W + (size_t)l * W_LAYER + WO_WIN);
  const u16* hb = (const u16*)(p.ws + OFF_HB1);
  u16* za = (u16*)(p.ws + OFF_R2); u16* zr = (u16*)(p.ws + OFF_R1);
  for (int it = 0;; ++it) {
    int tm, tn;
    if (!tile_map(it, NT / 256, 17, blk__, gridDim.x, tm, tn)) break;
    const int m0 = tm * 256, n0 = tn * 128;
    f32x4 acc[8][4]; zero_accm<8, 4>(acc);
    gemm256<8, 4>(acc, hb, 1024, Wt, 1024, 1024, m0, n0, smem);
    EPI_BEGIN
#pragma unroll
    for (int mi = 0; mi < 8; mi += 2) {
      const int m = m0 + wr * 128 + (mi + (lq & 1)) * 16 + lr;
#pragma unroll
      for (int ni = 0; ni < 4; ++ni) {
        const int n = n0 + wc * 64 + ni * 16 + (lq >> 1) * 8;
        const uint4 v = widen16(make_uint2(pack2(acc[mi][ni][0], acc[mi][ni][1]), pack2(acc[mi][ni][2], acc[mi][ni][3])),
                                make_uint2(pack2(acc[mi + 1][ni][0], acc[mi + 1][ni][1]), pack2(acc[mi + 1][ni][2], acc[mi + 1][ni][3])));
        if (n < ZA) *(uint4*)(za + (size_t)m * ZA + n) = v;
        else if (n < ZA + ZR) *(uint4*)(zr + (size_t)m * ZR + (n - ZA)) = v;
      }
    }
    EPI_END
  }
}

DI void phase_tokA(const Params& p, int l) {
  LAUNDER_IDS
  const int wave = tid__ >> 6, lane = tid__ & 63;
  const u16* za = (const u16*)(p.ws + OFF_R2);
  float* rsq = (float*)(p.ws + OFF_RSQ); float* rskv = (float*)(p.ws + OFF_RSKV);
  u16* krb = (u16*)(p.ws + OFF_KR);
  u16* pooled = (u16*)(p.ws + OFF_R4);
  const float* rt = (const float*)(p.ws + OFF_ROPE);
  const float* gk = p.in[I_GK] + l * 96;
  for (int r = blk__ * 4 + wave; r < NT; r += gridDim.x * 4) {
    const u16* z = za + (size_t)r * ZA;
    const bool lat = r < NTL;
    const int b = lat ? r >> 12 : (r - NTL) >> 8;
    const int t = lat ? r & 4095 : (r - NTL) & 255;
    const int Ls = lat ? L : LC;
    const int pos = lat ? t : 4096 + t;
    u16 zq[6], zk[4], pw[30], pc[4];
#pragma unroll
    for (int i = 0; i < 6; ++i) zq[i] = z[256 + i * 64 + lane];
#pragma unroll
    for (int i = 0; i < 4; ++i) zk[i] = z[640 + i * 64 + lane];
    const int d = lane & 31;
    const u16 kr_raw = z[896 + d];
    const float gkd = gk[64 + d];
    const int ri = d & 15;
    const int pp = ri < 8 ? (t >> 6) : (t & 63);
    const float cs = rt[(pp * 8 + (ri & 7)) * 2], sn = rt[(pp * 8 + (ri & 7)) * 2 + 1];
#pragma unroll
    for (int gi = 0; gi < 4; ++gi) {
      const int half = 1 << gi;
      pc[gi] = z[gi * 64 + lane];
#pragma unroll
      for (int j = 0; j < 2 * half; ++j) {
        const int qc = min(max(t - half + j, 0), Ls - 1);
        pw[2 * half - 2 + j] = z[(ptrdiff_t)(qc - t) * ZA + gi * 64 + lane];
      }
    }
    float sq = 0.f, skv = 0.f;
#pragma unroll
    for (int i = 0; i < 6; ++i) { const float v = bf2f(zq[i]); sq += v * v; }
#pragma unroll
    for (int i = 0; i < 4; ++i) { const float v = bf2f(zk[i]); skv += v * v; }
    sq = wavesum(sq); skv = wavesum(skv);
    const float rq = rsqrtf(sq * (1.f / 384.f) + 1e-6f), rkv = rsqrtf(skv * (1.f / 256.f) + 1e-6f);
    float kr = bf2f(kr_raw);
    float ss = rowsum16(kr * kr);
    { const int si = __builtin_bit_cast(int, ss);
      ss = __builtin_bit_cast(float, __builtin_amdgcn_readlane(si, 0)) + __builtin_bit_cast(float, __builtin_amdgcn_readlane(si, 16)); }
    kr = kr * rsqrtf(ss * (1.f / 32.f) + 1e-6f) * gkd;
    const float other = __shfl_xor(kr, 16, 64);
    const float rot = d < 16 ? kr * cs - other * sn : other * sn + kr * cs;
    const float outv = lat ? rot : kr;
    float pv[4];
#pragma unroll
    for (int gi = 0; gi < 4; ++gi) {
      const int half = 1 << gi;
      const int lo = max(t - half, 0), hi = min(t + half, Ls);
      float sm = 0.f;
#pragma unroll
      for (int j = 0; j < 2 * half; ++j) {
        const int q = t - half + j;
        sm += (q >= 0 && q < Ls) ? bf2f(pw[2 * half - 2 + j]) : 0.f;
      }
      pv[gi] = sm / (float)(hi - lo) - bf2f(pc[gi]);
    }
    if (lane == 0) { rsq[r] = rq; rskv[r] = rkv; }
    if (lane < 32) krb[(size_t)r * 32 + d] = f2bf(outv);
#pragma unroll
    for (int gi = 0; gi < 4; ++gi) pooled[(size_t)r * 256 + gi * 64 + lane] = f2bf(pv[gi]);
  }
}

constexpr int ZSL = 1160, TAL = 392;
DI void phase_tokB(const Params& p, int l, char* smem) {
  LAUNDER_IDS
  WAVE_COORDS
  const int tid = tid__;
  u16* Zs = (u16*)smem;
  u16* TA = Zs + 18 * ZSL;
  float* PV = (float*)(TA + 16 * TAL);
  const u16* zr = (const u16*)(p.ws + OFF_R1);
  const char* wl = p.ws + OFF_W + (size_t)l * W_LAYER;
  u16* sc = (u16*)(p.ws + OFF_R3);
  __syncthreads();
  for (int e = tid; e < 2 * ZR + 7 * 256; e += 256) {
    float v;
    if (e < 2 * ZR) v = p.in[I_MU][(size_t)l * 2 * ZR + e];
    else { const int f = e - 2 * ZR, a = f >> 8, c = f & 255;
      v = a == 0 ? p.in[I_KK][l * 256 + c] : a < 3 ? p.in[I_W0][(size_t)(l * 2 + a - 1) * 256 + c] : a < 5 ? p.in[I_A0][(size_t)(l * 2 + a - 3) * 256 + c] : p.in[I_KA][(size_t)(l * 2 + a - 5) * 256 + c]; }
    PV[e] = v;
  }
  const float* mu0 = PV; const float* mu1 = PV + ZR; const float* kkw = PV + 2 * ZR;
  const float* w0p = kkw + 256; const float* a0p = w0p + 512; const float* kap = a0p + 512;
  for (int tile = blk__; tile < NT / 16; tile += gridDim.x) {
    const int r0 = tile * 16;
    const bool lat = r0 < NTL;
    const int t0 = lat ? r0 & 4095 : (r0 - NTL) & 255;
    const int Ls = lat ? L : LC;
    __syncthreads();
    {
      uint4 v[11];
#pragma unroll
      for (int i = 0; i < 11; ++i) {
        const int c = tid + i * 256;
        const int ri = c / 144, ch = c - ri * 144;
        const int tt = t0 - 1 + ri;
        const int cc = min(c, 18 * 144 - 1);
        const int rc = cc / 144, chc = cc - rc * 144;
        const int ttc = min(max(t0 - 1 + rc, 0), Ls - 1);
        const uint4 ld = *(const uint4*)(zr + (size_t)(r0 - t0 + ttc) * ZR + chc * 8);
        const bool ok = (c < 18 * 144) && (tt >= 0) && (tt < Ls);
        v[i] = ok ? ld : make_uint4(0, 0, 0, 0);
      }
#pragma unroll
      for (int i = 0; i < 11; ++i) {
        const int c = tid + i * 256;
        const int ri = c / 144, ch = c - ri * 144;
        if (c < 18 * 144) {
          *(uint2*)(Zs + ri * ZSL + ch * 8) = make_uint2(v[i].x, v[i].y);
          *(uint2*)(Zs + ri * ZSL + ch * 8 + 4) = make_uint2(v[i].z, v[i].w);
        }
      }
    }
    __syncthreads();
#pragma unroll 4
    for (int e = tid; e < 16 * 384; e += 256) {
      const int i = e / 384, c = e - i * 384, zc = 768 + c;
      const float z = bf2f(Zs[(i + 1) * ZSL + zc]), zp = bf2f(Zs[i * ZSL + zc]), zn = bf2f(Zs[(i + 2) * ZSL + zc]);
      float v = z + mu0[zc] * (zp - z) + mu1[zc] * (zn - z);
      if (c < 128) v = 1.f - 2.f / (1.f + __expf(2.f * v)); else if (c >= 256) v = sigmoidf_(v);
      TA[i * TAL + c] = f2bf(v);
    }
    __syncthreads();
    const int row = r0 + lr;
    auto shifted4 = [&](int zc, float (&out)[4]) {
      const uint2 c0 = *(const uint2*)(Zs + (lr + 1) * ZSL + zc), cp = *(const uint2*)(Zs + lr * ZSL + zc), cn = *(const uint2*)(Zs + (lr + 2) * ZSL + zc);
      const float4 m0 = *(const float4*)(mu0 + zc), m1 = *(const float4*)(mu1 + zc);
      float z, zp, zn;
      z = bflo(c0.x); zp = bflo(cp.x); zn = bflo(cn.x); out[0] = z + m0.x * (zp - z) + m1.x * (zn - z);
      z = bfhi(c0.x); zp = bfhi(cp.x); zn = bfhi(cn.x); out[1] = z + m0.y * (zp - z) + m1.y * (zn - z);
      z = bflo(c0.y); zp = bflo(cp.y); zn = bflo(cn.y); out[2] = z + m0.z * (zp - z) + m1.z * (zn - z);
      z = bfhi(c0.y); zp = bfhi(cp.y); zn = bfhi(cn.y); out[3] = z + m0.w * (zp - z) + m1.w * (zn - z);
    };
    auto product128 = [&](f32x4 (&ac)[4], const u16* W, int off) {
      bf16x8 aop[4][4];
#pragma unroll
      for (int ks = 0; ks < 4; ++ks)
#pragma unroll
        for (int ni = 0; ni < 4; ++ni) aop[ks][ni] = *(const bf16x8*)(W + (size_t)(wave * 64 + ni * 16 + lr) * 128 + ks * 32 + lq * 8);
#pragma unroll
      for (int ni = 0; ni < 4; ++ni) ac[ni] = f32x4{0.f, 0.f, 0.f, 0.f};
#pragma unroll
      for (int ks = 0; ks < 4; ++ks) {
        const bf16x8 bop = *(const bf16x8*)(TA + lr * TAL + off + ks * 32 + lq * 8);
#pragma unroll
        for (int ni = 0; ni < 4; ++ni) ac[ni] = __builtin_amdgcn_mfma_f32_16x16x32_bf16(aop[ks][ni], bop, ac[ni], 0, 0, 0);
      }
      __builtin_amdgcn_sched_barrier(0);
    };
    auto product64x2 = [&](f32x4 (&ac0)[4], f32x4 (&ac1)[4], const u16* W0, const u16* W1, int off0, int off1) {
      bf16x8 a0[2][4], a1[2][4];
#pragma unroll
      for (int ks = 0; ks < 2; ++ks)
#pragma unroll
        for (int ni = 0; ni < 4; ++ni) {
          a0[ks][ni] = *(const bf16x8*)(W0 + (size_t)(wave * 64 + ni * 16 + lr) * 64 + ks * 32 + lq * 8);
          a1[ks][ni] = *(const bf16x8*)(W1 + (size_t)(wave * 64 + ni * 16 + lr) * 64 + ks * 32 + lq * 8);
        }
#pragma unroll
      for (int ni = 0; ni < 4; ++ni) { ac0[ni] = f32x4{0.f, 0.f, 0.f, 0.f}; ac1[ni] = f32x4{0.f, 0.f, 0.f, 0.f}; }
#pragma unroll
      for (int ks = 0; ks < 2; ++ks) {
        const bf16x8 b0 = *(const bf16x8*)(TA + lr * TAL + off0 + ks * 32 + lq * 8);
        const bf16x8 b1 = *(const bf16x8*)(TA + lr * TAL + off1 + ks * 32 + lq * 8);
#pragma unroll
        for (int ni = 0; ni < 4; ++ni) {
          ac0[ni] = __builtin_amdgcn_mfma_f32_16x16x32_bf16(a0[ks][ni], b0, ac0[ni], 0, 0, 0);
          ac1[ni] = __builtin_amdgcn_mfma_f32_16x16x32_bf16(a1[ks][ni], b1, ac1[ni], 0, 0, 0);
        }
      }
      __builtin_amdgcn_sched_barrier(0);
    };
    float ss = 0.f;
#pragma unroll
    for (int ni = 0; ni < 4; ++ni) {
      const int ch = wave * 64 + ni * 16 + lq * 4;
      float kx[4]; shifted4(256 + ch, kx);
      const float4 kw = *(const float4*)(kkw + ch);
      const float a0 = kx[0] * kw.x, a1 = kx[1] * kw.y, a2 = kx[2] * kw.z, a3 = kx[3] * kw.w;
      ss += a0 * a0 + a1 * a1 + a2 * a2 + a3 * a3;
    }
    ss += __shfl_xor(ss, 16, 64); ss += __shfl_xor(ss, 32, 64);
    const float kinv = rsqrtf(fmaxf(ss, 1e-24f));
    {
      f32x4 ag[4];
      product128(ag, (const u16*)(wl + WO_RG2), 256);
#pragma unroll
      for (int ni = 0; ni < 4; ++ni) {
        const int ch = wave * 64 + ni * 16 + lq * 4;
        const size_t o = (size_t)row * 256 + ch;
        float rx[4], kx[4], vx[4];
        shifted4(ch, rx); shifted4(256 + ch, kx); shifted4(512 + ch, vx);
        const float4 kw = *(const float4*)(kkw + ch);
        *(uint2*)(sc + SA_R * (size_t)NT * 256 + o) = make_uint2(pack2(rx[0], rx[1]), pack2(rx[2], rx[3]));
        *(uint2*)(sc + SA_V * (size_t)NT * 256 + o) = make_uint2(pack2(vx[0], vx[1]), pack2(vx[2], vx[3]));
        *(uint2*)(sc + SA_KKN * (size_t)NT * 256 + o) = make_uint2(pack2(-kx[0] * kw.x * kinv, -kx[1] * kw.y * kinv), pack2(-kx[2] * kw.z * kinv, -kx[3] * kw.w * kinv));
        *(uint2*)(sc + SA_G * (size_t)NT * 256 + o) = make_uint2(pack2(ag[ni][0], ag[ni][1]), pack2(ag[ni][2], ag[ni][3]));
        __builtin_amdgcn_sched_barrier(0);
      }
    }
#pragma unroll 1
    for (int d = 0; d < 2; ++d) {
      f32x4 aw[4], aa[4];
      product64x2(aw, aa, (const u16*)(wl + WO_RW2) + (size_t)d * 256 * 64, (const u16*)(wl + WO_RA2) + (size_t)d * 256 * 64, d * 64, 128 + d * 64);
      u16* oOMW = sc + (d ? SA_OMWB : SA_OMWF) * (size_t)NT * 256;
      u16* oKD = sc + (d ? SA_KDB : SA_KDF) * (size_t)NT * 256;
      u16* oB = sc + (d ? SA_BB : SA_BF) * (size_t)NT * 256;
#pragma unroll
      for (int ni = 0; ni < 4; ++ni) {
        const int ch = wave * 64 + ni * 16 + lq * 4;
        const size_t o = (size_t)row * 256 + ch;
        float kx[4]; shifted4(256 + ch, kx);
        const float4 kw = *(const float4*)(kkw + ch);
        const float kkn[4] = {kx[0] * kw.x * kinv, kx[1] * kw.y * kinv, kx[2] * kw.z * kinv, kx[3] * kw.w * kinv};
        const float4 w0 = *(const float4*)(w0p + d * 256 + ch);
        const float4 a0 = *(const float4*)(a0p + d * 256 + ch);
        const float4 ka = *(const float4*)(kap + d * 256 + ch);
        const float w0a[4] = {w0.x, w0.y, w0.z, w0.w}, a0a[4] = {a0.x, a0.y, a0.z, a0.w}, kaa[4] = {ka.x, ka.y, ka.z, ka.w};
        float omw[4], kd[4], bb[4];
#pragma unroll
        for (int j = 0; j < 4; ++j) {
          const float xw = -(w0a[j] + aw[ni][j]);
          const float sp = fmaxf(xw, 0.f) + __logf(1.f + __expf(-fabsf(xw)));
          const float wlog = -sp - 0.5f;
          const float e = __expf(wlog);
          omw[j] = 1.f - __expf(-e);
          const float a = sigmoidf_(a0a[j] + aa[ni][j]);
          kd[j] = kx[j] * (1.f + (a - 1.f) * kaa[j]);
          bb[j] = kkn[j] * a;
        }
        *(uint2*)(oOMW + o) = make_uint2(pack2(omw[0], omw[1]), pack2(omw[2], omw[3]));
        *(uint2*)(oKD + o) = make_uint2(pack2(kd[0], kd[1]), pack2(kd[2], kd[3]));
        *(uint2*)(oB + o) = make_uint2(pack2(bb[0], bb[1]), pack2(bb[2], bb[3]));
        __builtin_amdgcn_sched_barrier(0);
      }
    }
  }
}

DI size_t qk_index(int m, int h) {
  const bool lat = m < NTL;
  const int b = lat ? m >> 12 : (m - NTL) >> 8;
  const int pos = lat ? m & 4095 : 4096 + ((m - NTL) & 255);
  return ((size_t)(b * 8 + h) * LK + pos) * 96;
}
DI void phase_qkv(const Params& p, int l, char* smem) {
  LAUNDER_IDS
  WAVE_COORDS
  const char* wl = p.ws + OFF_W + (size_t)l * W_LAYER;
  const u16* za = (const u16*)(p.ws + OFF_R2);
  const float* rsq0 = (const float*)(p.ws + OFF_RSQ); const float* rskv0 = (const float*)(p.ws + OFF_RSKV);
  u16* Qb = (u16*)(p.ws + OFF_R1); u16* Kb = (u16*)(p.ws + OFF_R1 + SZ_Q); u16* Vt = (u16*)(p.ws + OFF_R1 + 2 * SZ_Q);
  const float* rt0 = (const float*)(p.ws + OFF_ROPE);
  const float* gq0 = p.in[I_GQ] + l * 96; const float* gk0 = p.in[I_GK] + l * 96;
  const float QS = 0.10206207261596577f * 1.4426950408889634f;
  constexpr int NTM = NT / 256;
  for (int it = 0;; ++it) {
    int tm, tn;
    if (!tile_map(it, NTM, 6, blk__, gridDim.x, tm, tn)) break;
    f32x4 acc[8][4]; zero_accm<8, 4>(acc);
    {
      const int m0 = tm * 256, n0 = tn * 128;
      gemm256<8, 4>(acc, za + 256, ZA, (const u16*)(wl + WO_UQ), 384, 384, m0, n0, smem);
      EPI_BEGIN
      const float* gq = gq0; const float* rt = rt0; const float* rsq = rsq0;
      asm volatile("" : "+v"(gq), "+v"(rt), "+v"(rsq));
      const int nw = n0 + wc * 64;
#pragma unroll
      for (int mi = 0; mi < 8; ++mi) {
        __builtin_amdgcn_sched_barrier(0);
        const int m = m0 + wr * 128 + mi * 16 + lr;
        const float rs = rsq[m];
        if (nw < 512) {
          const int h = nw >> 6;
          float ss = 0.f;
#pragma unroll
          for (int ni = 0; ni < 4; ++ni)
#pragma unroll
            for (int j = 0; j < 4; ++j) { const float v = acc[mi][ni][j] * rs; ss += v * v; }
          ss += __shfl_xor(ss, 16, 64); ss += __shfl_xor(ss, 32, 64);
          const float f = rs * rsqrtf(ss * (1.f / 64.f) + 1e-6f) * QS;
          u16* dst = Qb + qk_index(m, h);
#pragma unroll
          for (int ni = 0; ni < 4; ++ni) {
            const int d = ni * 16 + lq * 4;
            const float4 g = *(const float4*)(gq + d);
            *(uint2*)(dst + d) = make_uint2(pack2(acc[mi][ni][0] * f * g.x, acc[mi][ni][1] * f * g.y), pack2(acc[mi][ni][2] * f * g.z, acc[mi][ni][3] * f * g.w));
          }
        } else {
          const bool lat = m < NTL;
          const int tt = m & 4095;
#pragma unroll
          for (int hh = 0; hh < 2; ++hh) {
            __builtin_amdgcn_sched_barrier(0);
            const int h = ((nw - 512) >> 5) + hh;
            float ss = 0.f;
#pragma unroll
            for (int ni = 0; ni < 2; ++ni)
#pragma unroll
              for (int j = 0; j < 4; ++j) { const float v = acc[mi][hh * 2 + ni][j] * rs; ss += v * v; }
            ss += __shfl_xor(ss, 16, 64); ss += __shfl_xor(ss, 32, 64);
            const float f = rs * rsqrtf(ss * (1.f / 32.f) + 1e-6f) * QS;
            const int i0 = lq * 4;
            const float4 g1 = *(const float4*)(gq + 64 + i0), g2 = *(const float4*)(gq + 80 + i0);
            const float g1a[4] = {g1.x, g1.y, g1.z, g1.w}, g2a[4] = {g2.x, g2.y, g2.z, g2.w};
            float o1[4], o2[4];
#pragma unroll
            for (int j = 0; j < 4; ++j) {
              const float x1 = acc[mi][hh * 2][j] * f * g1a[j], x2 = acc[mi][hh * 2 + 1][j] * f * g2a[j];
              float cs = 1.f, sn = 0.f;
              if (lat) {
                const int i = i0 + j;
                const int pp = i < 8 ? (tt >> 6) : (tt & 63);
                cs = rt[(pp * 8 + (i & 7)) * 2]; sn = rt[(pp * 8 + (i & 7)) * 2 + 1];
              }
              o1[j] = x1 * cs - x2 * sn; o2[j] = x1 * sn + x2 * cs;
            }
            u16* dst = Qb + qk_index(m, h) + 64;
            *(uint2*)(dst + i0) = make_uint2(pack2(o1[0], o1[1]), pack2(o1[2], o1[3]));
            *(uint2*)(dst + 16 + i0) = make_uint2(pack2(o2[0], o2[1]), pack2(o2[2], o2[3]));
          }
        }
      }
      EPI_END
    }
  }
  __builtin_amdgcn_sched_barrier(0);
  for (int it = 0;; ++it) {
    int tm, tn;
    if (!tile_map(it, NTM, 8, blk__, gridDim.x, tm, tn)) break;
    f32x4 acc[8][4]; zero_accm<8, 4>(acc);
    {
      const int h = tn, m0 = tm * 256, n0 = h * 128;
      gemm256<8, 4>(acc, za + 640, ZA, (const u16*)(wl + WO_UKV), 256, 256, m0, n0, smem);
      EPI_BEGIN
      const float* gk = gk0; const float* rskv = rskv0;
      asm volatile("" : "+v"(gk), "+v"(rskv));
#pragma unroll
      for (int mi = 0; mi < 8; ++mi) {
        __builtin_amdgcn_sched_barrier(0);
        const int m = m0 + wr * 128 + mi * 16 + lr;
        const float rs = rskv[m];
        if (wc == 0) {
          float ss = 0.f;
#pragma unroll
          for (int ni = 0; ni < 4; ++ni)
#pragma unroll
            for (int j = 0; j < 4; ++j) { const float v = acc[mi][ni][j] * rs; ss += v * v; }
          ss += __shfl_xor(ss, 16, 64); ss += __shfl_xor(ss, 32, 64);
          const float f = rs * rsqrtf(ss * (1.f / 64.f) + 1e-6f);
          u16* dst = Kb + qk_index(m, h);
#pragma unroll
          for (int ni = 0; ni < 4; ++ni) {
            const int d = ni * 16 + lq * 4;
            const float4 g = *(const float4*)(gk + d);
            *(uint2*)(dst + d) = make_uint2(pack2(acc[mi][ni][0] * f * g.x, acc[mi][ni][1] * f * g.y), pack2(acc[mi][ni][2] * f * g.z, acc[mi][ni][3] * f * g.w));
          }
          *(uint4*)(dst + 64 + lq * 8) = *(const uint4*)((const u16*)(p.ws + OFF_KR) + (size_t)m * 32 + lq * 8);
        } else {
          const bool lat = m < NTL;
          const int b = lat ? m >> 12 : (m - NTL) >> 8;
          const int pos = lat ? m & 4095 : 4096 + ((m - NTL) & 255);
          u16* dst = Vt + (size_t)(b * 8 + h) * 64 * LK + pos + (size_t)(lq * 4) * LK;
#pragma unroll
          for (int ni = 0; ni < 4; ++ni) {
            asm volatile("" : "+v"(dst));
#pragma unroll
            for (int j = 0; j < 4; ++j) dst[j * LK] = f2bf(acc[mi][ni][j] * rs);
            dst += 16 * LK;
          }
        }
      }
      EPI_END
    }
  }
}

DI int scan_row(int b, int dir, int s) {
  if (s < LC) return NTL + b * LC + (dir ? LC - 1 - s : s);
  const int t = s - LC;
  return b * L + (dir ? L - 1 - t : t);
}
DI void phase_scan(const Params& p, char* smem) {
  LAUNDER_IDS
  const int blk = blk__;
  if (blk >= 256) return;
  const int tid = tid__, lane = tid & 63, wave = tid >> 6, kq = lane & 15, rg = lane >> 4;
  const int chain = (blk & 7) + 8 * (blk >> 5), quarter = (blk >> 3) & 3;
  const int b = chain >> 3, h = (chain >> 1) & 3, dir = chain & 1;
  const u16* sc = (const u16*)(p.ws + OFF_R3);
  const size_t AS = (size_t)NT * 256;
  const u16* aOMW = sc + (dir ? SA_OMWB : SA_OMWF) * AS;
  const u16* aKD = sc + (dir ? SA_KDB : SA_KDF) * AS;
  const u16* aB = sc + (dir ? SA_BB : SA_BF) * AS;
  const u16* aKKN = sc + SA_KKN * AS;
  const u16* aR = sc + SA_R * AS;
  const u16* aV = sc + SA_V * AS;
  u16* Y = (u16*)(p.ws + OFF_R2) + (dir ? AS : 0);
  constexpr int CH = 16, BSZ = 5 * CH * 64 + CH * 16;
  float* buf = (float*)smem;
  const int st_ld = tid >> 4, k4 = (tid & 15) * 4;
  const int vrow = quarter * 16 + wave * 4 + rg;
  uint2 g0, g1, g2, g3, g4; u16 gv;
#define SCAN_GLOAD(CHUNK) do { \
    const int row_ = scan_row(b, dir, (CHUNK) * CH + st_ld); \
    const size_t o_ = (size_t)row_ * 256 + h * 64 + k4; \
    g0 = *(const uint2*)(aOMW + o_); g1 = *(const uint2*)(aKD + o_); g2 = *(const uint2*)(aB + o_); g3 = *(const uint2*)(aKKN + o_); g4 = *(const uint2*)(aR + o_); \
    gv = aV[(size_t)row_ * 256 + h * 64 + quarter * 16 + (tid & 15)]; } while (0)
#define SCAN_LSTORE(BI) do { \
    float* bb_ = buf + (BI) * BSZ + st_ld * 64 + k4; \
    *(float4*)(bb_ + 0 * CH * 64) = make_float4(1.f - bflo(g0.x), 1.f - bfhi(g0.x), 1.f - bflo(g0.y), 1.f - bfhi(g0.y)); \
    *(float4*)(bb_ + 1 * CH * 64) = make_float4(bflo(g1.x), bfhi(g1.x), bflo(g1.y), bfhi(g1.y)); \
    *(float4*)(bb_ + 2 * CH * 64) = make_float4(bflo(g2.x), bfhi(g2.x), bflo(g2.y), bfhi(g2.y)); \
    *(float4*)(bb_ + 3 * CH * 64) = make_float4(bflo(g3.x), bfhi(g3.x), bflo(g3.y), bfhi(g3.y)); \
    *(float4*)(bb_ + 4 * CH * 64) = make_float4(bflo(g4.x), bfhi(g4.x), bflo(g4.y), bfhi(g4.y)); \
    buf[(BI) * BSZ + 5 * CH * 64 + st_ld * 16 + (tid & 15)] = bf2f(gv); } while (0)
  float2_t S01 = {0.f, 0.f}, S23 = {0.f, 0.f};
  __builtin_amdgcn_s_setprio(3);
  __syncthreads();
  SCAN_GLOAD(0); SCAN_LSTORE(0);
  __syncthreads();
  constexpr int NCH = LK / CH;
  for (int c = 0; c < NCH; ++c) {
    if (c + 1 < NCH) SCAN_GLOAD(c + 1);
    const float* bb = buf + (c & 1) * BSZ;
    const int rowbase = scan_row(b, dir, c * CH);
    const int rstep = dir ? -1 : 1;
    const float* bl = bb + kq * 4;
    const float* bv = bb + 5 * CH * 64 + wave * 4 + rg;
    float4 fwv[3], fkv[3], fbv[3], fav[3], frv[3]; float vvv[3];
#pragma unroll
    for (int q = 0; q < 2; ++q) {
      fwv[q] = *(const float4*)(bl + 0 * CH * 64 + q * 64); fkv[q] = *(const float4*)(bl + 1 * CH * 64 + q * 64); fbv[q] = *(const float4*)(bl + 2 * CH * 64 + q * 64);
      fav[q] = *(const float4*)(bl + 3 * CH * 64 + q * 64); frv[q] = *(const float4*)(bl + 4 * CH * 64 + q * 64); vvv[q] = bv[q * 16];
    }
    float ysel = 0.f, ypart = 0.f;
#pragma unroll
    for (int s = 0; s < CH; ++s) {
      const float4 fw = fwv[s % 3], fk = fkv[s % 3], fb = fbv[s % 3], fa = fav[s % 3], fr = frv[s % 3];
      const float vv = vvv[s % 3];
      const float2_t a01 = {fa.x, fa.y}, a23 = {fa.z, fa.w};
      const float2_t w01 = {fw.x, fw.y}, w23 = {fw.z, fw.w}, k01 = {fk.x, fk.y}, k23 = {fk.z, fk.w}, b01 = {fb.x, fb.y}, b23 = {fb.z, fb.w};
      const float2_t r01 = {fr.x, fr.y}, r23 = {fr.z, fr.w};
      const float2_t vv2 = {vv, vv};
      if (s + 2 < CH) {
        constexpr int dummy = 0; (void)dummy;
        const int q = (s + 2) % 3;
        fwv[q] = *(const float4*)(bl + 0 * CH * 64 + (s + 2) * 64); fkv[q] = *(const float4*)(bl + 1 * CH * 64 + (s + 2) * 64); fbv[q] = *(const float4*)(bl + 2 * CH * 64 + (s + 2) * 64);
        fav[q] = *(const float4*)(bl + 3 * CH * 64 + (s + 2) * 64); frv[q] = *(const float4*)(bl + 4 * CH * 64 + (s + 2) * 64); vvv[q] = bv[(s + 2) * 16];
      }
      float2_t t2 = S01 * a01; t2 = S23 * a23 + t2;
      const float2_t q01 = S01 * w01 + vv2 * k01, q23 = S23 * w23 + vv2 * k23;
      float xs = t2.x + t2.y, ys = ypart;
      xs += __builtin_bit_cast(float, __builtin_amdgcn_update_dpp(0, __builtin_bit_cast(int, xs), 0x128, 0xf, 0xf, false));
      ys += __builtin_bit_cast(float, __builtin_amdgcn_update_dpp(0, __builtin_bit_cast(int, ys), 0x128, 0xf, 0xf, false));
      xs += __builtin_bit_cast(float, __builtin_amdgcn_update_dpp(0, __builtin_bit_cast(int, xs), 0x124, 0xf, 0xf, false));
      ys += __builtin_bit_cast(float, __builtin_amdgcn_update_dpp(0, __builtin_bit_cast(int, ys), 0x124, 0xf, 0xf, false));
      xs += __builtin_bit_cast(float, __builtin_amdgcn_update_dpp(0, __builtin_bit_cast(int, xs), 0x122, 0xf, 0xf, false));
      ys += __builtin_bit_cast(float, __builtin_amdgcn_update_dpp(0, __builtin_bit_cast(int, ys), 0x122, 0xf, 0xf, false));
      xs += __builtin_bit_cast(float, __builtin_amdgcn_update_dpp(0, __builtin_bit_cast(int, xs), 0x121, 0xf, 0xf, false));
      ys += __builtin_bit_cast(float, __builtin_amdgcn_update_dpp(0, __builtin_bit_cast(int, ys), 0x121, 0xf, 0xf, false));
      if (s > 0) ysel = (kq == s - 1) ? ys : ysel;
      const float2_t sa2 = {xs, xs};
      S01 = sa2 * b01 + q01; S23 = sa2 * b23 + q23;
      float2_t y2 = S01 * r01; y2 = S23 * r23 + y2;
      ypart = y2.x + y2.y;
    }
    { const float yl = rowsum16(ypart); ysel = (kq == CH - 1) ? yl : ysel; }
    Y[(size_t)(rowbase + rstep * kq) * 256 + h * 64 + vrow] = f2bf(ysel);
    if (c + 1 < NCH) SCAN_LSTORE((c + 1) & 1);
    __syncthreads();
  }
  __builtin_amdgcn_s_setprio(0);
#undef SCAN_GLOAD
#undef SCAN_LSTORE
}

constexpr int KSL = 104, VSL = 68;
template <int B0>
DI bf16x8 pack8(const f32x16& v) {
  uint4 pw;
  pw.x = pack2(v[B0 + 0], v[B0 + 1]); pw.y = pack2(v[B0 + 2], v[B0 + 3]); pw.z = pack2(v[B0 + 4], v[B0 + 5]); pw.w = pack2(v[B0 + 6], v[B0 + 7]);
  return __builtin_bit_cast(bf16x8, pw);
}
DI void pv_step(f32x16& o0, f32x16& o1, const u16* Vc, int r32, int kb, bf16x8 pf) {
  {
    const uint2 lo = *(const uint2*)(Vc + r32 * VSL + kb), hi2 = *(const uint2*)(Vc + r32 * VSL + kb + 8);
    const bf16x8 va = __builtin_bit_cast(bf16x8, make_uint4(lo.x, lo.y, hi2.x, hi2.y));
    o0 = __builtin_amdgcn_mfma_f32_32x32x16_bf16(va, pf, o0, 0, 0, 0);
  }
  {
    const uint2 lo = *(const uint2*)(Vc + (32 + r32) * VSL + kb), hi2 = *(const uint2*)(Vc + (32 + r32) * VSL + kb + 8);
    const bf16x8 va = __builtin_bit_cast(bf16x8, make_uint4(lo.x, lo.y, hi2.x, hi2.y));
    o1 = __builtin_amdgcn_mfma_f32_32x32x16_bf16(va, pf, o1, 0, 0, 0);
  }
}
DI void attn_item(const Params& p, int item, char* smem) {
  LAUNDER_IDS
  const int tid = tid__, lane = tid & 63, wave = tid >> 6, r32 = lane & 31, hi = lane >> 5;
  int bh, qpos0, key0, nkt, orow0;
  if (item < 2048) { bh = item >> 5; const int qb = item & 31; qpos0 = qb * 128; key0 = 0; nkt = LK / 64; orow0 = (bh >> 3) * L + qpos0; }
  else { const int it = item - 2048; bh = it >> 1; const int qb = it & 1; qpos0 = 4096 + qb * 128; key0 = 4096; nkt = LC / 64; orow0 = NTL + (bh >> 3) * LC + qb * 128; }
  const int h = bh & 7;
  const u16* Qp = (const u16*)(p.ws + OFF_R1) + ((size_t)bh * LK + qpos0 + wave * 32 + r32) * 96 + hi * 8;
  const u16* Kp = (const u16*)(p.ws + OFF_R1 + SZ_Q) + ((size_t)bh * LK + key0) * 96;
  const u16* Vp = (const u16*)(p.ws + OFF_R1 + 2 * SZ_Q) + (size_t)bh * 64 * LK + key0;
  u16* Ks = (u16*)smem;
  u16* Vs = Ks + 2 * 64 * KSL;
  bf16x8 qr[6];
#pragma unroll
  for (int d0 = 0; d0 < 6; ++d0) qr[d0] = *(const bf16x8*)(Qp + d0 * 16);
  uint4 ak0, ak1, ak2, av0, av1, bk0, bk1, bk2, bv0, bv1;
  const int kr0 = tid / 12, kc0 = tid - kr0 * 12, kr1 = (tid + 256) / 12, kc1 = (tid + 256) - kr1 * 12, kr2 = (tid + 512) / 12, kc2 = (tid + 512) - kr2 * 12;
  const int vd0 = tid >> 3, vc0 = tid & 7, vd1 = vd0 + 32;
#define gload(S, kt) do { \
    S##k0 = *(const uint4*)(Kp + (size_t)((kt) * 64 + kr0) * 96 + kc0 * 8); S##k1 = *(const uint4*)(Kp + (size_t)((kt) * 64 + kr1) * 96 + kc1 * 8); \
    S##k2 = *(const uint4*)(Kp + (size_t)((kt) * 64 + kr2) * 96 + kc2 * 8); \
    S##v0 = *(const uint4*)(Vp + (size_t)vd0 * LK + (kt) * 64 + vc0 * 8); S##v1 = *(const uint4*)(Vp + (size_t)vd1 * LK + (kt) * 64 + vc0 * 8); } while (0)
#define lstore(S, bi) do { \
    *(uint4*)(Ks + (bi) * 64 * KSL + kr0 * KSL + kc0 * 8) = S##k0; *(uint4*)(Ks + (bi) * 64 * KSL + kr1 * KSL + kc1 * 8) = S##k1; *(uint4*)(Ks + (bi) * 64 * KSL + kr2 * KSL + kc2 * 8) = S##k2; \
    { u16* dst = Vs + (bi) * 64 * VSL + vd0 * VSL + vc0 * 8; *(uint2*)dst = make_uint2(S##v0.x, S##v0.y); *(uint2*)(dst + 4) = make_uint2(S##v0.z, S##v0.w); } \
    { u16* dst = Vs + (bi) * 64 * VSL + vd1 * VSL + vc0 * 8; *(uint2*)dst = make_uint2(S##v1.x, S##v1.y); *(uint2*)(dst + 4) = make_uint2(S##v1.z, S##v1.w); } } while (0)
  f32x16 o0, o1;
#pragma unroll
  for (int i = 0; i < 16; ++i) { o0[i] = 0.f; o1[i] = 0.f; }
  float mrun = -1e30f, lrun = 0.f;
  auto tile_compute = [&](int cur) {
    const u16* Kc = Ks + cur * 64 * KSL;
    const u16* Vc = Vs + cur * 64 * VSL;
    f32x16 p0, p1;
#pragma unroll
    for (int i = 0; i < 16; ++i) { p0[i] = 0.f; p1[i] = 0.f; }
#pragma unroll
    for (int d0 = 0; d0 < 6; ++d0) {
      const bf16x8 a0 = *(const bf16x8*)(Kc + r32 * KSL + d0 * 16 + hi * 8);
      const bf16x8 a1 = *(const bf16x8*)(Kc + (32 + r32) * KSL + d0 * 16 + hi * 8);
      p0 = __builtin_amdgcn_mfma_f32_32x32x16_bf16(a0, qr[d0], p0, 0, 0, 0);
      p1 = __builtin_amdgcn_mfma_f32_32x32x16_bf16(a1, qr[d0], p1, 0, 0, 0);
    }
    float mx = p0[0];
#pragma unroll
    for (int i = 1; i < 16; ++i) mx = fmaxf(mx, p0[i]);
#pragma unroll
    for (int i = 0; i < 16; ++i) mx = fmaxf(mx, p1[i]);
    { auto rr = __builtin_amdgcn_permlane32_swap(__float_as_uint(mx), __float_as_uint(mx), false, false);
      mx = fmaxf(__uint_as_float(rr[0]), __uint_as_float(rr[1])); }
    if (!__all(mx - mrun <= 8.f)) {
      const float mn = fmaxf(mrun, mx);
      const float alpha = __builtin_amdgcn_exp2f(mrun - mn);
      mrun = mn; lrun *= alpha;
#pragma unroll
      for (int i = 0; i < 16; ++i) { o0[i] *= alpha; o1[i] *= alpha; }
    }
    float ps = 0.f;
#pragma unroll
    for (int i = 0; i < 16; ++i) { p0[i] = __builtin_amdgcn_exp2f(p0[i] - mrun); ps += p0[i]; }
#pragma unroll
    for (int i = 0; i < 16; ++i) { p1[i] = __builtin_amdgcn_exp2f(p1[i] - mrun); ps += p1[i]; }
    lrun += ps;
    pv_step(o0, o1, Vc, r32, 0 + hi * 4, pack8<0>(p0));
    pv_step(o0, o1, Vc, r32, 16 + hi * 4, pack8<8>(p0));
    pv_step(o0, o1, Vc, r32, 32 + hi * 4, pack8<0>(p1));
    pv_step(o0, o1, Vc, r32, 48 + hi * 4, pack8<8>(p1));
  };
  __syncthreads();
  gload(a, 0); lstore(a, 0);
  gload(a, 1);
  __syncthreads();
  for (int kt = 0; kt < nkt; kt += 2) {
    if (kt + 2 < nkt) gload(b, kt + 2);
    tile_compute(0);
    lstore(a, 1);
    __syncthreads();
    if (kt + 3 < nkt) gload(a, kt + 3);
    tile_compute(1);
    if (kt + 2 < nkt) lstore(b, 0);
    __syncthreads();
  }
  lrun += __shfl_xor(lrun, 32, 64);
  const float inv = 1.f / lrun;
  u16* om = (u16*)(p.ws + OFF_OMLA) + (size_t)(orow0 + wave * 32 + r32) * 512 + h * 64;
#pragma unroll
  for (int g = 0; g < 4; ++g) {
    const int d = 8 * g + 4 * hi;
    *(uint2*)(om + d) = make_uint2(pack2(o0[4 * g] * inv, o0[4 * g + 1] * inv), pack2(o0[4 * g + 2] * inv, o0[4 * g + 3] * inv));
    *(uint2*)(om + 32 + d) = make_uint2(pack2(o1[4 * g] * inv, o1[4 * g + 1] * inv), pack2(o1[4 * g + 2] * inv, o1[4 * g + 3] * inv));
  }
#undef gload
#undef lstore
}

DI void readout_row(const Params& p, int l, int r) {
  LAUNDER_IDS
  const int lane = tid__ & 63;
  const u16* sc = (const u16*)(p.ws + OFF_R3);
  const size_t AS = (size_t)NT * 256;
  const size_t o = (size_t)r * 256 + lane * 4;
  const u16* Yf = (const u16*)(p.ws + OFF_R2);
  const uint2 yf = *(const uint2*)(Yf + o), yb = *(const uint2*)(Yf + AS + o);
  const uint2 ur = *(const uint2*)(sc + SA_R * AS + o), uv = *(const uint2*)(sc + SA_V * AS + o);
  const uint2 kf = *(const uint2*)(sc + SA_KDF * AS + o), kb = *(const uint2*)(sc + SA_KDB * AS + o), ug = *(const uint2*)(sc + SA_G * AS + o);
  float y[4] = {bflo(yf.x) + bflo(yb.x), bfhi(yf.x) + bfhi(yb.x), bflo(yf.y) + bflo(yb.y), bfhi(yf.y) + bfhi(yb.y)};
  const float rr[4] = {bflo(ur.x), bfhi(ur.x), bflo(ur.y), bfhi(ur.y)};
  const float vv[4] = {bflo(uv.x), bfhi(uv.x), bflo(uv.y), bfhi(uv.y)};
  const float km[4] = {0.5f * (bflo(kf.x) + bflo(kb.x)), 0.5f * (bfhi(kf.x) + bfhi(kb.x)), 0.5f * (bflo(kf.y) + bflo(kb.y)), 0.5f * (bfhi(kf.y) + bfhi(kb.y))};
  const float gg[4] = {bflo(ug.x), bfhi(ug.x), bflo(ug.y), bfhi(ug.y)};
  const float4 rk4 = *(const float4*)(p.in[I_RK] + l * 256 + lane * 4);
  const float4 lw4 = *(const float4*)(p.in[I_LNW] + l * 256 + lane * 4);
  const float4 lb4 = *(const float4*)(p.in[I_LNB] + l * 256 + lane * 4);
  const float rk[4] = {rk4.x, rk4.y, rk4.z, rk4.w}, lw[4] = {lw4.x, lw4.y, lw4.z, lw4.w}, lb[4] = {lb4.x, lb4.y, lb4.z, lb4.w};
  float s = y[0] + y[1] + y[2] + y[3];
  s = rowsum16(s);
  const float mu = s * (1.f / 64.f);
  float q = 0.f, bn = 0.f;
#pragma unroll
  for (int j = 0; j < 4; ++j) { const float d = y[j] - mu; q += d * d; bn += rr[j] * km[j] * rk[j]; }
  q = rowsum16(q); bn = rowsum16(bn);
  const float rstd = rsqrtf(q * (1.f / 64.f) + 64e-5f);
  float ov[4];
#pragma unroll
  for (int j = 0; j < 4; ++j) ov[j] = ((y[j] - mu) * rstd * lw[j] + lb[j] + bn * vv[j]) * gg[j];
  u16* orw = (u16*)(p.ws + OFF_R3 + SA_KKN * SZ_TOK256 + (size_t)NT * 512 * 2);
  *(uint2*)(orw + o) = make_uint2(pack2(ov[0], ov[1]), pack2(ov[2], ov[3]));
}

DI void phase_attn(const Params& p, int l, char* smem) {
  LAUNDER_IDS
  __shared__ int qslot_sh;
  const int nattn = (l == 0) ? 2048 + 128 : 2048;
  unsigned* ctr = (unsigned*)(p.ws + OFF_BAR) + 16 + l * 16;
  for (;;) {
    __syncthreads();
    if (tid__ == 0) qslot_sh = (int)__hip_atomic_fetch_add(ctr, 1u, __ATOMIC_RELAXED, __HIP_MEMORY_SCOPE_AGENT);
    __syncthreads();
    const int it = qslot_sh;
    if (it >= nattn) break;
    attn_item(p, it, smem);
  }
}
DI void phase_readout(const Params& p, int l, int Mout) {
  LAUNDER_IDS
  const int wave = tid__ >> 6;
  for (int r = blk__ * 4 + wave; r < Mout; r += gridDim.x * 4) readout_row(p, l, r);
}

DI void phase_merge(const Params& p, int l, int Mout, char* smem) {
  LAUNDER_IDS
  WAVE_COORDS
  const char* wl = p.ws + OFF_W + (size_t)l * W_LAYER;
  const u16* hg = (const u16*)(p.ws + OFF_HBG);
  const u16* opool = (const u16*)(p.ws + OFF_R4);
  const u16* omla = (const u16*)(p.ws + OFF_OMLA);
  const u16* orw = (const u16*)(p.ws + OFF_R3 + SA_KKN * SZ_TOK256) + (size_t)NT * 512;
  u16* mo = (u16*)(p.ws + OFF_R1);
  const int ntm = Mout / 128;
  for (int it = 0;; ++it) {
    int tm, tn;
    if (!tile_map(it, ntm, 8, blk__, gridDim.x, tm, tn)) break;
    const int m0 = tm * 128, n0 = tn * 128;
    f32x4 msum[4][4]; zero_accm<4, 4>(msum);
#pragma unroll 1
    for (int br = 0; br < 3; ++br) {
      unsigned gpk[4][4][2];
      {
        f32x4 ag[4][4]; zero_accm<4, 4>(ag);
        gemm256<4, 4>(ag, hg, 1024, (const u16*)(wl + WO_WIN) + (size_t)(2080 + br * 1024) * 1024, 1024, 1024, m0, n0, smem);
#pragma unroll
        for (int mi = 0; mi < 4; ++mi)
#pragma unroll
          for (int ni = 0; ni < 4; ++ni) {
            gpk[mi][ni][0] = pack2(sigmoidf_(ag[mi][ni][0]), sigmoidf_(ag[mi][ni][1]));
            gpk[mi][ni][1] = pack2(sigmoidf_(ag[mi][ni][2]), sigmoidf_(ag[mi][ni][3]));
          }
      }
      __builtin_amdgcn_sched_barrier(0);
      f32x4 ab[4][4]; zero_accm<4, 4>(ab);
      {
        const int Kb = br == 1 ? 512 : 256;
        const u16* Ab = br == 0 ? opool : br == 1 ? omla : orw;
        const u16* Wb = (const u16*)(wl + (br == 0 ? WO_BRP : br == 1 ? WO_BRM : WO_BRR));
        gemm256<4, 4>(ab, Ab, Kb, Wb, Kb, Kb, m0, n0, smem);
      }
#pragma unroll
      for (int mi = 0; mi < 4; ++mi)
#pragma unroll
        for (int ni = 0; ni < 4; ++ni) {
          msum[mi][ni][0] += bflo(gpk[mi][ni][0]) * ab[mi][ni][0];
          msum[mi][ni][1] += bfhi(gpk[mi][ni][0]) * ab[mi][ni][1];
          msum[mi][ni][2] += bflo(gpk[mi][ni][1]) * ab[mi][ni][2];
          msum[mi][ni][3] += bfhi(gpk[mi][ni][1]) * ab[mi][ni][3];
        }
      __builtin_amdgcn_sched_barrier(0);
    }
    EPI_BEGIN
#pragma unroll
    for (int mi = 0; mi < 4; mi += 2) {
      const int m = m0 + wr * 64 + (mi + (lq & 1)) * 16 + lr;
#pragma unroll
      for (int ni = 0; ni < 4; ++ni) {
        const int n = n0 + wc * 64 + ni * 16 + (lq >> 1) * 8;
        *(uint4*)(mo + (size_t)m * 1024 + n) = widen16(make_uint2(pack2(msum[mi][ni][0], msum[mi][ni][1]), pack2(msum[mi][ni][2], msum[mi][ni][3])),
                                                       make_uint2(pack2(msum[mi + 1][ni][0], msum[mi + 1][ni][1]), pack2(msum[mi + 1][ni][2], msum[mi + 1][ni][3])));
      }
    }
    EPI_END
  }
}

template <int MI, int NI>
DI void resid_tile(const u16* A, int K, const u16* Bt, const float* gate, const float* xl_in, const float* xc_in, float* xl_out, float* xc_out,
                   int m0, int n0, char* smem) {
  LAUNDER_IDS
  WAVE_COORDS
  f32x4 acc[MI][NI]; zero_accm<MI, NI>(acc);
  gemm256<MI, NI>(acc, A, K, Bt, K, K, m0, n0, smem);
  EPI_BEGIN
#pragma unroll
  for (int mi = 0; mi < MI; ++mi) {
    const int m = m0 + wr * 16 * MI + mi * 16 + lr;
    const int b9 = m < NTL ? m >> 12 : 8;
    const float* xi = xrow(xl_in, xc_in, m);
    float* xo = m < NTL ? xl_out + (size_t)m * D : xc_out + (size_t)(m - NTL) * D;
#pragma unroll
    for (int ni = 0; ni < NI; ++ni) {
      const int n = n0 + wc * 16 * NI + ni * 16 + lq * 4;
      const float4 g = *(const float4*)(gate + (size_t)b9 * 6144 + n);
      const float4 xv = *(const float4*)(xi + n);
      float4 ov;
      ov.x = xv.x + g.x * acc[mi][ni][0]; ov.y = xv.y + g.y * acc[mi][ni][1]; ov.z = xv.z + g.z * acc[mi][ni][2]; ov.w = xv.w + g.w * acc[mi][ni][3];
      *(float4*)(xo + n) = ov;
    }
    __builtin_amdgcn_sched_barrier(0);
  }
  EPI_END
}
DI void phase_resid(const Params& p, const u16* A, int K, const u16* Bt, const float* gate  ,
                    const float* xl_in, const float* xc_in, float* xl_out, float* xc_out, int Mout, char* smem) {
  LAUNDER_IDS
  for (int it = 0;; ++it) {
    int tm, tn;
    if (!tile_map(it, NTL / 256, 8, blk__, gridDim.x, tm, tn)) break;
    resid_tile<8, 4>(A, K, Bt, gate, xl_in, xc_in, xl_out, xc_out, tm * 256, tn * 128, smem);
  }
  if (Mout > NTL) {
    for (int t = blk__; t < (NTC / 64) * 16; t += gridDim.x) {
      const int tm = t >> 4, tn = t & 15;
      resid_tile<2, 2>(A, K, Bt, gate, xl_in, xc_in, xl_out, xc_out, NTL + tm * 64, tn * 64, smem);
    }
  }
}
DI void phase_mlp1(const Params& p, int l, int Mout, char* smem) {
  LAUNDER_IDS
  WAVE_COORDS
  const char* wl = p.ws + OFF_W + (size_t)l * W_LAYER;
  const u16* hb = (const u16*)(p.ws + OFF_HB2);
  u16* U = (u16*)(p.ws + OFF_R1);
  const int ntm = Mout / 256;
  for (int it = 0;; ++it) {
    int tm, tn;
    if (!tile_map(it, ntm, 32, blk__, gridDim.x, tm, tn)) break;
    const int m0 = tm * 256, n0 = tn * 128;
    f32x4 acc[8][4]; zero_accm<8, 4>(acc);
    gemm256<8, 4>(acc, hb, 1024, (const u16*)(wl + WO_W1), 1024, 1024, m0, n0, smem);
    EPI_BEGIN
#pragma unroll
    for (int mi = 0; mi < 8; mi += 2) {
      const int m = m0 + wr * 128 + (mi + (lq & 1)) * 16 + lr;
#pragma unroll
      for (int ni = 0; ni < 4; ++ni) {
        const int n = n0 + wc * 64 + ni * 16 + (lq >> 1) * 8;
        float va[4], vb[4];
#pragma unroll
        for (int j = 0; j < 4; ++j) { const float a = fmaxf(acc[mi][ni][j], 0.f); va[j] = a * a; const float b = fmaxf(acc[mi + 1][ni][j], 0.f); vb[j] = b * b; }
        *(uint4*)(U + (size_t)m * DFF + n) = widen16(make_uint2(pack2(va[0], va[1]), pack2(va[2], va[3])), make_uint2(pack2(vb[0], vb[1]), pack2(vb[2], vb[3])));
      }
      __builtin_amdgcn_sched_barrier(0);
    }
    EPI_END
  }
}

__global__ void __launch_bounds__(256, 2) fwd_megakernel(Params pk) {
  __shared__ __attribute__((aligned(16))) char smem[73728];
  cg::grid_group grid = cg::this_grid();
  if (threadIdx.x == 0) { g_base_sh[0] = (unsigned long long)pk.ws; g_base_sh[1] = (unsigned long long)pk.out; }
  xcd_barrier_post((unsigned*)(pk.ws + OFF_BAR));
  __syncthreads();
  phase_prep(pk, smem);
  if (pk.ws == nullptr) grid.sync();
  xcd_barrier();
  phase_tables(pk);
  xcd_barrier();
#define CTXBUF ((float*)(p.ws + OFF_CTX))
#define XLP (l == 0 ? p.in[I_X] : (const float*)p.out)
#define XCP (l == 0 ? p.in[I_CTX] : (const float*)CTXBUF)
#define MOUT (l == 0 ? NT : NTL)
#define WLP (p.ws + OFF_W + (size_t)l * W_LAYER)
#define TABP(nrm) ((const float*)(p.ws + OFF_TAB) + (size_t)(l * 2 + (nrm)) * 9 * 2048)
#define MODP(j) ((const float*)(p.ws + OFF_MODS) + (size_t)l * 9 * 6144 + (j) * 1024)
#ifndef PROBE_Q
#define PROBE_Q -1
#endif
#pragma nounroll
  for (int ph = 0; ph < 22; ++ph) {
    const int l = ph >= 11 ? 1 : 0, q = ph - l * 11;
    Params p = pk;
    {
      asm volatile("" ::: "memory");
      unsigned long long w_ = g_base_sh[0], o_ = g_base_sh[1];
      unsigned wl_ = (unsigned)w_, wh_ = (unsigned)(w_ >> 32), ol_ = (unsigned)o_, oh_ = (unsigned)(o_ >> 32);
      wl_ = __builtin_amdgcn_readfirstlane(wl_); wh_ = __builtin_amdgcn_readfirstlane(wh_); ol_ = __builtin_amdgcn_readfirstlane(ol_); oh_ = __builtin_amdgcn_readfirstlane(oh_);
      asm volatile("" : "+s"(wl_), "+s"(wh_), "+s"(ol_), "+s"(oh_));
      p.ws = (char*)(((unsigned long long)wh_ << 32) | wl_); p.out = (float*)(((unsigned long long)oh_ << 32) | ol_);
    }
#pragma nounroll
    for (int rep = 0; rep < (q == PROBE_Q ? 2 : 1); ++rep)
    switch (q) {
      case 0: phase_norm(XLP, XCP, TABP(0), (u16*)(p.ws + OFF_HB1), NT); break;
      case 1: phase_zgemm(p, l, smem); break;
      case 2: phase_tokA(p, l); phase_tokB(p, l, smem); break;
      case 3: phase_qkv(p, l, smem); break;
      case 4: phase_scan(p, smem); phase_attn(p, l, smem); break;
      case 5: phase_norm(XLP, XCP, TABP(0), (u16*)(p.ws + OFF_HBG), MOUT); phase_readout(p, l, MOUT); break;
      case 6: phase_merge(p, l, MOUT, smem); break;
      case 7: phase_resid(p, (const u16*)(p.ws + OFF_R1), 1024, (const u16*)(WLP + WO_WO), MODP(2), XLP, XCP, p.out, CTXBUF, MOUT, smem); break;
      case 8: phase_norm(p.out, CTXBUF, TABP(1), (u16*)(p.ws + OFF_HB2), MOUT); break;
      case 9: phase_mlp1(p, l, MOUT, smem); break;
      default: phase_resid(p, (const u16*)(p.ws + OFF_R1), 4096, (const u16*)(WLP + WO_W2), MODP(5), p.out, CTXBUF, p.out, CTXBUF, MOUT, smem); break;
    }
    if (ph != 21) xcd_barrier();
  }
}

extern "C" void kernel_launch(void* const* d_in, const int* in_sizes, int n_in, void* d_out, int out_size, void* d_ws, size_t ws_size, hipStream_t stream) {
  static int grid_blocks = 0;
  if (!grid_blocks) {
    int dev = 0, cus = 0, per_cu = 0;
    hipGetDevice(&dev);
    hipDeviceGetAttribute(&cus, hipDeviceAttributeMultiprocessorCount, dev);
    hipOccupancyMaxActiveBlocksPerMultiprocessor(&per_cu, fwd_megakernel, 256, 0);
    if (per_cu > 2) per_cu = 2;
    if (per_cu < 1) per_cu = 1;
    grid_blocks = cus * per_cu;
    if (ws_size < WS_END) fprintf(stderr, "kernel_launch: workspace too small: %zu < %zu\n", ws_size, (size_t)WS_END);
  }
  Params p{};
  for (int i = 0; i < 34; ++i) p.in[i] = (const float*)d_in[i];
  p.out = (float*)d_out;
  p.ws = (char*)d_ws;
  hipMemsetAsync(d_ws, 0, 16384, stream);
  void* args[] = {&p};
  hipError_t e = hipLaunchCooperativeKernel((void*)fwd_megakernel, dim3(grid_blocks), dim3(256), args, 0, stream);
  if (e != hipSuccess) fprintf(stderr, "cooperative launch failed: %s (grid %d)\n", hipGetErrorString(e), grid_blocks);
}
```

```cpp
#include <hip/hip_runtime.h>
#include <hip/hip_cooperative_groups.h>
#include <stdint.h>
#include <cstdio>
namespace cg = cooperative_groups;

typedef unsigned short u16;
typedef __attribute__((ext_vector_type(8))) short bf16x8;
typedef __attribute__((ext_vector_type(4))) float f32x4;
typedef __attribute__((ext_vector_type(16))) float f32x16;
typedef __bf16 bf16x2_t __attribute__((ext_vector_type(2)));
typedef float float2_t __attribute__((ext_vector_type(2)));

#define DI __device__ __forceinline__

constexpr int D = 1024, NB = 8, L = 4096, LC = 256, LK = 4352;
constexpr int NTL = NB * L;
constexpr int NTC = NB * LC;
constexpr int NT = NTL + NTC;
constexpr int INC = 5152;
constexpr int ZA = 928;
constexpr int ZR = 1152;
constexpr int DFF = 4096;

constexpr size_t al256(size_t x) { return (x + 255) / 256 * 256; }
constexpr size_t OFF_BAR = 0;
constexpr size_t OFF_MODS = 16384;
constexpr size_t OFF_TAB = OFF_MODS + al256(2 * 9 * 6144 * 4);
constexpr size_t OFF_ROPE = OFF_TAB + al256(2 * 2 * 9 * 2 * 1024 * 4);
constexpr size_t OFF_RS1 = OFF_ROPE + 4096;
constexpr size_t OFF_RS2 = OFF_RS1 + al256(NT * 4);
constexpr size_t OFF_RSQ = OFF_RS2 + al256(NT * 4);
constexpr size_t OFF_RSKV = OFF_RSQ + al256(NT * 4);
constexpr size_t OFF_CTX = OFF_RSKV + al256(NT * 4);
constexpr size_t OFF_W = OFF_CTX + (size_t)NTC * D * 4;
constexpr size_t WO_WIN = 0;
constexpr size_t WO_UQ = WO_WIN + (size_t)INC * 1024 * 2;
constexpr size_t WO_UKV = WO_UQ + (size_t)768 * 384 * 2;
constexpr size_t WO_BRP = WO_UKV + (size_t)1024 * 256 * 2;
constexpr size_t WO_BRM = WO_BRP + (size_t)1024 * 256 * 2;
constexpr size_t WO_BRR = WO_BRM + (size_t)1024 * 512 * 2;
constexpr size_t WO_WO = WO_BRR + (size_t)1024 * 256 * 2;
constexpr size_t WO_W1 = WO_WO + (size_t)1024 * 1024 * 2;
constexpr size_t WO_W2 = WO_W1 + (size_t)4096 * 1024 * 2;
constexpr size_t WO_RW2 = WO_W2 + (size_t)1024 * 4096 * 2;
constexpr size_t WO_RA2 = WO_RW2 + (size_t)2 * 256 * 64 * 2;
constexpr size_t WO_RG2 = WO_RA2 + (size_t)2 * 256 * 64 * 2;
constexpr size_t W_LAYER = al256(WO_RG2 + (size_t)256 * 128 * 2);
constexpr size_t OFF_R1 = OFF_W + 2 * W_LAYER;
constexpr size_t SZ_Q = (size_t)NB * 8 * LK * 96 * 2;
constexpr size_t SZ_VT = (size_t)NB * 8 * 64 * LK * 2;
constexpr size_t SZ_R1 = 2 * SZ_Q + SZ_VT;
constexpr size_t OFF_R2 = OFF_R1 + al256(SZ_R1);
constexpr size_t SZ_TOK256 = (size_t)NT * 256 * 2;
constexpr size_t OFF_R3 = OFF_R2 + al256((size_t)NT * ZA * 2);
constexpr size_t OFF_R4 = OFF_R3 + 10 * SZ_TOK256;
constexpr size_t OFF_KR = OFF_R4 + SZ_TOK256;
constexpr size_t OFF_OMLA = OFF_KR + al256((size_t)NT * 32 * 2);
constexpr size_t WS_END = OFF_OMLA + (size_t)NT * 512 * 2;
static_assert(WS_END <= 536870912ull, "workspace map exceeds 4x the largest tensor");
constexpr size_t OFF_HB1 = OFF_R3;
constexpr size_t OFF_HBG = OFF_R1 + (size_t)NT * 1024 * 2;
constexpr size_t OFF_HB2 = OFF_R3 + 5 * SZ_TOK256;
enum { SA_R = 0, SA_V = 1, SA_KDF = 2, SA_KDB = 3, SA_G = 4, SA_KKN = 5, SA_OMWF = 6, SA_BF = 7, SA_OMWB = 8, SA_BB = 9 };

struct Params { const float* in[34]; float* out; char* ws; };

enum { I_X = 0, I_C, I_CTX, I_CCTX, I_N1G, I_N2G, I_WADA, I_BADA, I_WIN, I_POOLW, I_POOLS, I_QNORM, I_WUQ, I_KVNORM, I_WUKV,
       I_GQ, I_GK, I_MU, I_W0, I_W2R, I_A0, I_A2R, I_KA, I_KK, I_RK, I_G2R, I_LNW, I_LNB, I_BRP, I_BRM, I_BRR, I_WO, I_W1, I_W2 };

DI float bf2f(u16 h) { return __uint_as_float(((unsigned)h) << 16); }
DI float bflo(unsigned u) { return __uint_as_float(u << 16); }
DI float bfhi(unsigned u) { return __uint_as_float(u & 0xffff0000u); }
DI unsigned pack2(float a, float b) { float2_t v = {a, b}; bf16x2_t r = __builtin_convertvector(v, bf16x2_t); return __builtin_bit_cast(unsigned, r); }
DI u16 f2bf(float a) { return (u16)(pack2(a, 0.f) & 0xffffu); }
DI float sigmoidf_(float x) { return 1.f / (1.f + __expf(-x)); }
DI float siluf_(float x) { return x / (1.f + __expf(-x)); }
DI float rowsum16(float x) {
  x += __builtin_bit_cast(float, __builtin_amdgcn_update_dpp(0, __builtin_bit_cast(int, x), 0x128, 0xf, 0xf, false));
  x += __builtin_bit_cast(float, __builtin_amdgcn_update_dpp(0, __builtin_bit_cast(int, x), 0x124, 0xf, 0xf, false));
  x += __builtin_bit_cast(float, __builtin_amdgcn_update_dpp(0, __builtin_bit_cast(int, x), 0x122, 0xf, 0xf, false));
  x += __builtin_bit_cast(float, __builtin_amdgcn_update_dpp(0, __builtin_bit_cast(int, x), 0x121, 0xf, 0xf, false));
  return x;
}
DI float wavesum(float x) {
  x = rowsum16(x);
  const int xi = __builtin_bit_cast(int, x);
  return __builtin_bit_cast(float, __builtin_amdgcn_readlane(xi, 0)) + __builtin_bit_cast(float, __builtin_amdgcn_readlane(xi, 16)) +
         __builtin_bit_cast(float, __builtin_amdgcn_readlane(xi, 32)) + __builtin_bit_cast(float, __builtin_amdgcn_readlane(xi, 48));
}
DI void grid_barrier(unsigned* ctr, unsigned& epoch) {
  asm volatile("s_waitcnt vmcnt(0)" ::: "memory");
  __syncthreads();
  epoch++;
  if (threadIdx.x == 0) {
    __builtin_amdgcn_fence(__ATOMIC_RELEASE, "agent");
    asm volatile("s_waitcnt vmcnt(0)" ::: "memory");
    const unsigned target = epoch * gridDim.x;
    __hip_atomic_fetch_add(ctr, 1u, __ATOMIC_RELAXED, __HIP_MEMORY_SCOPE_AGENT);
    while (__hip_atomic_load(ctr, __ATOMIC_RELAXED, __HIP_MEMORY_SCOPE_AGENT) < target) __builtin_amdgcn_s_sleep(2);
    __builtin_amdgcn_fence(__ATOMIC_ACQUIRE, "agent");
    asm volatile("s_waitcnt vmcnt(0)" ::: "memory");
  }
  __syncthreads();
}


#define XB_TMO      128
#define XB_XCNT(j)  (256  + 64 * (j))
#define XB_XSUB(j)  (1280 + 64 * (j))
#define XB_XGEN(j)  (2304 + 64 * (j))
#define XB_TOP      3328
#define XB_TOPGEN   3392
#define XB_SPIN_CAP (1u << 22)
#define LAS __attribute__((address_space(3)))
DI unsigned xb_ld(unsigned* p)              { return __hip_atomic_load(p, __ATOMIC_RELAXED, __HIP_MEMORY_SCOPE_AGENT); }
DI unsigned xb_add(unsigned* p, unsigned v) { return __hip_atomic_fetch_add(p, v, __ATOMIC_RELAXED, __HIP_MEMORY_SCOPE_AGENT); }
DI unsigned xb_xcc_id() { return (unsigned)__builtin_amdgcn_s_getreg((3 << 11) | 20) & 0xFu; }
#define XB_SPIN(cond, bar) do { unsigned _sp = 0; while (cond) { __builtin_amdgcn_s_sleep(1); \
    if ((++_sp & 255u) == 0u) { if (xb_ld(&(bar)[XB_TMO])) break; if (_sp > XB_SPIN_CAP) { atomicAdd(&(bar)[XB_TMO], 1u); break; } } } } while (0)
__shared__ uint4 g_xb_words;
__shared__ unsigned long long g_base_sh[2];
DI void xcd_barrier_post(unsigned* bar) {
  const unsigned x = xb_xcc_id();
  if (threadIdx.x == 0) { g_xb_words = make_uint4(0u, 0u, x, 0u); (void)xb_add(&bar[XB_XCNT(x)], 1u); }
}
DI void xcd_barrier_complete(unsigned* bar, unsigned x, unsigned& nloc, unsigned& nx) {
  const unsigned G = gridDim.x;
  unsigned sum, cnt, mine, sp = 0u;
  for (;;) {
    sum = 0u; cnt = 0u; mine = 0u;
#pragma unroll
    for (unsigned j = 0; j < 16; ++j) { const unsigned c = xb_ld(&bar[XB_XCNT(j)]); sum += c; cnt += (c > 0u) ? 1u : 0u; mine = (j == x) ? c : mine; }
    if (sum == G) break;
    __builtin_amdgcn_s_sleep(1);
    if ((++sp & 255u) == 0u) { if (xb_ld(&bar[XB_TMO])) break; if (sp > XB_SPIN_CAP) { atomicAdd(&bar[XB_TMO], 1u); break; } }
  }
  nloc = mine > 0u ? mine : 1u; nx = cnt > 0u ? cnt : 1u;
}
DI void xcd_barrier() {
  asm volatile("s_waitcnt vmcnt(0)" ::: "memory");
  __syncthreads();
  if (threadIdx.x == 0) {
    unsigned* bar = (unsigned*)(g_base_sh[0] + OFF_BAR);
    __builtin_amdgcn_s_waitcnt(0);
    unsigned nloc = g_xb_words.x, nx = g_xb_words.y; const unsigned x = g_xb_words.z;
    if (nloc == 0u) { xcd_barrier_complete(bar, x, nloc, nx); g_xb_words.x = nloc; g_xb_words.y = nx; }
    const unsigned old = xb_add(&bar[XB_XSUB(x)], 1u);
    const unsigned gen = old / nloc;
    if (old + 1u == (gen + 1u) * nloc) {
      __builtin_amdgcn_fence(__ATOMIC_RELEASE, "agent");
      asm volatile("s_waitcnt vmcnt(0)" ::: "memory");
      const unsigned og = xb_add(&bar[XB_TOP], 1u);
      const unsigned tg = og / nx;
      if (og + 1u == (tg + 1u) * nx) xb_add(&bar[XB_TOPGEN], 1u);
      else XB_SPIN(xb_ld(&bar[XB_TOPGEN]) == tg, bar);
      __builtin_amdgcn_fence(__ATOMIC_ACQUIRE, "agent");
      xb_add(&bar[XB_XGEN(x)], 1u);
      asm volatile("s_waitcnt vmcnt(0)" ::: "memory");
    } else {
      XB_SPIN(xb_ld(&bar[XB_XGEN(x)]) == gen, bar);
      __builtin_amdgcn_fence(__ATOMIC_ACQUIRE, "agent");
      asm volatile("s_waitcnt vmcnt(0)" ::: "memory");
    }
  }
  __syncthreads();
}
DI int launder_v(int x) { asm volatile("" : "+v"(x)); return x; }
DI int launder_s(int x) { asm volatile("" : "+s"(x)); return x; }
#define LAUNDER_IDS const int tid__ = launder_v((int)threadIdx.x); const int blk__ = launder_s((int)blockIdx.x); (void)tid__; (void)blk__;
DI void do_transpose(const float* __restrict__ src, int K, int N, u16* __restrict__ dst, const float* __restrict__ ksc, int perm, int tile, float* tl) {
  LAUNDER_IDS
  const int ntn = (N + 63) >> 6;
  const int kt = tile / ntn, nt = tile - kt * ntn;
  const int k0 = kt * 64, n0 = nt * 64;
  const int tid = tid__;
  __syncthreads();
#pragma unroll 4
  for (int i = 0; i < 16; ++i) {
    const int kk = i * 4 + (tid >> 6), nn = tid & 63;
    float v = 0.f;
    if (n0 + nn < N) v = src[(size_t)(k0 + kk) * N + n0 + nn];
    if (ksc) v *= ksc[k0 + kk];
    tl[kk * 65 + nn] = v;
  }
  __syncthreads();
#pragma unroll 4
  for (int i = 0; i < 16; ++i) {
    const int nn = i * 4 + (tid >> 6), kk = tid & 63;
    int n = n0 + nn;
    if (n < N) {
      if (perm) { const int h = n / 96, d = n - h * 96; n = d < 64 ? h * 64 + d : 512 + h * 32 + (d - 64); }
      dst[(size_t)n * K + k0 + kk] = f2bf(tl[kk * 65 + nn]);
    }
  }
}

DI void phase_prep(const Params& p, char* smem) {
  LAUNDER_IDS
  float* tl = (float*)smem;
  const int tid = tid__;
  constexpr int T_WIN = 16 * 81, T_UQ = 6 * 12, T_UKV = 4 * 16, T_BRM = 8 * 16, T_BRR = 4 * 16, T_WO = 16 * 16, T_W1 = 16 * 64, T_W2 = 64 * 16,
                T_RW2 = 4, T_RA2 = 4, T_RG2 = 2 * 4;
  constexpr int T_LAYER = T_WIN + T_UQ + T_UKV + T_BRM + T_BRR + T_WO + T_W1 + T_W2 + 2 * T_RW2 + 2 * T_RA2 + T_RG2;
  for (int g = blk__; g < 2 * T_LAYER; g += gridDim.x) {
    const int l = g / T_LAYER; int t = g - l * T_LAYER;
    char* wl = p.ws + OFF_W + (size_t)l * W_LAYER;
#define JOB(SRC, KK, NN, DSTOFF, SC, PERM, CNT) if (t < (CNT)) { do_transpose((SRC), (KK), (NN), (u16*)(wl + (DSTOFF)), (SC), (PERM), t, tl); continue; } t -= (CNT);
    JOB(p.in[I_WIN] + (size_t)l * 1024 * INC, 1024, INC, WO_WIN, nullptr, 0, T_WIN)
    JOB(p.in[I_WUQ] + (size_t)l * 384 * 768, 384, 768, WO_UQ, p.in[I_QNORM] + l * 384, 1, T_UQ)
    JOB(p.in[I_WUKV] + (size_t)l * 256 * 1024, 256, 1024, WO_UKV, p.in[I_KVNORM] + l * 256, 0, T_UKV)
    JOB(p.in[I_BRM] + (size_t)l * 512 * 1024, 512, 1024, WO_BRM, nullptr, 0, T_BRM)
    JOB(p.in[I_BRR] + (size_t)l * 256 * 1024, 256, 1024, WO_BRR, nullptr, 0, T_BRR)
    JOB(p.in[I_WO] + (size_t)l * 1024 * 1024, 1024, 1024, WO_WO, nullptr, 0, T_WO)
    JOB(p.in[I_W1] + (size_t)l * 1024 * 4096, 1024, 4096, WO_W1, nullptr, 0, T_W1)
    JOB(p.in[I_W2] + (size_t)l * 4096 * 1024, 4096, 1024, WO_W2, nullptr, 0, T_W2)
    JOB(p.in[I_W2R] + (size_t)(l * 2 + 0) * 64 * 256, 64, 256, WO_RW2, nullptr, 0, T_RW2)
    JOB(p.in[I_W2R] + (size_t)(l * 2 + 1) * 64 * 256, 64, 256, WO_RW2 + 256 * 64 * 2, nullptr, 0, T_RW2)
    JOB(p.in[I_A2R] + (size_t)(l * 2 + 0) * 64 * 256, 64, 256, WO_RA2, nullptr, 0, T_RA2)
    JOB(p.in[I_A2R] + (size_t)(l * 2 + 1) * 64 * 256, 64, 256, WO_RA2 + 256 * 64 * 2, nullptr, 0, T_RA2)
    JOB(p.in[I_G2R] + (size_t)l * 128 * 256, 128, 256, WO_RG2, nullptr, 0, T_RG2)
#undef JOB
  }
  for (int e = blk__ * 256 + tid; e < 2 * 256 * 1024; e += gridDim.x * 256) {
    const int l = e >> 18, r = e & 262143, cin = r >> 10, n = r & 1023, g = cin >> 6, c = cin & 63;
    const float* pw = p.in[I_POOLW] + ((size_t)(l * 4 + g) * 64 + c) * 64;
    const float* ps = p.in[I_POOLS] + l * 256 + g * 64;
    const float* wb = p.in[I_BRP] + ((size_t)l * 256 + g * 64) * 1024 + n;
    float s = 0.f;
    for (int d = 0; d < 64; ++d) s += pw[d] * ps[d] * wb[(size_t)d * 1024];
    ((u16*)(p.ws + OFF_W + (size_t)l * W_LAYER + WO_BRP))[(size_t)n * 256 + cin] = f2bf(s);
  }
  if (blk__ == gridDim.x - 1) {
    for (int e = tid; e < 512; e += 256) {
      const int pos = e >> 3, f = e & 7;
      const float inv = powf(10000.f, -(float)f / 8.f);
      const float ang = (float)pos * inv;
      float* rt = (float*)(p.ws + OFF_ROPE);
      rt[e * 2] = cosf(ang); rt[e * 2 + 1] = sinf(ang);
    }
  }
  {
    float* sl = (float*)smem;
    float* red = sl + 9 * 1024;
    __syncthreads();
    for (int e = tid; e < 9 * 1024; e += 256) {
      const int b = e >> 10, k = e & 1023;
      const float v = b < 8 ? p.in[I_C][b * 1024 + k] : p.in[I_CCTX][k];
      sl[e] = siluf_(v);
    }
    __syncthreads();
    const int wave = tid >> 6, lane = tid & 63;
    for (int it = blk__; it < 192; it += gridDim.x) {
      const int l = it / 96, cg_ = it - l * 96;
      const int col = cg_ * 64 + lane;
      const float* wa = p.in[I_WADA] + (size_t)l * 1024 * 6144 + col;
      float acc[9];
#pragma unroll
      for (int b = 0; b < 9; ++b) acc[b] = 0.f;
#pragma unroll 8
      for (int k = wave * 256; k < wave * 256 + 256; ++k) {
        const float w = wa[(size_t)k * 6144];
#pragma unroll
        for (int b = 0; b < 9; ++b) acc[b] += sl[b * 1024 + k] * w;
      }
#pragma unroll
      for (int b = 0; b < 9; ++b) red[(wave * 9 + b) * 64 + lane] = acc[b];
      __syncthreads();
      for (int e = tid; e < 9 * 64; e += 256) {
        const int b = e >> 6, c = e & 63;
        const float s = red[(0 * 9 + b) * 64 + c] + red[(1 * 9 + b) * 64 + c] + red[(2 * 9 + b) * 64 + c] + red[(3 * 9 + b) * 64 + c];
        ((float*)(p.ws + OFF_MODS))[(size_t)(l * 9 + b) * 6144 + cg_ * 64 + c] = s + p.in[I_BADA][l * 6144 + cg_ * 64 + c];
      }
      __syncthreads();
    }
  }
}

DI const float* xrow(const float* xl, const float* xc, int r) { return r < NTL ? xl + (size_t)r * D : xc + (size_t)(r - NTL) * D; }

DI void phase_norm(const float* xl, const float* xc, const float* tab  , u16* hb, int M) {
  LAUNDER_IDS
  const int wave = tid__ >> 6, lane = tid__ & 63;
  const int nw = gridDim.x * 4, rpw = (M + nw - 1) / nw;
  const int rbeg = (blk__ * 4 + wave) * rpw, rend = min(rbeg + rpw, M);
  int cur_b9 = -1;
  float4 g[4], sh[4];
#pragma unroll
  for (int i = 0; i < 4; ++i) { g[i] = make_float4(0.f, 0.f, 0.f, 0.f); sh[i] = g[i]; }
  float4 vn[4];
  if (rbeg < rend) {
    const float* xp0 = xrow(xl, xc, rbeg);
#pragma unroll
    for (int i = 0; i < 4; ++i) vn[i] = *(const float4*)(xp0 + i * 256 + lane * 4);
  }
  for (int r = rbeg; r < rend; ++r) {
    const int b9 = r < NTL ? r >> 12 : 8;
    float4 v[4];
#pragma unroll
    for (int i = 0; i < 4; ++i) v[i] = vn[i];
    {
      const float* xpn = xrow(xl, xc, min(r + 1, rend - 1));
#pragma unroll
      for (int i = 0; i < 4; ++i) vn[i] = *(const float4*)(xpn + i * 256 + lane * 4);
    }
    if (b9 != cur_b9) {
      cur_b9 = b9;
      const float* t = tab + b9 * 2048;
#pragma unroll
      for (int i = 0; i < 4; ++i) { g[i] = *(const float4*)(t + i * 256 + lane * 4); sh[i] = *(const float4*)(t + 1024 + i * 256 + lane * 4); }
    }
    float s = 0.f;
#pragma unroll
    for (int i = 0; i < 4; ++i) s += v[i].x * v[i].x + v[i].y * v[i].y + v[i].z * v[i].z + v[i].w * v[i].w;
    s = wavesum(s);
    const float rs = rsqrtf(s * (1.f / 1024.f) + 1e-6f);
#pragma unroll
    for (int i = 0; i < 4; ++i) {
      const int k = i * 256 + lane * 4;
      *(uint2*)(hb + (size_t)r * 1024 + k) = make_uint2(pack2(v[i].x * rs * g[i].x + sh[i].x, v[i].y * rs * g[i].y + sh[i].y), pack2(v[i].z * rs * g[i].z + sh[i].z, v[i].w * rs * g[i].w + sh[i].w));
    }
  }
}
DI void phase_tables(const Params& p) {
  LAUNDER_IDS
  const float* mods = (const float*)(p.ws + OFF_MODS);
  float* tab = (float*)(p.ws + OFF_TAB);
  for (int e = blk__ * 256 + tid__; e < 2 * 2 * 9 * 1024; e += gridDim.x * 256) {
    const int k = e & 1023, b9 = (e >> 10) % 9, ln = (e >> 10) / 9, l = ln >> 1, nrm = ln & 1;
    const float g = p.in[nrm ? I_N2G : I_N1G][l * 1024 + k];
    const float sh = mods[(size_t)(l * 9 + b9) * 6144 + (nrm * 3 + 0) * 1024 + k];
    const float sc = mods[(size_t)(l * 9 + b9) * 6144 + (nrm * 3 + 1) * 1024 + k];
    float* t = tab + ((size_t)(l * 2 + nrm) * 9 + b9) * 2048;
    t[k] = g * (1.f + sc); t[1024 + k] = sh;
  }
}

struct LoadBf16 {
  const u16* A; int lda;
  DI void init(int m0) {}
  DI uint4 load(int i, int m0, int k0) const {
    LAUNDER_IDS
    const int tid = tid__, kc = (tid & 7) * 8;
    return *(const uint4*)(A + (size_t)(m0 + (tid >> 3) + i * 32) * lda + k0 + kc);
  }
};
struct LoadNorm {
  const float* xl; const float* xc; const float* rs; const float* tab;
  float r0, r1, r2, r3;
  DI void init(int m0) {
    LAUNDER_IDS
    const int tid = tid__;
    r0 = rs[m0 + (tid >> 3)]; r1 = rs[m0 + (tid >> 3) + 32]; r2 = rs[m0 + (tid >> 3) + 64]; r3 = rs[m0 + (tid >> 3) + 96];
  }
  DI uint4 load(int i, int m0, int k0) const {
    LAUNDER_IDS
    const int tid = tid__, kc = (tid & 7) * 8;
    const int b9 = m0 < NTL ? m0 >> 12 : 8;
    const float* t = tab + b9 * 2048 + k0 + kc;
    const float4 g0 = *(const float4*)t, g1 = *(const float4*)(t + 4), s0 = *(const float4*)(t + 1024), s1 = *(const float4*)(t + 1028);
    const float* xp = xrow(xl, xc, m0 + (tid >> 3)) + k0 + kc + (size_t)i * 32 * D;
    const float4 x0 = *(const float4*)xp, x1 = *(const float4*)(xp + 4);
    const float rr = i == 0 ? r0 : i == 1 ? r1 : i == 2 ? r2 : r3;
    uint4 o;
    o.x = pack2(x0.x * rr * g0.x + s0.x, x0.y * rr * g0.y + s0.y);
    o.y = pack2(x0.z * rr * g0.z + s0.z, x0.w * rr * g0.w + s0.w);
    o.z = pack2(x1.x * rr * g1.x + s1.x, x1.y * rr * g1.y + s1.y);
    o.w = pack2(x1.z * rr * g1.z + s1.z, x1.w * rr * g1.w + s1.w);
    return o;
  }
};

DI bool tile_map(int it, int NTM, int NTN, int blk, int nblk, int& tm, int& tn) {
  const int xcd = blk & 7, local = blk >> 3, LB = nblk >> 3;
  const int R = NTM >> 3;
  const int s = it * LB + local;
  if (s >= R * NTN) return false;
  const int F = R >> 3, per_full = 8 * NTN;
  int mg, r, gm;
  if (s < F * per_full) { mg = s / per_full; r = s - mg * per_full; gm = 8; }
  else { mg = F; r = s - F * per_full; gm = R - F * 8; }
  const int ng = r / (gm * 8);
  const int r2 = r - ng * gm * 8;
  const int mi = r2 % gm, ni = r2 / gm;
  tm = xcd * R + mg * 8 + mi; tn = ng * 8 + ni;
  return true;
}
constexpr int LDT = 72;
template <int NI, class LA>
DI void gemm_mainloop(f32x4 (&acc)[4][NI], LA la, const u16* __restrict__ Bt, int ldb, int K, int m0, int n0, char* smem) {
  LAUNDER_IDS
  constexpr int NBI = NI;
  u16* As = (u16*)smem; u16* Bs = As + 2 * 128 * LDT;
  const int tid = tid__, lane = tid & 63, wave = tid >> 6, wr = wave >> 1, wc = wave & 1, lr = lane & 15, lq = lane >> 4;
  uint4 ra[4], rb[NBI];
  la.init(m0);
#pragma unroll
  for (int i = 0; i < 4; ++i) ra[i] = la.load(i, m0, 0);
#pragma unroll
  for (int i = 0; i < NBI; ++i) {
    const int c = tid + i * 256, row = c >> 3, kc = (c & 7) * 8;
    rb[i] = *(const uint4*)(Bt + (size_t)(n0 + row) * ldb + kc);
  }
#pragma unroll
  for (int i = 0; i < 4; ++i) {
    const int c = tid + i * 256, row = c >> 3, kc = (c & 7) * 8;
    *(uint4*)(As + row * LDT + kc) = ra[i];
    if (i < NBI) *(uint4*)(Bs + row * LDT + kc) = rb[i];
  }
  __syncthreads();
  const int nk = K >> 6;
  for (int kt = 0; kt < nk; ++kt) {
    const int cur = kt & 1;
    if (kt + 1 < nk) {
      const int k0 = (kt + 1) * 64;
#pragma unroll
      for (int i = 0; i < 4; ++i) ra[i] = la.load(i, m0, k0);
#pragma unroll
      for (int i = 0; i < NBI; ++i) {
        const int c = tid + i * 256, row = c >> 3, kc = (c & 7) * 8;
        rb[i] = *(const uint4*)(Bt + (size_t)(n0 + row) * ldb + k0 + kc);
      }
    }
    const u16* Ac = As + cur * 128 * LDT + (wr * 64 + lr) * LDT + lq * 8;
    const u16* Bc = Bs + cur * 128 * LDT + (wc * 16 * NI + lr) * LDT + lq * 8;
#pragma unroll
    for (int ks = 0; ks < 2; ++ks) {
      bf16x8 af[4], bfr[NI];
#pragma unroll
      for (int mi = 0; mi < 4; ++mi) af[mi] = *(const bf16x8*)(Ac + mi * 16 * LDT + ks * 32);
#pragma unroll
      for (int ni = 0; ni < NI; ++ni) bfr[ni] = *(const bf16x8*)(Bc + ni * 16 * LDT + ks * 32);
#pragma unroll
      for (int mi = 0; mi < 4; ++mi)
#pragma unroll
        for (int ni = 0; ni < NI; ++ni)
          acc[mi][ni] = __builtin_amdgcn_mfma_f32_16x16x32_bf16(bfr[ni], af[mi], acc[mi][ni], 0, 0, 0);
    }
    if (kt + 1 < nk) {
      const int nxt = cur ^ 1;
#pragma unroll
      for (int i = 0; i < 4; ++i) {
        const int c = tid + i * 256, row = c >> 3, kc = (c & 7) * 8;
        *(uint4*)(As + nxt * 128 * LDT + row * LDT + kc) = ra[i];
        if (i < NBI) *(uint4*)(Bs + nxt * 128 * LDT + row * LDT + kc) = rb[i];
      }
    }
    __syncthreads();
  }
}
template <int NI>
DI void zero_acc(f32x4 (&acc)[4][NI]) {
#pragma unroll
  for (int i = 0; i < 4; ++i)
#pragma unroll
    for (int j = 0; j < NI; ++j) acc[i][j] = f32x4{0.f, 0.f, 0.f, 0.f};
}
template <int MI, int NI>
DI void gemm256(f32x4 (&acc)[MI][NI], const u16* __restrict__ A, int lda, const u16* __restrict__ Bt, int ldb, int K, int m0, int n0, char* smem) {
  LAUNDER_IDS
  const int lane = tid__ & 63, wave = tid__ >> 6, wr = wave >> 1, wc = wave & 1, lr = lane & 15, lq = lane >> 4;
  constexpr int NAW = MI / 2;
  constexpr int NBW = NI / 2;
  constexpr int ABYTES = MI * 2 * 1024;
  constexpr int STAGE = ABYTES + NI * 2 * 1024;
  constexpr int LPS = NAW + NBW;
  static_assert(3 * STAGE <= 73728, "ring does not fit");
  const int srow = lane >> 2, scol = ((lane & 3) ^ ((lane >> 5) << 1)) * 8;
  const u16* Ag = A + (size_t)(m0 + wave * NAW * 16 + srow) * lda + scol;
  const u16* Bg = Bt + (size_t)(n0 + wave * NBW * 16 + srow) * ldb + scol;
  char* la = smem + (wave * NAW) * 1024 + lane * 16;
  char* lb = smem + ABYTES + (wave * NBW) * 1024 + lane * 16;
#define G256_ISSUE(S, K0) do { \
    _Pragma("unroll") for (int j_ = 0; j_ < NAW; ++j_) \
      __builtin_amdgcn_global_load_lds((const unsigned*)(Ag + (size_t)j_ * 16 * lda + (K0)), (__attribute__((address_space(3))) unsigned*)(la + (S) * STAGE + j_ * 1024), 16, 0, 0); \
    _Pragma("unroll") for (int j_ = 0; j_ < NBW; ++j_) \
      __builtin_amdgcn_global_load_lds((const unsigned*)(Bg + (size_t)j_ * 16 * ldb + (K0)), (__attribute__((address_space(3))) unsigned*)(lb + (S) * STAGE + j_ * 1024), 16, 0, 0); \
  } while (0)
  const int nk = K >> 5;
  G256_ISSUE(0, 0);
  if (nk > 1) G256_ISSUE(1, 32);
  const int foff = lr * 64 + ((lq ^ ((lr >> 3) << 1)) * 16);
  int st = 0;
  for (int kt = 0; kt < nk; ++kt) {
    if (kt + 1 < nk) asm volatile("s_waitcnt vmcnt(%0) lgkmcnt(0)" :: "n"(LPS) : "memory");
    else asm volatile("s_waitcnt vmcnt(0) lgkmcnt(0)" ::: "memory");
    __builtin_amdgcn_s_barrier();
    const char* sb = smem + st * STAGE + foff;
    bf16x8 af[MI], bfr[NI];
#pragma unroll
    for (int mi = 0; mi < MI; ++mi) af[mi] = *(const bf16x8*)(sb + (wr * MI + mi) * 1024);
#pragma unroll
    for (int ni = 0; ni < NI; ++ni) bfr[ni] = *(const bf16x8*)(sb + ABYTES + (wc * NI + ni) * 1024);
    __builtin_amdgcn_sched_barrier(0x0);
    if (kt + 2 < nk) { const int s2 = st >= 1 ? st - 1 : 2; G256_ISSUE(s2, (kt + 2) * 32); }
#pragma unroll
    for (int mi = 0; mi < MI; ++mi)
#pragma unroll
      for (int ni = 0; ni < NI; ++ni)
        acc[mi][ni] = __builtin_amdgcn_mfma_f32_16x16x32_bf16(bfr[ni], af[mi], acc[mi][ni], 0, 0, 0);
    st = st == 2 ? 0 : st + 1;
  }
  asm volatile("s_waitcnt lgkmcnt(0)" ::: "memory");
  __builtin_amdgcn_s_barrier();
#undef G256_ISSUE
}
template <int MI, int NI>
DI void zero_accm(f32x4 (&acc)[MI][NI]) {
#pragma unroll
  for (int i = 0; i < MI; ++i)
#pragma unroll
    for (int j = 0; j < NI; ++j) acc[i][j] = f32x4{0.f, 0.f, 0.f, 0.f};
}
#define EPI_BEGIN const int lr1_ = launder_v(lr), lq1_ = launder_v(lq), wr1_ = launder_v(wr), wc1_ = launder_v(wc); { const int lr = lr1_, lq = lq1_, wr = wr1_, wc = wc1_; (void)lr; (void)lq; (void)wr; (void)wc;
#define EPI_END }
DI uint4 widen16(uint2 a, uint2 b) {
  const auto r0 = __builtin_amdgcn_permlane16_swap(a.x, b.x, false, false);
  const auto r1 = __builtin_amdgcn_permlane16_swap(a.y, b.y, false, false);
  return make_uint4(r0[0], r1[0], r0[1], r1[1]);
}
#define WAVE_COORDS const int lane = tid__ & 63, wave = tid__ >> 6, wr = wave >> 1, wc = wave & 1, lr = lane & 15, lq = lane >> 4; (void)wr; (void)wc; (void)lr; (void)lq;

DI void phase_zgemm(const Params& p, int l, char* smem) {
  LAUNDER_IDS
  WAVE_COORDS
  const u16* Wt = (const u16*)(p.ws + OFF_W + (size_t)l * W_LAYER + WO_WIN);
  const u16* hb = (const u16*)(p.ws + OFF_HB1);
  u16* za = (u16*)(p.ws + OFF_R2); u16* zr = (u16*)(p.ws + OFF_R1);
  for (int it = 0;; ++it) {
    int tm, tn;
    if (!tile_map(it, NT / 256, 17, blk__, gridDim.x, tm, tn)) break;
    const int m0 = tm * 256, n0 = tn * 128;
    f32x4 acc[8][4]; zero_accm<8, 4>(acc);
    gemm256<8, 4>(acc, hb, 1024, Wt, 1024, 1024, m0, n0, smem);
    EPI_BEGIN
#pragma unroll
    for (int mi = 0; mi < 8; mi += 2) {
      const int m = m0 + wr * 128 + (mi + (lq & 1)) * 16 + lr;
#pragma unroll
      for (int ni = 0; ni < 4; ++ni) {
        const int n = n0 + wc * 64 + ni * 16 + (lq >> 1) * 8;
        const uint4 v = widen16(make_uint2(pack2(acc[mi][ni][0], acc[mi][ni][1]), pack2(acc[mi][ni][2], acc[mi][ni][3])),
                                make_uint2(pack2(acc[mi + 1][ni][0], acc[mi + 1][ni][1]), pack2(acc[mi + 1][ni][2], acc[mi + 1][ni][3])));
        if (n < ZA) *(uint4*)(za + (size_t)m * ZA + n) = v;
        else if (n < ZA + ZR) *(uint4*)(zr + (size_t)m * ZR + (n - ZA)) = v;
      }
    }
    EPI_END
  }
}

DI void phase_tokA(const Params& p, int l) {
  LAUNDER_IDS
  const int wave = tid__ >> 6, lane = tid__ & 63;
  const u16* za = (const u16*)(p.ws + OFF_R2);
  float* rsq = (float*)(p.ws + OFF_RSQ); float* rskv = (float*)(p.ws + OFF_RSKV);
  u16* krb = (u16*)(p.ws + OFF_KR);
  u16* pooled = (u16*)(p.ws + OFF_R4);
  const float* rt = (const float*)(p.ws + OFF_ROPE);
  const float* gk = p.in[I_GK] + l * 96;
  for (int r = blk__ * 4 + wave; r < NT; r += gridDim.x * 4) {
    const u16* z = za + (size_t)r * ZA;
    const bool lat = r < NTL;
    const int b = lat ? r >> 12 : (r - NTL) >> 8;
    const int t = lat ? r & 4095 : (r - NTL) & 255;
    const int Ls = lat ? L : LC;
    const int pos = lat ? t : 4096 + t;
    u16 zq[6], zk[4], pw[30], pc[4];
#pragma unroll
    for (int i = 0; i < 6; ++i) zq[i] = z[256 + i * 64 + lane];
#pragma unroll
    for (int i = 0; i < 4; ++i) zk[i] = z[640 + i * 64 + lane];
    const int d = lane & 31;
    const u16 kr_raw = z[896 + d];
    const float gkd = gk[64 + d];
    const int ri = d & 15;
    const int pp = ri < 8 ? (t >> 6) : (t & 63);
    const float cs = rt[(pp * 8 + (ri & 7)) * 2], sn = rt[(pp * 8 + (ri & 7)) * 2 + 1];
#pragma unroll
    for (int gi = 0; gi < 4; ++gi) {
      const int half = 1 << gi;
      pc[gi] = z[gi * 64 + lane];
#pragma unroll
      for (int j = 0; j < 2 * half; ++j) {
        const int qc = min(max(t - half + j, 0), Ls - 1);
        pw[2 * half - 2 + j] = z[(ptrdiff_t)(qc - t) * ZA + gi * 64 + lane];
      }
    }
    float sq = 0.f, skv = 0.f;
#pragma unroll
    for (int i = 0; i < 6; ++i) { const float v = bf2f(zq[i]); sq += v * v; }
#pragma unroll
    for (int i = 0; i < 4; ++i) { const float v = bf2f(zk[i]); skv += v * v; }
    sq = wavesum(sq); skv = wavesum(skv);
    const float rq = rsqrtf(sq * (1.f / 384.f) + 1e-6f), rkv = rsqrtf(skv * (1.f / 256.f) + 1e-6f);
    float kr = bf2f(kr_raw);
    float ss = rowsum16(kr * kr);
    { const int si = __builtin_bit_cast(int, ss);
      ss = __builtin_bit_cast(float, __builtin_amdgcn_readlane(si, 0)) + __builtin_bit_cast(float, __builtin_amdgcn_readlane(si, 16)); }
    kr = kr * rsqrtf(ss * (1.f / 32.f) + 1e-6f) * gkd;
    const float other = __shfl_xor(kr, 16, 64);
    const float rot = d < 16 ? kr * cs - other * sn : other * sn + kr * cs;
    const float outv = lat ? rot : kr;
    float pv[4];
#pragma unroll
    for (int gi = 0; gi < 4; ++gi) {
      const int half = 1 << gi;
      const int lo = max(t - half, 0), hi = min(t + half, Ls);
      float sm = 0.f;
#pragma unroll
      for (int j = 0; j < 2 * half; ++j) {
        const int q = t - half + j;
        sm += (q >= 0 && q < Ls) ? bf2f(pw[2 * half - 2 + j]) : 0.f;
      }
      pv[gi] = sm / (float)(hi - lo) - bf2f(pc[gi]);
    }
    if (lane == 0) { rsq[r] = rq; rskv[r] = rkv; }
    if (lane < 32) krb[(size_t)r * 32 + d] = f2bf(outv);
#pragma unroll
    for (int gi = 0; gi < 4; ++gi) pooled[(size_t)r * 256 + gi * 64 + lane] = f2bf(pv[gi]);
  }
}

constexpr int ZSL = 1160, TAL = 392;
DI void phase_tokB(const Params& p, int l, char* smem) {
  LAUNDER_IDS
  WAVE_COORDS
  const int tid = tid__;
  u16* Zs = (u16*)smem;
  u16* TA = Zs + 18 * ZSL;
  float* PV = (float*)(TA + 16 * TAL);
  const u16* zr = (const u16*)(p.ws + OFF_R1);
  const char* wl = p.ws + OFF_W + (size_t)l * W_LAYER;
  u16* sc = (u16*)(p.ws + OFF_R3);
  __syncthreads();
  for (int e = tid; e < 2 * ZR + 7 * 256; e += 256) {
    float v;
    if (e < 2 * ZR) v = p.in[I_MU][(size_t)l * 2 * ZR + e];
    else { const int f = e - 2 * ZR, a = f >> 8, c = f & 255;
      v = a == 0 ? p.in[I_KK][l * 256 + c] : a < 3 ? p.in[I_W0][(size_t)(l * 2 + a - 1) * 256 + c] : a < 5 ? p.in[I_A0][(size_t)(l * 2 + a - 3) * 256 + c] : p.in[I_KA][(size_t)(l * 2 + a - 5) * 256 + c]; }
    PV[e] = v;
  }
  const float* mu0 = PV; const float* mu1 = PV + ZR; const float* kkw = PV + 2 * ZR;
  const float* w0p = kkw + 256; const float* a0p = w0p + 512; const float* kap = a0p + 512;
  for (int tile = blk__; tile < NT / 16; tile += gridDim.x) {
    const int r0 = tile * 16;
    const bool lat = r0 < NTL;
    const int t0 = lat ? r0 & 4095 : (r0 - NTL) & 255;
    const int Ls = lat ? L : LC;
    __syncthreads();
    {
      uint4 v[11];
#pragma unroll
      for (int i = 0; i < 11; ++i) {
        const int c = tid + i * 256;
        const int ri = c / 144, ch = c - ri * 144;
        const int tt = t0 - 1 + ri;
        const int cc = min(c, 18 * 144 - 1);
        const int rc = cc / 144, chc = cc - rc * 144;
        const int ttc = min(max(t0 - 1 + rc, 0), Ls - 1);
        const uint4 ld = *(const uint4*)(zr + (size_t)(r0 - t0 + ttc) * ZR + chc * 8);
        const bool ok = (c < 18 * 144) && (tt >= 0) && (tt < Ls);
        v[i] = ok ? ld : make_uint4(0, 0, 0, 0);
      }
#pragma unroll
      for (int i = 0; i < 11; ++i) {
        const int c = tid + i * 256;
        const int ri = c / 144, ch = c - ri * 144;
        if (c < 18 * 144) {
          *(uint2*)(Zs + ri * ZSL + ch * 8) = make_uint2(v[i].x, v[i].y);
          *(uint2*)(Zs + ri * ZSL + ch * 8 + 4) = make_uint2(v[i].z, v[i].w);
        }
      }
    }
    __syncthreads();
#pragma unroll 4
    for (int e = tid; e < 16 * 384; e += 256) {
      const int i = e / 384, c = e - i * 384, zc = 768 + c;
      const float z = bf2f(Zs[(i + 1) * ZSL + zc]), zp = bf2f(Zs[i * ZSL + zc]), zn = bf2f(Zs[(i + 2) * ZSL + zc]);
      float v = z + mu0[zc] * (zp - z) + mu1[zc] * (zn - z);
      if (c < 128) v = 1.f - 2.f / (1.f + __expf(2.f * v)); else if (c >= 256) v = sigmoidf_(v);
      TA[i * TAL + c] = f2bf(v);
    }
    __syncthreads();
    const int row = r0 + lr;
    auto shifted4 = [&](int zc, float (&out)[4]) {
      const uint2 c0 = *(const uint2*)(Zs + (lr + 1) * ZSL + zc), cp = *(const uint2*)(Zs + lr * ZSL + zc), cn = *(const uint2*)(Zs + (lr + 2) * ZSL + zc);
      const float4 m0 = *(const float4*)(mu0 + zc), m1 = *(const float4*)(mu1 + zc);
      float z, zp, zn;
      z = bflo(c0.x); zp = bflo(cp.x); zn = bflo(cn.x); out[0] = z + m0.x * (zp - z) + m1.x * (zn - z);
      z = bfhi(c0.x); zp = bfhi(cp.x); zn = bfhi(cn.x); out[1] = z + m0.y * (zp - z) + m1.y * (zn - z);
      z = bflo(c0.y); zp = bflo(cp.y); zn = bflo(cn.y); out[2] = z + m0.z * (zp - z) + m1.z * (zn - z);
      z = bfhi(c0.y); zp = bfhi(cp.y); zn = bfhi(cn.y); out[3] = z + m0.w * (zp - z) + m1.w * (zn - z);
    };
    auto product128 = [&](f32x4 (&ac)[4], const u16* W, int off) {
      bf16x8 aop[4][4];
#pragma unroll
      for (int ks = 0; ks < 4; ++ks)
#pragma unroll
        for (int ni = 0; ni < 4; ++ni) aop[ks][ni] = *(const bf16x8*)(W + (size_t)(wave * 64 + ni * 16 + lr) * 128 + ks * 32 + lq * 8);
#pragma unroll
      for (int ni = 0; ni < 4; ++ni) ac[ni] = f32x4{0.f, 0.f, 0.f, 0.f};
#pragma unroll
      for (int ks = 0; ks < 4; ++ks) {
        const bf16x8 bop = *(const bf16x8*)(TA + lr * TAL + off + ks * 32 + lq * 8);
#pragma unroll
        for (int ni = 0; ni < 4; ++ni) ac[ni] = __builtin_amdgcn_mfma_f32_16x16x32_bf16(aop[ks][ni], bop, ac[ni], 0, 0, 0);
      }
      __builtin_amdgcn_sched_barrier(0);
    };
    auto product64x2 = [&](f32x4 (&ac0)[4], f32x4 (&ac1)[4], const u16* W0, const u16* W1, int off0, int off1) {
      bf16x8 a0[2][4], a1[2][4];
#pragma unroll
      for (int ks = 0; ks < 2; ++ks)
#pragma unroll
        for (int ni = 0; ni < 4; ++ni) {
          a0[ks][ni] = *(const bf16x8*)(W0 + (size_t)(wave * 64 + ni * 16 + lr) * 64 + ks * 32 + lq * 8);
          a1[ks][ni] = *(const bf16x8*)(W1 + (size_t)(wave * 64 + ni * 16 + lr) * 64 + ks * 32 + lq * 8);
        }
#pragma unroll
      for (int ni = 0; ni < 4; ++ni) { ac0[ni] = f32x4{0.f, 0.f, 0.f, 0.f}; ac1[ni] = f32x4{0.f, 0.f, 0.f, 0.f}; }
#pragma unroll
      for (int ks = 0; ks < 2; ++ks) {
        const bf16x8 b0 = *(const bf16x8*)(TA + lr * TAL + off0 + ks * 32 + lq * 8);
        const bf16x8 b1 = *(const bf16x8*)(TA + lr * TAL + off1 + ks * 32 + lq * 8);
#pragma unroll
        for (int ni = 0; ni < 4; ++ni) {
          ac0[ni] = __builtin_amdgcn_mfma_f32_16x16x32_bf16(a0[ks][ni], b0, ac0[ni], 0, 0, 0);
          ac1[ni] = __builtin_amdgcn_mfma_f32_16x16x32_bf16(a1[ks][ni], b1, ac1[ni], 0, 0, 0);
        }
      }
      __builtin_amdgcn_sched_barrier(0);
    };
    float ss = 0.f;
#pragma unroll
    for (int ni = 0; ni < 4; ++ni) {
      const int ch = wave * 64 + ni * 16 + lq * 4;
      float kx[4]; shifted4(256 + ch, kx);
      const float4 kw = *(const float4*)(kkw + ch);
      const float a0 = kx[0] * kw.x, a1 = kx[1] * kw.y, a2 = kx[2] * kw.z, a3 = kx[3] * kw.w;
      ss += a0 * a0 + a1 * a1 + a2 * a2 + a3 * a3;
    }
    ss += __shfl_xor(ss, 16, 64); ss += __shfl_xor(ss, 32, 64);
    const float kinv = rsqrtf(fmaxf(ss, 1e-24f));
    {
      f32x4 ag[4];
      product128(ag, (const u16*)(wl + WO_RG2), 256);
#pragma unroll
      for (int ni = 0; ni < 4; ++ni) {
        const int ch = wave * 64 + ni * 16 + lq * 4;
        const size_t o = (size_t)row * 256 + ch;
        float rx[4], kx[4], vx[4];
        shifted4(ch, rx); shifted4(256 + ch, kx); shifted4(512 + ch, vx);
        const float4 kw = *(const float4*)(kkw + ch);
        *(uint2*)(sc + SA_R * (size_t)NT * 256 + o) = make_uint2(pack2(rx[0], rx[1]), pack2(rx[2], rx[3]));
        *(uint2*)(sc + SA_V * (size_t)NT * 256 + o) = make_uint2(pack2(vx[0], vx[1]), pack2(vx[2], vx[3]));
        *(uint2*)(sc + SA_KKN * (size_t)NT * 256 + o) = make_uint2(pack2(-kx[0] * kw.x * kinv, -kx[1] * kw.y * kinv), pack2(-kx[2] * kw.z * kinv, -kx[3] * kw.w * kinv));
        *(uint2*)(sc + SA_G * (size_t)NT * 256 + o) = make_uint2(pack2(ag[ni][0], ag[ni][1]), pack2(ag[ni][2], ag[ni][3]));
        __builtin_amdgcn_sched_barrier(0);
      }
    }
#pragma unroll 1
    for (int d = 0; d < 2; ++d) {
      f32x4 aw[4], aa[4];
      product64x2(aw, aa, (const u16*)(wl + WO_RW2) + (size_t)d * 256 * 64, (const u16*)(wl + WO_RA2) + (size_t)d * 256 * 64, d * 64, 128 + d * 64);
      u16* oOMW = sc + (d ? SA_OMWB : SA_OMWF) * (size_t)NT * 256;
      u16* oKD = sc + (d ? SA_KDB : SA_KDF) * (size_t)NT * 256;
      u16* oB = sc + (d ? SA_BB : SA_BF) * (size_t)NT * 256;
#pragma unroll
      for (int ni = 0; ni < 4; ++ni) {
        const int ch = wave * 64 + ni * 16 + lq * 4;
        const size_t o = (size_t)row * 256 + ch;
        float kx[4]; shifted4(256 + ch, kx);
        const float4 kw = *(const float4*)(kkw + ch);
        const float kkn[4] = {kx[0] * kw.x * kinv, kx[1] * kw.y * kinv, kx[2] * kw.z * kinv, kx[3] * kw.w * kinv};
        const float4 w0 = *(const float4*)(w0p + d * 256 + ch);
        const float4 a0 = *(const float4*)(a0p + d * 256 + ch);
        const float4 ka = *(const float4*)(kap + d * 256 + ch);
        const float w0a[4] = {w0.x, w0.y, w0.z, w0.w}, a0a[4] = {a0.x, a0.y, a0.z, a0.w}, kaa[4] = {ka.x, ka.y, ka.z, ka.w};
        float omw[4], kd[4], bb[4];
#pragma unroll
        for (int j = 0; j < 4; ++j) {
          const float xw = -(w0a[j] + aw[ni][j]);
          const float sp = fmaxf(xw, 0.f) + __logf(1.f + __expf(-fabsf(xw)));
          const float wlog = -sp - 0.5f;
          const float e = __expf(wlog);
          omw[j] = 1.f - __expf(-e);
          const float a = sigmoidf_(a0a[j] + aa[ni][j]);
          kd[j] = kx[j] * (1.f + (a - 1.f) * kaa[j]);
          bb[j] = kkn[j] * a;
        }
        *(uint2*)(oOMW + o) = make_uint2(pack2(omw[0], omw[1]), pack2(omw[2], omw[3]));
        *(uint2*)(oKD + o) = make_uint2(pack2(kd[0], kd[1]), pack2(kd[2], kd[3]));
        *(uint2*)(oB + o) = make_uint2(pack2(bb[0], bb[1]), pack2(bb[2], bb[3]));
        __builtin_amdgcn_sched_barrier(0);
      }
    }
  }
}

DI size_t qk_index(int m, int h) {
  const bool lat = m < NTL;
  const int b = lat ? m >> 12 : (m - NTL) >> 8;
  const int pos = lat ? m & 4095 : 4096 + ((m - NTL) & 255);
  return ((size_t)(b * 8 + h) * LK + pos) * 96;
}
DI void phase_qkv(const Params& p, int l, char* smem) {
  LAUNDER_IDS
  WAVE_COORDS
  const char* wl = p.ws + OFF_W + (size_t)l * W_LAYER;
  const u16* za = (const u16*)(p.ws + OFF_R2);
  const float* rsq0 = (const float*)(p.ws + OFF_RSQ); const float* rskv0 = (const float*)(p.ws + OFF_RSKV);
  u16* Qb = (u16*)(p.ws + OFF_R1); u16* Kb = (u16*)(p.ws + OFF_R1 + SZ_Q); u16* Vt = (u16*)(p.ws + OFF_R1 + 2 * SZ_Q);
  const float* rt0 = (const float*)(p.ws + OFF_ROPE);
  const float* gq0 = p.in[I_GQ] + l * 96; const float* gk0 = p.in[I_GK] + l * 96;
  const float QS = 0.10206207261596577f * 1.4426950408889634f;
  constexpr int NTM = NT / 256;
  for (int it = 0;; ++it) {
    int tm, tn;
    if (!tile_map(it, NTM, 6, blk__, gridDim.x, tm, tn)) break;
    f32x4 acc[8][4]; zero_accm<8, 4>(acc);
    {
      const int m0 = tm * 256, n0 = tn * 128;
      gemm256<8, 4>(acc, za + 256, ZA, (const u16*)(wl + WO_UQ), 384, 384, m0, n0, smem);
      EPI_BEGIN
      const float* gq = gq0; const float* rt = rt0; const float* rsq = rsq0;
      asm volatile("" : "+v"(gq), "+v"(rt), "+v"(rsq));
      const int nw = n0 + wc * 64;
#pragma unroll
      for (int mi = 0; mi < 8; ++mi) {
        __builtin_amdgcn_sched_barrier(0);
        const int m = m0 + wr * 128 + mi * 16 + lr;
        const float rs = rsq[m];
        if (nw < 512) {
          const int h = nw >> 6;
          float ss = 0.f;
#pragma unroll
          for (int ni = 0; ni < 4; ++ni)
#pragma unroll
            for (int j = 0; j < 4; ++j) { const float v = acc[mi][ni][j] * rs; ss += v * v; }
          ss += __shfl_xor(ss, 16, 64); ss += __shfl_xor(ss, 32, 64);
          const float f = rs * rsqrtf(ss * (1.f / 64.f) + 1e-6f) * QS;
          u16* dst = Qb + qk_index(m, h);
#pragma unroll
          for (int ni = 0; ni < 4; ++ni) {
            const int d = ni * 16 + lq * 4;
            const float4 g = *(const float4*)(gq + d);
            *(uint2*)(dst + d) = make_uint2(pack2(acc[mi][ni][0] * f * g.x, acc[mi][ni][1] * f * g.y), pack2(acc[mi][ni][2] * f * g.z, acc[mi][ni][3] * f * g.w));
          }
        } else {
          const bool lat = m < NTL;
          const int tt = m & 4095;
#pragma unroll
          for (int hh = 0; hh < 2; ++hh) {
            __builtin_amdgcn_sched_barrier(0);
            const int h = ((nw - 512) >> 5) + hh;
            float ss = 0.f;
#pragma unroll
            for (int ni = 0; ni < 2; ++ni)
#pragma unroll
              for (int j = 0; j < 4; ++j) { const float v = acc[mi][hh * 2 + ni][j] * rs; ss += v * v; }
            ss += __shfl_xor(ss, 16, 64); ss += __shfl_xor(ss, 32, 64);
            const float f = rs * rsqrtf(ss * (1.f / 32.f) + 1e-6f) * QS;
            const int i0 = lq * 4;
            const float4 g1 = *(const float4*)(gq + 64 + i0), g2 = *(const float4*)(gq + 80 + i0);
            const float g1a[4] = {g1.x, g1.y, g1.z, g1.w}, g2a[4] = {g2.x, g2.y, g2.z, g2.w};
            float o1[4], o2[4];
#pragma unroll
            for (int j = 0; j < 4; ++j) {
              const float x1 = acc[mi][hh * 2][j] * f * g1a[j], x2 = acc[mi][hh * 2 + 1][j] * f * g2a[j];
              float cs = 1.f, sn = 0.f;
              if (lat) {
                const int i = i0 + j;
                const int pp = i < 8 ? (tt >> 6) : (tt & 63);
                cs = rt[(pp * 8 + (i & 7)) * 2]; sn = rt[(pp * 8 + (i & 7)) * 2 + 1];
              }
              o1[j] = x1 * cs - x2 * sn; o2[j] = x1 * sn + x2 * cs;
            }
            u16* dst = Qb + qk_index(m, h) + 64;
            *(uint2*)(dst + i0) = make_uint2(pack2(o1[0], o1[1]), pack2(o1[2], o1[3]));
            *(uint2*)(dst + 16 + i0) = make_uint2(pack2(o2[0], o2[1]), pack2(o2[2], o2[3]));
          }
        }
      }
      EPI_END
    }
  }
  __builtin_amdgcn_sched_barrier(0);
  for (int it = 0;; ++it) {
    int tm, tn;
    if (!tile_map(it, NTM, 8, blk__, gridDim.x, tm, tn)) break;
    f32x4 acc[8][4]; zero_accm<8, 4>(acc);
    {
      const int h = tn, m0 = tm * 256, n0 = h * 128;
      gemm256<8, 4>(acc, za + 640, ZA, (const u16*)(wl + WO_UKV), 256, 256, m0, n0, smem);
      EPI_BEGIN
      const float* gk = gk0; const float* rskv = rskv0;
      asm volatile("" : "+v"(gk), "+v"(rskv));
#pragma unroll
      for (int mi = 0; mi < 8; ++mi) {
        __builtin_amdgcn_sched_barrier(0);
        const int m = m0 + wr * 128 + mi * 16 + lr;
        const float rs = rskv[m];
        if (wc == 0) {
          float ss = 0.f;
#pragma unroll
          for (int ni = 0; ni < 4; ++ni)
#pragma unroll
            for (int j = 0; j < 4; ++j) { const float v = acc[mi][ni][j] * rs; ss += v * v; }
          ss += __shfl_xor(ss, 16, 64); ss += __shfl_xor(ss, 32, 64);
          const float f = rs * rsqrtf(ss * (1.f / 64.f) + 1e-6f);
          u16* dst = Kb + qk_index(m, h);
#pragma unroll
          for (int ni = 0; ni < 4; ++ni) {
            const int d = ni * 16 + lq * 4;
            const float4 g = *(const float4*)(gk + d);
            *(uint2*)(dst + d) = make_uint2(pack2(acc[mi][ni][0] * f * g.x, acc[mi][ni][1] * f * g.y), pack2(acc[mi][ni][2] * f * g.z, acc[mi][ni][3] * f * g.w));
          }
          *(uint4*)(dst + 64 + lq * 8) = *(const uint4*)((const u16*)(p.ws + OFF_KR) + (size_t)m * 32 + lq * 8);
        } else {
          const bool lat = m < NTL;
          const int b = lat ? m >> 12 : (m - NTL) >> 8;
          const int pos = lat ? m & 4095 : 4096 + ((m - NTL) & 255);
          u16* dst = Vt + (size_t)(b * 8 + h) * 64 * LK + pos + (size_t)(lq * 4) * LK;
#pragma unroll
          for (int ni = 0; ni < 4; ++ni) {
            asm volatile("" : "+v"(dst));
#pragma unroll
            for (int j = 0; j < 4; ++j) dst[j * LK] = f2bf(acc[mi][ni][j] * rs);
            dst += 16 * LK;
          }
        }
      }
      EPI_END
    }
  }
}

DI int scan_row(int b, int dir, int s) {
  if (s < LC) return NTL + b * LC + (dir ? LC - 1 - s : s);
  const int t = s - LC;
  return b * L + (dir ? L - 1 - t : t);
}
DI void phase_scan(const Params& p, char* smem) {
  LAUNDER_IDS
  const int blk = blk__;
  if (blk >= 256) return;
  const int tid = tid__, lane = tid & 63, wave = tid >> 6, kq = lane & 15, rg = lane >> 4;
  const int chain = (blk & 7) + 8 * (blk >> 5), quarter = (blk >> 3) & 3;
  const int b = chain >> 3, h = (chain >> 1) & 3, dir = chain & 1;
  const u16* sc = (const u16*)(p.ws + OFF_R3);
  const size_t AS = (size_t)NT * 256;
  const u16* aOMW = sc + (dir ? SA_OMWB : SA_OMWF) * AS;
  const u16* aKD = sc + (dir ? SA_KDB : SA_KDF) * AS;
  const u16* aB = sc + (dir ? SA_BB : SA_BF) * AS;
  const u16* aKKN = sc + SA_KKN * AS;
  const u16* aR = sc + SA_R * AS;
  const u16* aV = sc + SA_V * AS;
  u16* Y = (u16*)(p.ws + OFF_R2) + (dir ? AS : 0);
  constexpr int CH = 16, BSZ = 5 * CH * 64 + CH * 16;
  float* buf = (float*)smem;
  const int st_ld = tid >> 4, k4 = (tid & 15) * 4;
  const int vrow = quarter * 16 + wave * 4 + rg;
  uint2 g0, g1, g2, g3, g4; u16 gv;
#define SCAN_GLOAD(CHUNK) do { \
    const int row_ = scan_row(b, dir, (CHUNK) * CH + st_ld); \
    const size_t o_ = (size_t)row_ * 256 + h * 64 + k4; \
    g0 = *(const uint2*)(aOMW + o_); g1 = *(const uint2*)(aKD + o_); g2 = *(const uint2*)(aB + o_); g3 = *(const uint2*)(aKKN + o_); g4 = *(const uint2*)(aR + o_); \
    gv = aV[(size_t)row_ * 256 + h * 64 + quarter * 16 + (tid & 15)]; } while (0)
#define SCAN_LSTORE(BI) do { \
    float* bb_ = buf + (BI) * BSZ + st_ld * 64 + k4; \
    *(float4*)(bb_ + 0 * CH * 64) = make_float4(1.f - bflo(g0.x), 1.f - bfhi(g0.x), 1.f - bflo(g0.y), 1.f - bfhi(g0.y)); \
    *(float4*)(bb_ + 1 * CH * 64) = make_float4(bflo(g1.x), bfhi(g1.x), bflo(g1.y), bfhi(g1.y)); \
    *(float4*)(bb_ + 2 * CH * 64) = make_float4(bflo(g2.x), bfhi(g2.x), bflo(g2.y), bfhi(g2.y)); \
    *(float4*)(bb_ + 3 * CH * 64) = make_float4(bflo(g3.x), bfhi(g3.x), bflo(g3.y), bfhi(g3.y)); \
    *(float4*)(bb_ + 4 * CH * 64) = make_float4(bflo(g4.x), bfhi(g4.x), bflo(g4.y), bfhi(g4.y)); \
    buf[(BI) * BSZ + 5 * CH * 64 + st_ld * 16 + (tid & 15)] = bf2f(gv); } while (0)
  float2_t S01 = {0.f, 0.f}, S23 = {0.f, 0.f};
  __builtin_amdgcn_s_setprio(3);
  __syncthreads();
  SCAN_GLOAD(0); SCAN_LSTORE(0);
  __syncthreads();
  constexpr int NCH = LK / CH;
  for (int c = 0; c < NCH; ++c) {
    if (c + 1 < NCH) SCAN_GLOAD(c + 1);
    const float* bb = buf + (c & 1) * BSZ;
    const int rowbase = scan_row(b, dir, c * CH);
    const int rstep = dir ? -1 : 1;
    const float* bl = bb + kq * 4;
    const float* bv = bb + 5 * CH * 64 + wave * 4 + rg;
    float4 fwv[3], fkv[3], fbv[3], fav[3], frv[3]; float vvv[3];
#pragma unroll
    for (int q = 0; q < 2; ++q) {
      fwv[q] = *(const float4*)(bl + 0 * CH * 64 + q * 64); fkv[q] = *(const float4*)(bl + 1 * CH * 64 + q * 64); fbv[q] = *(const float4*)(bl + 2 * CH * 64 + q * 64);
      fav[q] = *(const float4*)(bl + 3 * CH * 64 + q * 64); frv[q] = *(const float4*)(bl + 4 * CH * 64 + q * 64); vvv[q] = bv[q * 16];
    }
    float ysel = 0.f, ypart = 0.f;
#pragma unroll
    for (int s = 0; s < CH; ++s) {
      const float4 fw = fwv[s % 3], fk = fkv[s % 3], fb = fbv[s % 3], fa = fav[s % 3], fr = frv[s % 3];
      const float vv = vvv[s % 3];
      const float2_t a01 = {fa.x, fa.y}, a23 = {fa.z, fa.w};
      const float2_t w01 = {fw.x, fw.y}, w23 = {fw.z, fw.w}, k01 = {fk.x, fk.y}, k23 = {fk.z, fk.w}, b01 = {fb.x, fb.y}, b23 = {fb.z, fb.w};
      const float2_t r01 = {fr.x, fr.y}, r23 = {fr.z, fr.w};
      const float2_t vv2 = {vv, vv};
      if (s + 2 < CH) {
        constexpr int dummy = 0; (void)dummy;
        const int q = (s + 2) % 3;
        fwv[q] = *(const float4*)(bl + 0 * CH * 64 + (s + 2) * 64); fkv[q] = *(const float4*)(bl + 1 * CH * 64 + (s + 2) * 64); fbv[q] = *(const float4*)(bl + 2 * CH * 64 + (s + 2) * 64);
        fav[q] = *(const float4*)(bl + 3 * CH * 64 + (s + 2) * 64); frv[q] = *(const float4*)(bl + 4 * CH * 64 + (s + 2) * 64); vvv[q] = bv[(s + 2) * 16];
      }
      float2_t t2 = S01 * a01; t2 = S23 * a23 + t2;
      const float2_t q01 = S01 * w01 + vv2 * k01, q23 = S23 * w23 + vv2 * k23;
      float xs = t2.x + t2.y, ys = ypart;
      xs += __builtin_bit_cast(float, __builtin_amdgcn_update_dpp(0, __builtin_bit_cast(int, xs), 0x128, 0xf, 0xf, false));
      ys += __builtin_bit_cast(float, __builtin_amdgcn_update_dpp(0, __builtin_bit_cast(int, ys), 0x128, 0xf, 0xf, false));
      xs += __builtin_bit_cast(float, __builtin_amdgcn_update_dpp(0, __builtin_bit_cast(int, xs), 0x124, 0xf, 0xf, false));
      ys += __builtin_bit_cast(float, __builtin_amdgcn_update_dpp(0, __builtin_bit_cast(int, ys), 0x124, 0xf, 0xf, false));
      xs += __builtin_bit_cast(float, __builtin_amdgcn_update_dpp(0, __builtin_bit_cast(int, xs), 0x122, 0xf, 0xf, false));
      ys += __builtin_bit_cast(float, __builtin_amdgcn_update_dpp(0, __builtin_bit_cast(int, ys), 0x122, 0xf, 0xf, false));
      xs += __builtin_bit_cast(float, __builtin_amdgcn_update_dpp(0, __builtin_bit_cast(int, xs), 0x121, 0xf, 0xf, false));
      ys += __builtin_bit_cast(float, __builtin_amdgcn_update_dpp(0, __builtin_bit_cast(int, ys), 0x121, 0xf, 0xf, false));
      if (s > 0) ysel = (kq == s - 1) ? ys : ysel;
      const float2_t sa2 = {xs, xs};
      S01 = sa2 * b01 + q01; S23 = sa2 * b23 + q23;
      float2_t y2 = S01 * r01; y2 = S23 * r23 + y2;
      ypart = y2.x + y2.y;
    }
    { const float yl = rowsum16(ypart); ysel = (kq == CH - 1) ? yl : ysel; }
    Y[(size_t)(rowbase + rstep * kq) * 256 + h * 64 + vrow] = f2bf(ysel);
    if (c + 1 < NCH) SCAN_LSTORE((c + 1) & 1);
    __syncthreads();
  }
  __builtin_amdgcn_s_setprio(0);
#undef SCAN_GLOAD
#undef SCAN_LSTORE
}

constexpr int KSL = 104, VSL = 68;
template <int B0>
DI bf16x8 pack8(const f32x16& v) {
  uint4 pw;
  pw.x = pack2(v[B0 + 0], v[B0 + 1]); pw.y = pack2(v[B0 + 2], v[B0 + 3]); pw.z = pack2(v[B0 + 4], v[B0 + 5]); pw.w = pack2(v[B0 + 6], v[B0 + 7]);
  return __builtin_bit_cast(bf16x8, pw);
}
DI void pv_step(f32x16& o0, f32x16& o1, const u16* Vc, int r32, int kb, bf16x8 pf) {
  {
    const uint2 lo = *(const uint2*)(Vc + r32 * VSL + kb), hi2 = *(const uint2*)(Vc + r32 * VSL + kb + 8);
    const bf16x8 va = __builtin_bit_cast(bf16x8, make_uint4(lo.x, lo.y, hi2.x, hi2.y));
    o0 = __builtin_amdgcn_mfma_f32_32x32x16_bf16(va, pf, o0, 0, 0, 0);
  }
  {
    const uint2 lo = *(const uint2*)(Vc + (32 + r32) * VSL + kb), hi2 = *(const uint2*)(Vc + (32 + r32) * VSL + kb + 8);
    const bf16x8 va = __builtin_bit_cast(bf16x8, make_uint4(lo.x, lo.y, hi2.x, hi2.y));
    o1 = __builtin_amdgcn_mfma_f32_32x32x16_bf16(va, pf, o1, 0, 0, 0);
  }
}
DI void attn_item(const Params& p, int item, char* smem) {
  LAUNDER_IDS
  const int tid = tid__, lane = tid & 63, wave = tid >> 6, r32 = lane & 31, hi = lane >> 5;
  int bh, qpos0, key0, nkt, orow0;
  if (item < 2048) { bh = item >> 5; const int qb = item & 31; qpos0 = qb * 128; key0 = 0; nkt = LK / 64; orow0 = (bh >> 3) * L + qpos0; }
  else { const int it = item - 2048; bh = it >> 1; const int qb = it & 1; qpos0 = 4096 + qb * 128; key0 = 4096; nkt = LC / 64; orow0 = NTL + (bh >> 3) * LC + qb * 128; }
  const int h = bh & 7;
  const u16* Qp = (const u16*)(p.ws + OFF_R1) + ((size_t)bh * LK + qpos0 + wave * 32 + r32) * 96 + hi * 8;
  const u16* Kp = (const u16*)(p.ws + OFF_R1 + SZ_Q) + ((size_t)bh * LK + key0) * 96;
  const u16* Vp = (const u16*)(p.ws + OFF_R1 + 2 * SZ_Q) + (size_t)bh * 64 * LK + key0;
  u16* Ks = (u16*)smem;
  u16* Vs = Ks + 2 * 64 * KSL;
  bf16x8 qr[6];
#pragma unroll
  for (int d0 = 0; d0 < 6; ++d0) qr[d0] = *(const bf16x8*)(Qp + d0 * 16);
  uint4 ak0, ak1, ak2, av0, av1, bk0, bk1, bk2, bv0, bv1;
  const int kr0 = tid / 12, kc0 = tid - kr0 * 12, kr1 = (tid + 256) / 12, kc1 = (tid + 256) - kr1 * 12, kr2 = (tid + 512) / 12, kc2 = (tid + 512) - kr2 * 12;
  const int vd0 = tid >> 3, vc0 = tid & 7, vd1 = vd0 + 32;
#define gload(S, kt) do { \
    S##k0 = *(const uint4*)(Kp + (size_t)((kt) * 64 + kr0) * 96 + kc0 * 8); S##k1 = *(const uint4*)(Kp + (size_t)((kt) * 64 + kr1) * 96 + kc1 * 8); \
    S##k2 = *(const uint4*)(Kp + (size_t)((kt) * 64 + kr2) * 96 + kc2 * 8); \
    S##v0 = *(const uint4*)(Vp + (size_t)vd0 * LK + (kt) * 64 + vc0 * 8); S##v1 = *(const uint4*)(Vp + (size_t)vd1 * LK + (kt) * 64 + vc0 * 8); } while (0)
#define lstore(S, bi) do { \
    *(uint4*)(Ks + (bi) * 64 * KSL + kr0 * KSL + kc0 * 8) = S##k0; *(uint4*)(Ks + (bi) * 64 * KSL + kr1 * KSL + kc1 * 8) = S##k1; *(uint4*)(Ks + (bi) * 64 * KSL + kr2 * KSL + kc2 * 8) = S##k2; \
    { u16* dst = Vs + (bi) * 64 * VSL + vd0 * VSL + vc0 * 8; *(uint2*)dst = make_uint2(S##v0.x, S##v0.y); *(uint2*)(dst + 4) = make_uint2(S##v0.z, S##v0.w); } \
    { u16* dst = Vs + (bi) * 64 * VSL + vd1 * VSL + vc0 * 8; *(uint2*)dst = make_uint2(S##v1.x, S##v1.y); *(uint2*)(dst + 4) = make_uint2(S##v1.z, S##v1.w); } } while (0)
  f32x16 o0, o1;
#pragma unroll
  for (int i = 0; i < 16; ++i) { o0[i] = 0.f; o1[i] = 0.f; }
  float mrun = -1e30f, lrun = 0.f;
  auto tile_compute = [&](int cur) {
    const u16* Kc = Ks + cur * 64 * KSL;
    const u16* Vc = Vs + cur * 64 * VSL;
    f32x16 p0, p1;
#pragma unroll
    for (int i = 0; i < 16; ++i) { p0[i] = 0.f; p1[i] = 0.f; }
#pragma unroll
    for (int d0 = 0; d0 < 6; ++d0) {
      const bf16x8 a0 = *(const bf16x8*)(Kc + r32 * KSL + d0 * 16 + hi * 8);
      const bf16x8 a1 = *(const bf16x8*)(Kc + (32 + r32) * KSL + d0 * 16 + hi * 8);
      p0 = __builtin_amdgcn_mfma_f32_32x32x16_bf16(a0, qr[d0], p0, 0, 0, 0);
      p1 = __builtin_amdgcn_mfma_f32_32x32x16_bf16(a1, qr[d0], p1, 0, 0, 0);
    }
    float mx = p0[0];
#pragma unroll
    for (int i = 1; i < 16; ++i) mx = fmaxf(mx, p0[i]);
#pragma unroll
    for (int i = 0; i < 16; ++i) mx = fmaxf(mx, p1[i]);
    { auto rr = __builtin_amdgcn_permlane32_swap(__float_as_uint(mx), __float_as_uint(mx), false, false);
      mx = fmaxf(__uint_as_float(rr[0]), __uint_as_float(rr[1])); }
    if (!__all(mx - mrun <= 8.f)) {
      const float mn = fmaxf(mrun, mx);
      const float alpha = __builtin_amdgcn_exp2f(mrun - mn);
      mrun = mn; lrun *= alpha;
#pragma unroll
      for (int i = 0; i < 16; ++i) { o0[i] *= alpha; o1[i] *= alpha; }
    }
    float ps = 0.f;
#pragma unroll
    for (int i = 0; i < 16; ++i) { p0[i] = __builtin_amdgcn_exp2f(p0[i] - mrun); ps += p0[i]; }
#pragma unroll
    for (int i = 0; i < 16; ++i) { p1[i] = __builtin_amdgcn_exp2f(p1[i] - mrun); ps += p1[i]; }
    lrun += ps;
    pv_step(o0, o1, Vc, r32, 0 + hi * 4, pack8<0>(p0));
    pv_step(o0, o1, Vc, r32, 16 + hi * 4, pack8<8>(p0));
    pv_step(o0, o1, Vc, r32, 32 + hi * 4, pack8<0>(p1));
    pv_step(o0, o1, Vc, r32, 48 + hi * 4, pack8<8>(p1));
  };
  __syncthreads();
  gload(a, 0); lstore(a, 0);
  gload(a, 1);
  __syncthreads();
  for (int kt = 0; kt < nkt; kt += 2) {
    if (kt + 2 < nkt) gload(b, kt + 2);
    tile_compute(0);
    lstore(a, 1);
    __syncthreads();
    if (kt + 3 < nkt) gload(a, kt + 3);
    tile_compute(1);
    if (kt + 2 < nkt) lstore(b, 0);
    __syncthreads();
  }
  lrun += __shfl_xor(lrun, 32, 64);
  const float inv = 1.f / lrun;
  u16* om = (u16*)(p.ws + OFF_OMLA) + (size_t)(orow0 + wave * 32 + r32) * 512 + h * 64;
#pragma unroll
  for (int g = 0; g < 4; ++g) {
    const int d = 8 * g + 4 * hi;
    *(uint2*)(om + d) = make_uint2(pack2(o0[4 * g] * inv, o0[4 * g + 1] * inv), pack2(o0[4 * g + 2] * inv, o0[4 * g + 3] * inv));
    *(uint2*)(om + 32 + d) = make_uint2(pack2(o1[4 * g] * inv, o1[4 * g + 1] * inv), pack2(o1[4 * g + 2] * inv, o1[4 * g + 3] * inv));
  }
#undef gload
#undef lstore
}

DI void readout_row(const Params& p, int l, int r) {
  LAUNDER_IDS
  const int lane = tid__ & 63;
  const u16* sc = (const u16*)(p.ws + OFF_R3);
  const size_t AS = (size_t)NT * 256;
  const size_t o = (size_t)r * 256 + lane * 4;
  const u16* Yf = (const u16*)(p.ws + OFF_R2);
  const uint2 yf = *(const uint2*)(Yf + o), yb = *(const uint2*)(Yf + AS + o);
  const uint2 ur = *(const uint2*)(sc + SA_R * AS + o), uv = *(const uint2*)(sc + SA_V * AS + o);
  const uint2 kf = *(const uint2*)(sc + SA_KDF * AS + o), kb = *(const uint2*)(sc + SA_KDB * AS + o), ug = *(const uint2*)(sc + SA_G * AS + o);
  float y[4] = {bflo(yf.x) + bflo(yb.x), bfhi(yf.x) + bfhi(yb.x), bflo(yf.y) + bflo(yb.y), bfhi(yf.y) + bfhi(yb.y)};
  const float rr[4] = {bflo(ur.x), bfhi(ur.x), bflo(ur.y), bfhi(ur.y)};
  const float vv[4] = {bflo(uv.x), bfhi(uv.x), bflo(uv.y), bfhi(uv.y)};
  const float km[4] = {0.5f * (bflo(kf.x) + bflo(kb.x)), 0.5f * (bfhi(kf.x) + bfhi(kb.x)), 0.5f * (bflo(kf.y) + bflo(kb.y)), 0.5f * (bfhi(kf.y) + bfhi(kb.y))};
  const float gg[4] = {bflo(ug.x), bfhi(ug.x), bflo(ug.y), bfhi(ug.y)};
  const float4 rk4 = *(const float4*)(p.in[I_RK] + l * 256 + lane * 4);
  const float4 lw4 = *(const float4*)(p.in[I_LNW] + l * 256 + lane * 4);
  const float4 lb4 = *(const float4*)(p.in[I_LNB] + l * 256 + lane * 4);
  const float rk[4] = {rk4.x, rk4.y, rk4.z, rk4.w}, lw[4] = {lw4.x, lw4.y, lw4.z, lw4.w}, lb[4] = {lb4.x, lb4.y, lb4.z, lb4.w};
  float s = y[0] + y[1] + y[2] + y[3];
  s = rowsum16(s);
  const float mu = s * (1.f / 64.f);
  float q = 0.f, bn = 0.f;
#pragma unroll
  for (int j = 0; j < 4; ++j) { const float d = y[j] - mu; q += d * d; bn += rr[j] * km[j] * rk[j]; }
  q = rowsum16(q); bn = rowsum16(bn);
  const float rstd = rsqrtf(q * (1.f / 64.f) + 64e-5f);
  float ov[4];
#pragma unroll
  for (int j = 0; j < 4; ++j) ov[j] = ((y[j] - mu) * rstd * lw[j] + lb[j] + bn * vv[j]) * gg[j];
  u16* orw = (u16*)(p.ws + OFF_R3 + SA_KKN * SZ_TOK256 + (size_t)NT * 512 * 2);
  *(uint2*)(orw + o) = make_uint2(pack2(ov[0], ov[1]), pack2(ov[2], ov[3]));
}

DI void phase_attn(const Params& p, int l, char* smem) {
  LAUNDER_IDS
  __shared__ int qslot_sh;
  const int nattn = (l == 0) ? 2048 + 128 : 2048;
  unsigned* ctr = (unsigned*)(p.ws + OFF_BAR) + 16 + l * 16;
  for (;;) {
    __syncthreads();
    if (tid__ == 0) qslot_sh = (int)__hip_atomic_fetch_add(ctr, 1u, __ATOMIC_RELAXED, __HIP_MEMORY_SCOPE_AGENT);
    __syncthreads();
    const int it = qslot_sh;
    if (it >= nattn) break;
    attn_item(p, it, smem);
  }
}
DI void phase_readout(const Params& p, int l, int Mout) {
  LAUNDER_IDS
  const int wave = tid__ >> 6;
  for (int r = blk__ * 4 + wave; r < Mout; r += gridDim.x * 4) readout_row(p, l, r);
}

DI void phase_merge(const Params& p, int l, int Mout, char* smem) {
  LAUNDER_IDS
  WAVE_COORDS
  const char* wl = p.ws + OFF_W + (size_t)l * W_LAYER;
  const u16* hg = (const u16*)(p.ws + OFF_HBG);
  const u16* opool = (const u16*)(p.ws + OFF_R4);
  const u16* omla = (const u16*)(p.ws + OFF_OMLA);
  const u16* orw = (const u16*)(p.ws + OFF_R3 + SA_KKN * SZ_TOK256) + (size_t)NT * 512;
  u16* mo = (u16*)(p.ws + OFF_R1);
  const int ntm = Mout / 128;
  for (int it = 0;; ++it) {
    int tm, tn;
    if (!tile_map(it, ntm, 8, blk__, gridDim.x, tm, tn)) break;
    const int m0 = tm * 128, n0 = tn * 128;
    f32x4 msum[4][4]; zero_accm<4, 4>(msum);
#pragma unroll 1
    for (int br = 0; br < 3; ++br) {
      unsigned gpk[4][4][2];
      {
        f32x4 ag[4][4]; zero_accm<4, 4>(ag);
        gemm256<4, 4>(ag, hg, 1024, (const u16*)(wl + WO_WIN) + (size_t)(2080 + br * 1024) * 1024, 1024, 1024, m0, n0, smem);
#pragma unroll
        for (int mi = 0; mi < 4; ++mi)
#pragma unroll
          for (int ni = 0; ni < 4; ++ni) {
            gpk[mi][ni][0] = pack2(sigmoidf_(ag[mi][ni][0]), sigmoidf_(ag[mi][ni][1]));
            gpk[mi][ni][1] = pack2(sigmoidf_(ag[mi][ni][2]), sigmoidf_(ag[mi][ni][3]));
          }
      }
      __builtin_amdgcn_sched_barrier(0);
      f32x4 ab[4][4]; zero_accm<4, 4>(ab);
      {
        const int Kb = br == 1 ? 512 : 256;
        const u16* Ab = br == 0 ? opool : br == 1 ? omla : orw;
        const u16* Wb = (const u16*)(wl + (br == 0 ? WO_BRP : br == 1 ? WO_BRM : WO_BRR));
        gemm256<4, 4>(ab, Ab, Kb, Wb, Kb, Kb, m0, n0, smem);
      }
#pragma unroll
      for (int mi = 0; mi < 4; ++mi)
#pragma unroll
        for (int ni = 0; ni < 4; ++ni) {
          msum[mi][ni][0] += bflo(gpk[mi][ni][0]) * ab[mi][ni][0];
          msum[mi][ni][1] += bfhi(gpk[mi][ni][0]) * ab[mi][ni][1];
          msum[mi][ni][2] += bflo(gpk[mi][ni][1]) * ab[mi][ni][2];
          msum[mi][ni][3] += bfhi(gpk[mi][ni][1]) * ab[mi][ni][3];
        }
      __builtin_amdgcn_sched_barrier(0);
    }
    EPI_BEGIN
#pragma unroll
    for (int mi = 0; mi < 4; mi += 2) {
      const int m = m0 + wr * 64 + (mi + (lq & 1)) * 16 + lr;
#pragma unroll
      for (int ni = 0; ni < 4; ++ni) {
        const int n = n0 + wc * 64 + ni * 16 + (lq >> 1) * 8;
        *(uint4*)(mo + (size_t)m * 1024 + n) = widen16(make_uint2(pack2(msum[mi][ni][0], msum[mi][ni][1]), pack2(msum[mi][ni][2], msum[mi][ni][3])),
                                                       make_uint2(pack2(msum[mi + 1][ni][0], msum[mi + 1][ni][1]), pack2(msum[mi + 1][ni][2], msum[mi + 1][ni][3])));
      }
    }
    EPI_END
  }
}

template <int MI, int NI>
DI void resid_tile(const u16* A, int K, const u16* Bt, const float* gate, const float* xl_in, const float* xc_in, float* xl_out, float* xc_out,
                   int m0, int n0, char* smem) {
  LAUNDER_IDS
  WAVE_COORDS
  f32x4 acc[MI][NI]; zero_accm<MI, NI>(acc);
  gemm256<MI, NI>(acc, A, K, Bt, K, K, m0, n0, smem);
  EPI_BEGIN
#pragma unroll
  for (int mi = 0; mi < MI; ++mi) {
    const int m = m0 + wr * 16 * MI + mi * 16 + lr;
    const int b9 = m < NTL ? m >> 12 : 8;
    const float* xi = xrow(xl_in, xc_in, m);
    float* xo = m < NTL ? xl_out + (size_t)m * D : xc_out + (size_t)(m - NTL) * D;
#pragma unroll
    for (int ni = 0; ni < NI; ++ni) {
      const int n = n0 + wc * 16 * NI + ni * 16 + lq * 4;
      const float4 g = *(const float4*)(gate + (size_t)b9 * 6144 + n);
      const float4 xv = *(const float4*)(xi + n);
      float4 ov;
      ov.x = xv.x + g.x * acc[mi][ni][0]; ov.y = xv.y + g.y * acc[mi][ni][1]; ov.z = xv.z + g.z * acc[mi][ni][2]; ov.w = xv.w + g.w * acc[mi][ni][3];
      *(float4*)(xo + n) = ov;
    }
    __builtin_amdgcn_sched_barrier(0);
  }
  EPI_END
}
DI void phase_resid(const Params& p, const u16* A, int K, const u16* Bt, const float* gate  ,
                    const float* xl_in, const float* xc_in, float* xl_out, float* xc_out, int Mout, char* smem) {
  LAUNDER_IDS
  for (int it = 0;; ++it) {
    int tm, tn;
    if (!tile_map(it, NTL / 256, 8, blk__, gridDim.x, tm, tn)) break;
    resid_tile<8, 4>(A, K, Bt, gate, xl_in, xc_in, xl_out, xc_out, tm * 256, tn * 128, smem);
  }
  if (Mout > NTL) {
    for (int t = blk__; t < (NTC / 64) * 16; t += gridDim.x) {
      const int tm = t >> 4, tn = t & 15;
      resid_tile<2, 2>(A, K, Bt, gate, xl_in, xc_in, xl_out, xc_out, NTL + tm * 64, tn * 64, smem);
    }
  }
}
DI void phase_mlp1(const Params& p, int l, int Mout, char* smem) {
  LAUNDER_IDS
  WAVE_COORDS
  const char* wl = p.ws + OFF_W + (size_t)l * W_LAYER;
  const u16* hb = (const u16*)(p.ws + OFF_HB2);
  u16* U = (u16*)(p.ws + OFF_R1);
  const int ntm = Mout / 256;
  for (int it = 0;; ++it) {
    int tm, tn;
    if (!tile_map(it, ntm, 32, blk__, gridDim.x, tm, tn)) break;
    const int m0 = tm * 256, n0 = tn * 128;
    f32x4 acc[8][4]; zero_accm<8, 4>(acc);
    gemm256<8, 4>(acc, hb, 1024, (const u16*)(wl + WO_W1), 1024, 1024, m0, n0, smem);
    EPI_BEGIN
#pragma unroll
    for (int mi = 0; mi < 8; mi += 2) {
      const int m = m0 + wr * 128 + (mi + (lq & 1)) * 16 + lr;
#pragma unroll
      for (int ni = 0; ni < 4; ++ni) {
        const int n = n0 + wc * 64 + ni * 16 + (lq >> 1) * 8;
        float va[4], vb[4];
#pragma unroll
        for (int j = 0; j < 4; ++j) { const float a = fmaxf(acc[mi][ni][j], 0.f); va[j] = a * a; const float b = fmaxf(acc[mi + 1][ni][j], 0.f); vb[j] = b * b; }
        *(uint4*)(U + (size_t)m * DFF + n) = widen16(make_uint2(pack2(va[0], va[1]), pack2(va[2], va[3])), make_uint2(pack2(vb[0], vb[1]), pack2(vb[2], vb[3])));
      }
      __builtin_amdgcn_sched_barrier(0);
    }
    EPI_END
  }
}

__global__ void __launch_bounds__(256, 2) fwd_megakernel(Params pk) {
  __shared__ __attribute__((aligned(16))) char smem[73728];
  cg::grid_group grid = cg::this_grid();
  if (threadIdx.x == 0) { g_base_sh[0] = (unsigned long long)pk.ws; g_base_sh[1] = (unsigned long long)pk.out; }
  xcd_barrier_post((unsigned*)(pk.ws + OFF_BAR));
  __syncthreads();
  phase_prep(pk, smem);
  if (pk.ws == nullptr) grid.sync();
  xcd_barrier();
  phase_tables(pk);
  xcd_barrier();
#define CTXBUF ((float*)(p.ws + OFF_CTX))
#define XLP (l == 0 ? p.in[I_X] : (const float*)p.out)
#define XCP (l == 0 ? p.in[I_CTX] : (const float*)CTXBUF)
#define MOUT (l == 0 ? NT : NTL)
#define WLP (p.ws + OFF_W + (size_t)l * W_LAYER)
#define TABP(nrm) ((const float*)(p.ws + OFF_TAB) + (size_t)(l * 2 + (nrm)) * 9 * 2048)
#define MODP(j) ((const float*)(p.ws + OFF_MODS) + (size_t)l * 9 * 6144 + (j) * 1024)
#ifndef PROBE_Q
#define PROBE_Q -1
#endif
#pragma nounroll
  for (int ph = 0; ph < 22; ++ph) {
    const int l = ph >= 11 ? 1 : 0, q = ph - l * 11;
    Params p = pk;
    {
      asm volatile("" ::: "memory");
      unsigned long long w_ = g_base_sh[0], o_ = g_base_sh[1];
      unsigned wl_ = (unsigned)w_, wh_ = (unsigned)(w_ >> 32), ol_ = (unsigned)o_, oh_ = (unsigned)(o_ >> 32);
      wl_ = __builtin_amdgcn_readfirstlane(wl_); wh_ = __builtin_amdgcn_readfirstlane(wh_); ol_ = __builtin_amdgcn_readfirstlane(ol_); oh_ = __builtin_amdgcn_readfirstlane(oh_);
      asm volatile("" : "+s"(wl_), "+s"(wh_), "+s"(ol_), "+s"(oh_));
      p.ws = (char*)(((unsigned long long)wh_ << 32) | wl_); p.out = (float*)(((unsigned long long)oh_ << 32) | ol_);
    }
#pragma nounroll
    for (int rep = 0; rep < (q == PROBE_Q ? 2 : 1); ++rep)
    switch (q) {
      case 0: phase_norm(XLP, XCP, TABP(0), (u16*)(p.ws + OFF_HB1), NT); break;
      case 1: phase_zgemm(p, l, smem); break;
      case 2: phase_tokA(p, l); phase_tokB(p, l, smem); break;
      case 3: phase_qkv(p, l, smem); break;
      case 4: phase_scan(p, smem); phase_attn(p, l, smem); break;
      case 5: phase_norm(XLP, XCP, TABP(0), (u16*)(p.ws + OFF_HBG), MOUT); phase_readout(p, l, MOUT); break;
      case 6: phase_merge(p, l, MOUT, smem); break;
      case 7: phase_resid(p, (const u16*)(p.ws + OFF_R1), 1024, (const u16*)(WLP + WO_WO), MODP(2), XLP, XCP, p.out, CTXBUF, MOUT, smem); break;
      case 8: phase_norm(p.out, CTXBUF, TABP(1), (u16*)(p.ws + OFF_HB2), MOUT); break;
      case 9: phase_mlp1(p, l, MOUT, smem); break;
      default: phase_resid(p, (const u16*)(p.ws + OFF_R1), 4096, (const u16*)(WLP + WO_W2), MODP(5), p.out, CTXBUF, p.out, CTXBUF, MOUT, smem); break;
    }
    if (ph != 21) xcd_barrier();
  }
}

extern "C" void kernel_launch(void* const* d_in, const int* in_sizes, int n_in, void* d_out, int out_size, void* d_ws, size_t ws_size, hipStream_t stream) {
  static int grid_blocks = 0;
  if (!grid_blocks) {
    int dev = 0, cus = 0, per_cu = 0;
    hipGetDevice(&dev);
    hipDeviceGetAttribute(&cus, hipDeviceAttributeMultiprocessorCount, dev);
    hipOccupancyMaxActiveBlocksPerMultiprocessor(&per_cu, fwd_megakernel, 256, 0);
    if (per_cu > 2) per_cu = 2;
    if (per_cu < 1) per_cu = 1;
    grid_blocks = cus * per_cu;
    if (ws_size < WS_END) fprintf(stderr, "kernel_launch: workspace too small: %zu < %zu\n", ws_size, (size_t)WS_END);
  }
  Params p{};
  for (int i = 0; i < 34; ++i) p.in[i] = (const float*)d_in[i];
  p.out = (float*)d_out;
  p.ws = (char*)d_ws;
  hipMemsetAsync(d_ws, 0, 16384, stream);
  void* args[] = {&p};
  hipError_t e = hipLaunchCooperativeKernel((void*)fwd_megakernel, dim3(grid_blocks), dim3(256), args, 0, stream);
  if (e != hipSuccess) fprintf(stderr, "cooperative launch failed: %s (grid %d)\n", hipGetErrorString(e), grid_blocks);
}
```

```cpp
#include <hip/hip_runtime.h>
#include <hip/hip_cooperative_groups.h>
#include <stdint.h>
#include <cstdio>
namespace cg = cooperative_groups;

typedef unsigned short u16;
typedef __attribute__((ext_vector_type(8))) short bf16x8;
typedef __attribute__((ext_vector_type(4))) float f32x4;
typedef __attribute__((ext_vector_type(16))) float f32x16;
typedef __bf16 bf16x2_t __attribute__((ext_vector_type(2)));
typedef float float2_t __attribute__((ext_vector_type(2)));

#define DI __device__ __forceinline__

constexpr int D = 1024, NB = 8, L = 4096, LC = 256, LK = 4352;
constexpr int NTL = NB * L;
constexpr int NTC = NB * LC;
constexpr int NT = NTL + NTC;
constexpr int INC = 5152;
constexpr int ZA = 928;
constexpr int ZR = 1152;
constexpr int DFF = 4096;

constexpr size_t al256(size_t x) { return (x + 255) / 256 * 256; }
constexpr size_t OFF_BAR = 0;
constexpr size_t OFF_MODS = 16384;
constexpr size_t OFF_TAB = OFF_MODS + al256(2 * 9 * 6144 * 4);
constexpr size_t OFF_ROPE = OFF_TAB + al256(2 * 2 * 9 * 2 * 1024 * 4);
constexpr size_t OFF_RS1 = OFF_ROPE + 4096;
constexpr size_t OFF_RS2 = OFF_RS1 + al256(NT * 4);
constexpr size_t OFF_RSQ = OFF_RS2 + al256(NT * 4);
constexpr size_t OFF_RSKV = OFF_RSQ + al256(NT * 4);
constexpr size_t OFF_CTX = OFF_RSKV + al256(NT * 4);
constexpr size_t OFF_W = OFF_CTX + (size_t)NTC * D * 4;
constexpr size_t WO_WIN = 0;
constexpr size_t WO_UQ = WO_WIN + (size_t)INC * 1024 * 2;
constexpr size_t WO_UKV = WO_UQ + (size_t)768 * 384 * 2;
constexpr size_t WO_BRP = WO_UKV + (size_t)1024 * 256 * 2;
constexpr size_t WO_BRM = WO_BRP + (size_t)1024 * 256 * 2;
constexpr size_t WO_BRR = WO_BRM + (size_t)1024 * 512 * 2;
constexpr size_t WO_WO = WO_BRR + (size_t)1024 * 256 * 2;
constexpr size_t WO_W1 = WO_WO + (size_t)1024 * 1024 * 2;
constexpr size_t WO_W2 = WO_W1 + (size_t)4096 * 1024 * 2;
constexpr size_t WO_RW2 = WO_W2 + (size_t)1024 * 4096 * 2;
constexpr size_t WO_RA2 = WO_RW2 + (size_t)2 * 256 * 64 * 2;
constexpr size_t WO_RG2 = WO_RA2 + (size_t)2 * 256 * 64 * 2;
constexpr size_t W_LAYER = al256(WO_RG2 + (size_t)256 * 128 * 2);
constexpr size_t OFF_R1 = OFF_W + 2 * W_LAYER;
constexpr size_t SZ_Q = (size_t)NB * 8 * LK * 96 * 2;
constexpr size_t SZ_VT = (size_t)NB * 8 * 64 * LK * 2;
constexpr size_t SZ_R1 = 2 * SZ_Q + SZ_VT;
constexpr size_t OFF_R2 = OFF_R1 + al256(SZ_R1);
constexpr size_t SZ_TOK256 = (size_t)NT * 256 * 2;
constexpr size_t OFF_R3 = OFF_R2 + al256((size_t)NT * ZA * 2);
constexpr size_t OFF_R4 = OFF_R3 + 10 * SZ_TOK256;
constexpr size_t OFF_KR = OFF_R4 + SZ_TOK256;
constexpr size_t OFF_OMLA = OFF_KR + al256((size_t)NT * 32 * 2);
constexpr size_t WS_END = OFF_OMLA + (size_t)NT * 512 * 2;
static_assert(WS_END <= 536870912ull, "workspace map exceeds 4x the largest tensor");
constexpr size_t OFF_HB1 = OFF_R3;
constexpr size_t OFF_HBG = OFF_R1 + (size_t)NT * 1024 * 2;
constexpr size_t OFF_HB2 = OFF_R3 + 5 * SZ_TOK256;
enum { SA_R = 0, SA_V = 1, SA_KDF = 2, SA_KDB = 3, SA_G = 4, SA_KKN = 5, SA_OMWF = 6, SA_BF = 7, SA_OMWB = 8, SA_BB = 9 };

struct Params { const float* in[34]; float* out; char* ws; };

enum { I_X = 0, I_C, I_CTX, I_CCTX, I_N1G, I_N2G, I_WADA, I_BADA, I_WIN, I_POOLW, I_POOLS, I_QNORM, I_WUQ, I_KVNORM, I_WUKV,
       I_GQ, I_GK, I_MU, I_W0, I_W2R, I_A0, I_A2R, I_KA, I_KK, I_RK, I_G2R, I_LNW, I_LNB, I_BRP, I_BRM, I_BRR, I_WO, I_W1, I_W2 };

DI float bf2f(u16 h) { return __uint_as_float(((unsigned)h) << 16); }
DI float bflo(unsigned u) { return __uint_as_float(u << 16); }
DI float bfhi(unsigned u) { return __uint_as_float(u & 0xffff0000u); }
DI unsigned pack2(float a, float b) { float2_t v = {a, b}; bf16x2_t r = __builtin_convertvector(v, bf16x2_t); return __builtin_bit_cast(unsigned, r); }
DI u16 f2bf(float a) { return (u16)(pack2(a, 0.f) & 0xffffu); }
DI float sigmoidf_(float x) { return 1.f / (1.f + __expf(-x)); }
DI float siluf_(float x) { return x / (1.f + __expf(-x)); }
DI float rowsum16(float x) {
  x += __builtin_bit_cast(float, __builtin_amdgcn_update_dpp(0, __builtin_bit_cast(int, x), 0x128, 0xf, 0xf, false));
  x += __builtin_bit_cast(float, __builtin_amdgcn_update_dpp(0, __builtin_bit_cast(int, x), 0x124, 0xf, 0xf, false));
  x += __builtin_bit_cast(float, __builtin_amdgcn_update_dpp(0, __builtin_bit_cast(int, x), 0x122, 0xf, 0xf, false));
  x += __builtin_bit_cast(float, __builtin_amdgcn_update_dpp(0, __builtin_bit_cast(int, x), 0x121, 0xf, 0xf, false));
  return x;
}
DI float wavesum(float x) {
  x = rowsum16(x);
  const int xi = __builtin_bit_cast(int, x);
  return __builtin_bit_cast(float, __builtin_amdgcn_readlane(xi, 0)) + __builtin_bit_cast(float, __builtin_amdgcn_readlane(xi, 16)) +
         __builtin_bit_cast(float, __builtin_amdgcn_readlane(xi, 32)) + __builtin_bit_cast(float, __builtin_amdgcn_readlane(xi, 48));
}
DI void grid_barrier(unsigned* ctr, unsigned& epoch) {
  asm volatile("s_waitcnt vmcnt(0)" ::: "memory");
  __syncthreads();
  epoch++;
  if (threadIdx.x == 0) {
    __builtin_amdgcn_fence(__ATOMIC_RELEASE, "agent");
    asm volatile("s_waitcnt vmcnt(0)" ::: "memory");
    const unsigned target = epoch * gridDim.x;
    __hip_atomic_fetch_add(ctr, 1u, __ATOMIC_RELAXED, __HIP_MEMORY_SCOPE_AGENT);
    while (__hip_atomic_load(ctr, __ATOMIC_RELAXED, __HIP_MEMORY_SCOPE_AGENT) < target) __builtin_amdgcn_s_sleep(2);
    __builtin_amdgcn_fence(__ATOMIC_ACQUIRE, "agent");
    asm volatile("s_waitcnt vmcnt(0)" ::: "memory");
  }
  __syncthreads();
}


#define XB_TMO      128
#define XB_XCNT(j)  (256  + 64 * (j))
#define XB_XSUB(j)  (1280 + 64 * (j))
#define XB_XGEN(j)  (2304 + 64 * (j))
#define XB_TOP      3328
#define XB_TOPGEN   3392
#define XB_SPIN_CAP (1u << 22)
#define LAS __attribute__((address_space(3)))
DI unsigned xb_ld(unsigned* p)              { return __hip_atomic_load(p, __ATOMIC_RELAXED, __HIP_MEMORY_SCOPE_AGENT); }
DI unsigned xb_add(unsigned* p, unsigned v) { return __hip_atomic_fetch_add(p, v, __ATOMIC_RELAXED, __HIP_MEMORY_SCOPE_AGENT); }
DI unsigned xb_xcc_id() { return (unsigned)__builtin_amdgcn_s_getreg((3 << 11) | 20) & 0xFu; }
#define XB_SPIN(cond, bar) do { unsigned _sp = 0; while (cond) { __builtin_amdgcn_s_sleep(1); \
    if ((++_sp & 255u) == 0u) { if (xb_ld(&(bar)[XB_TMO])) break; if (_sp > XB_SPIN_CAP) { atomicAdd(&(bar)[XB_TMO], 1u); break; } } } } while (0)
__shared__ uint4 g_xb_words;
__shared__ unsigned long long g_base_sh[2];
DI void xcd_barrier_post(unsigned* bar) {
  const unsigned x = xb_xcc_id();
  if (threadIdx.x == 0) { g_xb_words = make_uint4(0u, 0u, x, 0u); (void)xb_add(&bar[XB_XCNT(x)], 1u); }
}
DI void xcd_barrier_complete(unsigned* bar, unsigned x, unsigned& nloc, unsigned& nx) {
  const unsigned G = gridDim.x;
  unsigned sum, cnt, mine, sp = 0u;
  for (;;) {
    sum = 0u; cnt = 0u; mine = 0u;
#pragma unroll
    for (unsigned j = 0; j < 16; ++j) { const unsigned c = xb_ld(&bar[XB_XCNT(j)]); sum += c; cnt += (c > 0u) ? 1u : 0u; mine = (j == x) ? c : mine; }
    if (sum == G) break;
    __builtin_amdgcn_s_sleep(1);
    if ((++sp & 255u) == 0u) { if (xb_ld(&bar[XB_TMO])) break; if (sp > XB_SPIN_CAP) { atomicAdd(&bar[XB_TMO], 1u); break; } }
  }
  nloc = mine > 0u ? mine : 1u; nx = cnt > 0u ? cnt : 1u;
}
DI void xcd_barrier() {
  asm volatile("s_waitcnt vmcnt(0)" ::: "memory");
  __syncthreads();
  if (threadIdx.x == 0) {
    unsigned* bar = (unsigned*)(g_base_sh[0] + OFF_BAR);
    __builtin_amdgcn_s_waitcnt(0);
    unsigned nloc = g_xb_words.x, nx = g_xb_words.y; const unsigned x = g_xb_words.z;
    if (nloc == 0u) { xcd_barrier_complete(bar, x, nloc, nx); g_xb_words.x = nloc; g_xb_words.y = nx; }
    const unsigned old = xb_add(&bar[XB_XSUB(x)], 1u);
    const unsigned gen = old / nloc;
    if (old + 1u == (gen + 1u) * nloc) {
      __builtin_amdgcn_fence(__ATOMIC_RELEASE, "agent");
      asm volatile("s_waitcnt vmcnt(0)" ::: "memory");
      const unsigned og = xb_add(&bar[XB_TOP], 1u);
      const unsigned tg = og / nx;
      if (og + 1u == (tg + 1u) * nx) xb_add(&bar[XB_TOPGEN], 1u);
      else XB_SPIN(xb_ld(&bar[XB_TOPGEN]) == tg, bar);
      __builtin_amdgcn_fence(__ATOMIC_ACQUIRE, "agent");
      xb_add(&bar[XB_XGEN(x)], 1u);
      asm volatile("s_waitcnt vmcnt(0)" ::: "memory");
    } else {
      XB_SPIN(xb_ld(&bar[XB_XGEN(x)]) == gen, bar);
      __builtin_amdgcn_fence(__ATOMIC_ACQUIRE, "agent");
      asm volatile("s_waitcnt vmcnt(0)" ::: "memory");
    }
  }
  __syncthreads();
}
DI int launder_v(int x) { asm volatile("" : "+v"(x)); return x; }
DI int launder_s(int x) { asm volatile("" : "+s"(x)); return x; }
#define LAUNDER_IDS const int tid__ = launder_v((int)threadIdx.x); const int blk__ = launder_s((int)blockIdx.x); (void)tid__; (void)blk__;
DI void do_transpose(const float* __restrict__ src, int K, int N, u16* __restrict__ dst, const float* __restrict__ ksc, int perm, int tile, float* tl) {
  LAUNDER_IDS
  const int ntn = (N + 63) >> 6;
  const int kt = tile / ntn, nt = tile - kt * ntn;
  const int k0 = kt * 64, n0 = nt * 64;
  const int tid = tid__;
  __syncthreads();
#pragma unroll 4
  for (int i = 0; i < 16; ++i) {
    const int kk = i * 4 + (tid >> 6), nn = tid & 63;
    float v = 0.f;
    if (n0 + nn < N) v = src[(size_t)(k0 + kk) * N + n0 + nn];
    if (ksc) v *= ksc[k0 + kk];
    tl[kk * 65 + nn] = v;
  }
  __syncthreads();
#pragma unroll 4
  for (int i = 0; i < 16; ++i) {
    const int nn = i * 4 + (tid >> 6), kk = tid & 63;
    int n = n0 + nn;
    if (n < N) {
      if (perm) { const int h = n / 96, d = n - h * 96; n = d < 64 ? h * 64 + d : 512 + h * 32 + (d - 64); }
      dst[(size_t)n * K + k0 + kk] = f2bf(tl[kk * 65 + nn]);
    }
  }
}

DI void phase_prep(const Params& p, char* smem) {
  LAUNDER_IDS
  float* tl = (float*)smem;
  const int tid = tid__;
  constexpr int T_WIN = 16 * 81, T_UQ = 6 * 12, T_UKV = 4 * 16, T_BRM = 8 * 16, T_BRR = 4 * 16, T_WO = 16 * 16, T_W1 = 16 * 64, T_W2 = 64 * 16,
                T_RW2 = 4, T_RA2 = 4, T_RG2 = 2 * 4;
  constexpr int T_LAYER = T_WIN + T_UQ + T_UKV + T_BRM + T_BRR + T_WO + T_W1 + T_W2 + 2 * T_RW2 + 2 * T_RA2 + T_RG2;
  for (int g = blk__; g < 2 * T_LAYER; g += gridDim.x) {
    const int l = g / T_LAYER; int t = g - l * T_LAYER;
    char* wl = p.ws + OFF_W + (size_t)l * W_LAYER;
#define JOB(SRC, KK, NN, DSTOFF, SC, PERM, CNT) if (t < (CNT)) { do_transpose((SRC), (KK), (NN), (u16*)(wl + (DSTOFF)), (SC), (PERM), t, tl); continue; } t -= (CNT);
    JOB(p.in[I_WIN] + (size_t)l * 1024 * INC, 1024, INC, WO_WIN, nullptr, 0, T_WIN)
    JOB(p.in[I_WUQ] + (size_t)l * 384 * 768, 384, 768, WO_UQ, p.in[I_QNORM] + l * 384, 1, T_UQ)
    JOB(p.in[I_WUKV] + (size_t)l * 256 * 1024, 256, 1024, WO_UKV, p.in[I_KVNORM] + l * 256, 0, T_UKV)
    JOB(p.in[I_BRM] + (size_t)l * 512 * 1024, 512, 1024, WO_BRM, nullptr, 0, T_BRM)
    JOB(p.in[I_BRR] + (size_t)l * 256 * 1024, 256, 1024, WO_BRR, nullptr, 0, T_BRR)
    JOB(p.in[I_WO] + (size_t)l * 1024 * 1024, 1024, 1024, WO_WO, nullptr, 0, T_WO)
    JOB(p.in[I_W1] + (size_t)l * 1024 * 4096, 1024, 4096, WO_W1, nullptr, 0, T_W1)
    JOB(p.in[I_W2] + (size_t)l * 4096 * 1024, 4096, 1024, WO_W2, nullptr, 0, T_W2)
    JOB(p.in[I_W2R] + (size_t)(l * 2 + 0) * 64 * 256, 64, 256, WO_RW2, nullptr, 0, T_RW2)
    JOB(p.in[I_W2R] + (size_t)(l * 2 + 1) * 64 * 256, 64, 256, WO_RW2 + 256 * 64 * 2, nullptr, 0, T_RW2)
    JOB(p.in[I_A2R] + (size_t)(l * 2 + 0) * 64 * 256, 64, 256, WO_RA2, nullptr, 0, T_RA2)
    JOB(p.in[I_A2R] + (size_t)(l * 2 + 1) * 64 * 256, 64, 256, WO_RA2 + 256 * 64 * 2, nullptr, 0, T_RA2)
    JOB(p.in[I_G2R] + (size_t)l * 128 * 256, 128, 256, WO_RG2, nullptr, 0, T_RG2)
#undef JOB
  }
  for (int e = blk__ * 256 + tid; e < 2 * 256 * 1024; e += gridDim.x * 256) {
    const int l = e >> 18, r = e & 262143, cin = r >> 10, n = r & 1023, g = cin >> 6, c = cin & 63;
    const float* pw = p.in[I_POOLW] + ((size_t)(l * 4 + g) * 64 + c) * 64;
    const float* ps = p.in[I_POOLS] + l * 256 + g * 64;
    const float* wb = p.in[I_BRP] + ((size_t)l * 256 + g * 64) * 1024 + n;
    float s = 0.f;
    for (int d = 0; d < 64; ++d) s += pw[d] * ps[d] * wb[(size_t)d * 1024];
    ((u16*)(p.ws + OFF_W + (size_t)l * W_LAYER + WO_BRP))[(size_t)n * 256 + cin] = f2bf(s);
  }
  if (blk__ == gridDim.x - 1) {
    for (int e = tid; e < 512; e += 256) {
      const int pos = e >> 3, f = e & 7;
      const float inv = powf(10000.f, -(float)f / 8.f);
      const float ang = (float)pos * inv;
      float* rt = (float*)(p.ws + OFF_ROPE);
      rt[e * 2] = cosf(ang); rt[e * 2 + 1] = sinf(ang);
    }
  }
  {
    float* sl = (float*)smem;
    float* red = sl + 9 * 1024;
    __syncthreads();
    for (int e = tid; e < 9 * 1024; e += 256) {
      const int b = e >> 10, k = e & 1023;
      const float v = b < 8 ? p.in[I_C][b * 1024 + k] : p.in[I_CCTX][k];
      sl[e] = siluf_(v);
    }
    __syncthreads();
    const int wave = tid >> 6, lane = tid & 63;
    for (int it = blk__; it < 192; it += gridDim.x) {
      const int l = it / 96, cg_ = it - l * 96;
      const int col = cg_ * 64 + lane;
      const float* wa = p.in[I_WADA] + (size_t)l * 1024 * 6144 + col;
      float acc[9];
#pragma unroll
      for (int b = 0; b < 9; ++b) acc[b] = 0.f;
#pragma unroll 8
      for (int k = wave * 256; k < wave * 256 + 256; ++k) {
        const float w = wa[(size_t)k * 6144];
#pragma unroll
        for (int b = 0; b < 9; ++b) acc[b] += sl[b * 1024 + k] * w;
      }
#pragma unroll
      for (int b = 0; b < 9; ++b) red[(wave * 9 + b) * 64 + lane] = acc[b];
      __syncthreads();
      for (int e = tid; e < 9 * 64; e += 256) {
        const int b = e >> 6, c = e & 63;
        const float s = red[(0 * 9 + b) * 64 + c] + red[(1 * 9 + b) * 64 + c] + red[(2 * 9 + b) * 64 + c] + red[(3 * 9 + b) * 64 + c];
        ((float*)(p.ws + OFF_MODS))[(size_t)(l * 9 + b) * 6144 + cg_ * 64 + c] = s + p.in[I_BADA][l * 6144 + cg_ * 64 + c];
      }
      __syncthreads();
    }
  }
}

DI const float* xrow(const float* xl, const float* xc, int r) { return r < NTL ? xl + (size_t)r * D : xc + (size_t)(r - NTL) * D; }

DI void phase_norm(const float* xl, const float* xc, const float* tab  , u16* hb, int M) {
  LAUNDER_IDS
  const int wave = tid__ >> 6, lane = tid__ & 63;
  const int nw = gridDim.x * 4, rpw = (M + nw - 1) / nw;
  const int rbeg = (blk__ * 4 + wave) * rpw, rend = min(rbeg + rpw, M);
  int cur_b9 = -1;
  float4 g[4], sh[4];
#pragma unroll
  for (int i = 0; i < 4; ++i) { g[i] = make_float4(0.f, 0.f, 0.f, 0.f); sh[i] = g[i]; }
  float4 vn[4];
  if (rbeg < rend) {
    const float* xp0 = xrow(xl, xc, rbeg);
#pragma unroll
    for (int i = 0; i < 4; ++i) vn[i] = *(const float4*)(xp0 + i * 256 + lane * 4);
  }
  for (int r = rbeg; r < rend; ++r) {
    const int b9 = r < NTL ? r >> 12 : 8;
    float4 v[4];
#pragma unroll
    for (int i = 0; i < 4; ++i) v[i] = vn[i];
    {
      const float* xpn = xrow(xl, xc, min(r + 1, rend - 1));
#pragma unroll
      for (int i = 0; i < 4; ++i) vn[i] = *(const float4*)(xpn + i * 256 + lane * 4);
    }
    if (b9 != cur_b9) {
      cur_b9 = b9;
      const float* t = tab + b9 * 2048;
#pragma unroll
      for (int i = 0; i < 4; ++i) { g[i] = *(const float4*)(t + i * 256 + lane * 4); sh[i] = *(const float4*)(t + 1024 + i * 256 + lane * 4); }
    }
    float s = 0.f;
#pragma unroll
    for (int i = 0; i < 4; ++i) s += v[i].x * v[i].x + v[i].y * v[i].y + v[i].z * v[i].z + v[i].w * v[i].w;
    s = wavesum(s);
    const float rs = rsqrtf(s * (1.f / 1024.f) + 1e-6f);
#pragma unroll
    for (int i = 0; i < 4; ++i) {
      const int k = i * 256 + lane * 4;
      *(uint2*)(hb + (size_t)r * 1024 + k) = make_uint2(pack2(v[i].x * rs * g[i].x + sh[i].x, v[i].y * rs * g[i].y + sh[i].y), pack2(v[i].z * rs * g[i].z + sh[i].z, v[i].w * rs * g[i].w + sh[i].w));
    }
  }
}
DI void phase_tables(const Params& p) {
  LAUNDER_IDS
  const float* mods = (const float*)(p.ws + OFF_MODS);
  float* tab = (float*)(p.ws + OFF_TAB);
  for (int e = blk__ * 256 + tid__; e < 2 * 2 * 9 * 1024; e += gridDim.x * 256) {
    const int k = e & 1023, b9 = (e >> 10) % 9, ln = (e >> 10) / 9, l = ln >> 1, nrm = ln & 1;
    const float g = p.in[nrm ? I_N2G : I_N1G][l * 1024 + k];
    const float sh = mods[(size_t)(l * 9 + b9) * 6144 + (nrm * 3 + 0) * 1024 + k];
    const float sc = mods[(size_t)(l * 9 + b9) * 6144 + (nrm * 3 + 1) * 1024 + k];
    float* t = tab + ((size_t)(l * 2 + nrm) * 9 + b9) * 2048;
    t[k] = g * (1.f + sc); t[1024 + k] = sh;
  }
}

struct LoadBf16 {
  const u16* A; int lda;
  DI void init(int m0) {}
  DI uint4 load(int i, int m0, int k0) const {
    LAUNDER_IDS
    const int tid = tid__, kc = (tid & 7) * 8;
    return *(const uint4*)(A + (size_t)(m0 + (tid >> 3) + i * 32) * lda + k0 + kc);
  }
};
struct LoadNorm {
  const float* xl; const float* xc; const float* rs; const float* tab;
  float r0, r1, r2, r3;
  DI void init(int m0) {
    LAUNDER_IDS
    const int tid = tid__;
    r0 = rs[m0 + (tid >> 3)]; r1 = rs[m0 + (tid >> 3) + 32]; r2 = rs[m0 + (tid >> 3) + 64]; r3 = rs[m0 + (tid >> 3) + 96];
  }
  DI uint4 load(int i, int m0, int k0) const {
    LAUNDER_IDS
    const int tid = tid__, kc = (tid & 7) * 8;
    const int b9 = m0 < NTL ? m0 >> 12 : 8;
    const float* t = tab + b9 * 2048 + k0 + kc;
    const float4 g0 = *(const float4*)t, g1 = *(const float4*)(t + 4), s0 = *(const float4*)(t + 1024), s1 = *(const float4*)(t + 1028);
    const float* xp = xrow(xl, xc, m0 + (tid >> 3)) + k0 + kc + (size_t)i * 32 * D;
    const float4 x0 = *(const float4*)xp, x1 = *(const float4*)(xp + 4);
    const float rr = i == 0 ? r0 : i == 1 ? r1 : i == 2 ? r2 : r3;
    uint4 o;
    o.x = pack2(x0.x * rr * g0.x + s0.x, x0.y * rr * g0.y + s0.y);
    o.y = pack2(x0.z * rr * g0.z + s0.z, x0.w * rr * g0.w + s0.w);
    o.z = pack2(x1.x * rr * g1.x + s1.x, x1.y * rr * g1.y + s1.y);
    o.w = pack2(x1.z * rr * g1.z + s1.z, x1.w * rr * g1.w + s1.w);
    return o;
  }
};

DI bool tile_map(int it, int NTM, int NTN, int blk, int nblk, int& tm, int& tn) {
  const int xcd = blk & 7, local = blk >> 3, LB = nblk >> 3;
  const int R = NTM >> 3;
  const int s = it * LB + local;
  if (s >= R * NTN) return false;
  const int F = R >> 3, per_full = 8 * NTN;
  int mg, r, gm;
  if (s < F * per_full) { mg = s / per_full; r = s - mg * per_full; gm = 8; }
  else { mg = F; r = s - F * per_full; gm = R - F * 8; }
  const int ng = r / (gm * 8);
  const int r2 = r - ng * gm * 8;
  const int mi = r2 % gm, ni = r2 / gm;
  tm = xcd * R + mg * 8 + mi; tn = ng * 8 + ni;
  return true;
}
constexpr int LDT = 72;
template <int NI, class LA>
DI void gemm_mainloop(f32x4 (&acc)[4][NI], LA la, const u16* __restrict__ Bt, int ldb, int K, int m0, int n0, char* smem) {
  LAUNDER_IDS
  constexpr int NBI = NI;
  u16* As = (u16*)smem; u16* Bs = As + 2 * 128 * LDT;
  const int tid = tid__, lane = tid & 63, wave = tid >> 6, wr = wave >> 1, wc = wave & 1, lr = lane & 15, lq = lane >> 4;
  uint4 ra[4], rb[NBI];
  la.init(m0);
#pragma unroll
  for (int i = 0; i < 4; ++i) ra[i] = la.load(i, m0, 0);
#pragma unroll
  for (int i = 0; i < NBI; ++i) {
    const int c = tid + i * 256, row = c >> 3, kc = (c & 7) * 8;
    rb[i] = *(const uint4*)(Bt + (size_t)(n0 + row) * ldb + kc);
  }
#pragma unroll
  for (int i = 0; i < 4; ++i) {
    const int c = tid + i * 256, row = c >> 3, kc = (c & 7) * 8;
    *(uint4*)(As + row * LDT + kc) = ra[i];
    if (i < NBI) *(uint4*)(Bs + row * LDT + kc) = rb[i];
  }
  __syncthreads();
  const int nk = K >> 6;
  for (int kt = 0; kt < nk; ++kt) {
    const int cur = kt & 1;
    if (kt + 1 < nk) {
      const int k0 = (kt + 1) * 64;
#pragma unroll
      for (int i = 0; i < 4; ++i) ra[i] = la.load(i, m0, k0);
#pragma unroll
      for (int i = 0; i < NBI; ++i) {
        const int c = tid + i * 256, row = c >> 3, kc = (c & 7) * 8;
        rb[i] = *(const uint4*)(Bt + (size_t)(n0 + row) * ldb + k0 + kc);
      }
    }
    const u16* Ac = As + cur * 128 * LDT + (wr * 64 + lr) * LDT + lq * 8;
    const u16* Bc = Bs + cur * 128 * LDT + (wc * 16 * NI + lr) * LDT + lq * 8;
#pragma unroll
    for (int ks = 0; ks < 2; ++ks) {
      bf16x8 af[4], bfr[NI];
#pragma unroll
      for (int mi = 0; mi < 4; ++mi) af[mi] = *(const bf16x8*)(Ac + mi * 16 * LDT + ks * 32);
#pragma unroll
      for (int ni = 0; ni < NI; ++ni) bfr[ni] = *(const bf16x8*)(Bc + ni * 16 * LDT + ks * 32);
#pragma unroll
      for (int mi = 0; mi < 4; ++mi)
#pragma unroll
        for (int ni = 0; ni < NI; ++ni)
          acc[mi][ni] = __builtin_amdgcn_mfma_f32_16x16x32_bf16(bfr[ni], af[mi], acc[mi][ni], 0, 0, 0);
    }
    if (kt + 1 < nk) {
      const int nxt = cur ^ 1;
#pragma unroll
      for (int i = 0; i < 4; ++i) {
        const int c = tid + i * 256, row = c >> 3, kc = (c & 7) * 8;
        *(uint4*)(As + nxt * 128 * LDT + row * LDT + kc) = ra[i];
        if (i < NBI) *(uint4*)(Bs + nxt * 128 * LDT + row * LDT + kc) = rb[i];
      }
    }
    __syncthreads();
  }
}
template <int NI>
DI void zero_acc(f32x4 (&acc)[4][NI]) {
#pragma unroll
  for (int i = 0; i < 4; ++i)
#pragma unroll
    for (int j = 0; j < NI; ++j) acc[i][j] = f32x4{0.f, 0.f, 0.f, 0.f};
}
template <int MI, int NI>
DI void gemm256(f32x4 (&acc)[MI][NI], const u16* __restrict__ A, int lda, const u16* __restrict__ Bt, int ldb, int K, int m0, int n0, char* smem) {
  LAUNDER_IDS
  const int lane = tid__ & 63, wave = tid__ >> 6, wr = wave >> 1, wc = wave & 1, lr = lane & 15, lq = lane >> 4;
  constexpr int NAW = MI / 2;
  constexpr int NBW = NI / 2;
  constexpr int ABYTES = MI * 2 * 1024;
  constexpr int STAGE = ABYTES + NI * 2 * 1024;
  constexpr int LPS = NAW + NBW;
  static_assert(3 * STAGE <= 73728, "ring does not fit");
  const int srow = lane >> 2, scol = ((lane & 3) ^ ((lane >> 5) << 1)) * 8;
  const u16* Ag = A + (size_t)(m0 + wave * NAW * 16 + srow) * lda + scol;
  const u16* Bg = Bt + (size_t)(n0 + wave * NBW * 16 + srow) * ldb + scol;
  char* la = smem + (wave * NAW) * 1024 + lane * 16;
  char* lb = smem + ABYTES + (wave * NBW) * 1024 + lane * 16;
#define G256_ISSUE(S, K0) do { \
    _Pragma("unroll") for (int j_ = 0; j_ < NAW; ++j_) \
      __builtin_amdgcn_global_load_lds((const unsigned*)(Ag + (size_t)j_ * 16 * lda + (K0)), (__attribute__((address_space(3))) unsigned*)(la + (S) * STAGE + j_ * 1024), 16, 0, 0); \
    _Pragma("unroll") for (int j_ = 0; j_ < NBW; ++j_) \
      __builtin_amdgcn_global_load_lds((const unsigned*)(Bg + (size_t)j_ * 16 * ldb + (K0)), (__attribute__((address_space(3))) unsigned*)(lb + (S) * STAGE + j_ * 1024), 16, 0, 0); \
  } while (0)
  const int nk = K >> 5;
  G256_ISSUE(0, 0);
  if (nk > 1) G256_ISSUE(1, 32);
  const int foff = lr * 64 + ((lq ^ ((lr >> 3) << 1)) * 16);
  int st = 0;
  for (int kt = 0; kt < nk; ++kt) {
    if (kt + 1 < nk) asm volatile("s_waitcnt vmcnt(%0) lgkmcnt(0)" :: "n"(LPS) : "memory");
    else asm volatile("s_waitcnt vmcnt(0) lgkmcnt(0)" ::: "memory");
    __builtin_amdgcn_s_barrier();
    __builtin_amdgcn_s_setprio(1);
    const char* sb = smem + st * STAGE + foff;
    bf16x8 af[MI], bfr[NI];
#pragma unroll
    for (int mi = 0; mi < MI; ++mi) af[mi] = *(const bf16x8*)(sb + (wr * MI + mi) * 1024);
#pragma unroll
    for (int ni = 0; ni < NI; ++ni) bfr[ni] = *(const bf16x8*)(sb + ABYTES + (wc * NI + ni) * 1024);
    __builtin_amdgcn_sched_barrier(0x0);
    if (kt + 2 < nk) { const int s2 = st >= 1 ? st - 1 : 2; G256_ISSUE(s2, (kt + 2) * 32); }
    __builtin_amdgcn_s_setprio(0);
#pragma unroll
    for (int mi = 0; mi < MI; ++mi)
#pragma unroll
      for (int ni = 0; ni < NI; ++ni)
        acc[mi][ni] = __builtin_amdgcn_mfma_f32_16x16x32_bf16(bfr[ni], af[mi], acc[mi][ni], 0, 0, 0);
    st = st == 2 ? 0 : st + 1;
  }
  asm volatile("s_waitcnt lgkmcnt(0)" ::: "memory");
  __builtin_amdgcn_s_barrier();
#undef G256_ISSUE
}
template <int MI, int NI>
DI void zero_accm(f32x4 (&acc)[MI][NI]) {
#pragma unroll
  for (int i = 0; i < MI; ++i)
#pragma unroll
    for (int j = 0; j < NI; ++j) acc[i][j] = f32x4{0.f, 0.f, 0.f, 0.f};
}
#define EPI_BEGIN const int lr1_ = launder_v(lr), lq1_ = launder_v(lq), wr1_ = launder_v(wr), wc1_ = launder_v(wc); { const int lr = lr1_, lq = lq1_, wr = wr1_, wc = wc1_; (void)lr; (void)lq; (void)wr; (void)wc;
#define EPI_END }
DI uint4 widen16(uint2 a, uint2 b) {
  const auto r0 = __builtin_amdgcn_permlane16_swap(a.x, b.x, false, false);
  const auto r1 = __builtin_amdgcn_permlane16_swap(a.y, b.y, false, false);
  return make_uint4(r0[0], r1[0], r0[1], r1[1]);
}
#define WAVE_COORDS const int lane = tid__ & 63, wave = tid__ >> 6, wr = wave >> 1, wc = wave & 1, lr = lane & 15, lq = lane >> 4; (void)wr; (void)wc; (void)lr; (void)lq;

DI void phase_zgemm(const Params& p, int l, char* smem) {
  LAUNDER_IDS
  WAVE_COORDS
  const u16* Wt = (const u16*)(p.ws + OFF_W + (size_t)l * W_LAYER + WO_WIN);
  const u16* hb = (const u16*)(p.ws + OFF_HB1);
  u16* za = (u16*)(p.ws + OFF_R2); u16* zr = (u16*)(p.ws + OFF_R1);
  for (int it = 0;; ++it) {
    int tm, tn;
    if (!tile_map(it, NT / 256, 17, blk__, gridDim.x, tm, tn)) break;
    const int m0 = tm * 256, n0 = tn * 128;
    f32x4 acc[8][4]; zero_accm<8, 4>(acc);
    gemm256<8, 4>(acc, hb, 1024, Wt, 1024, 1024, m0, n0, smem);
    EPI_BEGIN
#pragma unroll
    for (int mi = 0; mi < 8; mi += 2) {
      const int m = m0 + wr * 128 + (mi + (lq & 1)) * 16 + lr;
#pragma unroll
      for (int ni = 0; ni < 4; ++ni) {
        const int n = n0 + wc * 64 + ni * 16 + (lq >> 1) * 8;
        const uint4 v = widen16(make_uint2(pack2(acc[mi][ni][0], acc[mi][ni][1]), pack2(acc[mi][ni][2], acc[mi][ni][3])),
                                make_uint2(pack2(acc[mi + 1][ni][0], acc[mi + 1][ni][1]), pack2(acc[mi + 1][ni][2], acc[mi + 1][ni][3])));
        if (n < ZA) *(uint4*)(za + (size_t)m * ZA + n) = v;
        else if (n < ZA + ZR) *(uint4*)(zr + (size_t)m * ZR + (n - ZA)) = v;
      }
    }
    EPI_END
  }
}

DI void phase_tokA(const Params& p, int l) {
  LAUNDER_IDS
  const int wave = tid__ >> 6, lane = tid__ & 63;
  const u16* za = (const u16*)(p.ws + OFF_R2);
  float* rsq = (float*)(p.ws + OFF_RSQ); float* rskv = (float*)(p.ws + OFF_RSKV);
  u16* krb = (u16*)(p.ws + OFF_KR);
  u16* pooled = (u16*)(p.ws + OFF_R4);
  const float* rt = (const float*)(p.ws + OFF_ROPE);
  const float* gk = p.in[I_GK] + l * 96;
  for (int r = blk__ * 4 + wave; r < NT; r += gridDim.x * 4) {
    const u16* z = za + (size_t)r * ZA;
    const bool lat = r < NTL;
    const int b = lat ? r >> 12 : (r - NTL) >> 8;
    const int t = lat ? r & 4095 : (r - NTL) & 255;
    const int Ls = lat ? L : LC;
    const int pos = lat ? t : 4096 + t;
    u16 zq[6], zk[4], pw[30], pc[4];
#pragma unroll
    for (int i = 0; i < 6; ++i) zq[i] = z[256 + i * 64 + lane];
#pragma unroll
    for (int i = 0; i < 4; ++i) zk[i] = z[640 + i * 64 + lane];
    const int d = lane & 31;
    const u16 kr_raw = z[896 + d];
    const float gkd = gk[64 + d];
    const int ri = d & 15;
    const int pp = ri < 8 ? (t >> 6) : (t & 63);
    const float cs = rt[(pp * 8 + (ri & 7)) * 2], sn = rt[(pp * 8 + (ri & 7)) * 2 + 1];
#pragma unroll
    for (int gi = 0; gi < 4; ++gi) {
      const int half = 1 << gi;
      pc[gi] = z[gi * 64 + lane];
#pragma unroll
      for (int j = 0; j < 2 * half; ++j) {
        const int qc = min(max(t - half + j, 0), Ls - 1);
        pw[2 * half - 2 + j] = z[(ptrdiff_t)(qc - t) * ZA + gi * 64 + lane];
      }
    }
    float sq = 0.f, skv = 0.f;
#pragma unroll
    for (int i = 0; i < 6; ++i) { const float v = bf2f(zq[i]); sq += v * v; }
#pragma unroll
    for (int i = 0; i < 4; ++i) { const float v = bf2f(zk[i]); skv += v * v; }
    sq = wavesum(sq); skv = wavesum(skv);
    const float rq = rsqrtf(sq * (1.f / 384.f) + 1e-6f), rkv = rsqrtf(skv * (1.f / 256.f) + 1e-6f);
    float kr = bf2f(kr_raw);
    float ss = rowsum16(kr * kr);
    { const int si = __builtin_bit_cast(int, ss);
      ss = __builtin_bit_cast(float, __builtin_amdgcn_readlane(si, 0)) + __builtin_bit_cast(float, __builtin_amdgcn_readlane(si, 16)); }
    kr = kr * rsqrtf(ss * (1.f / 32.f) + 1e-6f) * gkd;
    const float other = __shfl_xor(kr, 16, 64);
    const float rot = d < 16 ? kr * cs - other * sn : other * sn + kr * cs;
    const float outv = lat ? rot : kr;
    float pv[4];
#pragma unroll
    for (int gi = 0; gi < 4; ++gi) {
      const int half = 1 << gi;
      const int lo = max(t - half, 0), hi = min(t + half, Ls);
      float sm = 0.f;
#pragma unroll
      for (int j = 0; j < 2 * half; ++j) {
        const int q = t - half + j;
        sm += (q >= 0 && q < Ls) ? bf2f(pw[2 * half - 2 + j]) : 0.f;
      }
      pv[gi] = sm / (float)(hi - lo) - bf2f(pc[gi]);
    }
    if (lane == 0) { rsq[r] = rq; rskv[r] = rkv; }
    if (lane < 32) krb[(size_t)r * 32 + d] = f2bf(outv);
#pragma unroll
    for (int gi = 0; gi < 4; ++gi) pooled[(size_t)r * 256 + gi * 64 + lane] = f2bf(pv[gi]);
  }
}

constexpr int ZSL = 1160, TAL = 392;
DI void phase_tokB(const Params& p, int l, char* smem) {
  LAUNDER_IDS
  WAVE_COORDS
  const int tid = tid__;
  u16* Zs = (u16*)smem;
  u16* TA = Zs + 18 * ZSL;
  float* PV = (float*)(TA + 16 * TAL);
  const u16* zr = (const u16*)(p.ws + OFF_R1);
  const char* wl = p.ws + OFF_W + (size_t)l * W_LAYER;
  u16* sc = (u16*)(p.ws + OFF_R3);
  __syncthreads();
  for (int e = tid; e < 2 * ZR + 7 * 256; e += 256) {
    float v;
    if (e < 2 * ZR) v = p.in[I_MU][(size_t)l * 2 * ZR + e];
    else { const int f = e - 2 * ZR, a = f >> 8, c = f & 255;
      v = a == 0 ? p.in[I_KK][l * 256 + c] : a < 3 ? p.in[I_W0][(size_t)(l * 2 + a - 1) * 256 + c] : a < 5 ? p.in[I_A0][(size_t)(l * 2 + a - 3) * 256 + c] : p.in[I_KA][(size_t)(l * 2 + a - 5) * 256 + c]; }
    PV[e] = v;
  }
  const float* mu0 = PV; const float* mu1 = PV + ZR; const float* kkw = PV + 2 * ZR;
  const float* w0p = kkw + 256; const float* a0p = w0p + 512; const float* kap = a0p + 512;
  for (int tile = blk__; tile < NT / 16; tile += gridDim.x) {
    const int r0 = tile * 16;
    const bool lat = r0 < NTL;
    const int t0 = lat ? r0 & 4095 : (r0 - NTL) & 255;
    const int Ls = lat ? L : LC;
    __syncthreads();
    {
      uint4 v[11];
#pragma unroll
      for (int i = 0; i < 11; ++i) {
        const int c = tid + i * 256;
        const int ri = c / 144, ch = c - ri * 144;
        const int tt = t0 - 1 + ri;
        const int cc = min(c, 18 * 144 - 1);
        const int rc = cc / 144, chc = cc - rc * 144;
        const int ttc = min(max(t0 - 1 + rc, 0), Ls - 1);
        const uint4 ld = *(const uint4*)(zr + (size_t)(r0 - t0 + ttc) * ZR + chc * 8);
        const bool ok = (c < 18 * 144) && (tt >= 0) && (tt < Ls);
        v[i] = ok ? ld : make_uint4(0, 0, 0, 0);
      }
#pragma unroll
      for (int i = 0; i < 11; ++i) {
        const int c = tid + i * 256;
        const int ri = c / 144, ch = c - ri * 144;
        if (c < 18 * 144) {
          *(uint2*)(Zs + ri * ZSL + ch * 8) = make_uint2(v[i].x, v[i].y);
          *(uint2*)(Zs + ri * ZSL + ch * 8 + 4) = make_uint2(v[i].z, v[i].w);
        }
      }
    }
    __syncthreads();
#pragma unroll 4
    for (int e = tid; e < 16 * 384; e += 256) {
      const int i = e / 384, c = e - i * 384, zc = 768 + c;
      const float z = bf2f(Zs[(i + 1) * ZSL + zc]), zp = bf2f(Zs[i * ZSL + zc]), zn = bf2f(Zs[(i + 2) * ZSL + zc]);
      float v = z + mu0[zc] * (zp - z) + mu1[zc] * (zn - z);
      if (c < 128) v = 1.f - 2.f / (1.f + __expf(2.f * v)); else if (c >= 256) v = sigmoidf_(v);
      TA[i * TAL + c] = f2bf(v);
    }
    __syncthreads();
    const int row = r0 + lr;
    auto shifted4 = [&](int zc, float (&out)[4]) {
      const uint2 c0 = *(const uint2*)(Zs + (lr + 1) * ZSL + zc), cp = *(const uint2*)(Zs + lr * ZSL + zc), cn = *(const uint2*)(Zs + (lr + 2) * ZSL + zc);
      const float4 m0 = *(const float4*)(mu0 + zc), m1 = *(const float4*)(mu1 + zc);
      float z, zp, zn;
      z = bflo(c0.x); zp = bflo(cp.x); zn = bflo(cn.x); out[0] = z + m0.x * (zp - z) + m1.x * (zn - z);
      z = bfhi(c0.x); zp = bfhi(cp.x); zn = bfhi(cn.x); out[1] = z + m0.y * (zp - z) + m1.y * (zn - z);
      z = bflo(c0.y); zp = bflo(cp.y); zn = bflo(cn.y); out[2] = z + m0.z * (zp - z) + m1.z * (zn - z);
      z = bfhi(c0.y); zp = bfhi(cp.y); zn = bfhi(cn.y); out[3] = z + m0.w * (zp - z) + m1.w * (zn - z);
    };
    auto product128 = [&](f32x4 (&ac)[4], const u16* W, int off) {
      bf16x8 aop[4][4];
#pragma unroll
      for (int ks = 0; ks < 4; ++ks)
#pragma unroll
        for (int ni = 0; ni < 4; ++ni) aop[ks][ni] = *(const bf16x8*)(W + (size_t)(wave * 64 + ni * 16 + lr) * 128 + ks * 32 + lq * 8);
#pragma unroll
      for (int ni = 0; ni < 4; ++ni) ac[ni] = f32x4{0.f, 0.f, 0.f, 0.f};
#pragma unroll
      for (int ks = 0; ks < 4; ++ks) {
        const bf16x8 bop = *(const bf16x8*)(TA + lr * TAL + off + ks * 32 + lq * 8);
#pragma unroll
        for (int ni = 0; ni < 4; ++ni) ac[ni] = __builtin_amdgcn_mfma_f32_16x16x32_bf16(aop[ks][ni], bop, ac[ni], 0, 0, 0);
      }
      __builtin_amdgcn_sched_barrier(0);
    };
    auto product64x2 = [&](f32x4 (&ac0)[4], f32x4 (&ac1)[4], const u16* W0, const u16* W1, int off0, int off1) {
      bf16x8 a0[2][4], a1[2][4];
#pragma unroll
      for (int ks = 0; ks < 2; ++ks)
#pragma unroll
        for (int ni = 0; ni < 4; ++ni) {
          a0[ks][ni] = *(const bf16x8*)(W0 + (size_t)(wave * 64 + ni * 16 + lr) * 64 + ks * 32 + lq * 8);
          a1[ks][ni] = *(const bf16x8*)(W1 + (size_t)(wave * 64 + ni * 16 + lr) * 64 + ks * 32 + lq * 8);
        }
#pragma unroll
      for (int ni = 0; ni < 4; ++ni) { ac0[ni] = f32x4{0.f, 0.f, 0.f, 0.f}; ac1[ni] = f32x4{0.f, 0.f, 0.f, 0.f}; }
#pragma unroll
      for (int ks = 0; ks < 2; ++ks) {
        const bf16x8 b0 = *(const bf16x8*)(TA + lr * TAL + off0 + ks * 32 + lq * 8);
        const bf16x8 b1 = *(const bf16x8*)(TA + lr * TAL + off1 + ks * 32 + lq * 8);
#pragma unroll
        for (int ni = 0; ni < 4; ++ni) {
          ac0[ni] = __builtin_amdgcn_mfma_f32_16x16x32_bf16(a0[ks][ni], b0, ac0[ni], 0, 0, 0);
          ac1[ni] = __builtin_amdgcn_mfma_f32_16x16x32_bf16(a1[ks][ni], b1, ac1[ni], 0, 0, 0);
        }
      }
      __builtin_amdgcn_sched_barrier(0);
    };
    float ss = 0.f;
#pragma unroll
    for (int ni = 0; ni < 4; ++ni) {
      const int ch = wave * 64 + ni * 16 + lq * 4;
      float kx[4]; shifted4(256 + ch, kx);
      const float4 kw = *(const float4*)(kkw + ch);
      const float a0 = kx[0] * kw.x, a1 = kx[1] * kw.y, a2 = kx[2] * kw.z, a3 = kx[3] * kw.w;
      ss += a0 * a0 + a1 * a1 + a2 * a2 + a3 * a3;
    }
    ss += __shfl_xor(ss, 16, 64); ss += __shfl_xor(ss, 32, 64);
    const float kinv = rsqrtf(fmaxf(ss, 1e-24f));
    {
      f32x4 ag[4];
      product128(ag, (const u16*)(wl + WO_RG2), 256);
#pragma unroll
      for (int ni = 0; ni < 4; ++ni) {
        const int ch = wave * 64 + ni * 16 + lq * 4;
        const size_t o = (size_t)row * 256 + ch;
        float rx[4], kx[4], vx[4];
        shifted4(ch, rx); shifted4(256 + ch, kx); shifted4(512 + ch, vx);
        const float4 kw = *(const float4*)(kkw + ch);
        *(uint2*)(sc + SA_R * (size_t)NT * 256 + o) = make_uint2(pack2(rx[0], rx[1]), pack2(rx[2], rx[3]));
        *(uint2*)(sc + SA_V * (size_t)NT * 256 + o) = make_uint2(pack2(vx[0], vx[1]), pack2(vx[2], vx[3]));
        *(uint2*)(sc + SA_KKN * (size_t)NT * 256 + o) = make_uint2(pack2(-kx[0] * kw.x * kinv, -kx[1] * kw.y * kinv), pack2(-kx[2] * kw.z * kinv, -kx[3] * kw.w * kinv));
        *(uint2*)(sc + SA_G * (size_t)NT * 256 + o) = make_uint2(pack2(ag[ni][0], ag[ni][1]), pack2(ag[ni][2], ag[ni][3]));
        __builtin_amdgcn_sched_barrier(0);
      }
    }
#pragma unroll 1
    for (int d = 0; d < 2; ++d) {
      f32x4 aw[4], aa[4];
      product64x2(aw, aa, (const u16*)(wl + WO_RW2) + (size_t)d * 256 * 64, (const u16*)(wl + WO_RA2) + (size_t)d * 256 * 64, d * 64, 128 + d * 64);
      u16* oOMW = sc + (d ? SA_OMWB : SA_OMWF) * (size_t)NT * 256;
      u16* oKD = sc + (d ? SA_KDB : SA_KDF) * (size_t)NT * 256;
      u16* oB = sc + (d ? SA_BB : SA_BF) * (size_t)NT * 256;
#pragma unroll
      for (int ni = 0; ni < 4; ++ni) {
        const int ch = wave * 64 + ni * 16 + lq * 4;
        const size_t o = (size_t)row * 256 + ch;
        float kx[4]; shifted4(256 + ch, kx);
        const float4 kw = *(const float4*)(kkw + ch);
        const float kkn[4] = {kx[0] * kw.x * kinv, kx[1] * kw.y * kinv, kx[2] * kw.z * kinv, kx[3] * kw.w * kinv};
        const float4 w0 = *(const float4*)(w0p + d * 256 + ch);
        const float4 a0 = *(const float4*)(a0p + d * 256 + ch);
        const float4 ka = *(const float4*)(kap + d * 256 + ch);
        const float w0a[4] = {w0.x, w0.y, w0.z, w0.w}, a0a[4] = {a0.x, a0.y, a0.z, a0.w}, kaa[4] = {ka.x, ka.y, ka.z, ka.w};
        float omw[4], kd[4], bb[4];
#pragma unroll
        for (int j = 0; j < 4; ++j) {
          const float xw = -(w0a[j] + aw[ni][j]);
          const float sp = fmaxf(xw, 0.f) + __logf(1.f + __expf(-fabsf(xw)));
          const float wlog = -sp - 0.5f;
          const float e = __expf(wlog);
          omw[j] = 1.f - __expf(-e);
          const float a = sigmoidf_(a0a[j] + aa[ni][j]);
          kd[j] = kx[j] * (1.f + (a - 1.f) * kaa[j]);
          bb[j] = kkn[j] * a;
        }
        *(uint2*)(oOMW + o) = make_uint2(pack2(omw[0], omw[1]), pack2(omw[2], omw[3]));
        *(uint2*)(oKD + o) = make_uint2(pack2(kd[0], kd[1]), pack2(kd[2], kd[3]));
        *(uint2*)(oB + o) = make_uint2(pack2(bb[0], bb[1]), pack2(bb[2], bb[3]));
        __builtin_amdgcn_sched_barrier(0);
      }
    }
  }
}

DI size_t qk_index(int m, int h) {
  const bool lat = m < NTL;
  const int b = lat ? m >> 12 : (m - NTL) >> 8;
  const int pos = lat ? m & 4095 : 4096 + ((m - NTL) & 255);
  return ((size_t)(b * 8 + h) * LK + pos) * 96;
}
DI void phase_qkv(const Params& p, int l, char* smem) {
  LAUNDER_IDS
  WAVE_COORDS
  const char* wl = p.ws + OFF_W + (size_t)l * W_LAYER;
  const u16* za = (const u16*)(p.ws + OFF_R2);
  const float* rsq0 = (const float*)(p.ws + OFF_RSQ); const float* rskv0 = (const float*)(p.ws + OFF_RSKV);
  u16* Qb = (u16*)(p.ws + OFF_R1); u16* Kb = (u16*)(p.ws + OFF_R1 + SZ_Q); u16* Vt = (u16*)(p.ws + OFF_R1 + 2 * SZ_Q);
  const float* rt0 = (const float*)(p.ws + OFF_ROPE);
  const float* gq0 = p.in[I_GQ] + l * 96; const float* gk0 = p.in[I_GK] + l * 96;
  const float QS = 0.10206207261596577f * 1.4426950408889634f;
  constexpr int NTM = NT / 256;
  for (int it = 0;; ++it) {
    int tm, tn;
    if (!tile_map(it, NTM, 6, blk__, gridDim.x, tm, tn)) break;
    f32x4 acc[8][4]; zero_accm<8, 4>(acc);
    {
      const int m0 = tm * 256, n0 = tn * 128;
      gemm256<8, 4>(acc, za + 256, ZA, (const u16*)(wl + WO_UQ), 384, 384, m0, n0, smem);
      EPI_BEGIN
      const float* gq = gq0; const float* rt = rt0; const float* rsq = rsq0;
      asm volatile("" : "+v"(gq), "+v"(rt), "+v"(rsq));
      const int nw = n0 + wc * 64;
#pragma unroll
      for (int mi = 0; mi < 8; ++mi) {
        __builtin_amdgcn_sched_barrier(0);
        const int m = m0 + wr * 128 + mi * 16 + lr;
        const float rs = rsq[m];
        if (nw < 512) {
          const int h = nw >> 6;
          float ss = 0.f;
#pragma unroll
          for (int ni = 0; ni < 4; ++ni)
#pragma unroll
            for (int j = 0; j < 4; ++j) { const float v = acc[mi][ni][j] * rs; ss += v * v; }
          ss += __shfl_xor(ss, 16, 64); ss += __shfl_xor(ss, 32, 64);
          const float f = rs * rsqrtf(ss * (1.f / 64.f) + 1e-6f) * QS;
          u16* dst = Qb + qk_index(m, h);
#pragma unroll
          for (int ni = 0; ni < 4; ++ni) {
            const int d = ni * 16 + lq * 4;
            const float4 g = *(const float4*)(gq + d);
            *(uint2*)(dst + d) = make_uint2(pack2(acc[mi][ni][0] * f * g.x, acc[mi][ni][1] * f * g.y), pack2(acc[mi][ni][2] * f * g.z, acc[mi][ni][3] * f * g.w));
          }
        } else {
          const bool lat = m < NTL;
          const int tt = m & 4095;
#pragma unroll
          for (int hh = 0; hh < 2; ++hh) {
            __builtin_amdgcn_sched_barrier(0);
            const int h = ((nw - 512) >> 5) + hh;
            float ss = 0.f;
#pragma unroll
            for (int ni = 0; ni < 2; ++ni)
#pragma unroll
              for (int j = 0; j < 4; ++j) { const float v = acc[mi][hh * 2 + ni][j] * rs; ss += v * v; }
            ss += __shfl_xor(ss, 16, 64); ss += __shfl_xor(ss, 32, 64);
            const float f = rs * rsqrtf(ss * (1.f / 32.f) + 1e-6f) * QS;
            const int i0 = lq * 4;
            const float4 g1 = *(const float4*)(gq + 64 + i0), g2 = *(const float4*)(gq + 80 + i0);
            const float g1a[4] = {g1.x, g1.y, g1.z, g1.w}, g2a[4] = {g2.x, g2.y, g2.z, g2.w};
            float o1[4], o2[4];
#pragma unroll
            for (int j = 0; j < 4; ++j) {
              const float x1 = acc[mi][hh * 2][j] * f * g1a[j], x2 = acc[mi][hh * 2 + 1][j] * f * g2a[j];
              float cs = 1.f, sn = 0.f;
              if (lat) {
                const int i = i0 + j;
                const int pp = i < 8 ? (tt >> 6) : (tt & 63);
                cs = rt[(pp * 8 + (i & 7)) * 2]; sn = rt[(pp * 8 + (i & 7)) * 2 + 1];
              }
              o1[j] = x1 * cs - x2 * sn; o2[j] = x1 * sn + x2 * cs;
            }
            u16* dst = Qb + qk_index(m, h) + 64;
            *(uint2*)(dst + i0) = make_uint2(pack2(o1[0], o1[1]), pack2(o1[2], o1[3]));
            *(uint2*)(dst + 16 + i0) = make_uint2(pack2(o2[0], o2[1]), pack2(o2[2], o2[3]));
          }
        }
      }
      EPI_END
    }
  }
  __builtin_amdgcn_sched_barrier(0);
  for (int it = 0;; ++it) {
    int tm, tn;
    if (!tile_map(it, NTM, 8, blk__, gridDim.x, tm, tn)) break;
    f32x4 acc[8][4]; zero_accm<8, 4>(acc);
    {
      const int h = tn, m0 = tm * 256, n0 = h * 128;
      gemm256<8, 4>(acc, za + 640, ZA, (const u16*)(wl + WO_UKV), 256, 256, m0, n0, smem);
      EPI_BEGIN
      const float* gk = gk0; const float* rskv = rskv0;
      asm volatile("" : "+v"(gk), "+v"(rskv));
#pragma unroll
      for (int mi = 0; mi < 8; ++mi) {
        __builtin_amdgcn_sched_barrier(0);
        const int m = m0 + wr * 128 + mi * 16 + lr;
        const float rs = rskv[m];
        if (wc == 0) {
          float ss = 0.f;
#pragma unroll
          for (int ni = 0; ni < 4; ++ni)
#pragma unroll
            for (int j = 0; j < 4; ++j) { const float v = acc[mi][ni][j] * rs; ss += v * v; }
          ss += __shfl_xor(ss, 16, 64); ss += __shfl_xor(ss, 32, 64);
          const float f = rs * rsqrtf(ss * (1.f / 64.f) + 1e-6f);
          u16* dst = Kb + qk_index(m, h);
#pragma unroll
          for (int ni = 0; ni < 4; ++ni) {
            const int d = ni * 16 + lq * 4;
            const float4 g = *(const float4*)(gk + d);
            *(uint2*)(dst + d) = make_uint2(pack2(acc[mi][ni][0] * f * g.x, acc[mi][ni][1] * f * g.y), pack2(acc[mi][ni][2] * f * g.z, acc[mi][ni][3] * f * g.w));
          }
          *(uint4*)(dst + 64 + lq * 8) = *(const uint4*)((const u16*)(p.ws + OFF_KR) + (size_t)m * 32 + lq * 8);
        } else {
          const bool lat = m < NTL;
          const int b = lat ? m >> 12 : (m - NTL) >> 8;
          const int pos = lat ? m & 4095 : 4096 + ((m - NTL) & 255);
          u16* dst = Vt + (size_t)(b * 8 + h) * 64 * LK + pos + (size_t)(lq * 4) * LK;
#pragma unroll
          for (int ni = 0; ni < 4; ++ni) {
            asm volatile("" : "+v"(dst));
#pragma unroll
            for (int j = 0; j < 4; ++j) dst[j * LK] = f2bf(acc[mi][ni][j] * rs);
            dst += 16 * LK;
          }
        }
      }
      EPI_END
    }
  }
}

DI int scan_row(int b, int dir, int s) {
  if (s < LC) return NTL + b * LC + (dir ? LC - 1 - s : s);
  const int t = s - LC;
  return b * L + (dir ? L - 1 - t : t);
}
DI void phase_scan(const Params& p, char* smem) {
  LAUNDER_IDS
  const int blk = blk__;
  if (blk >= 256) return;
  const int tid = tid__, lane = tid & 63, wave = tid >> 6, kq = lane & 15, rg = lane >> 4;
  const int chain = (blk & 7) + 8 * (blk >> 5), quarter = (blk >> 3) & 3;
  const int b = chain >> 3, h = (chain >> 1) & 3, dir = chain & 1;
  const u16* sc = (const u16*)(p.ws + OFF_R3);
  const size_t AS = (size_t)NT * 256;
  const u16* aOMW = sc + (dir ? SA_OMWB : SA_OMWF) * AS;
  const u16* aKD = sc + (dir ? SA_KDB : SA_KDF) * AS;
  const u16* aB = sc + (dir ? SA_BB : SA_BF) * AS;
  const u16* aKKN = sc + SA_KKN * AS;
  const u16* aR = sc + SA_R * AS;
  const u16* aV = sc + SA_V * AS;
  u16* Y = (u16*)(p.ws + OFF_R2) + (dir ? AS : 0);
  constexpr int CH = 16, BSZ = 5 * CH * 64 + CH * 16;
  float* buf = (float*)smem;
  const int st_ld = tid >> 4, k4 = (tid & 15) * 4;
  const int vrow = quarter * 16 + wave * 4 + rg;
  uint2 g0, g1, g2, g3, g4; u16 gv;
#define SCAN_GLOAD(CHUNK) do { \
    const int row_ = scan_row(b, dir, (CHUNK) * CH + st_ld); \
    const size_t o_ = (size_t)row_ * 256 + h * 64 + k4; \
    g0 = *(const uint2*)(aOMW + o_); g1 = *(const uint2*)(aKD + o_); g2 = *(const uint2*)(aB + o_); g3 = *(const uint2*)(aKKN + o_); g4 = *(const uint2*)(aR + o_); \
    gv = aV[(size_t)row_ * 256 + h * 64 + quarter * 16 + (tid & 15)]; } while (0)
#define SCAN_LSTORE(BI) do { \
    float* bb_ = buf + (BI) * BSZ + st_ld * 64 + k4; \
    *(float4*)(bb_ + 0 * CH * 64) = make_float4(1.f - bflo(g0.x), 1.f - bfhi(g0.x), 1.f - bflo(g0.y), 1.f - bfhi(g0.y)); \
    *(float4*)(bb_ + 1 * CH * 64) = make_float4(bflo(g1.x), bfhi(g1.x), bflo(g1.y), bfhi(g1.y)); \
    *(float4*)(bb_ + 2 * CH * 64) = make_float4(bflo(g2.x), bfhi(g2.x), bflo(g2.y), bfhi(g2.y)); \
    *(float4*)(bb_ + 3 * CH * 64) = make_float4(bflo(g3.x), bfhi(g3.x), bflo(g3.y), bfhi(g3.y)); \
    *(float4*)(bb_ + 4 * CH * 64) = make_float4(bflo(g4.x), bfhi(g4.x), bflo(g4.y), bfhi(g4.y)); \
    buf[(BI) * BSZ + 5 * CH * 64 + st_ld * 16 + (tid & 15)] = bf2f(gv); } while (0)
  float2_t S01 = {0.f, 0.f}, S23 = {0.f, 0.f};
  __builtin_amdgcn_s_setprio(3);
  __syncthreads();
  SCAN_GLOAD(0); SCAN_LSTORE(0);
  __syncthreads();
  constexpr int NCH = LK / CH;
  for (int c = 0; c < NCH; ++c) {
    if (c + 1 < NCH) SCAN_GLOAD(c + 1);
    const float* bb = buf + (c & 1) * BSZ;
    const int rowbase = scan_row(b, dir, c * CH);
    const int rstep = dir ? -1 : 1;
    const float* bl = bb + kq * 4;
    const float* bv = bb + 5 * CH * 64 + wave * 4 + rg;
    float4 fwv[3], fkv[3], fbv[3], fav[3], frv[3]; float vvv[3];
#pragma unroll
    for (int q = 0; q < 2; ++q) {
      fwv[q] = *(const float4*)(bl + 0 * CH * 64 + q * 64); fkv[q] = *(const float4*)(bl + 1 * CH * 64 + q * 64); fbv[q] = *(const float4*)(bl + 2 * CH * 64 + q * 64);
      fav[q] = *(const float4*)(bl + 3 * CH * 64 + q * 64); frv[q] = *(const float4*)(bl + 4 * CH * 64 + q * 64); vvv[q] = bv[q * 16];
    }
    float ysel = 0.f, ypart = 0.f;
#pragma unroll
    for (int s = 0; s < CH; ++s) {
      const float4 fw = fwv[s % 3], fk = fkv[s % 3], fb = fbv[s % 3], fa = fav[s % 3], fr = frv[s % 3];
      const float vv = vvv[s % 3];
      const float2_t a01 = {fa.x, fa.y}, a23 = {fa.z, fa.w};
      const float2_t w01 = {fw.x, fw.y}, w23 = {fw.z, fw.w}, k01 = {fk.x, fk.y}, k23 = {fk.z, fk.w}, b01 = {fb.x, fb.y}, b23 = {fb.z, fb.w};
      const float2_t r01 = {fr.x, fr.y}, r23 = {fr.z, fr.w};
      const float2_t vv2 = {vv, vv};
      if (s + 2 < CH) {
        constexpr int dummy = 0; (void)dummy;
        const int q = (s + 2) % 3;
        fwv[q] = *(const float4*)(bl + 0 * CH * 64 + (s + 2) * 64); fkv[q] = *(const float4*)(bl + 1 * CH * 64 + (s + 2) * 64); fbv[q] = *(const float4*)(bl + 2 * CH * 64 + (s + 2) * 64);
        fav[q] = *(const float4*)(bl + 3 * CH * 64 + (s + 2) * 64); frv[q] = *(const float4*)(bl + 4 * CH * 64 + (s + 2) * 64); vvv[q] = bv[(s + 2) * 16];
      }
      float2_t t2 = S01 * a01; t2 = S23 * a23 + t2;
      const float2_t q01 = S01 * w01 + vv2 * k01, q23 = S23 * w23 + vv2 * k23;
      float xs = t2.x + t2.y, ys = ypart;
      xs += __builtin_bit_cast(float, __builtin_amdgcn_update_dpp(0, __builtin_bit_cast(int, xs), 0x128, 0xf, 0xf, false));
      ys += __builtin_bit_cast(float, __builtin_amdgcn_update_dpp(0, __builtin_bit_cast(int, ys), 0x128, 0xf, 0xf, false));
      xs += __builtin_bit_cast(float, __builtin_amdgcn_update_dpp(0, __builtin_bit_cast(int, xs), 0x124, 0xf, 0xf, false));
      ys += __builtin_bit_cast(float, __builtin_amdgcn_update_dpp(0, __builtin_bit_cast(int, ys), 0x124, 0xf, 0xf, false));
      xs += __builtin_bit_cast(float, __builtin_amdgcn_update_dpp(0, __builtin_bit_cast(int, xs), 0x122, 0xf, 0xf, false));
      ys += __builtin_bit_cast(float, __builtin_amdgcn_update_dpp(0, __builtin_bit_cast(int, ys), 0x122, 0xf, 0xf, false));
      xs += __builtin_bit_cast(float, __builtin_amdgcn_update_dpp(0, __builtin_bit_cast(int, xs), 0x121, 0xf, 0xf, false));
      ys += __builtin_bit_cast(float, __builtin_amdgcn_update_dpp(0, __builtin_bit_cast(int, ys), 0x121, 0xf, 0xf, false));
      if (s > 0) ysel = (kq == s - 1) ? ys : ysel;
      const float2_t sa2 = {xs, xs};
      S01 = sa2 * b01 + q01; S23 = sa2 * b23 + q23;
      float2_t y2 = S01 * r01; y2 = S23 * r23 + y2;
      ypart = y2.x + y2.y;
    }
    { const float yl = rowsum16(ypart); ysel = (kq == CH - 1) ? yl : ysel; }
    Y[(size_t)(rowbase + rstep * kq) * 256 + h * 64 + vrow] = f2bf(ysel);
    if (c + 1 < NCH) SCAN_LSTORE((c + 1) & 1);
    __syncthreads();
  }
  __builtin_amdgcn_s_setprio(0);
#undef SCAN_GLOAD
#undef SCAN_LSTORE
}

constexpr int KSL = 104, VSL = 68;
template <int B0>
DI bf16x8 pack8(const f32x16& v) {
  uint4 pw;
  pw.x = pack2(v[B0 + 0], v[B0 + 1]); pw.y = pack2(v[B0 + 2], v[B0 + 3]); pw.z = pack2(v[B0 + 4], v[B0 + 5]); pw.w = pack2(v[B0 + 6], v[B0 + 7]);
  return __builtin_bit_cast(bf16x8, pw);
}
DI void pv_step(f32x16& o0, f32x16& o1, const u16* Vc, int r32, int kb, bf16x8 pf) {
  {
    const uint2 lo = *(const uint2*)(Vc + r32 * VSL + kb), hi2 = *(const uint2*)(Vc + r32 * VSL + kb + 8);
    const bf16x8 va = __builtin_bit_cast(bf16x8, make_uint4(lo.x, lo.y, hi2.x, hi2.y));
    o0 = __builtin_amdgcn_mfma_f32_32x32x16_bf16(va, pf, o0, 0, 0, 0);
  }
  {
    const uint2 lo = *(const uint2*)(Vc + (32 + r32) * VSL + kb), hi2 = *(const uint2*)(Vc + (32 + r32) * VSL + kb + 8);
    const bf16x8 va = __builtin_bit_cast(bf16x8, make_uint4(lo.x, lo.y, hi2.x, hi2.y));
    o1 = __builtin_amdgcn_mfma_f32_32x32x16_bf16(va, pf, o1, 0, 0, 0);
  }
}
DI void attn_item(const Params& p, int item, char* smem) {
  LAUNDER_IDS
  const int tid = tid__, lane = tid & 63, wave = tid >> 6, r32 = lane & 31, hi = lane >> 5;
  int bh, qpos0, key0, nkt, orow0;
  if (item < 2048) { bh = item >> 5; const int qb = item & 31; qpos0 = qb * 128; key0 = 0; nkt = LK / 64; orow0 = (bh >> 3) * L + qpos0; }
  else { const int it = item - 2048; bh = it >> 1; const int qb = it & 1; qpos0 = 4096 + qb * 128; key0 = 4096; nkt = LC / 64; orow0 = NTL + (bh >> 3) * LC + qb * 128; }
  const int h = bh & 7;
  const u16* Qp = (const u16*)(p.ws + OFF_R1) + ((size_t)bh * LK + qpos0 + wave * 32 + r32) * 96 + hi * 8;
  const u16* Kp = (const u16*)(p.ws + OFF_R1 + SZ_Q) + ((size_t)bh * LK + key0) * 96;
  const u16* Vp = (const u16*)(p.ws + OFF_R1 + 2 * SZ_Q) + (size_t)bh * 64 * LK + key0;
  u16* Ks = (u16*)smem;
  u16* Vs = Ks + 2 * 64 * KSL;
  bf16x8 qr[6];
#pragma unroll
  for (int d0 = 0; d0 < 6; ++d0) qr[d0] = *(const bf16x8*)(Qp + d0 * 16);
  uint4 ak0, ak1, ak2, av0, av1, bk0, bk1, bk2, bv0, bv1;
  const int kr0 = tid / 12, kc0 = tid - kr0 * 12, kr1 = (tid + 256) / 12, kc1 = (tid + 256) - kr1 * 12, kr2 = (tid + 512) / 12, kc2 = (tid + 512) - kr2 * 12;
  const int vd0 = tid >> 3, vc0 = tid & 7, vd1 = vd0 + 32;
#define gload(S, kt) do { \
    S##k0 = *(const uint4*)(Kp + (size_t)((kt) * 64 + kr0) * 96 + kc0 * 8); S##k1 = *(const uint4*)(Kp + (size_t)((kt) * 64 + kr1) * 96 + kc1 * 8); \
    S##k2 = *(const uint4*)(Kp + (size_t)((kt) * 64 + kr2) * 96 + kc2 * 8); \
    S##v0 = *(const uint4*)(Vp + (size_t)vd0 * LK + (kt) * 64 + vc0 * 8); S##v1 = *(const uint4*)(Vp + (size_t)vd1 * LK + (kt) * 64 + vc0 * 8); } while (0)
#define lstore(S, bi) do { \
    *(uint4*)(Ks + (bi) * 64 * KSL + kr0 * KSL + kc0 * 8) = S##k0; *(uint4*)(Ks + (bi) * 64 * KSL + kr1 * KSL + kc1 * 8) = S##k1; *(uint4*)(Ks + (bi) * 64 * KSL + kr2 * KSL + kc2 * 8) = S##k2; \
    { u16* dst = Vs + (bi) * 64 * VSL + vd0 * VSL + vc0 * 8; *(uint2*)dst = make_uint2(S##v0.x, S##v0.y); *(uint2*)(dst + 4) = make_uint2(S##v0.z, S##v0.w); } \
    { u16* dst = Vs + (bi) * 64 * VSL + vd1 * VSL + vc0 * 8; *(uint2*)dst = make_uint2(S##v1.x, S##v1.y); *(uint2*)(dst + 4) = make_uint2(S##v1.z, S##v1.w); } } while (0)
  f32x16 o0, o1;
#pragma unroll
  for (int i = 0; i < 16; ++i) { o0[i] = 0.f; o1[i] = 0.f; }
  float mrun = -1e30f, lrun = 0.f;
  auto tile_compute = [&](int cur) {
    const u16* Kc = Ks + cur * 64 * KSL;
    const u16* Vc = Vs + cur * 64 * VSL;
    f32x16 p0, p1;
#pragma unroll
    for (int i = 0; i < 16; ++i) { p0[i] = 0.f; p1[i] = 0.f; }
#pragma unroll
    for (int d0 = 0; d0 < 6; ++d0) {
      const bf16x8 a0 = *(const bf16x8*)(Kc + r32 * KSL + d0 * 16 + hi * 8);
      const bf16x8 a1 = *(const bf16x8*)(Kc + (32 + r32) * KSL + d0 * 16 + hi * 8);
      p0 = __builtin_amdgcn_mfma_f32_32x32x16_bf16(a0, qr[d0], p0, 0, 0, 0);
      p1 = __builtin_amdgcn_mfma_f32_32x32x16_bf16(a1, qr[d0], p1, 0, 0, 0);
    }
    float mx = p0[0];
#pragma unroll
    for (int i = 1; i < 16; ++i) mx = fmaxf(mx, p0[i]);
#pragma unroll
    for (int i = 0; i < 16; ++i) mx = fmaxf(mx, p1[i]);
    { auto rr = __builtin_amdgcn_permlane32_swap(__float_as_uint(mx), __float_as_uint(mx), false, false);
      mx = fmaxf(__uint_as_float(rr[0]), __uint_as_float(rr[1])); }
    if (!__all(mx - mrun <= 8.f)) {
      const float mn = fmaxf(mrun, mx);
      const float alpha = __builtin_amdgcn_exp2f(mrun - mn);
      mrun = mn; lrun *= alpha;
#pragma unroll
      for (int i = 0; i < 16; ++i) { o0[i] *= alpha; o1[i] *= alpha; }
    }
    float ps = 0.f;
#pragma unroll
    for (int i = 0; i < 16; ++i) { p0[i] = __builtin_amdgcn_exp2f(p0[i] - mrun); ps += p0[i]; }
#pragma unroll
    for (int i = 0; i < 16; ++i) { p1[i] = __builtin_amdgcn_exp2f(p1[i] - mrun); ps += p1[i]; }
    lrun += ps;
    pv_step(o0, o1, Vc, r32, 0 + hi * 4, pack8<0>(p0));
    pv_step(o0, o1, Vc, r32, 16 + hi * 4, pack8<8>(p0));
    pv_step(o0, o1, Vc, r32, 32 + hi * 4, pack8<0>(p1));
    pv_step(o0, o1, Vc, r32, 48 + hi * 4, pack8<8>(p1));
  };
  __syncthreads();
  gload(a, 0); lstore(a, 0);
  gload(a, 1);
  __syncthreads();
  for (int kt = 0; kt < nkt; kt += 2) {
    if (kt + 2 < nkt) gload(b, kt + 2);
    tile_compute(0);
    lstore(a, 1);
    __syncthreads();
    if (kt + 3 < nkt) gload(a, kt + 3);
    tile_compute(1);
    if (kt + 2 < nkt) lstore(b, 0);
    __syncthreads();
  }
  lrun += __shfl_xor(lrun, 32, 64);
  const float inv = 1.f / lrun;
  u16* om = (u16*)(p.ws + OFF_OMLA) + (size_t)(orow0 + wave * 32 + r32) * 512 + h * 64;
#pragma unroll
  for (int g = 0; g < 4; ++g) {
    const int d = 8 * g + 4 * hi;
    *(uint2*)(om + d) = make_uint2(pack2(o0[4 * g] * inv, o0[4 * g + 1] * inv), pack2(o0[4 * g + 2] * inv, o0[4 * g + 3] * inv));
    *(uint2*)(om + 32 + d) = make_uint2(pack2(o1[4 * g] * inv, o1[4 * g + 1] * inv), pack2(o1[4 * g + 2] * inv, o1[4 * g + 3] * inv));
  }
#undef gload
#undef lstore
}

DI void readout_row(const Params& p, int l, int r) {
  LAUNDER_IDS
  const int lane = tid__ & 63;
  const u16* sc = (const u16*)(p.ws + OFF_R3);
  const size_t AS = (size_t)NT * 256;
  const size_t o = (size_t)r * 256 + lane * 4;
  const u16* Yf = (const u16*)(p.ws + OFF_R2);
  const uint2 yf = *(const uint2*)(Yf + o), yb = *(const uint2*)(Yf + AS + o);
  const uint2 ur = *(const uint2*)(sc + SA_R * AS + o), uv = *(const uint2*)(sc + SA_V * AS + o);
  const uint2 kf = *(const uint2*)(sc + SA_KDF * AS + o), kb = *(const uint2*)(sc + SA_KDB * AS + o), ug = *(const uint2*)(sc + SA_G * AS + o);
  float y[4] = {bflo(yf.x) + bflo(yb.x), bfhi(yf.x) + bfhi(yb.x), bflo(yf.y) + bflo(yb.y), bfhi(yf.y) + bfhi(yb.y)};
  const float rr[4] = {bflo(ur.x), bfhi(ur.x), bflo(ur.y), bfhi(ur.y)};
  const float vv[4] = {bflo(uv.x), bfhi(uv.x), bflo(uv.y), bfhi(uv.y)};
  const float km[4] = {0.5f * (bflo(kf.x) + bflo(kb.x)), 0.5f * (bfhi(kf.x) + bfhi(kb.x)), 0.5f * (bflo(kf.y) + bflo(kb.y)), 0.5f * (bfhi(kf.y) + bfhi(kb.y))};
  const float gg[4] = {bflo(ug.x), bfhi(ug.x), bflo(ug.y), bfhi(ug.y)};
  const float4 rk4 = *(const float4*)(p.in[I_RK] + l * 256 + lane * 4);
  const float4 lw4 = *(const float4*)(p.in[I_LNW] + l * 256 + lane * 4);
  const float4 lb4 = *(const float4*)(p.in[I_LNB] + l * 256 + lane * 4);
  const float rk[4] = {rk4.x, rk4.y, rk4.z, rk4.w}, lw[4] = {lw4.x, lw4.y, lw4.z, lw4.w}, lb[4] = {lb4.x, lb4.y, lb4.z, lb4.w};
  float s = y[0] + y[1] + y[2] + y[3];
  s = rowsum16(s);
  const float mu = s * (1.f / 64.f);
  float q = 0.f, bn = 0.f;
#pragma unroll
  for (int j = 0; j < 4; ++j) { const float d = y[j] - mu; q += d * d; bn += rr[j] * km[j] * rk[j]; }
  q = rowsum16(q); bn = rowsum16(bn);
  const float rstd = rsqrtf(q * (1.f / 64.f) + 64e-5f);
  float ov[4];
#pragma unroll
  for (int j = 0; j < 4; ++j) ov[j] = ((y[j] - mu) * rstd * lw[j] + lb[j] + bn * vv[j]) * gg[j];
  u16* orw = (u16*)(p.ws + OFF_R3 + SA_KKN * SZ_TOK256 + (size_t)NT * 512 * 2);
  *(uint2*)(orw + o) = make_uint2(pack2(ov[0], ov[1]), pack2(ov[2], ov[3]));
}

DI void phase_attn(const Params& p, int l, char* smem) {
  LAUNDER_IDS
  __shared__ int qslot_sh;
  const int nattn = (l == 0) ? 2048 + 128 : 2048;
  unsigned* ctr = (unsigned*)(p.ws + OFF_BAR) + 16 + l * 16;
  for (;;) {
    __syncthreads();
    if (tid__ == 0) qslot_sh = (int)__hip_atomic_fetch_add(ctr, 1u, __ATOMIC_RELAXED, __HIP_MEMORY_SCOPE_AGENT);
    __syncthreads();
    const int it = qslot_sh;
    if (it >= nattn) break;
    attn_item(p, it, smem);
  }
}
DI void phase_readout(const Params& p, int l, int Mout) {
  LAUNDER_IDS
  const int wave = tid__ >> 6;
  for (int r = blk__ * 4 + wave; r < Mout; r += gridDim.x * 4) readout_row(p, l, r);
}

DI void phase_merge(const Params& p, int l, int Mout, char* smem) {
  LAUNDER_IDS
  WAVE_COORDS
  const char* wl = p.ws + OFF_W + (size_t)l * W_LAYER;
  const u16* hg = (const u16*)(p.ws + OFF_HBG);
  const u16* opool = (const u16*)(p.ws + OFF_R4);
  const u16* omla = (const u16*)(p.ws + OFF_OMLA);
  const u16* orw = (const u16*)(p.ws + OFF_R3 + SA_KKN * SZ_TOK256) + (size_t)NT * 512;
  u16* mo = (u16*)(p.ws + OFF_R1);
  const int ntm = Mout / 128;
  for (int it = 0;; ++it) {
    int tm, tn;
    if (!tile_map(it, ntm, 8, blk__, gridDim.x, tm, tn)) break;
    const int m0 = tm * 128, n0 = tn * 128;
    f32x4 msum[4][4]; zero_accm<4, 4>(msum);
#pragma unroll 1
    for (int br = 0; br < 3; ++br) {
      unsigned gpk[4][4][2];
      {
        f32x4 ag[4][4]; zero_accm<4, 4>(ag);
        gemm256<4, 4>(ag, hg, 1024, (const u16*)(wl + WO_WIN) + (size_t)(2080 + br * 1024) * 1024, 1024, 1024, m0, n0, smem);
#pragma unroll
        for (int mi = 0; mi < 4; ++mi)
#pragma unroll
          for (int ni = 0; ni < 4; ++ni) {
            gpk[mi][ni][0] = pack2(sigmoidf_(ag[mi][ni][0]), sigmoidf_(ag[mi][ni][1]));
            gpk[mi][ni][1] = pack2(sigmoidf_(ag[mi][ni][2]), sigmoidf_(ag[mi][ni][3]));
          }
      }
      __builtin_amdgcn_sched_barrier(0);
      f32x4 ab[4][4]; zero_accm<4, 4>(ab);
      {
        const int Kb = br == 1 ? 512 : 256;
        const u16* Ab = br == 0 ? opool : br == 1 ? omla : orw;
        const u16* Wb = (const u16*)(wl + (br == 0 ? WO_BRP : br == 1 ? WO_BRM : WO_BRR));
        gemm256<4, 4>(ab, Ab, Kb, Wb, Kb, Kb, m0, n0, smem);
      }
#pragma unroll
      for (int mi = 0; mi < 4; ++mi)
#pragma unroll
        for (int ni = 0; ni < 4; ++ni) {
          msum[mi][ni][0] += bflo(gpk[mi][ni][0]) * ab[mi][ni][0];
          msum[mi][ni][1] += bfhi(gpk[mi][ni][0]) * ab[mi][ni][1];
          msum[mi][ni][2] += bflo(gpk[mi][ni][1]) * ab[mi][ni][2];
          msum[mi][ni][3] += bfhi(gpk[mi][ni][1]) * ab[mi][ni][3];
        }
      __builtin_amdgcn_sched_barrier(0);
    }
    EPI_BEGIN
#pragma unroll
    for (int mi = 0; mi < 4; mi += 2) {
      const int m = m0 + wr * 64 + (mi + (lq & 1)) * 16 + lr;
#pragma unroll
      for (int ni = 0; ni < 4; ++ni) {
        const int n = n0 + wc * 64 + ni * 16 + (lq >> 1) * 8;
        *(uint4*)(mo + (size_t)m * 1024 + n) = widen16(make_uint2(pack2(msum[mi][ni][0], msum[mi][ni][1]), pack2(msum[mi][ni][2], msum[mi][ni][3])),
                                                       make_uint2(pack2(msum[mi + 1][ni][0], msum[mi + 1][ni][1]), pack2(msum[mi + 1][ni][2], msum[mi + 1][ni][3])));
      }
    }
    EPI_END
  }
}

template <int MI, int NI>
DI void resid_tile(const u16* A, int K, const u16* Bt, const float* gate, const float* xl_in, const float* xc_in, float* xl_out, float* xc_out,
                   int m0, int n0, char* smem) {
  LAUNDER_IDS
  WAVE_COORDS
  f32x4 acc[MI][NI]; zero_accm<MI, NI>(acc);
  gemm256<MI, NI>(acc, A, K, Bt, K, K, m0, n0, smem);
  EPI_BEGIN
#pragma unroll
  for (int mi = 0; mi < MI; ++mi) {
    const int m = m0 + wr * 16 * MI + mi * 16 + lr;
    const int b9 = m < NTL ? m >> 12 : 8;
    const float* xi = xrow(xl_in, xc_in, m);
    float* xo = m < NTL ? xl_out + (size_t)m * D : xc_out + (size_t)(m - NTL) * D;
#pragma unroll
    for (int ni = 0; ni < NI; ++ni) {
      const int n = n0 + wc * 16 * NI + ni * 16 + lq * 4;
      const float4 g = *(const float4*)(gate + (size_t)b9 * 6144 + n);
      const float4 xv = *(const float4*)(xi + n);
      float4 ov;
      ov.x = xv.x + g.x * acc[mi][ni][0]; ov.y = xv.y + g.y * acc[mi][ni][1]; ov.z = xv.z + g.z * acc[mi][ni][2]; ov.w = xv.w + g.w * acc[mi][ni][3];
      *(float4*)(xo + n) = ov;
    }
    __builtin_amdgcn_sched_barrier(0);
  }
  EPI_END
}
DI void phase_resid(const Params& p, const u16* A, int K, const u16* Bt, const float* gate  ,
                    const float* xl_in, const float* xc_in, float* xl_out, float* xc_out, int Mout, char* smem) {
  LAUNDER_IDS
  for (int it = 0;; ++it) {
    int tm, tn;
    if (!tile_map(it, NTL / 256, 8, blk__, gridDim.x, tm, tn)) break;
    resid_tile<8, 4>(A, K, Bt, gate, xl_in, xc_in, xl_out, xc_out, tm * 256, tn * 128, smem);
  }
  if (Mout > NTL) {
    for (int t = blk__; t < (NTC / 64) * 16; t += gridDim.x) {
      const int tm = t >> 4, tn = t & 15;
      resid_tile<2, 2>(A, K, Bt, gate, xl_in, xc_in, xl_out, xc_out, NTL + tm * 64, tn * 64, smem);
    }
  }
}
DI void phase_mlp1(const Params& p, int l, int Mout, char* smem) {
  LAUNDER_IDS
  WAVE_COORDS
  const char* wl = p.ws + OFF_W + (size_t)l * W_LAYER;
  const u16* hb = (const u16*)(p.ws + OFF_HB2);
  u16* U = (u16*)(p.ws + OFF_R1);
  const int ntm = Mout / 256;
  for (int it = 0;; ++it) {
    int tm, tn;
    if (!tile_map(it, ntm, 32, blk__, gridDim.x, tm, tn)) break;
    const int m0 = tm * 256, n0 = tn * 128;
    f32x4 acc[8][4]; zero_accm<8, 4>(acc);
    gemm256<8, 4>(acc, hb, 1024, (const u16*)(wl + WO_W1), 1024, 1024, m0, n0, smem);
    EPI_BEGIN
#pragma unroll
    for (int mi = 0; mi < 8; mi += 2) {
      const int m = m0 + wr * 128 + (mi + (lq & 1)) * 16 + lr;
#pragma unroll
      for (int ni = 0; ni < 4; ++ni) {
        const int n = n0 + wc * 64 + ni * 16 + (lq >> 1) * 8;
        float va[4], vb[4];
#pragma unroll
        for (int j = 0; j < 4; ++j) { const float a = fmaxf(acc[mi][ni][j], 0.f); va[j] = a * a; const float b = fmaxf(acc[mi + 1][ni][j], 0.f); vb[j] = b * b; }
        *(uint4*)(U + (size_t)m * DFF + n) = widen16(make_uint2(pack2(va[0], va[1]), pack2(va[2], va[3])), make_uint2(pack2(vb[0], vb[1]), pack2(vb[2], vb[3])));
      }
      __builtin_amdgcn_sched_barrier(0);
    }
    EPI_END
  }
}

__global__ void __launch_bounds__(256, 2) fwd_megakernel(Params pk) {
  __shared__ __attribute__((aligned(16))) char smem[73728];
  cg::grid_group grid = cg::this_grid();
  if (threadIdx.x == 0) { g_base_sh[0] = (unsigned long long)pk.ws; g_base_sh[1] = (unsigned long long)pk.out; }
  xcd_barrier_post((unsigned*)(pk.ws + OFF_BAR));
  __syncthreads();
  phase_prep(pk, smem);
  if (pk.ws == nullptr) grid.sync();
  xcd_barrier();
  phase_tables(pk);
  xcd_barrier();
#define CTXBUF ((float*)(p.ws + OFF_CTX))
#define XLP (l == 0 ? p.in[I_X] : (const float*)p.out)
#define XCP (l == 0 ? p.in[I_CTX] : (const float*)CTXBUF)
#define MOUT (l == 0 ? NT : NTL)
#define WLP (p.ws + OFF_W + (size_t)l * W_LAYER)
#define TABP(nrm) ((const float*)(p.ws + OFF_TAB) + (size_t)(l * 2 + (nrm)) * 9 * 2048)
#define MODP(j) ((const float*)(p.ws + OFF_MODS) + (size_t)l * 9 * 6144 + (j) * 1024)
#ifndef PROBE_Q
#define PROBE_Q -1
#endif
#pragma nounroll
  for (int ph = 0; ph < 22; ++ph) {
    const int l = ph >= 11 ? 1 : 0, q = ph - l * 11;
    Params p = pk;
    {
      asm volatile("" ::: "memory");
      unsigned long long w_ = g_base_sh[0], o_ = g_base_sh[1];
      unsigned wl_ = (unsigned)w_, wh_ = (unsigned)(w_ >> 32), ol_ = (unsigned)o_, oh_ = (unsigned)(o_ >> 32);
      wl_ = __builtin_amdgcn_readfirstlane(wl_); wh_ = __builtin_amdgcn_readfirstlane(wh_); ol_ = __builtin_amdgcn_readfirstlane(ol_); oh_ = __builtin_amdgcn_readfirstlane(oh_);
      asm volatile("" : "+s"(wl_), "+s"(wh_), "+s"(ol_), "+s"(oh_));
      p.ws = (char*)(((unsigned long long)wh_ << 32) | wl_); p.out = (float*)(((unsigned long long)oh_ << 32) | ol_);
    }
#pragma nounroll
    for (int rep = 0; rep < (q == PROBE_Q ? 2 : 1); ++rep)
    switch (q) {
      case 0: phase_norm(XLP, XCP, TABP(0), (u16*)(p.ws + OFF_HB1), NT); break;
      case 1: phase_zgemm(p, l, smem); break;
      case 2: phase_tokA(p, l); phase_tokB(p, l, smem); break;
      case 3: phase_qkv(p, l, smem); break;
      case 4: phase_scan(p, smem); phase_attn(p, l, smem); break;
      case 5: phase_norm(XLP, XCP, TABP(0), (u16*)(p.ws + OFF_HBG), MOUT); phase_readout(p, l, MOUT); break;
      case 6: phase_merge(p, l, MOUT, smem); break;
      case 7: phase_resid(p, (const u16*)(p.ws + OFF_R1), 1024, (const u16*)(WLP + WO_WO), MODP(2), XLP, XCP, p.out, CTXBUF, MOUT, smem); break;
      case 8: phase_norm(p.out, CTXBUF, TABP(1), (u16*)(p.ws + OFF_HB2), MOUT); break;
      case 9: phase_mlp1(p, l, MOUT, smem); break;
      default: phase_resid(p, (const u16*)(p.ws + OFF_R1), 4096, (const u16*)(WLP + WO_W2), MODP(5), p.out, CTXBUF, p.out, CTXBUF, MOUT, smem); break;
    }
    if (ph != 21) xcd_barrier();
  }
}

extern "C" void kernel_launch(void* const* d_in, const int* in_sizes, int n_in, void* d_out, int out_size, void* d_ws, size_t ws_size, hipStream_t stream) {
  static int grid_blocks = 0;
  if (!grid_blocks) {
    int dev = 0, cus = 0, per_cu = 0;
    hipGetDevice(&dev);
    hipDeviceGetAttribute(&cus, hipDeviceAttributeMultiprocessorCount, dev);
    hipOccupancyMaxActiveBlocksPerMultiprocessor(&per_cu, fwd_megakernel, 256, 0);
    if (per_cu > 2) per_cu = 2;
    if (per_cu < 1) per_cu = 1;
    grid_blocks = cus * per_cu;
    if (ws_size < WS_END) fprintf(stderr, "kernel_launch: workspace too small: %zu < %zu\n", ws_size, (size_t)WS_END);
  }
  Params p{};
  for (int i = 0; i < 34; ++i) p.in[i] = (const float*)d_in[i];
  p.out = (float*)d_out;
  p.ws = (char*)d_ws;
  hipMemsetAsync(d_ws, 0, 16384, stream);
  void* args[] = {&p};
  hipError_t e = hipLaunchCooperativeKernel((void*)fwd_megakernel, dim3(grid_blocks), dim3(256), args, 0, stream);
  if (e != hipSuccess) fprintf(stderr, "cooperative launch failed: %s (grid %d)\n", hipGetErrorString(e), grid_blocks);
}
```
